# Optimizing an MI355X kernel written in HIP

```python
import jax
import jax.numpy as jnp
from jax import lax
import numpy as np

D_MODEL = 1024
BATCH = 8
SEQ = 4096
DEPTH = 2

POOL_WINDOWS = (2, 4, 8, 16)
N_POOL_GROUPS = len(POOL_WINDOWS)
POOL_WIDTH = D_MODEL // 2
POOL_GROUP = POOL_WIDTH // N_POOL_GROUPS
RET_HEADS = 4
RET_QK_DIM = 64
RET_V_DIM = 128
RET_WIDTH = RET_HEADS * RET_V_DIM
RET_CHUNK = 128
ROPE_BASE = 10000.0
AB_SPLITS = (POOL_WIDTH,
             POOL_WIDTH + RET_HEADS * RET_QK_DIM,
             POOL_WIDTH + 2 * RET_HEADS * RET_QK_DIM,
             POOL_WIDTH + 2 * RET_HEADS * RET_QK_DIM + RET_WIDTH)
AB_IN = POOL_WIDTH + 2 * RET_HEADS * RET_QK_DIM + 2 * RET_WIDTH
AB_OUT_IN = POOL_WIDTH + RET_WIDTH
HGRN_HEADS = 8
HGRN_EXPAND = 128
HGRN_FDIM = HGRN_HEADS * HGRN_EXPAND
HGRN_V_DIM = D_MODEL // HGRN_HEADS
HGRN_CHUNK = 32
C_SPLITS = (HGRN_FDIM, 2 * HGRN_FDIM, 2 * HGRN_FDIM + D_MODEL)
C_IN = 2 * HGRN_FDIM + 2 * D_MODEL
PEER_HEADS = 8
PEER_NKEYS = 128
PEER_EXPERTS = PEER_NKEYS * PEER_NKEYS
PEER_KEY_DIM = 256
PEER_HALF = PEER_KEY_DIM // 2
PEER_TOPK = 16
PEER_BLOCK = 128
DN_ALPHA = (2 * DEPTH) ** 0.25
DN_BETA = (8 * DEPTH) ** -0.25
LN_EPS = 1e-5
N_EVEN = (DEPTH + 1) // 2
N_ODD = DEPTH // 2

kernel_name = "hybrid_pool_retention_hgrn2_peer_deepnorm"


def layer_norm(x, g, b):
    xf = x.astype(jnp.float32)
    mu = xf.mean(-1, keepdims=True)
    var = jnp.square(xf - mu).mean(-1, keepdims=True)
    return ((xf - mu) * lax.rsqrt(var + LN_EPS) * g + b).astype(x.dtype)


def head_layernorm(o, g):
    B_, S_, H, d = o.shape
    mu = o.mean(-1, keepdims=True)
    var = jnp.square(o - mu).mean(-1, keepdims=True)
    return ((o - mu) * lax.rsqrt(var + LN_EPS)).reshape(B_, S_, H * d) * g


def head_rmsnorm(o, g):
    B_, S_, H, d = o.shape
    y = o * lax.rsqrt(jnp.square(o).mean(-1, keepdims=True) + LN_EPS)
    return y.reshape(B_, S_, H * d) * g


def to_chunks(t, chunk, heads):
    B_, S_ = t.shape[0], t.shape[1]
    t = t.astype(jnp.float32).reshape(B_, S_ // chunk, chunk, heads, -1)
    return t.transpose(1, 0, 3, 2, 4)


def from_chunks(t):
    N, B_, H, C, d = t.shape
    return t.transpose(1, 0, 3, 2, 4).reshape(B_, N * C, H, d)


def pool_mixer(u, pool_w, pool_scale):
    B_, S_, _ = u.shape
    ug = u.astype(jnp.float32).reshape(B_, S_, N_POOL_GROUPS, POOL_GROUP)
    count = jnp.arange(1, S_ + 1, dtype=jnp.float32)
    outs = []
    for gi, w in enumerate(POOL_WINDOWS):
        xg = ug[:, :, gi]
        cs = jnp.cumsum(xg, axis=1)
        lagged = jnp.pad(cs, ((0, 0), (w, 0), (0, 0)))[:, :S_]
        mean = (cs - lagged) / jnp.minimum(count, float(w))[None, :, None]
        outs.append(mean - xg)
    p = jnp.stack(outs, axis=2).astype(u.dtype)
    y = jnp.einsum('bsgc,gcd->bsgd', p, pool_w).reshape(B_, S_, POOL_WIDTH)
    return y * pool_scale


def rotary(x, pos):
    half = x.shape[-1] // 2
    inv = 1.0 / (ROPE_BASE ** jnp.linspace(0.0, 1.0, half, dtype=jnp.float32))
    ang = pos[:, None] * inv[None, :]
    cos = jnp.cos(ang)[None, :, None, :]
    sin = jnp.sin(ang)[None, :, None, :]
    xf = x.astype(jnp.float32)
    x1, x2 = xf[..., :half], xf[..., half:]
    return jnp.concatenate([x1 * cos - x2 * sin, x2 * cos + x1 * sin], axis=-1)


def retention(q, k, v):
    C = RET_CHUNK
    H = q.shape[2]
    log_gamma = jnp.log1p(-jnp.exp2(-5.0 - jnp.arange(H, dtype=jnp.float32)))
    idx = jnp.arange(C, dtype=jnp.float32)
    diff = idx[:, None] - idx[None, :]
    dmask = jnp.where(diff >= 0, jnp.exp(log_gamma[:, None, None] * jnp.maximum(diff, 0.0)), 0.0)
    q_decay = jnp.exp(log_gamma[:, None] * (idx[None, :] + 1.0))[None, :, :, None]
    k_decay = jnp.exp(log_gamma[:, None] * (C - 1.0 - idx[None, :]))[None, :, :, None]
    chunk_decay = jnp.exp(log_gamma * C)[None, :, None, None]
    qc, kc, vc = to_chunks(q, C, H), to_chunks(k, C, H), to_chunks(v, C, H)
    scores = jnp.einsum('nbhcd,nbhsd->nbhcs', qc, kc) * dmask
    intra = jnp.einsum('nbhcs,nbhse->nbhce', scores, vc)

    def step(state, inp):
        q_n, k_n, v_n = inp
        cross = jnp.einsum('bhcd,bhde->bhce', q_n, state) * q_decay
        state = state * chunk_decay + jnp.einsum('bhsd,bhse->bhde', k_n * k_decay, v_n)
        return state, cross

    state0 = jnp.zeros((q.shape[0], H, q.shape[3], v.shape[3]), jnp.float32)
    _, cross = lax.scan(step, state0, (qc, kc, vc))
    return from_chunks(intra + cross)


def hgrn2_chunkwise(q, k, v, logf):
    C, H = HGRN_CHUNK, HGRN_HEADS
    qc, kc, vc, lc = (to_chunks(t, C, H) for t in (q, k, v, logf))
    b = jnp.cumsum(lc, axis=3)
    b_last = b[:, :, :, -1:, :]
    q_in = qc * jnp.exp(b)
    k_in = kc * jnp.exp(-b)
    k_out = kc * jnp.exp(b_last - b)
    causal = jnp.tril(jnp.ones((C, C), dtype=bool))
    scores = jnp.where(causal, jnp.einsum('nbhcd,nbhsd->nbhcs', q_in, k_in), 0.0)
    intra = jnp.einsum('nbhcs,nbhse->nbhce', scores, vc)
    chunk_decay = jnp.exp(b_last[:, :, :, 0, :])

    def step(state, inp):
        q_n, k_n, v_n, d_n = inp
        cross = jnp.einsum('bhcd,bhde->bhce', q_n, state)
        state = state * d_n[..., None] + jnp.einsum('bhsd,bhse->bhde', k_n, v_n)
        return state, cross

    state0 = jnp.zeros((q.shape[0], H, HGRN_EXPAND, HGRN_V_DIM), jnp.float32)
    _, cross = lax.scan(step, state0, (q_in, k_out, vc, chunk_decay))
    return from_chunks(intra + cross)


def mixer_ab(x, w_in, pool_w, pool_scale, ret_norm_g, w_out):
    B_, S_, _ = x.shape
    h = x @ w_in
    u, q, k, v, g = jnp.split(h, AB_SPLITS, axis=-1)
    y_a = pool_mixer(u, pool_w, pool_scale)
    pos = jnp.arange(S_, dtype=jnp.float32)
    q = rotary(q.reshape(B_, S_, RET_HEADS, RET_QK_DIM), pos)
    k = rotary(k.reshape(B_, S_, RET_HEADS, RET_QK_DIM), pos) * (RET_QK_DIM ** -0.5)
    o = retention(q, k, v.reshape(B_, S_, RET_HEADS, RET_V_DIM))
    y_b = head_layernorm(o, ret_norm_g) * jax.nn.silu(g.astype(jnp.float32))
    y = jnp.concatenate([y_a.astype(x.dtype), y_b.astype(x.dtype)], axis=-1)
    return y @ w_out


def mixer_c(x, w_in, lower_bound, norm_g, w_out):
    h = x @ w_in
    q, fz, i, g = jnp.split(h, C_SPLITS, axis=-1)
    f = lower_bound + (1.0 - lower_bound) * jax.nn.sigmoid(fz.astype(jnp.float32))
    o = hgrn2_chunkwise(q, 1.0 - f, i, jnp.log(f))
    y = head_rmsnorm(o, norm_g) * jax.nn.silu(g.astype(jnp.float32))
    return y.astype(x.dtype) @ w_out


def peer(x, w_q, sub_keys, u_tab, v_tab):
    B_, S_, D = x.shape
    xb = x.reshape((B_ * S_) // PEER_BLOCK, PEER_BLOCK, D)
    kk = PEER_TOPK * PEER_TOPK

    def block(xt):
        T = xt.shape[0]
        q = (xt @ w_q).reshape(T, PEER_HEADS, 2, PEER_HALF)
        s = jnp.einsum('thpd,hpkd->thpk', q, sub_keys).astype(jnp.float32)
        s_top, i_top = lax.top_k(s, PEER_TOPK)
        cand = (s_top[:, :, 0, :, None] + s_top[:, :, 1, None, :]).reshape(T, PEER_HEADS, kk)
        cand_id = (i_top[:, :, 0, :, None] * PEER_NKEYS + i_top[:, :, 1, None, :]).reshape(T, PEER_HEADS, kk)
        best, pos = lax.top_k(cand, PEER_TOPK)
        eid = jnp.take_along_axis(cand_id, pos, axis=-1)
        gate = jax.nn.softmax(best, axis=-1)
        u_sel = jnp.take(u_tab, eid, axis=0)
        v_sel = jnp.take(v_tab, eid, axis=0)
        act = jax.nn.gelu(jnp.einsum('td,thkd->thk', xt, u_sel).astype(jnp.float32), approximate=False)
        coef = (gate * act).astype(xt.dtype)
        return jnp.einsum('thk,thkd->td', coef, v_sel)

    return lax.map(block, xb).reshape(B_, S_, D)


def setup_inputs(seed: int = 0) -> dict:
    key = jax.random.key(seed)
    ks = jax.random.split(key, 16)

    def nrm(k, shape, scale):
        return jax.random.normal(k, shape, jnp.float32) * scale

    return {
        "x": nrm(ks[0], (BATCH, SEQ, D_MODEL), 1.0),
        "ab_w_in": nrm(ks[1], (N_EVEN, D_MODEL, AB_IN), D_MODEL ** -0.5),
        "pool_w": nrm(ks[2], (N_EVEN, N_POOL_GROUPS, POOL_GROUP, POOL_GROUP), POOL_GROUP ** -0.5),
        "pool_scale": 1.0 + nrm(ks[3], (N_EVEN, POOL_WIDTH), 0.02),
        "ret_norm_g": 1.0 + nrm(ks[4], (N_EVEN, RET_WIDTH), 0.02),
        "ab_w_out": nrm(ks[5], (N_EVEN, AB_OUT_IN, D_MODEL), AB_OUT_IN ** -0.5 * DN_BETA),
        "c_w_in": nrm(ks[6], (N_ODD, D_MODEL, C_IN), D_MODEL ** -0.5),
        "hgrn_lb": nrm(ks[7], (DEPTH, HGRN_FDIM), 0.1),
        "hgrn_norm_g": 1.0 + nrm(ks[8], (N_ODD, HGRN_HEADS * HGRN_V_DIM), 0.02),
        "c_w_out": nrm(ks[9], (N_ODD, D_MODEL, D_MODEL), D_MODEL ** -0.5 * DN_BETA),
        "peer_w_q": nrm(ks[10], (DEPTH, D_MODEL, PEER_HEADS * PEER_KEY_DIM), D_MODEL ** -0.5),
        "peer_sub_keys": nrm(ks[11], (DEPTH, PEER_HEADS, 2, PEER_NKEYS, PEER_HALF), PEER_HALF ** -0.5),
        "peer_u": nrm(ks[12], (DEPTH, PEER_EXPERTS, D_MODEL), D_MODEL ** -0.5),
        "peer_v": nrm(ks[13], (DEPTH, PEER_EXPERTS, D_MODEL), PEER_HEADS ** -0.5 * DN_BETA),
        "ln_g": 1.0 + nrm(ks[14], (DEPTH, 2, D_MODEL), 0.02),
        "ln_b": nrm(ks[15], (DEPTH, 2, D_MODEL), 0.02),
    }


def reference(x, ab_w_in, pool_w, pool_scale, ret_norm_g, ab_w_out, c_w_in, hgrn_lb,
              hgrn_norm_g, c_w_out, peer_w_q, peer_sub_keys, peer_u, peer_v, ln_g, ln_b):
    lb_p = jax.nn.softmax(hgrn_lb.astype(jnp.float32), axis=0)
    lower_bounds = jnp.cumsum(lb_p, axis=0) - lb_p[0]
    h = x
    for layer in range(DEPTH):
        j = layer // 2
        if layer % 2 == 0:
            mix = mixer_ab(h, ab_w_in[j], pool_w[j], pool_scale[j], ret_norm_g[j], ab_w_out[j])
        else:
            mix = mixer_c(h, c_w_in[j], lower_bounds[layer], hgrn_norm_g[j], c_w_out[j])
        h = layer_norm(DN_ALPHA * h + mix.astype(h.dtype), ln_g[layer, 0], ln_b[layer, 0])
        ffn = peer(h, peer_w_q[layer], peer_sub_keys[layer], peer_u[layer], peer_v[layer])
        h = layer_norm(DN_ALPHA * h + ffn.astype(h.dtype), ln_g[layer, 1], ln_b[layer, 1])
    return h
```

```cpp
#include <hip/hip_runtime.h>
#include <cstdio>
#include <cstdint>

#ifndef MK_N_LAUNCHES
#define MK_N_LAUNCHES 18
#endif
constexpr int NPHASE = 18;
constexpr int N_LAUNCHES = MK_N_LAUNCHES;

constexpr int BATCH = 8, SEQ = 4096, D = 1024, T = BATCH * SEQ;
constexpr int AB_IN = 2048, C_IN = 4096, NEXP = 16384;
constexpr float LN_EPS = 1e-5f;
constexpr float ALPHA = 1.41421356237309515f;
constexpr int NWAVES = 8, NTHR = 512;

constexpr size_t MiB = 1u << 20;
constexpr size_t WS_CTL = 0, CTL_ZERO_BYTES = 1 * MiB;
constexpr size_t WS_LB = 1 * MiB;
constexpr size_t WS_ROPE = 2 * MiB;
constexpr size_t WS_WABIN = 4 * MiB;
constexpr size_t WS_WABOUT = 8 * MiB;
constexpr size_t WS_WCIN = 10 * MiB;
constexpr size_t WS_WCOUT = 18 * MiB;
constexpr size_t WS_WQ = 20 * MiB;
constexpr size_t WS_KEYS = 28 * MiB;
constexpr size_t WS_XB = 96 * MiB;
constexpr size_t WS_H0 = 160 * MiB;
constexpr size_t WS_LST = 288 * MiB;
constexpr size_t WS_Y = 320 * MiB;
constexpr size_t WS_H1 = 384 * MiB;
constexpr size_t WS_EID = 448 * MiB;
constexpr size_t WS_GATE = 464 * MiB;
constexpr size_t WS_CQ = 160 * MiB, WS_CK = 224 * MiB, WS_CV = 288 * MiB, WS_CG = 352 * MiB;
constexpr size_t WS_O = 416 * MiB;
constexpr size_t WS_Y2 = 160 * MiB;
constexpr size_t WS_Q1 = 224 * MiB;
constexpr size_t WS_END = 480 * MiB;

constexpr int CW_BAR = 4096;
constexpr int LDS_BYTES = 147456;
constexpr int MISC_OFF = LDS_BYTES - 128;

#define GAS __attribute__((address_space(1)))
#define LAS __attribute__((address_space(3)))
typedef unsigned short bf16;
typedef unsigned v4u __attribute__((ext_vector_type(4)));
typedef unsigned v2u __attribute__((ext_vector_type(2)));
typedef float f32x4 __attribute__((ext_vector_type(4)));
typedef GAS unsigned gu32;
#define RLX_AGENT __ATOMIC_RELAXED, __HIP_MEMORY_SCOPE_AGENT
#define LDS_WAIT() asm volatile("s_waitcnt lgkmcnt(0)" ::: "memory")
__device__ __forceinline__ unsigned f2bf(float f) { unsigned u = __builtin_bit_cast(unsigned, f); return (u + 0x7fffu + ((u >> 16) & 1u)) >> 16; }
__device__ __forceinline__ unsigned pk2(float lo, float hi) { return f2bf(lo) | (f2bf(hi) << 16); }
__device__ __forceinline__ float bf2f(unsigned b) { return __builtin_bit_cast(float, b << 16); }
__device__ __forceinline__ float bflo(unsigned w) { return __builtin_bit_cast(float, w << 16); }
__device__ __forceinline__ float bfhi(unsigned w) { return __builtin_bit_cast(float, w & 0xffff0000u); }
__device__ __forceinline__ float wave_sum(float v) {
#pragma unroll
    for (int o = 1; o < 64; o <<= 1) v += __shfl_xor(v, o);
    return v;
}

#define XB_TMO      128
#define XB_XCNT(j)  (256  + 64 * (j))
#define XB_XSUB(j)  (1280 + 64 * (j))
#define XB_XGEN(j)  (2304 + 64 * (j))
#define XB_TOP      3328
#define XB_TOPGEN   3392
#define XCD_BAR_WORDS 3456
#define XB_SPIN_CAP (1u << 21)
__device__ __forceinline__ unsigned xb_ld(unsigned* p)              { return __hip_atomic_load(p, __ATOMIC_RELAXED, __HIP_MEMORY_SCOPE_AGENT); }
__device__ __forceinline__ unsigned xb_add(unsigned* p, unsigned v) { return __hip_atomic_fetch_add(p, v, __ATOMIC_RELAXED, __HIP_MEMORY_SCOPE_AGENT); }
__device__ __forceinline__ unsigned xb_xcc_id() { return (unsigned)__builtin_amdgcn_s_getreg((3 << 11) | 20) & 0xFu; }
#define XB_SPIN(cond, bar) do { unsigned _sp = 0; while (cond) { __builtin_amdgcn_s_sleep(1); \
    if ((++_sp & 255u) == 0u) { if (xb_ld(&(bar)[XB_TMO])) break; if (_sp > XB_SPIN_CAP) { atomicAdd(&(bar)[XB_TMO], 1u); break; } } } } while (0)
struct XcdBarrier { unsigned* bar; unsigned x; volatile LAS unsigned* st; };
__device__ __forceinline__ XcdBarrier xcd_barrier_post(unsigned* bar, volatile LAS unsigned* st) {
    XcdBarrier b; b.bar = bar; b.x = xb_xcc_id(); b.st = st;
    if (threadIdx.x == 0) (void)xb_add(&bar[XB_XCNT(b.x)], 1u);
    return b;
}
__device__ __forceinline__ void xcd_barrier_complete(unsigned* bar, unsigned x, unsigned& nloc, unsigned& nx) {
    const unsigned G = gridDim.x * gridDim.y * gridDim.z;
    unsigned sum, cnt, mine, sp = 0u;
    for (;;) {
        sum = 0u; cnt = 0u; mine = 0u;
#pragma unroll
        for (unsigned j = 0; j < 16; ++j) { const unsigned c = xb_ld(&bar[XB_XCNT(j)]); sum += c; cnt += (c > 0u) ? 1u : 0u; mine = (j == x) ? c : mine; }
        if (sum == G) break;
        __builtin_amdgcn_s_sleep(1);
        if ((++sp & 255u) == 0u) { if (xb_ld(&bar[XB_TMO])) break; if (sp > XB_SPIN_CAP) { atomicAdd(&bar[XB_TMO], 1u); break; } }
    }
    nloc = mine > 0u ? mine : 1u; nx = cnt > 0u ? cnt : 1u;
}
__device__ __forceinline__ void xcd_barrier(const XcdBarrier& b) {
    asm volatile("s_waitcnt vmcnt(0)" ::: "memory");
    __syncthreads();
    if (threadIdx.x == 0) {
        unsigned* bar = b.bar;
        __builtin_amdgcn_s_waitcnt(0);
        unsigned nloc = b.st[0], nx = b.st[1];
        if (nloc == 0u) { xcd_barrier_complete(bar, b.x, nloc, nx); b.st[0] = nloc; b.st[1] = nx; }
        const unsigned old = xb_add(&bar[XB_XSUB(b.x)], 1u);
        const unsigned gen = old / nloc;
        if (old + 1u == (gen + 1u) * nloc) {
            __builtin_amdgcn_fence(__ATOMIC_RELEASE, "agent");
            asm volatile("s_waitcnt vmcnt(0)" ::: "memory");
            const unsigned og = xb_add(&bar[XB_TOP], 1u);
            const unsigned tg = og / nx;
            if (og + 1u == (tg + 1u) * nx) xb_add(&bar[XB_TOPGEN], 1u);
            else XB_SPIN(xb_ld(&bar[XB_TOPGEN]) == tg, bar);
            __builtin_amdgcn_fence(__ATOMIC_ACQUIRE, "agent");
            xb_add(&bar[XB_XGEN(b.x)], 1u);
            asm volatile("s_waitcnt vmcnt(0)" ::: "memory");
        } else {
            XB_SPIN(xb_ld(&bar[XB_XGEN(b.x)]) == gen, bar);
            __builtin_amdgcn_fence(__ATOMIC_ACQUIRE, "agent");
            asm volatile("s_waitcnt vmcnt(0)" ::: "memory");
        }
    }
    __syncthreads();
}

__device__ __forceinline__ void p0_transpose_item(const float* W, int K, int N, bf16* WT, LAS float* scr, int item, int lane) {
    const int nblk = N / 32, kb = item / nblk, nb = item % nblk, k0 = 64 * kb, n0 = 32 * nb;
#pragma unroll 8
    for (int i = 0; i < 32; ++i) { const int kk = 2 * i + (lane >> 5); scr[kk * 33 + (lane & 31)] = W[(size_t)(k0 + kk) * N + n0 + (lane & 31)]; }
    LDS_WAIT(); asm volatile("" ::: "memory");
    const int c = lane & 7;
#pragma unroll
    for (int j = 0; j < 4; ++j) { const int n = (lane >> 3) + 8 * j; const LAS float* s = scr + (8 * c) * 33 + n;
        v4u o; o.x = pk2(s[0 * 33], s[1 * 33]); o.y = pk2(s[2 * 33], s[3 * 33]); o.z = pk2(s[4 * 33], s[5 * 33]); o.w = pk2(s[6 * 33], s[7 * 33]);
        *(GAS v4u*)(WT + (size_t)(n0 + n) * K + k0 + 8 * c) = o; }
    LDS_WAIT(); asm volatile("" ::: "memory");
}

template <class Epi>
__device__ __forceinline__ void gemm_naive(LAS unsigned char* lds, const bf16* A, const bf16* Bt, int M, int N, int K, const Epi& E) {
    LAS float* As = (LAS float*)lds;
    LAS float* Bs = As + 128 * 33;
    const int tid = threadIdx.x, tx = tid & 15, ty = tid >> 4;
    const int ntn = N / 128, ntiles = (M / 128) * ntn;
    for (int tile = blockIdx.x; tile < ntiles; tile += gridDim.x) {
        const int tm = tile / ntn, tn = tile % ntn;
        float acc[4][8];
#pragma unroll
        for (int i = 0; i < 4; ++i)
#pragma unroll
            for (int j = 0; j < 8; ++j) acc[i][j] = 0.f;
        for (int k0 = 0; k0 < K; k0 += 32) {
            { const int r = tid >> 2, kc = (tid & 3) * 8;
              const v4u va = *(const GAS v4u*)(A + (size_t)(tm * 128 + r) * K + k0 + kc);
              const v4u vb = *(const GAS v4u*)(Bt + (size_t)(tn * 128 + r) * K + k0 + kc);
              LAS float* pa = As + r * 33 + kc; LAS float* pb = Bs + r * 33 + kc;
              pa[0] = bflo(va.x); pa[1] = bfhi(va.x); pa[2] = bflo(va.y); pa[3] = bfhi(va.y); pa[4] = bflo(va.z); pa[5] = bfhi(va.z); pa[6] = bflo(va.w); pa[7] = bfhi(va.w);
              pb[0] = bflo(vb.x); pb[1] = bfhi(vb.x); pb[2] = bflo(vb.y); pb[3] = bfhi(vb.y); pb[4] = bflo(vb.z); pb[5] = bfhi(vb.z); pb[6] = bflo(vb.w); pb[7] = bfhi(vb.w); }
            __syncthreads();
#pragma unroll 8
            for (int kk = 0; kk < 32; ++kk) {
                float a[4], b[8];
#pragma unroll
                for (int i = 0; i < 4; ++i) a[i] = As[(ty * 4 + i) * 33 + kk];
#pragma unroll
                for (int j = 0; j < 8; ++j) b[j] = Bs[(tx + 16 * j) * 33 + kk];
#pragma unroll
                for (int i = 0; i < 4; ++i)
#pragma unroll
                    for (int j = 0; j < 8; ++j) acc[i][j] += a[i] * b[j];
            }
            __syncthreads();
        }
#pragma unroll
        for (int i = 0; i < 4; ++i)
#pragma unroll
            for (int j = 0; j < 8; ++j) E(tm * 128 + ty * 4 + i, tn * 128 + tx + 16 * j, acc[i][j]);
    }
}
struct EpiStore { bf16* O; int ldc;
    __device__ __forceinline__ void operator()(int r, int c, float v) const { O[(size_t)r * ldc + c] = (bf16)f2bf(v); } };
struct EpiResid { const bf16* X; float* Z;
    __device__ __forceinline__ void operator()(int r, int c, float v) const { Z[(size_t)r * D + c] = ALPHA * bf2f(X[(size_t)r * D + c]) + v; } };
struct EpiCIn { bf16 *CQ, *CK, *CV, *CG; const float* lb;
    __device__ __forceinline__ void operator()(int r, int c, float v) const {
        const int seg = c >> 10, cc = c & 1023; const size_t o = (size_t)r * D + cc;
        if (seg == 0) CQ[o] = (bf16)f2bf(v);
        else if (seg == 1) { const float k = (1.f - lb[cc]) / (1.f + expf(v)); CK[o] = (bf16)f2bf(k); }
        else if (seg == 2) CV[o] = (bf16)f2bf(v);
        else CG[o] = (bf16)f2bf(v);
    } };

__device__ __forceinline__ float gamma_log2(int h) { return log2f(1.f - exp2f(-5.f - (float)h)); }

__device__ __forceinline__ void phase_prologue(LAS unsigned char* lds, const float* const* in, unsigned char* ws) {
    const int tid = threadIdx.x, lane = tid & 63, wave = tid >> 6;
    const int gw = blockIdx.x * NWAVES + wave, NGW = gridDim.x * NWAVES;
    LAS float* scr = (LAS float*)(lds + wave * 16384);
    constexpr int I_ABIN = (D / 64) * (AB_IN / 32), I_SQ = (D / 64) * (D / 32), I_CIN = (D / 64) * (C_IN / 32), I_WQ = (D / 64) * (2048 / 32);
    constexpr int NITEMS = I_ABIN + I_SQ + I_CIN + I_SQ + 2 * I_WQ;
    for (int it = gw; it < NITEMS; it += NGW) {
        int r = it;
        if (r < I_ABIN) { p0_transpose_item(in[1], D, AB_IN, (bf16*)(ws + WS_WABIN), scr, r, lane); continue; } r -= I_ABIN;
        if (r < I_SQ) { p0_transpose_item(in[5], D, D, (bf16*)(ws + WS_WABOUT), scr, r, lane); continue; } r -= I_SQ;
        if (r < I_CIN) { p0_transpose_item(in[6], D, C_IN, (bf16*)(ws + WS_WCIN), scr, r, lane); continue; } r -= I_CIN;
        if (r < I_SQ) { p0_transpose_item(in[9], D, D, (bf16*)(ws + WS_WCOUT), scr, r, lane); continue; } r -= I_SQ;
        if (r < I_WQ) { p0_transpose_item(in[10], D, 2048, (bf16*)(ws + WS_WQ), scr, r, lane); continue; } r -= I_WQ;
        p0_transpose_item(in[10] + (size_t)D * 2048, D, 2048, (bf16*)(ws + WS_WQ) + (size_t)2048 * D, scr, r, lane);
    }
    const size_t gt = (size_t)blockIdx.x * NTHR + tid, NT = (size_t)gridDim.x * NTHR;
    { const float* x = in[0]; bf16* xb = (bf16*)(ws + WS_XB);
      for (size_t i = gt; i < (size_t)T * D / 8; i += NT) { const f32x4 a = *(const GAS f32x4*)(x + i * 8), b = *(const GAS f32x4*)(x + i * 8 + 4);
          v4u o; o.x = pk2(a.x, a.y); o.y = pk2(a.z, a.w); o.z = pk2(b.x, b.y); o.w = pk2(b.z, b.w); *(GAS v4u*)(xb + i * 8) = o; } }
    { const float* k = in[11]; bf16* kb = (bf16*)(ws + WS_KEYS);
      for (size_t i = gt; i < (size_t)2 * 8 * 2 * 128 * 128 / 8; i += NT) { const f32x4 a = *(const GAS f32x4*)(k + i * 8), b = *(const GAS f32x4*)(k + i * 8 + 4);
          v4u o; o.x = pk2(a.x, a.y); o.y = pk2(a.z, a.w); o.z = pk2(b.x, b.y); o.w = pk2(b.z, b.w); *(GAS v4u*)(kb + i * 8) = o; } }
    { float* ct = (float*)(ws + WS_ROPE); float* st = ct + 4096 * 32;
      for (size_t i = gt; i < (size_t)4096 * 32; i += NT) { const int pos = (int)(i >> 5), f = (int)(i & 31);
          const double inv = exp(-log(10000.0) * ((double)f / 31.0)); const double ang = (double)pos * inv;
          ct[i] = (float)cos(ang); st[i] = (float)sin(ang); } }
    { const float* l = in[7]; float* lb = (float*)(ws + WS_LB);
      for (size_t i = gt; i < 1024; i += NT) { const float a = l[i], b = l[1024 + i]; const float m = fmaxf(a, b); const float ea = expf(a - m), eb = expf(b - m); lb[i] = eb / (ea + eb); } }
}

__device__ __forceinline__ void phase_ret_local(LAS unsigned char* lds, unsigned char* ws) {
    const int tid = threadIdx.x;
    const bf16* H0 = (const bf16*)(ws + WS_H0); float* LST = (float*)(ws + WS_LST);
    const float* ct = (const float*)(ws + WS_ROPE); const float* st = ct + 4096 * 32;
    LAS float* kd = (LAS float*)lds;
    LAS float* vv = (LAS float*)(lds + 32768);
    for (int item = blockIdx.x; item < 1024; item += gridDim.x) {
        const int n = item & 31, h = (item >> 5) & 3, b = item >> 7;
        const size_t t0 = (size_t)b * SEQ + n * 128; const float lg = gamma_log2(h);
        for (int idx = tid; idx < 4096; idx += NTHR) { const int s = idx >> 5, i = idx & 31, pos = n * 128 + s;
            const bf16* row = H0 + (t0 + s) * AB_IN + 768 + h * 64;
            const float x1 = bf2f(row[i]), x2 = bf2f(row[i + 32]); const float c = ct[pos * 32 + i], sn = st[pos * 32 + i];
            const float dec = exp2f((float)(127 - s) * lg) * 0.125f;
            kd[s * 64 + i] = (x1 * c - x2 * sn) * dec; kd[s * 64 + i + 32] = (x2 * c + x1 * sn) * dec; }
        for (int idx = tid; idx < 16384; idx += NTHR) { const int s = idx >> 7, e = idx & 127; vv[idx] = bf2f(H0[(t0 + s) * AB_IN + 1024 + h * 128 + e]); }
        __syncthreads();
        const int e = tid & 127, dg = tid >> 7;
        float acc[16];
#pragma unroll
        for (int j = 0; j < 16; ++j) acc[j] = 0.f;
        for (int s = 0; s < 128; ++s) { const float v = vv[s * 128 + e];
#pragma unroll
            for (int j = 0; j < 16; ++j) acc[j] += kd[s * 64 + dg * 16 + j] * v; }
#pragma unroll
        for (int j = 0; j < 16; ++j) LST[(size_t)item * 8192 + (dg * 16 + j) * 128 + e] = acc[j];
        __syncthreads();
    }
}
__device__ __forceinline__ void phase_ret_prefix(unsigned char* ws) {
    float* LST = (float*)(ws + WS_LST);
    const size_t gt = (size_t)blockIdx.x * NTHR + threadIdx.x, NT = (size_t)gridDim.x * NTHR;
    for (size_t idx = gt; idx < (size_t)32 * 8192; idx += NT) { const int bh = (int)(idx >> 13), el = (int)(idx & 8191), h = bh & 3;
        const float g128 = exp2f(128.f * gamma_log2(h)); float S = 0.f;
        for (int n = 0; n < 32; ++n) { float* p = LST + ((size_t)(bh * 32 + n) * 8192 + el); const float tmp = *p; *p = S; S = S * g128 + tmp; } }
}
__device__ __forceinline__ void phase_ret_out_pool(LAS unsigned char* lds, const float* const* in, unsigned char* ws) {
    const int tid = threadIdx.x;
    const bf16* H0 = (const bf16*)(ws + WS_H0); const float* LST = (const float*)(ws + WS_LST); bf16* Y = (bf16*)(ws + WS_Y);
    const float* ct = (const float*)(ws + WS_ROPE); const float* st = ct + 4096 * 32;
    const float* pool_w = in[2]; const float* pool_scale = in[3]; const float* ret_g = in[4];
    LAS float* qs = (LAS float*)lds;
    LAS float* ks = qs + 128 * 65;
    LAS float* R2 = (LAS float*)(lds + 66560);
    LAS float* PA = (LAS float*)lds;
    LAS float* PB = (LAS float*)(lds + 66048);
    for (int item = blockIdx.x; item < 256; item += gridDim.x) {
        const int n = item & 31, b = item >> 5; const size_t t0 = (size_t)b * SEQ + n * 128;
        const int c = tid >> 2, eg = tid & 3;
        for (int h = 0; h < 4; ++h) {
            const float lg = gamma_log2(h);
            for (int idx = tid; idx < 4096; idx += NTHR) { const int s = idx >> 5, i = idx & 31, pos = n * 128 + s;
                const bf16* rq = H0 + (t0 + s) * AB_IN + 512 + h * 64; const bf16* rk = H0 + (t0 + s) * AB_IN + 768 + h * 64;
                const float cs = ct[pos * 32 + i], sn = st[pos * 32 + i];
                const float q1 = bf2f(rq[i]), q2 = bf2f(rq[i + 32]), k1 = bf2f(rk[i]), k2 = bf2f(rk[i + 32]);
                qs[s * 65 + i] = q1 * cs - q2 * sn; qs[s * 65 + i + 32] = q2 * cs + q1 * sn;
                ks[s * 65 + i] = (k1 * cs - k2 * sn) * 0.125f; ks[s * 65 + i + 32] = (k2 * cs + k1 * sn) * 0.125f; }
            { const float* Sg = LST + (size_t)((b * 4 + h) * 32 + n) * 8192;
              for (int idx = tid; idx < 8192; idx += NTHR) R2[idx] = Sg[idx]; }
            __syncthreads();
            float o[32];
#pragma unroll
            for (int j = 0; j < 32; ++j) o[j] = 0.f;
            for (int d = 0; d < 64; ++d) { const float qv = qs[c * 65 + d];
#pragma unroll
                for (int j = 0; j < 32; ++j) o[j] += qv * R2[d * 128 + eg * 32 + j]; }
            { const float qd = exp2f((float)(c + 1) * lg);
#pragma unroll
              for (int j = 0; j < 32; ++j) o[j] *= qd; }
            __syncthreads();
            for (int idx = tid; idx < 16384; idx += NTHR) { const int s = idx >> 7, e = idx & 127; R2[idx] = bf2f(H0[(t0 + s) * AB_IN + 1024 + h * 128 + e]); }
            __syncthreads();
            for (int s = 0; s <= c; ++s) {
                float dot = 0.f;
#pragma unroll 16
                for (int d = 0; d < 64; ++d) dot += qs[c * 65 + d] * ks[s * 65 + d];
                const float w = dot * exp2f((float)(c - s) * lg);
#pragma unroll
                for (int j = 0; j < 32; ++j) o[j] += w * R2[s * 128 + eg * 32 + j];
            }
            float sum = 0.f;
#pragma unroll
            for (int j = 0; j < 32; ++j) sum += o[j];
            sum += __shfl_xor(sum, 1); sum += __shfl_xor(sum, 2);
            const float mean = sum * (1.f / 128.f); float sq = 0.f;
#pragma unroll
            for (int j = 0; j < 32; ++j) { const float dl = o[j] - mean; sq += dl * dl; }
            sq += __shfl_xor(sq, 1); sq += __shfl_xor(sq, 2);
            const float rstd = 1.f / sqrtf(sq * (1.f / 128.f) + LN_EPS);
            { const bf16* rg = H0 + (t0 + c) * AB_IN + 1536 + h * 128 + eg * 32; bf16* yo = Y + (t0 + c) * D + 512 + h * 128 + eg * 32;
#pragma unroll
              for (int j = 0; j < 32; ++j) { const float g = bf2f(rg[j]); const float sg = g / (1.f + expf(-g));
                  yo[j] = (bf16)f2bf((o[j] - mean) * rstd * ret_g[h * 128 + eg * 32 + j] * sg); } }
            __syncthreads();
        }
        for (int gi = 0; gi < 4; ++gi) {
            const int w = 2 << gi;
            for (int idx = tid; idx < 16384; idx += NTHR) { const int s = idx >> 7, cc = idx & 127, pos = n * 128 + s; const int cnt = (pos + 1 < w) ? pos + 1 : w;
                float sum = 0.f; for (int j = 0; j < cnt; ++j) sum += bf2f(H0[(t0 + s - j) * AB_IN + gi * 128 + cc]);
                PA[s * 129 + cc] = sum / (float)cnt - bf2f(H0[(t0 + s) * AB_IN + gi * 128 + cc]); }
            for (int idx = tid; idx < 16384; idx += NTHR) PB[idx] = pool_w[gi * 16384 + idx];
            __syncthreads();
            float o[32];
#pragma unroll
            for (int j = 0; j < 32; ++j) o[j] = 0.f;
            for (int cc = 0; cc < 128; ++cc) { const float pv = PA[c * 129 + cc];
#pragma unroll
                for (int j = 0; j < 32; ++j) o[j] += pv * PB[cc * 128 + eg * 32 + j]; }
            { bf16* yo = Y + (t0 + c) * D + gi * 128 + eg * 32;
#pragma unroll
              for (int j = 0; j < 32; ++j) yo[j] = (bf16)f2bf(o[j] * pool_scale[gi * 128 + eg * 32 + j]); }
            __syncthreads();
        }
    }
}
__device__ __forceinline__ void phase_ln(const float* Z, bf16* O, const float* g, const float* bb) {
    const int tid = threadIdx.x, lane = tid & 63, wave = tid >> 6;
    const int gw = blockIdx.x * NWAVES + wave, NGW = gridDim.x * NWAVES;
    for (int m = gw; m < T; m += NGW) {
        const GAS f32x4* zr = (const GAS f32x4*)(Z + (size_t)m * D) + lane;
        f32x4 v[4]; float s = 0.f;
#pragma unroll
        for (int j = 0; j < 4; ++j) { v[j] = zr[64 * j]; s += (v[j].x + v[j].y) + (v[j].z + v[j].w); }
        const float mean = wave_sum(s) * (1.f / D); float s2 = 0.f;
#pragma unroll
        for (int j = 0; j < 4; ++j) { v[j] = v[j] - mean; s2 += (v[j].x * v[j].x + v[j].y * v[j].y) + (v[j].z * v[j].z + v[j].w * v[j].w); }
        const float rstd = 1.f / sqrtf(wave_sum(s2) * (1.f / D) + LN_EPS);
        GAS v2u* o8 = (GAS v2u*)(O + (size_t)m * D) + lane;
#pragma unroll
        for (int j = 0; j < 4; ++j) { const f32x4 gg = *((const GAS f32x4*)g + lane + 64 * j), b4 = *((const GAS f32x4*)bb + lane + 64 * j);
            v2u o; o.x = pk2(v[j].x * rstd * gg.x + b4.x, v[j].y * rstd * gg.y + b4.y); o.y = pk2(v[j].z * rstd * gg.z + b4.z, v[j].w * rstd * gg.w + b4.w); o8[64 * j] = o; }
    }
}
__device__ __forceinline__ void wave_argmax(float& bv, int& bi) {
#pragma unroll
    for (int off = 32; off >= 1; off >>= 1) { const float ov = __shfl_xor(bv, off); const int oi = __shfl_xor(bi, off);
        if (ov > bv || (ov == bv && oi < bi)) { bv = ov; bi = oi; } }
}
__device__ __forceinline__ void phase_topk(LAS unsigned char* lds, const bf16* Q, const float* keys  , int* EID, float* GATE) {
    const int tid = threadIdx.x, lane = tid & 63, wave = tid >> 6;
    LAS float* kl = (LAS float*)lds;
    LAS float* qt = (LAS float*)(lds + 66048);
    LAS float* sc = (LAS float*)(lds + 82560);
    for (int item = blockIdx.x; item < (T / 32) * 8; item += gridDim.x) {
        const int h = item & 7, tile = item >> 3; const size_t tok0 = (size_t)tile * 32;
        for (int p = 0; p < 2; ++p) {
            const float* kg = keys + (size_t)((h * 2 + p) * 128) * 128;
            for (int idx = tid; idx < 16384; idx += NTHR) { const int k = idx >> 7, d = idx & 127; kl[k * 129 + d] = kg[idx]; }
            for (int idx = tid; idx < 4096; idx += NTHR) { const int t = idx >> 7, d = idx & 127; qt[t * 129 + d] = bf2f(Q[(tok0 + t) * 2048 + h * 256 + p * 128 + d]); }
            __syncthreads();
            { const int t = tid >> 4, kg16 = tid & 15;
              for (int jj = 0; jj < 8; ++jj) { const int k = kg16 + 16 * jj; float dot = 0.f;
#pragma unroll 16
                  for (int d = 0; d < 128; ++d) dot += qt[t * 129 + d] * kl[k * 129 + d];
                  sc[(t * 2 + p) * 128 + k] = dot; } }
            __syncthreads();
        }
        for (int tt = 0; tt < 4; ++tt) {
            const int t = wave * 4 + tt;
            float tv[2]; int ti[2];
#pragma unroll
            for (int p = 0; p < 2; ++p) {
                float v0 = sc[(t * 2 + p) * 128 + lane], v1 = sc[(t * 2 + p) * 128 + lane + 64];
                float mv = 0.f; int mi = 0;
                for (int j = 0; j < 16; ++j) {
                    float bv; int bi; if (v0 >= v1) { bv = v0; bi = lane; } else { bv = v1; bi = lane + 64; }
                    wave_argmax(bv, bi);
                    if (lane == j) { mv = bv; mi = bi; }
                    if (bi == lane) v0 = -INFINITY; if (bi == lane + 64) v1 = -INFINITY;
                }
                tv[p] = mv; ti[p] = mi;
            }
            float cv[4];
#pragma unroll
            for (int m = 0; m < 4; ++m) { const int cidx = lane + 64 * m; cv[m] = __shfl(tv[0], cidx >> 4) + __shfl(tv[1], cidx & 15); }
            float bestv = 0.f; int bestc = 0;
            for (int j = 0; j < 16; ++j) {
                float bv = cv[0]; int bi = lane;
#pragma unroll
                for (int m = 1; m < 4; ++m) if (cv[m] > bv) { bv = cv[m]; bi = lane + 64 * m; }
                wave_argmax(bv, bi);
                if (lane == j) { bestv = bv; bestc = bi; }
#pragma unroll
                for (int m = 0; m < 4; ++m) if (bi == lane + 64 * m) cv[m] = -INFINITY;
            }
            const float mx = __shfl(bestv, 0);
            const float ex = (lane < 16) ? expf(bestv - mx) : 0.f;
            const float den = wave_sum(ex);
            const int ia = __shfl(ti[0], bestc >> 4), ib = __shfl(ti[1], bestc & 15);
            if (lane < 16) { const size_t o = (tok0 + t) * 128 + h * 16 + lane; EID[o] = ia * 128 + ib; GATE[o] = ex / den; }
        }
        __syncthreads();
    }
}
template <bool FINAL>
__device__ __forceinline__ void phase_gather(const bf16* X, const int* EID, const float* GATE, const float* U, const float* V, const float* g, const float* bb, bf16* Ob, float* Of) {
    const int tid = threadIdx.x, lane = tid & 63, wave = tid >> 6;
    const int gw = blockIdx.x * NWAVES + wave, NGW = gridDim.x * NWAVES;
    for (int t = gw; t < T; t += NGW) {
        f32x4 x[4], acc[4];
#pragma unroll
        for (int j = 0; j < 4; ++j) { const v2u w = *((const GAS v2u*)(X + (size_t)t * D) + lane + 64 * j);
            x[j] = (f32x4){bflo(w.x), bfhi(w.x), bflo(w.y), bfhi(w.y)}; acc[j] = (f32x4){0.f, 0.f, 0.f, 0.f}; }
        const int e0 = EID[(size_t)t * 128 + lane], e1 = EID[(size_t)t * 128 + 64 + lane];
        const float g0 = GATE[(size_t)t * 128 + lane], g1 = GATE[(size_t)t * 128 + 64 + lane];
#pragma unroll 2
        for (int k = 0; k < 128; ++k) {
            const int e = (k < 64) ? __shfl(e0, k) : __shfl(e1, k - 64);
            const float gt = (k < 64) ? __shfl(g0, k) : __shfl(g1, k - 64);
            const GAS f32x4* ur = (const GAS f32x4*)(U + (size_t)e * D) + lane;
            float dot = 0.f;
#pragma unroll
            for (int j = 0; j < 4; ++j) { const f32x4 u = ur[64 * j]; dot += (x[j].x * u.x + x[j].y * u.y) + (x[j].z * u.z + x[j].w * u.w); }
            dot = wave_sum(dot);
            const float a = 0.5f * dot * (1.f + erff(dot * 0.70710678118654752f));
            const float cf = gt * a;
            const GAS f32x4* vr = (const GAS f32x4*)(V + (size_t)e * D) + lane;
#pragma unroll
            for (int j = 0; j < 4; ++j) { const f32x4 v = vr[64 * j]; acc[j] += cf * v; }
        }
        float s = 0.f;
#pragma unroll
        for (int j = 0; j < 4; ++j) { acc[j] = ALPHA * x[j] + acc[j]; s += (acc[j].x + acc[j].y) + (acc[j].z + acc[j].w); }
        const float mean = wave_sum(s) * (1.f / D); float s2 = 0.f;
#pragma unroll
        for (int j = 0; j < 4; ++j) { acc[j] = acc[j] - mean; s2 += (acc[j].x * acc[j].x + acc[j].y * acc[j].y) + (acc[j].z * acc[j].z + acc[j].w * acc[j].w); }
        const float rstd = 1.f / sqrtf(wave_sum(s2) * (1.f / D) + LN_EPS);
#pragma unroll
        for (int j = 0; j < 4; ++j) { const f32x4 gg = *((const GAS f32x4*)g + lane + 64 * j), b4 = *((const GAS f32x4*)bb + lane + 64 * j);
            const f32x4 o = acc[j] * rstd * gg + b4;
            if (FINAL) *((GAS f32x4*)(Of + (size_t)t * D) + lane + 64 * j) = o;
            else { v2u w; w.x = pk2(o.x, o.y); w.y = pk2(o.z, o.w); *((GAS v2u*)(Ob + (size_t)t * D) + lane + 64 * j) = w; } }
    }
}
__device__ __forceinline__ void phase_hgrn(LAS unsigned char* lds, unsigned char* ws) {
    const int tid = threadIdx.x;
    const bf16* CQ = (const bf16*)(ws + WS_CQ); const bf16* CK = (const bf16*)(ws + WS_CK); const bf16* CV = (const bf16*)(ws + WS_CV); bf16* O = (bf16*)(ws + WS_O);
    LAS float* fL = (LAS float*)lds;
    LAS float* kL = fL + 4096; LAS float* qL = kL + 4096;
    LAS float* vL = qL + 4096;
    LAS float* part = vL + 1024;
    for (int item = blockIdx.x; item < 256; item += gridDim.x) {
        const int es = item & 3, h = (item >> 2) & 7, b = item >> 5;
        const int e = tid & 31, dg = tid >> 5;
        float S[8];
#pragma unroll
        for (int j = 0; j < 8; ++j) S[j] = 0.f;
        for (int blk = 0; blk < SEQ / 32; ++blk) {
            const size_t t0 = (size_t)b * SEQ + blk * 32;
            for (int idx = tid; idx < 4096; idx += NTHR) { const int s = idx >> 7, d = idx & 127; const size_t o = (t0 + s) * D + h * 128 + d;
                const float kk = bf2f(CK[o]); kL[idx] = kk; fL[idx] = 1.f - kk; qL[idx] = bf2f(CQ[o]); }
            for (int idx = tid; idx < 1024; idx += NTHR) { const int s = idx >> 5, ee = idx & 31; vL[idx] = bf2f(CV[(t0 + s) * D + h * 128 + es * 32 + ee]); }
            __syncthreads();
            for (int s = 0; s < 32; ++s) { const float v = vL[s * 32 + e]; float po = 0.f;
#pragma unroll
                for (int j = 0; j < 8; ++j) { const int d = dg * 8 + j; S[j] = fL[s * 128 + d] * S[j] + kL[s * 128 + d] * v; po += qL[s * 128 + d] * S[j]; }
                part[(s * 16 + dg) * 32 + e] = po; }
            __syncthreads();
            for (int idx = tid; idx < 1024; idx += NTHR) { const int s = idx >> 5, ee = idx & 31; float o = 0.f;
#pragma unroll
                for (int g = 0; g < 16; ++g) o += part[(s * 16 + g) * 32 + ee];
                O[(t0 + s) * D + h * 128 + es * 32 + ee] = (bf16)f2bf(o); }
            __syncthreads();
        }
    }
}
__device__ __forceinline__ void phase_hgrn_norm(const float* norm_g, unsigned char* ws) {
    const int tid = threadIdx.x, lane = tid & 63, wave = tid >> 6;
    const int gw = blockIdx.x * NWAVES + wave, NGW = gridDim.x * NWAVES;
    const bf16* O = (const bf16*)(ws + WS_O); const bf16* CG = (const bf16*)(ws + WS_CG); bf16* Y2 = (bf16*)(ws + WS_Y2);
    for (int t = gw; t < T; t += NGW) {
        const v4u a0 = *((const GAS v4u*)(O + (size_t)t * D) + lane * 2), a1 = *((const GAS v4u*)(O + (size_t)t * D) + lane * 2 + 1);
        const v4u g0 = *((const GAS v4u*)(CG + (size_t)t * D) + lane * 2), g1 = *((const GAS v4u*)(CG + (size_t)t * D) + lane * 2 + 1);
        float o[16], gv[16];
        o[0] = bflo(a0.x); o[1] = bfhi(a0.x); o[2] = bflo(a0.y); o[3] = bfhi(a0.y); o[4] = bflo(a0.z); o[5] = bfhi(a0.z); o[6] = bflo(a0.w); o[7] = bfhi(a0.w);
        o[8] = bflo(a1.x); o[9] = bfhi(a1.x); o[10] = bflo(a1.y); o[11] = bfhi(a1.y); o[12] = bflo(a1.z); o[13] = bfhi(a1.z); o[14] = bflo(a1.w); o[15] = bfhi(a1.w);
        gv[0] = bflo(g0.x); gv[1] = bfhi(g0.x); gv[2] = bflo(g0.y); gv[3] = bfhi(g0.y); gv[4] = bflo(g0.z); gv[5] = bfhi(g0.z); gv[6] = bflo(g0.w); gv[7] = bfhi(g0.w);
        gv[8] = bflo(g1.x); gv[9] = bfhi(g1.x); gv[10] = bflo(g1.y); gv[11] = bfhi(g1.y); gv[12] = bflo(g1.z); gv[13] = bfhi(g1.z); gv[14] = bflo(g1.w); gv[15] = bfhi(g1.w);
        float sq = 0.f;
#pragma unroll
        for (int j = 0; j < 16; ++j) sq += o[j] * o[j];
        sq += __shfl_xor(sq, 1); sq += __shfl_xor(sq, 2); sq += __shfl_xor(sq, 4);
        const float r = 1.f / sqrtf(sq * (1.f / 128.f) + LN_EPS);
        float y[16];
#pragma unroll
        for (int j = 0; j < 16; ++j) { const float sg = gv[j] / (1.f + expf(-gv[j])); y[j] = o[j] * r * norm_g[lane * 16 + j] * sg; }
        v4u w0, w1; w0.x = pk2(y[0], y[1]); w0.y = pk2(y[2], y[3]); w0.z = pk2(y[4], y[5]); w0.w = pk2(y[6], y[7]);
        w1.x = pk2(y[8], y[9]); w1.y = pk2(y[10], y[11]); w1.z = pk2(y[12], y[13]); w1.w = pk2(y[14], y[15]);
        *((GAS v4u*)(Y2 + (size_t)t * D) + lane * 2) = w0; *((GAS v4u*)(Y2 + (size_t)t * D) + lane * 2 + 1) = w1;
    }
}

struct Args { const float* in[16]; float* out; unsigned char* ws; int ph_lo, ph_hi, li, pad; };
__global__ void __launch_bounds__(NTHR, 2) mk_fwd(Args args) {
    extern __shared__ __attribute__((aligned(16))) unsigned char lds_raw[];
    LAS unsigned char* lds = (LAS unsigned char*)lds_raw;
    volatile LAS unsigned* MISC = (volatile LAS unsigned*)(lds + MISC_OFF);
    const int tid = threadIdx.x;
    unsigned char* ws = args.ws;
    gu32* ctl = (gu32*)(ws + WS_CTL);
    if (tid < 32) ((LAS unsigned*)(lds + MISC_OFF))[tid] = 0u;
    __syncthreads();
    XcdBarrier bar; bar.bar = (unsigned*)ctl + CW_BAR; bar.x = 0; bar.st = nullptr;
    if (N_LAUNCHES == 1) bar = xcd_barrier_post((unsigned*)ctl + CW_BAR, MISC + 8);
    const int lo = args.ph_lo, hi = args.ph_hi;
#define IN(k) (lo <= (k) && (k) < hi)
#define SEAM(k) do { if (IN(k) && IN((k) + 1)) xcd_barrier(bar); } while (0)
    const float* const* in = args.in;
    bf16* XB = (bf16*)(ws + WS_XB); bf16* H0 = (bf16*)(ws + WS_H0); bf16* Y = (bf16*)(ws + WS_Y); bf16* H1 = (bf16*)(ws + WS_H1);
    int* EID = (int*)(ws + WS_EID); float* GATE = (float*)(ws + WS_GATE);
    float* Z = args.out;

    if (IN(0)) { phase_prologue(lds, in, ws); } SEAM(0);
    if (IN(1)) { EpiStore E{H0, AB_IN}; gemm_naive(lds, XB, (const bf16*)(ws + WS_WABIN), T, AB_IN, D, E); } SEAM(1);
    if (IN(2)) { phase_ret_local(lds, ws); } SEAM(2);
    if (IN(3)) { phase_ret_prefix(ws); } SEAM(3);
    if (IN(4)) { phase_ret_out_pool(lds, in, ws); } SEAM(4);
    if (IN(5)) { EpiResid E{XB, Z}; gemm_naive(lds, Y, (const bf16*)(ws + WS_WABOUT), T, D, D, E); } SEAM(5);
    if (IN(6)) { phase_ln(Z, H1, in[14], in[15]); } SEAM(6);
    if (IN(7)) { EpiStore E{H0  , 2048}; gemm_naive(lds, H1, (const bf16*)(ws + WS_WQ), T, 2048, D, E); } SEAM(7);
    if (IN(8)) { phase_topk(lds, H0, in[11], EID, GATE); } SEAM(8);
    if (IN(9)) { phase_gather<false>(H1, EID, GATE, in[12], in[13], in[14] + D, in[15] + D, XB  , nullptr); } SEAM(9);
    if (IN(10)) { EpiCIn E{(bf16*)(ws + WS_CQ), (bf16*)(ws + WS_CK), (bf16*)(ws + WS_CV), (bf16*)(ws + WS_CG), (const float*)(ws + WS_LB)};
                  gemm_naive(lds, XB, (const bf16*)(ws + WS_WCIN), T, C_IN, D, E); } SEAM(10);
    if (IN(11)) { phase_hgrn(lds, ws); } SEAM(11);
    if (IN(12)) { phase_hgrn_norm(in[8], ws); } SEAM(12);
    if (IN(13)) { EpiResid E{XB, Z}; gemm_naive(lds, (const bf16*)(ws + WS_Y2), (const bf16*)(ws + WS_WCOUT), T, D, D, E); } SEAM(13);
    if (IN(14)) { phase_ln(Z, H1  , in[14] + 2 * D, in[15] + 2 * D); } SEAM(14);
    if (IN(15)) { EpiStore E{(bf16*)(ws + WS_Q1), 2048}; gemm_naive(lds, H1, (const bf16*)(ws + WS_WQ) + (size_t)2048 * D, T, 2048, D, E); } SEAM(15);
    if (IN(16)) { phase_topk(lds, (const bf16*)(ws + WS_Q1), in[11] + (size_t)8 * 2 * 128 * 128, EID, GATE); } SEAM(16);
    if (IN(17)) { phase_gather<true>(H1, EID, GATE, in[12] + (size_t)NEXP * D, in[13] + (size_t)NEXP * D, in[14] + 3 * D, in[15] + 3 * D, nullptr, args.out); }
#undef IN
#undef SEAM
}

extern "C" void kernel_launch(void* const* d_in, const int* in_sizes, int n_in, void* d_out, int out_size, void* d_ws, size_t ws_size, hipStream_t stream) {
    static int grid = 0;
    if (grid == 0) {
        if (n_in != 16 || in_sizes[0] != T * D || out_size != T * D || ws_size < WS_END) { fprintf(stderr, "kernel_launch: unexpected problem (n_in %d, in0 %d, out %d, ws %zu); nothing launched\n", n_in, n_in > 0 ? in_sizes[0] : -1, out_size, ws_size); grid = -1; return; }
        int dev = 0, cus = 0;
        if (hipGetDevice(&dev) != hipSuccess || hipDeviceGetAttribute(&cus, hipDeviceAttributeMultiprocessorCount, dev) != hipSuccess) { grid = -1; return; }
        if (hipFuncSetAttribute((const void*)mk_fwd, hipFuncAttributeMaxDynamicSharedMemorySize, LDS_BYTES) != hipSuccess) { fprintf(stderr, "kernel_launch: hipFuncSetAttribute failed\n"); grid = -1; return; }
        (void)hipGetLastError();
        grid = cus;
    }
    if (grid < 0) return;
    if (hipMemsetAsync((char*)d_ws + WS_CTL, 0, CTL_ZERO_BYTES, stream) != hipSuccess) return;
    Args a{};
    for (int i = 0; i < 16; ++i) a.in[i] = (const float*)d_in[i];
    a.out = (float*)d_out; a.ws = (unsigned char*)d_ws;
    for (int li = 0; li < N_LAUNCHES; ++li) {
        a.ph_lo = (N_LAUNCHES == 1) ? 0 : li; a.ph_hi = (N_LAUNCHES == 1) ? NPHASE : li + 1; a.li = li;
        hipLaunchKernelGGL(mk_fwd, dim3(grid), dim3(NTHR), LDS_BYTES, stream, a);
        if (hipPeekAtLastError() != hipSuccess) { fprintf(stderr, "kernel_launch: launch %d failed\n", li); break; }
    }
}
```

```cpp
#include <hip/hip_runtime.h>
#include <cstdio>
#include <cstdint>

#ifndef MK_N_LAUNCHES
#define MK_N_LAUNCHES 1
#endif
constexpr int NPHASE = 18;
constexpr int N_LAUNCHES = MK_N_LAUNCHES;

constexpr int BATCH = 8, SEQ = 4096, D = 1024, T = BATCH * SEQ;
constexpr int AB_IN = 2048, C_IN = 4096, NEXP = 16384;
constexpr float LN_EPS = 1e-5f;
constexpr float ALPHA = 1.41421356237309515f;
constexpr int NWAVES = 8, NTHR = 512;

constexpr size_t MiB = 1u << 20;
constexpr size_t WS_CTL = 0, CTL_ZERO_BYTES = 1 * MiB;
constexpr size_t WS_LB = 1 * MiB;
constexpr size_t WS_ROPE = 2 * MiB;
constexpr size_t WS_WABIN = 4 * MiB;
constexpr size_t WS_WABOUT = 8 * MiB;
constexpr size_t WS_WCIN = 10 * MiB;
constexpr size_t WS_WCOUT = 18 * MiB;
constexpr size_t WS_WQ = 20 * MiB;
constexpr size_t WS_KEYS = 28 * MiB;
constexpr size_t WS_XB = 96 * MiB;
constexpr size_t WS_H0 = 160 * MiB;
constexpr size_t WS_LST = 288 * MiB;
constexpr size_t WS_Y = 320 * MiB;
constexpr size_t WS_H1 = 384 * MiB;
constexpr size_t WS_EID = 448 * MiB;
constexpr size_t WS_GATE = 464 * MiB;
constexpr size_t WS_CQ = 160 * MiB, WS_CK = 224 * MiB, WS_CV = 288 * MiB, WS_CG = 352 * MiB;
constexpr size_t WS_O = 416 * MiB;
constexpr size_t WS_Y2 = 160 * MiB;
constexpr size_t WS_Q1 = 224 * MiB;
constexpr size_t WS_END = 480 * MiB;

constexpr int CW_BAR = 4096;
constexpr int LDS_BYTES = 147456;
constexpr int MISC_OFF = LDS_BYTES - 128;

#define GAS __attribute__((address_space(1)))
#define LAS __attribute__((address_space(3)))
typedef unsigned short bf16;
typedef unsigned v4u __attribute__((ext_vector_type(4)));
typedef unsigned v2u __attribute__((ext_vector_type(2)));
typedef float f32x4 __attribute__((ext_vector_type(4)));
typedef GAS unsigned gu32;
#define RLX_AGENT __ATOMIC_RELAXED, __HIP_MEMORY_SCOPE_AGENT
#define LDS_WAIT() asm volatile("s_waitcnt lgkmcnt(0)" ::: "memory")
__device__ __forceinline__ unsigned f2bf(float f) { unsigned u = __builtin_bit_cast(unsigned, f); return (u + 0x7fffu + ((u >> 16) & 1u)) >> 16; }
__device__ __forceinline__ unsigned pk2(float lo, float hi) { return f2bf(lo) | (f2bf(hi) << 16); }
__device__ __forceinline__ float bf2f(unsigned b) { return __builtin_bit_cast(float, b << 16); }
__device__ __forceinline__ float bflo(unsigned w) { return __builtin_bit_cast(float, w << 16); }
__device__ __forceinline__ float bfhi(unsigned w) { return __builtin_bit_cast(float, w & 0xffff0000u); }
__device__ __forceinline__ float wave_sum(float v) {
#pragma unroll
    for (int o = 1; o < 64; o <<= 1) v += __shfl_xor(v, o);
    return v;
}

#define XB_TMO      128
#define XB_XCNT(j)  (256  + 64 * (j))
#define XB_XSUB(j)  (1280 + 64 * (j))
#define XB_XGEN(j)  (2304 + 64 * (j))
#define XB_TOP      3328
#define XB_TOPGEN   3392
#define XCD_BAR_WORDS 3456
#define XB_SPIN_CAP (1u << 21)
__device__ __forceinline__ unsigned xb_ld(unsigned* p)              { return __hip_atomic_load(p, __ATOMIC_RELAXED, __HIP_MEMORY_SCOPE_AGENT); }
__device__ __forceinline__ unsigned xb_add(unsigned* p, unsigned v) { return __hip_atomic_fetch_add(p, v, __ATOMIC_RELAXED, __HIP_MEMORY_SCOPE_AGENT); }
__device__ __forceinline__ unsigned xb_xcc_id() { return (unsigned)__builtin_amdgcn_s_getreg((3 << 11) | 20) & 0xFu; }
#define XB_SPIN(cond, bar) do { unsigned _sp = 0; while (cond) { __builtin_amdgcn_s_sleep(1); \
    if ((++_sp & 255u) == 0u) { if (xb_ld(&(bar)[XB_TMO])) break; if (_sp > XB_SPIN_CAP) { atomicAdd(&(bar)[XB_TMO], 1u); break; } } } } while (0)
struct XcdBarrier { unsigned* bar; unsigned x; volatile LAS unsigned* st; };
__device__ __forceinline__ XcdBarrier xcd_barrier_post(unsigned* bar, volatile LAS unsigned* st) {
    XcdBarrier b; b.bar = bar; b.x = xb_xcc_id(); b.st = st;
    if (threadIdx.x == 0) (void)xb_add(&bar[XB_XCNT(b.x)], 1u);
    return b;
}
__device__ __forceinline__ void xcd_barrier_complete(unsigned* bar, unsigned x, unsigned& nloc, unsigned& nx) {
    const unsigned G = gridDim.x * gridDim.y * gridDim.z;
    unsigned sum, cnt, mine, sp = 0u;
    for (;;) {
        sum = 0u; cnt = 0u; mine = 0u;
#pragma unroll
        for (unsigned j = 0; j < 16; ++j) { const unsigned c = xb_ld(&bar[XB_XCNT(j)]); sum += c; cnt += (c > 0u) ? 1u : 0u; mine = (j == x) ? c : mine; }
        if (sum == G) break;
        __builtin_amdgcn_s_sleep(1);
        if ((++sp & 255u) == 0u) { if (xb_ld(&bar[XB_TMO])) break; if (sp > XB_SPIN_CAP) { atomicAdd(&bar[XB_TMO], 1u); break; } }
    }
    nloc = mine > 0u ? mine : 1u; nx = cnt > 0u ? cnt : 1u;
}
__device__ __forceinline__ void xcd_barrier(const XcdBarrier& b) {
    asm volatile("s_waitcnt vmcnt(0)" ::: "memory");
    __syncthreads();
    if (threadIdx.x == 0) {
        unsigned* bar = b.bar;
        __builtin_amdgcn_s_waitcnt(0);
        unsigned nloc = b.st[0], nx = b.st[1];
        if (nloc == 0u) { xcd_barrier_complete(bar, b.x, nloc, nx); b.st[0] = nloc; b.st[1] = nx; }
        const unsigned old = xb_add(&bar[XB_XSUB(b.x)], 1u);
        const unsigned gen = old / nloc;
        if (old + 1u == (gen + 1u) * nloc) {
            __builtin_amdgcn_fence(__ATOMIC_RELEASE, "agent");
            asm volatile("s_waitcnt vmcnt(0)" ::: "memory");
            const unsigned og = xb_add(&bar[XB_TOP], 1u);
            const unsigned tg = og / nx;
            if (og + 1u == (tg + 1u) * nx) xb_add(&bar[XB_TOPGEN], 1u);
            else XB_SPIN(xb_ld(&bar[XB_TOPGEN]) == tg, bar);
            __builtin_amdgcn_fence(__ATOMIC_ACQUIRE, "agent");
            xb_add(&bar[XB_XGEN(b.x)], 1u);
            asm volatile("s_waitcnt vmcnt(0)" ::: "memory");
        } else {
            XB_SPIN(xb_ld(&bar[XB_XGEN(b.x)]) == gen, bar);
            __builtin_amdgcn_fence(__ATOMIC_ACQUIRE, "agent");
            asm volatile("s_waitcnt vmcnt(0)" ::: "memory");
        }
    }
    __syncthreads();
}

__device__ __forceinline__ void p0_transpose_item(const float* W, int K, int N, bf16* WT, LAS float* scr, int item, int lane) {
    const int nblk = N / 32, kb = item / nblk, nb = item % nblk, k0 = 64 * kb, n0 = 32 * nb;
#pragma unroll 8
    for (int i = 0; i < 32; ++i) { const int kk = 2 * i + (lane >> 5); scr[kk * 33 + (lane & 31)] = W[(size_t)(k0 + kk) * N + n0 + (lane & 31)]; }
    LDS_WAIT(); asm volatile("" ::: "memory");
    const int c = lane & 7;
#pragma unroll
    for (int j = 0; j < 4; ++j) { const int n = (lane >> 3) + 8 * j; const LAS float* s = scr + (8 * c) * 33 + n;
        v4u o; o.x = pk2(s[0 * 33], s[1 * 33]); o.y = pk2(s[2 * 33], s[3 * 33]); o.z = pk2(s[4 * 33], s[5 * 33]); o.w = pk2(s[6 * 33], s[7 * 33]);
        *(GAS v4u*)(WT + (size_t)(n0 + n) * K + k0 + 8 * c) = o; }
    LDS_WAIT(); asm volatile("" ::: "memory");
}

template <class Epi>
__device__ __forceinline__ void gemm_naive(LAS unsigned char* lds, const bf16* A, const bf16* Bt, int M, int N, int K, const Epi& E) {
    LAS float* As = (LAS float*)lds;
    LAS float* Bs = As + 128 * 33;
    const int tid = threadIdx.x, tx = tid & 15, ty = tid >> 4;
    const int ntn = N / 128, ntiles = (M / 128) * ntn;
    for (int tile = blockIdx.x; tile < ntiles; tile += gridDim.x) {
        const int tm = tile / ntn, tn = tile % ntn;
        float acc[4][8];
#pragma unroll
        for (int i = 0; i < 4; ++i)
#pragma unroll
            for (int j = 0; j < 8; ++j) acc[i][j] = 0.f;
        for (int k0 = 0; k0 < K; k0 += 32) {
            { const int r = tid >> 2, kc = (tid & 3) * 8;
              const v4u va = *(const GAS v4u*)(A + (size_t)(tm * 128 + r) * K + k0 + kc);
              const v4u vb = *(const GAS v4u*)(Bt + (size_t)(tn * 128 + r) * K + k0 + kc);
              LAS float* pa = As + r * 33 + kc; LAS float* pb = Bs + r * 33 + kc;
              pa[0] = bflo(va.x); pa[1] = bfhi(va.x); pa[2] = bflo(va.y); pa[3] = bfhi(va.y); pa[4] = bflo(va.z); pa[5] = bfhi(va.z); pa[6] = bflo(va.w); pa[7] = bfhi(va.w);
              pb[0] = bflo(vb.x); pb[1] = bfhi(vb.x); pb[2] = bflo(vb.y); pb[3] = bfhi(vb.y); pb[4] = bflo(vb.z); pb[5] = bfhi(vb.z); pb[6] = bflo(vb.w); pb[7] = bfhi(vb.w); }
            __syncthreads();
#pragma unroll 8
            for (int kk = 0; kk < 32; ++kk) {
                float a[4], b[8];
#pragma unroll
                for (int i = 0; i < 4; ++i) a[i] = As[(ty * 4 + i) * 33 + kk];
#pragma unroll
                for (int j = 0; j < 8; ++j) b[j] = Bs[(tx + 16 * j) * 33 + kk];
#pragma unroll
                for (int i = 0; i < 4; ++i)
#pragma unroll
                    for (int j = 0; j < 8; ++j) acc[i][j] += a[i] * b[j];
            }
            __syncthreads();
        }
#pragma unroll
        for (int i = 0; i < 4; ++i)
#pragma unroll
            for (int j = 0; j < 8; ++j) E(tm * 128 + ty * 4 + i, tn * 128 + tx + 16 * j, acc[i][j]);
    }
}
struct EpiStore { bf16* O; int ldc;
    __device__ __forceinline__ void operator()(int r, int c, float v) const { O[(size_t)r * ldc + c] = (bf16)f2bf(v); } };
struct EpiResid { const bf16* X; float* Z;
    __device__ __forceinline__ void operator()(int r, int c, float v) const { Z[(size_t)r * D + c] = ALPHA * bf2f(X[(size_t)r * D + c]) + v; } };
struct EpiCIn { bf16 *CQ, *CK, *CV, *CG; const float* lb;
    __device__ __forceinline__ void operator()(int r, int c, float v) const {
        const int seg = c >> 10, cc = c & 1023; const size_t o = (size_t)r * D + cc;
        if (seg == 0) CQ[o] = (bf16)f2bf(v);
        else if (seg == 1) { const float k = (1.f - lb[cc]) / (1.f + expf(v)); CK[o] = (bf16)f2bf(k); }
        else if (seg == 2) CV[o] = (bf16)f2bf(v);
        else CG[o] = (bf16)f2bf(v);
    } };

__device__ __forceinline__ float gamma_log2(int h) { return log2f(1.f - exp2f(-5.f - (float)h)); }

__device__ __forceinline__ void phase_prologue(LAS unsigned char* lds, const float* const* in, unsigned char* ws) {
    const int tid = threadIdx.x, lane = tid & 63, wave = tid >> 6;
    const int gw = blockIdx.x * NWAVES + wave, NGW = gridDim.x * NWAVES;
    LAS float* scr = (LAS float*)(lds + wave * 16384);
    constexpr int I_ABIN = (D / 64) * (AB_IN / 32), I_SQ = (D / 64) * (D / 32), I_CIN = (D / 64) * (C_IN / 32), I_WQ = (D / 64) * (2048 / 32);
    constexpr int NITEMS = I_ABIN + I_SQ + I_CIN + I_SQ + 2 * I_WQ;
    for (int it = gw; it < NITEMS; it += NGW) {
        int r = it;
        if (r < I_ABIN) { p0_transpose_item(in[1], D, AB_IN, (bf16*)(ws + WS_WABIN), scr, r, lane); continue; } r -= I_ABIN;
        if (r < I_SQ) { p0_transpose_item(in[5], D, D, (bf16*)(ws + WS_WABOUT), scr, r, lane); continue; } r -= I_SQ;
        if (r < I_CIN) { p0_transpose_item(in[6], D, C_IN, (bf16*)(ws + WS_WCIN), scr, r, lane); continue; } r -= I_CIN;
        if (r < I_SQ) { p0_transpose_item(in[9], D, D, (bf16*)(ws + WS_WCOUT), scr, r, lane); continue; } r -= I_SQ;
        if (r < I_WQ) { p0_transpose_item(in[10], D, 2048, (bf16*)(ws + WS_WQ), scr, r, lane); continue; } r -= I_WQ;
        p0_transpose_item(in[10] + (size_t)D * 2048, D, 2048, (bf16*)(ws + WS_WQ) + (size_t)2048 * D, scr, r, lane);
    }
    const size_t gt = (size_t)blockIdx.x * NTHR + tid, NT = (size_t)gridDim.x * NTHR;
    { const float* x = in[0]; bf16* xb = (bf16*)(ws + WS_XB);
      for (size_t i = gt; i < (size_t)T * D / 8; i += NT) { const f32x4 a = *(const GAS f32x4*)(x + i * 8), b = *(const GAS f32x4*)(x + i * 8 + 4);
          v4u o; o.x = pk2(a.x, a.y); o.y = pk2(a.z, a.w); o.z = pk2(b.x, b.y); o.w = pk2(b.z, b.w); *(GAS v4u*)(xb + i * 8) = o; } }
    { const float* k = in[11]; bf16* kb = (bf16*)(ws + WS_KEYS);
      for (size_t i = gt; i < (size_t)2 * 8 * 2 * 128 * 128 / 8; i += NT) { const f32x4 a = *(const GAS f32x4*)(k + i * 8), b = *(const GAS f32x4*)(k + i * 8 + 4);
          v4u o; o.x = pk2(a.x, a.y); o.y = pk2(a.z, a.w); o.z = pk2(b.x, b.y); o.w = pk2(b.z, b.w); *(GAS v4u*)(kb + i * 8) = o; } }
    { float* ct = (float*)(ws + WS_ROPE); float* st = ct + 4096 * 32;
      for (size_t i = gt; i < (size_t)4096 * 32; i += NT) { const int pos = (int)(i >> 5), f = (int)(i & 31);
          const double inv = exp(-log(10000.0) * ((double)f / 31.0)); const double ang = (double)pos * inv;
          ct[i] = (float)cos(ang); st[i] = (float)sin(ang); } }
    { const float* l = in[7]; float* lb = (float*)(ws + WS_LB);
      for (size_t i = gt; i < 1024; i += NT) { const float a = l[i], b = l[1024 + i]; const float m = fmaxf(a, b); const float ea = expf(a - m), eb = expf(b - m); lb[i] = eb / (ea + eb); } }
}

__device__ __forceinline__ void phase_ret_local(LAS unsigned char* lds, unsigned char* ws) {
    const int tid = threadIdx.x;
    const bf16* H0 = (const bf16*)(ws + WS_H0); float* LST = (float*)(ws + WS_LST);
    const float* ct = (const float*)(ws + WS_ROPE); const float* st = ct + 4096 * 32;
    LAS float* kd = (LAS float*)lds;
    LAS float* vv = (LAS float*)(lds + 32768);
    for (int item = blockIdx.x; item < 1024; item += gridDim.x) {
        const int n = item & 31, h = (item >> 5) & 3, b = item >> 7;
        const size_t t0 = (size_t)b * SEQ + n * 128; const float lg = gamma_log2(h);
        for (int idx = tid; idx < 4096; idx += NTHR) { const int s = idx >> 5, i = idx & 31, pos = n * 128 + s;
            const bf16* row = H0 + (t0 + s) * AB_IN + 768 + h * 64;
            const float x1 = bf2f(row[i]), x2 = bf2f(row[i + 32]); const float c = ct[pos * 32 + i], sn = st[pos * 32 + i];
            const float dec = exp2f((float)(127 - s) * lg) * 0.125f;
            kd[s * 64 + i] = (x1 * c - x2 * sn) * dec; kd[s * 64 + i + 32] = (x2 * c + x1 * sn) * dec; }
        for (int idx = tid; idx < 16384; idx += NTHR) { const int s = idx >> 7, e = idx & 127; vv[idx] = bf2f(H0[(t0 + s) * AB_IN + 1024 + h * 128 + e]); }
        __syncthreads();
        const int e = tid & 127, dg = tid >> 7;
        float acc[16];
#pragma unroll
        for (int j = 0; j < 16; ++j) acc[j] = 0.f;
        for (int s = 0; s < 128; ++s) { const float v = vv[s * 128 + e];
#pragma unroll
            for (int j = 0; j < 16; ++j) acc[j] += kd[s * 64 + dg * 16 + j] * v; }
#pragma unroll
        for (int j = 0; j < 16; ++j) LST[(size_t)item * 8192 + (dg * 16 + j) * 128 + e] = acc[j];
        __syncthreads();
    }
}
__device__ __forceinline__ void phase_ret_prefix(unsigned char* ws) {
    float* LST = (float*)(ws + WS_LST);
    const size_t gt = (size_t)blockIdx.x * NTHR + threadIdx.x, NT = (size_t)gridDim.x * NTHR;
    for (size_t idx = gt; idx < (size_t)32 * 8192; idx += NT) { const int bh = (int)(idx >> 13), el = (int)(idx & 8191), h = bh & 3;
        const float g128 = exp2f(128.f * gamma_log2(h)); float S = 0.f;
        for (int n = 0; n < 32; ++n) { float* p = LST + ((size_t)(bh * 32 + n) * 8192 + el); const float tmp = *p; *p = S; S = S * g128 + tmp; } }
}
__device__ __forceinline__ void phase_ret_out_pool(LAS unsigned char* lds, const float* const* in, unsigned char* ws) {
    const int tid = threadIdx.x;
    const bf16* H0 = (const bf16*)(ws + WS_H0); const float* LST = (const float*)(ws + WS_LST); bf16* Y = (bf16*)(ws + WS_Y);
    const float* ct = (const float*)(ws + WS_ROPE); const float* st = ct + 4096 * 32;
    const float* pool_w = in[2]; const float* pool_scale = in[3]; const float* ret_g = in[4];
    LAS float* qs = (LAS float*)lds;
    LAS float* ks = qs + 128 * 65;
    LAS float* R2 = (LAS float*)(lds + 66560);
    LAS float* PA = (LAS float*)lds;
    LAS float* PB = (LAS float*)(lds + 66048);
    for (int item = blockIdx.x; item < 256; item += gridDim.x) {
        const int n = item & 31, b = item >> 5; const size_t t0 = (size_t)b * SEQ + n * 128;
        const int c = tid >> 2, eg = tid & 3;
        for (int h = 0; h < 4; ++h) {
            const float lg = gamma_log2(h);
            for (int idx = tid; idx < 4096; idx += NTHR) { const int s = idx >> 5, i = idx & 31, pos = n * 128 + s;
                const bf16* rq = H0 + (t0 + s) * AB_IN + 512 + h * 64; const bf16* rk = H0 + (t0 + s) * AB_IN + 768 + h * 64;
                const float cs = ct[pos * 32 + i], sn = st[pos * 32 + i];
                const float q1 = bf2f(rq[i]), q2 = bf2f(rq[i + 32]), k1 = bf2f(rk[i]), k2 = bf2f(rk[i + 32]);
                qs[s * 65 + i] = q1 * cs - q2 * sn; qs[s * 65 + i + 32] = q2 * cs + q1 * sn;
                ks[s * 65 + i] = (k1 * cs - k2 * sn) * 0.125f; ks[s * 65 + i + 32] = (k2 * cs + k1 * sn) * 0.125f; }
            { const float* Sg = LST + (size_t)((b * 4 + h) * 32 + n) * 8192;
              for (int idx = tid; idx < 8192; idx += NTHR) R2[idx] = Sg[idx]; }
            __syncthreads();
            float o[32];
#pragma unroll
            for (int j = 0; j < 32; ++j) o[j] = 0.f;
            for (int d = 0; d < 64; ++d) { const float qv = qs[c * 65 + d];
#pragma unroll
                for (int j = 0; j < 32; ++j) o[j] += qv * R2[d * 128 + eg * 32 + j]; }
            { const float qd = exp2f((float)(c + 1) * lg);
#pragma unroll
              for (int j = 0; j < 32; ++j) o[j] *= qd; }
            __syncthreads();
            for (int idx = tid; idx < 16384; idx += NTHR) { const int s = idx >> 7, e = idx & 127; R2[idx] = bf2f(H0[(t0 + s) * AB_IN + 1024 + h * 128 + e]); }
            __syncthreads();
            for (int s = 0; s <= c; ++s) {
                float dot = 0.f;
#pragma unroll 16
                for (int d = 0; d < 64; ++d) dot += qs[c * 65 + d] * ks[s * 65 + d];
                const float w = dot * exp2f((float)(c - s) * lg);
#pragma unroll
                for (int j = 0; j < 32; ++j) o[j] += w * R2[s * 128 + eg * 32 + j];
            }
            float sum = 0.f;
#pragma unroll
            for (int j = 0; j < 32; ++j) sum += o[j];
            sum += __shfl_xor(sum, 1); sum += __shfl_xor(sum, 2);
            const float mean = sum * (1.f / 128.f); float sq = 0.f;
#pragma unroll
            for (int j = 0; j < 32; ++j) { const float dl = o[j] - mean; sq += dl * dl; }
            sq += __shfl_xor(sq, 1); sq += __shfl_xor(sq, 2);
            const float rstd = 1.f / sqrtf(sq * (1.f / 128.f) + LN_EPS);
            { const bf16* rg = H0 + (t0 + c) * AB_IN + 1536 + h * 128 + eg * 32; bf16* yo = Y + (t0 + c) * D + 512 + h * 128 + eg * 32;
#pragma unroll
              for (int j = 0; j < 32; ++j) { const float g = bf2f(rg[j]); const float sg = g / (1.f + expf(-g));
                  yo[j] = (bf16)f2bf((o[j] - mean) * rstd * ret_g[h * 128 + eg * 32 + j] * sg); } }
            __syncthreads();
        }
        for (int gi = 0; gi < 4; ++gi) {
            const int w = 2 << gi;
            for (int idx = tid; idx < 16384; idx += NTHR) { const int s = idx >> 7, cc = idx & 127, pos = n * 128 + s; const int cnt = (pos + 1 < w) ? pos + 1 : w;
                float sum = 0.f; for (int j = 0; j < cnt; ++j) sum += bf2f(H0[(t0 + s - j) * AB_IN + gi * 128 + cc]);
                PA[s * 129 + cc] = sum / (float)cnt - bf2f(H0[(t0 + s) * AB_IN + gi * 128 + cc]); }
            for (int idx = tid; idx < 16384; idx += NTHR) PB[idx] = pool_w[gi * 16384 + idx];
            __syncthreads();
            float o[32];
#pragma unroll
            for (int j = 0; j < 32; ++j) o[j] = 0.f;
            for (int cc = 0; cc < 128; ++cc) { const float pv = PA[c * 129 + cc];
#pragma unroll
                for (int j = 0; j < 32; ++j) o[j] += pv * PB[cc * 128 + eg * 32 + j]; }
            { bf16* yo = Y + (t0 + c) * D + gi * 128 + eg * 32;
#pragma unroll
              for (int j = 0; j < 32; ++j) yo[j] = (bf16)f2bf(o[j] * pool_scale[gi * 128 + eg * 32 + j]); }
            __syncthreads();
        }
    }
}
__device__ __forceinline__ void phase_ln(const float* Z, bf16* O, const float* g, const float* bb) {
    const int tid = threadIdx.x, lane = tid & 63, wave = tid >> 6;
    const int gw = blockIdx.x * NWAVES + wave, NGW = gridDim.x * NWAVES;
    for (int m = gw; m < T; m += NGW) {
        const GAS f32x4* zr = (const GAS f32x4*)(Z + (size_t)m * D) + lane;
        f32x4 v[4]; float s = 0.f;
#pragma unroll
        for (int j = 0; j < 4; ++j) { v[j] = zr[64 * j]; s += (v[j].x + v[j].y) + (v[j].z + v[j].w); }
        const float mean = wave_sum(s) * (1.f / D); float s2 = 0.f;
#pragma unroll
        for (int j = 0; j < 4; ++j) { v[j] = v[j] - mean; s2 += (v[j].x * v[j].x + v[j].y * v[j].y) + (v[j].z * v[j].z + v[j].w * v[j].w); }
        const float rstd = 1.f / sqrtf(wave_sum(s2) * (1.f / D) + LN_EPS);
        GAS v2u* o8 = (GAS v2u*)(O + (size_t)m * D) + lane;
#pragma unroll
        for (int j = 0; j < 4; ++j) { const f32x4 gg = *((const GAS f32x4*)g + lane + 64 * j), b4 = *((const GAS f32x4*)bb + lane + 64 * j);
            v2u o; o.x = pk2(v[j].x * rstd * gg.x + b4.x, v[j].y * rstd * gg.y + b4.y); o.y = pk2(v[j].z * rstd * gg.z + b4.z, v[j].w * rstd * gg.w + b4.w); o8[64 * j] = o; }
    }
}
__device__ __forceinline__ void wave_argmax(float& bv, int& bi) {
#pragma unroll
    for (int off = 32; off >= 1; off >>= 1) { const float ov = __shfl_xor(bv, off); const int oi = __shfl_xor(bi, off);
        if (ov > bv || (ov == bv && oi < bi)) { bv = ov; bi = oi; } }
}
__device__ __forceinline__ void phase_topk(LAS unsigned char* lds, const bf16* Q, const float* keys  , int* EID, float* GATE) {
    const int tid = threadIdx.x, lane = tid & 63, wave = tid >> 6;
    LAS float* kl = (LAS float*)lds;
    LAS float* qt = (LAS float*)(lds + 66048);
    LAS float* sc = (LAS float*)(lds + 82560);
    for (int item = blockIdx.x; item < (T / 32) * 8; item += gridDim.x) {
        const int h = item & 7, tile = item >> 3; const size_t tok0 = (size_t)tile * 32;
        for (int p = 0; p < 2; ++p) {
            const float* kg = keys + (size_t)((h * 2 + p) * 128) * 128;
            for (int idx = tid; idx < 16384; idx += NTHR) { const int k = idx >> 7, d = idx & 127; kl[k * 129 + d] = kg[idx]; }
            for (int idx = tid; idx < 4096; idx += NTHR) { const int t = idx >> 7, d = idx & 127; qt[t * 129 + d] = bf2f(Q[(tok0 + t) * 2048 + h * 256 + p * 128 + d]); }
            __syncthreads();
            { const int t = tid >> 4, kg16 = tid & 15;
              for (int jj = 0; jj < 8; ++jj) { const int k = kg16 + 16 * jj; float dot = 0.f;
#pragma unroll 16
                  for (int d = 0; d < 128; ++d) dot += qt[t * 129 + d] * kl[k * 129 + d];
                  sc[(t * 2 + p) * 128 + k] = dot; } }
            __syncthreads();
        }
        for (int tt = 0; tt < 4; ++tt) {
            const int t = wave * 4 + tt;
            float tv[2]; int ti[2];
#pragma unroll
            for (int p = 0; p < 2; ++p) {
                float v0 = sc[(t * 2 + p) * 128 + lane], v1 = sc[(t * 2 + p) * 128 + lane + 64];
                float mv = 0.f; int mi = 0;
                for (int j = 0; j < 16; ++j) {
                    float bv; int bi; if (v0 >= v1) { bv = v0; bi = lane; } else { bv = v1; bi = lane + 64; }
                    wave_argmax(bv, bi);
                    if (lane == j) { mv = bv; mi = bi; }
                    if (bi == lane) v0 = -INFINITY; if (bi == lane + 64) v1 = -INFINITY;
                }
                tv[p] = mv; ti[p] = mi;
            }
            float cv[4];
#pragma unroll
            for (int m = 0; m < 4; ++m) { const int cidx = lane + 64 * m; cv[m] = __shfl(tv[0], cidx >> 4) + __shfl(tv[1], cidx & 15); }
            float bestv = 0.f; int bestc = 0;
            for (int j = 0; j < 16; ++j) {
                float bv = cv[0]; int bi = lane;
#pragma unroll
                for (int m = 1; m < 4; ++m) if (cv[m] > bv) { bv = cv[m]; bi = lane + 64 * m; }
                wave_argmax(bv, bi);
                if (lane == j) { bestv = bv; bestc = bi; }
#pragma unroll
                for (int m = 0; m < 4; ++m) if (bi == lane + 64 * m) cv[m] = -INFINITY;
            }
            const float mx = __shfl(bestv, 0);
            const float ex = (lane < 16) ? expf(bestv - mx) : 0.f;
            const float den = wave_sum(ex);
            const int ia = __shfl(ti[0], bestc >> 4), ib = __shfl(ti[1], bestc & 15);
            if (lane < 16) { const size_t o = (tok0 + t) * 128 + h * 16 + lane; EID[o] = ia * 128 + ib; GATE[o] = ex / den; }
        }
        __syncthreads();
    }
}
template <bool FINAL>
__device__ __forceinline__ void phase_gather(const bf16* X, const int* EID, const float* GATE, const float* U, const float* V, const float* g, const float* bb, bf16* Ob, float* Of) {
    const int tid = threadIdx.x, lane = tid & 63, wave = tid >> 6;
    const int gw = blockIdx.x * NWAVES + wave, NGW = gridDim.x * NWAVES;
    for (int t = gw; t < T; t += NGW) {
        f32x4 x[4], acc[4];
#pragma unroll
        for (int j = 0; j < 4; ++j) { const v2u w = *((const GAS v2u*)(X + (size_t)t * D) + lane + 64 * j);
            x[j] = (f32x4){bflo(w.x), bfhi(w.x), bflo(w.y), bfhi(w.y)}; acc[j] = (f32x4){0.f, 0.f, 0.f, 0.f}; }
        const int e0 = EID[(size_t)t * 128 + lane], e1 = EID[(size_t)t * 128 + 64 + lane];
        const float g0 = GATE[(size_t)t * 128 + lane], g1 = GATE[(size_t)t * 128 + 64 + lane];
#pragma unroll 2
        for (int k = 0; k < 128; ++k) {
            const int e = (k < 64) ? __shfl(e0, k) : __shfl(e1, k - 64);
            const float gt = (k < 64) ? __shfl(g0, k) : __shfl(g1, k - 64);
            const GAS f32x4* ur = (const GAS f32x4*)(U + (size_t)e * D) + lane;
            float dot = 0.f;
#pragma unroll
            for (int j = 0; j < 4; ++j) { const f32x4 u = ur[64 * j]; dot += (x[j].x * u.x + x[j].y * u.y) + (x[j].z * u.z + x[j].w * u.w); }
            dot = wave_sum(dot);
            const float a = 0.5f * dot * (1.f + erff(dot * 0.70710678118654752f));
            const float cf = gt * a;
            const GAS f32x4* vr = (const GAS f32x4*)(V + (size_t)e * D) + lane;
#pragma unroll
            for (int j = 0; j < 4; ++j) { const f32x4 v = vr[64 * j]; acc[j] += cf * v; }
        }
        float s = 0.f;
#pragma unroll
        for (int j = 0; j < 4; ++j) { acc[j] = ALPHA * x[j] + acc[j]; s += (acc[j].x + acc[j].y) + (acc[j].z + acc[j].w); }
        const float mean = wave_sum(s) * (1.f / D); float s2 = 0.f;
#pragma unroll
        for (int j = 0; j < 4; ++j) { acc[j] = acc[j] - mean; s2 += (acc[j].x * acc[j].x + acc[j].y * acc[j].y) + (acc[j].z * acc[j].z + acc[j].w * acc[j].w); }
        const float rstd = 1.f / sqrtf(wave_sum(s2) * (1.f / D) + LN_EPS);
#pragma unroll
        for (int j = 0; j < 4; ++j) { const f32x4 gg = *((const GAS f32x4*)g + lane + 64 * j), b4 = *((const GAS f32x4*)bb + lane + 64 * j);
            const f32x4 o = acc[j] * rstd * gg + b4;
            if (FINAL) *((GAS f32x4*)(Of + (size_t)t * D) + lane + 64 * j) = o;
            else { v2u w; w.x = pk2(o.x, o.y); w.y = pk2(o.z, o.w); *((GAS v2u*)(Ob + (size_t)t * D) + lane + 64 * j) = w; } }
    }
}
__device__ __forceinline__ void phase_hgrn(LAS unsigned char* lds, unsigned char* ws) {
    const int tid = threadIdx.x;
    const bf16* CQ = (const bf16*)(ws + WS_CQ); const bf16* CK = (const bf16*)(ws + WS_CK); const bf16* CV = (const bf16*)(ws + WS_CV); bf16* O = (bf16*)(ws + WS_O);
    LAS float* fL = (LAS float*)lds;
    LAS float* kL = fL + 4096; LAS float* qL = kL + 4096;
    LAS float* vL = qL + 4096;
    LAS float* part = vL + 1024;
    for (int item = blockIdx.x; item < 256; item += gridDim.x) {
        const int es = item & 3, h = (item >> 2) & 7, b = item >> 5;
        const int e = tid & 31, dg = tid >> 5;
        float S[8];
#pragma unroll
        for (int j = 0; j < 8; ++j) S[j] = 0.f;
        for (int blk = 0; blk < SEQ / 32; ++blk) {
            const size_t t0 = (size_t)b * SEQ + blk * 32;
            for (int idx = tid; idx < 4096; idx += NTHR) { const int s = idx >> 7, d = idx & 127; const size_t o = (t0 + s) * D + h * 128 + d;
                const float kk = bf2f(CK[o]); kL[idx] = kk; fL[idx] = 1.f - kk; qL[idx] = bf2f(CQ[o]); }
            for (int idx = tid; idx < 1024; idx += NTHR) { const int s = idx >> 5, ee = idx & 31; vL[idx] = bf2f(CV[(t0 + s) * D + h * 128 + es * 32 + ee]); }
            __syncthreads();
            for (int s = 0; s < 32; ++s) { const float v = vL[s * 32 + e]; float po = 0.f;
#pragma unroll
                for (int j = 0; j < 8; ++j) { const int d = dg * 8 + j; S[j] = fL[s * 128 + d] * S[j] + kL[s * 128 + d] * v; po += qL[s * 128 + d] * S[j]; }
                part[(s * 16 + dg) * 32 + e] = po; }
            __syncthreads();
            for (int idx = tid; idx < 1024; idx += NTHR) { const int s = idx >> 5, ee = idx & 31; float o = 0.f;
#pragma unroll
                for (int g = 0; g < 16; ++g) o += part[(s * 16 + g) * 32 + ee];
                O[(t0 + s) * D + h * 128 + es * 32 + ee] = (bf16)f2bf(o); }
            __syncthreads();
        }
    }
}
__device__ __forceinline__ void phase_hgrn_norm(const float* norm_g, unsigned char* ws) {
    const int tid = threadIdx.x, lane = tid & 63, wave = tid >> 6;
    const int gw = blockIdx.x * NWAVES + wave, NGW = gridDim.x * NWAVES;
    const bf16* O = (const bf16*)(ws + WS_O); const bf16* CG = (const bf16*)(ws + WS_CG); bf16* Y2 = (bf16*)(ws + WS_Y2);
    for (int t = gw; t < T; t += NGW) {
        const v4u a0 = *((const GAS v4u*)(O + (size_t)t * D) + lane * 2), a1 = *((const GAS v4u*)(O + (size_t)t * D) + lane * 2 + 1);
        const v4u g0 = *((const GAS v4u*)(CG + (size_t)t * D) + lane * 2), g1 = *((const GAS v4u*)(CG + (size_t)t * D) + lane * 2 + 1);
        float o[16], gv[16];
        o[0] = bflo(a0.x); o[1] = bfhi(a0.x); o[2] = bflo(a0.y); o[3] = bfhi(a0.y); o[4] = bflo(a0.z); o[5] = bfhi(a0.z); o[6] = bflo(a0.w); o[7] = bfhi(a0.w);
        o[8] = bflo(a1.x); o[9] = bfhi(a1.x); o[10] = bflo(a1.y); o[11] = bfhi(a1.y); o[12] = bflo(a1.z); o[13] = bfhi(a1.z); o[14] = bflo(a1.w); o[15] = bfhi(a1.w);
        gv[0] = bflo(g0.x); gv[1] = bfhi(g0.x); gv[2] = bflo(g0.y); gv[3] = bfhi(g0.y); gv[4] = bflo(g0.z); gv[5] = bfhi(g0.z); gv[6] = bflo(g0.w); gv[7] = bfhi(g0.w);
        gv[8] = bflo(g1.x); gv[9] = bfhi(g1.x); gv[10] = bflo(g1.y); gv[11] = bfhi(g1.y); gv[12] = bflo(g1.z); gv[13] = bfhi(g1.z); gv[14] = bflo(g1.w); gv[15] = bfhi(g1.w);
        float sq = 0.f;
#pragma unroll
        for (int j = 0; j < 16; ++j) sq += o[j] * o[j];
        sq += __shfl_xor(sq, 1); sq += __shfl_xor(sq, 2); sq += __shfl_xor(sq, 4);
        const float r = 1.f / sqrtf(sq * (1.f / 128.f) + LN_EPS);
        float y[16];
#pragma unroll
        for (int j = 0; j < 16; ++j) { const float sg = gv[j] / (1.f + expf(-gv[j])); y[j] = o[j] * r * norm_g[lane * 16 + j] * sg; }
        v4u w0, w1; w0.x = pk2(y[0], y[1]); w0.y = pk2(y[2], y[3]); w0.z = pk2(y[4], y[5]); w0.w = pk2(y[6], y[7]);
        w1.x = pk2(y[8], y[9]); w1.y = pk2(y[10], y[11]); w1.z = pk2(y[12], y[13]); w1.w = pk2(y[14], y[15]);
        *((GAS v4u*)(Y2 + (size_t)t * D) + lane * 2) = w0; *((GAS v4u*)(Y2 + (size_t)t * D) + lane * 2 + 1) = w1;
    }
}

struct Args { const float* in[16]; float* out; unsigned char* ws; int ph_lo, ph_hi, li, pad; };
__global__ void __launch_bounds__(NTHR, 2) mk_fwd(Args args) {
    extern __shared__ __attribute__((aligned(16))) unsigned char lds_raw[];
    LAS unsigned char* lds = (LAS unsigned char*)lds_raw;
    volatile LAS unsigned* MISC = (volatile LAS unsigned*)(lds + MISC_OFF);
    const int tid = threadIdx.x;
    unsigned char* ws = args.ws;
    gu32* ctl = (gu32*)(ws + WS_CTL);
    if (tid < 32) ((LAS unsigned*)(lds + MISC_OFF))[tid] = 0u;
    __syncthreads();
    XcdBarrier bar; bar.bar = (unsigned*)ctl + CW_BAR; bar.x = 0; bar.st = nullptr;
    if (N_LAUNCHES == 1) bar = xcd_barrier_post((unsigned*)ctl + CW_BAR, MISC + 8);
    const int lo = args.ph_lo, hi = args.ph_hi;
#define IN(k) (lo <= (k) && (k) < hi)
#define SEAM(k) do { if (IN(k) && IN((k) + 1)) xcd_barrier(bar); } while (0)
    const float* const* in = args.in;
    bf16* XB = (bf16*)(ws + WS_XB); bf16* H0 = (bf16*)(ws + WS_H0); bf16* Y = (bf16*)(ws + WS_Y); bf16* H1 = (bf16*)(ws + WS_H1);
    int* EID = (int*)(ws + WS_EID); float* GATE = (float*)(ws + WS_GATE);
    float* Z = args.out;

    if (IN(0)) { phase_prologue(lds, in, ws); } SEAM(0);
    if (IN(1)) { EpiStore E{H0, AB_IN}; gemm_naive(lds, XB, (const bf16*)(ws + WS_WABIN), T, AB_IN, D, E); } SEAM(1);
    if (IN(2)) { phase_ret_local(lds, ws); } SEAM(2);
    if (IN(3)) { phase_ret_prefix(ws); } SEAM(3);
    if (IN(4)) { phase_ret_out_pool(lds, in, ws); } SEAM(4);
    if (IN(5)) { EpiResid E{XB, Z}; gemm_naive(lds, Y, (const bf16*)(ws + WS_WABOUT), T, D, D, E); } SEAM(5);
    if (IN(6)) { phase_ln(Z, H1, in[14], in[15]); } SEAM(6);
    if (IN(7)) { EpiStore E{H0  , 2048}; gemm_naive(lds, H1, (const bf16*)(ws + WS_WQ), T, 2048, D, E); } SEAM(7);
    if (IN(8)) { phase_topk(lds, H0, in[11], EID, GATE); } SEAM(8);
    if (IN(9)) { phase_gather<false>(H1, EID, GATE, in[12], in[13], in[14] + D, in[15] + D, XB  , nullptr); } SEAM(9);
    if (IN(10)) { EpiCIn E{(bf16*)(ws + WS_CQ), (bf16*)(ws + WS_CK), (bf16*)(ws + WS_CV), (bf16*)(ws + WS_CG), (const float*)(ws + WS_LB)};
                  gemm_naive(lds, XB, (const bf16*)(ws + WS_WCIN), T, C_IN, D, E); } SEAM(10);
    if (IN(11)) { phase_hgrn(lds, ws); } SEAM(11);
    if (IN(12)) { phase_hgrn_norm(in[8], ws); } SEAM(12);
    if (IN(13)) { EpiResid E{XB, Z}; gemm_naive(lds, (const bf16*)(ws + WS_Y2), (const bf16*)(ws + WS_WCOUT), T, D, D, E); } SEAM(13);
    if (IN(14)) { phase_ln(Z, H1  , in[14] + 2 * D, in[15] + 2 * D); } SEAM(14);
    if (IN(15)) { EpiStore E{(bf16*)(ws + WS_Q1), 2048}; gemm_naive(lds, H1, (const bf16*)(ws + WS_WQ) + (size_t)2048 * D, T, 2048, D, E); } SEAM(15);
    if (IN(16)) { phase_topk(lds, (const bf16*)(ws + WS_Q1), in[11] + (size_t)8 * 2 * 128 * 128, EID, GATE); } SEAM(16);
    if (IN(17)) { phase_gather<true>(H1, EID, GATE, in[12] + (size_t)NEXP * D, in[13] + (size_t)NEXP * D, in[14] + 3 * D, in[15] + 3 * D, nullptr, args.out); }
#undef IN
#undef SEAM
}

extern "C" void kernel_launch(void* const* d_in, const int* in_sizes, int n_in, void* d_out, int out_size, void* d_ws, size_t ws_size, hipStream_t stream) {
    static int grid = 0;
    if (grid == 0) {
        if (n_in != 16 || in_sizes[0] != T * D || out_size != T * D || ws_size < WS_END) { fprintf(stderr, "kernel_launch: unexpected problem (n_in %d, in0 %d, out %d, ws %zu); nothing launched\n", n_in, n_in > 0 ? in_sizes[0] : -1, out_size, ws_size); grid = -1; return; }
        int dev = 0, cus = 0;
        if (hipGetDevice(&dev) != hipSuccess || hipDeviceGetAttribute(&cus, hipDeviceAttributeMultiprocessorCount, dev) != hipSuccess) { grid = -1; return; }
        if (hipFuncSetAttribute((const void*)mk_fwd, hipFuncAttributeMaxDynamicSharedMemorySize, LDS_BYTES) != hipSuccess) { fprintf(stderr, "kernel_launch: hipFuncSetAttribute failed\n"); grid = -1; return; }
        (void)hipGetLastError();
        grid = cus;
    }
    if (grid < 0) return;
    if (hipMemsetAsync((char*)d_ws + WS_CTL, 0, CTL_ZERO_BYTES, stream) != hipSuccess) return;
    Args a{};
    for (int i = 0; i < 16; ++i) a.in[i] = (const float*)d_in[i];
    a.out = (float*)d_out; a.ws = (unsigned char*)d_ws;
    for (int li = 0; li < N_LAUNCHES; ++li) {
        a.ph_lo = (N_LAUNCHES == 1) ? 0 : li; a.ph_hi = (N_LAUNCHES == 1) ? NPHASE : li + 1; a.li = li;
        hipLaunchKernelGGL(mk_fwd, dim3(grid), dim3(NTHR), LDS_BYTES, stream, a);
        if (hipPeekAtLastError() != hipSuccess) { fprintf(stderr, "kernel_launch: launch %d failed\n", li); break; }
    }
}
```

```cpp
#include <hip/hip_runtime.h>
#include <cstdio>
#include <cstdint>

#ifndef MK_N_LAUNCHES
#define MK_N_LAUNCHES 1
#endif
constexpr int NPHASE = 18;
constexpr int N_LAUNCHES = MK_N_LAUNCHES;

constexpr int BATCH = 8, SEQ = 4096, D = 1024, T = BATCH * SEQ;
constexpr int AB_IN = 2048, C_IN = 4096, NEXP = 16384;
constexpr float LN_EPS = 1e-5f;
constexpr float ALPHA = 1.41421356237309515f;
constexpr int NWAVES = 8, NTHR = 512;

constexpr size_t MiB = 1u << 20;
constexpr size_t WS_CTL = 0, CTL_ZERO_BYTES = 1 * MiB;
constexpr size_t WS_LB = 1 * MiB;
constexpr size_t WS_ROPE = 2 * MiB;
constexpr size_t WS_WABIN = 4 * MiB;
constexpr size_t WS_WABOUT = 8 * MiB;
constexpr size_t WS_WCIN = 10 * MiB;
constexpr size_t WS_WCOUT = 18 * MiB;
constexpr size_t WS_WQ = 20 * MiB;
constexpr size_t WS_KEYS = 28 * MiB;
constexpr size_t WS_XB = 96 * MiB;
constexpr size_t WS_H0 = 160 * MiB;
constexpr size_t WS_LST = 288 * MiB;
constexpr size_t WS_Y = 320 * MiB;
constexpr size_t WS_H1 = 384 * MiB;
constexpr size_t WS_EID = 448 * MiB;
constexpr size_t WS_GATE = 464 * MiB;
constexpr size_t WS_CQ = 160 * MiB, WS_CK = 224 * MiB, WS_CV = 288 * MiB, WS_CG = 352 * MiB;
constexpr size_t WS_O = 416 * MiB;
constexpr size_t WS_Y2 = 160 * MiB;
constexpr size_t WS_Q1 = 224 * MiB;
constexpr size_t WS_END = 480 * MiB;

constexpr int CW_BAR = 4096;
constexpr int LDS_BYTES = 147456;
constexpr int MISC_OFF = LDS_BYTES - 128;

#define GAS __attribute__((address_space(1)))
#define LAS __attribute__((address_space(3)))
typedef unsigned short bf16;
typedef unsigned v4u __attribute__((ext_vector_type(4)));
typedef unsigned v2u __attribute__((ext_vector_type(2)));
typedef float f32x4 __attribute__((ext_vector_type(4)));
typedef GAS unsigned gu32;
#define RLX_AGENT __ATOMIC_RELAXED, __HIP_MEMORY_SCOPE_AGENT
#define LDS_WAIT() asm volatile("s_waitcnt lgkmcnt(0)" ::: "memory")
__device__ __forceinline__ unsigned f2bf(float f) { unsigned u = __builtin_bit_cast(unsigned, f); return (u + 0x7fffu + ((u >> 16) & 1u)) >> 16; }
__device__ __forceinline__ unsigned pk2(float lo, float hi) { return f2bf(lo) | (f2bf(hi) << 16); }
__device__ __forceinline__ float bf2f(unsigned b) { return __builtin_bit_cast(float, b << 16); }
__device__ __forceinline__ float bflo(unsigned w) { return __builtin_bit_cast(float, w << 16); }
__device__ __forceinline__ float bfhi(unsigned w) { return __builtin_bit_cast(float, w & 0xffff0000u); }
__device__ __forceinline__ float wave_sum(float v) {
#pragma unroll
    for (int o = 1; o < 64; o <<= 1) v += __shfl_xor(v, o);
    return v;
}

#define XB_TMO      128
#define XB_XCNT(j)  (256  + 64 * (j))
#define XB_XSUB(j)  (1280 + 64 * (j))
#define XB_XGEN(j)  (2304 + 64 * (j))
#define XB_TOP      3328
#define XB_TOPGEN   3392
#define XCD_BAR_WORDS 3456
#define XB_SPIN_CAP (1u << 21)
__device__ __forceinline__ unsigned xb_ld(unsigned* p)              { return __hip_atomic_load(p, __ATOMIC_RELAXED, __HIP_MEMORY_SCOPE_AGENT); }
__device__ __forceinline__ unsigned xb_add(unsigned* p, unsigned v) { return __hip_atomic_fetch_add(p, v, __ATOMIC_RELAXED, __HIP_MEMORY_SCOPE_AGENT); }
__device__ __forceinline__ unsigned xb_xcc_id() { return (unsigned)__builtin_amdgcn_s_getreg((3 << 11) | 20) & 0xFu; }
#define XB_SPIN(cond, bar) do { unsigned _sp = 0; while (cond) { __builtin_amdgcn_s_sleep(1); \
    if ((++_sp & 255u) == 0u) { if (xb_ld(&(bar)[XB_TMO])) break; if (_sp > XB_SPIN_CAP) { atomicAdd(&(bar)[XB_TMO], 1u); break; } } } } while (0)
struct XcdBarrier { unsigned* bar; unsigned x; volatile LAS unsigned* st; };
__device__ __forceinline__ XcdBarrier xcd_barrier_post(unsigned* bar, volatile LAS unsigned* st) {
    XcdBarrier b; b.bar = bar; b.x = xb_xcc_id(); b.st = st;
    if (threadIdx.x == 0) (void)xb_add(&bar[XB_XCNT(b.x)], 1u);
    return b;
}
__device__ __forceinline__ void xcd_barrier_complete(unsigned* bar, unsigned x, unsigned& nloc, unsigned& nx) {
    const unsigned G = gridDim.x * gridDim.y * gridDim.z;
    unsigned sum, cnt, mine, sp = 0u;
    for (;;) {
        sum = 0u; cnt = 0u; mine = 0u;
#pragma unroll
        for (unsigned j = 0; j < 16; ++j) { const unsigned c = xb_ld(&bar[XB_XCNT(j)]); sum += c; cnt += (c > 0u) ? 1u : 0u; mine = (j == x) ? c : mine; }
        if (sum == G) break;
        __builtin_amdgcn_s_sleep(1);
        if ((++sp & 255u) == 0u) { if (xb_ld(&bar[XB_TMO])) break; if (sp > XB_SPIN_CAP) { atomicAdd(&bar[XB_TMO], 1u); break; } }
    }
    nloc = mine > 0u ? mine : 1u; nx = cnt > 0u ? cnt : 1u;
}
__device__ __forceinline__ void xcd_barrier(const XcdBarrier& b) {
    asm volatile("s_waitcnt vmcnt(0)" ::: "memory");
    __syncthreads();
    if (threadIdx.x == 0) {
        unsigned* bar = b.bar;
        __builtin_amdgcn_s_waitcnt(0);
        unsigned nloc = b.st[0], nx = b.st[1];
        if (nloc == 0u) { xcd_barrier_complete(bar, b.x, nloc, nx); b.st[0] = nloc; b.st[1] = nx; }
        const unsigned old = xb_add(&bar[XB_XSUB(b.x)], 1u);
        const unsigned gen = old / nloc;
        if (old + 1u == (gen + 1u) * nloc) {
            __builtin_amdgcn_fence(__ATOMIC_RELEASE, "agent");
            asm volatile("s_waitcnt vmcnt(0)" ::: "memory");
            const unsigned og = xb_add(&bar[XB_TOP], 1u);
            const unsigned tg = og / nx;
            if (og + 1u == (tg + 1u) * nx) xb_add(&bar[XB_TOPGEN], 1u);
            else XB_SPIN(xb_ld(&bar[XB_TOPGEN]) == tg, bar);
            __builtin_amdgcn_fence(__ATOMIC_ACQUIRE, "agent");
            xb_add(&bar[XB_XGEN(b.x)], 1u);
            asm volatile("s_waitcnt vmcnt(0)" ::: "memory");
        } else {
            XB_SPIN(xb_ld(&bar[XB_XGEN(b.x)]) == gen, bar);
            __builtin_amdgcn_fence(__ATOMIC_ACQUIRE, "agent");
            asm volatile("s_waitcnt vmcnt(0)" ::: "memory");
        }
    }
    __syncthreads();
}

__device__ __forceinline__ void p0_transpose_item(const float* W, int K, int N, bf16* WT, LAS float* scr, int item, int lane) {
    const int nblk = N / 32, kb = item / nblk, nb = item % nblk, k0 = 64 * kb, n0 = 32 * nb;
#pragma unroll 8
    for (int i = 0; i < 32; ++i) { const int kk = 2 * i + (lane >> 5); scr[kk * 33 + (lane & 31)] = W[(size_t)(k0 + kk) * N + n0 + (lane & 31)]; }
    LDS_WAIT(); asm volatile("" ::: "memory");
    const int c = lane & 7;
#pragma unroll
    for (int j = 0; j < 4; ++j) { const int n = (lane >> 3) + 8 * j; const LAS float* s = scr + (8 * c) * 33 + n;
        v4u o; o.x = pk2(s[0 * 33], s[1 * 33]); o.y = pk2(s[2 * 33], s[3 * 33]); o.z = pk2(s[4 * 33], s[5 * 33]); o.w = pk2(s[6 * 33], s[7 * 33]);
        *(GAS v4u*)(WT + (size_t)(n0 + n) * K + k0 + 8 * c) = o; }
    LDS_WAIT(); asm volatile("" ::: "memory");
}

template <class Epi>
__device__ __forceinline__ void gemm_naive(LAS unsigned char* lds, const bf16* A, const bf16* Bt, int M, int N, int K, const Epi& E) {
    LAS float* As = (LAS float*)lds;
    LAS float* Bs = As + 128 * 33;
    const int tid = threadIdx.x, tx = tid & 15, ty = tid >> 4;
    const int ntn = N / 128, ntiles = (M / 128) * ntn;
    for (int tile = blockIdx.x; tile < ntiles; tile += gridDim.x) {
        const int tm = tile / ntn, tn = tile % ntn;
        float acc[4][8];
#pragma unroll
        for (int i = 0; i < 4; ++i)
#pragma unroll
            for (int j = 0; j < 8; ++j) acc[i][j] = 0.f;
        for (int k0 = 0; k0 < K; k0 += 32) {
            { const int r = tid >> 2, kc = (tid & 3) * 8;
              const v4u va = *(const GAS v4u*)(A + (size_t)(tm * 128 + r) * K + k0 + kc);
              const v4u vb = *(const GAS v4u*)(Bt + (size_t)(tn * 128 + r) * K + k0 + kc);
              LAS float* pa = As + r * 33 + kc; LAS float* pb = Bs + r * 33 + kc;
              pa[0] = bflo(va.x); pa[1] = bfhi(va.x); pa[2] = bflo(va.y); pa[3] = bfhi(va.y); pa[4] = bflo(va.z); pa[5] = bfhi(va.z); pa[6] = bflo(va.w); pa[7] = bfhi(va.w);
              pb[0] = bflo(vb.x); pb[1] = bfhi(vb.x); pb[2] = bflo(vb.y); pb[3] = bfhi(vb.y); pb[4] = bflo(vb.z); pb[5] = bfhi(vb.z); pb[6] = bflo(vb.w); pb[7] = bfhi(vb.w); }
            __syncthreads();
#pragma unroll 8
            for (int kk = 0; kk < 32; ++kk) {
                float a[4], b[8];
#pragma unroll
                for (int i = 0; i < 4; ++i) a[i] = As[(ty * 4 + i) * 33 + kk];
#pragma unroll
                for (int j = 0; j < 8; ++j) b[j] = Bs[(tx + 16 * j) * 33 + kk];
#pragma unroll
                for (int i = 0; i < 4; ++i)
#pragma unroll
                    for (int j = 0; j < 8; ++j) acc[i][j] += a[i] * b[j];
            }
            __syncthreads();
        }
#pragma unroll
        for (int i = 0; i < 4; ++i)
#pragma unroll
            for (int j = 0; j < 8; ++j) E(tm * 128 + ty * 4 + i, tn * 128 + tx + 16 * j, acc[i][j]);
    }
}
struct EpiStore { bf16* O; int ldc;
    __device__ __forceinline__ void operator()(int r, int c, float v) const { O[(size_t)r * ldc + c] = (bf16)f2bf(v); } };
struct EpiResid { const bf16* X; float* Z;
    __device__ __forceinline__ void operator()(int r, int c, float v) const { Z[(size_t)r * D + c] = ALPHA * bf2f(X[(size_t)r * D + c]) + v; } };
struct EpiCIn { bf16 *CQ, *CK, *CV, *CG; const float* lb;
    __device__ __forceinline__ void operator()(int r, int c, float v) const {
        const int seg = c >> 10, cc = c & 1023; const size_t o = (size_t)r * D + cc;
        if (seg == 0) CQ[o] = (bf16)f2bf(v);
        else if (seg == 1) { const float k = (1.f - lb[cc]) / (1.f + expf(v)); CK[o] = (bf16)f2bf(k); }
        else if (seg == 2) CV[o] = (bf16)f2bf(v);
        else CG[o] = (bf16)f2bf(v);
    } };

namespace pg8 {
#define PG8_LAS __attribute__((address_space(3)))
typedef unsigned short bf16_t;
typedef short bf16x8 __attribute__((ext_vector_type(8)));
typedef float f32x4 __attribute__((ext_vector_type(4)));
typedef unsigned u32x4 __attribute__((ext_vector_type(4)));
constexpr int BM = 256, BK = 64, HALF = 128, HTB = HALF * BK * 2  , STAGE_BYTES = 8 * HTB, NXCD = 8, WGM = 8;

__host__ __device__ __forceinline__ int lds_byte(int r, int c) { const int st = (r >> 4) * 2 + (c >> 5), rr = r & 15, cc = c & 31, ob = rr * 64 + cc * 2; return st * 1024 + (ob ^ (((ob >> 9) & 1) << 5)); }
__host__ __device__ __forceinline__ void stage_rc(int b, int& R, int& C) { const int st = b / 1024, sb = b % 1024, swz = sb ^ (((sb >> 9) & 1) << 5); R = (st >> 1) * 16 + swz / 64; C = (st & 1) * 32 + (swz % 64) / 2; }
__host__ __device__ __forceinline__ int perm32(int rho) { const int n = rho >> 4, i = rho & 15; return 8 * (i >> 2) + 4 * n + (i & 3); }

struct Unit { int pm, pn; };
struct Gemm { const bf16_t* A; const bf16_t* Bt; int M, N, K; };

struct StaticOrder {
    int nM, nN, nwg, G, c;
    __host__ __device__ void init(int M, int N, int G_, int c_) { nM = M / BM; nN = N / BM; nwg = nM * nN; G = G_; c = c_; }
    __host__ __device__ bool next(int i, Unit& u) const {
        const long L = (long)i * G + c; if (L >= nwg) return false;
        int wgid = (int)L; { const int q = nwg / NXCD, r = nwg % NXCD, xcd = wgid % NXCD, off = wgid / NXCD; wgid = (xcd < r ? xcd * (q + 1) : r * (q + 1) + (xcd - r) * q) + off; }
        const int nig = WGM * nN, gid = wgid / nig, fm = gid * WGM, gsz = (nM - fm) < WGM ? (nM - fm) : WGM;
        u.pm = fm + ((wgid % nig) % gsz); u.pn = (wgid % nig) / gsz; return true;
    }
    __device__ __forceinline__ void a_ready(const Unit&) const {}
    __device__ __forceinline__ void done(const Unit&) const {}
};

__device__ __forceinline__ unsigned cvt_pk_bf16(float lo, float hi) { unsigned r; asm volatile("v_cvt_pk_bf16_f32 %0, %1, %2" : "=v"(r) : "v"(lo), "v"(hi)); return r; }
typedef float f32x2 __attribute__((ext_vector_type(2)));
__device__ __forceinline__ f32x2 gelu_pk(f32x2 v) {
    const f32x2 av = __builtin_elementwise_abs(v), d = av * 0.2316418882f + 1.0f;
    f32x2 t; t.x = __builtin_amdgcn_rcpf(d.x); t.y = __builtin_amdgcn_rcpf(d.y);
    f32x2 q = t * 0.5307027145f + (-0.7265760135f); q = q * t + 0.7107068705f; q = q * t + (-0.142248368f); q = q * t + 0.127414796f; q = q * t;
    const f32x2 s = (v * v) * (-0.72134752044f);
    f32x2 e; e.x = __builtin_amdgcn_exp2f(s.x); e.y = __builtin_amdgcn_exp2f(s.y);
    const f32x2 m = v * (q * e), r = v - m;
    f32x2 o; o.x = v.x < 0.f ? m.x : r.x; o.y = v.y < 0.f ? m.y : r.y; return o;
}

template <int ACT  > struct EpiBf16 {
    static constexpr bool PERM = true, AFTER_DRAIN = false; static_assert(ACT == 0 || ACT == 1, "EpiBf16: ACT is 0 (none) or 1 (gelu_pk)");
    bf16_t* O; int ldc; const float* bias; int split_cols; size_t split_stride; float scale0;
    __device__ __forceinline__ void operator()(const f32x4 (&acc)[2][2][4][2], const Unit& u, int wr, int wc, int fr, int fq) const {
        const int row0 = u.pm * BM + wr * 64 + fr; int colt = u.pn * BM; bf16_t* base = O;
        float sc = 1.f; if (split_cols) { const int t = colt / split_cols; base += (size_t)t * split_stride; colt -= t * split_cols; if (t == 0) sc = scale0; }
        const int col0 = colt + wc * 32 + 8 * fq, bcol0 = u.pn * BM + wc * 32 + 8 * fq;
        f32x4 bv[2][2];
#pragma unroll
        for (int bj = 0; bj < 2; ++bj)
#pragma unroll
            for (int n = 0; n < 2; ++n) bv[bj][n] = bias ? *(const f32x4*)(bias + bcol0 + bj * HALF + 4 * n) : (f32x4){0.f, 0.f, 0.f, 0.f};
#pragma unroll
        for (int ai = 0; ai < 2; ++ai)
#pragma unroll
            for (int m = 0; m < 4; ++m) { bf16_t* rowp = base + (size_t)(row0 + ai * HALF + m * 16) * ldc + col0;
#pragma unroll
                for (int bj = 0; bj < 2; ++bj) { f32x4 v0 = acc[ai][bj][m][0] + bv[bj][0], v1 = acc[ai][bj][m][1] + bv[bj][1];
                    if (ACT == 1) { f32x2 a = gelu_pk((f32x2){v0[0], v0[1]}), b = gelu_pk((f32x2){v0[2], v0[3]}), c = gelu_pk((f32x2){v1[0], v1[1]}), d = gelu_pk((f32x2){v1[2], v1[3]});
                        v0 = (f32x4){a.x, a.y, b.x, b.y}; v1 = (f32x4){c.x, c.y, d.x, d.y}; }
                    v0 = v0 * sc; v1 = v1 * sc; u32x4 w; w.x = cvt_pk_bf16(v0[0], v0[1]); w.y = cvt_pk_bf16(v0[2], v0[3]); w.z = cvt_pk_bf16(v1[0], v1[1]); w.w = cvt_pk_bf16(v1[2], v1[3]);
                    *(u32x4*)(rowp + bj * HALF) = w; } }
    }
};

struct EpiResidF32 {
    static constexpr bool PERM = false, AFTER_DRAIN = false;
    const bf16_t* X; float* Z;
    __device__ __forceinline__ void operator()(const f32x4 (&acc)[2][2][4][2], const Unit& u, int wr, int wc, int fr, int fq) const {
        typedef unsigned u32x2 __attribute__((ext_vector_type(2)));
        const int row0 = u.pm * BM + wr * 64 + fr, col0 = u.pn * BM + wc * 32 + 4 * fq;
#pragma unroll
        for (int ai = 0; ai < 2; ++ai)
#pragma unroll
            for (int m = 0; m < 4; ++m) { const size_t ro = (size_t)(row0 + ai * HALF + m * 16) * 1024;
#pragma unroll
                for (int bj = 0; bj < 2; ++bj)
#pragma unroll
                    for (int n = 0; n < 2; ++n) { const int c = col0 + bj * HALF + n * 16; const u32x2 xw = *(const u32x2*)(X + ro + c);
                        f32x4 xv; xv[0] = __builtin_bit_cast(float, xw.x << 16); xv[1] = __builtin_bit_cast(float, xw.x & 0xffff0000u); xv[2] = __builtin_bit_cast(float, xw.y << 16); xv[3] = __builtin_bit_cast(float, xw.y & 0xffff0000u);
                        *(f32x4*)(Z + ro + c) = xv * 1.41421356237309515f + acc[ai][bj][m][n]; } }
    }
};
struct EpiCInF {
    static constexpr bool PERM = true, AFTER_DRAIN = false;
    bf16_t *CQ, *CK, *CV, *CG; const float* lb;
    __device__ __forceinline__ void operator()(const f32x4 (&acc)[2][2][4][2], const Unit& u, int wr, int wc, int fr, int fq) const {
        const int seg = u.pn >> 2, colt = (u.pn & 3) * BM;
        bf16_t* base = seg == 0 ? CQ : (seg == 1 ? CK : (seg == 2 ? CV : CG));
        const int row0 = u.pm * BM + wr * 64 + fr, col0 = colt + wc * 32 + 8 * fq;
        f32x4 om[2][2];
#pragma unroll
        for (int bj = 0; bj < 2; ++bj)
#pragma unroll
            for (int n = 0; n < 2; ++n) { const f32x4 l = *(const f32x4*)(lb + col0 + bj * HALF + 4 * n); om[bj][n] = 1.0f - l; }
#pragma unroll
        for (int ai = 0; ai < 2; ++ai)
#pragma unroll
            for (int m = 0; m < 4; ++m) { bf16_t* rowp = base + (size_t)(row0 + ai * HALF + m * 16) * 1024 + col0;
#pragma unroll
                for (int bj = 0; bj < 2; ++bj) { f32x4 v0 = acc[ai][bj][m][0], v1 = acc[ai][bj][m][1];
                    if (seg == 1) {
#pragma unroll
                        for (int q = 0; q < 4; ++q) { v0[q] = om[bj][0][q] / (1.0f + __expf(v0[q])); v1[q] = om[bj][1][q] / (1.0f + __expf(v1[q])); } }
                    u32x4 w; w.x = cvt_pk_bf16(v0[0], v0[1]); w.y = cvt_pk_bf16(v0[2], v0[3]); w.z = cvt_pk_bf16(v1[0], v1[1]); w.w = cvt_pk_bf16(v1[2], v1[3]);
                    *(u32x4*)(rowp + bj * HALF) = w; } }
    }
};
template <class Epi, class Sched, bool ALIGN_EPI = false, bool SP2 = false>
__device__ __forceinline__ void gemm_phase(PG8_LAS unsigned char* lds, const Gemm g, const Sched& S, const Epi& E) {
    const int tid = threadIdx.x, wid = __builtin_amdgcn_readfirstlane(tid >> 6), lane = tid & 63, wr = wid >> 2, wc = wid & 3, fr = lane & 15, fq = lane >> 4;
    const int K = g.K, nt = K / BK;
    unsigned voffA[2], voffB[2];
#pragma unroll
    for (int i = 0; i < 2; ++i) { int R, C; stage_rc(tid * 16 + i * 8192, R, C); const int Rb = Epi::PERM ? ((R & ~31) + perm32(R & 31)) : R;
        voffA[i] = (unsigned)(R * K + C) * 2u; voffB[i] = (unsigned)(Rb * K + C) * 2u; }
    const size_t kstep = (size_t)(BK * 2);
    const size_t hstep = (size_t)HALF * K * 2;
    const size_t tstep = 2 * hstep;
    const unsigned ldsw = (unsigned)wid * 1024u;
    const int aoff = lds_byte(wr * 64 + fr, fq * 8), boff = lds_byte(wc * 32 + fr, fq * 8);
#define PG8_SA(b, h) (((b) * 2 + (h)) * HTB)
#define PG8_SB(b, h) ((4 + (b) * 2 + (h)) * HTB)
#define PG8_STAGE(bufoff, gbase, voff) do { _Pragma("unroll") for (int _i = 0; _i < 2; ++_i) \
        __builtin_amdgcn_global_load_lds((const unsigned*)((const char*)(gbase) + (voff)[_i]), (PG8_LAS unsigned*)(lds + (bufoff) + ldsw + _i * 8192), 16, 0, 0); } while (0)
#define PG8_LDA(dst, b, h) do { _Pragma("unroll") for (int m = 0; m < 4; ++m) _Pragma("unroll") for (int k = 0; k < 2; ++k) dst[m][k] = *(const PG8_LAS bf16x8*)(lds + PG8_SA(b, h) + aoff + m * 2048 + k * 1024); } while (0)
#define PG8_LDB(dst, b, h) do { _Pragma("unroll") for (int n = 0; n < 2; ++n) _Pragma("unroll") for (int k = 0; k < 2; ++k) dst[n][k] = *(const PG8_LAS bf16x8*)(lds + PG8_SB(b, h) + boff + n * 2048 + k * 1024); } while (0)
#define PG8_MMA(ai, bj, At, Bt) do { __builtin_amdgcn_s_setprio(1); _Pragma("unroll") for (int m = 0; m < 4; ++m) _Pragma("unroll") for (int n = 0; n < 2; ++n) _Pragma("unroll") for (int k = 0; k < 2; ++k) \
        acc[ai][bj][m][n] = __builtin_amdgcn_mfma_f32_16x16x32_bf16(Bt[n][k], At[m][k], acc[ai][bj][m][n], 0, 0, 0); __builtin_amdgcn_s_setprio(0); } while (0)
#define PG8_WAIT_V(n) asm volatile("s_waitcnt vmcnt(" #n ")" ::: "memory")
#define PG8_WAIT_L(n) asm volatile("s_waitcnt lgkmcnt(" #n ")" ::: "memory")
#define PG8_BAR __builtin_amdgcn_s_barrier()
#define PG8_SCHED __builtin_amdgcn_sched_barrier(0)
    Unit cur, nxt; int ui = 0;
    if (!S.next(0, cur)) return;
    f32x4 acc[2][2][4][2];
#pragma unroll
    for (int a = 0; a < 2; ++a)
#pragma unroll
        for (int b = 0; b < 2; ++b)
#pragma unroll
            for (int m = 0; m < 4; ++m)
#pragma unroll
                for (int n = 0; n < 2; ++n) acc[a][b][m][n] = (f32x4){0.f, 0.f, 0.f, 0.f};
    bf16x8 At[4][2], B0[2][2], B1[2][2];
    const char* cA = (const char*)g.A + (size_t)cur.pm * tstep; const char* cB = (const char*)g.Bt + (size_t)cur.pn * tstep;
    S.a_ready(cur);
    if constexpr (SP2) {
        PG8_STAGE(PG8_SB(0, 0), cB, voffB); PG8_STAGE(PG8_SB(0, 1), cB + hstep, voffB); PG8_STAGE(PG8_SA(0, 0), cA, voffA); PG8_STAGE(PG8_SA(0, 1), cA + hstep, voffA);
        if (wr == 1) PG8_BAR;
        PG8_WAIT_V(2); PG8_BAR;
        PG8_STAGE(PG8_SB(1, 0), cB + kstep, voffB); PG8_STAGE(PG8_SA(1, 0), cA + kstep, voffA); PG8_STAGE(PG8_SB(1, 1), cB + hstep + kstep, voffB);
        PG8_WAIT_V(6); PG8_BAR;
    } else {
        PG8_STAGE(PG8_SB(0, 0), cB, voffB); PG8_STAGE(PG8_SA(0, 0), cA, voffA); PG8_STAGE(PG8_SB(0, 1), cB + hstep, voffB); PG8_STAGE(PG8_SA(0, 1), cA + hstep, voffA);
        if (wr == 1) PG8_BAR;
        PG8_WAIT_V(4); PG8_BAR;
        PG8_STAGE(PG8_SB(1, 0), cB + kstep, voffB); PG8_STAGE(PG8_SA(1, 0), cA + kstep, voffA); PG8_STAGE(PG8_SB(1, 1), cB + hstep + kstep, voffB);
        PG8_WAIT_V(6); PG8_BAR;
    }
    for (;;) {
        const bool has_next = S.next(ui + 1, nxt);
        const char* nA = has_next ? (const char*)g.A + (size_t)nxt.pm * tstep : cA; const char* nB = has_next ? (const char*)g.Bt + (size_t)nxt.pn * tstep : cB;
        for (int t = 0; t < nt; t += 2) {
            const bool last = (t == nt - 2);
            const char* a1 = cA + (size_t)(t + 1) * kstep;
            const char* a2 = last ? nA : cA + (size_t)(t + 2) * kstep; const char* b2 = last ? nB : cB + (size_t)(t + 2) * kstep;
            const char* a3 = a2 + kstep; const char* b3 = b2 + kstep;
            if (last && has_next) S.a_ready(nxt);
            if constexpr (SP2) {
            PG8_LDB(B0, 0, 0); PG8_LDB(B1, 0, 1); PG8_SCHED; PG8_LDA(At, 0, 0); PG8_STAGE(PG8_SA(1, 1), a1 + hstep, voffA);
            PG8_WAIT_V(8); PG8_WAIT_L(0); PG8_BAR; PG8_MMA(0, 0, At, B0); PG8_MMA(0, 1, At, B1); PG8_BAR; PG8_SCHED;
            PG8_LDA(At, 0, 1); PG8_STAGE(PG8_SB(0, 0), b2, voffB); PG8_STAGE(PG8_SB(0, 1), b2 + hstep, voffB); PG8_STAGE(PG8_SA(0, 0), a2, voffA);
            PG8_WAIT_V(8); PG8_WAIT_L(0); PG8_BAR; PG8_MMA(1, 0, At, B0); PG8_MMA(1, 1, At, B1); PG8_BAR; PG8_SCHED;
            PG8_LDB(B0, 1, 0); PG8_LDB(B1, 1, 1); PG8_SCHED; PG8_LDA(At, 1, 0); PG8_STAGE(PG8_SA(0, 1), a2 + hstep, voffA);
            PG8_WAIT_V(8); PG8_WAIT_L(0); PG8_BAR; PG8_MMA(0, 0, At, B0); PG8_MMA(0, 1, At, B1); PG8_BAR; PG8_SCHED;
            PG8_LDA(At, 1, 1); PG8_STAGE(PG8_SB(1, 0), b3, voffB); PG8_STAGE(PG8_SB(1, 1), b3 + hstep, voffB); PG8_STAGE(PG8_SA(1, 0), a3, voffA);
            PG8_WAIT_V(8); PG8_WAIT_L(0); PG8_BAR; PG8_MMA(1, 0, At, B0); PG8_MMA(1, 1, At, B1); PG8_BAR; PG8_SCHED;
            } else {
            PG8_LDB(B0, 0, 0); PG8_SCHED; PG8_LDA(At, 0, 0); PG8_STAGE(PG8_SA(1, 1), a1 + hstep, voffA);
            PG8_WAIT_L(8); PG8_BAR; PG8_WAIT_L(0); PG8_MMA(0, 0, At, B0); PG8_BAR; PG8_SCHED;
            PG8_LDB(B1, 0, 1); PG8_STAGE(PG8_SB(0, 0), b2, voffB);
            PG8_BAR; PG8_WAIT_L(0); PG8_MMA(0, 1, At, B1); PG8_BAR;
            PG8_LDA(At, 0, 1); PG8_STAGE(PG8_SA(0, 0), a2, voffA);
            PG8_BAR; PG8_WAIT_L(0); PG8_MMA(1, 0, At, B0); PG8_BAR; PG8_SCHED;
            PG8_STAGE(PG8_SB(0, 1), b2 + hstep, voffB);
            PG8_WAIT_V(6); PG8_BAR; PG8_MMA(1, 1, At, B1); PG8_BAR;
            PG8_LDB(B0, 1, 0); PG8_SCHED; PG8_LDA(At, 1, 0); PG8_STAGE(PG8_SA(0, 1), a2 + hstep, voffA);
            PG8_WAIT_L(8); PG8_BAR; PG8_WAIT_L(0); PG8_MMA(0, 0, At, B0); PG8_BAR; PG8_SCHED;
            PG8_LDB(B1, 1, 1); PG8_STAGE(PG8_SB(1, 0), b3, voffB);
            PG8_BAR; PG8_WAIT_L(0); PG8_MMA(0, 1, At, B1); PG8_BAR;
            PG8_LDA(At, 1, 1); PG8_STAGE(PG8_SA(1, 0), a3, voffA);
            PG8_BAR; PG8_WAIT_L(0); PG8_MMA(1, 0, At, B0); PG8_BAR; PG8_SCHED;
            PG8_STAGE(PG8_SB(1, 1), b3 + hstep, voffB);
            PG8_WAIT_V(6); PG8_BAR; PG8_MMA(1, 1, At, B1); PG8_BAR;
            }
        }
        if constexpr (ALIGN_EPI) { if (wr == 0) PG8_BAR; }
        if constexpr (!Epi::AFTER_DRAIN) { E(acc, cur, wr, wc, fr, fq); S.done(cur); }
        if (!has_next) break;
#pragma unroll
        for (int a = 0; a < 2; ++a)
#pragma unroll
            for (int b = 0; b < 2; ++b)
#pragma unroll
                for (int m = 0; m < 4; ++m)
#pragma unroll
                    for (int n = 0; n < 2; ++n) acc[a][b][m][n] = (f32x4){0.f, 0.f, 0.f, 0.f};
        cur = nxt; cA = nA; cB = nB; ++ui;
        if constexpr (ALIGN_EPI) { if (wr == 1) PG8_BAR; }
    }
    PG8_WAIT_V(0);
    if constexpr (!ALIGN_EPI) { if (wr == 0) PG8_BAR; }
    PG8_BAR;
    if constexpr (Epi::AFTER_DRAIN) { E.fused(acc, cur, wr, wc, fr, fq, lds, wid, lane); S.done(cur); }
#undef PG8_SA
#undef PG8_SB
#undef PG8_STAGE
#undef PG8_LDA
#undef PG8_LDB
#undef PG8_MMA
#undef PG8_WAIT_V
#undef PG8_WAIT_L
#undef PG8_BAR
#undef PG8_SCHED
}
}

__device__ __forceinline__ float gamma_log2(int h) { return log2f(1.f - exp2f(-5.f - (float)h)); }

__device__ __forceinline__ void phase_prologue(LAS unsigned char* lds, const float* const* in, unsigned char* ws) {
    const int tid = threadIdx.x, lane = tid & 63, wave = tid >> 6;
    const int gw = blockIdx.x * NWAVES + wave, NGW = gridDim.x * NWAVES;
    LAS float* scr = (LAS float*)(lds + wave * 16384);
    constexpr int I_ABIN = (D / 64) * (AB_IN / 32), I_SQ = (D / 64) * (D / 32), I_CIN = (D / 64) * (C_IN / 32), I_WQ = (D / 64) * (2048 / 32);
    constexpr int NITEMS = I_ABIN + I_SQ + I_CIN + I_SQ + 2 * I_WQ;
    for (int it = gw; it < NITEMS; it += NGW) {
        int r = it;
        if (r < I_ABIN) { p0_transpose_item(in[1], D, AB_IN, (bf16*)(ws + WS_WABIN), scr, r, lane); continue; } r -= I_ABIN;
        if (r < I_SQ) { p0_transpose_item(in[5], D, D, (bf16*)(ws + WS_WABOUT), scr, r, lane); continue; } r -= I_SQ;
        if (r < I_CIN) { p0_transpose_item(in[6], D, C_IN, (bf16*)(ws + WS_WCIN), scr, r, lane); continue; } r -= I_CIN;
        if (r < I_SQ) { p0_transpose_item(in[9], D, D, (bf16*)(ws + WS_WCOUT), scr, r, lane); continue; } r -= I_SQ;
        if (r < I_WQ) { p0_transpose_item(in[10], D, 2048, (bf16*)(ws + WS_WQ), scr, r, lane); continue; } r -= I_WQ;
        p0_transpose_item(in[10] + (size_t)D * 2048, D, 2048, (bf16*)(ws + WS_WQ) + (size_t)2048 * D, scr, r, lane);
    }
    const size_t gt = (size_t)blockIdx.x * NTHR + tid, NT = (size_t)gridDim.x * NTHR;
    { const float* x = in[0]; bf16* xb = (bf16*)(ws + WS_XB);
      for (size_t i = gt; i < (size_t)T * D / 8; i += NT) { const f32x4 a = *(const GAS f32x4*)(x + i * 8), b = *(const GAS f32x4*)(x + i * 8 + 4);
          v4u o; o.x = pk2(a.x, a.y); o.y = pk2(a.z, a.w); o.z = pk2(b.x, b.y); o.w = pk2(b.z, b.w); *(GAS v4u*)(xb + i * 8) = o; } }
    { const float* k = in[11]; bf16* kb = (bf16*)(ws + WS_KEYS);
      for (size_t i = gt; i < (size_t)2 * 8 * 2 * 128 * 128 / 8; i += NT) { const f32x4 a = *(const GAS f32x4*)(k + i * 8), b = *(const GAS f32x4*)(k + i * 8 + 4);
          v4u o; o.x = pk2(a.x, a.y); o.y = pk2(a.z, a.w); o.z = pk2(b.x, b.y); o.w = pk2(b.z, b.w); *(GAS v4u*)(kb + i * 8) = o; } }
    { float* ct = (float*)(ws + WS_ROPE); float* st = ct + 4096 * 32;
      for (size_t i = gt; i < (size_t)4096 * 32; i += NT) { const int pos = (int)(i >> 5), f = (int)(i & 31);
          const double inv = exp(-log(10000.0) * ((double)f / 31.0)); const double ang = (double)pos * inv;
          ct[i] = (float)cos(ang); st[i] = (float)sin(ang); } }
    { const float* l = in[7]; float* lb = (float*)(ws + WS_LB);
      for (size_t i = gt; i < 1024; i += NT) { const float a = l[i], b = l[1024 + i]; const float m = fmaxf(a, b); const float ea = expf(a - m), eb = expf(b - m); lb[i] = eb / (ea + eb); } }
}

__device__ __forceinline__ void phase_ret_local(LAS unsigned char* lds, unsigned char* ws) {
    const int tid = threadIdx.x;
    const bf16* H0 = (const bf16*)(ws + WS_H0); float* LST = (float*)(ws + WS_LST);
    const float* ct = (const float*)(ws + WS_ROPE); const float* st = ct + 4096 * 32;
    LAS float* kd = (LAS float*)lds;
    LAS float* vv = (LAS float*)(lds + 32768);
    for (int item = blockIdx.x; item < 1024; item += gridDim.x) {
        const int n = item & 31, h = (item >> 5) & 3, b = item >> 7;
        const size_t t0 = (size_t)b * SEQ + n * 128; const float lg = gamma_log2(h);
        for (int idx = tid; idx < 4096; idx += NTHR) { const int s = idx >> 5, i = idx & 31, pos = n * 128 + s;
            const bf16* row = H0 + (t0 + s) * AB_IN + 768 + h * 64;
            const float x1 = bf2f(row[i]), x2 = bf2f(row[i + 32]); const float c = ct[pos * 32 + i], sn = st[pos * 32 + i];
            const float dec = exp2f((float)(127 - s) * lg) * 0.125f;
            kd[s * 64 + i] = (x1 * c - x2 * sn) * dec; kd[s * 64 + i + 32] = (x2 * c + x1 * sn) * dec; }
        for (int idx = tid; idx < 16384; idx += NTHR) { const int s = idx >> 7, e = idx & 127; vv[idx] = bf2f(H0[(t0 + s) * AB_IN + 1024 + h * 128 + e]); }
        __syncthreads();
        const int e = tid & 127, dg = tid >> 7;
        float acc[16];
#pragma unroll
        for (int j = 0; j < 16; ++j) acc[j] = 0.f;
        for (int s = 0; s < 128; ++s) { const float v = vv[s * 128 + e];
#pragma unroll
            for (int j = 0; j < 16; ++j) acc[j] += kd[s * 64 + dg * 16 + j] * v; }
#pragma unroll
        for (int j = 0; j < 16; ++j) LST[(size_t)item * 8192 + (dg * 16 + j) * 128 + e] = acc[j];
        __syncthreads();
    }
}
__device__ __forceinline__ void phase_ret_prefix(unsigned char* ws) {
    float* LST = (float*)(ws + WS_LST);
    const size_t gt = (size_t)blockIdx.x * NTHR + threadIdx.x, NT = (size_t)gridDim.x * NTHR;
    for (size_t idx = gt; idx < (size_t)32 * 8192; idx += NT) { const int bh = (int)(idx >> 13), el = (int)(idx & 8191), h = bh & 3;
        const float g128 = exp2f(128.f * gamma_log2(h)); float S = 0.f;
        for (int n = 0; n < 32; ++n) { float* p = LST + ((size_t)(bh * 32 + n) * 8192 + el); const float tmp = *p; *p = S; S = S * g128 + tmp; } }
}
__device__ __forceinline__ void phase_ret_out_pool(LAS unsigned char* lds, const float* const* in, unsigned char* ws) {
    const int tid = threadIdx.x;
    const bf16* H0 = (const bf16*)(ws + WS_H0); const float* LST = (const float*)(ws + WS_LST); bf16* Y = (bf16*)(ws + WS_Y);
    const float* ct = (const float*)(ws + WS_ROPE); const float* st = ct + 4096 * 32;
    const float* pool_w = in[2]; const float* pool_scale = in[3]; const float* ret_g = in[4];
    LAS float* qs = (LAS float*)lds;
    LAS float* ks = qs + 128 * 65;
    LAS float* R2 = (LAS float*)(lds + 66560);
    LAS float* PA = (LAS float*)lds;
    LAS float* PB = (LAS float*)(lds + 66048);
    for (int item = blockIdx.x; item < 256; item += gridDim.x) {
        const int n = item & 31, b = item >> 5; const size_t t0 = (size_t)b * SEQ + n * 128;
        const int c = tid >> 2, eg = tid & 3;
        for (int h = 0; h < 4; ++h) {
            const float lg = gamma_log2(h);
            for (int idx = tid; idx < 4096; idx += NTHR) { const int s = idx >> 5, i = idx & 31, pos = n * 128 + s;
                const bf16* rq = H0 + (t0 + s) * AB_IN + 512 + h * 64; const bf16* rk = H0 + (t0 + s) * AB_IN + 768 + h * 64;
                const float cs = ct[pos * 32 + i], sn = st[pos * 32 + i];
                const float q1 = bf2f(rq[i]), q2 = bf2f(rq[i + 32]), k1 = bf2f(rk[i]), k2 = bf2f(rk[i + 32]);
                qs[s * 65 + i] = q1 * cs - q2 * sn; qs[s * 65 + i + 32] = q2 * cs + q1 * sn;
                ks[s * 65 + i] = (k1 * cs - k2 * sn) * 0.125f; ks[s * 65 + i + 32] = (k2 * cs + k1 * sn) * 0.125f; }
            { const float* Sg = LST + (size_t)((b * 4 + h) * 32 + n) * 8192;
              for (int idx = tid; idx < 8192; idx += NTHR) R2[idx] = Sg[idx]; }
            __syncthreads();
            float o[32];
#pragma unroll
            for (int j = 0; j < 32; ++j) o[j] = 0.f;
            for (int d = 0; d < 64; ++d) { const float qv = qs[c * 65 + d];
#pragma unroll
                for (int j = 0; j < 32; ++j) o[j] += qv * R2[d * 128 + eg * 32 + j]; }
            { const float qd = exp2f((float)(c + 1) * lg);
#pragma unroll
              for (int j = 0; j < 32; ++j) o[j] *= qd; }
            __syncthreads();
            for (int idx = tid; idx < 16384; idx += NTHR) { const int s = idx >> 7, e = idx & 127; R2[idx] = bf2f(H0[(t0 + s) * AB_IN + 1024 + h * 128 + e]); }
            __syncthreads();
            for (int s = 0; s <= c; ++s) {
                float dot = 0.f;
#pragma unroll 16
                for (int d = 0; d < 64; ++d) dot += qs[c * 65 + d] * ks[s * 65 + d];
                const float w = dot * exp2f((float)(c - s) * lg);
#pragma unroll
                for (int j = 0; j < 32; ++j) o[j] += w * R2[s * 128 + eg * 32 + j];
            }
            float sum = 0.f;
#pragma unroll
            for (int j = 0; j < 32; ++j) sum += o[j];
            sum += __shfl_xor(sum, 1); sum += __shfl_xor(sum, 2);
            const float mean = sum * (1.f / 128.f); float sq = 0.f;
#pragma unroll
            for (int j = 0; j < 32; ++j) { const float dl = o[j] - mean; sq += dl * dl; }
            sq += __shfl_xor(sq, 1); sq += __shfl_xor(sq, 2);
            const float rstd = 1.f / sqrtf(sq * (1.f / 128.f) + LN_EPS);
            { const bf16* rg = H0 + (t0 + c) * AB_IN + 1536 + h * 128 + eg * 32; bf16* yo = Y + (t0 + c) * D + 512 + h * 128 + eg * 32;
#pragma unroll
              for (int j = 0; j < 32; ++j) { const float g = bf2f(rg[j]); const float sg = g / (1.f + expf(-g));
                  yo[j] = (bf16)f2bf((o[j] - mean) * rstd * ret_g[h * 128 + eg * 32 + j] * sg); } }
            __syncthreads();
        }
        for (int gi = 0; gi < 4; ++gi) {
            const int w = 2 << gi;
            for (int idx = tid; idx < 16384; idx += NTHR) { const int s = idx >> 7, cc = idx & 127, pos = n * 128 + s; const int cnt = (pos + 1 < w) ? pos + 1 : w;
                float sum = 0.f; for (int j = 0; j < cnt; ++j) sum += bf2f(H0[(t0 + s - j) * AB_IN + gi * 128 + cc]);
                PA[s * 129 + cc] = sum / (float)cnt - bf2f(H0[(t0 + s) * AB_IN + gi * 128 + cc]); }
            for (int idx = tid; idx < 16384; idx += NTHR) PB[idx] = pool_w[gi * 16384 + idx];
            __syncthreads();
            float o[32];
#pragma unroll
            for (int j = 0; j < 32; ++j) o[j] = 0.f;
            for (int cc = 0; cc < 128; ++cc) { const float pv = PA[c * 129 + cc];
#pragma unroll
                for (int j = 0; j < 32; ++j) o[j] += pv * PB[cc * 128 + eg * 32 + j]; }
            { bf16* yo = Y + (t0 + c) * D + gi * 128 + eg * 32;
#pragma unroll
              for (int j = 0; j < 32; ++j) yo[j] = (bf16)f2bf(o[j] * pool_scale[gi * 128 + eg * 32 + j]); }
            __syncthreads();
        }
    }
}
__device__ __forceinline__ void phase_ln(const float* Z, bf16* O, const float* g, const float* bb) {
    const int tid = threadIdx.x, lane = tid & 63, wave = tid >> 6;
    const int gw = blockIdx.x * NWAVES + wave, NGW = gridDim.x * NWAVES;
    for (int m = gw; m < T; m += NGW) {
        const GAS f32x4* zr = (const GAS f32x4*)(Z + (size_t)m * D) + lane;
        f32x4 v[4]; float s = 0.f;
#pragma unroll
        for (int j = 0; j < 4; ++j) { v[j] = zr[64 * j]; s += (v[j].x + v[j].y) + (v[j].z + v[j].w); }
        const float mean = wave_sum(s) * (1.f / D); float s2 = 0.f;
#pragma unroll
        for (int j = 0; j < 4; ++j) { v[j] = v[j] - mean; s2 += (v[j].x * v[j].x + v[j].y * v[j].y) + (v[j].z * v[j].z + v[j].w * v[j].w); }
        const float rstd = 1.f / sqrtf(wave_sum(s2) * (1.f / D) + LN_EPS);
        GAS v2u* o8 = (GAS v2u*)(O + (size_t)m * D) + lane;
#pragma unroll
        for (int j = 0; j < 4; ++j) { const f32x4 gg = *((const GAS f32x4*)g + lane + 64 * j), b4 = *((const GAS f32x4*)bb + lane + 64 * j);
            v2u o; o.x = pk2(v[j].x * rstd * gg.x + b4.x, v[j].y * rstd * gg.y + b4.y); o.y = pk2(v[j].z * rstd * gg.z + b4.z, v[j].w * rstd * gg.w + b4.w); o8[64 * j] = o; }
    }
}
__device__ __forceinline__ void wave_argmax(float& bv, int& bi) {
#pragma unroll
    for (int off = 32; off >= 1; off >>= 1) { const float ov = __shfl_xor(bv, off); const int oi = __shfl_xor(bi, off);
        if (ov > bv || (ov == bv && oi < bi)) { bv = ov; bi = oi; } }
}
__device__ __forceinline__ void phase_topk(LAS unsigned char* lds, const bf16* Q, const float* keys  , int* EID, float* GATE) {
    const int tid = threadIdx.x, lane = tid & 63, wave = tid >> 6;
    LAS float* kl = (LAS float*)lds;
    LAS float* qt = (LAS float*)(lds + 66048);
    LAS float* sc = (LAS float*)(lds + 82560);
    for (int item = blockIdx.x; item < (T / 32) * 8; item += gridDim.x) {
        const int h = item & 7, tile = item >> 3; const size_t tok0 = (size_t)tile * 32;
        for (int p = 0; p < 2; ++p) {
            const float* kg = keys + (size_t)((h * 2 + p) * 128) * 128;
            for (int idx = tid; idx < 16384; idx += NTHR) { const int k = idx >> 7, d = idx & 127; kl[k * 129 + d] = kg[idx]; }
            for (int idx = tid; idx < 4096; idx += NTHR) { const int t = idx >> 7, d = idx & 127; qt[t * 129 + d] = bf2f(Q[(tok0 + t) * 2048 + h * 256 + p * 128 + d]); }
            __syncthreads();
            { const int t = tid >> 4, kg16 = tid & 15;
              for (int jj = 0; jj < 8; ++jj) { const int k = kg16 + 16 * jj; float dot = 0.f;
#pragma unroll 16
                  for (int d = 0; d < 128; ++d) dot += qt[t * 129 + d] * kl[k * 129 + d];
                  sc[(t * 2 + p) * 128 + k] = dot; } }
            __syncthreads();
        }
        for (int tt = 0; tt < 4; ++tt) {
            const int t = wave * 4 + tt;
            float tv[2]; int ti[2];
#pragma unroll
            for (int p = 0; p < 2; ++p) {
                float v0 = sc[(t * 2 + p) * 128 + lane], v1 = sc[(t * 2 + p) * 128 + lane + 64];
                float mv = 0.f; int mi = 0;
                for (int j = 0; j < 16; ++j) {
                    float bv; int bi; if (v0 >= v1) { bv = v0; bi = lane; } else { bv = v1; bi = lane + 64; }
                    wave_argmax(bv, bi);
                    if (lane == j) { mv = bv; mi = bi; }
                    if (bi == lane) v0 = -INFINITY; if (bi == lane + 64) v1 = -INFINITY;
                }
                tv[p] = mv; ti[p] = mi;
            }
            float cv[4];
#pragma unroll
            for (int m = 0; m < 4; ++m) { const int cidx = lane + 64 * m; cv[m] = __shfl(tv[0], cidx >> 4) + __shfl(tv[1], cidx & 15); }
            float bestv = 0.f; int bestc = 0;
            for (int j = 0; j < 16; ++j) {
                float bv = cv[0]; int bi = lane;
#pragma unroll
                for (int m = 1; m < 4; ++m) if (cv[m] > bv) { bv = cv[m]; bi = lane + 64 * m; }
                wave_argmax(bv, bi);
                if (lane == j) { bestv = bv; bestc = bi; }
#pragma unroll
                for (int m = 0; m < 4; ++m) if (bi == lane + 64 * m) cv[m] = -INFINITY;
            }
            const float mx = __shfl(bestv, 0);
            const float ex = (lane < 16) ? expf(bestv - mx) : 0.f;
            const float den = wave_sum(ex);
            const int ia = __shfl(ti[0], bestc >> 4), ib = __shfl(ti[1], bestc & 15);
            if (lane < 16) { const size_t o = (tok0 + t) * 128 + h * 16 + lane; EID[o] = ia * 128 + ib; GATE[o] = ex / den; }
        }
        __syncthreads();
    }
}
template <bool FINAL>
__device__ __forceinline__ void phase_gather(const bf16* X, const int* EID, const float* GATE, const float* U, const float* V, const float* g, const float* bb, bf16* Ob, float* Of) {
    const int tid = threadIdx.x, lane = tid & 63, wave = tid >> 6;
    const int gw = blockIdx.x * NWAVES + wave, NGW = gridDim.x * NWAVES;
    for (int t = gw; t < T; t += NGW) {
        f32x4 x[4], acc[4];
#pragma unroll
        for (int j = 0; j < 4; ++j) { const v2u w = *((const GAS v2u*)(X + (size_t)t * D) + lane + 64 * j);
            x[j] = (f32x4){bflo(w.x), bfhi(w.x), bflo(w.y), bfhi(w.y)}; acc[j] = (f32x4){0.f, 0.f, 0.f, 0.f}; }
        const int e0 = EID[(size_t)t * 128 + lane], e1 = EID[(size_t)t * 128 + 64 + lane];
        const float g0 = GATE[(size_t)t * 128 + lane], g1 = GATE[(size_t)t * 128 + 64 + lane];
#pragma unroll 2
        for (int k = 0; k < 128; ++k) {
            const int e = (k < 64) ? __shfl(e0, k) : __shfl(e1, k - 64);
            const float gt = (k < 64) ? __shfl(g0, k) : __shfl(g1, k - 64);
            const GAS f32x4* ur = (const GAS f32x4*)(U + (size_t)e * D) + lane;
            float dot = 0.f;
#pragma unroll
            for (int j = 0; j < 4; ++j) { const f32x4 u = ur[64 * j]; dot += (x[j].x * u.x + x[j].y * u.y) + (x[j].z * u.z + x[j].w * u.w); }
            dot = wave_sum(dot);
            const float a = 0.5f * dot * (1.f + erff(dot * 0.70710678118654752f));
            const float cf = gt * a;
            const GAS f32x4* vr = (const GAS f32x4*)(V + (size_t)e * D) + lane;
#pragma unroll
            for (int j = 0; j < 4; ++j) { const f32x4 v = vr[64 * j]; acc[j] += cf * v; }
        }
        float s = 0.f;
#pragma unroll
        for (int j = 0; j < 4; ++j) { acc[j] = ALPHA * x[j] + acc[j]; s += (acc[j].x + acc[j].y) + (acc[j].z + acc[j].w); }
        const float mean = wave_sum(s) * (1.f / D); float s2 = 0.f;
#pragma unroll
        for (int j = 0; j < 4; ++j) { acc[j] = acc[j] - mean; s2 += (acc[j].x * acc[j].x + acc[j].y * acc[j].y) + (acc[j].z * acc[j].z + acc[j].w * acc[j].w); }
        const float rstd = 1.f / sqrtf(wave_sum(s2) * (1.f / D) + LN_EPS);
#pragma unroll
        for (int j = 0; j < 4; ++j) { const f32x4 gg = *((const GAS f32x4*)g + lane + 64 * j), b4 = *((const GAS f32x4*)bb + lane + 64 * j);
            const f32x4 o = acc[j] * rstd * gg + b4;
            if (FINAL) *((GAS f32x4*)(Of + (size_t)t * D) + lane + 64 * j) = o;
            else { v2u w; w.x = pk2(o.x, o.y); w.y = pk2(o.z, o.w); *((GAS v2u*)(Ob + (size_t)t * D) + lane + 64 * j) = w; } }
    }
}
__device__ __forceinline__ void phase_hgrn(LAS unsigned char* lds, unsigned char* ws) {
    const int tid = threadIdx.x;
    const bf16* CQ = (const bf16*)(ws + WS_CQ); const bf16* CK = (const bf16*)(ws + WS_CK); const bf16* CV = (const bf16*)(ws + WS_CV); bf16* O = (bf16*)(ws + WS_O);
    LAS float* fL = (LAS float*)lds;
    LAS float* kL = fL + 4096; LAS float* qL = kL + 4096;
    LAS float* vL = qL + 4096;
    LAS float* part = vL + 1024;
    for (int item = blockIdx.x; item < 256; item += gridDim.x) {
        const int es = item & 3, h = (item >> 2) & 7, b = item >> 5;
        const int e = tid & 31, dg = tid >> 5;
        float S[8];
#pragma unroll
        for (int j = 0; j < 8; ++j) S[j] = 0.f;
        for (int blk = 0; blk < SEQ / 32; ++blk) {
            const size_t t0 = (size_t)b * SEQ + blk * 32;
            for (int idx = tid; idx < 4096; idx += NTHR) { const int s = idx >> 7, d = idx & 127; const size_t o = (t0 + s) * D + h * 128 + d;
                const float kk = bf2f(CK[o]); kL[idx] = kk; fL[idx] = 1.f - kk; qL[idx] = bf2f(CQ[o]); }
            for (int idx = tid; idx < 1024; idx += NTHR) { const int s = idx >> 5, ee = idx & 31; vL[idx] = bf2f(CV[(t0 + s) * D + h * 128 + es * 32 + ee]); }
            __syncthreads();
            for (int s = 0; s < 32; ++s) { const float v = vL[s * 32 + e]; float po = 0.f;
#pragma unroll
                for (int j = 0; j < 8; ++j) { const int d = dg * 8 + j; S[j] = fL[s * 128 + d] * S[j] + kL[s * 128 + d] * v; po += qL[s * 128 + d] * S[j]; }
                part[(s * 16 + dg) * 32 + e] = po; }
            __syncthreads();
            for (int idx = tid; idx < 1024; idx += NTHR) { const int s = idx >> 5, ee = idx & 31; float o = 0.f;
#pragma unroll
                for (int g = 0; g < 16; ++g) o += part[(s * 16 + g) * 32 + ee];
                O[(t0 + s) * D + h * 128 + es * 32 + ee] = (bf16)f2bf(o); }
            __syncthreads();
        }
    }
}
__device__ __forceinline__ void phase_hgrn_norm(const float* norm_g, unsigned char* ws) {
    const int tid = threadIdx.x, lane = tid & 63, wave = tid >> 6;
    const int gw = blockIdx.x * NWAVES + wave, NGW = gridDim.x * NWAVES;
    const bf16* O = (const bf16*)(ws + WS_O); const bf16* CG = (const bf16*)(ws + WS_CG); bf16* Y2 = (bf16*)(ws + WS_Y2);
    for (int t = gw; t < T; t += NGW) {
        const v4u a0 = *((const GAS v4u*)(O + (size_t)t * D) + lane * 2), a1 = *((const GAS v4u*)(O + (size_t)t * D) + lane * 2 + 1);
        const v4u g0 = *((const GAS v4u*)(CG + (size_t)t * D) + lane * 2), g1 = *((const GAS v4u*)(CG + (size_t)t * D) + lane * 2 + 1);
        float o[16], gv[16];
        o[0] = bflo(a0.x); o[1] = bfhi(a0.x); o[2] = bflo(a0.y); o[3] = bfhi(a0.y); o[4] = bflo(a0.z); o[5] = bfhi(a0.z); o[6] = bflo(a0.w); o[7] = bfhi(a0.w);
        o[8] = bflo(a1.x); o[9] = bfhi(a1.x); o[10] = bflo(a1.y); o[11] = bfhi(a1.y); o[12] = bflo(a1.z); o[13] = bfhi(a1.z); o[14] = bflo(a1.w); o[15] = bfhi(a1.w);
        gv[0] = bflo(g0.x); gv[1] = bfhi(g0.x); gv[2] = bflo(g0.y); gv[3] = bfhi(g0.y); gv[4] = bflo(g0.z); gv[5] = bfhi(g0.z); gv[6] = bflo(g0.w); gv[7] = bfhi(g0.w);
        gv[8] = bflo(g1.x); gv[9] = bfhi(g1.x); gv[10] = bflo(g1.y); gv[11] = bfhi(g1.y); gv[12] = bflo(g1.z); gv[13] = bfhi(g1.z); gv[14] = bflo(g1.w); gv[15] = bfhi(g1.w);
        float sq = 0.f;
#pragma unroll
        for (int j = 0; j < 16; ++j) sq += o[j] * o[j];
        sq += __shfl_xor(sq, 1); sq += __shfl_xor(sq, 2); sq += __shfl_xor(sq, 4);
        const float r = 1.f / sqrtf(sq * (1.f / 128.f) + LN_EPS);
        float y[16];
#pragma unroll
        for (int j = 0; j < 16; ++j) { const float sg = gv[j] / (1.f + expf(-gv[j])); y[j] = o[j] * r * norm_g[lane * 16 + j] * sg; }
        v4u w0, w1; w0.x = pk2(y[0], y[1]); w0.y = pk2(y[2], y[3]); w0.z = pk2(y[4], y[5]); w0.w = pk2(y[6], y[7]);
        w1.x = pk2(y[8], y[9]); w1.y = pk2(y[10], y[11]); w1.z = pk2(y[12], y[13]); w1.w = pk2(y[14], y[15]);
        *((GAS v4u*)(Y2 + (size_t)t * D) + lane * 2) = w0; *((GAS v4u*)(Y2 + (size_t)t * D) + lane * 2 + 1) = w1;
    }
}

struct Args { const float* in[16]; float* out; unsigned char* ws; int ph_lo, ph_hi, li, pad; };
__global__ void __launch_bounds__(NTHR, 2) mk_fwd(Args args) {
    extern __shared__ __attribute__((aligned(16))) unsigned char lds_raw[];
    LAS unsigned char* lds = (LAS unsigned char*)lds_raw;
    volatile LAS unsigned* MISC = (volatile LAS unsigned*)(lds + MISC_OFF);
    const int tid = threadIdx.x;
    unsigned char* ws = args.ws;
    gu32* ctl = (gu32*)(ws + WS_CTL);
    if (tid < 32) ((LAS unsigned*)(lds + MISC_OFF))[tid] = 0u;
    __syncthreads();
    XcdBarrier bar; bar.bar = (unsigned*)ctl + CW_BAR; bar.x = 0; bar.st = nullptr;
    if (N_LAUNCHES == 1) bar = xcd_barrier_post((unsigned*)ctl + CW_BAR, MISC + 8);
    const int lo = args.ph_lo, hi = args.ph_hi;
#define IN(k) (lo <= (k) && (k) < hi)
#define SEAM(k) do { if (IN(k) && IN((k) + 1)) xcd_barrier(bar); } while (0)
    const float* const* in = args.in;
    bf16* XB = (bf16*)(ws + WS_XB); bf16* H0 = (bf16*)(ws + WS_H0); bf16* Y = (bf16*)(ws + WS_Y); bf16* H1 = (bf16*)(ws + WS_H1);
    int* EID = (int*)(ws + WS_EID); float* GATE = (float*)(ws + WS_GATE);
    float* Z = args.out;

    if (IN(0)) { phase_prologue(lds, in, ws); } SEAM(0);
    if (IN(1)) { pg8::Gemm g{XB, (const bf16*)(ws + WS_WABIN), T, AB_IN, D}; pg8::StaticOrder S; S.init(T, AB_IN, (int)gridDim.x, (int)blockIdx.x); pg8::EpiBf16<0> E{H0, AB_IN, nullptr, 0, 0, 1.f};
                 pg8::gemm_phase<pg8::EpiBf16<0>, pg8::StaticOrder, true, true>(lds, g, S, E); } SEAM(1);
    if (IN(2)) { phase_ret_local(lds, ws); } SEAM(2);
    if (IN(3)) { phase_ret_prefix(ws); } SEAM(3);
    if (IN(4)) { phase_ret_out_pool(lds, in, ws); } SEAM(4);
    if (IN(5)) { pg8::Gemm g{Y, (const bf16*)(ws + WS_WABOUT), T, D, D}; pg8::StaticOrder S; S.init(T, D, (int)gridDim.x, (int)blockIdx.x); pg8::EpiResidF32 E{XB, Z};
                 pg8::gemm_phase<pg8::EpiResidF32, pg8::StaticOrder, true, true>(lds, g, S, E); } SEAM(5);
    if (IN(6)) { phase_ln(Z, H1, in[14], in[15]); } SEAM(6);
    if (IN(7)) { pg8::Gemm g{H1, (const bf16*)(ws + WS_WQ), T, 2048, D}; pg8::StaticOrder S; S.init(T, 2048, (int)gridDim.x, (int)blockIdx.x); pg8::EpiBf16<0> E{H0  , 2048, nullptr, 0, 0, 1.f};
                 pg8::gemm_phase<pg8::EpiBf16<0>, pg8::StaticOrder, true, true>(lds, g, S, E); } SEAM(7);
    if (IN(8)) { phase_topk(lds, H0, in[11], EID, GATE); } SEAM(8);
    if (IN(9)) { phase_gather<false>(H1, EID, GATE, in[12], in[13], in[14] + D, in[15] + D, XB  , nullptr); } SEAM(9);
    if (IN(10)) { EpiCIn E{(bf16*)(ws + WS_CQ), (bf16*)(ws + WS_CK), (bf16*)(ws + WS_CV), (bf16*)(ws + WS_CG), (const float*)(ws + WS_LB)};
                  (void)E; pg8::Gemm g{XB, (const bf16*)(ws + WS_WCIN), T, C_IN, D}; pg8::StaticOrder S; S.init(T, C_IN, (int)gridDim.x, (int)blockIdx.x);
                  pg8::EpiCInF E2{(bf16*)(ws + WS_CQ), (bf16*)(ws + WS_CK), (bf16*)(ws + WS_CV), (bf16*)(ws + WS_CG), (const float*)(ws + WS_LB)};
                  pg8::gemm_phase<pg8::EpiCInF, pg8::StaticOrder, true, true>(lds, g, S, E2); } SEAM(10);
    if (IN(11)) { phase_hgrn(lds, ws); } SEAM(11);
    if (IN(12)) { phase_hgrn_norm(in[8], ws); } SEAM(12);
    if (IN(13)) { pg8::Gemm g{(const bf16*)(ws + WS_Y2), (const bf16*)(ws + WS_WCOUT), T, D, D}; pg8::StaticOrder S; S.init(T, D, (int)gridDim.x, (int)blockIdx.x); pg8::EpiResidF32 E{XB, Z};
                  pg8::gemm_phase<pg8::EpiResidF32, pg8::StaticOrder, true, true>(lds, g, S, E); } SEAM(13);
    if (IN(14)) { phase_ln(Z, H1  , in[14] + 2 * D, in[15] + 2 * D); } SEAM(14);
    if (IN(15)) { pg8::Gemm g{H1, (const bf16*)(ws + WS_WQ) + (size_t)2048 * D, T, 2048, D}; pg8::StaticOrder S; S.init(T, 2048, (int)gridDim.x, (int)blockIdx.x); pg8::EpiBf16<0> E{(bf16*)(ws + WS_Q1), 2048, nullptr, 0, 0, 1.f};
                  pg8::gemm_phase<pg8::EpiBf16<0>, pg8::StaticOrder, true, true>(lds, g, S, E); } SEAM(15);
    if (IN(16)) { phase_topk(lds, (const bf16*)(ws + WS_Q1), in[11] + (size_t)8 * 2 * 128 * 128, EID, GATE); } SEAM(16);
    if (IN(17)) { phase_gather<true>(H1, EID, GATE, in[12] + (size_t)NEXP * D, in[13] + (size_t)NEXP * D, in[14] + 3 * D, in[15] + 3 * D, nullptr, args.out); }
#undef IN
#undef SEAM
}

extern "C" void kernel_launch(void* const* d_in, const int* in_sizes, int n_in, void* d_out, int out_size, void* d_ws, size_t ws_size, hipStream_t stream) {
    static int grid = 0;
    if (grid == 0) {
        if (n_in != 16 || in_sizes[0] != T * D || out_size != T * D || ws_size < WS_END) { fprintf(stderr, "kernel_launch: unexpected problem (n_in %d, in0 %d, out %d, ws %zu); nothing launched\n", n_in, n_in > 0 ? in_sizes[0] : -1, out_size, ws_size); grid = -1; return; }
        int dev = 0, cus = 0;
        if (hipGetDevice(&dev) != hipSuccess || hipDeviceGetAttribute(&cus, hipDeviceAttributeMultiprocessorCount, dev) != hipSuccess) { grid = -1; return; }
        if (hipFuncSetAttribute((const void*)mk_fwd, hipFuncAttributeMaxDynamicSharedMemorySize, LDS_BYTES) != hipSuccess) { fprintf(stderr, "kernel_launch: hipFuncSetAttribute failed\n"); grid = -1; return; }
        (void)hipGetLastError();
        grid = cus;
    }
    if (grid < 0) return;
    if (hipMemsetAsync((char*)d_ws + WS_CTL, 0, CTL_ZERO_BYTES, stream) != hipSuccess) return;
    Args a{};
    for (int i = 0; i < 16; ++i) a.in[i] = (const float*)d_in[i];
    a.out = (float*)d_out; a.ws = (unsigned char*)d_ws;
    for (int li = 0; li < N_LAUNCHES; ++li) {
        a.ph_lo = (N_LAUNCHES == 1) ? 0 : li; a.ph_hi = (N_LAUNCHES == 1) ? NPHASE : li + 1; a.li = li;
        hipLaunchKernelGGL(mk_fwd, dim3(grid), dim3(NTHR), LDS_BYTES, stream, a);
        if (hipPeekAtLastError() != hipSuccess) { fprintf(stderr, "kernel_launch: launch %d failed\n", li); break; }
    }
}
```

```cpp
#include <hip/hip_runtime.h>
#include <cstdio>
#include <cstdint>

#ifndef MK_N_LAUNCHES
#define MK_N_LAUNCHES 1
#endif
constexpr int NPHASE = 18;
constexpr int N_LAUNCHES = MK_N_LAUNCHES;

constexpr int BATCH = 8, SEQ = 4096, D = 1024, T = BATCH * SEQ;
constexpr int AB_IN = 2048, C_IN = 4096, NEXP = 16384;
constexpr float LN_EPS = 1e-5f;
constexpr float ALPHA = 1.41421356237309515f;
constexpr int NWAVES = 8, NTHR = 512;

constexpr size_t MiB = 1u << 20;
constexpr size_t WS_CTL = 0, CTL_ZERO_BYTES = 1 * MiB;
constexpr size_t WS_LB = 1 * MiB;
constexpr size_t WS_ROPE = 2 * MiB;
constexpr size_t WS_WABIN = 4 * MiB;
constexpr size_t WS_WABOUT = 8 * MiB;
constexpr size_t WS_WCIN = 10 * MiB;
constexpr size_t WS_WCOUT = 18 * MiB;
constexpr size_t WS_WQ = 20 * MiB;
constexpr size_t WS_KEYS = 28 * MiB;
constexpr size_t WS_DQU = 29 * MiB;
constexpr size_t WS_DQV = 29 * MiB + 131072;
constexpr size_t WS_U8 = 32 * MiB;
constexpr size_t WS_V8 = 64 * MiB;
constexpr size_t WS_XB = 96 * MiB;
constexpr size_t WS_H0 = 160 * MiB;
constexpr size_t WS_LST = 288 * MiB;
constexpr size_t WS_Y = 320 * MiB;
constexpr size_t WS_H1 = 384 * MiB;
constexpr size_t WS_EID = 448 * MiB;
constexpr size_t WS_GATE = 464 * MiB;
constexpr size_t WS_CQ = 160 * MiB, WS_CK = 224 * MiB, WS_CV = 288 * MiB, WS_CG = 352 * MiB;
constexpr size_t WS_O = 416 * MiB;
constexpr size_t WS_Y2 = 160 * MiB;
constexpr size_t WS_Q1 = 224 * MiB;
constexpr size_t WS_END = 480 * MiB;

constexpr int CW_BAR = 4096;
constexpr int LDS_BYTES = 147456;
constexpr int MISC_OFF = LDS_BYTES - 128;

#define GAS __attribute__((address_space(1)))
#define LAS __attribute__((address_space(3)))
typedef unsigned short bf16;
typedef unsigned v4u __attribute__((ext_vector_type(4)));
typedef unsigned v2u __attribute__((ext_vector_type(2)));
typedef float f32x4 __attribute__((ext_vector_type(4)));
typedef GAS unsigned gu32;
#define RLX_AGENT __ATOMIC_RELAXED, __HIP_MEMORY_SCOPE_AGENT
#define LDS_WAIT() asm volatile("s_waitcnt lgkmcnt(0)" ::: "memory")
__device__ __forceinline__ unsigned f2bf(float f) { unsigned u = __builtin_bit_cast(unsigned, f); return (u + 0x7fffu + ((u >> 16) & 1u)) >> 16; }
__device__ __forceinline__ unsigned pk2(float lo, float hi) { return f2bf(lo) | (f2bf(hi) << 16); }
__device__ __forceinline__ float bf2f(unsigned b) { return __builtin_bit_cast(float, b << 16); }
__device__ __forceinline__ float bflo(unsigned w) { return __builtin_bit_cast(float, w << 16); }
__device__ __forceinline__ float bfhi(unsigned w) { return __builtin_bit_cast(float, w & 0xffff0000u); }
__device__ __forceinline__ float wave_sum(float v) {
#pragma unroll
    for (int o = 1; o < 64; o <<= 1) v += __shfl_xor(v, o);
    return v;
}

#define XB_TMO      128
#define XB_XCNT(j)  (256  + 64 * (j))
#define XB_XSUB(j)  (1280 + 64 * (j))
#define XB_XGEN(j)  (2304 + 64 * (j))
#define XB_TOP      3328
#define XB_TOPGEN   3392
#define XCD_BAR_WORDS 3456
#define XB_SPIN_CAP (1u << 21)
__device__ __forceinline__ unsigned xb_ld(unsigned* p)              { return __hip_atomic_load(p, __ATOMIC_RELAXED, __HIP_MEMORY_SCOPE_AGENT); }
__device__ __forceinline__ unsigned xb_add(unsigned* p, unsigned v) { return __hip_atomic_fetch_add(p, v, __ATOMIC_RELAXED, __HIP_MEMORY_SCOPE_AGENT); }
__device__ __forceinline__ unsigned xb_xcc_id() { return (unsigned)__builtin_amdgcn_s_getreg((3 << 11) | 20) & 0xFu; }
#define XB_SPIN(cond, bar) do { unsigned _sp = 0; while (cond) { __builtin_amdgcn_s_sleep(1); \
    if ((++_sp & 255u) == 0u) { if (xb_ld(&(bar)[XB_TMO])) break; if (_sp > XB_SPIN_CAP) { atomicAdd(&(bar)[XB_TMO], 1u); break; } } } } while (0)
struct XcdBarrier { unsigned* bar; unsigned x; volatile LAS unsigned* st; };
__device__ __forceinline__ XcdBarrier xcd_barrier_post(unsigned* bar, volatile LAS unsigned* st) {
    XcdBarrier b; b.bar = bar; b.x = xb_xcc_id(); b.st = st;
    if (threadIdx.x == 0) (void)xb_add(&bar[XB_XCNT(b.x)], 1u);
    return b;
}
__device__ __forceinline__ void xcd_barrier_complete(unsigned* bar, unsigned x, unsigned& nloc, unsigned& nx) {
    const unsigned G = gridDim.x * gridDim.y * gridDim.z;
    unsigned sum, cnt, mine, sp = 0u;
    for (;;) {
        sum = 0u; cnt = 0u; mine = 0u;
#pragma unroll
        for (unsigned j = 0; j < 16; ++j) { const unsigned c = xb_ld(&bar[XB_XCNT(j)]); sum += c; cnt += (c > 0u) ? 1u : 0u; mine = (j == x) ? c : mine; }
        if (sum == G) break;
        __builtin_amdgcn_s_sleep(1);
        if ((++sp & 255u) == 0u) { if (xb_ld(&bar[XB_TMO])) break; if (sp > XB_SPIN_CAP) { atomicAdd(&bar[XB_TMO], 1u); break; } }
    }
    nloc = mine > 0u ? mine : 1u; nx = cnt > 0u ? cnt : 1u;
}
__device__ __forceinline__ void xcd_barrier(const XcdBarrier& b) {
    asm volatile("s_waitcnt vmcnt(0)" ::: "memory");
    __syncthreads();
    if (threadIdx.x == 0) {
        unsigned* bar = b.bar;
        __builtin_amdgcn_s_waitcnt(0);
        unsigned nloc = b.st[0], nx = b.st[1];
        if (nloc == 0u) { xcd_barrier_complete(bar, b.x, nloc, nx); b.st[0] = nloc; b.st[1] = nx; }
        const unsigned old = xb_add(&bar[XB_XSUB(b.x)], 1u);
        const unsigned gen = old / nloc;
        if (old + 1u == (gen + 1u) * nloc) {
            __builtin_amdgcn_fence(__ATOMIC_RELEASE, "agent");
            asm volatile("s_waitcnt vmcnt(0)" ::: "memory");
            const unsigned og = xb_add(&bar[XB_TOP], 1u);
            const unsigned tg = og / nx;
            if (og + 1u == (tg + 1u) * nx) xb_add(&bar[XB_TOPGEN], 1u);
            else XB_SPIN(xb_ld(&bar[XB_TOPGEN]) == tg, bar);
            __builtin_amdgcn_fence(__ATOMIC_ACQUIRE, "agent");
            xb_add(&bar[XB_XGEN(b.x)], 1u);
            asm volatile("s_waitcnt vmcnt(0)" ::: "memory");
        } else {
            XB_SPIN(xb_ld(&bar[XB_XGEN(b.x)]) == gen, bar);
            __builtin_amdgcn_fence(__ATOMIC_ACQUIRE, "agent");
            asm volatile("s_waitcnt vmcnt(0)" ::: "memory");
        }
    }
    __syncthreads();
}

__device__ __forceinline__ void p0_transpose_item(const float* W, int K, int N, bf16* WT, LAS float* scr, int item, int lane) {
    const int nblk = N / 32, kb = item / nblk, nb = item % nblk, k0 = 64 * kb, n0 = 32 * nb;
#pragma unroll 8
    for (int i = 0; i < 32; ++i) { const int kk = 2 * i + (lane >> 5); scr[kk * 33 + (lane & 31)] = W[(size_t)(k0 + kk) * N + n0 + (lane & 31)]; }
    LDS_WAIT(); asm volatile("" ::: "memory");
    const int c = lane & 7;
#pragma unroll
    for (int j = 0; j < 4; ++j) { const int n = (lane >> 3) + 8 * j; const LAS float* s = scr + (8 * c) * 33 + n;
        v4u o; o.x = pk2(s[0 * 33], s[1 * 33]); o.y = pk2(s[2 * 33], s[3 * 33]); o.z = pk2(s[4 * 33], s[5 * 33]); o.w = pk2(s[6 * 33], s[7 * 33]);
        *(GAS v4u*)(WT + (size_t)(n0 + n) * K + k0 + 8 * c) = o; }
    LDS_WAIT(); asm volatile("" ::: "memory");
}

template <class Epi>
__device__ __forceinline__ void gemm_naive(LAS unsigned char* lds, const bf16* A, const bf16* Bt, int M, int N, int K, const Epi& E) {
    LAS float* As = (LAS float*)lds;
    LAS float* Bs = As + 128 * 33;
    const int tid = threadIdx.x, tx = tid & 15, ty = tid >> 4;
    const int ntn = N / 128, ntiles = (M / 128) * ntn;
    for (int tile = blockIdx.x; tile < ntiles; tile += gridDim.x) {
        const int tm = tile / ntn, tn = tile % ntn;
        float acc[4][8];
#pragma unroll
        for (int i = 0; i < 4; ++i)
#pragma unroll
            for (int j = 0; j < 8; ++j) acc[i][j] = 0.f;
        for (int k0 = 0; k0 < K; k0 += 32) {
            { const int r = tid >> 2, kc = (tid & 3) * 8;
              const v4u va = *(const GAS v4u*)(A + (size_t)(tm * 128 + r) * K + k0 + kc);
              const v4u vb = *(const GAS v4u*)(Bt + (size_t)(tn * 128 + r) * K + k0 + kc);
              LAS float* pa = As + r * 33 + kc; LAS float* pb = Bs + r * 33 + kc;
              pa[0] = bflo(va.x); pa[1] = bfhi(va.x); pa[2] = bflo(va.y); pa[3] = bfhi(va.y); pa[4] = bflo(va.z); pa[5] = bfhi(va.z); pa[6] = bflo(va.w); pa[7] = bfhi(va.w);
              pb[0] = bflo(vb.x); pb[1] = bfhi(vb.x); pb[2] = bflo(vb.y); pb[3] = bfhi(vb.y); pb[4] = bflo(vb.z); pb[5] = bfhi(vb.z); pb[6] = bflo(vb.w); pb[7] = bfhi(vb.w); }
            __syncthreads();
#pragma unroll 8
            for (int kk = 0; kk < 32; ++kk) {
                float a[4], b[8];
#pragma unroll
                for (int i = 0; i < 4; ++i) a[i] = As[(ty * 4 + i) * 33 + kk];
#pragma unroll
                for (int j = 0; j < 8; ++j) b[j] = Bs[(tx + 16 * j) * 33 + kk];
#pragma unroll
                for (int i = 0; i < 4; ++i)
#pragma unroll
                    for (int j = 0; j < 8; ++j) acc[i][j] += a[i] * b[j];
            }
            __syncthreads();
        }
#pragma unroll
        for (int i = 0; i < 4; ++i)
#pragma unroll
            for (int j = 0; j < 8; ++j) E(tm * 128 + ty * 4 + i, tn * 128 + tx + 16 * j, acc[i][j]);
    }
}
struct EpiStore { bf16* O; int ldc;
    __device__ __forceinline__ void operator()(int r, int c, float v) const { O[(size_t)r * ldc + c] = (bf16)f2bf(v); } };
struct EpiResid { const bf16* X; float* Z;
    __device__ __forceinline__ void operator()(int r, int c, float v) const { Z[(size_t)r * D + c] = ALPHA * bf2f(X[(size_t)r * D + c]) + v; } };
struct EpiCIn { bf16 *CQ, *CK, *CV, *CG; const float* lb;
    __device__ __forceinline__ void operator()(int r, int c, float v) const {
        const int seg = c >> 10, cc = c & 1023; const size_t o = (size_t)r * D + cc;
        if (seg == 0) CQ[o] = (bf16)f2bf(v);
        else if (seg == 1) { const float k = (1.f - lb[cc]) / (1.f + expf(v)); CK[o] = (bf16)f2bf(k); }
        else if (seg == 2) CV[o] = (bf16)f2bf(v);
        else CG[o] = (bf16)f2bf(v);
    } };

namespace pg8 {
#define PG8_LAS __attribute__((address_space(3)))
typedef unsigned short bf16_t;
typedef short bf16x8 __attribute__((ext_vector_type(8)));
typedef float f32x4 __attribute__((ext_vector_type(4)));
typedef unsigned u32x4 __attribute__((ext_vector_type(4)));
constexpr int BM = 256, BK = 64, HALF = 128, HTB = HALF * BK * 2  , STAGE_BYTES = 8 * HTB, NXCD = 8, WGM = 8;

__host__ __device__ __forceinline__ int lds_byte(int r, int c) { const int st = (r >> 4) * 2 + (c >> 5), rr = r & 15, cc = c & 31, ob = rr * 64 + cc * 2; return st * 1024 + (ob ^ (((ob >> 9) & 1) << 5)); }
__host__ __device__ __forceinline__ void stage_rc(int b, int& R, int& C) { const int st = b / 1024, sb = b % 1024, swz = sb ^ (((sb >> 9) & 1) << 5); R = (st >> 1) * 16 + swz / 64; C = (st & 1) * 32 + (swz % 64) / 2; }
__host__ __device__ __forceinline__ int perm32(int rho) { const int n = rho >> 4, i = rho & 15; return 8 * (i >> 2) + 4 * n + (i & 3); }

struct Unit { int pm, pn; };
struct Gemm { const bf16_t* A; const bf16_t* Bt; int M, N, K; };

struct StaticOrder {
    int nM, nN, nwg, G, c;
    __host__ __device__ void init(int M, int N, int G_, int c_) { nM = M / BM; nN = N / BM; nwg = nM * nN; G = G_; c = c_; }
    __host__ __device__ bool next(int i, Unit& u) const {
        const long L = (long)i * G + c; if (L >= nwg) return false;
        int wgid = (int)L; { const int q = nwg / NXCD, r = nwg % NXCD, xcd = wgid % NXCD, off = wgid / NXCD; wgid = (xcd < r ? xcd * (q + 1) : r * (q + 1) + (xcd - r) * q) + off; }
        const int nig = WGM * nN, gid = wgid / nig, fm = gid * WGM, gsz = (nM - fm) < WGM ? (nM - fm) : WGM;
        u.pm = fm + ((wgid % nig) % gsz); u.pn = (wgid % nig) / gsz; return true;
    }
    __device__ __forceinline__ void a_ready(const Unit&) const {}
    __device__ __forceinline__ void done(const Unit&) const {}
};

__device__ __forceinline__ unsigned cvt_pk_bf16(float lo, float hi) { unsigned r; asm volatile("v_cvt_pk_bf16_f32 %0, %1, %2" : "=v"(r) : "v"(lo), "v"(hi)); return r; }
typedef float f32x2 __attribute__((ext_vector_type(2)));
__device__ __forceinline__ f32x2 gelu_pk(f32x2 v) {
    const f32x2 av = __builtin_elementwise_abs(v), d = av * 0.2316418882f + 1.0f;
    f32x2 t; t.x = __builtin_amdgcn_rcpf(d.x); t.y = __builtin_amdgcn_rcpf(d.y);
    f32x2 q = t * 0.5307027145f + (-0.7265760135f); q = q * t + 0.7107068705f; q = q * t + (-0.142248368f); q = q * t + 0.127414796f; q = q * t;
    const f32x2 s = (v * v) * (-0.72134752044f);
    f32x2 e; e.x = __builtin_amdgcn_exp2f(s.x); e.y = __builtin_amdgcn_exp2f(s.y);
    const f32x2 m = v * (q * e), r = v - m;
    f32x2 o; o.x = v.x < 0.f ? m.x : r.x; o.y = v.y < 0.f ? m.y : r.y; return o;
}

template <int ACT  > struct EpiBf16 {
    static constexpr bool PERM = true, AFTER_DRAIN = false; static_assert(ACT == 0 || ACT == 1, "EpiBf16: ACT is 0 (none) or 1 (gelu_pk)");
    bf16_t* O; int ldc; const float* bias; int split_cols; size_t split_stride; float scale0;
    __device__ __forceinline__ void operator()(const f32x4 (&acc)[2][2][4][2], const Unit& u, int wr, int wc, int fr, int fq) const {
        const int row0 = u.pm * BM + wr * 64 + fr; int colt = u.pn * BM; bf16_t* base = O;
        float sc = 1.f; if (split_cols) { const int t = colt / split_cols; base += (size_t)t * split_stride; colt -= t * split_cols; if (t == 0) sc = scale0; }
        const int col0 = colt + wc * 32 + 8 * fq, bcol0 = u.pn * BM + wc * 32 + 8 * fq;
        f32x4 bv[2][2];
#pragma unroll
        for (int bj = 0; bj < 2; ++bj)
#pragma unroll
            for (int n = 0; n < 2; ++n) bv[bj][n] = bias ? *(const f32x4*)(bias + bcol0 + bj * HALF + 4 * n) : (f32x4){0.f, 0.f, 0.f, 0.f};
#pragma unroll
        for (int ai = 0; ai < 2; ++ai)
#pragma unroll
            for (int m = 0; m < 4; ++m) { bf16_t* rowp = base + (size_t)(row0 + ai * HALF + m * 16) * ldc + col0;
#pragma unroll
                for (int bj = 0; bj < 2; ++bj) { f32x4 v0 = acc[ai][bj][m][0] + bv[bj][0], v1 = acc[ai][bj][m][1] + bv[bj][1];
                    if (ACT == 1) { f32x2 a = gelu_pk((f32x2){v0[0], v0[1]}), b = gelu_pk((f32x2){v0[2], v0[3]}), c = gelu_pk((f32x2){v1[0], v1[1]}), d = gelu_pk((f32x2){v1[2], v1[3]});
                        v0 = (f32x4){a.x, a.y, b.x, b.y}; v1 = (f32x4){c.x, c.y, d.x, d.y}; }
                    v0 = v0 * sc; v1 = v1 * sc; u32x4 w; w.x = cvt_pk_bf16(v0[0], v0[1]); w.y = cvt_pk_bf16(v0[2], v0[3]); w.z = cvt_pk_bf16(v1[0], v1[1]); w.w = cvt_pk_bf16(v1[2], v1[3]);
                    *(u32x4*)(rowp + bj * HALF) = w; } }
    }
};

struct EpiResidF32 {
    static constexpr bool PERM = false, AFTER_DRAIN = false;
    const bf16_t* X; float* Z;
    __device__ __forceinline__ void operator()(const f32x4 (&acc)[2][2][4][2], const Unit& u, int wr, int wc, int fr, int fq) const {
        typedef unsigned u32x2 __attribute__((ext_vector_type(2)));
        const int row0 = u.pm * BM + wr * 64 + fr, col0 = u.pn * BM + wc * 32 + 4 * fq;
#pragma unroll
        for (int ai = 0; ai < 2; ++ai)
#pragma unroll
            for (int m = 0; m < 4; ++m) { const size_t ro = (size_t)(row0 + ai * HALF + m * 16) * 1024;
#pragma unroll
                for (int bj = 0; bj < 2; ++bj)
#pragma unroll
                    for (int n = 0; n < 2; ++n) { const int c = col0 + bj * HALF + n * 16; const u32x2 xw = *(const u32x2*)(X + ro + c);
                        f32x4 xv; xv[0] = __builtin_bit_cast(float, xw.x << 16); xv[1] = __builtin_bit_cast(float, xw.x & 0xffff0000u); xv[2] = __builtin_bit_cast(float, xw.y << 16); xv[3] = __builtin_bit_cast(float, xw.y & 0xffff0000u);
                        *(f32x4*)(Z + ro + c) = xv * 1.41421356237309515f + acc[ai][bj][m][n]; } }
    }
};
struct EpiCInF {
    static constexpr bool PERM = true, AFTER_DRAIN = false;
    bf16_t *CQ, *CK, *CV, *CG; const float* lb;
    __device__ __forceinline__ void operator()(const f32x4 (&acc)[2][2][4][2], const Unit& u, int wr, int wc, int fr, int fq) const {
        const int seg = u.pn >> 2, colt = (u.pn & 3) * BM;
        bf16_t* base = seg == 0 ? CQ : (seg == 1 ? CK : (seg == 2 ? CV : CG));
        const int row0 = u.pm * BM + wr * 64 + fr, col0 = colt + wc * 32 + 8 * fq;
        f32x4 om[2][2];
#pragma unroll
        for (int bj = 0; bj < 2; ++bj)
#pragma unroll
            for (int n = 0; n < 2; ++n) { const f32x4 l = *(const f32x4*)(lb + col0 + bj * HALF + 4 * n); om[bj][n] = 1.0f - l; }
#pragma unroll
        for (int ai = 0; ai < 2; ++ai)
#pragma unroll
            for (int m = 0; m < 4; ++m) { bf16_t* rowp = base + (size_t)(row0 + ai * HALF + m * 16) * 1024 + col0;
#pragma unroll
                for (int bj = 0; bj < 2; ++bj) { f32x4 v0 = acc[ai][bj][m][0], v1 = acc[ai][bj][m][1];
                    if (seg == 1) {
#pragma unroll
                        for (int q = 0; q < 4; ++q) { v0[q] = om[bj][0][q] / (1.0f + __expf(v0[q])); v1[q] = om[bj][1][q] / (1.0f + __expf(v1[q])); } }
                    u32x4 w; w.x = cvt_pk_bf16(v0[0], v0[1]); w.y = cvt_pk_bf16(v0[2], v0[3]); w.z = cvt_pk_bf16(v1[0], v1[1]); w.w = cvt_pk_bf16(v1[2], v1[3]);
                    *(u32x4*)(rowp + bj * HALF) = w; } }
    }
};
template <class Epi, class Sched, bool ALIGN_EPI = false, bool SP2 = false>
__device__ __forceinline__ void gemm_phase(PG8_LAS unsigned char* lds, const Gemm g, const Sched& S, const Epi& E) {
    const int tid = threadIdx.x, wid = __builtin_amdgcn_readfirstlane(tid >> 6), lane = tid & 63, wr = wid >> 2, wc = wid & 3, fr = lane & 15, fq = lane >> 4;
    const int K = g.K, nt = K / BK;
    unsigned voffA[2], voffB[2];
#pragma unroll
    for (int i = 0; i < 2; ++i) { int R, C; stage_rc(tid * 16 + i * 8192, R, C); const int Rb = Epi::PERM ? ((R & ~31) + perm32(R & 31)) : R;
        voffA[i] = (unsigned)(R * K + C) * 2u; voffB[i] = (unsigned)(Rb * K + C) * 2u; }
    const size_t kstep = (size_t)(BK * 2);
    const size_t hstep = (size_t)HALF * K * 2;
    const size_t tstep = 2 * hstep;
    const unsigned ldsw = (unsigned)wid * 1024u;
    const int aoff = lds_byte(wr * 64 + fr, fq * 8), boff = lds_byte(wc * 32 + fr, fq * 8);
#define PG8_SA(b, h) (((b) * 2 + (h)) * HTB)
#define PG8_SB(b, h) ((4 + (b) * 2 + (h)) * HTB)
#define PG8_STAGE(bufoff, gbase, voff) do { _Pragma("unroll") for (int _i = 0; _i < 2; ++_i) \
        __builtin_amdgcn_global_load_lds((const unsigned*)((const char*)(gbase) + (voff)[_i]), (PG8_LAS unsigned*)(lds + (bufoff) + ldsw + _i * 8192), 16, 0, 0); } while (0)
#define PG8_LDA(dst, b, h) do { _Pragma("unroll") for (int m = 0; m < 4; ++m) _Pragma("unroll") for (int k = 0; k < 2; ++k) dst[m][k] = *(const PG8_LAS bf16x8*)(lds + PG8_SA(b, h) + aoff + m * 2048 + k * 1024); } while (0)
#define PG8_LDB(dst, b, h) do { _Pragma("unroll") for (int n = 0; n < 2; ++n) _Pragma("unroll") for (int k = 0; k < 2; ++k) dst[n][k] = *(const PG8_LAS bf16x8*)(lds + PG8_SB(b, h) + boff + n * 2048 + k * 1024); } while (0)
#define PG8_MMA(ai, bj, At, Bt) do { __builtin_amdgcn_s_setprio(1); _Pragma("unroll") for (int m = 0; m < 4; ++m) _Pragma("unroll") for (int n = 0; n < 2; ++n) _Pragma("unroll") for (int k = 0; k < 2; ++k) \
        acc[ai][bj][m][n] = __builtin_amdgcn_mfma_f32_16x16x32_bf16(Bt[n][k], At[m][k], acc[ai][bj][m][n], 0, 0, 0); __builtin_amdgcn_s_setprio(0); } while (0)
#define PG8_WAIT_V(n) asm volatile("s_waitcnt vmcnt(" #n ")" ::: "memory")
#define PG8_WAIT_L(n) asm volatile("s_waitcnt lgkmcnt(" #n ")" ::: "memory")
#define PG8_BAR __builtin_amdgcn_s_barrier()
#define PG8_SCHED __builtin_amdgcn_sched_barrier(0)
    Unit cur, nxt; int ui = 0;
    if (!S.next(0, cur)) return;
    f32x4 acc[2][2][4][2];
#pragma unroll
    for (int a = 0; a < 2; ++a)
#pragma unroll
        for (int b = 0; b < 2; ++b)
#pragma unroll
            for (int m = 0; m < 4; ++m)
#pragma unroll
                for (int n = 0; n < 2; ++n) acc[a][b][m][n] = (f32x4){0.f, 0.f, 0.f, 0.f};
    bf16x8 At[4][2], B0[2][2], B1[2][2];
    const char* cA = (const char*)g.A + (size_t)cur.pm * tstep; const char* cB = (const char*)g.Bt + (size_t)cur.pn * tstep;
    S.a_ready(cur);
    if constexpr (SP2) {
        PG8_STAGE(PG8_SB(0, 0), cB, voffB); PG8_STAGE(PG8_SB(0, 1), cB + hstep, voffB); PG8_STAGE(PG8_SA(0, 0), cA, voffA); PG8_STAGE(PG8_SA(0, 1), cA + hstep, voffA);
        if (wr == 1) PG8_BAR;
        PG8_WAIT_V(2); PG8_BAR;
        PG8_STAGE(PG8_SB(1, 0), cB + kstep, voffB); PG8_STAGE(PG8_SA(1, 0), cA + kstep, voffA); PG8_STAGE(PG8_SB(1, 1), cB + hstep + kstep, voffB);
        PG8_WAIT_V(6); PG8_BAR;
    } else {
        PG8_STAGE(PG8_SB(0, 0), cB, voffB); PG8_STAGE(PG8_SA(0, 0), cA, voffA); PG8_STAGE(PG8_SB(0, 1), cB + hstep, voffB); PG8_STAGE(PG8_SA(0, 1), cA + hstep, voffA);
        if (wr == 1) PG8_BAR;
        PG8_WAIT_V(4); PG8_BAR;
        PG8_STAGE(PG8_SB(1, 0), cB + kstep, voffB); PG8_STAGE(PG8_SA(1, 0), cA + kstep, voffA); PG8_STAGE(PG8_SB(1, 1), cB + hstep + kstep, voffB);
        PG8_WAIT_V(6); PG8_BAR;
    }
    for (;;) {
        const bool has_next = S.next(ui + 1, nxt);
        const char* nA = has_next ? (const char*)g.A + (size_t)nxt.pm * tstep : cA; const char* nB = has_next ? (const char*)g.Bt + (size_t)nxt.pn * tstep : cB;
        for (int t = 0; t < nt; t += 2) {
            const bool last = (t == nt - 2);
            const char* a1 = cA + (size_t)(t + 1) * kstep;
            const char* a2 = last ? nA : cA + (size_t)(t + 2) * kstep; const char* b2 = last ? nB : cB + (size_t)(t + 2) * kstep;
            const char* a3 = a2 + kstep; const char* b3 = b2 + kstep;
            if (last && has_next) S.a_ready(nxt);
            if constexpr (SP2) {
            PG8_LDB(B0, 0, 0); PG8_LDB(B1, 0, 1); PG8_SCHED; PG8_LDA(At, 0, 0); PG8_STAGE(PG8_SA(1, 1), a1 + hstep, voffA);
            PG8_WAIT_V(8); PG8_WAIT_L(0); PG8_BAR; PG8_MMA(0, 0, At, B0); PG8_MMA(0, 1, At, B1); PG8_BAR; PG8_SCHED;
            PG8_LDA(At, 0, 1); PG8_STAGE(PG8_SB(0, 0), b2, voffB); PG8_STAGE(PG8_SB(0, 1), b2 + hstep, voffB); PG8_STAGE(PG8_SA(0, 0), a2, voffA);
            PG8_WAIT_V(8); PG8_WAIT_L(0); PG8_BAR; PG8_MMA(1, 0, At, B0); PG8_MMA(1, 1, At, B1); PG8_BAR; PG8_SCHED;
            PG8_LDB(B0, 1, 0); PG8_LDB(B1, 1, 1); PG8_SCHED; PG8_LDA(At, 1, 0); PG8_STAGE(PG8_SA(0, 1), a2 + hstep, voffA);
            PG8_WAIT_V(8); PG8_WAIT_L(0); PG8_BAR; PG8_MMA(0, 0, At, B0); PG8_MMA(0, 1, At, B1); PG8_BAR; PG8_SCHED;
            PG8_LDA(At, 1, 1); PG8_STAGE(PG8_SB(1, 0), b3, voffB); PG8_STAGE(PG8_SB(1, 1), b3 + hstep, voffB); PG8_STAGE(PG8_SA(1, 0), a3, voffA);
            PG8_WAIT_V(8); PG8_WAIT_L(0); PG8_BAR; PG8_MMA(1, 0, At, B0); PG8_MMA(1, 1, At, B1); PG8_BAR; PG8_SCHED;
            } else {
            PG8_LDB(B0, 0, 0); PG8_SCHED; PG8_LDA(At, 0, 0); PG8_STAGE(PG8_SA(1, 1), a1 + hstep, voffA);
            PG8_WAIT_L(8); PG8_BAR; PG8_WAIT_L(0); PG8_MMA(0, 0, At, B0); PG8_BAR; PG8_SCHED;
            PG8_LDB(B1, 0, 1); PG8_STAGE(PG8_SB(0, 0), b2, voffB);
            PG8_BAR; PG8_WAIT_L(0); PG8_MMA(0, 1, At, B1); PG8_BAR;
            PG8_LDA(At, 0, 1); PG8_STAGE(PG8_SA(0, 0), a2, voffA);
            PG8_BAR; PG8_WAIT_L(0); PG8_MMA(1, 0, At, B0); PG8_BAR; PG8_SCHED;
            PG8_STAGE(PG8_SB(0, 1), b2 + hstep, voffB);
            PG8_WAIT_V(6); PG8_BAR; PG8_MMA(1, 1, At, B1); PG8_BAR;
            PG8_LDB(B0, 1, 0); PG8_SCHED; PG8_LDA(At, 1, 0); PG8_STAGE(PG8_SA(0, 1), a2 + hstep, voffA);
            PG8_WAIT_L(8); PG8_BAR; PG8_WAIT_L(0); PG8_MMA(0, 0, At, B0); PG8_BAR; PG8_SCHED;
            PG8_LDB(B1, 1, 1); PG8_STAGE(PG8_SB(1, 0), b3, voffB);
            PG8_BAR; PG8_WAIT_L(0); PG8_MMA(0, 1, At, B1); PG8_BAR;
            PG8_LDA(At, 1, 1); PG8_STAGE(PG8_SA(1, 0), a3, voffA);
            PG8_BAR; PG8_WAIT_L(0); PG8_MMA(1, 0, At, B0); PG8_BAR; PG8_SCHED;
            PG8_STAGE(PG8_SB(1, 1), b3 + hstep, voffB);
            PG8_WAIT_V(6); PG8_BAR; PG8_MMA(1, 1, At, B1); PG8_BAR;
            }
        }
        if constexpr (ALIGN_EPI) { if (wr == 0) PG8_BAR; }
        if constexpr (!Epi::AFTER_DRAIN) { E(acc, cur, wr, wc, fr, fq); S.done(cur); }
        if (!has_next) break;
#pragma unroll
        for (int a = 0; a < 2; ++a)
#pragma unroll
            for (int b = 0; b < 2; ++b)
#pragma unroll
                for (int m = 0; m < 4; ++m)
#pragma unroll
                    for (int n = 0; n < 2; ++n) acc[a][b][m][n] = (f32x4){0.f, 0.f, 0.f, 0.f};
        cur = nxt; cA = nA; cB = nB; ++ui;
        if constexpr (ALIGN_EPI) { if (wr == 1) PG8_BAR; }
    }
    PG8_WAIT_V(0);
    if constexpr (!ALIGN_EPI) { if (wr == 0) PG8_BAR; }
    PG8_BAR;
    if constexpr (Epi::AFTER_DRAIN) { E.fused(acc, cur, wr, wc, fr, fq, lds, wid, lane); S.done(cur); }
#undef PG8_SA
#undef PG8_SB
#undef PG8_STAGE
#undef PG8_LDA
#undef PG8_LDB
#undef PG8_MMA
#undef PG8_WAIT_V
#undef PG8_WAIT_L
#undef PG8_BAR
#undef PG8_SCHED
}
}

__device__ __forceinline__ float gamma_log2(int h) { return log2f(1.f - exp2f(-5.f - (float)h)); }

__device__ __forceinline__ void phase_prologue(LAS unsigned char* lds, const float* const* in, unsigned char* ws) {
    const int tid = threadIdx.x, lane = tid & 63, wave = tid >> 6;
    const int gw = blockIdx.x * NWAVES + wave, NGW = gridDim.x * NWAVES;
    LAS float* scr = (LAS float*)(lds + wave * 16384);
    constexpr int I_ABIN = (D / 64) * (AB_IN / 32), I_SQ = (D / 64) * (D / 32), I_CIN = (D / 64) * (C_IN / 32), I_WQ = (D / 64) * (2048 / 32);
    constexpr int NITEMS = I_ABIN + I_SQ + I_CIN + I_SQ + 2 * I_WQ;
    for (int it = gw; it < NITEMS; it += NGW) {
        int r = it;
        if (r < I_ABIN) { p0_transpose_item(in[1], D, AB_IN, (bf16*)(ws + WS_WABIN), scr, r, lane); continue; } r -= I_ABIN;
        if (r < I_SQ) { p0_transpose_item(in[5], D, D, (bf16*)(ws + WS_WABOUT), scr, r, lane); continue; } r -= I_SQ;
        if (r < I_CIN) { p0_transpose_item(in[6], D, C_IN, (bf16*)(ws + WS_WCIN), scr, r, lane); continue; } r -= I_CIN;
        if (r < I_SQ) { p0_transpose_item(in[9], D, D, (bf16*)(ws + WS_WCOUT), scr, r, lane); continue; } r -= I_SQ;
        if (r < I_WQ) { p0_transpose_item(in[10], D, 2048, (bf16*)(ws + WS_WQ), scr, r, lane); continue; } r -= I_WQ;
        p0_transpose_item(in[10] + (size_t)D * 2048, D, 2048, (bf16*)(ws + WS_WQ) + (size_t)2048 * D, scr, r, lane);
    }
    const size_t gt = (size_t)blockIdx.x * NTHR + tid, NT = (size_t)gridDim.x * NTHR;
    { const float* x = in[0]; bf16* xb = (bf16*)(ws + WS_XB);
      for (size_t i = gt; i < (size_t)T * D / 8; i += NT) { const f32x4 a = *(const GAS f32x4*)(x + i * 8), b = *(const GAS f32x4*)(x + i * 8 + 4);
          v4u o; o.x = pk2(a.x, a.y); o.y = pk2(a.z, a.w); o.z = pk2(b.x, b.y); o.w = pk2(b.z, b.w); *(GAS v4u*)(xb + i * 8) = o; } }
    { const float* k = in[11]; bf16* kb = (bf16*)(ws + WS_KEYS);
      for (size_t i = gt; i < (size_t)2 * 8 * 2 * 128 * 128 / 8; i += NT) { const f32x4 a = *(const GAS f32x4*)(k + i * 8), b = *(const GAS f32x4*)(k + i * 8 + 4);
          v4u o; o.x = pk2(a.x, a.y); o.y = pk2(a.z, a.w); o.z = pk2(b.x, b.y); o.w = pk2(b.z, b.w); *(GAS v4u*)(kb + i * 8) = o; } }
    { float* ct = (float*)(ws + WS_ROPE); float* st = ct + 4096 * 32;
      for (size_t i = gt; i < (size_t)4096 * 32; i += NT) { const int pos = (int)(i >> 5), f = (int)(i & 31);
          const double inv = exp(-log(10000.0) * ((double)f / 31.0)); const double ang = (double)pos * inv;
          ct[i] = (float)cos(ang); st[i] = (float)sin(ang); } }
    { const float* l = in[7]; float* lb = (float*)(ws + WS_LB);
      for (size_t i = gt; i < 1024; i += NT) { const float a = l[i], b = l[1024 + i]; const float m = fmaxf(a, b); const float ea = expf(a - m), eb = expf(b - m); lb[i] = eb / (ea + eb); } }
}

__device__ __forceinline__ void phase_ret_local(LAS unsigned char* lds, unsigned char* ws) {
    const int tid = threadIdx.x;
    const bf16* H0 = (const bf16*)(ws + WS_H0); float* LST = (float*)(ws + WS_LST);
    const float* ct = (const float*)(ws + WS_ROPE); const float* st = ct + 4096 * 32;
    LAS float* kd = (LAS float*)lds;
    LAS float* vv = (LAS float*)(lds + 32768);
    for (int item = blockIdx.x; item < 1024; item += gridDim.x) {
        const int n = item & 31, h = (item >> 5) & 3, b = item >> 7;
        const size_t t0 = (size_t)b * SEQ + n * 128; const float lg = gamma_log2(h);
        for (int idx = tid; idx < 4096; idx += NTHR) { const int s = idx >> 5, i = idx & 31, pos = n * 128 + s;
            const bf16* row = H0 + (t0 + s) * AB_IN + 768 + h * 64;
            const float x1 = bf2f(row[i]), x2 = bf2f(row[i + 32]); const float c = ct[pos * 32 + i], sn = st[pos * 32 + i];
            const float dec = exp2f((float)(127 - s) * lg) * 0.125f;
            kd[s * 64 + i] = (x1 * c - x2 * sn) * dec; kd[s * 64 + i + 32] = (x2 * c + x1 * sn) * dec; }
        for (int idx = tid; idx < 16384; idx += NTHR) { const int s = idx >> 7, e = idx & 127; vv[idx] = bf2f(H0[(t0 + s) * AB_IN + 1024 + h * 128 + e]); }
        __syncthreads();
        const int e = tid & 127, dg = tid >> 7;
        float acc[16];
#pragma unroll
        for (int j = 0; j < 16; ++j) acc[j] = 0.f;
        for (int s = 0; s < 128; ++s) { const float v = vv[s * 128 + e];
#pragma unroll
            for (int j = 0; j < 16; ++j) acc[j] += kd[s * 64 + dg * 16 + j] * v; }
#pragma unroll
        for (int j = 0; j < 16; ++j) LST[(size_t)item * 8192 + (dg * 16 + j) * 128 + e] = acc[j];
        __syncthreads();
    }
}
__device__ __forceinline__ void phase_ret_prefix(unsigned char* ws) {
    float* LST = (float*)(ws + WS_LST);
    const size_t gt = (size_t)blockIdx.x * NTHR + threadIdx.x, NT = (size_t)gridDim.x * NTHR;
    for (size_t idx = gt; idx < (size_t)32 * 8192; idx += NT) { const int bh = (int)(idx >> 13), el = (int)(idx & 8191), h = bh & 3;
        const float g128 = exp2f(128.f * gamma_log2(h)); float S = 0.f;
        for (int n = 0; n < 32; ++n) { float* p = LST + ((size_t)(bh * 32 + n) * 8192 + el); const float tmp = *p; *p = S; S = S * g128 + tmp; } }
}
__device__ __forceinline__ void phase_ret_out_pool(LAS unsigned char* lds, const float* const* in, unsigned char* ws) {
    const int tid = threadIdx.x;
    const bf16* H0 = (const bf16*)(ws + WS_H0); const float* LST = (const float*)(ws + WS_LST); bf16* Y = (bf16*)(ws + WS_Y);
    const float* ct = (const float*)(ws + WS_ROPE); const float* st = ct + 4096 * 32;
    const float* pool_w = in[2]; const float* pool_scale = in[3]; const float* ret_g = in[4];
    LAS float* qs = (LAS float*)lds;
    LAS float* ks = qs + 128 * 65;
    LAS float* R2 = (LAS float*)(lds + 66560);
    LAS float* PA = (LAS float*)lds;
    LAS float* PB = (LAS float*)(lds + 66048);
    for (int item = blockIdx.x; item < 256; item += gridDim.x) {
        const int n = item & 31, b = item >> 5; const size_t t0 = (size_t)b * SEQ + n * 128;
        const int c = tid >> 2, eg = tid & 3;
        for (int h = 0; h < 4; ++h) {
            const float lg = gamma_log2(h);
            for (int idx = tid; idx < 4096; idx += NTHR) { const int s = idx >> 5, i = idx & 31, pos = n * 128 + s;
                const bf16* rq = H0 + (t0 + s) * AB_IN + 512 + h * 64; const bf16* rk = H0 + (t0 + s) * AB_IN + 768 + h * 64;
                const float cs = ct[pos * 32 + i], sn = st[pos * 32 + i];
                const float q1 = bf2f(rq[i]), q2 = bf2f(rq[i + 32]), k1 = bf2f(rk[i]), k2 = bf2f(rk[i + 32]);
                qs[s * 65 + i] = q1 * cs - q2 * sn; qs[s * 65 + i + 32] = q2 * cs + q1 * sn;
                ks[s * 65 + i] = (k1 * cs - k2 * sn) * 0.125f; ks[s * 65 + i + 32] = (k2 * cs + k1 * sn) * 0.125f; }
            { const float* Sg = LST + (size_t)((b * 4 + h) * 32 + n) * 8192;
              for (int idx = tid; idx < 8192; idx += NTHR) R2[idx] = Sg[idx]; }
            __syncthreads();
            float o[32];
#pragma unroll
            for (int j = 0; j < 32; ++j) o[j] = 0.f;
            for (int d = 0; d < 64; ++d) { const float qv = qs[c * 65 + d];
#pragma unroll
                for (int j = 0; j < 32; ++j) o[j] += qv * R2[d * 128 + eg * 32 + j]; }
            { const float qd = exp2f((float)(c + 1) * lg);
#pragma unroll
              for (int j = 0; j < 32; ++j) o[j] *= qd; }
            __syncthreads();
            for (int idx = tid; idx < 16384; idx += NTHR) { const int s = idx >> 7, e = idx & 127; R2[idx] = bf2f(H0[(t0 + s) * AB_IN + 1024 + h * 128 + e]); }
            __syncthreads();
            for (int s = 0; s <= c; ++s) {
                float dot = 0.f;
#pragma unroll 16
                for (int d = 0; d < 64; ++d) dot += qs[c * 65 + d] * ks[s * 65 + d];
                const float w = dot * exp2f((float)(c - s) * lg);
#pragma unroll
                for (int j = 0; j < 32; ++j) o[j] += w * R2[s * 128 + eg * 32 + j];
            }
            float sum = 0.f;
#pragma unroll
            for (int j = 0; j < 32; ++j) sum += o[j];
            sum += __shfl_xor(sum, 1); sum += __shfl_xor(sum, 2);
            const float mean = sum * (1.f / 128.f); float sq = 0.f;
#pragma unroll
            for (int j = 0; j < 32; ++j) { const float dl = o[j] - mean; sq += dl * dl; }
            sq += __shfl_xor(sq, 1); sq += __shfl_xor(sq, 2);
            const float rstd = 1.f / sqrtf(sq * (1.f / 128.f) + LN_EPS);
            { const bf16* rg = H0 + (t0 + c) * AB_IN + 1536 + h * 128 + eg * 32; bf16* yo = Y + (t0 + c) * D + 512 + h * 128 + eg * 32;
#pragma unroll
              for (int j = 0; j < 32; ++j) { const float g = bf2f(rg[j]); const float sg = g / (1.f + expf(-g));
                  yo[j] = (bf16)f2bf((o[j] - mean) * rstd * ret_g[h * 128 + eg * 32 + j] * sg); } }
            __syncthreads();
        }
        for (int gi = 0; gi < 4; ++gi) {
            const int w = 2 << gi;
            for (int idx = tid; idx < 16384; idx += NTHR) { const int s = idx >> 7, cc = idx & 127, pos = n * 128 + s; const int cnt = (pos + 1 < w) ? pos + 1 : w;
                float sum = 0.f; for (int j = 0; j < cnt; ++j) sum += bf2f(H0[(t0 + s - j) * AB_IN + gi * 128 + cc]);
                PA[s * 129 + cc] = sum / (float)cnt - bf2f(H0[(t0 + s) * AB_IN + gi * 128 + cc]); }
            for (int idx = tid; idx < 16384; idx += NTHR) PB[idx] = pool_w[gi * 16384 + idx];
            __syncthreads();
            float o[32];
#pragma unroll
            for (int j = 0; j < 32; ++j) o[j] = 0.f;
            for (int cc = 0; cc < 128; ++cc) { const float pv = PA[c * 129 + cc];
#pragma unroll
                for (int j = 0; j < 32; ++j) o[j] += pv * PB[cc * 128 + eg * 32 + j]; }
            { bf16* yo = Y + (t0 + c) * D + gi * 128 + eg * 32;
#pragma unroll
              for (int j = 0; j < 32; ++j) yo[j] = (bf16)f2bf(o[j] * pool_scale[gi * 128 + eg * 32 + j]); }
            __syncthreads();
        }
    }
}
__device__ __forceinline__ void phase_ln(const float* Z, bf16* O, const float* g, const float* bb) {
    const int tid = threadIdx.x, lane = tid & 63, wave = tid >> 6;
    const int gw = blockIdx.x * NWAVES + wave, NGW = gridDim.x * NWAVES;
    for (int m = gw; m < T; m += NGW) {
        const GAS f32x4* zr = (const GAS f32x4*)(Z + (size_t)m * D) + lane;
        f32x4 v[4]; float s = 0.f;
#pragma unroll
        for (int j = 0; j < 4; ++j) { v[j] = zr[64 * j]; s += (v[j].x + v[j].y) + (v[j].z + v[j].w); }
        const float mean = wave_sum(s) * (1.f / D); float s2 = 0.f;
#pragma unroll
        for (int j = 0; j < 4; ++j) { v[j] = v[j] - mean; s2 += (v[j].x * v[j].x + v[j].y * v[j].y) + (v[j].z * v[j].z + v[j].w * v[j].w); }
        const float rstd = 1.f / sqrtf(wave_sum(s2) * (1.f / D) + LN_EPS);
        GAS v2u* o8 = (GAS v2u*)(O + (size_t)m * D) + lane;
#pragma unroll
        for (int j = 0; j < 4; ++j) { const f32x4 gg = *((const GAS f32x4*)g + lane + 64 * j), b4 = *((const GAS f32x4*)bb + lane + 64 * j);
            v2u o; o.x = pk2(v[j].x * rstd * gg.x + b4.x, v[j].y * rstd * gg.y + b4.y); o.y = pk2(v[j].z * rstd * gg.z + b4.z, v[j].w * rstd * gg.w + b4.w); o8[64 * j] = o; }
    }
}
__device__ __forceinline__ void wave_argmax(float& bv, int& bi) {
#pragma unroll
    for (int off = 32; off >= 1; off >>= 1) { const float ov = __shfl_xor(bv, off); const int oi = __shfl_xor(bi, off);
        if (ov > bv || (ov == bv && oi < bi)) { bv = ov; bi = oi; } }
}
__device__ __forceinline__ void phase_topk(LAS unsigned char* lds, const bf16* Q, const float* keys  , int* EID, float* GATE) {
    const int tid = threadIdx.x, lane = tid & 63, wave = tid >> 6;
    LAS float* kl = (LAS float*)lds;
    LAS float* qt = (LAS float*)(lds + 66048);
    LAS float* sc = (LAS float*)(lds + 82560);
    for (int item = blockIdx.x; item < (T / 32) * 8; item += gridDim.x) {
        const int h = item & 7, tile = item >> 3; const size_t tok0 = (size_t)tile * 32;
        for (int p = 0; p < 2; ++p) {
            const float* kg = keys + (size_t)((h * 2 + p) * 128) * 128;
            for (int idx = tid; idx < 16384; idx += NTHR) { const int k = idx >> 7, d = idx & 127; kl[k * 129 + d] = kg[idx]; }
            for (int idx = tid; idx < 4096; idx += NTHR) { const int t = idx >> 7, d = idx & 127; qt[t * 129 + d] = bf2f(Q[(tok0 + t) * 2048 + h * 256 + p * 128 + d]); }
            __syncthreads();
            { const int t = tid >> 4, kg16 = tid & 15;
              for (int jj = 0; jj < 8; ++jj) { const int k = kg16 + 16 * jj; float dot = 0.f;
#pragma unroll 16
                  for (int d = 0; d < 128; ++d) dot += qt[t * 129 + d] * kl[k * 129 + d];
                  sc[(t * 2 + p) * 128 + k] = dot; } }
            __syncthreads();
        }
        for (int tt = 0; tt < 4; ++tt) {
            const int t = wave * 4 + tt;
            float tv[2]; int ti[2];
#pragma unroll
            for (int p = 0; p < 2; ++p) {
                float v0 = sc[(t * 2 + p) * 128 + lane], v1 = sc[(t * 2 + p) * 128 + lane + 64];
                float mv = 0.f; int mi = 0;
                for (int j = 0; j < 16; ++j) {
                    float bv; int bi; if (v0 >= v1) { bv = v0; bi = lane; } else { bv = v1; bi = lane + 64; }
                    wave_argmax(bv, bi);
                    if (lane == j) { mv = bv; mi = bi; }
                    if (bi == lane) v0 = -INFINITY; if (bi == lane + 64) v1 = -INFINITY;
                }
                tv[p] = mv; ti[p] = mi;
            }
            float cv[4];
#pragma unroll
            for (int m = 0; m < 4; ++m) { const int cidx = lane + 64 * m; cv[m] = __shfl(tv[0], cidx >> 4) + __shfl(tv[1], cidx & 15); }
            float bestv = 0.f; int bestc = 0;
            for (int j = 0; j < 16; ++j) {
                float bv = cv[0]; int bi = lane;
#pragma unroll
                for (int m = 1; m < 4; ++m) if (cv[m] > bv) { bv = cv[m]; bi = lane + 64 * m; }
                wave_argmax(bv, bi);
                if (lane == j) { bestv = bv; bestc = bi; }
#pragma unroll
                for (int m = 0; m < 4; ++m) if (bi == lane + 64 * m) cv[m] = -INFINITY;
            }
            const float mx = __shfl(bestv, 0);
            const float ex = (lane < 16) ? expf(bestv - mx) : 0.f;
            const float den = wave_sum(ex);
            const int ia = __shfl(ti[0], bestc >> 4), ib = __shfl(ti[1], bestc & 15);
            if (lane < 16) { const size_t o = (tok0 + t) * 128 + h * 16 + lane; EID[o] = ia * 128 + ib; GATE[o] = ex / den; }
        }
        __syncthreads();
    }
}
template <bool FINAL>
__device__ __forceinline__ void phase_gather(const bf16* X, const int* EID, const float* GATE, const float* U, const float* V, const float* g, const float* bb, bf16* Ob, float* Of) {
    const int tid = threadIdx.x, lane = tid & 63, wave = tid >> 6;
    const int gw = blockIdx.x * NWAVES + wave, NGW = gridDim.x * NWAVES;
    for (int t = gw; t < T; t += NGW) {
        f32x4 x[4], acc[4];
#pragma unroll
        for (int j = 0; j < 4; ++j) { const v2u w = *((const GAS v2u*)(X + (size_t)t * D) + lane + 64 * j);
            x[j] = (f32x4){bflo(w.x), bfhi(w.x), bflo(w.y), bfhi(w.y)}; acc[j] = (f32x4){0.f, 0.f, 0.f, 0.f}; }
        const int e0 = EID[(size_t)t * 128 + lane], e1 = EID[(size_t)t * 128 + 64 + lane];
        const float g0 = GATE[(size_t)t * 128 + lane], g1 = GATE[(size_t)t * 128 + 64 + lane];
#pragma unroll 2
        for (int k = 0; k < 128; ++k) {
            const int e = (k < 64) ? __shfl(e0, k) : __shfl(e1, k - 64);
            const float gt = (k < 64) ? __shfl(g0, k) : __shfl(g1, k - 64);
            const GAS f32x4* ur = (const GAS f32x4*)(U + (size_t)e * D) + lane;
            float dot = 0.f;
#pragma unroll
            for (int j = 0; j < 4; ++j) { const f32x4 u = ur[64 * j]; dot += (x[j].x * u.x + x[j].y * u.y) + (x[j].z * u.z + x[j].w * u.w); }
            dot = wave_sum(dot);
            const float a = 0.5f * dot * (1.f + erff(dot * 0.70710678118654752f));
            const float cf = gt * a;
            const GAS f32x4* vr = (const GAS f32x4*)(V + (size_t)e * D) + lane;
#pragma unroll
            for (int j = 0; j < 4; ++j) { const f32x4 v = vr[64 * j]; acc[j] += cf * v; }
        }
        float s = 0.f;
#pragma unroll
        for (int j = 0; j < 4; ++j) { acc[j] = ALPHA * x[j] + acc[j]; s += (acc[j].x + acc[j].y) + (acc[j].z + acc[j].w); }
        const float mean = wave_sum(s) * (1.f / D); float s2 = 0.f;
#pragma unroll
        for (int j = 0; j < 4; ++j) { acc[j] = acc[j] - mean; s2 += (acc[j].x * acc[j].x + acc[j].y * acc[j].y) + (acc[j].z * acc[j].z + acc[j].w * acc[j].w); }
        const float rstd = 1.f / sqrtf(wave_sum(s2) * (1.f / D) + LN_EPS);
#pragma unroll
        for (int j = 0; j < 4; ++j) { const f32x4 gg = *((const GAS f32x4*)g + lane + 64 * j), b4 = *((const GAS f32x4*)bb + lane + 64 * j);
            const f32x4 o = acc[j] * rstd * gg + b4;
            if (FINAL) *((GAS f32x4*)(Of + (size_t)t * D) + lane + 64 * j) = o;
            else { v2u w; w.x = pk2(o.x, o.y); w.y = pk2(o.z, o.w); *((GAS v2u*)(Ob + (size_t)t * D) + lane + 64 * j) = w; } }
    }
}

typedef float f32x2 __attribute__((ext_vector_type(2)));
__device__ __forceinline__ void phase_convert_tables(const float* U, const float* V, unsigned char* ws) {
    const int tid = threadIdx.x, lane = tid & 63, wave = tid >> 6;
    const int gw = blockIdx.x * NWAVES + wave, NGW = gridDim.x * NWAVES;
    for (int row = gw; row < 4 * NEXP; row += NGW) {
        const bool isv = row >= 2 * NEXP; const int r = row & (2 * NEXP - 1);
        const GAS f32x4* src = (const GAS f32x4*)((isv ? V : U) + (size_t)r * D) + lane;
        f32x4 v[4]; float m = 0.f;
#pragma unroll
        for (int j = 0; j < 4; ++j) { v[j] = src[64 * j]; m = fmaxf(fmaxf(m, fmaxf(fabsf(v[j].x), fabsf(v[j].y))), fmaxf(fabsf(v[j].z), fabsf(v[j].w))); }
#pragma unroll
        for (int o = 1; o < 64; o <<= 1) m = fmaxf(m, __shfl_xor(m, o));
        m = fmaxf(m, 1e-30f);
        const float sc = 400.f / m;
        v4u w;
        { int t0 = __builtin_amdgcn_cvt_pk_fp8_f32(v[0].x * sc, v[0].y * sc, 0, false); t0 = __builtin_amdgcn_cvt_pk_fp8_f32(v[0].z * sc, v[0].w * sc, t0, true); w.x = (unsigned)t0; }
        { int t0 = __builtin_amdgcn_cvt_pk_fp8_f32(v[1].x * sc, v[1].y * sc, 0, false); t0 = __builtin_amdgcn_cvt_pk_fp8_f32(v[1].z * sc, v[1].w * sc, t0, true); w.y = (unsigned)t0; }
        { int t0 = __builtin_amdgcn_cvt_pk_fp8_f32(v[2].x * sc, v[2].y * sc, 0, false); t0 = __builtin_amdgcn_cvt_pk_fp8_f32(v[2].z * sc, v[2].w * sc, t0, true); w.z = (unsigned)t0; }
        { int t0 = __builtin_amdgcn_cvt_pk_fp8_f32(v[3].x * sc, v[3].y * sc, 0, false); t0 = __builtin_amdgcn_cvt_pk_fp8_f32(v[3].z * sc, v[3].w * sc, t0, true); w.w = (unsigned)t0; }
        *((GAS v4u*)(ws + (isv ? WS_V8 : WS_U8) + (size_t)r * 1024) + lane) = w;
        if (lane == 0) ((float*)(ws + (isv ? WS_DQV : WS_DQU)))[r] = m * (1.f / 400.f);
    }
}
__host__ __device__ constexpr int rev4(int i) { return ((i & 1) << 3) | ((i & 2) << 1) | ((i & 4) >> 1) | ((i & 8) >> 3); }
#define FMA2(a, b, c) __builtin_elementwise_fma((a), (b), (c))
#define CVT8(w, hi) __builtin_amdgcn_cvt_pk_f32_fp8((int)(w), (hi))
template <bool FINAL>
__device__ __forceinline__ void phase_gather8(const bf16* X, const int* EID, const float* GATE, const unsigned char* U8, const unsigned char* V8, const float* DQU, const float* DQV,
                                              const float* g, const float* bb, bf16* Ob, float* Of) {
    const int tid = threadIdx.x, lane = tid & 63, wave = tid >> 6;
    const int gw = blockIdx.x * NWAVES + wave, NGW = gridDim.x * NWAVES;
    const bool b0 = (lane & 1) != 0, b1 = (lane & 2) != 0, b2 = (lane & 4) != 0, b3 = (lane & 8) != 0; const int myrow = lane >> 4;
    for (int t = gw; t < T; t += NGW) {
        f32x2 x[8];
#pragma unroll
        for (int j = 0; j < 4; ++j) { const v2u w = *((const GAS v2u*)(X + (size_t)t * D) + lane + 64 * j);
            x[2 * j] = (f32x2){bflo(w.x), bfhi(w.x)}; x[2 * j + 1] = (f32x2){bflo(w.y), bfhi(w.y)}; }
        const int e0 = EID[(size_t)t * 128 + lane], e1 = EID[(size_t)t * 128 + 64 + lane];
        const float gt0 = GATE[(size_t)t * 128 + lane], gt1 = GATE[(size_t)t * 128 + 64 + lane];
        const float dqu0 = DQU[e0], dqu1 = DQU[e1], dqv0 = DQV[e0], dqv1 = DQV[e1];
        float act0 = 0.f, act1 = 0.f;
#pragma unroll
        for (int r = 0; r < 2; ++r) {
            const int er = r ? e1 : e0;
            for (int row = 0; row < 4; ++row) {
                v4u w[16];
#pragma unroll
                for (int i = 0; i < 16; ++i) { const int e = __builtin_amdgcn_readlane(er, row * 16 + rev4(i)); w[i] = *((const GAS v4u*)(U8 + (size_t)e * 1024) + lane); }
                float p[16];
#pragma unroll
                for (int i = 0; i < 16; ++i) { f32x2 a = (f32x2){0.f, 0.f};
                    a = FMA2(x[0], CVT8(w[i].x, false), a); a = FMA2(x[1], CVT8(w[i].x, true), a);
                    a = FMA2(x[2], CVT8(w[i].y, false), a); a = FMA2(x[3], CVT8(w[i].y, true), a);
                    a = FMA2(x[4], CVT8(w[i].z, false), a); a = FMA2(x[5], CVT8(w[i].z, true), a);
                    a = FMA2(x[6], CVT8(w[i].w, false), a); a = FMA2(x[7], CVT8(w[i].w, true), a);
                    p[i] = a.x + a.y; }
                float r8[8], r4[4], r2[2];
#pragma unroll
                for (int i = 0; i < 8; ++i) { const float keep = b0 ? p[8 + i] : p[i], send = b0 ? p[i] : p[8 + i]; r8[i] = keep + __shfl_xor(send, 1); }
#pragma unroll
                for (int i = 0; i < 4; ++i) { const float keep = b1 ? r8[4 + i] : r8[i], send = b1 ? r8[i] : r8[4 + i]; r4[i] = keep + __shfl_xor(send, 2); }
#pragma unroll
                for (int i = 0; i < 2; ++i) { const float keep = b2 ? r4[2 + i] : r4[i], send = b2 ? r4[i] : r4[2 + i]; r2[i] = keep + __shfl_xor(send, 4); }
                float r1 = (b3 ? r2[1] : r2[0]) + __shfl_xor(b3 ? r2[0] : r2[1], 8);
                r1 += __shfl_xor(r1, 16); r1 += __shfl_xor(r1, 32);
                if (myrow == row) { if (r == 0) act0 = r1; else act1 = r1; }
            }
        }
        float c0, c1;
        { const float a0 = act0 * dqu0, a1 = act1 * dqu1;
          c0 = gt0 * (0.5f * a0 * (1.f + erff(a0 * 0.70710678118654752f))) * dqv0;
          c1 = gt1 * (0.5f * a1 * (1.f + erff(a1 * 0.70710678118654752f))) * dqv1; }
        f32x2 acc[8];
#pragma unroll
        for (int j = 0; j < 8; ++j) acc[j] = (f32x2){0.f, 0.f};
#pragma unroll
        for (int r = 0; r < 2; ++r) {
            const int er = r ? e1 : e0; const int cr = __builtin_bit_cast(int, r ? c1 : c0);
            for (int row = 0; row < 4; ++row) {
                v4u w[16];
#pragma unroll
                for (int i = 0; i < 16; ++i) { const int e = __builtin_amdgcn_readlane(er, row * 16 + i); w[i] = *((const GAS v4u*)(V8 + (size_t)e * 1024) + lane); }
#pragma unroll
                for (int i = 0; i < 16; ++i) { const float cf = __builtin_bit_cast(float, __builtin_amdgcn_readlane(cr, row * 16 + i)); const f32x2 c2 = (f32x2){cf, cf};
                    acc[0] = FMA2(c2, CVT8(w[i].x, false), acc[0]); acc[1] = FMA2(c2, CVT8(w[i].x, true), acc[1]);
                    acc[2] = FMA2(c2, CVT8(w[i].y, false), acc[2]); acc[3] = FMA2(c2, CVT8(w[i].y, true), acc[3]);
                    acc[4] = FMA2(c2, CVT8(w[i].z, false), acc[4]); acc[5] = FMA2(c2, CVT8(w[i].z, true), acc[5]);
                    acc[6] = FMA2(c2, CVT8(w[i].w, false), acc[6]); acc[7] = FMA2(c2, CVT8(w[i].w, true), acc[7]); }
            }
        }
        float s = 0.f;
#pragma unroll
        for (int j = 0; j < 8; ++j) { acc[j] = x[j] * ALPHA + acc[j]; s += acc[j].x + acc[j].y; }
        const float mean = wave_sum(s) * (1.f / D); float s2 = 0.f;
#pragma unroll
        for (int j = 0; j < 8; ++j) { acc[j] = acc[j] - mean; s2 += acc[j].x * acc[j].x + acc[j].y * acc[j].y; }
        const float rstd = 1.f / sqrtf(wave_sum(s2) * (1.f / D) + LN_EPS);
#pragma unroll
        for (int j = 0; j < 4; ++j) { const f32x4 gg = *((const GAS f32x4*)g + lane + 64 * j), b4 = *((const GAS f32x4*)bb + lane + 64 * j);
            const f32x4 o = (f32x4){acc[2 * j].x, acc[2 * j].y, acc[2 * j + 1].x, acc[2 * j + 1].y} * rstd * gg + b4;
            if (FINAL) *((GAS f32x4*)(Of + (size_t)t * D) + lane + 64 * j) = o;
            else { v2u w; w.x = pk2(o.x, o.y); w.y = pk2(o.z, o.w); *((GAS v2u*)(Ob + (size_t)t * D) + lane + 64 * j) = w; } }
    }
}
__device__ __forceinline__ void phase_hgrn(LAS unsigned char* lds, unsigned char* ws) {
    const int tid = threadIdx.x;
    const bf16* CQ = (const bf16*)(ws + WS_CQ); const bf16* CK = (const bf16*)(ws + WS_CK); const bf16* CV = (const bf16*)(ws + WS_CV); bf16* O = (bf16*)(ws + WS_O);
    LAS float* fL = (LAS float*)lds;
    LAS float* kL = fL + 4096; LAS float* qL = kL + 4096;
    LAS float* vL = qL + 4096;
    LAS float* part = vL + 1024;
    for (int item = blockIdx.x; item < 256; item += gridDim.x) {
        const int es = item & 3, h = (item >> 2) & 7, b = item >> 5;
        const int e = tid & 31, dg = tid >> 5;
        float S[8];
#pragma unroll
        for (int j = 0; j < 8; ++j) S[j] = 0.f;
        for (int blk = 0; blk < SEQ / 32; ++blk) {
            const size_t t0 = (size_t)b * SEQ + blk * 32;
            for (int idx = tid; idx < 4096; idx += NTHR) { const int s = idx >> 7, d = idx & 127; const size_t o = (t0 + s) * D + h * 128 + d;
                const float kk = bf2f(CK[o]); kL[idx] = kk; fL[idx] = 1.f - kk; qL[idx] = bf2f(CQ[o]); }
            for (int idx = tid; idx < 1024; idx += NTHR) { const int s = idx >> 5, ee = idx & 31; vL[idx] = bf2f(CV[(t0 + s) * D + h * 128 + es * 32 + ee]); }
            __syncthreads();
            for (int s = 0; s < 32; ++s) { const float v = vL[s * 32 + e]; float po = 0.f;
#pragma unroll
                for (int j = 0; j < 8; ++j) { const int d = dg * 8 + j; S[j] = fL[s * 128 + d] * S[j] + kL[s * 128 + d] * v; po += qL[s * 128 + d] * S[j]; }
                part[(s * 16 + dg) * 32 + e] = po; }
            __syncthreads();
            for (int idx = tid; idx < 1024; idx += NTHR) { const int s = idx >> 5, ee = idx & 31; float o = 0.f;
#pragma unroll
                for (int g = 0; g < 16; ++g) o += part[(s * 16 + g) * 32 + ee];
                O[(t0 + s) * D + h * 128 + es * 32 + ee] = (bf16)f2bf(o); }
            __syncthreads();
        }
    }
}
__device__ __forceinline__ void phase_hgrn_norm(const float* norm_g, unsigned char* ws) {
    const int tid = threadIdx.x, lane = tid & 63, wave = tid >> 6;
    const int gw = blockIdx.x * NWAVES + wave, NGW = gridDim.x * NWAVES;
    const bf16* O = (const bf16*)(ws + WS_O); const bf16* CG = (const bf16*)(ws + WS_CG); bf16* Y2 = (bf16*)(ws + WS_Y2);
    for (int t = gw; t < T; t += NGW) {
        const v4u a0 = *((const GAS v4u*)(O + (size_t)t * D) + lane * 2), a1 = *((const GAS v4u*)(O + (size_t)t * D) + lane * 2 + 1);
        const v4u g0 = *((const GAS v4u*)(CG + (size_t)t * D) + lane * 2), g1 = *((const GAS v4u*)(CG + (size_t)t * D) + lane * 2 + 1);
        float o[16], gv[16];
        o[0] = bflo(a0.x); o[1] = bfhi(a0.x); o[2] = bflo(a0.y); o[3] = bfhi(a0.y); o[4] = bflo(a0.z); o[5] = bfhi(a0.z); o[6] = bflo(a0.w); o[7] = bfhi(a0.w);
        o[8] = bflo(a1.x); o[9] = bfhi(a1.x); o[10] = bflo(a1.y); o[11] = bfhi(a1.y); o[12] = bflo(a1.z); o[13] = bfhi(a1.z); o[14] = bflo(a1.w); o[15] = bfhi(a1.w);
        gv[0] = bflo(g0.x); gv[1] = bfhi(g0.x); gv[2] = bflo(g0.y); gv[3] = bfhi(g0.y); gv[4] = bflo(g0.z); gv[5] = bfhi(g0.z); gv[6] = bflo(g0.w); gv[7] = bfhi(g0.w);
        gv[8] = bflo(g1.x); gv[9] = bfhi(g1.x); gv[10] = bflo(g1.y); gv[11] = bfhi(g1.y); gv[12] = bflo(g1.z); gv[13] = bfhi(g1.z); gv[14] = bflo(g1.w); gv[15] = bfhi(g1.w);
        float sq = 0.f;
#pragma unroll
        for (int j = 0; j < 16; ++j) sq += o[j] * o[j];
        sq += __shfl_xor(sq, 1); sq += __shfl_xor(sq, 2); sq += __shfl_xor(sq, 4);
        const float r = 1.f / sqrtf(sq * (1.f / 128.f) + LN_EPS);
        float y[16];
#pragma unroll
        for (int j = 0; j < 16; ++j) { const float sg = gv[j] / (1.f + expf(-gv[j])); y[j] = o[j] * r * norm_g[lane * 16 + j] * sg; }
        v4u w0, w1; w0.x = pk2(y[0], y[1]); w0.y = pk2(y[2], y[3]); w0.z = pk2(y[4], y[5]); w0.w = pk2(y[6], y[7]);
        w1.x = pk2(y[8], y[9]); w1.y = pk2(y[10], y[11]); w1.z = pk2(y[12], y[13]); w1.w = pk2(y[14], y[15]);
        *((GAS v4u*)(Y2 + (size_t)t * D) + lane * 2) = w0; *((GAS v4u*)(Y2 + (size_t)t * D) + lane * 2 + 1) = w1;
    }
}

struct Args { const float* in[16]; float* out; unsigned char* ws; int ph_lo, ph_hi, li, pad; };
__global__ void __launch_bounds__(NTHR, 2) mk_fwd(Args args) {
    extern __shared__ __attribute__((aligned(16))) unsigned char lds_raw[];
    LAS unsigned char* lds = (LAS unsigned char*)lds_raw;
    volatile LAS unsigned* MISC = (volatile LAS unsigned*)(lds + MISC_OFF);
    const int tid = threadIdx.x;
    unsigned char* ws = args.ws;
    gu32* ctl = (gu32*)(ws + WS_CTL);
    if (tid < 32) ((LAS unsigned*)(lds + MISC_OFF))[tid] = 0u;
    __syncthreads();
    XcdBarrier bar; bar.bar = (unsigned*)ctl + CW_BAR; bar.x = 0; bar.st = nullptr;
    if (N_LAUNCHES == 1) bar = xcd_barrier_post((unsigned*)ctl + CW_BAR, MISC + 8);
    const int lo = args.ph_lo, hi = args.ph_hi;
#define IN(k) (lo <= (k) && (k) < hi)
#define SEAM(k) do { if (IN(k) && IN((k) + 1)) xcd_barrier(bar); } while (0)
    const float* const* in = args.in;
    bf16* XB = (bf16*)(ws + WS_XB); bf16* H0 = (bf16*)(ws + WS_H0); bf16* Y = (bf16*)(ws + WS_Y); bf16* H1 = (bf16*)(ws + WS_H1);
    int* EID = (int*)(ws + WS_EID); float* GATE = (float*)(ws + WS_GATE);
    float* Z = args.out;

    if (IN(0)) { phase_prologue(lds, in, ws); phase_convert_tables(in[12], in[13], ws); } SEAM(0);
    if (IN(1)) { pg8::Gemm g{XB, (const bf16*)(ws + WS_WABIN), T, AB_IN, D}; pg8::StaticOrder S; S.init(T, AB_IN, (int)gridDim.x, (int)blockIdx.x); pg8::EpiBf16<0> E{H0, AB_IN, nullptr, 0, 0, 1.f};
                 pg8::gemm_phase<pg8::EpiBf16<0>, pg8::StaticOrder, true, true>(lds, g, S, E); } SEAM(1);
    if (IN(2)) { phase_ret_local(lds, ws); } SEAM(2);
    if (IN(3)) { phase_ret_prefix(ws); } SEAM(3);
    if (IN(4)) { phase_ret_out_pool(lds, in, ws); } SEAM(4);
    if (IN(5)) { pg8::Gemm g{Y, (const bf16*)(ws + WS_WABOUT), T, D, D}; pg8::StaticOrder S; S.init(T, D, (int)gridDim.x, (int)blockIdx.x); pg8::EpiResidF32 E{XB, Z};
                 pg8::gemm_phase<pg8::EpiResidF32, pg8::StaticOrder, true, true>(lds, g, S, E); } SEAM(5);
    if (IN(6)) { phase_ln(Z, H1, in[14], in[15]); } SEAM(6);
    if (IN(7)) { pg8::Gemm g{H1, (const bf16*)(ws + WS_WQ), T, 2048, D}; pg8::StaticOrder S; S.init(T, 2048, (int)gridDim.x, (int)blockIdx.x); pg8::EpiBf16<0> E{H0  , 2048, nullptr, 0, 0, 1.f};
                 pg8::gemm_phase<pg8::EpiBf16<0>, pg8::StaticOrder, true, true>(lds, g, S, E); } SEAM(7);
    if (IN(8)) { phase_topk(lds, H0, in[11], EID, GATE); } SEAM(8);
    if (IN(9)) { phase_gather8<false>(H1, EID, GATE, ws + WS_U8, ws + WS_V8, (const float*)(ws + WS_DQU), (const float*)(ws + WS_DQV), in[14] + D, in[15] + D, XB  , nullptr); } SEAM(9);
    if (IN(10)) { EpiCIn E{(bf16*)(ws + WS_CQ), (bf16*)(ws + WS_CK), (bf16*)(ws + WS_CV), (bf16*)(ws + WS_CG), (const float*)(ws + WS_LB)};
                  (void)E; pg8::Gemm g{XB, (const bf16*)(ws + WS_WCIN), T, C_IN, D}; pg8::StaticOrder S; S.init(T, C_IN, (int)gridDim.x, (int)blockIdx.x);
                  pg8::EpiCInF E2{(bf16*)(ws + WS_CQ), (bf16*)(ws + WS_CK), (bf16*)(ws + WS_CV), (bf16*)(ws + WS_CG), (const float*)(ws + WS_LB)};
                  pg8::gemm_phase<pg8::EpiCInF, pg8::StaticOrder, true, true>(lds, g, S, E2); } SEAM(10);
    if (IN(11)) { phase_hgrn(lds, ws); } SEAM(11);
    if (IN(12)) { phase_hgrn_norm(in[8], ws); } SEAM(12);
    if (IN(13)) { pg8::Gemm g{(const bf16*)(ws + WS_Y2), (const bf16*)(ws + WS_WCOUT), T, D, D}; pg8::StaticOrder S; S.init(T, D, (int)gridDim.x, (int)blockIdx.x); pg8::EpiResidF32 E{XB, Z};
                  pg8::gemm_phase<pg8::EpiResidF32, pg8::StaticOrder, true, true>(lds, g, S, E); } SEAM(13);
    if (IN(14)) { phase_ln(Z, H1  , in[14] + 2 * D, in[15] + 2 * D); } SEAM(14);
    if (IN(15)) { pg8::Gemm g{H1, (const bf16*)(ws + WS_WQ) + (size_t)2048 * D, T, 2048, D}; pg8::StaticOrder S; S.init(T, 2048, (int)gridDim.x, (int)blockIdx.x); pg8::EpiBf16<0> E{(bf16*)(ws + WS_Q1), 2048, nullptr, 0, 0, 1.f};
                  pg8::gemm_phase<pg8::EpiBf16<0>, pg8::StaticOrder, true, true>(lds, g, S, E); } SEAM(15);
    if (IN(16)) { phase_topk(lds, (const bf16*)(ws + WS_Q1), in[11] + (size_t)8 * 2 * 128 * 128, EID, GATE); } SEAM(16);
    if (IN(17)) { phase_gather8<true>(H1, EID, GATE, ws + WS_U8 + (size_t)NEXP * 1024, ws + WS_V8 + (size_t)NEXP * 1024, (const float*)(ws + WS_DQU) + NEXP, (const float*)(ws + WS_DQV) + NEXP, in[14] + 3 * D, in[15] + 3 * D, nullptr, args.out); }
#undef IN
#undef SEAM
}

extern "C" void kernel_launch(void* const* d_in, const int* in_sizes, int n_in, void* d_out, int out_size, void* d_ws, size_t ws_size, hipStream_t stream) {
    static int grid = 0;
    if (grid == 0) {
        if (n_in != 16 || in_sizes[0] != T * D || out_size != T * D || ws_size < WS_END) { fprintf(stderr, "kernel_launch: unexpected problem (n_in %d, in0 %d, out %d, ws %zu); nothing launched\n", n_in, n_in > 0 ? in_sizes[0] : -1, out_size, ws_size); grid = -1; return; }
        int dev = 0, cus = 0;
        if (hipGetDevice(&dev) != hipSuccess || hipDeviceGetAttribute(&cus, hipDeviceAttributeMultiprocessorCount, dev) != hipSuccess) { grid = -1; return; }
        if (hipFuncSetAttribute((const void*)mk_fwd, hipFuncAttributeMaxDynamicSharedMemorySize, LDS_BYTES) != hipSuccess) { fprintf(stderr, "kernel_launch: hipFuncSetAttribute failed\n"); grid = -1; return; }
        (void)hipGetLastError();
        grid = cus;
    }
    if (grid < 0) return;
    if (hipMemsetAsync((char*)d_ws + WS_CTL, 0, CTL_ZERO_BYTES, stream) != hipSuccess) return;
    Args a{};
    for (int i = 0; i < 16; ++i) a.in[i] = (const float*)d_in[i];
    a.out = (float*)d_out; a.ws = (unsigned char*)d_ws;
    for (int li = 0; li < N_LAUNCHES; ++li) {
        a.ph_lo = (N_LAUNCHES == 1) ? 0 : li; a.ph_hi = (N_LAUNCHES == 1) ? NPHASE : li + 1; a.li = li;
        hipLaunchKernelGGL(mk_fwd, dim3(grid), dim3(NTHR), LDS_BYTES, stream, a);
        if (hipPeekAtLastError() != hipSuccess) { fprintf(stderr, "kernel_launch: launch %d failed\n", li); break; }
    }
}
```

```cpp
#include <hip/hip_runtime.h>
#include <cstdio>
#include <cstdint>

#ifndef MK_N_LAUNCHES
#define MK_N_LAUNCHES 1
#endif
constexpr int NPHASE = 18;
#ifndef DUP_MASK
#define DUP_MASK 0u
#endif
constexpr int N_LAUNCHES = MK_N_LAUNCHES;

constexpr int BATCH = 8, SEQ = 4096, D = 1024, T = BATCH * SEQ;
constexpr int AB_IN = 2048, C_IN = 4096, NEXP = 16384;
constexpr float LN_EPS = 1e-5f;
constexpr float ALPHA = 1.41421356237309515f;
constexpr int NWAVES = 8, NTHR = 512;

constexpr size_t MiB = 1u << 20;
constexpr size_t WS_CTL = 0, CTL_ZERO_BYTES = 1 * MiB;
constexpr size_t WS_LB = 1 * MiB;
constexpr size_t WS_ROPE = 2 * MiB;
constexpr size_t WS_WABIN = 4 * MiB;
constexpr size_t WS_WABOUT = 8 * MiB;
constexpr size_t WS_WCIN = 10 * MiB;
constexpr size_t WS_WCOUT = 18 * MiB;
constexpr size_t WS_WQ = 20 * MiB;
constexpr size_t WS_KEYS = 28 * MiB;
constexpr size_t WS_DQU = 29 * MiB;
constexpr size_t WS_DQV = 29 * MiB + 131072;
constexpr size_t WS_U8 = 32 * MiB;
constexpr size_t WS_V8 = 64 * MiB;
constexpr size_t WS_XB = 96 * MiB;
constexpr size_t WS_H0 = 160 * MiB;
constexpr size_t WS_LST = 288 * MiB;
constexpr size_t WS_Y = 320 * MiB;
constexpr size_t WS_H1 = 384 * MiB;
constexpr size_t WS_EID = 448 * MiB;
constexpr size_t WS_GATE = 464 * MiB;
constexpr size_t WS_CQ = 160 * MiB, WS_CK = 224 * MiB, WS_CV = 288 * MiB, WS_CG = 352 * MiB;
constexpr size_t WS_O = 416 * MiB;
constexpr size_t WS_Y2 = 160 * MiB;
constexpr size_t WS_Q1 = 224 * MiB;
constexpr size_t WS_END = 480 * MiB;

constexpr int CW_BAR = 4096;
constexpr int LDS_BYTES = 147456;
constexpr int MISC_OFF = LDS_BYTES - 128;

#define GAS __attribute__((address_space(1)))
#define LAS __attribute__((address_space(3)))
typedef unsigned short bf16;
typedef unsigned v4u __attribute__((ext_vector_type(4)));
typedef unsigned v2u __attribute__((ext_vector_type(2)));
typedef float f32x4 __attribute__((ext_vector_type(4)));
typedef GAS unsigned gu32;
#define RLX_AGENT __ATOMIC_RELAXED, __HIP_MEMORY_SCOPE_AGENT
#define LDS_WAIT() asm volatile("s_waitcnt lgkmcnt(0)" ::: "memory")
__device__ __forceinline__ unsigned f2bf(float f) { unsigned u = __builtin_bit_cast(unsigned, f); return (u + 0x7fffu + ((u >> 16) & 1u)) >> 16; }
__device__ __forceinline__ unsigned pk2(float lo, float hi) { return f2bf(lo) | (f2bf(hi) << 16); }
__device__ __forceinline__ float bf2f(unsigned b) { return __builtin_bit_cast(float, b << 16); }
__device__ __forceinline__ float bflo(unsigned w) { return __builtin_bit_cast(float, w << 16); }
__device__ __forceinline__ float bfhi(unsigned w) { return __builtin_bit_cast(float, w & 0xffff0000u); }
__device__ __forceinline__ float wave_sum(float v) {
#pragma unroll
    for (int o = 1; o < 64; o <<= 1) v += __shfl_xor(v, o);
    return v;
}

#define XB_TMO      128
#define XB_XCNT(j)  (256  + 64 * (j))
#define XB_XSUB(j)  (1280 + 64 * (j))
#define XB_XGEN(j)  (2304 + 64 * (j))
#define XB_TOP      3328
#define XB_TOPGEN   3392
#define XCD_BAR_WORDS 3456
#define XB_SPIN_CAP (1u << 21)
__device__ __forceinline__ unsigned xb_ld(unsigned* p)              { return __hip_atomic_load(p, __ATOMIC_RELAXED, __HIP_MEMORY_SCOPE_AGENT); }
__device__ __forceinline__ unsigned xb_add(unsigned* p, unsigned v) { return __hip_atomic_fetch_add(p, v, __ATOMIC_RELAXED, __HIP_MEMORY_SCOPE_AGENT); }
__device__ __forceinline__ unsigned xb_xcc_id() { return (unsigned)__builtin_amdgcn_s_getreg((3 << 11) | 20) & 0xFu; }
#define XB_SPIN(cond, bar) do { unsigned _sp = 0; while (cond) { __builtin_amdgcn_s_sleep(1); \
    if ((++_sp & 255u) == 0u) { if (xb_ld(&(bar)[XB_TMO])) break; if (_sp > XB_SPIN_CAP) { atomicAdd(&(bar)[XB_TMO], 1u); break; } } } } while (0)
struct XcdBarrier { unsigned* bar; unsigned x; volatile LAS unsigned* st; };
__device__ __forceinline__ XcdBarrier xcd_barrier_post(unsigned* bar, volatile LAS unsigned* st) {
    XcdBarrier b; b.bar = bar; b.x = xb_xcc_id(); b.st = st;
    if (threadIdx.x == 0) (void)xb_add(&bar[XB_XCNT(b.x)], 1u);
    return b;
}
__device__ __forceinline__ void xcd_barrier_complete(unsigned* bar, unsigned x, unsigned& nloc, unsigned& nx) {
    const unsigned G = gridDim.x * gridDim.y * gridDim.z;
    unsigned sum, cnt, mine, sp = 0u;
    for (;;) {
        sum = 0u; cnt = 0u; mine = 0u;
#pragma unroll
        for (unsigned j = 0; j < 16; ++j) { const unsigned c = xb_ld(&bar[XB_XCNT(j)]); sum += c; cnt += (c > 0u) ? 1u : 0u; mine = (j == x) ? c : mine; }
        if (sum == G) break;
        __builtin_amdgcn_s_sleep(1);
        if ((++sp & 255u) == 0u) { if (xb_ld(&bar[XB_TMO])) break; if (sp > XB_SPIN_CAP) { atomicAdd(&bar[XB_TMO], 1u); break; } }
    }
    nloc = mine > 0u ? mine : 1u; nx = cnt > 0u ? cnt : 1u;
}
__device__ __forceinline__ void xcd_barrier(const XcdBarrier& b) {
    asm volatile("s_waitcnt vmcnt(0)" ::: "memory");
    __syncthreads();
    if (threadIdx.x == 0) {
        unsigned* bar = b.bar;
        __builtin_amdgcn_s_waitcnt(0);
        unsigned nloc = b.st[0], nx = b.st[1];
        if (nloc == 0u) { xcd_barrier_complete(bar, b.x, nloc, nx); b.st[0] = nloc; b.st[1] = nx; }
        const unsigned old = xb_add(&bar[XB_XSUB(b.x)], 1u);
        const unsigned gen = old / nloc;
        if (old + 1u == (gen + 1u) * nloc) {
            __builtin_amdgcn_fence(__ATOMIC_RELEASE, "agent");
            asm volatile("s_waitcnt vmcnt(0)" ::: "memory");
            const unsigned og = xb_add(&bar[XB_TOP], 1u);
            const unsigned tg = og / nx;
            if (og + 1u == (tg + 1u) * nx) xb_add(&bar[XB_TOPGEN], 1u);
            else XB_SPIN(xb_ld(&bar[XB_TOPGEN]) == tg, bar);
            __builtin_amdgcn_fence(__ATOMIC_ACQUIRE, "agent");
            xb_add(&bar[XB_XGEN(b.x)], 1u);
            asm volatile("s_waitcnt vmcnt(0)" ::: "memory");
        } else {
            XB_SPIN(xb_ld(&bar[XB_XGEN(b.x)]) == gen, bar);
            __builtin_amdgcn_fence(__ATOMIC_ACQUIRE, "agent");
            asm volatile("s_waitcnt vmcnt(0)" ::: "memory");
        }
    }
    __syncthreads();
}

__device__ __forceinline__ void p0_transpose_item(const float* W, int K, int N, bf16* WT, LAS float* scr, int item, int lane) {
    const int nblk = N / 32, kb = item / nblk, nb = item % nblk, k0 = 64 * kb, n0 = 32 * nb;
#pragma unroll 8
    for (int i = 0; i < 32; ++i) { const int kk = 2 * i + (lane >> 5); scr[kk * 33 + (lane & 31)] = W[(size_t)(k0 + kk) * N + n0 + (lane & 31)]; }
    LDS_WAIT(); asm volatile("" ::: "memory");
    const int c = lane & 7;
#pragma unroll
    for (int j = 0; j < 4; ++j) { const int n = (lane >> 3) + 8 * j; const LAS float* s = scr + (8 * c) * 33 + n;
        v4u o; o.x = pk2(s[0 * 33], s[1 * 33]); o.y = pk2(s[2 * 33], s[3 * 33]); o.z = pk2(s[4 * 33], s[5 * 33]); o.w = pk2(s[6 * 33], s[7 * 33]);
        *(GAS v4u*)(WT + (size_t)(n0 + n) * K + k0 + 8 * c) = o; }
    LDS_WAIT(); asm volatile("" ::: "memory");
}

template <class Epi>
__device__ __forceinline__ void gemm_naive(LAS unsigned char* lds, const bf16* A, const bf16* Bt, int M, int N, int K, const Epi& E) {
    LAS float* As = (LAS float*)lds;
    LAS float* Bs = As + 128 * 33;
    const int tid = threadIdx.x, tx = tid & 15, ty = tid >> 4;
    const int ntn = N / 128, ntiles = (M / 128) * ntn;
    for (int tile = blockIdx.x; tile < ntiles; tile += gridDim.x) {
        const int tm = tile / ntn, tn = tile % ntn;
        float acc[4][8];
#pragma unroll
        for (int i = 0; i < 4; ++i)
#pragma unroll
            for (int j = 0; j < 8; ++j) acc[i][j] = 0.f;
        for (int k0 = 0; k0 < K; k0 += 32) {
            { const int r = tid >> 2, kc = (tid & 3) * 8;
              const v4u va = *(const GAS v4u*)(A + (size_t)(tm * 128 + r) * K + k0 + kc);
              const v4u vb = *(const GAS v4u*)(Bt + (size_t)(tn * 128 + r) * K + k0 + kc);
              LAS float* pa = As + r * 33 + kc; LAS float* pb = Bs + r * 33 + kc;
              pa[0] = bflo(va.x); pa[1] = bfhi(va.x); pa[2] = bflo(va.y); pa[3] = bfhi(va.y); pa[4] = bflo(va.z); pa[5] = bfhi(va.z); pa[6] = bflo(va.w); pa[7] = bfhi(va.w);
              pb[0] = bflo(vb.x); pb[1] = bfhi(vb.x); pb[2] = bflo(vb.y); pb[3] = bfhi(vb.y); pb[4] = bflo(vb.z); pb[5] = bfhi(vb.z); pb[6] = bflo(vb.w); pb[7] = bfhi(vb.w); }
            __syncthreads();
#pragma unroll 8
            for (int kk = 0; kk < 32; ++kk) {
                float a[4], b[8];
#pragma unroll
                for (int i = 0; i < 4; ++i) a[i] = As[(ty * 4 + i) * 33 + kk];
#pragma unroll
                for (int j = 0; j < 8; ++j) b[j] = Bs[(tx + 16 * j) * 33 + kk];
#pragma unroll
                for (int i = 0; i < 4; ++i)
#pragma unroll
                    for (int j = 0; j < 8; ++j) acc[i][j] += a[i] * b[j];
            }
            __syncthreads();
        }
#pragma unroll
        for (int i = 0; i < 4; ++i)
#pragma unroll
            for (int j = 0; j < 8; ++j) E(tm * 128 + ty * 4 + i, tn * 128 + tx + 16 * j, acc[i][j]);
    }
}
struct EpiStore { bf16* O; int ldc;
    __device__ __forceinline__ void operator()(int r, int c, float v) const { O[(size_t)r * ldc + c] = (bf16)f2bf(v); } };
struct EpiResid { const bf16* X; float* Z;
    __device__ __forceinline__ void operator()(int r, int c, float v) const { Z[(size_t)r * D + c] = ALPHA * bf2f(X[(size_t)r * D + c]) + v; } };
struct EpiCIn { bf16 *CQ, *CK, *CV, *CG; const float* lb;
    __device__ __forceinline__ void operator()(int r, int c, float v) const {
        const int seg = c >> 10, cc = c & 1023; const size_t o = (size_t)r * D + cc;
        if (seg == 0) CQ[o] = (bf16)f2bf(v);
        else if (seg == 1) { const float k = (1.f - lb[cc]) / (1.f + expf(v)); CK[o] = (bf16)f2bf(k); }
        else if (seg == 2) CV[o] = (bf16)f2bf(v);
        else CG[o] = (bf16)f2bf(v);
    } };

namespace pg8 {
#define PG8_LAS __attribute__((address_space(3)))
typedef unsigned short bf16_t;
typedef short bf16x8 __attribute__((ext_vector_type(8)));
typedef float f32x4 __attribute__((ext_vector_type(4)));
typedef unsigned u32x4 __attribute__((ext_vector_type(4)));
constexpr int BM = 256, BK = 64, HALF = 128, HTB = HALF * BK * 2  , STAGE_BYTES = 8 * HTB, NXCD = 8, WGM = 8;

__host__ __device__ __forceinline__ int lds_byte(int r, int c) { const int st = (r >> 4) * 2 + (c >> 5), rr = r & 15, cc = c & 31, ob = rr * 64 + cc * 2; return st * 1024 + (ob ^ (((ob >> 9) & 1) << 5)); }
__host__ __device__ __forceinline__ void stage_rc(int b, int& R, int& C) { const int st = b / 1024, sb = b % 1024, swz = sb ^ (((sb >> 9) & 1) << 5); R = (st >> 1) * 16 + swz / 64; C = (st & 1) * 32 + (swz % 64) / 2; }
__host__ __device__ __forceinline__ int perm32(int rho) { const int n = rho >> 4, i = rho & 15; return 8 * (i >> 2) + 4 * n + (i & 3); }

struct Unit { int pm, pn; };
struct Gemm { const bf16_t* A; const bf16_t* Bt; int M, N, K; };

struct StaticOrder {
    int nM, nN, nwg, G, c;
    __host__ __device__ void init(int M, int N, int G_, int c_) { nM = M / BM; nN = N / BM; nwg = nM * nN; G = G_; c = c_; }
    __host__ __device__ bool next(int i, Unit& u) const {
        const long L = (long)i * G + c; if (L >= nwg) return false;
        int wgid = (int)L; { const int q = nwg / NXCD, r = nwg % NXCD, xcd = wgid % NXCD, off = wgid / NXCD; wgid = (xcd < r ? xcd * (q + 1) : r * (q + 1) + (xcd - r) * q) + off; }
        const int nig = WGM * nN, gid = wgid / nig, fm = gid * WGM, gsz = (nM - fm) < WGM ? (nM - fm) : WGM;
        u.pm = fm + ((wgid % nig) % gsz); u.pn = (wgid % nig) / gsz; return true;
    }
    __device__ __forceinline__ void a_ready(const Unit&) const {}
    __device__ __forceinline__ void done(const Unit&) const {}
};

__device__ __forceinline__ unsigned cvt_pk_bf16(float lo, float hi) { unsigned r; asm volatile("v_cvt_pk_bf16_f32 %0, %1, %2" : "=v"(r) : "v"(lo), "v"(hi)); return r; }
typedef float f32x2 __attribute__((ext_vector_type(2)));
__device__ __forceinline__ f32x2 gelu_pk(f32x2 v) {
    const f32x2 av = __builtin_elementwise_abs(v), d = av * 0.2316418882f + 1.0f;
    f32x2 t; t.x = __builtin_amdgcn_rcpf(d.x); t.y = __builtin_amdgcn_rcpf(d.y);
    f32x2 q = t * 0.5307027145f + (-0.7265760135f); q = q * t + 0.7107068705f; q = q * t + (-0.142248368f); q = q * t + 0.127414796f; q = q * t;
    const f32x2 s = (v * v) * (-0.72134752044f);
    f32x2 e; e.x = __builtin_amdgcn_exp2f(s.x); e.y = __builtin_amdgcn_exp2f(s.y);
    const f32x2 m = v * (q * e), r = v - m;
    f32x2 o; o.x = v.x < 0.f ? m.x : r.x; o.y = v.y < 0.f ? m.y : r.y; return o;
}

template <int ACT  > struct EpiBf16 {
    static constexpr bool PERM = true, AFTER_DRAIN = false; static_assert(ACT == 0 || ACT == 1, "EpiBf16: ACT is 0 (none) or 1 (gelu_pk)");
    bf16_t* O; int ldc; const float* bias; int split_cols; size_t split_stride; float scale0;
    __device__ __forceinline__ void operator()(const f32x4 (&acc)[2][2][4][2], const Unit& u, int wr, int wc, int fr, int fq) const {
        const int row0 = u.pm * BM + wr * 64 + fr; int colt = u.pn * BM; bf16_t* base = O;
        float sc = 1.f; if (split_cols) { const int t = colt / split_cols; base += (size_t)t * split_stride; colt -= t * split_cols; if (t == 0) sc = scale0; }
        const int col0 = colt + wc * 32 + 8 * fq, bcol0 = u.pn * BM + wc * 32 + 8 * fq;
        f32x4 bv[2][2];
#pragma unroll
        for (int bj = 0; bj < 2; ++bj)
#pragma unroll
            for (int n = 0; n < 2; ++n) bv[bj][n] = bias ? *(const f32x4*)(bias + bcol0 + bj * HALF + 4 * n) : (f32x4){0.f, 0.f, 0.f, 0.f};
#pragma unroll
        for (int ai = 0; ai < 2; ++ai)
#pragma unroll
            for (int m = 0; m < 4; ++m) { bf16_t* rowp = base + (size_t)(row0 + ai * HALF + m * 16) * ldc + col0;
#pragma unroll
                for (int bj = 0; bj < 2; ++bj) { f32x4 v0 = acc[ai][bj][m][0] + bv[bj][0], v1 = acc[ai][bj][m][1] + bv[bj][1];
                    if (ACT == 1) { f32x2 a = gelu_pk((f32x2){v0[0], v0[1]}), b = gelu_pk((f32x2){v0[2], v0[3]}), c = gelu_pk((f32x2){v1[0], v1[1]}), d = gelu_pk((f32x2){v1[2], v1[3]});
                        v0 = (f32x4){a.x, a.y, b.x, b.y}; v1 = (f32x4){c.x, c.y, d.x, d.y}; }
                    v0 = v0 * sc; v1 = v1 * sc; u32x4 w; w.x = cvt_pk_bf16(v0[0], v0[1]); w.y = cvt_pk_bf16(v0[2], v0[3]); w.z = cvt_pk_bf16(v1[0], v1[1]); w.w = cvt_pk_bf16(v1[2], v1[3]);
                    *(u32x4*)(rowp + bj * HALF) = w; } }
    }
};

struct EpiResidF32 {
    static constexpr bool PERM = false, AFTER_DRAIN = false;
    const bf16_t* X; float* Z;
    __device__ __forceinline__ void operator()(const f32x4 (&acc)[2][2][4][2], const Unit& u, int wr, int wc, int fr, int fq) const {
        typedef unsigned u32x2 __attribute__((ext_vector_type(2)));
        const int row0 = u.pm * BM + wr * 64 + fr, col0 = u.pn * BM + wc * 32 + 4 * fq;
#pragma unroll
        for (int ai = 0; ai < 2; ++ai)
#pragma unroll
            for (int m = 0; m < 4; ++m) { const size_t ro = (size_t)(row0 + ai * HALF + m * 16) * 1024;
#pragma unroll
                for (int bj = 0; bj < 2; ++bj)
#pragma unroll
                    for (int n = 0; n < 2; ++n) { const int c = col0 + bj * HALF + n * 16; const u32x2 xw = *(const u32x2*)(X + ro + c);
                        f32x4 xv; xv[0] = __builtin_bit_cast(float, xw.x << 16); xv[1] = __builtin_bit_cast(float, xw.x & 0xffff0000u); xv[2] = __builtin_bit_cast(float, xw.y << 16); xv[3] = __builtin_bit_cast(float, xw.y & 0xffff0000u);
                        *(f32x4*)(Z + ro + c) = xv * 1.41421356237309515f + acc[ai][bj][m][n]; } }
    }
};
struct EpiCInF {
    static constexpr bool PERM = true, AFTER_DRAIN = false;
    bf16_t *CQ, *CK, *CV, *CG; const float* lb;
    __device__ __forceinline__ void operator()(const f32x4 (&acc)[2][2][4][2], const Unit& u, int wr, int wc, int fr, int fq) const {
        const int seg = u.pn >> 2, colt = (u.pn & 3) * BM;
        bf16_t* base = seg == 0 ? CQ : (seg == 1 ? CK : (seg == 2 ? CV : CG));
        const int row0 = u.pm * BM + wr * 64 + fr, col0 = colt + wc * 32 + 8 * fq;
        f32x4 om[2][2];
#pragma unroll
        for (int bj = 0; bj < 2; ++bj)
#pragma unroll
            for (int n = 0; n < 2; ++n) { const f32x4 l = *(const f32x4*)(lb + col0 + bj * HALF + 4 * n); om[bj][n] = 1.0f - l; }
#pragma unroll
        for (int ai = 0; ai < 2; ++ai)
#pragma unroll
            for (int m = 0; m < 4; ++m) { bf16_t* rowp = base + (size_t)(row0 + ai * HALF + m * 16) * 1024 + col0;
#pragma unroll
                for (int bj = 0; bj < 2; ++bj) { f32x4 v0 = acc[ai][bj][m][0], v1 = acc[ai][bj][m][1];
                    if (seg == 1) {
#pragma unroll
                        for (int q = 0; q < 4; ++q) { v0[q] = om[bj][0][q] / (1.0f + __expf(v0[q])); v1[q] = om[bj][1][q] / (1.0f + __expf(v1[q])); } }
                    u32x4 w; w.x = cvt_pk_bf16(v0[0], v0[1]); w.y = cvt_pk_bf16(v0[2], v0[3]); w.z = cvt_pk_bf16(v1[0], v1[1]); w.w = cvt_pk_bf16(v1[2], v1[3]);
                    *(u32x4*)(rowp + bj * HALF) = w; } }
    }
};
template <class Epi, class Sched, bool ALIGN_EPI = false, bool SP2 = false>
__device__ __forceinline__ void gemm_phase(PG8_LAS unsigned char* lds, const Gemm g, const Sched& S, const Epi& E) {
    const int tid = threadIdx.x, wid = __builtin_amdgcn_readfirstlane(tid >> 6), lane = tid & 63, wr = wid >> 2, wc = wid & 3, fr = lane & 15, fq = lane >> 4;
    const int K = g.K, nt = K / BK;
    unsigned voffA[2], voffB[2];
#pragma unroll
    for (int i = 0; i < 2; ++i) { int R, C; stage_rc(tid * 16 + i * 8192, R, C); const int Rb = Epi::PERM ? ((R & ~31) + perm32(R & 31)) : R;
        voffA[i] = (unsigned)(R * K + C) * 2u; voffB[i] = (unsigned)(Rb * K + C) * 2u; }
    const size_t kstep = (size_t)(BK * 2);
    const size_t hstep = (size_t)HALF * K * 2;
    const size_t tstep = 2 * hstep;
    const unsigned ldsw = (unsigned)wid * 1024u;
    const int aoff = lds_byte(wr * 64 + fr, fq * 8), boff = lds_byte(wc * 32 + fr, fq * 8);
#define PG8_SA(b, h) (((b) * 2 + (h)) * HTB)
#define PG8_SB(b, h) ((4 + (b) * 2 + (h)) * HTB)
#define PG8_STAGE(bufoff, gbase, voff) do { _Pragma("unroll") for (int _i = 0; _i < 2; ++_i) \
        __builtin_amdgcn_global_load_lds((const unsigned*)((const char*)(gbase) + (voff)[_i]), (PG8_LAS unsigned*)(lds + (bufoff) + ldsw + _i * 8192), 16, 0, 0); } while (0)
#define PG8_LDA(dst, b, h) do { _Pragma("unroll") for (int m = 0; m < 4; ++m) _Pragma("unroll") for (int k = 0; k < 2; ++k) dst[m][k] = *(const PG8_LAS bf16x8*)(lds + PG8_SA(b, h) + aoff + m * 2048 + k * 1024); } while (0)
#define PG8_LDB(dst, b, h) do { _Pragma("unroll") for (int n = 0; n < 2; ++n) _Pragma("unroll") for (int k = 0; k < 2; ++k) dst[n][k] = *(const PG8_LAS bf16x8*)(lds + PG8_SB(b, h) + boff + n * 2048 + k * 1024); } while (0)
#define PG8_MMA(ai, bj, At, Bt) do { __builtin_amdgcn_s_setprio(1); _Pragma("unroll") for (int m = 0; m < 4; ++m) _Pragma("unroll") for (int n = 0; n < 2; ++n) _Pragma("unroll") for (int k = 0; k < 2; ++k) \
        acc[ai][bj][m][n] = __builtin_amdgcn_mfma_f32_16x16x32_bf16(Bt[n][k], At[m][k], acc[ai][bj][m][n], 0, 0, 0); __builtin_amdgcn_s_setprio(0); } while (0)
#define PG8_WAIT_V(n) asm volatile("s_waitcnt vmcnt(" #n ")" ::: "memory")
#define PG8_WAIT_L(n) asm volatile("s_waitcnt lgkmcnt(" #n ")" ::: "memory")
#define PG8_BAR __builtin_amdgcn_s_barrier()
#define PG8_SCHED __builtin_amdgcn_sched_barrier(0)
    Unit cur, nxt; int ui = 0;
    if (!S.next(0, cur)) return;
    f32x4 acc[2][2][4][2];
#pragma unroll
    for (int a = 0; a < 2; ++a)
#pragma unroll
        for (int b = 0; b < 2; ++b)
#pragma unroll
            for (int m = 0; m < 4; ++m)
#pragma unroll
                for (int n = 0; n < 2; ++n) acc[a][b][m][n] = (f32x4){0.f, 0.f, 0.f, 0.f};
    bf16x8 At[4][2], B0[2][2], B1[2][2];
    const char* cA = (const char*)g.A + (size_t)cur.pm * tstep; const char* cB = (const char*)g.Bt + (size_t)cur.pn * tstep;
    S.a_ready(cur);
    if constexpr (SP2) {
        PG8_STAGE(PG8_SB(0, 0), cB, voffB); PG8_STAGE(PG8_SB(0, 1), cB + hstep, voffB); PG8_STAGE(PG8_SA(0, 0), cA, voffA); PG8_STAGE(PG8_SA(0, 1), cA + hstep, voffA);
        if (wr == 1) PG8_BAR;
        PG8_WAIT_V(2); PG8_BAR;
        PG8_STAGE(PG8_SB(1, 0), cB + kstep, voffB); PG8_STAGE(PG8_SA(1, 0), cA + kstep, voffA); PG8_STAGE(PG8_SB(1, 1), cB + hstep + kstep, voffB);
        PG8_WAIT_V(6); PG8_BAR;
    } else {
        PG8_STAGE(PG8_SB(0, 0), cB, voffB); PG8_STAGE(PG8_SA(0, 0), cA, voffA); PG8_STAGE(PG8_SB(0, 1), cB + hstep, voffB); PG8_STAGE(PG8_SA(0, 1), cA + hstep, voffA);
        if (wr == 1) PG8_BAR;
        PG8_WAIT_V(4); PG8_BAR;
        PG8_STAGE(PG8_SB(1, 0), cB + kstep, voffB); PG8_STAGE(PG8_SA(1, 0), cA + kstep, voffA); PG8_STAGE(PG8_SB(1, 1), cB + hstep + kstep, voffB);
        PG8_WAIT_V(6); PG8_BAR;
    }
    for (;;) {
        const bool has_next = S.next(ui + 1, nxt);
        const char* nA = has_next ? (const char*)g.A + (size_t)nxt.pm * tstep : cA; const char* nB = has_next ? (const char*)g.Bt + (size_t)nxt.pn * tstep : cB;
        for (int t = 0; t < nt; t += 2) {
            const bool last = (t == nt - 2);
            const char* a1 = cA + (size_t)(t + 1) * kstep;
            const char* a2 = last ? nA : cA + (size_t)(t + 2) * kstep; const char* b2 = last ? nB : cB + (size_t)(t + 2) * kstep;
            const char* a3 = a2 + kstep; const char* b3 = b2 + kstep;
            if (last && has_next) S.a_ready(nxt);
            if constexpr (SP2) {
            PG8_LDB(B0, 0, 0); PG8_LDB(B1, 0, 1); PG8_SCHED; PG8_LDA(At, 0, 0); PG8_STAGE(PG8_SA(1, 1), a1 + hstep, voffA);
            PG8_WAIT_V(8); PG8_WAIT_L(0); PG8_BAR; PG8_MMA(0, 0, At, B0); PG8_MMA(0, 1, At, B1); PG8_BAR; PG8_SCHED;
            PG8_LDA(At, 0, 1); PG8_STAGE(PG8_SB(0, 0), b2, voffB); PG8_STAGE(PG8_SB(0, 1), b2 + hstep, voffB); PG8_STAGE(PG8_SA(0, 0), a2, voffA);
            PG8_WAIT_V(8); PG8_WAIT_L(0); PG8_BAR; PG8_MMA(1, 0, At, B0); PG8_MMA(1, 1, At, B1); PG8_BAR; PG8_SCHED;
            PG8_LDB(B0, 1, 0); PG8_LDB(B1, 1, 1); PG8_SCHED; PG8_LDA(At, 1, 0); PG8_STAGE(PG8_SA(0, 1), a2 + hstep, voffA);
            PG8_WAIT_V(8); PG8_WAIT_L(0); PG8_BAR; PG8_MMA(0, 0, At, B0); PG8_MMA(0, 1, At, B1); PG8_BAR; PG8_SCHED;
            PG8_LDA(At, 1, 1); PG8_STAGE(PG8_SB(1, 0), b3, voffB); PG8_STAGE(PG8_SB(1, 1), b3 + hstep, voffB); PG8_STAGE(PG8_SA(1, 0), a3, voffA);
            PG8_WAIT_V(8); PG8_WAIT_L(0); PG8_BAR; PG8_MMA(1, 0, At, B0); PG8_MMA(1, 1, At, B1); PG8_BAR; PG8_SCHED;
            } else {
            PG8_LDB(B0, 0, 0); PG8_SCHED; PG8_LDA(At, 0, 0); PG8_STAGE(PG8_SA(1, 1), a1 + hstep, voffA);
            PG8_WAIT_L(8); PG8_BAR; PG8_WAIT_L(0); PG8_MMA(0, 0, At, B0); PG8_BAR; PG8_SCHED;
            PG8_LDB(B1, 0, 1); PG8_STAGE(PG8_SB(0, 0), b2, voffB);
            PG8_BAR; PG8_WAIT_L(0); PG8_MMA(0, 1, At, B1); PG8_BAR;
            PG8_LDA(At, 0, 1); PG8_STAGE(PG8_SA(0, 0), a2, voffA);
            PG8_BAR; PG8_WAIT_L(0); PG8_MMA(1, 0, At, B0); PG8_BAR; PG8_SCHED;
            PG8_STAGE(PG8_SB(0, 1), b2 + hstep, voffB);
            PG8_WAIT_V(6); PG8_BAR; PG8_MMA(1, 1, At, B1); PG8_BAR;
            PG8_LDB(B0, 1, 0); PG8_SCHED; PG8_LDA(At, 1, 0); PG8_STAGE(PG8_SA(0, 1), a2 + hstep, voffA);
            PG8_WAIT_L(8); PG8_BAR; PG8_WAIT_L(0); PG8_MMA(0, 0, At, B0); PG8_BAR; PG8_SCHED;
            PG8_LDB(B1, 1, 1); PG8_STAGE(PG8_SB(1, 0), b3, voffB);
            PG8_BAR; PG8_WAIT_L(0); PG8_MMA(0, 1, At, B1); PG8_BAR;
            PG8_LDA(At, 1, 1); PG8_STAGE(PG8_SA(1, 0), a3, voffA);
            PG8_BAR; PG8_WAIT_L(0); PG8_MMA(1, 0, At, B0); PG8_BAR; PG8_SCHED;
            PG8_STAGE(PG8_SB(1, 1), b3 + hstep, voffB);
            PG8_WAIT_V(6); PG8_BAR; PG8_MMA(1, 1, At, B1); PG8_BAR;
            }
        }
        if constexpr (ALIGN_EPI) { if (wr == 0) PG8_BAR; }
        if constexpr (!Epi::AFTER_DRAIN) { E(acc, cur, wr, wc, fr, fq); S.done(cur); }
        if (!has_next) break;
#pragma unroll
        for (int a = 0; a < 2; ++a)
#pragma unroll
            for (int b = 0; b < 2; ++b)
#pragma unroll
                for (int m = 0; m < 4; ++m)
#pragma unroll
                    for (int n = 0; n < 2; ++n) acc[a][b][m][n] = (f32x4){0.f, 0.f, 0.f, 0.f};
        cur = nxt; cA = nA; cB = nB; ++ui;
        if constexpr (ALIGN_EPI) { if (wr == 1) PG8_BAR; }
    }
    PG8_WAIT_V(0);
    if constexpr (!ALIGN_EPI) { if (wr == 0) PG8_BAR; }
    PG8_BAR;
    if constexpr (Epi::AFTER_DRAIN) { E.fused(acc, cur, wr, wc, fr, fq, lds, wid, lane); S.done(cur); }
#undef PG8_SA
#undef PG8_SB
#undef PG8_STAGE
#undef PG8_LDA
#undef PG8_LDB
#undef PG8_MMA
#undef PG8_WAIT_V
#undef PG8_WAIT_L
#undef PG8_BAR
#undef PG8_SCHED
}
}

__device__ __forceinline__ float gamma_log2(int h) { return log2f(1.f - exp2f(-5.f - (float)h)); }

__device__ __forceinline__ void phase_prologue(LAS unsigned char* lds, const float* const* in, unsigned char* ws) {
    const int tid = threadIdx.x, lane = tid & 63, wave = tid >> 6;
    const int gw = blockIdx.x * NWAVES + wave, NGW = gridDim.x * NWAVES;
    LAS float* scr = (LAS float*)(lds + wave * 16384);
    constexpr int I_ABIN = (D / 64) * (AB_IN / 32), I_SQ = (D / 64) * (D / 32), I_CIN = (D / 64) * (C_IN / 32), I_WQ = (D / 64) * (2048 / 32);
    constexpr int NITEMS = I_ABIN + I_SQ + I_CIN + I_SQ + 2 * I_WQ;
    for (int it = gw; it < NITEMS; it += NGW) {
        int r = it;
        if (r < I_ABIN) { p0_transpose_item(in[1], D, AB_IN, (bf16*)(ws + WS_WABIN), scr, r, lane); continue; } r -= I_ABIN;
        if (r < I_SQ) { p0_transpose_item(in[5], D, D, (bf16*)(ws + WS_WABOUT), scr, r, lane); continue; } r -= I_SQ;
        if (r < I_CIN) { p0_transpose_item(in[6], D, C_IN, (bf16*)(ws + WS_WCIN), scr, r, lane); continue; } r -= I_CIN;
        if (r < I_SQ) { p0_transpose_item(in[9], D, D, (bf16*)(ws + WS_WCOUT), scr, r, lane); continue; } r -= I_SQ;
        if (r < I_WQ) { p0_transpose_item(in[10], D, 2048, (bf16*)(ws + WS_WQ), scr, r, lane); continue; } r -= I_WQ;
        p0_transpose_item(in[10] + (size_t)D * 2048, D, 2048, (bf16*)(ws + WS_WQ) + (size_t)2048 * D, scr, r, lane);
    }
    const size_t gt = (size_t)blockIdx.x * NTHR + tid, NT = (size_t)gridDim.x * NTHR;
    { const float* x = in[0]; bf16* xb = (bf16*)(ws + WS_XB);
      for (size_t i = gt; i < (size_t)T * D / 8; i += NT) { const f32x4 a = *(const GAS f32x4*)(x + i * 8), b = *(const GAS f32x4*)(x + i * 8 + 4);
          v4u o; o.x = pk2(a.x, a.y); o.y = pk2(a.z, a.w); o.z = pk2(b.x, b.y); o.w = pk2(b.z, b.w); *(GAS v4u*)(xb + i * 8) = o; } }
    { const float* k = in[11]; bf16* kb = (bf16*)(ws + WS_KEYS);
      for (size_t i = gt; i < (size_t)2 * 8 * 2 * 128 * 128 / 8; i += NT) { const f32x4 a = *(const GAS f32x4*)(k + i * 8), b = *(const GAS f32x4*)(k + i * 8 + 4);
          v4u o; o.x = pk2(a.x, a.y); o.y = pk2(a.z, a.w); o.z = pk2(b.x, b.y); o.w = pk2(b.z, b.w); *(GAS v4u*)(kb + i * 8) = o; } }
    { float* ct = (float*)(ws + WS_ROPE); float* st = ct + 4096 * 32;
      for (size_t i = gt; i < (size_t)4096 * 32; i += NT) { const int pos = (int)(i >> 5), f = (int)(i & 31);
          const double inv = exp(-log(10000.0) * ((double)f / 31.0)); const double ang = (double)pos * inv;
          ct[i] = (float)cos(ang); st[i] = (float)sin(ang); } }
    { const float* l = in[7]; float* lb = (float*)(ws + WS_LB);
      for (size_t i = gt; i < 1024; i += NT) { const float a = l[i], b = l[1024 + i]; const float m = fmaxf(a, b); const float ea = expf(a - m), eb = expf(b - m); lb[i] = eb / (ea + eb); } }
}

__device__ __forceinline__ void phase_ret_local(LAS unsigned char* lds, unsigned char* ws) {
    const int tid = threadIdx.x;
    const bf16* H0 = (const bf16*)(ws + WS_H0); float* LST = (float*)(ws + WS_LST);
    const float* ct = (const float*)(ws + WS_ROPE); const float* st = ct + 4096 * 32;
    LAS float* kd = (LAS float*)lds;
    LAS float* vv = (LAS float*)(lds + 32768);
    for (int item = blockIdx.x; item < 1024; item += gridDim.x) {
        const int n = item & 31, h = (item >> 5) & 3, b = item >> 7;
        const size_t t0 = (size_t)b * SEQ + n * 128; const float lg = gamma_log2(h);
        for (int idx = tid; idx < 4096; idx += NTHR) { const int s = idx >> 5, i = idx & 31, pos = n * 128 + s;
            const bf16* row = H0 + (t0 + s) * AB_IN + 768 + h * 64;
            const float x1 = bf2f(row[i]), x2 = bf2f(row[i + 32]); const float c = ct[pos * 32 + i], sn = st[pos * 32 + i];
            const float dec = exp2f((float)(127 - s) * lg) * 0.125f;
            kd[s * 64 + i] = (x1 * c - x2 * sn) * dec; kd[s * 64 + i + 32] = (x2 * c + x1 * sn) * dec; }
        for (int idx = tid; idx < 16384; idx += NTHR) { const int s = idx >> 7, e = idx & 127; vv[idx] = bf2f(H0[(t0 + s) * AB_IN + 1024 + h * 128 + e]); }
        __syncthreads();
        const int e = tid & 127, dg = tid >> 7;
        float acc[16];
#pragma unroll
        for (int j = 0; j < 16; ++j) acc[j] = 0.f;
        for (int s = 0; s < 128; ++s) { const float v = vv[s * 128 + e];
#pragma unroll
            for (int j = 0; j < 16; ++j) acc[j] += kd[s * 64 + dg * 16 + j] * v; }
#pragma unroll
        for (int j = 0; j < 16; ++j) LST[(size_t)item * 8192 + (dg * 16 + j) * 128 + e] = acc[j];
        __syncthreads();
    }
}
__device__ __forceinline__ void phase_ret_prefix(unsigned char* ws) {
    float* LST = (float*)(ws + WS_LST);
    const size_t gt = (size_t)blockIdx.x * NTHR + threadIdx.x, NT = (size_t)gridDim.x * NTHR;
    for (size_t idx = gt; idx < (size_t)32 * 8192; idx += NT) { const int bh = (int)(idx >> 13), el = (int)(idx & 8191), h = bh & 3;
        const float g128 = exp2f(128.f * gamma_log2(h)); float S = 0.f;
        for (int n = 0; n < 32; ++n) { float* p = LST + ((size_t)(bh * 32 + n) * 8192 + el); const float tmp = *p; *p = S; S = S * g128 + tmp; } }
}
__device__ __forceinline__ void phase_ret_out_pool(LAS unsigned char* lds, const float* const* in, unsigned char* ws) {
    const int tid = threadIdx.x;
    const bf16* H0 = (const bf16*)(ws + WS_H0); const float* LST = (const float*)(ws + WS_LST); bf16* Y = (bf16*)(ws + WS_Y);
    const float* ct = (const float*)(ws + WS_ROPE); const float* st = ct + 4096 * 32;
    const float* pool_w = in[2]; const float* pool_scale = in[3]; const float* ret_g = in[4];
    LAS float* qs = (LAS float*)lds;
    LAS float* ks = qs + 128 * 65;
    LAS float* R2 = (LAS float*)(lds + 66560);
    LAS float* PA = (LAS float*)lds;
    LAS float* PB = (LAS float*)(lds + 66048);
    for (int item = blockIdx.x; item < 256; item += gridDim.x) {
        const int n = item & 31, b = item >> 5; const size_t t0 = (size_t)b * SEQ + n * 128;
        const int c = tid >> 2, eg = tid & 3;
        for (int h = 0; h < 4; ++h) {
            const float lg = gamma_log2(h);
            for (int idx = tid; idx < 4096; idx += NTHR) { const int s = idx >> 5, i = idx & 31, pos = n * 128 + s;
                const bf16* rq = H0 + (t0 + s) * AB_IN + 512 + h * 64; const bf16* rk = H0 + (t0 + s) * AB_IN + 768 + h * 64;
                const float cs = ct[pos * 32 + i], sn = st[pos * 32 + i];
                const float q1 = bf2f(rq[i]), q2 = bf2f(rq[i + 32]), k1 = bf2f(rk[i]), k2 = bf2f(rk[i + 32]);
                qs[s * 65 + i] = q1 * cs - q2 * sn; qs[s * 65 + i + 32] = q2 * cs + q1 * sn;
                ks[s * 65 + i] = (k1 * cs - k2 * sn) * 0.125f; ks[s * 65 + i + 32] = (k2 * cs + k1 * sn) * 0.125f; }
            { const float* Sg = LST + (size_t)((b * 4 + h) * 32 + n) * 8192;
              for (int idx = tid; idx < 8192; idx += NTHR) R2[idx] = Sg[idx]; }
            __syncthreads();
            float o[32];
#pragma unroll
            for (int j = 0; j < 32; ++j) o[j] = 0.f;
            for (int d = 0; d < 64; ++d) { const float qv = qs[c * 65 + d];
#pragma unroll
                for (int j = 0; j < 32; ++j) o[j] += qv * R2[d * 128 + eg * 32 + j]; }
            { const float qd = exp2f((float)(c + 1) * lg);
#pragma unroll
              for (int j = 0; j < 32; ++j) o[j] *= qd; }
            __syncthreads();
            for (int idx = tid; idx < 16384; idx += NTHR) { const int s = idx >> 7, e = idx & 127; R2[idx] = bf2f(H0[(t0 + s) * AB_IN + 1024 + h * 128 + e]); }
            __syncthreads();
            for (int s = 0; s <= c; ++s) {
                float dot = 0.f;
#pragma unroll 16
                for (int d = 0; d < 64; ++d) dot += qs[c * 65 + d] * ks[s * 65 + d];
                const float w = dot * exp2f((float)(c - s) * lg);
#pragma unroll
                for (int j = 0; j < 32; ++j) o[j] += w * R2[s * 128 + eg * 32 + j];
            }
            float sum = 0.f;
#pragma unroll
            for (int j = 0; j < 32; ++j) sum += o[j];
            sum += __shfl_xor(sum, 1); sum += __shfl_xor(sum, 2);
            const float mean = sum * (1.f / 128.f); float sq = 0.f;
#pragma unroll
            for (int j = 0; j < 32; ++j) { const float dl = o[j] - mean; sq += dl * dl; }
            sq += __shfl_xor(sq, 1); sq += __shfl_xor(sq, 2);
            const float rstd = 1.f / sqrtf(sq * (1.f / 128.f) + LN_EPS);
            { const bf16* rg = H0 + (t0 + c) * AB_IN + 1536 + h * 128 + eg * 32; bf16* yo = Y + (t0 + c) * D + 512 + h * 128 + eg * 32;
#pragma unroll
              for (int j = 0; j < 32; ++j) { const float g = bf2f(rg[j]); const float sg = g / (1.f + expf(-g));
                  yo[j] = (bf16)f2bf((o[j] - mean) * rstd * ret_g[h * 128 + eg * 32 + j] * sg); } }
            __syncthreads();
        }
        for (int gi = 0; gi < 4; ++gi) {
            const int w = 2 << gi;
            for (int idx = tid; idx < 16384; idx += NTHR) { const int s = idx >> 7, cc = idx & 127, pos = n * 128 + s; const int cnt = (pos + 1 < w) ? pos + 1 : w;
                float sum = 0.f; for (int j = 0; j < cnt; ++j) sum += bf2f(H0[(t0 + s - j) * AB_IN + gi * 128 + cc]);
                PA[s * 129 + cc] = sum / (float)cnt - bf2f(H0[(t0 + s) * AB_IN + gi * 128 + cc]); }
            for (int idx = tid; idx < 16384; idx += NTHR) PB[idx] = pool_w[gi * 16384 + idx];
            __syncthreads();
            float o[32];
#pragma unroll
            for (int j = 0; j < 32; ++j) o[j] = 0.f;
            for (int cc = 0; cc < 128; ++cc) { const float pv = PA[c * 129 + cc];
#pragma unroll
                for (int j = 0; j < 32; ++j) o[j] += pv * PB[cc * 128 + eg * 32 + j]; }
            { bf16* yo = Y + (t0 + c) * D + gi * 128 + eg * 32;
#pragma unroll
              for (int j = 0; j < 32; ++j) yo[j] = (bf16)f2bf(o[j] * pool_scale[gi * 128 + eg * 32 + j]); }
            __syncthreads();
        }
    }
}
__device__ __forceinline__ void phase_ln(const float* Z, bf16* O, const float* g, const float* bb) {
    const int tid = threadIdx.x, lane = tid & 63, wave = tid >> 6;
    const int gw = blockIdx.x * NWAVES + wave, NGW = gridDim.x * NWAVES;
    for (int m = gw; m < T; m += NGW) {
        const GAS f32x4* zr = (const GAS f32x4*)(Z + (size_t)m * D) + lane;
        f32x4 v[4]; float s = 0.f;
#pragma unroll
        for (int j = 0; j < 4; ++j) { v[j] = zr[64 * j]; s += (v[j].x + v[j].y) + (v[j].z + v[j].w); }
        const float mean = wave_sum(s) * (1.f / D); float s2 = 0.f;
#pragma unroll
        for (int j = 0; j < 4; ++j) { v[j] = v[j] - mean; s2 += (v[j].x * v[j].x + v[j].y * v[j].y) + (v[j].z * v[j].z + v[j].w * v[j].w); }
        const float rstd = 1.f / sqrtf(wave_sum(s2) * (1.f / D) + LN_EPS);
        GAS v2u* o8 = (GAS v2u*)(O + (size_t)m * D) + lane;
#pragma unroll
        for (int j = 0; j < 4; ++j) { const f32x4 gg = *((const GAS f32x4*)g + lane + 64 * j), b4 = *((const GAS f32x4*)bb + lane + 64 * j);
            v2u o; o.x = pk2(v[j].x * rstd * gg.x + b4.x, v[j].y * rstd * gg.y + b4.y); o.y = pk2(v[j].z * rstd * gg.z + b4.z, v[j].w * rstd * gg.w + b4.w); o8[64 * j] = o; }
    }
}
__device__ __forceinline__ void wave_argmax(float& bv, int& bi) {
#pragma unroll
    for (int off = 32; off >= 1; off >>= 1) { const float ov = __shfl_xor(bv, off); const int oi = __shfl_xor(bi, off);
        if (ov > bv || (ov == bv && oi < bi)) { bv = ov; bi = oi; } }
}
__device__ __forceinline__ void phase_topk(LAS unsigned char* lds, const bf16* Q, const float* keys  , int* EID, float* GATE) {
    const int tid = threadIdx.x, lane = tid & 63, wave = tid >> 6;
    LAS float* kl = (LAS float*)lds;
    LAS float* qt = (LAS float*)(lds + 66048);
    LAS float* sc = (LAS float*)(lds + 82560);
    for (int item = blockIdx.x; item < (T / 32) * 8; item += gridDim.x) {
        const int h = item & 7, tile = item >> 3; const size_t tok0 = (size_t)tile * 32;
        for (int p = 0; p < 2; ++p) {
            const float* kg = keys + (size_t)((h * 2 + p) * 128) * 128;
            for (int idx = tid; idx < 16384; idx += NTHR) { const int k = idx >> 7, d = idx & 127; kl[k * 129 + d] = kg[idx]; }
            for (int idx = tid; idx < 4096; idx += NTHR) { const int t = idx >> 7, d = idx & 127; qt[t * 129 + d] = bf2f(Q[(tok0 + t) * 2048 + h * 256 + p * 128 + d]); }
            __syncthreads();
            { const int t = tid >> 4, kg16 = tid & 15;
              for (int jj = 0; jj < 8; ++jj) { const int k = kg16 + 16 * jj; float dot = 0.f;
#pragma unroll 16
                  for (int d = 0; d < 128; ++d) dot += qt[t * 129 + d] * kl[k * 129 + d];
                  sc[(t * 2 + p) * 128 + k] = dot; } }
            __syncthreads();
        }
        for (int tt = 0; tt < 4; ++tt) {
            const int t = wave * 4 + tt;
            float tv[2]; int ti[2];
#pragma unroll
            for (int p = 0; p < 2; ++p) {
                float v0 = sc[(t * 2 + p) * 128 + lane], v1 = sc[(t * 2 + p) * 128 + lane + 64];
                float mv = 0.f; int mi = 0;
                for (int j = 0; j < 16; ++j) {
                    float bv; int bi; if (v0 >= v1) { bv = v0; bi = lane; } else { bv = v1; bi = lane + 64; }
                    wave_argmax(bv, bi);
                    if (lane == j) { mv = bv; mi = bi; }
                    if (bi == lane) v0 = -INFINITY; if (bi == lane + 64) v1 = -INFINITY;
                }
                tv[p] = mv; ti[p] = mi;
            }
            float cv[4];
#pragma unroll
            for (int m = 0; m < 4; ++m) { const int cidx = lane + 64 * m; cv[m] = __shfl(tv[0], cidx >> 4) + __shfl(tv[1], cidx & 15); }
            float bestv = 0.f; int bestc = 0;
            for (int j = 0; j < 16; ++j) {
                float bv = cv[0]; int bi = lane;
#pragma unroll
                for (int m = 1; m < 4; ++m) if (cv[m] > bv) { bv = cv[m]; bi = lane + 64 * m; }
                wave_argmax(bv, bi);
                if (lane == j) { bestv = bv; bestc = bi; }
#pragma unroll
                for (int m = 0; m < 4; ++m) if (bi == lane + 64 * m) cv[m] = -INFINITY;
            }
            const float mx = __shfl(bestv, 0);
            const float ex = (lane < 16) ? expf(bestv - mx) : 0.f;
            const float den = wave_sum(ex);
            const int ia = __shfl(ti[0], bestc >> 4), ib = __shfl(ti[1], bestc & 15);
            if (lane < 16) { const size_t o = (tok0 + t) * 128 + h * 16 + lane; EID[o] = ia * 128 + ib; GATE[o] = ex / den; }
        }
        __syncthreads();
    }
}

typedef short bf16x8 __attribute__((ext_vector_type(8)));
typedef float f32x16 __attribute__((ext_vector_type(16)));
#define CEF_D(a, b) { const float hi_ = fmaxf((a), (b)), lo_ = fminf((a), (b)); (a) = hi_; (b) = lo_; }
#define CEF_A(a, b) { const float hi_ = fmaxf((a), (b)), lo_ = fminf((a), (b)); (a) = lo_; (b) = hi_; }
#define CEP_D(ka, pa, kb, pb) { const bool sw_ = (kb) > (ka); const float k0_ = sw_ ? (kb) : (ka), k1_ = sw_ ? (ka) : (kb); const int p0_ = sw_ ? (pb) : (pa), p1_ = sw_ ? (pa) : (pb); (ka) = k0_; (kb) = k1_; (pa) = p0_; (pb) = p1_; }
template <int OFF, int NV> __device__ __forceinline__ void bsort16_desc(float (&v)[NV]) {
#pragma unroll
    for (int k = 2; k <= 16; k <<= 1) {
#pragma unroll
        for (int j = k >> 1; j > 0; j >>= 1) {
#pragma unroll
            for (int i = 0; i < 16; ++i) { const int l = i ^ j;
                if (l > i) { if ((i & k) == 0) CEF_D(v[OFF + i], v[OFF + l]) else CEF_A(v[OFF + i], v[OFF + l]) } }
        }
    }
}
template <int OA, int NV> __device__ __forceinline__ void bmerge16_desc(float (&v)[NV]) {
#pragma unroll
    for (int j = 8; j > 0; j >>= 1) {
#pragma unroll
        for (int i = 0; i < 16; ++i) { const int l = i ^ j; if (l > i) CEF_D(v[OA + i], v[OA + l]) }
    }
}
template <int OA, int OB, int NV> __device__ __forceinline__ void merge_top16(float (&v)[NV]) {
#pragma unroll
    for (int i = 0; i < 16; ++i) v[OA + i] = fmaxf(v[OA + i], v[OB + 15 - i]);
    bmerge16_desc<OA, NV>(v);
}
template <int OFF, int NV> __device__ __forceinline__ void bsort16p_desc(float (&v)[NV], int (&q)[NV]) {
#pragma unroll
    for (int k = 2; k <= 16; k <<= 1) {
#pragma unroll
        for (int j = k >> 1; j > 0; j >>= 1) {
#pragma unroll
            for (int i = 0; i < 16; ++i) { const int l = i ^ j;
                if (l > i) { if ((i & k) == 0) CEP_D(v[OFF + i], q[OFF + i], v[OFF + l], q[OFF + l]) else CEP_D(v[OFF + l], q[OFF + l], v[OFF + i], q[OFF + i]) } }
        }
    }
}
template <int OA, int NV> __device__ __forceinline__ void bmerge16p_desc(float (&v)[NV], int (&q)[NV]) {
#pragma unroll
    for (int j = 8; j > 0; j >>= 1) {
#pragma unroll
        for (int i = 0; i < 16; ++i) { const int l = i ^ j; if (l > i) CEP_D(v[OA + i], q[OA + i], v[OA + l], q[OA + l]) }
    }
}
__host__ __device__ constexpr int pair_i(int s) { return s < 16 ? 0 : s < 24 ? 1 : s < 29 ? 2 : s < 33 ? 3 : s < 36 ? 4 : s < 38 ? 5 : s < 40 ? 6 : s < 42 ? 7 : (s - 42 + 8); }
__host__ __device__ constexpr int pair_j(int s) { return s < 16 ? s : s < 24 ? s - 16 : s < 29 ? s - 24 : s < 33 ? s - 29 : s < 36 ? s - 33 : s < 38 ? s - 36 : s < 40 ? s - 38 : s < 42 ? s - 40 : 0; }
__device__ __forceinline__ void phase_topk_fast(LAS unsigned char* lds, const bf16* Q, const bf16* keysb  , int* EID, float* GATE) {
    const int tid = threadIdx.x, lane = tid & 63, wave = __builtin_amdgcn_readfirstlane(tid >> 6);
    const int c = lane & 31, hh = lane >> 5;
    for (int hi = blockIdx.x; hi < 256; hi += gridDim.x) {
        const int h = hi & 7, rank = hi >> 3;
        __syncthreads();
        for (int idx = tid; idx < 2 * 128 * 16; idx += NTHR) { const int rowi = idx >> 4, ch = idx & 15;
            const v4u kv = *(const GAS v4u*)(keysb + (size_t)h * 32768 + rowi * 128 + ch * 8);
            *(LAS v4u*)(lds + rowi * 272 + ch * 16) = kv; }
        __syncthreads();
        for (int it = 0; it < 4; ++it) {
            const int tile = rank * 8 + wave + 256 * it;
            const size_t tok0 = (size_t)tile * 32;
            float ta[16], tb[16];
#pragma unroll
            for (int p = 0; p < 2; ++p) {
                bf16x8 bq[8];
                const bf16* qrow = Q + (tok0 + c) * 2048 + h * 256 + p * 128 + 8 * hh;
#pragma unroll
                for (int ks = 0; ks < 8; ++ks) bq[ks] = *(const GAS bf16x8*)(qrow + 16 * ks);
                f32x16 acc[4];
#pragma unroll
                for (int blk = 0; blk < 4; ++blk) {
#pragma unroll
                    for (int r = 0; r < 16; ++r) acc[blk][r] = 0.f;
#pragma unroll
                    for (int ks = 0; ks < 8; ++ks) { const bf16x8 a = *(const LAS bf16x8*)(lds + (p * 128 + 32 * blk + c) * 272 + (16 * ks + 8 * hh) * 2);
                        acc[blk] = __builtin_amdgcn_mfma_f32_32x32x16_bf16(a, bq[ks], acc[blk], 0, 0, 0); }
                }
                float v[64];
#pragma unroll
                for (int blk = 0; blk < 4; ++blk)
#pragma unroll
                    for (int r = 0; r < 16; ++r)
                    { const float sv = acc[blk][r]; v[blk * 16 + r] = __uint_as_float((__float_as_uint(sv) & ~127u) | (unsigned)(32 * blk + (r & 3) + 8 * (r >> 2)) | (unsigned)(hh << 2)); }
                __builtin_amdgcn_sched_barrier(0);
                bsort16_desc<0, 64>(v); bsort16_desc<16, 64>(v); bsort16_desc<32, 64>(v); bsort16_desc<48, 64>(v);
                merge_top16<0, 16, 64>(v); merge_top16<32, 48, 64>(v); merge_top16<0, 32, 64>(v);
                float o[16];
#pragma unroll
                for (int i = 0; i < 16; ++i) o[i] = __shfl_xor(v[i], 32);
#pragma unroll
                for (int i = 0; i < 16; ++i) v[i] = fmaxf(v[i], o[15 - i]);
                bmerge16_desc<0, 64>(v);
#pragma unroll
                for (int i = 0; i < 16; ++i) { if (p == 0) ta[i] = v[i]; else tb[i] = v[i]; }
                __builtin_amdgcn_sched_barrier(0);
            }
            float av[16], bv[16]; int ai[16], bi[16];
#pragma unroll
            for (int i = 0; i < 16; ++i) { const unsigned ua = __builtin_bit_cast(unsigned, ta[i]), ub = __builtin_bit_cast(unsigned, tb[i]);
                av[i] = __builtin_bit_cast(float, ua & ~127u); ai[i] = (int)(ua & 127u); bv[i] = __builtin_bit_cast(float, ub & ~127u); bi[i] = (int)(ub & 127u); }
            float ck[32]; int cp[32];
#pragma unroll
            for (int s2 = 0; s2 < 32; ++s2) {
                const float k0 = av[pair_i(s2)] + bv[pair_j(s2)]; const int p0 = (ai[pair_i(s2)] << 7) | bi[pair_j(s2)];
                float k1 = -INFINITY; int p1 = 0;
                if (s2 + 32 < 50) { k1 = av[pair_i(s2 + 32 < 50 ? s2 + 32 : 0)] + bv[pair_j(s2 + 32 < 50 ? s2 + 32 : 0)]; p1 = (ai[pair_i(s2 + 32 < 50 ? s2 + 32 : 0)] << 7) | bi[pair_j(s2 + 32 < 50 ? s2 + 32 : 0)]; }
                ck[s2] = hh ? k1 : k0; cp[s2] = hh ? p1 : p0;
            }
            __builtin_amdgcn_sched_barrier(0);
            bsort16p_desc<0, 32>(ck, cp); bsort16p_desc<16, 32>(ck, cp);
#pragma unroll
            for (int i = 0; i < 16; ++i) { if (ck[16 + 15 - i] > ck[i]) { ck[i] = ck[16 + 15 - i]; cp[i] = cp[16 + 15 - i]; } }
            bmerge16p_desc<0, 32>(ck, cp);
            { float ok[16]; int op[16];
#pragma unroll
              for (int i = 0; i < 16; ++i) { ok[i] = __shfl_xor(ck[i], 32); op[i] = __shfl_xor(cp[i], 32); }
#pragma unroll
              for (int i = 0; i < 16; ++i) { if (ok[15 - i] > ck[i]) { ck[i] = ok[15 - i]; cp[i] = op[15 - i]; } } }
            bmerge16p_desc<0, 32>(ck, cp);
            float ex[16]; float sum = 0.f;
#pragma unroll
            for (int i = 0; i < 16; ++i) { ex[i] = __expf(ck[i] - ck[0]); sum += ex[i]; }
            const float inv = 1.f / sum;
            if (hh == 0) {
                int* eo = EID + (tok0 + c) * 128 + h * 16; float* go = GATE + (tok0 + c) * 128 + h * 16;
#pragma unroll
                for (int i = 0; i < 4; ++i) { *(GAS v4u*)(eo + 4 * i) = (v4u){(unsigned)cp[4 * i], (unsigned)cp[4 * i + 1], (unsigned)cp[4 * i + 2], (unsigned)cp[4 * i + 3]};
                    *(GAS f32x4*)(go + 4 * i) = (f32x4){ex[4 * i] * inv, ex[4 * i + 1] * inv, ex[4 * i + 2] * inv, ex[4 * i + 3] * inv}; }
            }
        }
    }
    __syncthreads();
}
template <bool FINAL>
__device__ __forceinline__ void phase_gather(const bf16* X, const int* EID, const float* GATE, const float* U, const float* V, const float* g, const float* bb, bf16* Ob, float* Of) {
    const int tid = threadIdx.x, lane = tid & 63, wave = tid >> 6;
    const int gw = blockIdx.x * NWAVES + wave, NGW = gridDim.x * NWAVES;
    for (int t = gw; t < T; t += NGW) {
        f32x4 x[4], acc[4];
#pragma unroll
        for (int j = 0; j < 4; ++j) { const v2u w = *((const GAS v2u*)(X + (size_t)t * D) + lane + 64 * j);
            x[j] = (f32x4){bflo(w.x), bfhi(w.x), bflo(w.y), bfhi(w.y)}; acc[j] = (f32x4){0.f, 0.f, 0.f, 0.f}; }
        const int e0 = EID[(size_t)t * 128 + lane], e1 = EID[(size_t)t * 128 + 64 + lane];
        const float g0 = GATE[(size_t)t * 128 + lane], g1 = GATE[(size_t)t * 128 + 64 + lane];
#pragma unroll 2
        for (int k = 0; k < 128; ++k) {
            const int e = (k < 64) ? __shfl(e0, k) : __shfl(e1, k - 64);
            const float gt = (k < 64) ? __shfl(g0, k) : __shfl(g1, k - 64);
            const GAS f32x4* ur = (const GAS f32x4*)(U + (size_t)e * D) + lane;
            float dot = 0.f;
#pragma unroll
            for (int j = 0; j < 4; ++j) { const f32x4 u = ur[64 * j]; dot += (x[j].x * u.x + x[j].y * u.y) + (x[j].z * u.z + x[j].w * u.w); }
            dot = wave_sum(dot);
            const float a = 0.5f * dot * (1.f + erff(dot * 0.70710678118654752f));
            const float cf = gt * a;
            const GAS f32x4* vr = (const GAS f32x4*)(V + (size_t)e * D) + lane;
#pragma unroll
            for (int j = 0; j < 4; ++j) { const f32x4 v = vr[64 * j]; acc[j] += cf * v; }
        }
        float s = 0.f;
#pragma unroll
        for (int j = 0; j < 4; ++j) { acc[j] = ALPHA * x[j] + acc[j]; s += (acc[j].x + acc[j].y) + (acc[j].z + acc[j].w); }
        const float mean = wave_sum(s) * (1.f / D); float s2 = 0.f;
#pragma unroll
        for (int j = 0; j < 4; ++j) { acc[j] = acc[j] - mean; s2 += (acc[j].x * acc[j].x + acc[j].y * acc[j].y) + (acc[j].z * acc[j].z + acc[j].w * acc[j].w); }
        const float rstd = 1.f / sqrtf(wave_sum(s2) * (1.f / D) + LN_EPS);
#pragma unroll
        for (int j = 0; j < 4; ++j) { const f32x4 gg = *((const GAS f32x4*)g + lane + 64 * j), b4 = *((const GAS f32x4*)bb + lane + 64 * j);
            const f32x4 o = acc[j] * rstd * gg + b4;
            if (FINAL) *((GAS f32x4*)(Of + (size_t)t * D) + lane + 64 * j) = o;
            else { v2u w; w.x = pk2(o.x, o.y); w.y = pk2(o.z, o.w); *((GAS v2u*)(Ob + (size_t)t * D) + lane + 64 * j) = w; } }
    }
}

typedef float f32x2 __attribute__((ext_vector_type(2)));
__device__ __forceinline__ void phase_convert_tables(const float* U, const float* V, unsigned char* ws) {
    const int tid = threadIdx.x, lane = tid & 63, wave = tid >> 6;
    const int gw = blockIdx.x * NWAVES + wave, NGW = gridDim.x * NWAVES;
    for (int row = gw; row < 4 * NEXP; row += NGW) {
        const bool isv = row >= 2 * NEXP; const int r = row & (2 * NEXP - 1);
        const GAS f32x4* src = (const GAS f32x4*)((isv ? V : U) + (size_t)r * D) + lane;
        f32x4 v[4]; float m = 0.f;
#pragma unroll
        for (int j = 0; j < 4; ++j) { v[j] = src[64 * j]; m = fmaxf(fmaxf(m, fmaxf(fabsf(v[j].x), fabsf(v[j].y))), fmaxf(fabsf(v[j].z), fabsf(v[j].w))); }
#pragma unroll
        for (int o = 1; o < 64; o <<= 1) m = fmaxf(m, __shfl_xor(m, o));
        m = fmaxf(m, 1e-30f);
        const float sc = 400.f / m;
        v4u w;
        { int t0 = __builtin_amdgcn_cvt_pk_fp8_f32(v[0].x * sc, v[0].y * sc, 0, false); t0 = __builtin_amdgcn_cvt_pk_fp8_f32(v[0].z * sc, v[0].w * sc, t0, true); w.x = (unsigned)t0; }
        { int t0 = __builtin_amdgcn_cvt_pk_fp8_f32(v[1].x * sc, v[1].y * sc, 0, false); t0 = __builtin_amdgcn_cvt_pk_fp8_f32(v[1].z * sc, v[1].w * sc, t0, true); w.y = (unsigned)t0; }
        { int t0 = __builtin_amdgcn_cvt_pk_fp8_f32(v[2].x * sc, v[2].y * sc, 0, false); t0 = __builtin_amdgcn_cvt_pk_fp8_f32(v[2].z * sc, v[2].w * sc, t0, true); w.z = (unsigned)t0; }
        { int t0 = __builtin_amdgcn_cvt_pk_fp8_f32(v[3].x * sc, v[3].y * sc, 0, false); t0 = __builtin_amdgcn_cvt_pk_fp8_f32(v[3].z * sc, v[3].w * sc, t0, true); w.w = (unsigned)t0; }
        *((GAS v4u*)(ws + (isv ? WS_V8 : WS_U8) + (size_t)r * 1024) + lane) = w;
        if (lane == 0) ((float*)(ws + (isv ? WS_DQV : WS_DQU)))[r] = m * (1.f / 400.f);
    }
}
__host__ __device__ constexpr int rev4(int i) { return ((i & 1) << 3) | ((i & 2) << 1) | ((i & 4) >> 1) | ((i & 8) >> 3); }
#define FMA2(a, b, c) __builtin_elementwise_fma((a), (b), (c))
#define CVT8(w, hi) __builtin_amdgcn_cvt_pk_f32_fp8((int)(w), (hi))
template <bool FINAL>
__device__ __forceinline__ void phase_gather8(const bf16* X, const int* EID, const float* GATE, const unsigned char* U8, const unsigned char* V8, const float* DQU, const float* DQV,
                                              const float* g, const float* bb, bf16* Ob, float* Of) {
    const int tid = threadIdx.x, lane = tid & 63, wave = tid >> 6;
    const int gw = blockIdx.x * NWAVES + wave, NGW = gridDim.x * NWAVES;
    const bool b0 = (lane & 1) != 0, b1 = (lane & 2) != 0, b2 = (lane & 4) != 0, b3 = (lane & 8) != 0; const int myrow = lane >> 4;
    for (int t = gw; t < T; t += NGW) {
        f32x2 x[8];
#pragma unroll
        for (int j = 0; j < 4; ++j) { const v2u w = *((const GAS v2u*)(X + (size_t)t * D) + lane + 64 * j);
            x[2 * j] = (f32x2){bflo(w.x), bfhi(w.x)}; x[2 * j + 1] = (f32x2){bflo(w.y), bfhi(w.y)}; }
        const int e0 = EID[(size_t)t * 128 + lane], e1 = EID[(size_t)t * 128 + 64 + lane];
        const float gt0 = GATE[(size_t)t * 128 + lane], gt1 = GATE[(size_t)t * 128 + 64 + lane];
        const float dqu0 = DQU[e0], dqu1 = DQU[e1], dqv0 = DQV[e0], dqv1 = DQV[e1];
        float act0 = 0.f, act1 = 0.f;
#pragma unroll
        for (int r = 0; r < 2; ++r) {
            const int er = r ? e1 : e0;
            for (int row = 0; row < 4; ++row) {
                v4u w[16];
#pragma unroll
                for (int i = 0; i < 16; ++i) { const int e = __builtin_amdgcn_readlane(er, row * 16 + rev4(i)); w[i] = *((const GAS v4u*)(U8 + (size_t)e * 1024) + lane); }
                float p[16];
#pragma unroll
                for (int i = 0; i < 16; ++i) { f32x2 a = (f32x2){0.f, 0.f};
                    a = FMA2(x[0], CVT8(w[i].x, false), a); a = FMA2(x[1], CVT8(w[i].x, true), a);
                    a = FMA2(x[2], CVT8(w[i].y, false), a); a = FMA2(x[3], CVT8(w[i].y, true), a);
                    a = FMA2(x[4], CVT8(w[i].z, false), a); a = FMA2(x[5], CVT8(w[i].z, true), a);
                    a = FMA2(x[6], CVT8(w[i].w, false), a); a = FMA2(x[7], CVT8(w[i].w, true), a);
                    p[i] = a.x + a.y; }
                float r8[8], r4[4], r2[2];
#pragma unroll
                for (int i = 0; i < 8; ++i) { const float keep = b0 ? p[8 + i] : p[i], send = b0 ? p[i] : p[8 + i]; r8[i] = keep + __shfl_xor(send, 1); }
#pragma unroll
                for (int i = 0; i < 4; ++i) { const float keep = b1 ? r8[4 + i] : r8[i], send = b1 ? r8[i] : r8[4 + i]; r4[i] = keep + __shfl_xor(send, 2); }
#pragma unroll
                for (int i = 0; i < 2; ++i) { const float keep = b2 ? r4[2 + i] : r4[i], send = b2 ? r4[i] : r4[2 + i]; r2[i] = keep + __shfl_xor(send, 4); }
                float r1 = (b3 ? r2[1] : r2[0]) + __shfl_xor(b3 ? r2[0] : r2[1], 8);
                r1 += __shfl_xor(r1, 16); r1 += __shfl_xor(r1, 32);
                if (myrow == row) { if (r == 0) act0 = r1; else act1 = r1; }
            }
        }
        float c0, c1;
        { const float a0 = act0 * dqu0, a1 = act1 * dqu1;
          c0 = gt0 * (0.5f * a0 * (1.f + erff(a0 * 0.70710678118654752f))) * dqv0;
          c1 = gt1 * (0.5f * a1 * (1.f + erff(a1 * 0.70710678118654752f))) * dqv1; }
        f32x2 acc[8];
#pragma unroll
        for (int j = 0; j < 8; ++j) acc[j] = (f32x2){0.f, 0.f};
#pragma unroll
        for (int r = 0; r < 2; ++r) {
            const int er = r ? e1 : e0; const int cr = __builtin_bit_cast(int, r ? c1 : c0);
            for (int row = 0; row < 4; ++row) {
                v4u w[16];
#pragma unroll
                for (int i = 0; i < 16; ++i) { const int e = __builtin_amdgcn_readlane(er, row * 16 + i); w[i] = *((const GAS v4u*)(V8 + (size_t)e * 1024) + lane); }
#pragma unroll
                for (int i = 0; i < 16; ++i) { const float cf = __builtin_bit_cast(float, __builtin_amdgcn_readlane(cr, row * 16 + i)); const f32x2 c2 = (f32x2){cf, cf};
                    acc[0] = FMA2(c2, CVT8(w[i].x, false), acc[0]); acc[1] = FMA2(c2, CVT8(w[i].x, true), acc[1]);
                    acc[2] = FMA2(c2, CVT8(w[i].y, false), acc[2]); acc[3] = FMA2(c2, CVT8(w[i].y, true), acc[3]);
                    acc[4] = FMA2(c2, CVT8(w[i].z, false), acc[4]); acc[5] = FMA2(c2, CVT8(w[i].z, true), acc[5]);
                    acc[6] = FMA2(c2, CVT8(w[i].w, false), acc[6]); acc[7] = FMA2(c2, CVT8(w[i].w, true), acc[7]); }
            }
        }
        float s = 0.f;
#pragma unroll
        for (int j = 0; j < 8; ++j) { acc[j] = x[j] * ALPHA + acc[j]; s += acc[j].x + acc[j].y; }
        const float mean = wave_sum(s) * (1.f / D); float s2 = 0.f;
#pragma unroll
        for (int j = 0; j < 8; ++j) { acc[j] = acc[j] - mean; s2 += acc[j].x * acc[j].x + acc[j].y * acc[j].y; }
        const float rstd = 1.f / sqrtf(wave_sum(s2) * (1.f / D) + LN_EPS);
#pragma unroll
        for (int j = 0; j < 4; ++j) { const f32x4 gg = *((const GAS f32x4*)g + lane + 64 * j), b4 = *((const GAS f32x4*)bb + lane + 64 * j);
            const f32x4 o = (f32x4){acc[2 * j].x, acc[2 * j].y, acc[2 * j + 1].x, acc[2 * j + 1].y} * rstd * gg + b4;
            if (FINAL) *((GAS f32x4*)(Of + (size_t)t * D) + lane + 64 * j) = o;
            else { v2u w; w.x = pk2(o.x, o.y); w.y = pk2(o.z, o.w); *((GAS v2u*)(Ob + (size_t)t * D) + lane + 64 * j) = w; } }
    }
}
__device__ __forceinline__ void phase_hgrn(LAS unsigned char* lds, unsigned char* ws) {
    const int tid = threadIdx.x;
    const bf16* CQ = (const bf16*)(ws + WS_CQ); const bf16* CK = (const bf16*)(ws + WS_CK); const bf16* CV = (const bf16*)(ws + WS_CV); bf16* O = (bf16*)(ws + WS_O);
    LAS float* fL = (LAS float*)lds;
    LAS float* kL = fL + 4096; LAS float* qL = kL + 4096;
    LAS float* vL = qL + 4096;
    LAS float* part = vL + 1024;
    for (int item = blockIdx.x; item < 256; item += gridDim.x) {
        const int es = item & 3, h = (item >> 2) & 7, b = item >> 5;
        const int e = tid & 31, dg = tid >> 5;
        float S[8];
#pragma unroll
        for (int j = 0; j < 8; ++j) S[j] = 0.f;
        for (int blk = 0; blk < SEQ / 32; ++blk) {
            const size_t t0 = (size_t)b * SEQ + blk * 32;
            for (int idx = tid; idx < 4096; idx += NTHR) { const int s = idx >> 7, d = idx & 127; const size_t o = (t0 + s) * D + h * 128 + d;
                const float kk = bf2f(CK[o]); kL[idx] = kk; fL[idx] = 1.f - kk; qL[idx] = bf2f(CQ[o]); }
            for (int idx = tid; idx < 1024; idx += NTHR) { const int s = idx >> 5, ee = idx & 31; vL[idx] = bf2f(CV[(t0 + s) * D + h * 128 + es * 32 + ee]); }
            __syncthreads();
            for (int s = 0; s < 32; ++s) { const float v = vL[s * 32 + e]; float po = 0.f;
#pragma unroll
                for (int j = 0; j < 8; ++j) { const int d = dg * 8 + j; S[j] = fL[s * 128 + d] * S[j] + kL[s * 128 + d] * v; po += qL[s * 128 + d] * S[j]; }
                part[(s * 16 + dg) * 32 + e] = po; }
            __syncthreads();
            for (int idx = tid; idx < 1024; idx += NTHR) { const int s = idx >> 5, ee = idx & 31; float o = 0.f;
#pragma unroll
                for (int g = 0; g < 16; ++g) o += part[(s * 16 + g) * 32 + ee];
                O[(t0 + s) * D + h * 128 + es * 32 + ee] = (bf16)f2bf(o); }
            __syncthreads();
        }
    }
}
__device__ __forceinline__ void phase_hgrn_norm(const float* norm_g, unsigned char* ws) {
    const int tid = threadIdx.x, lane = tid & 63, wave = tid >> 6;
    const int gw = blockIdx.x * NWAVES + wave, NGW = gridDim.x * NWAVES;
    const bf16* O = (const bf16*)(ws + WS_O); const bf16* CG = (const bf16*)(ws + WS_CG); bf16* Y2 = (bf16*)(ws + WS_Y2);
    for (int t = gw; t < T; t += NGW) {
        const v4u a0 = *((const GAS v4u*)(O + (size_t)t * D) + lane * 2), a1 = *((const GAS v4u*)(O + (size_t)t * D) + lane * 2 + 1);
        const v4u g0 = *((const GAS v4u*)(CG + (size_t)t * D) + lane * 2), g1 = *((const GAS v4u*)(CG + (size_t)t * D) + lane * 2 + 1);
        float o[16], gv[16];
        o[0] = bflo(a0.x); o[1] = bfhi(a0.x); o[2] = bflo(a0.y); o[3] = bfhi(a0.y); o[4] = bflo(a0.z); o[5] = bfhi(a0.z); o[6] = bflo(a0.w); o[7] = bfhi(a0.w);
        o[8] = bflo(a1.x); o[9] = bfhi(a1.x); o[10] = bflo(a1.y); o[11] = bfhi(a1.y); o[12] = bflo(a1.z); o[13] = bfhi(a1.z); o[14] = bflo(a1.w); o[15] = bfhi(a1.w);
        gv[0] = bflo(g0.x); gv[1] = bfhi(g0.x); gv[2] = bflo(g0.y); gv[3] = bfhi(g0.y); gv[4] = bflo(g0.z); gv[5] = bfhi(g0.z); gv[6] = bflo(g0.w); gv[7] = bfhi(g0.w);
        gv[8] = bflo(g1.x); gv[9] = bfhi(g1.x); gv[10] = bflo(g1.y); gv[11] = bfhi(g1.y); gv[12] = bflo(g1.z); gv[13] = bfhi(g1.z); gv[14] = bflo(g1.w); gv[15] = bfhi(g1.w);
        float sq = 0.f;
#pragma unroll
        for (int j = 0; j < 16; ++j) sq += o[j] * o[j];
        sq += __shfl_xor(sq, 1); sq += __shfl_xor(sq, 2); sq += __shfl_xor(sq, 4);
        const float r = 1.f / sqrtf(sq * (1.f / 128.f) + LN_EPS);
        float y[16];
#pragma unroll
        for (int j = 0; j < 16; ++j) { const float sg = gv[j] / (1.f + expf(-gv[j])); y[j] = o[j] * r * norm_g[lane * 16 + j] * sg; }
        v4u w0, w1; w0.x = pk2(y[0], y[1]); w0.y = pk2(y[2], y[3]); w0.z = pk2(y[4], y[5]); w0.w = pk2(y[6], y[7]);
        w1.x = pk2(y[8], y[9]); w1.y = pk2(y[10], y[11]); w1.z = pk2(y[12], y[13]); w1.w = pk2(y[14], y[15]);
        *((GAS v4u*)(Y2 + (size_t)t * D) + lane * 2) = w0; *((GAS v4u*)(Y2 + (size_t)t * D) + lane * 2 + 1) = w1;
    }
}

struct Args { const float* in[16]; float* out; unsigned char* ws; int ph_lo, ph_hi, li, pad; };
__global__ void __launch_bounds__(NTHR, 2) mk_fwd(Args args) {
    extern __shared__ __attribute__((aligned(16))) unsigned char lds_raw[];
    LAS unsigned char* lds = (LAS unsigned char*)lds_raw;
    volatile LAS unsigned* MISC = (volatile LAS unsigned*)(lds + MISC_OFF);
    const int tid = threadIdx.x;
    unsigned char* ws = args.ws;
    gu32* ctl = (gu32*)(ws + WS_CTL);
    if (tid < 32) ((LAS unsigned*)(lds + MISC_OFF))[tid] = 0u;
    __syncthreads();
    XcdBarrier bar; bar.bar = (unsigned*)ctl + CW_BAR; bar.x = 0; bar.st = nullptr;
    if (N_LAUNCHES == 1) bar = xcd_barrier_post((unsigned*)ctl + CW_BAR, MISC + 8);
    const int lo = args.ph_lo, hi = args.ph_hi;
#define IN(k) (lo <= (k) && (k) < hi)
#define SEAM(k) do { if (IN(k) && IN((k) + 1)) xcd_barrier(bar); } while (0)
    const float* const* in = args.in;
    bf16* XB = (bf16*)(ws + WS_XB); bf16* H0 = (bf16*)(ws + WS_H0); bf16* Y = (bf16*)(ws + WS_Y); bf16* H1 = (bf16*)(ws + WS_H1);
    int* EID = (int*)(ws + WS_EID); float* GATE = (float*)(ws + WS_GATE);
    float* Z = args.out;

    if (IN(0)) for (int rep_ = 0; rep_ < 1 + (int)((DUP_MASK >> 0) & 1u); ++rep_) { phase_prologue(lds, in, ws); phase_convert_tables(in[12], in[13], ws); } SEAM(0);
    if (IN(1)) for (int rep_ = 0; rep_ < 1 + (int)((DUP_MASK >> 1) & 1u); ++rep_) { pg8::Gemm g{XB, (const bf16*)(ws + WS_WABIN), T, AB_IN, D}; pg8::StaticOrder S; S.init(T, AB_IN, (int)gridDim.x, (int)blockIdx.x); pg8::EpiBf16<0> E{H0, AB_IN, nullptr, 0, 0, 1.f};
                 pg8::gemm_phase<pg8::EpiBf16<0>, pg8::StaticOrder, true, true>(lds, g, S, E); } SEAM(1);
    if (IN(2)) for (int rep_ = 0; rep_ < 1 + (int)((DUP_MASK >> 2) & 1u); ++rep_) { phase_ret_local(lds, ws); } SEAM(2);
    if (IN(3)) for (int rep_ = 0; rep_ < 1 + (int)((DUP_MASK >> 3) & 1u); ++rep_) { phase_ret_prefix(ws); } SEAM(3);
    if (IN(4)) for (int rep_ = 0; rep_ < 1 + (int)((DUP_MASK >> 4) & 1u); ++rep_) { phase_ret_out_pool(lds, in, ws); } SEAM(4);
    if (IN(5)) for (int rep_ = 0; rep_ < 1 + (int)((DUP_MASK >> 5) & 1u); ++rep_) { pg8::Gemm g{Y, (const bf16*)(ws + WS_WABOUT), T, D, D}; pg8::StaticOrder S; S.init(T, D, (int)gridDim.x, (int)blockIdx.x); pg8::EpiResidF32 E{XB, Z};
                 pg8::gemm_phase<pg8::EpiResidF32, pg8::StaticOrder, true, true>(lds, g, S, E); } SEAM(5);
    if (IN(6)) for (int rep_ = 0; rep_ < 1 + (int)((DUP_MASK >> 6) & 1u); ++rep_) { phase_ln(Z, H1, in[14], in[15]); } SEAM(6);
    if (IN(7)) for (int rep_ = 0; rep_ < 1 + (int)((DUP_MASK >> 7) & 1u); ++rep_) { pg8::Gemm g{H1, (const bf16*)(ws + WS_WQ), T, 2048, D}; pg8::StaticOrder S; S.init(T, 2048, (int)gridDim.x, (int)blockIdx.x); pg8::EpiBf16<0> E{H0  , 2048, nullptr, 0, 0, 1.f};
                 pg8::gemm_phase<pg8::EpiBf16<0>, pg8::StaticOrder, true, true>(lds, g, S, E); } SEAM(7);
    if (IN(8)) for (int rep_ = 0; rep_ < 1 + (int)((DUP_MASK >> 8) & 1u); ++rep_) { phase_topk_fast(lds, H0, (const bf16*)(ws + WS_KEYS), EID, GATE); } SEAM(8);
    if (IN(9)) for (int rep_ = 0; rep_ < 1 + (int)((DUP_MASK >> 9) & 1u); ++rep_) { phase_gather8<false>(H1, EID, GATE, ws + WS_U8, ws + WS_V8, (const float*)(ws + WS_DQU), (const float*)(ws + WS_DQV), in[14] + D, in[15] + D, XB  , nullptr); } SEAM(9);
    if (IN(10)) for (int rep_ = 0; rep_ < 1 + (int)((DUP_MASK >> 10) & 1u); ++rep_) { EpiCIn E{(bf16*)(ws + WS_CQ), (bf16*)(ws + WS_CK), (bf16*)(ws + WS_CV), (bf16*)(ws + WS_CG), (const float*)(ws + WS_LB)};
                  (void)E; pg8::Gemm g{XB, (const bf16*)(ws + WS_WCIN), T, C_IN, D}; pg8::StaticOrder S; S.init(T, C_IN, (int)gridDim.x, (int)blockIdx.x);
                  pg8::EpiCInF E2{(bf16*)(ws + WS_CQ), (bf16*)(ws + WS_CK), (bf16*)(ws + WS_CV), (bf16*)(ws + WS_CG), (const float*)(ws + WS_LB)};
                  pg8::gemm_phase<pg8::EpiCInF, pg8::StaticOrder, true, true>(lds, g, S, E2); } SEAM(10);
    if (IN(11)) for (int rep_ = 0; rep_ < 1 + (int)((DUP_MASK >> 11) & 1u); ++rep_) { phase_hgrn(lds, ws); } SEAM(11);
    if (IN(12)) for (int rep_ = 0; rep_ < 1 + (int)((DUP_MASK >> 12) & 1u); ++rep_) { phase_hgrn_norm(in[8], ws); } SEAM(12);
    if (IN(13)) for (int rep_ = 0; rep_ < 1 + (int)((DUP_MASK >> 13) & 1u); ++rep_) { pg8::Gemm g{(const bf16*)(ws + WS_Y2), (const bf16*)(ws + WS_WCOUT), T, D, D}; pg8::StaticOrder S; S.init(T, D, (int)gridDim.x, (int)blockIdx.x); pg8::EpiResidF32 E{XB, Z};
                  pg8::gemm_phase<pg8::EpiResidF32, pg8::StaticOrder, true, true>(lds, g, S, E); } SEAM(13);
    if (IN(14)) for (int rep_ = 0; rep_ < 1 + (int)((DUP_MASK >> 14) & 1u); ++rep_) { phase_ln(Z, H1  , in[14] + 2 * D, in[15] + 2 * D); } SEAM(14);
    if (IN(15)) for (int rep_ = 0; rep_ < 1 + (int)((DUP_MASK >> 15) & 1u); ++rep_) { pg8::Gemm g{H1, (const bf16*)(ws + WS_WQ) + (size_t)2048 * D, T, 2048, D}; pg8::StaticOrder S; S.init(T, 2048, (int)gridDim.x, (int)blockIdx.x); pg8::EpiBf16<0> E{(bf16*)(ws + WS_Q1), 2048, nullptr, 0, 0, 1.f};
                  pg8::gemm_phase<pg8::EpiBf16<0>, pg8::StaticOrder, true, true>(lds, g, S, E); } SEAM(15);
    if (IN(16)) for (int rep_ = 0; rep_ < 1 + (int)((DUP_MASK >> 16) & 1u); ++rep_) { phase_topk_fast(lds, (const bf16*)(ws + WS_Q1), (const bf16*)(ws + WS_KEYS) + (size_t)8 * 2 * 128 * 128, EID, GATE); } SEAM(16);
    if (IN(17)) for (int rep_ = 0; rep_ < 1 + (int)((DUP_MASK >> 17) & 1u); ++rep_) { phase_gather8<true>(H1, EID, GATE, ws + WS_U8 + (size_t)NEXP * 1024, ws + WS_V8 + (size_t)NEXP * 1024, (const float*)(ws + WS_DQU) + NEXP, (const float*)(ws + WS_DQV) + NEXP, in[14] + 3 * D, in[15] + 3 * D, nullptr, args.out); }
#undef IN
#undef SEAM
}

extern "C" void kernel_launch(void* const* d_in, const int* in_sizes, int n_in, void* d_out, int out_size, void* d_ws, size_t ws_size, hipStream_t stream) {
    static int grid = 0;
    if (grid == 0) {
        if (n_in != 16 || in_sizes[0] != T * D || out_size != T * D || ws_size < WS_END) { fprintf(stderr, "kernel_launch: unexpected problem (n_in %d, in0 %d, out %d, ws %zu); nothing launched\n", n_in, n_in > 0 ? in_sizes[0] : -1, out_size, ws_size); grid = -1; return; }
        int dev = 0, cus = 0;
        if (hipGetDevice(&dev) != hipSuccess || hipDeviceGetAttribute(&cus, hipDeviceAttributeMultiprocessorCount, dev) != hipSuccess) { grid = -1; return; }
        if (hipFuncSetAttribute((const void*)mk_fwd, hipFuncAttributeMaxDynamicSharedMemorySize, LDS_BYTES) != hipSuccess) { fprintf(stderr, "kernel_launch: hipFuncSetAttribute failed\n"); grid = -1; return; }
        (void)hipGetLastError();
        grid = cus;
    }
    if (grid < 0) return;
    if (hipMemsetAsync((char*)d_ws + WS_CTL, 0, CTL_ZERO_BYTES, stream) != hipSuccess) return;
    Args a{};
    for (int i = 0; i < 16; ++i) a.in[i] = (const float*)d_in[i];
    a.out = (float*)d_out; a.ws = (unsigned char*)d_ws;
    for (int li = 0; li < N_LAUNCHES; ++li) {
        a.ph_lo = (N_LAUNCHES == 1) ? 0 : li; a.ph_hi = (N_LAUNCHES == 1) ? NPHASE : li + 1; a.li = li;
        hipLaunchKernelGGL(mk_fwd, dim3(grid), dim3(NTHR), LDS_BYTES, stream, a);
        if (hipPeekAtLastError() != hipSuccess) { fprintf(stderr, "kernel_launch: launch %d failed\n", li); break; }
    }
}
```

```cpp
#include <hip/hip_runtime.h>
#include <cstdio>
#include <cstdint>

#ifndef MK_N_LAUNCHES
#define MK_N_LAUNCHES 1
#endif
constexpr int NPHASE = 19;
#ifndef DUP_MASK
#define DUP_MASK 0u
#endif
constexpr int N_LAUNCHES = MK_N_LAUNCHES;

constexpr int BATCH = 8, SEQ = 4096, D = 1024, T = BATCH * SEQ;
constexpr int AB_IN = 2048, C_IN = 4096, NEXP = 16384;
constexpr float LN_EPS = 1e-5f;
constexpr float ALPHA = 1.41421356237309515f;
constexpr int NWAVES = 8, NTHR = 512;

constexpr size_t MiB = 1u << 20;
constexpr size_t WS_CTL = 0, CTL_ZERO_BYTES = 1 * MiB;
constexpr size_t WS_LB = 1 * MiB;
constexpr size_t WS_ROPE = 2 * MiB;
constexpr size_t WS_WABIN = 4 * MiB;
constexpr size_t WS_WABOUT = 8 * MiB;
constexpr size_t WS_WCIN = 10 * MiB;
constexpr size_t WS_WCOUT = 18 * MiB;
constexpr size_t WS_WQ = 20 * MiB;
constexpr size_t WS_KEYS = 28 * MiB;
constexpr size_t WS_DQU = 29 * MiB;
constexpr size_t WS_DQV = 29 * MiB + 131072;
constexpr size_t WS_U8 = 32 * MiB;
constexpr size_t WS_V8 = 64 * MiB;
constexpr size_t WS_XB = 96 * MiB;
constexpr size_t WS_H0 = 160 * MiB;
constexpr size_t WS_LST = 288 * MiB;
constexpr size_t WS_Y = 320 * MiB;
constexpr size_t WS_H1 = 384 * MiB;
constexpr size_t WS_EID = 448 * MiB;
constexpr size_t WS_GATE = 464 * MiB;
constexpr size_t WS_CQ = 160 * MiB, WS_CK = 224 * MiB, WS_CV = 288 * MiB, WS_CG = 352 * MiB;
constexpr size_t WS_O = 416 * MiB;
constexpr size_t WS_Y2 = 160 * MiB;
constexpr size_t WS_Q1 = 224 * MiB;
constexpr size_t WS_DEC = 480 * MiB;
constexpr size_t WS_END = 484 * MiB;

constexpr int CW_BAR = 4096;
constexpr int LDS_BYTES = 147456;
constexpr int MISC_OFF = LDS_BYTES - 128;

#define GAS __attribute__((address_space(1)))
#define LAS __attribute__((address_space(3)))
typedef unsigned short bf16;
typedef unsigned v4u __attribute__((ext_vector_type(4)));
typedef unsigned v2u __attribute__((ext_vector_type(2)));
typedef float f32x4 __attribute__((ext_vector_type(4)));
typedef GAS unsigned gu32;
#define RLX_AGENT __ATOMIC_RELAXED, __HIP_MEMORY_SCOPE_AGENT
#define LDS_WAIT() asm volatile("s_waitcnt lgkmcnt(0)" ::: "memory")
__device__ __forceinline__ unsigned f2bf(float f) { unsigned u = __builtin_bit_cast(unsigned, f); return (u + 0x7fffu + ((u >> 16) & 1u)) >> 16; }
__device__ __forceinline__ unsigned pk2(float lo, float hi) { return f2bf(lo) | (f2bf(hi) << 16); }
__device__ __forceinline__ float bf2f(unsigned b) { return __builtin_bit_cast(float, b << 16); }
__device__ __forceinline__ float bflo(unsigned w) { return __builtin_bit_cast(float, w << 16); }
__device__ __forceinline__ float bfhi(unsigned w) { return __builtin_bit_cast(float, w & 0xffff0000u); }
__device__ __forceinline__ float wave_sum(float v) {
#pragma unroll
    for (int o = 1; o < 64; o <<= 1) v += __shfl_xor(v, o);
    return v;
}

#define XB_TMO      128
#define XB_XCNT(j)  (256  + 64 * (j))
#define XB_XSUB(j)  (1280 + 64 * (j))
#define XB_XGEN(j)  (2304 + 64 * (j))
#define XB_TOP      3328
#define XB_TOPGEN   3392
#define XCD_BAR_WORDS 3456
#define XB_SPIN_CAP (1u << 21)
__device__ __forceinline__ unsigned xb_ld(unsigned* p)              { return __hip_atomic_load(p, __ATOMIC_RELAXED, __HIP_MEMORY_SCOPE_AGENT); }
__device__ __forceinline__ unsigned xb_add(unsigned* p, unsigned v) { return __hip_atomic_fetch_add(p, v, __ATOMIC_RELAXED, __HIP_MEMORY_SCOPE_AGENT); }
__device__ __forceinline__ unsigned xb_xcc_id() { return (unsigned)__builtin_amdgcn_s_getreg((3 << 11) | 20) & 0xFu; }
#define XB_SPIN(cond, bar) do { unsigned _sp = 0; while (cond) { __builtin_amdgcn_s_sleep(1); \
    if ((++_sp & 255u) == 0u) { if (xb_ld(&(bar)[XB_TMO])) break; if (_sp > XB_SPIN_CAP) { atomicAdd(&(bar)[XB_TMO], 1u); break; } } } } while (0)
struct XcdBarrier { unsigned* bar; unsigned x; volatile LAS unsigned* st; };
__device__ __forceinline__ XcdBarrier xcd_barrier_post(unsigned* bar, volatile LAS unsigned* st) {
    XcdBarrier b; b.bar = bar; b.x = xb_xcc_id(); b.st = st;
    if (threadIdx.x == 0) (void)xb_add(&bar[XB_XCNT(b.x)], 1u);
    return b;
}
__device__ __forceinline__ void xcd_barrier_complete(unsigned* bar, unsigned x, unsigned& nloc, unsigned& nx) {
    const unsigned G = gridDim.x * gridDim.y * gridDim.z;
    unsigned sum, cnt, mine, sp = 0u;
    for (;;) {
        sum = 0u; cnt = 0u; mine = 0u;
#pragma unroll
        for (unsigned j = 0; j < 16; ++j) { const unsigned c = xb_ld(&bar[XB_XCNT(j)]); sum += c; cnt += (c > 0u) ? 1u : 0u; mine = (j == x) ? c : mine; }
        if (sum == G) break;
        __builtin_amdgcn_s_sleep(1);
        if ((++sp & 255u) == 0u) { if (xb_ld(&bar[XB_TMO])) break; if (sp > XB_SPIN_CAP) { atomicAdd(&bar[XB_TMO], 1u); break; } }
    }
    nloc = mine > 0u ? mine : 1u; nx = cnt > 0u ? cnt : 1u;
}
__device__ __forceinline__ void xcd_barrier(const XcdBarrier& b) {
    asm volatile("s_waitcnt vmcnt(0)" ::: "memory");
    __syncthreads();
    if (threadIdx.x == 0) {
        unsigned* bar = b.bar;
        __builtin_amdgcn_s_waitcnt(0);
        unsigned nloc = b.st[0], nx = b.st[1];
        if (nloc == 0u) { xcd_barrier_complete(bar, b.x, nloc, nx); b.st[0] = nloc; b.st[1] = nx; }
        const unsigned old = xb_add(&bar[XB_XSUB(b.x)], 1u);
        const unsigned gen = old / nloc;
        if (old + 1u == (gen + 1u) * nloc) {
            __builtin_amdgcn_fence(__ATOMIC_RELEASE, "agent");
            asm volatile("s_waitcnt vmcnt(0)" ::: "memory");
            const unsigned og = xb_add(&bar[XB_TOP], 1u);
            const unsigned tg = og / nx;
            if (og + 1u == (tg + 1u) * nx) xb_add(&bar[XB_TOPGEN], 1u);
            else XB_SPIN(xb_ld(&bar[XB_TOPGEN]) == tg, bar);
            __builtin_amdgcn_fence(__ATOMIC_ACQUIRE, "agent");
            xb_add(&bar[XB_XGEN(b.x)], 1u);
            asm volatile("s_waitcnt vmcnt(0)" ::: "memory");
        } else {
            XB_SPIN(xb_ld(&bar[XB_XGEN(b.x)]) == gen, bar);
            __builtin_amdgcn_fence(__ATOMIC_ACQUIRE, "agent");
            asm volatile("s_waitcnt vmcnt(0)" ::: "memory");
        }
    }
    __syncthreads();
}

__device__ __forceinline__ void p0_transpose_item(const float* W, int K, int N, bf16* WT, LAS float* scr, int item, int lane) {
    const int nblk = N / 32, kb = item / nblk, nb = item % nblk, k0 = 64 * kb, n0 = 32 * nb;
#pragma unroll 8
    for (int i = 0; i < 32; ++i) { const int kk = 2 * i + (lane >> 5); scr[kk * 33 + (lane & 31)] = W[(size_t)(k0 + kk) * N + n0 + (lane & 31)]; }
    LDS_WAIT(); asm volatile("" ::: "memory");
    const int c = lane & 7;
#pragma unroll
    for (int j = 0; j < 4; ++j) { const int n = (lane >> 3) + 8 * j; const LAS float* s = scr + (8 * c) * 33 + n;
        v4u o; o.x = pk2(s[0 * 33], s[1 * 33]); o.y = pk2(s[2 * 33], s[3 * 33]); o.z = pk2(s[4 * 33], s[5 * 33]); o.w = pk2(s[6 * 33], s[7 * 33]);
        *(GAS v4u*)(WT + (size_t)(n0 + n) * K + k0 + 8 * c) = o; }
    LDS_WAIT(); asm volatile("" ::: "memory");
}

template <class Epi>
__device__ __forceinline__ void gemm_naive(LAS unsigned char* lds, const bf16* A, const bf16* Bt, int M, int N, int K, const Epi& E) {
    LAS float* As = (LAS float*)lds;
    LAS float* Bs = As + 128 * 33;
    const int tid = threadIdx.x, tx = tid & 15, ty = tid >> 4;
    const int ntn = N / 128, ntiles = (M / 128) * ntn;
    for (int tile = blockIdx.x; tile < ntiles; tile += gridDim.x) {
        const int tm = tile / ntn, tn = tile % ntn;
        float acc[4][8];
#pragma unroll
        for (int i = 0; i < 4; ++i)
#pragma unroll
            for (int j = 0; j < 8; ++j) acc[i][j] = 0.f;
        for (int k0 = 0; k0 < K; k0 += 32) {
            { const int r = tid >> 2, kc = (tid & 3) * 8;
              const v4u va = *(const GAS v4u*)(A + (size_t)(tm * 128 + r) * K + k0 + kc);
              const v4u vb = *(const GAS v4u*)(Bt + (size_t)(tn * 128 + r) * K + k0 + kc);
              LAS float* pa = As + r * 33 + kc; LAS float* pb = Bs + r * 33 + kc;
              pa[0] = bflo(va.x); pa[1] = bfhi(va.x); pa[2] = bflo(va.y); pa[3] = bfhi(va.y); pa[4] = bflo(va.z); pa[5] = bfhi(va.z); pa[6] = bflo(va.w); pa[7] = bfhi(va.w);
              pb[0] = bflo(vb.x); pb[1] = bfhi(vb.x); pb[2] = bflo(vb.y); pb[3] = bfhi(vb.y); pb[4] = bflo(vb.z); pb[5] = bfhi(vb.z); pb[6] = bflo(vb.w); pb[7] = bfhi(vb.w); }
            __syncthreads();
#pragma unroll 8
            for (int kk = 0; kk < 32; ++kk) {
                float a[4], b[8];
#pragma unroll
                for (int i = 0; i < 4; ++i) a[i] = As[(ty * 4 + i) * 33 + kk];
#pragma unroll
                for (int j = 0; j < 8; ++j) b[j] = Bs[(tx + 16 * j) * 33 + kk];
#pragma unroll
                for (int i = 0; i < 4; ++i)
#pragma unroll
                    for (int j = 0; j < 8; ++j) acc[i][j] += a[i] * b[j];
            }
            __syncthreads();
        }
#pragma unroll
        for (int i = 0; i < 4; ++i)
#pragma unroll
            for (int j = 0; j < 8; ++j) E(tm * 128 + ty * 4 + i, tn * 128 + tx + 16 * j, acc[i][j]);
    }
}
struct EpiStore { bf16* O; int ldc;
    __device__ __forceinline__ void operator()(int r, int c, float v) const { O[(size_t)r * ldc + c] = (bf16)f2bf(v); } };
struct EpiResid { const bf16* X; float* Z;
    __device__ __forceinline__ void operator()(int r, int c, float v) const { Z[(size_t)r * D + c] = ALPHA * bf2f(X[(size_t)r * D + c]) + v; } };
struct EpiCIn { bf16 *CQ, *CK, *CV, *CG; const float* lb;
    __device__ __forceinline__ void operator()(int r, int c, float v) const {
        const int seg = c >> 10, cc = c & 1023; const size_t o = (size_t)r * D + cc;
        if (seg == 0) CQ[o] = (bf16)f2bf(v);
        else if (seg == 1) { const float k = (1.f - lb[cc]) / (1.f + expf(v)); CK[o] = (bf16)f2bf(k); }
        else if (seg == 2) CV[o] = (bf16)f2bf(v);
        else CG[o] = (bf16)f2bf(v);
    } };

namespace pg8 {
#define PG8_LAS __attribute__((address_space(3)))
typedef unsigned short bf16_t;
typedef short bf16x8 __attribute__((ext_vector_type(8)));
typedef float f32x4 __attribute__((ext_vector_type(4)));
typedef unsigned u32x4 __attribute__((ext_vector_type(4)));
constexpr int BM = 256, BK = 64, HALF = 128, HTB = HALF * BK * 2  , STAGE_BYTES = 8 * HTB, NXCD = 8, WGM = 8;

__host__ __device__ __forceinline__ int lds_byte(int r, int c) { const int st = (r >> 4) * 2 + (c >> 5), rr = r & 15, cc = c & 31, ob = rr * 64 + cc * 2; return st * 1024 + (ob ^ (((ob >> 9) & 1) << 5)); }
__host__ __device__ __forceinline__ void stage_rc(int b, int& R, int& C) { const int st = b / 1024, sb = b % 1024, swz = sb ^ (((sb >> 9) & 1) << 5); R = (st >> 1) * 16 + swz / 64; C = (st & 1) * 32 + (swz % 64) / 2; }
__host__ __device__ __forceinline__ int perm32(int rho) { const int n = rho >> 4, i = rho & 15; return 8 * (i >> 2) + 4 * n + (i & 3); }

struct Unit { int pm, pn; };
struct Gemm { const bf16_t* A; const bf16_t* Bt; int M, N, K; };

struct StaticOrder {
    int nM, nN, nwg, G, c;
    __host__ __device__ void init(int M, int N, int G_, int c_) { nM = M / BM; nN = N / BM; nwg = nM * nN; G = G_; c = c_; }
    __host__ __device__ bool next(int i, Unit& u) const {
        const long L = (long)i * G + c; if (L >= nwg) return false;
        int wgid = (int)L; { const int q = nwg / NXCD, r = nwg % NXCD, xcd = wgid % NXCD, off = wgid / NXCD; wgid = (xcd < r ? xcd * (q + 1) : r * (q + 1) + (xcd - r) * q) + off; }
        const int nig = WGM * nN, gid = wgid / nig, fm = gid * WGM, gsz = (nM - fm) < WGM ? (nM - fm) : WGM;
        u.pm = fm + ((wgid % nig) % gsz); u.pn = (wgid % nig) / gsz; return true;
    }
    __device__ __forceinline__ void a_ready(const Unit&) const {}
    __device__ __forceinline__ void done(const Unit&) const {}
};

__device__ __forceinline__ unsigned cvt_pk_bf16(float lo, float hi) { unsigned r; asm volatile("v_cvt_pk_bf16_f32 %0, %1, %2" : "=v"(r) : "v"(lo), "v"(hi)); return r; }
typedef float f32x2 __attribute__((ext_vector_type(2)));
__device__ __forceinline__ f32x2 gelu_pk(f32x2 v) {
    const f32x2 av = __builtin_elementwise_abs(v), d = av * 0.2316418882f + 1.0f;
    f32x2 t; t.x = __builtin_amdgcn_rcpf(d.x); t.y = __builtin_amdgcn_rcpf(d.y);
    f32x2 q = t * 0.5307027145f + (-0.7265760135f); q = q * t + 0.7107068705f; q = q * t + (-0.142248368f); q = q * t + 0.127414796f; q = q * t;
    const f32x2 s = (v * v) * (-0.72134752044f);
    f32x2 e; e.x = __builtin_amdgcn_exp2f(s.x); e.y = __builtin_amdgcn_exp2f(s.y);
    const f32x2 m = v * (q * e), r = v - m;
    f32x2 o; o.x = v.x < 0.f ? m.x : r.x; o.y = v.y < 0.f ? m.y : r.y; return o;
}

template <int ACT  > struct EpiBf16 {
    static constexpr bool PERM = true, AFTER_DRAIN = false; static_assert(ACT == 0 || ACT == 1, "EpiBf16: ACT is 0 (none) or 1 (gelu_pk)");
    bf16_t* O; int ldc; const float* bias; int split_cols; size_t split_stride; float scale0;
    __device__ __forceinline__ void operator()(const f32x4 (&acc)[2][2][4][2], const Unit& u, int wr, int wc, int fr, int fq) const {
        const int row0 = u.pm * BM + wr * 64 + fr; int colt = u.pn * BM; bf16_t* base = O;
        float sc = 1.f; if (split_cols) { const int t = colt / split_cols; base += (size_t)t * split_stride; colt -= t * split_cols; if (t == 0) sc = scale0; }
        const int col0 = colt + wc * 32 + 8 * fq, bcol0 = u.pn * BM + wc * 32 + 8 * fq;
        f32x4 bv[2][2];
#pragma unroll
        for (int bj = 0; bj < 2; ++bj)
#pragma unroll
            for (int n = 0; n < 2; ++n) bv[bj][n] = bias ? *(const f32x4*)(bias + bcol0 + bj * HALF + 4 * n) : (f32x4){0.f, 0.f, 0.f, 0.f};
#pragma unroll
        for (int ai = 0; ai < 2; ++ai)
#pragma unroll
            for (int m = 0; m < 4; ++m) { bf16_t* rowp = base + (size_t)(row0 + ai * HALF + m * 16) * ldc + col0;
#pragma unroll
                for (int bj = 0; bj < 2; ++bj) { f32x4 v0 = acc[ai][bj][m][0] + bv[bj][0], v1 = acc[ai][bj][m][1] + bv[bj][1];
                    if (ACT == 1) { f32x2 a = gelu_pk((f32x2){v0[0], v0[1]}), b = gelu_pk((f32x2){v0[2], v0[3]}), c = gelu_pk((f32x2){v1[0], v1[1]}), d = gelu_pk((f32x2){v1[2], v1[3]});
                        v0 = (f32x4){a.x, a.y, b.x, b.y}; v1 = (f32x4){c.x, c.y, d.x, d.y}; }
                    v0 = v0 * sc; v1 = v1 * sc; u32x4 w; w.x = cvt_pk_bf16(v0[0], v0[1]); w.y = cvt_pk_bf16(v0[2], v0[3]); w.z = cvt_pk_bf16(v1[0], v1[1]); w.w = cvt_pk_bf16(v1[2], v1[3]);
                    *(u32x4*)(rowp + bj * HALF) = w; } }
    }
};

struct EpiResidF32 {
    static constexpr bool PERM = false, AFTER_DRAIN = false;
    const bf16_t* X; float* Z;
    __device__ __forceinline__ void operator()(const f32x4 (&acc)[2][2][4][2], const Unit& u, int wr, int wc, int fr, int fq) const {
        typedef unsigned u32x2 __attribute__((ext_vector_type(2)));
        const int row0 = u.pm * BM + wr * 64 + fr, col0 = u.pn * BM + wc * 32 + 4 * fq;
#pragma unroll
        for (int ai = 0; ai < 2; ++ai)
#pragma unroll
            for (int m = 0; m < 4; ++m) { const size_t ro = (size_t)(row0 + ai * HALF + m * 16) * 1024;
#pragma unroll
                for (int bj = 0; bj < 2; ++bj)
#pragma unroll
                    for (int n = 0; n < 2; ++n) { const int c = col0 + bj * HALF + n * 16; const u32x2 xw = *(const u32x2*)(X + ro + c);
                        f32x4 xv; xv[0] = __builtin_bit_cast(float, xw.x << 16); xv[1] = __builtin_bit_cast(float, xw.x & 0xffff0000u); xv[2] = __builtin_bit_cast(float, xw.y << 16); xv[3] = __builtin_bit_cast(float, xw.y & 0xffff0000u);
                        *(f32x4*)(Z + ro + c) = xv * 1.41421356237309515f + acc[ai][bj][m][n]; } }
    }
};
struct EpiCInF {
    static constexpr bool PERM = true, AFTER_DRAIN = false;
    bf16_t *CQ, *CK, *CV, *CG; const float* lb;
    __device__ __forceinline__ void operator()(const f32x4 (&acc)[2][2][4][2], const Unit& u, int wr, int wc, int fr, int fq) const {
        const int seg = u.pn >> 2, colt = (u.pn & 3) * BM;
        bf16_t* base = seg == 0 ? CQ : (seg == 1 ? CK : (seg == 2 ? CV : CG));
        const int row0 = u.pm * BM + wr * 64 + fr, col0 = colt + wc * 32 + 8 * fq;
        f32x4 om[2][2];
#pragma unroll
        for (int bj = 0; bj < 2; ++bj)
#pragma unroll
            for (int n = 0; n < 2; ++n) { const f32x4 l = *(const f32x4*)(lb + col0 + bj * HALF + 4 * n); om[bj][n] = 1.0f - l; }
#pragma unroll
        for (int ai = 0; ai < 2; ++ai)
#pragma unroll
            for (int m = 0; m < 4; ++m) { bf16_t* rowp = base + (size_t)(row0 + ai * HALF + m * 16) * 1024 + col0;
#pragma unroll
                for (int bj = 0; bj < 2; ++bj) { f32x4 v0 = acc[ai][bj][m][0], v1 = acc[ai][bj][m][1];
                    if (seg == 1) {
#pragma unroll
                        for (int q = 0; q < 4; ++q) { v0[q] = om[bj][0][q] / (1.0f + __expf(v0[q])); v1[q] = om[bj][1][q] / (1.0f + __expf(v1[q])); } }
                    u32x4 w; w.x = cvt_pk_bf16(v0[0], v0[1]); w.y = cvt_pk_bf16(v0[2], v0[3]); w.z = cvt_pk_bf16(v1[0], v1[1]); w.w = cvt_pk_bf16(v1[2], v1[3]);
                    *(u32x4*)(rowp + bj * HALF) = w; } }
    }
};
template <class Epi, class Sched, bool ALIGN_EPI = false, bool SP2 = false>
__device__ __forceinline__ void gemm_phase(PG8_LAS unsigned char* lds, const Gemm g, const Sched& S, const Epi& E) {
    const int tid = threadIdx.x, wid = __builtin_amdgcn_readfirstlane(tid >> 6), lane = tid & 63, wr = wid >> 2, wc = wid & 3, fr = lane & 15, fq = lane >> 4;
    const int K = g.K, nt = K / BK;
    unsigned voffA[2], voffB[2];
#pragma unroll
    for (int i = 0; i < 2; ++i) { int R, C; stage_rc(tid * 16 + i * 8192, R, C); const int Rb = Epi::PERM ? ((R & ~31) + perm32(R & 31)) : R;
        voffA[i] = (unsigned)(R * K + C) * 2u; voffB[i] = (unsigned)(Rb * K + C) * 2u; }
    const size_t kstep = (size_t)(BK * 2);
    const size_t hstep = (size_t)HALF * K * 2;
    const size_t tstep = 2 * hstep;
    const unsigned ldsw = (unsigned)wid * 1024u;
    const int aoff = lds_byte(wr * 64 + fr, fq * 8), boff = lds_byte(wc * 32 + fr, fq * 8);
#define PG8_SA(b, h) (((b) * 2 + (h)) * HTB)
#define PG8_SB(b, h) ((4 + (b) * 2 + (h)) * HTB)
#define PG8_STAGE(bufoff, gbase, voff) do { _Pragma("unroll") for (int _i = 0; _i < 2; ++_i) \
        __builtin_amdgcn_global_load_lds((const unsigned*)((const char*)(gbase) + (voff)[_i]), (PG8_LAS unsigned*)(lds + (bufoff) + ldsw + _i * 8192), 16, 0, 0); } while (0)
#define PG8_LDA(dst, b, h) do { _Pragma("unroll") for (int m = 0; m < 4; ++m) _Pragma("unroll") for (int k = 0; k < 2; ++k) dst[m][k] = *(const PG8_LAS bf16x8*)(lds + PG8_SA(b, h) + aoff + m * 2048 + k * 1024); } while (0)
#define PG8_LDB(dst, b, h) do { _Pragma("unroll") for (int n = 0; n < 2; ++n) _Pragma("unroll") for (int k = 0; k < 2; ++k) dst[n][k] = *(const PG8_LAS bf16x8*)(lds + PG8_SB(b, h) + boff + n * 2048 + k * 1024); } while (0)
#define PG8_MMA(ai, bj, At, Bt) do { __builtin_amdgcn_s_setprio(1); _Pragma("unroll") for (int m = 0; m < 4; ++m) _Pragma("unroll") for (int n = 0; n < 2; ++n) _Pragma("unroll") for (int k = 0; k < 2; ++k) \
        acc[ai][bj][m][n] = __builtin_amdgcn_mfma_f32_16x16x32_bf16(Bt[n][k], At[m][k], acc[ai][bj][m][n], 0, 0, 0); __builtin_amdgcn_s_setprio(0); } while (0)
#define PG8_WAIT_V(n) asm volatile("s_waitcnt vmcnt(" #n ")" ::: "memory")
#define PG8_WAIT_L(n) asm volatile("s_waitcnt lgkmcnt(" #n ")" ::: "memory")
#define PG8_BAR __builtin_amdgcn_s_barrier()
#define PG8_SCHED __builtin_amdgcn_sched_barrier(0)
    Unit cur, nxt; int ui = 0;
    if (!S.next(0, cur)) return;
    f32x4 acc[2][2][4][2];
#pragma unroll
    for (int a = 0; a < 2; ++a)
#pragma unroll
        for (int b = 0; b < 2; ++b)
#pragma unroll
            for (int m = 0; m < 4; ++m)
#pragma unroll
                for (int n = 0; n < 2; ++n) acc[a][b][m][n] = (f32x4){0.f, 0.f, 0.f, 0.f};
    bf16x8 At[4][2], B0[2][2], B1[2][2];
    const char* cA = (const char*)g.A + (size_t)cur.pm * tstep; const char* cB = (const char*)g.Bt + (size_t)cur.pn * tstep;
    S.a_ready(cur);
    if constexpr (SP2) {
        PG8_STAGE(PG8_SB(0, 0), cB, voffB); PG8_STAGE(PG8_SB(0, 1), cB + hstep, voffB); PG8_STAGE(PG8_SA(0, 0), cA, voffA); PG8_STAGE(PG8_SA(0, 1), cA + hstep, voffA);
        if (wr == 1) PG8_BAR;
        PG8_WAIT_V(2); PG8_BAR;
        PG8_STAGE(PG8_SB(1, 0), cB + kstep, voffB); PG8_STAGE(PG8_SA(1, 0), cA + kstep, voffA); PG8_STAGE(PG8_SB(1, 1), cB + hstep + kstep, voffB);
        PG8_WAIT_V(6); PG8_BAR;
    } else {
        PG8_STAGE(PG8_SB(0, 0), cB, voffB); PG8_STAGE(PG8_SA(0, 0), cA, voffA); PG8_STAGE(PG8_SB(0, 1), cB + hstep, voffB); PG8_STAGE(PG8_SA(0, 1), cA + hstep, voffA);
        if (wr == 1) PG8_BAR;
        PG8_WAIT_V(4); PG8_BAR;
        PG8_STAGE(PG8_SB(1, 0), cB + kstep, voffB); PG8_STAGE(PG8_SA(1, 0), cA + kstep, voffA); PG8_STAGE(PG8_SB(1, 1), cB + hstep + kstep, voffB);
        PG8_WAIT_V(6); PG8_BAR;
    }
    for (;;) {
        const bool has_next = S.next(ui + 1, nxt);
        const char* nA = has_next ? (const char*)g.A + (size_t)nxt.pm * tstep : cA; const char* nB = has_next ? (const char*)g.Bt + (size_t)nxt.pn * tstep : cB;
        for (int t = 0; t < nt; t += 2) {
            const bool last = (t == nt - 2);
            const char* a1 = cA + (size_t)(t + 1) * kstep;
            const char* a2 = last ? nA : cA + (size_t)(t + 2) * kstep; const char* b2 = last ? nB : cB + (size_t)(t + 2) * kstep;
            const char* a3 = a2 + kstep; const char* b3 = b2 + kstep;
            if (last && has_next) S.a_ready(nxt);
            if constexpr (SP2) {
            PG8_LDB(B0, 0, 0); PG8_LDB(B1, 0, 1); PG8_SCHED; PG8_LDA(At, 0, 0); PG8_STAGE(PG8_SA(1, 1), a1 + hstep, voffA);
            PG8_WAIT_V(8); PG8_WAIT_L(0); PG8_BAR; PG8_MMA(0, 0, At, B0); PG8_MMA(0, 1, At, B1); PG8_BAR; PG8_SCHED;
            PG8_LDA(At, 0, 1); PG8_STAGE(PG8_SB(0, 0), b2, voffB); PG8_STAGE(PG8_SB(0, 1), b2 + hstep, voffB); PG8_STAGE(PG8_SA(0, 0), a2, voffA);
            PG8_WAIT_V(8); PG8_WAIT_L(0); PG8_BAR; PG8_MMA(1, 0, At, B0); PG8_MMA(1, 1, At, B1); PG8_BAR; PG8_SCHED;
            PG8_LDB(B0, 1, 0); PG8_LDB(B1, 1, 1); PG8_SCHED; PG8_LDA(At, 1, 0); PG8_STAGE(PG8_SA(0, 1), a2 + hstep, voffA);
            PG8_WAIT_V(8); PG8_WAIT_L(0); PG8_BAR; PG8_MMA(0, 0, At, B0); PG8_MMA(0, 1, At, B1); PG8_BAR; PG8_SCHED;
            PG8_LDA(At, 1, 1); PG8_STAGE(PG8_SB(1, 0), b3, voffB); PG8_STAGE(PG8_SB(1, 1), b3 + hstep, voffB); PG8_STAGE(PG8_SA(1, 0), a3, voffA);
            PG8_WAIT_V(8); PG8_WAIT_L(0); PG8_BAR; PG8_MMA(1, 0, At, B0); PG8_MMA(1, 1, At, B1); PG8_BAR; PG8_SCHED;
            } else {
            PG8_LDB(B0, 0, 0); PG8_SCHED; PG8_LDA(At, 0, 0); PG8_STAGE(PG8_SA(1, 1), a1 + hstep, voffA);
            PG8_WAIT_L(8); PG8_BAR; PG8_WAIT_L(0); PG8_MMA(0, 0, At, B0); PG8_BAR; PG8_SCHED;
            PG8_LDB(B1, 0, 1); PG8_STAGE(PG8_SB(0, 0), b2, voffB);
            PG8_BAR; PG8_WAIT_L(0); PG8_MMA(0, 1, At, B1); PG8_BAR;
            PG8_LDA(At, 0, 1); PG8_STAGE(PG8_SA(0, 0), a2, voffA);
            PG8_BAR; PG8_WAIT_L(0); PG8_MMA(1, 0, At, B0); PG8_BAR; PG8_SCHED;
            PG8_STAGE(PG8_SB(0, 1), b2 + hstep, voffB);
            PG8_WAIT_V(6); PG8_BAR; PG8_MMA(1, 1, At, B1); PG8_BAR;
            PG8_LDB(B0, 1, 0); PG8_SCHED; PG8_LDA(At, 1, 0); PG8_STAGE(PG8_SA(0, 1), a2 + hstep, voffA);
            PG8_WAIT_L(8); PG8_BAR; PG8_WAIT_L(0); PG8_MMA(0, 0, At, B0); PG8_BAR; PG8_SCHED;
            PG8_LDB(B1, 1, 1); PG8_STAGE(PG8_SB(1, 0), b3, voffB);
            PG8_BAR; PG8_WAIT_L(0); PG8_MMA(0, 1, At, B1); PG8_BAR;
            PG8_LDA(At, 1, 1); PG8_STAGE(PG8_SA(1, 0), a3, voffA);
            PG8_BAR; PG8_WAIT_L(0); PG8_MMA(1, 0, At, B0); PG8_BAR; PG8_SCHED;
            PG8_STAGE(PG8_SB(1, 1), b3 + hstep, voffB);
            PG8_WAIT_V(6); PG8_BAR; PG8_MMA(1, 1, At, B1); PG8_BAR;
            }
        }
        if constexpr (ALIGN_EPI) { if (wr == 0) PG8_BAR; }
        if constexpr (!Epi::AFTER_DRAIN) { E(acc, cur, wr, wc, fr, fq); S.done(cur); }
        if (!has_next) break;
#pragma unroll
        for (int a = 0; a < 2; ++a)
#pragma unroll
            for (int b = 0; b < 2; ++b)
#pragma unroll
                for (int m = 0; m < 4; ++m)
#pragma unroll
                    for (int n = 0; n < 2; ++n) acc[a][b][m][n] = (f32x4){0.f, 0.f, 0.f, 0.f};
        cur = nxt; cA = nA; cB = nB; ++ui;
        if constexpr (ALIGN_EPI) { if (wr == 1) PG8_BAR; }
    }
    PG8_WAIT_V(0);
    if constexpr (!ALIGN_EPI) { if (wr == 0) PG8_BAR; }
    PG8_BAR;
    if constexpr (Epi::AFTER_DRAIN) { E.fused(acc, cur, wr, wc, fr, fq, lds, wid, lane); S.done(cur); }
#undef PG8_SA
#undef PG8_SB
#undef PG8_STAGE
#undef PG8_LDA
#undef PG8_LDB
#undef PG8_MMA
#undef PG8_WAIT_V
#undef PG8_WAIT_L
#undef PG8_BAR
#undef PG8_SCHED
}
}

__device__ __forceinline__ float gamma_log2(int h) { return log2f(1.f - exp2f(-5.f - (float)h)); }

__device__ __forceinline__ void phase_prologue(LAS unsigned char* lds, const float* const* in, unsigned char* ws) {
    const int tid = threadIdx.x, lane = tid & 63, wave = tid >> 6;
    const int gw = blockIdx.x * NWAVES + wave, NGW = gridDim.x * NWAVES;
    LAS float* scr = (LAS float*)(lds + wave * 16384);
    constexpr int I_ABIN = (D / 64) * (AB_IN / 32), I_SQ = (D / 64) * (D / 32), I_CIN = (D / 64) * (C_IN / 32), I_WQ = (D / 64) * (2048 / 32);
    constexpr int NITEMS = I_ABIN + I_SQ + I_CIN + I_SQ + 2 * I_WQ;
    for (int it = gw; it < NITEMS; it += NGW) {
        int r = it;
        if (r < I_ABIN) { p0_transpose_item(in[1], D, AB_IN, (bf16*)(ws + WS_WABIN), scr, r, lane); continue; } r -= I_ABIN;
        if (r < I_SQ) { p0_transpose_item(in[5], D, D, (bf16*)(ws + WS_WABOUT), scr, r, lane); continue; } r -= I_SQ;
        if (r < I_CIN) { p0_transpose_item(in[6], D, C_IN, (bf16*)(ws + WS_WCIN), scr, r, lane); continue; } r -= I_CIN;
        if (r < I_SQ) { p0_transpose_item(in[9], D, D, (bf16*)(ws + WS_WCOUT), scr, r, lane); continue; } r -= I_SQ;
        if (r < I_WQ) { p0_transpose_item(in[10], D, 2048, (bf16*)(ws + WS_WQ), scr, r, lane); continue; } r -= I_WQ;
        p0_transpose_item(in[10] + (size_t)D * 2048, D, 2048, (bf16*)(ws + WS_WQ) + (size_t)2048 * D, scr, r, lane);
    }
    const size_t gt = (size_t)blockIdx.x * NTHR + tid, NT = (size_t)gridDim.x * NTHR;
    { const float* x = in[0]; bf16* xb = (bf16*)(ws + WS_XB);
      for (size_t i = gt; i < (size_t)T * D / 8; i += NT) { const f32x4 a = *(const GAS f32x4*)(x + i * 8), b = *(const GAS f32x4*)(x + i * 8 + 4);
          v4u o; o.x = pk2(a.x, a.y); o.y = pk2(a.z, a.w); o.z = pk2(b.x, b.y); o.w = pk2(b.z, b.w); *(GAS v4u*)(xb + i * 8) = o; } }
    { const float* k = in[11]; bf16* kb = (bf16*)(ws + WS_KEYS);
      for (size_t i = gt; i < (size_t)2 * 8 * 2 * 128 * 128 / 8; i += NT) { const f32x4 a = *(const GAS f32x4*)(k + i * 8), b = *(const GAS f32x4*)(k + i * 8 + 4);
          v4u o; o.x = pk2(a.x, a.y); o.y = pk2(a.z, a.w); o.z = pk2(b.x, b.y); o.w = pk2(b.z, b.w); *(GAS v4u*)(kb + i * 8) = o; } }
    { float* ct = (float*)(ws + WS_ROPE); float* st = ct + 4096 * 32;
      for (size_t i = gt; i < (size_t)4096 * 32; i += NT) { const int pos = (int)(i >> 5), f = (int)(i & 31);
          const double inv = exp(-log(10000.0) * ((double)f / 31.0)); const double ang = (double)pos * inv;
          ct[i] = (float)cos(ang); st[i] = (float)sin(ang); } }
    { const float* l = in[7]; float* lb = (float*)(ws + WS_LB);
      for (size_t i = gt; i < 1024; i += NT) { const float a = l[i], b = l[1024 + i]; const float m = fmaxf(a, b); const float ea = expf(a - m), eb = expf(b - m); lb[i] = eb / (ea + eb); } }
}

__device__ __forceinline__ void phase_ret_local(LAS unsigned char* lds, unsigned char* ws) {
    const int tid = threadIdx.x;
    const bf16* H0 = (const bf16*)(ws + WS_H0); float* LST = (float*)(ws + WS_LST);
    const float* ct = (const float*)(ws + WS_ROPE); const float* st = ct + 4096 * 32;
    LAS float* kd = (LAS float*)lds;
    LAS float* vv = (LAS float*)(lds + 32768);
    for (int item = blockIdx.x; item < 1024; item += gridDim.x) {
        const int n = item & 31, h = (item >> 5) & 3, b = item >> 7;
        const size_t t0 = (size_t)b * SEQ + n * 128; const float lg = gamma_log2(h);
        for (int idx = tid; idx < 4096; idx += NTHR) { const int s = idx >> 5, i = idx & 31, pos = n * 128 + s;
            const bf16* row = H0 + (t0 + s) * AB_IN + 768 + h * 64;
            const float x1 = bf2f(row[i]), x2 = bf2f(row[i + 32]); const float c = ct[pos * 32 + i], sn = st[pos * 32 + i];
            const float dec = exp2f((float)(127 - s) * lg) * 0.125f;
            kd[s * 64 + i] = (x1 * c - x2 * sn) * dec; kd[s * 64 + i + 32] = (x2 * c + x1 * sn) * dec; }
        for (int idx = tid; idx < 16384; idx += NTHR) { const int s = idx >> 7, e = idx & 127; vv[idx] = bf2f(H0[(t0 + s) * AB_IN + 1024 + h * 128 + e]); }
        __syncthreads();
        const int e = tid & 127, dg = tid >> 7;
        float acc[16];
#pragma unroll
        for (int j = 0; j < 16; ++j) acc[j] = 0.f;
        for (int s = 0; s < 128; ++s) { const float v = vv[s * 128 + e];
#pragma unroll
            for (int j = 0; j < 16; ++j) acc[j] += kd[s * 64 + dg * 16 + j] * v; }
#pragma unroll
        for (int j = 0; j < 16; ++j) LST[(size_t)item * 8192 + (dg * 16 + j) * 128 + e] = acc[j];
        __syncthreads();
    }
}
__device__ __forceinline__ void phase_ret_prefix(unsigned char* ws) {
    float* LST = (float*)(ws + WS_LST);
    const size_t gt = (size_t)blockIdx.x * NTHR + threadIdx.x, NT = (size_t)gridDim.x * NTHR;
    for (size_t idx = gt; idx < (size_t)32 * 8192; idx += NT) { const int bh = (int)(idx >> 13), el = (int)(idx & 8191), h = bh & 3;
        const float g128 = exp2f(128.f * gamma_log2(h)); float S = 0.f;
        for (int n = 0; n < 32; ++n) { float* p = LST + ((size_t)(bh * 32 + n) * 8192 + el); const float tmp = *p; *p = S; S = S * g128 + tmp; } }
}
__device__ __forceinline__ void phase_ret_out_pool(LAS unsigned char* lds, const float* const* in, unsigned char* ws) {
    const int tid = threadIdx.x;
    const bf16* H0 = (const bf16*)(ws + WS_H0); const float* LST = (const float*)(ws + WS_LST); bf16* Y = (bf16*)(ws + WS_Y);
    const float* ct = (const float*)(ws + WS_ROPE); const float* st = ct + 4096 * 32;
    const float* pool_w = in[2]; const float* pool_scale = in[3]; const float* ret_g = in[4];
    LAS float* qs = (LAS float*)lds;
    LAS float* ks = qs + 128 * 65;
    LAS float* R2 = (LAS float*)(lds + 66560);
    LAS float* PA = (LAS float*)lds;
    LAS float* PB = (LAS float*)(lds + 66048);
    for (int item = blockIdx.x; item < 256; item += gridDim.x) {
        const int n = item & 31, b = item >> 5; const size_t t0 = (size_t)b * SEQ + n * 128;
        const int c = tid >> 2, eg = tid & 3;
        for (int h = 0; h < 4; ++h) {
            const float lg = gamma_log2(h);
            for (int idx = tid; idx < 4096; idx += NTHR) { const int s = idx >> 5, i = idx & 31, pos = n * 128 + s;
                const bf16* rq = H0 + (t0 + s) * AB_IN + 512 + h * 64; const bf16* rk = H0 + (t0 + s) * AB_IN + 768 + h * 64;
                const float cs = ct[pos * 32 + i], sn = st[pos * 32 + i];
                const float q1 = bf2f(rq[i]), q2 = bf2f(rq[i + 32]), k1 = bf2f(rk[i]), k2 = bf2f(rk[i + 32]);
                qs[s * 65 + i] = q1 * cs - q2 * sn; qs[s * 65 + i + 32] = q2 * cs + q1 * sn;
                ks[s * 65 + i] = (k1 * cs - k2 * sn) * 0.125f; ks[s * 65 + i + 32] = (k2 * cs + k1 * sn) * 0.125f; }
            { const float* Sg = LST + (size_t)((b * 4 + h) * 32 + n) * 8192;
              for (int idx = tid; idx < 8192; idx += NTHR) R2[idx] = Sg[idx]; }
            __syncthreads();
            float o[32];
#pragma unroll
            for (int j = 0; j < 32; ++j) o[j] = 0.f;
            for (int d = 0; d < 64; ++d) { const float qv = qs[c * 65 + d];
#pragma unroll
                for (int j = 0; j < 32; ++j) o[j] += qv * R2[d * 128 + eg * 32 + j]; }
            { const float qd = exp2f((float)(c + 1) * lg);
#pragma unroll
              for (int j = 0; j < 32; ++j) o[j] *= qd; }
            __syncthreads();
            for (int idx = tid; idx < 16384; idx += NTHR) { const int s = idx >> 7, e = idx & 127; R2[idx] = bf2f(H0[(t0 + s) * AB_IN + 1024 + h * 128 + e]); }
            __syncthreads();
            for (int s = 0; s <= c; ++s) {
                float dot = 0.f;
#pragma unroll 16
                for (int d = 0; d < 64; ++d) dot += qs[c * 65 + d] * ks[s * 65 + d];
                const float w = dot * exp2f((float)(c - s) * lg);
#pragma unroll
                for (int j = 0; j < 32; ++j) o[j] += w * R2[s * 128 + eg * 32 + j];
            }
            float sum = 0.f;
#pragma unroll
            for (int j = 0; j < 32; ++j) sum += o[j];
            sum += __shfl_xor(sum, 1); sum += __shfl_xor(sum, 2);
            const float mean = sum * (1.f / 128.f); float sq = 0.f;
#pragma unroll
            for (int j = 0; j < 32; ++j) { const float dl = o[j] - mean; sq += dl * dl; }
            sq += __shfl_xor(sq, 1); sq += __shfl_xor(sq, 2);
            const float rstd = 1.f / sqrtf(sq * (1.f / 128.f) + LN_EPS);
            { const bf16* rg = H0 + (t0 + c) * AB_IN + 1536 + h * 128 + eg * 32; bf16* yo = Y + (t0 + c) * D + 512 + h * 128 + eg * 32;
#pragma unroll
              for (int j = 0; j < 32; ++j) { const float g = bf2f(rg[j]); const float sg = g / (1.f + expf(-g));
                  yo[j] = (bf16)f2bf((o[j] - mean) * rstd * ret_g[h * 128 + eg * 32 + j] * sg); } }
            __syncthreads();
        }
        for (int gi = 0; gi < 4; ++gi) {
            const int w = 2 << gi;
            for (int idx = tid; idx < 16384; idx += NTHR) { const int s = idx >> 7, cc = idx & 127, pos = n * 128 + s; const int cnt = (pos + 1 < w) ? pos + 1 : w;
                float sum = 0.f; for (int j = 0; j < cnt; ++j) sum += bf2f(H0[(t0 + s - j) * AB_IN + gi * 128 + cc]);
                PA[s * 129 + cc] = sum / (float)cnt - bf2f(H0[(t0 + s) * AB_IN + gi * 128 + cc]); }
            for (int idx = tid; idx < 16384; idx += NTHR) PB[idx] = pool_w[gi * 16384 + idx];
            __syncthreads();
            float o[32];
#pragma unroll
            for (int j = 0; j < 32; ++j) o[j] = 0.f;
            for (int cc = 0; cc < 128; ++cc) { const float pv = PA[c * 129 + cc];
#pragma unroll
                for (int j = 0; j < 32; ++j) o[j] += pv * PB[cc * 128 + eg * 32 + j]; }
            { bf16* yo = Y + (t0 + c) * D + gi * 128 + eg * 32;
#pragma unroll
              for (int j = 0; j < 32; ++j) yo[j] = (bf16)f2bf(o[j] * pool_scale[gi * 128 + eg * 32 + j]); }
            __syncthreads();
        }
    }
}
__device__ __forceinline__ void phase_ln(const float* Z, bf16* O, const float* g, const float* bb) {
    const int tid = threadIdx.x, lane = tid & 63, wave = tid >> 6;
    const int gw = blockIdx.x * NWAVES + wave, NGW = gridDim.x * NWAVES;
    for (int m = gw; m < T; m += NGW) {
        const GAS f32x4* zr = (const GAS f32x4*)(Z + (size_t)m * D) + lane;
        f32x4 v[4]; float s = 0.f;
#pragma unroll
        for (int j = 0; j < 4; ++j) { v[j] = zr[64 * j]; s += (v[j].x + v[j].y) + (v[j].z + v[j].w); }
        const float mean = wave_sum(s) * (1.f / D); float s2 = 0.f;
#pragma unroll
        for (int j = 0; j < 4; ++j) { v[j] = v[j] - mean; s2 += (v[j].x * v[j].x + v[j].y * v[j].y) + (v[j].z * v[j].z + v[j].w * v[j].w); }
        const float rstd = 1.f / sqrtf(wave_sum(s2) * (1.f / D) + LN_EPS);
        GAS v2u* o8 = (GAS v2u*)(O + (size_t)m * D) + lane;
#pragma unroll
        for (int j = 0; j < 4; ++j) { const f32x4 gg = *((const GAS f32x4*)g + lane + 64 * j), b4 = *((const GAS f32x4*)bb + lane + 64 * j);
            v2u o; o.x = pk2(v[j].x * rstd * gg.x + b4.x, v[j].y * rstd * gg.y + b4.y); o.y = pk2(v[j].z * rstd * gg.z + b4.z, v[j].w * rstd * gg.w + b4.w); o8[64 * j] = o; }
    }
}
__device__ __forceinline__ void wave_argmax(float& bv, int& bi) {
#pragma unroll
    for (int off = 32; off >= 1; off >>= 1) { const float ov = __shfl_xor(bv, off); const int oi = __shfl_xor(bi, off);
        if (ov > bv || (ov == bv && oi < bi)) { bv = ov; bi = oi; } }
}
__device__ __forceinline__ void phase_topk(LAS unsigned char* lds, const bf16* Q, const float* keys  , int* EID, float* GATE) {
    const int tid = threadIdx.x, lane = tid & 63, wave = tid >> 6;
    LAS float* kl = (LAS float*)lds;
    LAS float* qt = (LAS float*)(lds + 66048);
    LAS float* sc = (LAS float*)(lds + 82560);
    for (int item = blockIdx.x; item < (T / 32) * 8; item += gridDim.x) {
        const int h = item & 7, tile = item >> 3; const size_t tok0 = (size_t)tile * 32;
        for (int p = 0; p < 2; ++p) {
            const float* kg = keys + (size_t)((h * 2 + p) * 128) * 128;
            for (int idx = tid; idx < 16384; idx += NTHR) { const int k = idx >> 7, d = idx & 127; kl[k * 129 + d] = kg[idx]; }
            for (int idx = tid; idx < 4096; idx += NTHR) { const int t = idx >> 7, d = idx & 127; qt[t * 129 + d] = bf2f(Q[(tok0 + t) * 2048 + h * 256 + p * 128 + d]); }
            __syncthreads();
            { const int t = tid >> 4, kg16 = tid & 15;
              for (int jj = 0; jj < 8; ++jj) { const int k = kg16 + 16 * jj; float dot = 0.f;
#pragma unroll 16
                  for (int d = 0; d < 128; ++d) dot += qt[t * 129 + d] * kl[k * 129 + d];
                  sc[(t * 2 + p) * 128 + k] = dot; } }
            __syncthreads();
        }
        for (int tt = 0; tt < 4; ++tt) {
            const int t = wave * 4 + tt;
            float tv[2]; int ti[2];
#pragma unroll
            for (int p = 0; p < 2; ++p) {
                float v0 = sc[(t * 2 + p) * 128 + lane], v1 = sc[(t * 2 + p) * 128 + lane + 64];
                float mv = 0.f; int mi = 0;
                for (int j = 0; j < 16; ++j) {
                    float bv; int bi; if (v0 >= v1) { bv = v0; bi = lane; } else { bv = v1; bi = lane + 64; }
                    wave_argmax(bv, bi);
                    if (lane == j) { mv = bv; mi = bi; }
                    if (bi == lane) v0 = -INFINITY; if (bi == lane + 64) v1 = -INFINITY;
                }
                tv[p] = mv; ti[p] = mi;
            }
            float cv[4];
#pragma unroll
            for (int m = 0; m < 4; ++m) { const int cidx = lane + 64 * m; cv[m] = __shfl(tv[0], cidx >> 4) + __shfl(tv[1], cidx & 15); }
            float bestv = 0.f; int bestc = 0;
            for (int j = 0; j < 16; ++j) {
                float bv = cv[0]; int bi = lane;
#pragma unroll
                for (int m = 1; m < 4; ++m) if (cv[m] > bv) { bv = cv[m]; bi = lane + 64 * m; }
                wave_argmax(bv, bi);
                if (lane == j) { bestv = bv; bestc = bi; }
#pragma unroll
                for (int m = 0; m < 4; ++m) if (bi == lane + 64 * m) cv[m] = -INFINITY;
            }
            const float mx = __shfl(bestv, 0);
            const float ex = (lane < 16) ? expf(bestv - mx) : 0.f;
            const float den = wave_sum(ex);
            const int ia = __shfl(ti[0], bestc >> 4), ib = __shfl(ti[1], bestc & 15);
            if (lane < 16) { const size_t o = (tok0 + t) * 128 + h * 16 + lane; EID[o] = ia * 128 + ib; GATE[o] = ex / den; }
        }
        __syncthreads();
    }
}

typedef short bf16x8 __attribute__((ext_vector_type(8)));
typedef float f32x16 __attribute__((ext_vector_type(16)));
#define CEF_D(a, b) { const float hi_ = fmaxf((a), (b)), lo_ = fminf((a), (b)); (a) = hi_; (b) = lo_; }
#define CEF_A(a, b) { const float hi_ = fmaxf((a), (b)), lo_ = fminf((a), (b)); (a) = lo_; (b) = hi_; }
#define CEP_D(ka, pa, kb, pb) { const bool sw_ = (kb) > (ka); const float k0_ = sw_ ? (kb) : (ka), k1_ = sw_ ? (ka) : (kb); const int p0_ = sw_ ? (pb) : (pa), p1_ = sw_ ? (pa) : (pb); (ka) = k0_; (kb) = k1_; (pa) = p0_; (pb) = p1_; }
template <int OFF, int NV> __device__ __forceinline__ void bsort16_desc(float (&v)[NV]) {
#pragma unroll
    for (int k = 2; k <= 16; k <<= 1) {
#pragma unroll
        for (int j = k >> 1; j > 0; j >>= 1) {
#pragma unroll
            for (int i = 0; i < 16; ++i) { const int l = i ^ j;
                if (l > i) { if ((i & k) == 0) CEF_D(v[OFF + i], v[OFF + l]) else CEF_A(v[OFF + i], v[OFF + l]) } }
        }
    }
}
template <int OA, int NV> __device__ __forceinline__ void bmerge16_desc(float (&v)[NV]) {
#pragma unroll
    for (int j = 8; j > 0; j >>= 1) {
#pragma unroll
        for (int i = 0; i < 16; ++i) { const int l = i ^ j; if (l > i) CEF_D(v[OA + i], v[OA + l]) }
    }
}
template <int OA, int OB, int NV> __device__ __forceinline__ void merge_top16(float (&v)[NV]) {
#pragma unroll
    for (int i = 0; i < 16; ++i) v[OA + i] = fmaxf(v[OA + i], v[OB + 15 - i]);
    bmerge16_desc<OA, NV>(v);
}
template <int OFF, int NV> __device__ __forceinline__ void bsort16p_desc(float (&v)[NV], int (&q)[NV]) {
#pragma unroll
    for (int k = 2; k <= 16; k <<= 1) {
#pragma unroll
        for (int j = k >> 1; j > 0; j >>= 1) {
#pragma unroll
            for (int i = 0; i < 16; ++i) { const int l = i ^ j;
                if (l > i) { if ((i & k) == 0) CEP_D(v[OFF + i], q[OFF + i], v[OFF + l], q[OFF + l]) else CEP_D(v[OFF + l], q[OFF + l], v[OFF + i], q[OFF + i]) } }
        }
    }
}
template <int OA, int NV> __device__ __forceinline__ void bmerge16p_desc(float (&v)[NV], int (&q)[NV]) {
#pragma unroll
    for (int j = 8; j > 0; j >>= 1) {
#pragma unroll
        for (int i = 0; i < 16; ++i) { const int l = i ^ j; if (l > i) CEP_D(v[OA + i], q[OA + i], v[OA + l], q[OA + l]) }
    }
}
__host__ __device__ constexpr int pair_i(int s) { return s < 16 ? 0 : s < 24 ? 1 : s < 29 ? 2 : s < 33 ? 3 : s < 36 ? 4 : s < 38 ? 5 : s < 40 ? 6 : s < 42 ? 7 : (s - 42 + 8); }
__host__ __device__ constexpr int pair_j(int s) { return s < 16 ? s : s < 24 ? s - 16 : s < 29 ? s - 24 : s < 33 ? s - 29 : s < 36 ? s - 33 : s < 38 ? s - 36 : s < 40 ? s - 38 : s < 42 ? s - 40 : 0; }
__device__ __forceinline__ void phase_topk_fast(LAS unsigned char* lds, const bf16* Q, const bf16* keysb  , int* EID, float* GATE) {
    const int tid = threadIdx.x, lane = tid & 63, wave = __builtin_amdgcn_readfirstlane(tid >> 6);
    const int c = lane & 31, hh = lane >> 5;
    for (int hi = blockIdx.x; hi < 256; hi += gridDim.x) {
        const int h = hi & 7, rank = hi >> 3;
        __syncthreads();
        for (int idx = tid; idx < 2 * 128 * 16; idx += NTHR) { const int rowi = idx >> 4, ch = idx & 15;
            const v4u kv = *(const GAS v4u*)(keysb + (size_t)h * 32768 + rowi * 128 + ch * 8);
            *(LAS v4u*)(lds + rowi * 272 + ch * 16) = kv; }
        __syncthreads();
        for (int it = 0; it < 4; ++it) {
            const int tile = rank * 8 + wave + 256 * it;
            const size_t tok0 = (size_t)tile * 32;
            float ta[16], tb[16];
#pragma unroll
            for (int p = 0; p < 2; ++p) {
                bf16x8 bq[8];
                const bf16* qrow = Q + (tok0 + c) * 2048 + h * 256 + p * 128 + 8 * hh;
#pragma unroll
                for (int ks = 0; ks < 8; ++ks) bq[ks] = *(const GAS bf16x8*)(qrow + 16 * ks);
                f32x16 acc[4];
#pragma unroll
                for (int blk = 0; blk < 4; ++blk) {
#pragma unroll
                    for (int r = 0; r < 16; ++r) acc[blk][r] = 0.f;
#pragma unroll
                    for (int ks = 0; ks < 8; ++ks) { const bf16x8 a = *(const LAS bf16x8*)(lds + (p * 128 + 32 * blk + c) * 272 + (16 * ks + 8 * hh) * 2);
                        acc[blk] = __builtin_amdgcn_mfma_f32_32x32x16_bf16(a, bq[ks], acc[blk], 0, 0, 0); }
                }
                float v[64];
#pragma unroll
                for (int blk = 0; blk < 4; ++blk)
#pragma unroll
                    for (int r = 0; r < 16; ++r)
                    { const float sv = acc[blk][r]; v[blk * 16 + r] = __uint_as_float((__float_as_uint(sv) & ~127u) | (unsigned)(32 * blk + (r & 3) + 8 * (r >> 2)) | (unsigned)(hh << 2)); }
                __builtin_amdgcn_sched_barrier(0);
                bsort16_desc<0, 64>(v); bsort16_desc<16, 64>(v); bsort16_desc<32, 64>(v); bsort16_desc<48, 64>(v);
                merge_top16<0, 16, 64>(v); merge_top16<32, 48, 64>(v); merge_top16<0, 32, 64>(v);
                float o[16];
#pragma unroll
                for (int i = 0; i < 16; ++i) o[i] = __shfl_xor(v[i], 32);
#pragma unroll
                for (int i = 0; i < 16; ++i) v[i] = fmaxf(v[i], o[15 - i]);
                bmerge16_desc<0, 64>(v);
#pragma unroll
                for (int i = 0; i < 16; ++i) { if (p == 0) ta[i] = v[i]; else tb[i] = v[i]; }
                __builtin_amdgcn_sched_barrier(0);
            }
            float av[16], bv[16]; int ai[16], bi[16];
#pragma unroll
            for (int i = 0; i < 16; ++i) { const unsigned ua = __builtin_bit_cast(unsigned, ta[i]), ub = __builtin_bit_cast(unsigned, tb[i]);
                av[i] = __builtin_bit_cast(float, ua & ~127u); ai[i] = (int)(ua & 127u); bv[i] = __builtin_bit_cast(float, ub & ~127u); bi[i] = (int)(ub & 127u); }
            float ck[32]; int cp[32];
#pragma unroll
            for (int s2 = 0; s2 < 32; ++s2) {
                const float k0 = av[pair_i(s2)] + bv[pair_j(s2)]; const int p0 = (ai[pair_i(s2)] << 7) | bi[pair_j(s2)];
                float k1 = -INFINITY; int p1 = 0;
                if (s2 + 32 < 50) { k1 = av[pair_i(s2 + 32 < 50 ? s2 + 32 : 0)] + bv[pair_j(s2 + 32 < 50 ? s2 + 32 : 0)]; p1 = (ai[pair_i(s2 + 32 < 50 ? s2 + 32 : 0)] << 7) | bi[pair_j(s2 + 32 < 50 ? s2 + 32 : 0)]; }
                ck[s2] = hh ? k1 : k0; cp[s2] = hh ? p1 : p0;
            }
            __builtin_amdgcn_sched_barrier(0);
            bsort16p_desc<0, 32>(ck, cp); bsort16p_desc<16, 32>(ck, cp);
#pragma unroll
            for (int i = 0; i < 16; ++i) { if (ck[16 + 15 - i] > ck[i]) { ck[i] = ck[16 + 15 - i]; cp[i] = cp[16 + 15 - i]; } }
            bmerge16p_desc<0, 32>(ck, cp);
            { float ok[16]; int op[16];
#pragma unroll
              for (int i = 0; i < 16; ++i) { ok[i] = __shfl_xor(ck[i], 32); op[i] = __shfl_xor(cp[i], 32); }
#pragma unroll
              for (int i = 0; i < 16; ++i) { if (ok[15 - i] > ck[i]) { ck[i] = ok[15 - i]; cp[i] = op[15 - i]; } } }
            bmerge16p_desc<0, 32>(ck, cp);
            float ex[16]; float sum = 0.f;
#pragma unroll
            for (int i = 0; i < 16; ++i) { ex[i] = __expf(ck[i] - ck[0]); sum += ex[i]; }
            const float inv = 1.f / sum;
            if (hh == 0) {
                int* eo = EID + (tok0 + c) * 128 + h * 16; float* go = GATE + (tok0 + c) * 128 + h * 16;
#pragma unroll
                for (int i = 0; i < 4; ++i) { *(GAS v4u*)(eo + 4 * i) = (v4u){(unsigned)cp[4 * i], (unsigned)cp[4 * i + 1], (unsigned)cp[4 * i + 2], (unsigned)cp[4 * i + 3]};
                    *(GAS f32x4*)(go + 4 * i) = (f32x4){ex[4 * i] * inv, ex[4 * i + 1] * inv, ex[4 * i + 2] * inv, ex[4 * i + 3] * inv}; }
            }
        }
    }
    __syncthreads();
}
template <bool FINAL>
__device__ __forceinline__ void phase_gather(const bf16* X, const int* EID, const float* GATE, const float* U, const float* V, const float* g, const float* bb, bf16* Ob, float* Of) {
    const int tid = threadIdx.x, lane = tid & 63, wave = tid >> 6;
    const int gw = blockIdx.x * NWAVES + wave, NGW = gridDim.x * NWAVES;
    for (int t = gw; t < T; t += NGW) {
        f32x4 x[4], acc[4];
#pragma unroll
        for (int j = 0; j < 4; ++j) { const v2u w = *((const GAS v2u*)(X + (size_t)t * D) + lane + 64 * j);
            x[j] = (f32x4){bflo(w.x), bfhi(w.x), bflo(w.y), bfhi(w.y)}; acc[j] = (f32x4){0.f, 0.f, 0.f, 0.f}; }
        const int e0 = EID[(size_t)t * 128 + lane], e1 = EID[(size_t)t * 128 + 64 + lane];
        const float g0 = GATE[(size_t)t * 128 + lane], g1 = GATE[(size_t)t * 128 + 64 + lane];
#pragma unroll 2
        for (int k = 0; k < 128; ++k) {
            const int e = (k < 64) ? __shfl(e0, k) : __shfl(e1, k - 64);
            const float gt = (k < 64) ? __shfl(g0, k) : __shfl(g1, k - 64);
            const GAS f32x4* ur = (const GAS f32x4*)(U + (size_t)e * D) + lane;
            float dot = 0.f;
#pragma unroll
            for (int j = 0; j < 4; ++j) { const f32x4 u = ur[64 * j]; dot += (x[j].x * u.x + x[j].y * u.y) + (x[j].z * u.z + x[j].w * u.w); }
            dot = wave_sum(dot);
            const float a = 0.5f * dot * (1.f + erff(dot * 0.70710678118654752f));
            const float cf = gt * a;
            const GAS f32x4* vr = (const GAS f32x4*)(V + (size_t)e * D) + lane;
#pragma unroll
            for (int j = 0; j < 4; ++j) { const f32x4 v = vr[64 * j]; acc[j] += cf * v; }
        }
        float s = 0.f;
#pragma unroll
        for (int j = 0; j < 4; ++j) { acc[j] = ALPHA * x[j] + acc[j]; s += (acc[j].x + acc[j].y) + (acc[j].z + acc[j].w); }
        const float mean = wave_sum(s) * (1.f / D); float s2 = 0.f;
#pragma unroll
        for (int j = 0; j < 4; ++j) { acc[j] = acc[j] - mean; s2 += (acc[j].x * acc[j].x + acc[j].y * acc[j].y) + (acc[j].z * acc[j].z + acc[j].w * acc[j].w); }
        const float rstd = 1.f / sqrtf(wave_sum(s2) * (1.f / D) + LN_EPS);
#pragma unroll
        for (int j = 0; j < 4; ++j) { const f32x4 gg = *((const GAS f32x4*)g + lane + 64 * j), b4 = *((const GAS f32x4*)bb + lane + 64 * j);
            const f32x4 o = acc[j] * rstd * gg + b4;
            if (FINAL) *((GAS f32x4*)(Of + (size_t)t * D) + lane + 64 * j) = o;
            else { v2u w; w.x = pk2(o.x, o.y); w.y = pk2(o.z, o.w); *((GAS v2u*)(Ob + (size_t)t * D) + lane + 64 * j) = w; } }
    }
}

typedef float f32x2 __attribute__((ext_vector_type(2)));
__device__ __forceinline__ void phase_convert_tables(const float* U, const float* V, unsigned char* ws) {
    const int tid = threadIdx.x, lane = tid & 63, wave = tid >> 6;
    const int gw = blockIdx.x * NWAVES + wave, NGW = gridDim.x * NWAVES;
    for (int row = gw; row < 4 * NEXP; row += NGW) {
        const bool isv = row >= 2 * NEXP; const int r = row & (2 * NEXP - 1);
        const GAS f32x4* src = (const GAS f32x4*)((isv ? V : U) + (size_t)r * D) + lane;
        f32x4 v[4]; float m = 0.f;
#pragma unroll
        for (int j = 0; j < 4; ++j) { v[j] = src[64 * j]; m = fmaxf(fmaxf(m, fmaxf(fabsf(v[j].x), fabsf(v[j].y))), fmaxf(fabsf(v[j].z), fabsf(v[j].w))); }
#pragma unroll
        for (int o = 1; o < 64; o <<= 1) m = fmaxf(m, __shfl_xor(m, o));
        m = fmaxf(m, 1e-30f);
        const float sc = 400.f / m;
        v4u w;
        { int t0 = __builtin_amdgcn_cvt_pk_fp8_f32(v[0].x * sc, v[0].y * sc, 0, false); t0 = __builtin_amdgcn_cvt_pk_fp8_f32(v[0].z * sc, v[0].w * sc, t0, true); w.x = (unsigned)t0; }
        { int t0 = __builtin_amdgcn_cvt_pk_fp8_f32(v[1].x * sc, v[1].y * sc, 0, false); t0 = __builtin_amdgcn_cvt_pk_fp8_f32(v[1].z * sc, v[1].w * sc, t0, true); w.y = (unsigned)t0; }
        { int t0 = __builtin_amdgcn_cvt_pk_fp8_f32(v[2].x * sc, v[2].y * sc, 0, false); t0 = __builtin_amdgcn_cvt_pk_fp8_f32(v[2].z * sc, v[2].w * sc, t0, true); w.z = (unsigned)t0; }
        { int t0 = __builtin_amdgcn_cvt_pk_fp8_f32(v[3].x * sc, v[3].y * sc, 0, false); t0 = __builtin_amdgcn_cvt_pk_fp8_f32(v[3].z * sc, v[3].w * sc, t0, true); w.w = (unsigned)t0; }
        *((GAS v4u*)(ws + (isv ? WS_V8 : WS_U8) + (size_t)r * 1024) + lane) = w;
        if (lane == 0) ((float*)(ws + (isv ? WS_DQV : WS_DQU)))[r] = m * (1.f / 400.f);
    }
}
__host__ __device__ constexpr int rev4(int i) { return ((i & 1) << 3) | ((i & 2) << 1) | ((i & 4) >> 1) | ((i & 8) >> 3); }
#define FMA2(a, b, c) __builtin_elementwise_fma((a), (b), (c))
#define CVT8(w, hi) __builtin_amdgcn_cvt_pk_f32_fp8((int)(w), (hi))
template <bool FINAL>
__device__ __forceinline__ void phase_gather8(const bf16* X, const int* EID, const float* GATE, const unsigned char* U8, const unsigned char* V8, const float* DQU, const float* DQV,
                                              const float* g, const float* bb, bf16* Ob, float* Of) {
    const int tid = threadIdx.x, lane = tid & 63, wave = tid >> 6;
    const int gw = blockIdx.x * NWAVES + wave, NGW = gridDim.x * NWAVES;
    const bool b0 = (lane & 1) != 0, b1 = (lane & 2) != 0, b2 = (lane & 4) != 0, b3 = (lane & 8) != 0; const int myrow = lane >> 4;
    for (int t = gw; t < T; t += NGW) {
        f32x2 x[8];
#pragma unroll
        for (int j = 0; j < 4; ++j) { const v2u w = *((const GAS v2u*)(X + (size_t)t * D) + lane + 64 * j);
            x[2 * j] = (f32x2){bflo(w.x), bfhi(w.x)}; x[2 * j + 1] = (f32x2){bflo(w.y), bfhi(w.y)}; }
        const int e0 = EID[(size_t)t * 128 + lane], e1 = EID[(size_t)t * 128 + 64 + lane];
        const float gt0 = GATE[(size_t)t * 128 + lane], gt1 = GATE[(size_t)t * 128 + 64 + lane];
        const float dqu0 = DQU[e0], dqu1 = DQU[e1], dqv0 = DQV[e0], dqv1 = DQV[e1];
        float act0 = 0.f, act1 = 0.f;
#pragma unroll
        for (int r = 0; r < 2; ++r) {
            const int er = r ? e1 : e0;
            for (int row = 0; row < 4; ++row) {
                v4u w[16];
#pragma unroll
                for (int i = 0; i < 16; ++i) { const int e = __builtin_amdgcn_readlane(er, row * 16 + rev4(i)); w[i] = *((const GAS v4u*)(U8 + (size_t)e * 1024) + lane); }
                float p[16];
#pragma unroll
                for (int i = 0; i < 16; ++i) { f32x2 a = (f32x2){0.f, 0.f};
                    a = FMA2(x[0], CVT8(w[i].x, false), a); a = FMA2(x[1], CVT8(w[i].x, true), a);
                    a = FMA2(x[2], CVT8(w[i].y, false), a); a = FMA2(x[3], CVT8(w[i].y, true), a);
                    a = FMA2(x[4], CVT8(w[i].z, false), a); a = FMA2(x[5], CVT8(w[i].z, true), a);
                    a = FMA2(x[6], CVT8(w[i].w, false), a); a = FMA2(x[7], CVT8(w[i].w, true), a);
                    p[i] = a.x + a.y; }
                float r8[8], r4[4], r2[2];
#pragma unroll
                for (int i = 0; i < 8; ++i) { const float keep = b0 ? p[8 + i] : p[i], send = b0 ? p[i] : p[8 + i]; r8[i] = keep + __shfl_xor(send, 1); }
#pragma unroll
                for (int i = 0; i < 4; ++i) { const float keep = b1 ? r8[4 + i] : r8[i], send = b1 ? r8[i] : r8[4 + i]; r4[i] = keep + __shfl_xor(send, 2); }
#pragma unroll
                for (int i = 0; i < 2; ++i) { const float keep = b2 ? r4[2 + i] : r4[i], send = b2 ? r4[i] : r4[2 + i]; r2[i] = keep + __shfl_xor(send, 4); }
                float r1 = (b3 ? r2[1] : r2[0]) + __shfl_xor(b3 ? r2[0] : r2[1], 8);
                r1 += __shfl_xor(r1, 16); r1 += __shfl_xor(r1, 32);
                if (myrow == row) { if (r == 0) act0 = r1; else act1 = r1; }
            }
        }
        float c0, c1;
        { const float a0 = act0 * dqu0, a1 = act1 * dqu1;
          c0 = gt0 * (0.5f * a0 * (1.f + erff(a0 * 0.70710678118654752f))) * dqv0;
          c1 = gt1 * (0.5f * a1 * (1.f + erff(a1 * 0.70710678118654752f))) * dqv1; }
        f32x2 acc[8];
#pragma unroll
        for (int j = 0; j < 8; ++j) acc[j] = (f32x2){0.f, 0.f};
#pragma unroll
        for (int r = 0; r < 2; ++r) {
            const int er = r ? e1 : e0; const int cr = __builtin_bit_cast(int, r ? c1 : c0);
            for (int row = 0; row < 4; ++row) {
                v4u w[16];
#pragma unroll
                for (int i = 0; i < 16; ++i) { const int e = __builtin_amdgcn_readlane(er, row * 16 + i); w[i] = *((const GAS v4u*)(V8 + (size_t)e * 1024) + lane); }
#pragma unroll
                for (int i = 0; i < 16; ++i) { const float cf = __builtin_bit_cast(float, __builtin_amdgcn_readlane(cr, row * 16 + i)); const f32x2 c2 = (f32x2){cf, cf};
                    acc[0] = FMA2(c2, CVT8(w[i].x, false), acc[0]); acc[1] = FMA2(c2, CVT8(w[i].x, true), acc[1]);
                    acc[2] = FMA2(c2, CVT8(w[i].y, false), acc[2]); acc[3] = FMA2(c2, CVT8(w[i].y, true), acc[3]);
                    acc[4] = FMA2(c2, CVT8(w[i].z, false), acc[4]); acc[5] = FMA2(c2, CVT8(w[i].z, true), acc[5]);
                    acc[6] = FMA2(c2, CVT8(w[i].w, false), acc[6]); acc[7] = FMA2(c2, CVT8(w[i].w, true), acc[7]); }
            }
        }
        float s = 0.f;
#pragma unroll
        for (int j = 0; j < 8; ++j) { acc[j] = x[j] * ALPHA + acc[j]; s += acc[j].x + acc[j].y; }
        const float mean = wave_sum(s) * (1.f / D); float s2 = 0.f;
#pragma unroll
        for (int j = 0; j < 8; ++j) { acc[j] = acc[j] - mean; s2 += acc[j].x * acc[j].x + acc[j].y * acc[j].y; }
        const float rstd = 1.f / sqrtf(wave_sum(s2) * (1.f / D) + LN_EPS);
#pragma unroll
        for (int j = 0; j < 4; ++j) { const f32x4 gg = *((const GAS f32x4*)g + lane + 64 * j), b4 = *((const GAS f32x4*)bb + lane + 64 * j);
            const f32x4 o = (f32x4){acc[2 * j].x, acc[2 * j].y, acc[2 * j + 1].x, acc[2 * j + 1].y} * rstd * gg + b4;
            if (FINAL) *((GAS f32x4*)(Of + (size_t)t * D) + lane + 64 * j) = o;
            else { v2u w; w.x = pk2(o.x, o.y); w.y = pk2(o.z, o.w); *((GAS v2u*)(Ob + (size_t)t * D) + lane + 64 * j) = w; } }
    }
}
__device__ __forceinline__ void phase_hgrn(LAS unsigned char* lds, unsigned char* ws) {
    const int tid = threadIdx.x;
    const bf16* CQ = (const bf16*)(ws + WS_CQ); const bf16* CK = (const bf16*)(ws + WS_CK); const bf16* CV = (const bf16*)(ws + WS_CV); bf16* O = (bf16*)(ws + WS_O);
    LAS float* fL = (LAS float*)lds;
    LAS float* kL = fL + 4096; LAS float* qL = kL + 4096;
    LAS float* vL = qL + 4096;
    LAS float* part = vL + 1024;
    for (int item = blockIdx.x; item < 256; item += gridDim.x) {
        const int es = item & 3, h = (item >> 2) & 7, b = item >> 5;
        const int e = tid & 31, dg = tid >> 5;
        float S[8];
#pragma unroll
        for (int j = 0; j < 8; ++j) S[j] = 0.f;
        for (int blk = 0; blk < SEQ / 32; ++blk) {
            const size_t t0 = (size_t)b * SEQ + blk * 32;
            for (int idx = tid; idx < 4096; idx += NTHR) { const int s = idx >> 7, d = idx & 127; const size_t o = (t0 + s) * D + h * 128 + d;
                const float kk = bf2f(CK[o]); kL[idx] = kk; fL[idx] = 1.f - kk; qL[idx] = bf2f(CQ[o]); }
            for (int idx = tid; idx < 1024; idx += NTHR) { const int s = idx >> 5, ee = idx & 31; vL[idx] = bf2f(CV[(t0 + s) * D + h * 128 + es * 32 + ee]); }
            __syncthreads();
            for (int s = 0; s < 32; ++s) { const float v = vL[s * 32 + e]; float po = 0.f;
#pragma unroll
                for (int j = 0; j < 8; ++j) { const int d = dg * 8 + j; S[j] = fL[s * 128 + d] * S[j] + kL[s * 128 + d] * v; po += qL[s * 128 + d] * S[j]; }
                part[(s * 16 + dg) * 32 + e] = po; }
            __syncthreads();
            for (int idx = tid; idx < 1024; idx += NTHR) { const int s = idx >> 5, ee = idx & 31; float o = 0.f;
#pragma unroll
                for (int g = 0; g < 16; ++g) o += part[(s * 16 + g) * 32 + ee];
                O[(t0 + s) * D + h * 128 + es * 32 + ee] = (bf16)f2bf(o); }
            __syncthreads();
        }
    }
}

__device__ __forceinline__ void phase_hgrn_prep(unsigned char* ws, float* scratch  ) {
    const int tid = threadIdx.x, lane = tid & 63, wave = tid >> 6;
    const int gw = blockIdx.x * NWAVES + wave, NGW = gridDim.x * NWAVES;
    bf16* CQ = (bf16*)(ws + WS_CQ); bf16* CK = (bf16*)(ws + WS_CK); const bf16* CV = (const bf16*)(ws + WS_CV);
    bf16* KOT = (bf16*)scratch; bf16* VT = (bf16*)scratch + (size_t)T * D; float* DEC = (float*)(ws + WS_DEC);
    for (int item = gw; item < 1024 * 8; item += NGW) {
        const int g = item >> 3, h = item & 7; const size_t t0 = (size_t)g * 32;
        float k0[32], k1[32], b0[32], b1[32]; float c0 = 0.f, c1 = 0.f;
#pragma unroll
        for (int s2 = 0; s2 < 32; ++s2) { const size_t o = (t0 + s2) * D + h * 128 + 2 * lane;
            const unsigned kw = *(const GAS unsigned*)(CK + o), qw = *(const GAS unsigned*)(CQ + o);
            const float ka = bflo(kw), kb = bfhi(kw);
            c0 += __logf(1.f - ka); c1 += __logf(1.f - kb);
            k0[s2] = ka; k1[s2] = kb; b0[s2] = c0; b1[s2] = c1;
            *(GAS unsigned*)(CQ + o) = pk2(bflo(qw) * __expf(c0), bfhi(qw) * __expf(c1));
            *(GAS unsigned*)(CK + o) = pk2(ka * __expf(-c0), kb * __expf(-c1)); }
        { GAS v4u* r0 = (GAS v4u*)(KOT + ((size_t)g * 1024 + h * 128 + 2 * lane) * 32);
#pragma unroll
          for (int j = 0; j < 4; ++j) { v4u w;
              w.x = pk2(k0[8 * j + 0] * __expf(c0 - b0[8 * j + 0]), k0[8 * j + 1] * __expf(c0 - b0[8 * j + 1])); w.y = pk2(k0[8 * j + 2] * __expf(c0 - b0[8 * j + 2]), k0[8 * j + 3] * __expf(c0 - b0[8 * j + 3]));
              w.z = pk2(k0[8 * j + 4] * __expf(c0 - b0[8 * j + 4]), k0[8 * j + 5] * __expf(c0 - b0[8 * j + 5])); w.w = pk2(k0[8 * j + 6] * __expf(c0 - b0[8 * j + 6]), k0[8 * j + 7] * __expf(c0 - b0[8 * j + 7]));
              r0[j] = w; }
#pragma unroll
          for (int j = 0; j < 4; ++j) { v4u w;
              w.x = pk2(k1[8 * j + 0] * __expf(c1 - b1[8 * j + 0]), k1[8 * j + 1] * __expf(c1 - b1[8 * j + 1])); w.y = pk2(k1[8 * j + 2] * __expf(c1 - b1[8 * j + 2]), k1[8 * j + 3] * __expf(c1 - b1[8 * j + 3]));
              w.z = pk2(k1[8 * j + 4] * __expf(c1 - b1[8 * j + 4]), k1[8 * j + 5] * __expf(c1 - b1[8 * j + 5])); w.w = pk2(k1[8 * j + 6] * __expf(c1 - b1[8 * j + 6]), k1[8 * j + 7] * __expf(c1 - b1[8 * j + 7]));
              r0[4 + j] = w; } }
        *(GAS v2u*)(DEC + (size_t)g * 1024 + h * 128 + 2 * lane) = (v2u){__float_as_uint(__expf(c0)), __float_as_uint(__expf(c1))};
        { unsigned va[16], vb[16];
#pragma unroll
          for (int j = 0; j < 16; ++j) { const unsigned w0 = *(const GAS unsigned*)(CV + (t0 + 2 * j) * D + h * 128 + 2 * lane), w1 = *(const GAS unsigned*)(CV + (t0 + 2 * j + 1) * D + h * 128 + 2 * lane);
              va[j] = (w0 & 0xffffu) | (w1 << 16); vb[j] = (w0 >> 16) | (w1 & 0xffff0000u); }
          GAS v4u* r0 = (GAS v4u*)(VT + ((size_t)g * 1024 + h * 128 + 2 * lane) * 32);
#pragma unroll
          for (int j = 0; j < 4; ++j) { r0[j] = (v4u){va[4 * j], va[4 * j + 1], va[4 * j + 2], va[4 * j + 3]}; r0[4 + j] = (v4u){vb[4 * j], vb[4 * j + 1], vb[4 * j + 2], vb[4 * j + 3]}; } }
    }
}
__device__ __forceinline__ void phase_hgrn_scan(LAS unsigned char* lds, unsigned char* ws, const float* scratch) {
    const int tid = threadIdx.x, lane = tid & 63, wave = __builtin_amdgcn_readfirstlane(tid >> 6);
    const int c = lane & 31, hh = lane >> 5;
    const bf16* QI = (const bf16*)(ws + WS_CQ); const bf16* KI = (const bf16*)(ws + WS_CK);
    const bf16* KOT = (const bf16*)scratch; const bf16* VT = (const bf16*)scratch + (size_t)T * D; const float* DEC = (const float*)(ws + WS_DEC);
    bf16* O = (bf16*)(ws + WS_O);
    constexpr int BUF = 30720, O_KI = 0, O_QI = 8704, O_KOT = 17408, O_VT = 27648, O_DEC = 30208, O_ST = 61440, O_P = 70144;
    for (int item = blockIdx.x; item < 256; item += gridDim.x) {
        const int es = item & 3, h = (item >> 2) & 7, b = item >> 5;
        __syncthreads();
        for (int i = tid; i < 8704 / 16; i += NTHR) *(LAS v4u*)(lds + O_ST + i * 16) = (v4u){0u, 0u, 0u, 0u};
        f32x16 S[4];
#pragma unroll
        for (int blk = 0; blk < 4; ++blk)
#pragma unroll
            for (int r = 0; r < 16; ++r) S[blk][r] = 0.f;
        v4u rk, rq, ro, rx;
        auto load_chunk = [&](int n) {
            const size_t gch = (size_t)b * 128 + n, t0 = gch * 32;
            rk = *(const GAS v4u*)(KI + (t0 + (tid >> 4)) * D + h * 128 + 8 * (tid & 15));
            rq = *(const GAS v4u*)(QI + (t0 + (tid >> 4)) * D + h * 128 + 8 * (tid & 15));
            ro = *(const GAS v4u*)(KOT + (gch * 1024 + h * 128 + (tid >> 2)) * 32 + 8 * (tid & 3));
            if (tid < 128) rx = *(const GAS v4u*)(VT + (gch * 1024 + h * 128 + es * 32 + (tid >> 2)) * 32 + 8 * (tid & 3));
            else if (tid < 160) rx = *(const GAS v4u*)(DEC + gch * 1024 + h * 128 + 4 * (tid - 128));
        };
        auto store_chunk = [&](int bufi) {
            LAS unsigned char* bp = lds + bufi * BUF;
            *(LAS v4u*)(bp + O_KI + (tid >> 4) * 272 + (tid & 15) * 16) = rk;
            *(LAS v4u*)(bp + O_QI + (tid >> 4) * 272 + (tid & 15) * 16) = rq;
            *(LAS v4u*)(bp + O_KOT + (tid >> 2) * 80 + (tid & 3) * 16) = ro;
            if (tid < 128) *(LAS v4u*)(bp + O_VT + (tid >> 2) * 80 + (tid & 3) * 16) = rx;
            else if (tid < 160) *(LAS v4u*)(bp + O_DEC + (tid - 128) * 16) = rx;
        };
        load_chunk(0); store_chunk(0); load_chunk(1);
        __syncthreads();
        for (int n = 0; n < 128; ++n) {
            if (n + 1 < 128) store_chunk((n + 1) & 1);
            if (n + 2 < 128) load_chunk(n + 2);
            if (wave == 0) {
                LAS unsigned char* bp = lds + (n & 1) * BUF;
                const size_t t0 = ((size_t)b * 128 + n) * 32;
                bf16x8 qf[8];
                f32x16 sc;
#pragma unroll
                for (int r = 0; r < 16; ++r) sc[r] = 0.f;
#pragma unroll
                for (int ks = 0; ks < 8; ++ks) { const bf16x8 kf = *(const LAS bf16x8*)(bp + O_KI + c * 272 + (16 * ks + 8 * hh) * 2);
                    qf[ks] = *(const LAS bf16x8*)(bp + O_QI + c * 272 + (16 * ks + 8 * hh) * 2);
                    sc = __builtin_amdgcn_mfma_f32_32x32x16_bf16(kf, qf[ks], sc, 0, 0, 0); }
#pragma unroll
                for (int g4 = 0; g4 < 4; ++g4) { float m[4];
#pragma unroll
                    for (int q = 0; q < 4; ++q) { const float sv = sc[4 * g4 + q]; m[q] = (8 * g4 + 4 * hh + q <= c) ? sv : 0.f; }
                    *(LAS v2u*)(lds + O_P + c * 80 + (8 * g4 + 4 * hh) * 2) = (v2u){pk2(m[0], m[1]), pk2(m[2], m[3])}; }
                bf16x8 vf[2];
                f32x16 o;
#pragma unroll
                for (int r = 0; r < 16; ++r) o[r] = 0.f;
#pragma unroll
                for (int ks = 0; ks < 2; ++ks) { const bf16x8 pf = *(const LAS bf16x8*)(lds + O_P + c * 80 + (16 * ks + 8 * hh) * 2);
                    vf[ks] = *(const LAS bf16x8*)(bp + O_VT + c * 80 + (16 * ks + 8 * hh) * 2);
                    o = __builtin_amdgcn_mfma_f32_32x32x16_bf16(pf, vf[ks], o, 0, 0, 0); }
#pragma unroll
                for (int ks = 0; ks < 8; ++ks) { const bf16x8 sf = *(const LAS bf16x8*)(lds + O_ST + c * 272 + (16 * ks + 8 * hh) * 2);
                    o = __builtin_amdgcn_mfma_f32_32x32x16_bf16(qf[ks], sf, o, 0, 0, 0); }
#pragma unroll
                for (int r = 0; r < 16; ++r) { const float ov = o[r]; O[(t0 + (r & 3) + 8 * (r >> 2) + 4 * hh) * D + h * 128 + es * 32 + c] = (bf16)f2bf(ov); }
#pragma unroll
                for (int blk = 0; blk < 4; ++blk) {
#pragma unroll
                    for (int g4 = 0; g4 < 4; ++g4) { const f32x4 dv = *(const LAS f32x4*)(bp + O_DEC + (32 * blk + 8 * g4 + 4 * hh) * 4);
                        S[blk][4 * g4 + 0] *= dv.x; S[blk][4 * g4 + 1] *= dv.y; S[blk][4 * g4 + 2] *= dv.z; S[blk][4 * g4 + 3] *= dv.w; }
#pragma unroll
                    for (int ks = 0; ks < 2; ++ks) { const bf16x8 af = *(const LAS bf16x8*)(bp + O_KOT + (32 * blk + c) * 80 + (16 * ks + 8 * hh) * 2);
                        S[blk] = __builtin_amdgcn_mfma_f32_32x32x16_bf16(af, vf[ks], S[blk], 0, 0, 0); }
#pragma unroll
                    for (int g4 = 0; g4 < 4; ++g4) { const float s0 = S[blk][4 * g4 + 0], s1 = S[blk][4 * g4 + 1], s2 = S[blk][4 * g4 + 2], s3 = S[blk][4 * g4 + 3];
                        *(LAS v2u*)(lds + O_ST + c * 272 + (32 * blk + 8 * g4 + 4 * hh) * 2) = (v2u){pk2(s0, s1), pk2(s2, s3)}; }
                }
            }
            __syncthreads();
        }
    }
}
__device__ __forceinline__ void phase_hgrn_norm(const float* norm_g, unsigned char* ws) {
    const int tid = threadIdx.x, lane = tid & 63, wave = tid >> 6;
    const int gw = blockIdx.x * NWAVES + wave, NGW = gridDim.x * NWAVES;
    const bf16* O = (const bf16*)(ws + WS_O); const bf16* CG = (const bf16*)(ws + WS_CG); bf16* Y2 = (bf16*)(ws + WS_Y2);
    for (int t = gw; t < T; t += NGW) {
        const v4u a0 = *((const GAS v4u*)(O + (size_t)t * D) + lane * 2), a1 = *((const GAS v4u*)(O + (size_t)t * D) + lane * 2 + 1);
        const v4u g0 = *((const GAS v4u*)(CG + (size_t)t * D) + lane * 2), g1 = *((const GAS v4u*)(CG + (size_t)t * D) + lane * 2 + 1);
        float o[16], gv[16];
        o[0] = bflo(a0.x); o[1] = bfhi(a0.x); o[2] = bflo(a0.y); o[3] = bfhi(a0.y); o[4] = bflo(a0.z); o[5] = bfhi(a0.z); o[6] = bflo(a0.w); o[7] = bfhi(a0.w);
        o[8] = bflo(a1.x); o[9] = bfhi(a1.x); o[10] = bflo(a1.y); o[11] = bfhi(a1.y); o[12] = bflo(a1.z); o[13] = bfhi(a1.z); o[14] = bflo(a1.w); o[15] = bfhi(a1.w);
        gv[0] = bflo(g0.x); gv[1] = bfhi(g0.x); gv[2] = bflo(g0.y); gv[3] = bfhi(g0.y); gv[4] = bflo(g0.z); gv[5] = bfhi(g0.z); gv[6] = bflo(g0.w); gv[7] = bfhi(g0.w);
        gv[8] = bflo(g1.x); gv[9] = bfhi(g1.x); gv[10] = bflo(g1.y); gv[11] = bfhi(g1.y); gv[12] = bflo(g1.z); gv[13] = bfhi(g1.z); gv[14] = bflo(g1.w); gv[15] = bfhi(g1.w);
        float sq = 0.f;
#pragma unroll
        for (int j = 0; j < 16; ++j) sq += o[j] * o[j];
        sq += __shfl_xor(sq, 1); sq += __shfl_xor(sq, 2); sq += __shfl_xor(sq, 4);
        const float r = 1.f / sqrtf(sq * (1.f / 128.f) + LN_EPS);
        float y[16];
#pragma unroll
        for (int j = 0; j < 16; ++j) { const float sg = gv[j] / (1.f + expf(-gv[j])); y[j] = o[j] * r * norm_g[lane * 16 + j] * sg; }
        v4u w0, w1; w0.x = pk2(y[0], y[1]); w0.y = pk2(y[2], y[3]); w0.z = pk2(y[4], y[5]); w0.w = pk2(y[6], y[7]);
        w1.x = pk2(y[8], y[9]); w1.y = pk2(y[10], y[11]); w1.z = pk2(y[12], y[13]); w1.w = pk2(y[14], y[15]);
        *((GAS v4u*)(Y2 + (size_t)t * D) + lane * 2) = w0; *((GAS v4u*)(Y2 + (size_t)t * D) + lane * 2 + 1) = w1;
    }
}

struct Args { const float* in[16]; float* out; unsigned char* ws; int ph_lo, ph_hi, li, pad; };
__global__ void __launch_bounds__(NTHR, 2) mk_fwd(Args args) {
    extern __shared__ __attribute__((aligned(16))) unsigned char lds_raw[];
    LAS unsigned char* lds = (LAS unsigned char*)lds_raw;
    volatile LAS unsigned* MISC = (volatile LAS unsigned*)(lds + MISC_OFF);
    const int tid = threadIdx.x;
    unsigned char* ws = args.ws;
    gu32* ctl = (gu32*)(ws + WS_CTL);
    if (tid < 32) ((LAS unsigned*)(lds + MISC_OFF))[tid] = 0u;
    __syncthreads();
    XcdBarrier bar; bar.bar = (unsigned*)ctl + CW_BAR; bar.x = 0; bar.st = nullptr;
    if (N_LAUNCHES == 1) bar = xcd_barrier_post((unsigned*)ctl + CW_BAR, MISC + 8);
    const int lo = args.ph_lo, hi = args.ph_hi;
#define IN(k) (lo <= (k) && (k) < hi)
#define SEAM(k) do { if (IN(k) && IN((k) + 1)) xcd_barrier(bar); } while (0)
    const float* const* in = args.in;
    bf16* XB = (bf16*)(ws + WS_XB); bf16* H0 = (bf16*)(ws + WS_H0); bf16* Y = (bf16*)(ws + WS_Y); bf16* H1 = (bf16*)(ws + WS_H1);
    int* EID = (int*)(ws + WS_EID); float* GATE = (float*)(ws + WS_GATE);
    float* Z = args.out;

    if (IN(0)) for (int rep_ = 0; rep_ < 1 + (int)((DUP_MASK >> 0) & 1u); ++rep_) { phase_prologue(lds, in, ws); phase_convert_tables(in[12], in[13], ws); } SEAM(0);
    if (IN(1)) for (int rep_ = 0; rep_ < 1 + (int)((DUP_MASK >> 1) & 1u); ++rep_) { pg8::Gemm g{XB, (const bf16*)(ws + WS_WABIN), T, AB_IN, D}; pg8::StaticOrder S; S.init(T, AB_IN, (int)gridDim.x, (int)blockIdx.x); pg8::EpiBf16<0> E{H0, AB_IN, nullptr, 0, 0, 1.f};
                 pg8::gemm_phase<pg8::EpiBf16<0>, pg8::StaticOrder, true, true>(lds, g, S, E); } SEAM(1);
    if (IN(2)) for (int rep_ = 0; rep_ < 1 + (int)((DUP_MASK >> 2) & 1u); ++rep_) { phase_ret_local(lds, ws); } SEAM(2);
    if (IN(3)) for (int rep_ = 0; rep_ < 1 + (int)((DUP_MASK >> 3) & 1u); ++rep_) { phase_ret_prefix(ws); } SEAM(3);
    if (IN(4)) for (int rep_ = 0; rep_ < 1 + (int)((DUP_MASK >> 4) & 1u); ++rep_) { phase_ret_out_pool(lds, in, ws); } SEAM(4);
    if (IN(5)) for (int rep_ = 0; rep_ < 1 + (int)((DUP_MASK >> 5) & 1u); ++rep_) { pg8::Gemm g{Y, (const bf16*)(ws + WS_WABOUT), T, D, D}; pg8::StaticOrder S; S.init(T, D, (int)gridDim.x, (int)blockIdx.x); pg8::EpiResidF32 E{XB, Z};
                 pg8::gemm_phase<pg8::EpiResidF32, pg8::StaticOrder, true, true>(lds, g, S, E); } SEAM(5);
    if (IN(6)) for (int rep_ = 0; rep_ < 1 + (int)((DUP_MASK >> 6) & 1u); ++rep_) { phase_ln(Z, H1, in[14], in[15]); } SEAM(6);
    if (IN(7)) for (int rep_ = 0; rep_ < 1 + (int)((DUP_MASK >> 7) & 1u); ++rep_) { pg8::Gemm g{H1, (const bf16*)(ws + WS_WQ), T, 2048, D}; pg8::StaticOrder S; S.init(T, 2048, (int)gridDim.x, (int)blockIdx.x); pg8::EpiBf16<0> E{H0  , 2048, nullptr, 0, 0, 1.f};
                 pg8::gemm_phase<pg8::EpiBf16<0>, pg8::StaticOrder, true, true>(lds, g, S, E); } SEAM(7);
    if (IN(8)) for (int rep_ = 0; rep_ < 1 + (int)((DUP_MASK >> 8) & 1u); ++rep_) { phase_topk_fast(lds, H0, (const bf16*)(ws + WS_KEYS), EID, GATE); } SEAM(8);
    if (IN(9)) for (int rep_ = 0; rep_ < 1 + (int)((DUP_MASK >> 9) & 1u); ++rep_) { phase_gather8<false>(H1, EID, GATE, ws + WS_U8, ws + WS_V8, (const float*)(ws + WS_DQU), (const float*)(ws + WS_DQV), in[14] + D, in[15] + D, XB  , nullptr); } SEAM(9);
    if (IN(10)) for (int rep_ = 0; rep_ < 1 + (int)((DUP_MASK >> 10) & 1u); ++rep_) { EpiCIn E{(bf16*)(ws + WS_CQ), (bf16*)(ws + WS_CK), (bf16*)(ws + WS_CV), (bf16*)(ws + WS_CG), (const float*)(ws + WS_LB)};
                  (void)E; pg8::Gemm g{XB, (const bf16*)(ws + WS_WCIN), T, C_IN, D}; pg8::StaticOrder S; S.init(T, C_IN, (int)gridDim.x, (int)blockIdx.x);
                  pg8::EpiCInF E2{(bf16*)(ws + WS_CQ), (bf16*)(ws + WS_CK), (bf16*)(ws + WS_CV), (bf16*)(ws + WS_CG), (const float*)(ws + WS_LB)};
                  pg8::gemm_phase<pg8::EpiCInF, pg8::StaticOrder, true, true>(lds, g, S, E2); } SEAM(10);
    if (IN(11)) for (int rep_ = 0; rep_ < 1 + (int)((DUP_MASK >> 11) & 1u); ++rep_) { phase_hgrn_prep(ws, args.out); } SEAM(11);
    if (IN(12)) for (int rep_ = 0; rep_ < 1 + (int)((DUP_MASK >> 12) & 1u); ++rep_) { phase_hgrn_scan(lds, ws, args.out); } SEAM(12);
    if (IN(13)) for (int rep_ = 0; rep_ < 1 + (int)((DUP_MASK >> 13) & 1u); ++rep_) { phase_hgrn_norm(in[8], ws); } SEAM(13);
    if (IN(14)) for (int rep_ = 0; rep_ < 1 + (int)((DUP_MASK >> 14) & 1u); ++rep_) { pg8::Gemm g{(const bf16*)(ws + WS_Y2), (const bf16*)(ws + WS_WCOUT), T, D, D}; pg8::StaticOrder S; S.init(T, D, (int)gridDim.x, (int)blockIdx.x); pg8::EpiResidF32 E{XB, Z};
                  pg8::gemm_phase<pg8::EpiResidF32, pg8::StaticOrder, true, true>(lds, g, S, E); } SEAM(14);
    if (IN(15)) for (int rep_ = 0; rep_ < 1 + (int)((DUP_MASK >> 15) & 1u); ++rep_) { phase_ln(Z, H1  , in[14] + 2 * D, in[15] + 2 * D); } SEAM(15);
    if (IN(16)) for (int rep_ = 0; rep_ < 1 + (int)((DUP_MASK >> 16) & 1u); ++rep_) { pg8::Gemm g{H1, (const bf16*)(ws + WS_WQ) + (size_t)2048 * D, T, 2048, D}; pg8::StaticOrder S; S.init(T, 2048, (int)gridDim.x, (int)blockIdx.x); pg8::EpiBf16<0> E{(bf16*)(ws + WS_Q1), 2048, nullptr, 0, 0, 1.f};
                  pg8::gemm_phase<pg8::EpiBf16<0>, pg8::StaticOrder, true, true>(lds, g, S, E); } SEAM(16);
    if (IN(17)) for (int rep_ = 0; rep_ < 1 + (int)((DUP_MASK >> 17) & 1u); ++rep_) { phase_topk_fast(lds, (const bf16*)(ws + WS_Q1), (const bf16*)(ws + WS_KEYS) + (size_t)8 * 2 * 128 * 128, EID, GATE); } SEAM(17);
    if (IN(18)) for (int rep_ = 0; rep_ < 1 + (int)((DUP_MASK >> 18) & 1u); ++rep_) { phase_gather8<true>(H1, EID, GATE, ws + WS_U8 + (size_t)NEXP * 1024, ws + WS_V8 + (size_t)NEXP * 1024, (const float*)(ws + WS_DQU) + NEXP, (const float*)(ws + WS_DQV) + NEXP, in[14] + 3 * D, in[15] + 3 * D, nullptr, args.out); }
#undef IN
#undef SEAM
}

extern "C" void kernel_launch(void* const* d_in, const int* in_sizes, int n_in, void* d_out, int out_size, void* d_ws, size_t ws_size, hipStream_t stream) {
    static int grid = 0;
    if (grid == 0) {
        if (n_in != 16 || in_sizes[0] != T * D || out_size != T * D || ws_size < WS_END) { fprintf(stderr, "kernel_launch: unexpected problem (n_in %d, in0 %d, out %d, ws %zu); nothing launched\n", n_in, n_in > 0 ? in_sizes[0] : -1, out_size, ws_size); grid = -1; return; }
        int dev = 0, cus = 0;
        if (hipGetDevice(&dev) != hipSuccess || hipDeviceGetAttribute(&cus, hipDeviceAttributeMultiprocessorCount, dev) != hipSuccess) { grid = -1; return; }
        if (hipFuncSetAttribute((const void*)mk_fwd, hipFuncAttributeMaxDynamicSharedMemorySize, LDS_BYTES) != hipSuccess) { fprintf(stderr, "kernel_launch: hipFuncSetAttribute failed\n"); grid = -1; return; }
        (void)hipGetLastError();
        grid = cus;
    }
    if (grid < 0) return;
    if (hipMemsetAsync((char*)d_ws + WS_CTL, 0, CTL_ZERO_BYTES, stream) != hipSuccess) return;
    Args a{};
    for (int i = 0; i < 16; ++i) a.in[i] = (const float*)d_in[i];
    a.out = (float*)d_out; a.ws = (unsigned char*)d_ws;
    for (int li = 0; li < N_LAUNCHES; ++li) {
        a.ph_lo = (N_LAUNCHES == 1) ? 0 : li; a.ph_hi = (N_LAUNCHES == 1) ? NPHASE : li + 1; a.li = li;
        hipLaunchKernelGGL(mk_fwd, dim3(grid), dim3(NTHR), LDS_BYTES, stream, a);
        if (hipPeekAtLastError() != hipSuccess) { fprintf(stderr, "kernel_launch: launch %d failed\n", li); break; }
    }
}
```

```cpp
#include <hip/hip_runtime.h>
#include <cstdio>
#include <cstdint>

#ifndef MK_N_LAUNCHES
#define MK_N_LAUNCHES 1
#endif
constexpr int NPHASE = 19;
#ifndef DUP_MASK
#define DUP_MASK 0u
#endif
constexpr int N_LAUNCHES = MK_N_LAUNCHES;

constexpr int BATCH = 8, SEQ = 4096, D = 1024, T = BATCH * SEQ;
constexpr int AB_IN = 2048, C_IN = 4096, NEXP = 16384;
constexpr float LN_EPS = 1e-5f;
constexpr float ALPHA = 1.41421356237309515f;
constexpr int NWAVES = 8, NTHR = 512;

constexpr size_t MiB = 1u << 20;
constexpr size_t WS_CTL = 0, CTL_ZERO_BYTES = 1 * MiB;
constexpr size_t WS_LB = 1 * MiB;
constexpr size_t WS_ROPE = 2 * MiB;
constexpr size_t WS_WABIN = 4 * MiB;
constexpr size_t WS_WABOUT = 8 * MiB;
constexpr size_t WS_WCIN = 10 * MiB;
constexpr size_t WS_WCOUT = 18 * MiB;
constexpr size_t WS_WQ = 20 * MiB;
constexpr size_t WS_KEYS = 28 * MiB;
constexpr size_t WS_DQU = 29 * MiB;
constexpr size_t WS_DQV = 29 * MiB + 131072;
constexpr size_t WS_U8 = 32 * MiB;
constexpr size_t WS_V8 = 64 * MiB;
constexpr size_t WS_POOLWT = 30 * MiB;
constexpr size_t WS_XB = 96 * MiB;
constexpr size_t WS_H0 = 160 * MiB;
constexpr size_t WS_LST = 288 * MiB;
constexpr size_t WS_Y = 320 * MiB;
constexpr size_t WS_H1 = 384 * MiB;
constexpr size_t WS_EID = 448 * MiB;
constexpr size_t WS_GATE = 464 * MiB;
constexpr size_t WS_CQ = 160 * MiB, WS_CK = 224 * MiB, WS_CV = 288 * MiB, WS_CG = 352 * MiB;
constexpr size_t WS_O = 416 * MiB;
constexpr size_t WS_Y2 = 160 * MiB;
constexpr size_t WS_Q1 = 224 * MiB;
constexpr size_t WS_DEC = 480 * MiB;
constexpr size_t WS_END = 484 * MiB;

constexpr int CW_BAR = 4096;
constexpr int LDS_BYTES = 147456;
constexpr int MISC_OFF = LDS_BYTES - 128;

#define GAS __attribute__((address_space(1)))
#define LAS __attribute__((address_space(3)))
typedef unsigned short bf16;
typedef unsigned v4u __attribute__((ext_vector_type(4)));
typedef unsigned v2u __attribute__((ext_vector_type(2)));
typedef float f32x4 __attribute__((ext_vector_type(4)));
typedef GAS unsigned gu32;
typedef short bf16x8 __attribute__((ext_vector_type(8)));
typedef float f32x16 __attribute__((ext_vector_type(16)));
#define RLX_AGENT __ATOMIC_RELAXED, __HIP_MEMORY_SCOPE_AGENT
#define LDS_WAIT() asm volatile("s_waitcnt lgkmcnt(0)" ::: "memory")
__device__ __forceinline__ unsigned f2bf(float f) { unsigned u = __builtin_bit_cast(unsigned, f); return (u + 0x7fffu + ((u >> 16) & 1u)) >> 16; }
__device__ __forceinline__ unsigned pk2(float lo, float hi) { return f2bf(lo) | (f2bf(hi) << 16); }
__device__ __forceinline__ float bf2f(unsigned b) { return __builtin_bit_cast(float, b << 16); }
__device__ __forceinline__ float bflo(unsigned w) { return __builtin_bit_cast(float, w << 16); }
__device__ __forceinline__ float bfhi(unsigned w) { return __builtin_bit_cast(float, w & 0xffff0000u); }
__device__ __forceinline__ float wave_sum(float v) {
#pragma unroll
    for (int o = 1; o < 64; o <<= 1) v += __shfl_xor(v, o);
    return v;
}

#define XB_TMO      128
#define XB_XCNT(j)  (256  + 64 * (j))
#define XB_XSUB(j)  (1280 + 64 * (j))
#define XB_XGEN(j)  (2304 + 64 * (j))
#define XB_TOP      3328
#define XB_TOPGEN   3392
#define XCD_BAR_WORDS 3456
#define XB_SPIN_CAP (1u << 21)
__device__ __forceinline__ unsigned xb_ld(unsigned* p)              { return __hip_atomic_load(p, __ATOMIC_RELAXED, __HIP_MEMORY_SCOPE_AGENT); }
__device__ __forceinline__ unsigned xb_add(unsigned* p, unsigned v) { return __hip_atomic_fetch_add(p, v, __ATOMIC_RELAXED, __HIP_MEMORY_SCOPE_AGENT); }
__device__ __forceinline__ unsigned xb_xcc_id() { return (unsigned)__builtin_amdgcn_s_getreg((3 << 11) | 20) & 0xFu; }
#define XB_SPIN(cond, bar) do { unsigned _sp = 0; while (cond) { __builtin_amdgcn_s_sleep(1); \
    if ((++_sp & 255u) == 0u) { if (xb_ld(&(bar)[XB_TMO])) break; if (_sp > XB_SPIN_CAP) { atomicAdd(&(bar)[XB_TMO], 1u); break; } } } } while (0)
struct XcdBarrier { unsigned* bar; unsigned x; volatile LAS unsigned* st; };
__device__ __forceinline__ XcdBarrier xcd_barrier_post(unsigned* bar, volatile LAS unsigned* st) {
    XcdBarrier b; b.bar = bar; b.x = xb_xcc_id(); b.st = st;
    if (threadIdx.x == 0) (void)xb_add(&bar[XB_XCNT(b.x)], 1u);
    return b;
}
__device__ __forceinline__ void xcd_barrier_complete(unsigned* bar, unsigned x, unsigned& nloc, unsigned& nx) {
    const unsigned G = gridDim.x * gridDim.y * gridDim.z;
    unsigned sum, cnt, mine, sp = 0u;
    for (;;) {
        sum = 0u; cnt = 0u; mine = 0u;
#pragma unroll
        for (unsigned j = 0; j < 16; ++j) { const unsigned c = xb_ld(&bar[XB_XCNT(j)]); sum += c; cnt += (c > 0u) ? 1u : 0u; mine = (j == x) ? c : mine; }
        if (sum == G) break;
        __builtin_amdgcn_s_sleep(1);
        if ((++sp & 255u) == 0u) { if (xb_ld(&bar[XB_TMO])) break; if (sp > XB_SPIN_CAP) { atomicAdd(&bar[XB_TMO], 1u); break; } }
    }
    nloc = mine > 0u ? mine : 1u; nx = cnt > 0u ? cnt : 1u;
}
__device__ __forceinline__ void xcd_barrier(const XcdBarrier& b) {
    asm volatile("s_waitcnt vmcnt(0)" ::: "memory");
    __syncthreads();
    if (threadIdx.x == 0) {
        unsigned* bar = b.bar;
        __builtin_amdgcn_s_waitcnt(0);
        unsigned nloc = b.st[0], nx = b.st[1];
        if (nloc == 0u) { xcd_barrier_complete(bar, b.x, nloc, nx); b.st[0] = nloc; b.st[1] = nx; }
        const unsigned old = xb_add(&bar[XB_XSUB(b.x)], 1u);
        const unsigned gen = old / nloc;
        if (old + 1u == (gen + 1u) * nloc) {
            __builtin_amdgcn_fence(__ATOMIC_RELEASE, "agent");
            asm volatile("s_waitcnt vmcnt(0)" ::: "memory");
            const unsigned og = xb_add(&bar[XB_TOP], 1u);
            const unsigned tg = og / nx;
            if (og + 1u == (tg + 1u) * nx) xb_add(&bar[XB_TOPGEN], 1u);
            else XB_SPIN(xb_ld(&bar[XB_TOPGEN]) == tg, bar);
            __builtin_amdgcn_fence(__ATOMIC_ACQUIRE, "agent");
            xb_add(&bar[XB_XGEN(b.x)], 1u);
            asm volatile("s_waitcnt vmcnt(0)" ::: "memory");
        } else {
            XB_SPIN(xb_ld(&bar[XB_XGEN(b.x)]) == gen, bar);
            __builtin_amdgcn_fence(__ATOMIC_ACQUIRE, "agent");
            asm volatile("s_waitcnt vmcnt(0)" ::: "memory");
        }
    }
    __syncthreads();
}

__device__ __forceinline__ void p0_transpose_item(const float* W, int K, int N, bf16* WT, LAS float* scr, int item, int lane) {
    const int nblk = N / 32, kb = item / nblk, nb = item % nblk, k0 = 64 * kb, n0 = 32 * nb;
#pragma unroll 8
    for (int i = 0; i < 32; ++i) { const int kk = 2 * i + (lane >> 5); scr[kk * 33 + (lane & 31)] = W[(size_t)(k0 + kk) * N + n0 + (lane & 31)]; }
    LDS_WAIT(); asm volatile("" ::: "memory");
    const int c = lane & 7;
#pragma unroll
    for (int j = 0; j < 4; ++j) { const int n = (lane >> 3) + 8 * j; const LAS float* s = scr + (8 * c) * 33 + n;
        v4u o; o.x = pk2(s[0 * 33], s[1 * 33]); o.y = pk2(s[2 * 33], s[3 * 33]); o.z = pk2(s[4 * 33], s[5 * 33]); o.w = pk2(s[6 * 33], s[7 * 33]);
        *(GAS v4u*)(WT + (size_t)(n0 + n) * K + k0 + 8 * c) = o; }
    LDS_WAIT(); asm volatile("" ::: "memory");
}

template <class Epi>
__device__ __forceinline__ void gemm_naive(LAS unsigned char* lds, const bf16* A, const bf16* Bt, int M, int N, int K, const Epi& E) {
    LAS float* As = (LAS float*)lds;
    LAS float* Bs = As + 128 * 33;
    const int tid = threadIdx.x, tx = tid & 15, ty = tid >> 4;
    const int ntn = N / 128, ntiles = (M / 128) * ntn;
    for (int tile = blockIdx.x; tile < ntiles; tile += gridDim.x) {
        const int tm = tile / ntn, tn = tile % ntn;
        float acc[4][8];
#pragma unroll
        for (int i = 0; i < 4; ++i)
#pragma unroll
            for (int j = 0; j < 8; ++j) acc[i][j] = 0.f;
        for (int k0 = 0; k0 < K; k0 += 32) {
            { const int r = tid >> 2, kc = (tid & 3) * 8;
              const v4u va = *(const GAS v4u*)(A + (size_t)(tm * 128 + r) * K + k0 + kc);
              const v4u vb = *(const GAS v4u*)(Bt + (size_t)(tn * 128 + r) * K + k0 + kc);
              LAS float* pa = As + r * 33 + kc; LAS float* pb = Bs + r * 33 + kc;
              pa[0] = bflo(va.x); pa[1] = bfhi(va.x); pa[2] = bflo(va.y); pa[3] = bfhi(va.y); pa[4] = bflo(va.z); pa[5] = bfhi(va.z); pa[6] = bflo(va.w); pa[7] = bfhi(va.w);
              pb[0] = bflo(vb.x); pb[1] = bfhi(vb.x); pb[2] = bflo(vb.y); pb[3] = bfhi(vb.y); pb[4] = bflo(vb.z); pb[5] = bfhi(vb.z); pb[6] = bflo(vb.w); pb[7] = bfhi(vb.w); }
            __syncthreads();
#pragma unroll 8
            for (int kk = 0; kk < 32; ++kk) {
                float a[4], b[8];
#pragma unroll
                for (int i = 0; i < 4; ++i) a[i] = As[(ty * 4 + i) * 33 + kk];
#pragma unroll
                for (int j = 0; j < 8; ++j) b[j] = Bs[(tx + 16 * j) * 33 + kk];
#pragma unroll
                for (int i = 0; i < 4; ++i)
#pragma unroll
                    for (int j = 0; j < 8; ++j) acc[i][j] += a[i] * b[j];
            }
            __syncthreads();
        }
#pragma unroll
        for (int i = 0; i < 4; ++i)
#pragma unroll
            for (int j = 0; j < 8; ++j) E(tm * 128 + ty * 4 + i, tn * 128 + tx + 16 * j, acc[i][j]);
    }
}
struct EpiStore { bf16* O; int ldc;
    __device__ __forceinline__ void operator()(int r, int c, float v) const { O[(size_t)r * ldc + c] = (bf16)f2bf(v); } };
struct EpiResid { const bf16* X; float* Z;
    __device__ __forceinline__ void operator()(int r, int c, float v) const { Z[(size_t)r * D + c] = ALPHA * bf2f(X[(size_t)r * D + c]) + v; } };
struct EpiCIn { bf16 *CQ, *CK, *CV, *CG; const float* lb;
    __device__ __forceinline__ void operator()(int r, int c, float v) const {
        const int seg = c >> 10, cc = c & 1023; const size_t o = (size_t)r * D + cc;
        if (seg == 0) CQ[o] = (bf16)f2bf(v);
        else if (seg == 1) { const float k = (1.f - lb[cc]) / (1.f + expf(v)); CK[o] = (bf16)f2bf(k); }
        else if (seg == 2) CV[o] = (bf16)f2bf(v);
        else CG[o] = (bf16)f2bf(v);
    } };

namespace pg8 {
#define PG8_LAS __attribute__((address_space(3)))
typedef unsigned short bf16_t;
typedef short bf16x8 __attribute__((ext_vector_type(8)));
typedef float f32x4 __attribute__((ext_vector_type(4)));
typedef unsigned u32x4 __attribute__((ext_vector_type(4)));
constexpr int BM = 256, BK = 64, HALF = 128, HTB = HALF * BK * 2  , STAGE_BYTES = 8 * HTB, NXCD = 8, WGM = 8;

__host__ __device__ __forceinline__ int lds_byte(int r, int c) { const int st = (r >> 4) * 2 + (c >> 5), rr = r & 15, cc = c & 31, ob = rr * 64 + cc * 2; return st * 1024 + (ob ^ (((ob >> 9) & 1) << 5)); }
__host__ __device__ __forceinline__ void stage_rc(int b, int& R, int& C) { const int st = b / 1024, sb = b % 1024, swz = sb ^ (((sb >> 9) & 1) << 5); R = (st >> 1) * 16 + swz / 64; C = (st & 1) * 32 + (swz % 64) / 2; }
__host__ __device__ __forceinline__ int perm32(int rho) { const int n = rho >> 4, i = rho & 15; return 8 * (i >> 2) + 4 * n + (i & 3); }

struct Unit { int pm, pn; };
struct Gemm { const bf16_t* A; const bf16_t* Bt; int M, N, K; };

struct StaticOrder {
    int nM, nN, nwg, G, c;
    __host__ __device__ void init(int M, int N, int G_, int c_) { nM = M / BM; nN = N / BM; nwg = nM * nN; G = G_; c = c_; }
    __host__ __device__ bool next(int i, Unit& u) const {
        const long L = (long)i * G + c; if (L >= nwg) return false;
        int wgid = (int)L; { const int q = nwg / NXCD, r = nwg % NXCD, xcd = wgid % NXCD, off = wgid / NXCD; wgid = (xcd < r ? xcd * (q + 1) : r * (q + 1) + (xcd - r) * q) + off; }
        const int nig = WGM * nN, gid = wgid / nig, fm = gid * WGM, gsz = (nM - fm) < WGM ? (nM - fm) : WGM;
        u.pm = fm + ((wgid % nig) % gsz); u.pn = (wgid % nig) / gsz; return true;
    }
    __device__ __forceinline__ void a_ready(const Unit&) const {}
    __device__ __forceinline__ void done(const Unit&) const {}
};

__device__ __forceinline__ unsigned cvt_pk_bf16(float lo, float hi) { unsigned r; asm volatile("v_cvt_pk_bf16_f32 %0, %1, %2" : "=v"(r) : "v"(lo), "v"(hi)); return r; }
typedef float f32x2 __attribute__((ext_vector_type(2)));
__device__ __forceinline__ f32x2 gelu_pk(f32x2 v) {
    const f32x2 av = __builtin_elementwise_abs(v), d = av * 0.2316418882f + 1.0f;
    f32x2 t; t.x = __builtin_amdgcn_rcpf(d.x); t.y = __builtin_amdgcn_rcpf(d.y);
    f32x2 q = t * 0.5307027145f + (-0.7265760135f); q = q * t + 0.7107068705f; q = q * t + (-0.142248368f); q = q * t + 0.127414796f; q = q * t;
    const f32x2 s = (v * v) * (-0.72134752044f);
    f32x2 e; e.x = __builtin_amdgcn_exp2f(s.x); e.y = __builtin_amdgcn_exp2f(s.y);
    const f32x2 m = v * (q * e), r = v - m;
    f32x2 o; o.x = v.x < 0.f ? m.x : r.x; o.y = v.y < 0.f ? m.y : r.y; return o;
}

template <int ACT  > struct EpiBf16 {
    static constexpr bool PERM = true, AFTER_DRAIN = false; static_assert(ACT == 0 || ACT == 1, "EpiBf16: ACT is 0 (none) or 1 (gelu_pk)");
    bf16_t* O; int ldc; const float* bias; int split_cols; size_t split_stride; float scale0;
    __device__ __forceinline__ void operator()(const f32x4 (&acc)[2][2][4][2], const Unit& u, int wr, int wc, int fr, int fq) const {
        const int row0 = u.pm * BM + wr * 64 + fr; int colt = u.pn * BM; bf16_t* base = O;
        float sc = 1.f; if (split_cols) { const int t = colt / split_cols; base += (size_t)t * split_stride; colt -= t * split_cols; if (t == 0) sc = scale0; }
        const int col0 = colt + wc * 32 + 8 * fq, bcol0 = u.pn * BM + wc * 32 + 8 * fq;
        f32x4 bv[2][2];
#pragma unroll
        for (int bj = 0; bj < 2; ++bj)
#pragma unroll
            for (int n = 0; n < 2; ++n) bv[bj][n] = bias ? *(const f32x4*)(bias + bcol0 + bj * HALF + 4 * n) : (f32x4){0.f, 0.f, 0.f, 0.f};
#pragma unroll
        for (int ai = 0; ai < 2; ++ai)
#pragma unroll
            for (int m = 0; m < 4; ++m) { bf16_t* rowp = base + (size_t)(row0 + ai * HALF + m * 16) * ldc + col0;
#pragma unroll
                for (int bj = 0; bj < 2; ++bj) { f32x4 v0 = acc[ai][bj][m][0] + bv[bj][0], v1 = acc[ai][bj][m][1] + bv[bj][1];
                    if (ACT == 1) { f32x2 a = gelu_pk((f32x2){v0[0], v0[1]}), b = gelu_pk((f32x2){v0[2], v0[3]}), c = gelu_pk((f32x2){v1[0], v1[1]}), d = gelu_pk((f32x2){v1[2], v1[3]});
                        v0 = (f32x4){a.x, a.y, b.x, b.y}; v1 = (f32x4){c.x, c.y, d.x, d.y}; }
                    v0 = v0 * sc; v1 = v1 * sc; u32x4 w; w.x = cvt_pk_bf16(v0[0], v0[1]); w.y = cvt_pk_bf16(v0[2], v0[3]); w.z = cvt_pk_bf16(v1[0], v1[1]); w.w = cvt_pk_bf16(v1[2], v1[3]);
                    *(u32x4*)(rowp + bj * HALF) = w; } }
    }
};

struct EpiResidF32 {
    static constexpr bool PERM = false, AFTER_DRAIN = false;
    const bf16_t* X; float* Z;
    __device__ __forceinline__ void operator()(const f32x4 (&acc)[2][2][4][2], const Unit& u, int wr, int wc, int fr, int fq) const {
        typedef unsigned u32x2 __attribute__((ext_vector_type(2)));
        const int row0 = u.pm * BM + wr * 64 + fr, col0 = u.pn * BM + wc * 32 + 4 * fq;
#pragma unroll
        for (int ai = 0; ai < 2; ++ai)
#pragma unroll
            for (int m = 0; m < 4; ++m) { const size_t ro = (size_t)(row0 + ai * HALF + m * 16) * 1024;
#pragma unroll
                for (int bj = 0; bj < 2; ++bj)
#pragma unroll
                    for (int n = 0; n < 2; ++n) { const int c = col0 + bj * HALF + n * 16; const u32x2 xw = *(const u32x2*)(X + ro + c);
                        f32x4 xv; xv[0] = __builtin_bit_cast(float, xw.x << 16); xv[1] = __builtin_bit_cast(float, xw.x & 0xffff0000u); xv[2] = __builtin_bit_cast(float, xw.y << 16); xv[3] = __builtin_bit_cast(float, xw.y & 0xffff0000u);
                        *(f32x4*)(Z + ro + c) = xv * 1.41421356237309515f + acc[ai][bj][m][n]; } }
    }
};
struct EpiCInF {
    static constexpr bool PERM = true, AFTER_DRAIN = false;
    bf16_t *CQ, *CK, *CV, *CG; const float* lb;
    __device__ __forceinline__ void operator()(const f32x4 (&acc)[2][2][4][2], const Unit& u, int wr, int wc, int fr, int fq) const {
        const int seg = u.pn >> 2, colt = (u.pn & 3) * BM;
        bf16_t* base = seg == 0 ? CQ : (seg == 1 ? CK : (seg == 2 ? CV : CG));
        const int row0 = u.pm * BM + wr * 64 + fr, col0 = colt + wc * 32 + 8 * fq;
        f32x4 om[2][2];
#pragma unroll
        for (int bj = 0; bj < 2; ++bj)
#pragma unroll
            for (int n = 0; n < 2; ++n) { const f32x4 l = *(const f32x4*)(lb + col0 + bj * HALF + 4 * n); om[bj][n] = 1.0f - l; }
#pragma unroll
        for (int ai = 0; ai < 2; ++ai)
#pragma unroll
            for (int m = 0; m < 4; ++m) { bf16_t* rowp = base + (size_t)(row0 + ai * HALF + m * 16) * 1024 + col0;
#pragma unroll
                for (int bj = 0; bj < 2; ++bj) { f32x4 v0 = acc[ai][bj][m][0], v1 = acc[ai][bj][m][1];
                    if (seg == 1) {
#pragma unroll
                        for (int q = 0; q < 4; ++q) { v0[q] = om[bj][0][q] / (1.0f + __expf(v0[q])); v1[q] = om[bj][1][q] / (1.0f + __expf(v1[q])); } }
                    u32x4 w; w.x = cvt_pk_bf16(v0[0], v0[1]); w.y = cvt_pk_bf16(v0[2], v0[3]); w.z = cvt_pk_bf16(v1[0], v1[1]); w.w = cvt_pk_bf16(v1[2], v1[3]);
                    *(u32x4*)(rowp + bj * HALF) = w; } }
    }
};
template <class Epi, class Sched, bool ALIGN_EPI = false, bool SP2 = false>
__device__ __forceinline__ void gemm_phase(PG8_LAS unsigned char* lds, const Gemm g, const Sched& S, const Epi& E) {
    const int tid = threadIdx.x, wid = __builtin_amdgcn_readfirstlane(tid >> 6), lane = tid & 63, wr = wid >> 2, wc = wid & 3, fr = lane & 15, fq = lane >> 4;
    const int K = g.K, nt = K / BK;
    unsigned voffA[2], voffB[2];
#pragma unroll
    for (int i = 0; i < 2; ++i) { int R, C; stage_rc(tid * 16 + i * 8192, R, C); const int Rb = Epi::PERM ? ((R & ~31) + perm32(R & 31)) : R;
        voffA[i] = (unsigned)(R * K + C) * 2u; voffB[i] = (unsigned)(Rb * K + C) * 2u; }
    const size_t kstep = (size_t)(BK * 2);
    const size_t hstep = (size_t)HALF * K * 2;
    const size_t tstep = 2 * hstep;
    const unsigned ldsw = (unsigned)wid * 1024u;
    const int aoff = lds_byte(wr * 64 + fr, fq * 8), boff = lds_byte(wc * 32 + fr, fq * 8);
#define PG8_SA(b, h) (((b) * 2 + (h)) * HTB)
#define PG8_SB(b, h) ((4 + (b) * 2 + (h)) * HTB)
#define PG8_STAGE(bufoff, gbase, voff) do { _Pragma("unroll") for (int _i = 0; _i < 2; ++_i) \
        __builtin_amdgcn_global_load_lds((const unsigned*)((const char*)(gbase) + (voff)[_i]), (PG8_LAS unsigned*)(lds + (bufoff) + ldsw + _i * 8192), 16, 0, 0); } while (0)
#define PG8_LDA(dst, b, h) do { _Pragma("unroll") for (int m = 0; m < 4; ++m) _Pragma("unroll") for (int k = 0; k < 2; ++k) dst[m][k] = *(const PG8_LAS bf16x8*)(lds + PG8_SA(b, h) + aoff + m * 2048 + k * 1024); } while (0)
#define PG8_LDB(dst, b, h) do { _Pragma("unroll") for (int n = 0; n < 2; ++n) _Pragma("unroll") for (int k = 0; k < 2; ++k) dst[n][k] = *(const PG8_LAS bf16x8*)(lds + PG8_SB(b, h) + boff + n * 2048 + k * 1024); } while (0)
#define PG8_MMA(ai, bj, At, Bt) do { __builtin_amdgcn_s_setprio(1); _Pragma("unroll") for (int m = 0; m < 4; ++m) _Pragma("unroll") for (int n = 0; n < 2; ++n) _Pragma("unroll") for (int k = 0; k < 2; ++k) \
        acc[ai][bj][m][n] = __builtin_amdgcn_mfma_f32_16x16x32_bf16(Bt[n][k], At[m][k], acc[ai][bj][m][n], 0, 0, 0); __builtin_amdgcn_s_setprio(0); } while (0)
#define PG8_WAIT_V(n) asm volatile("s_waitcnt vmcnt(" #n ")" ::: "memory")
#define PG8_WAIT_L(n) asm volatile("s_waitcnt lgkmcnt(" #n ")" ::: "memory")
#define PG8_BAR __builtin_amdgcn_s_barrier()
#define PG8_SCHED __builtin_amdgcn_sched_barrier(0)
    Unit cur, nxt; int ui = 0;
    if (!S.next(0, cur)) return;
    f32x4 acc[2][2][4][2];
#pragma unroll
    for (int a = 0; a < 2; ++a)
#pragma unroll
        for (int b = 0; b < 2; ++b)
#pragma unroll
            for (int m = 0; m < 4; ++m)
#pragma unroll
                for (int n = 0; n < 2; ++n) acc[a][b][m][n] = (f32x4){0.f, 0.f, 0.f, 0.f};
    bf16x8 At[4][2], B0[2][2], B1[2][2];
    const char* cA = (const char*)g.A + (size_t)cur.pm * tstep; const char* cB = (const char*)g.Bt + (size_t)cur.pn * tstep;
    S.a_ready(cur);
    if constexpr (SP2) {
        PG8_STAGE(PG8_SB(0, 0), cB, voffB); PG8_STAGE(PG8_SB(0, 1), cB + hstep, voffB); PG8_STAGE(PG8_SA(0, 0), cA, voffA); PG8_STAGE(PG8_SA(0, 1), cA + hstep, voffA);
        if (wr == 1) PG8_BAR;
        PG8_WAIT_V(2); PG8_BAR;
        PG8_STAGE(PG8_SB(1, 0), cB + kstep, voffB); PG8_STAGE(PG8_SA(1, 0), cA + kstep, voffA); PG8_STAGE(PG8_SB(1, 1), cB + hstep + kstep, voffB);
        PG8_WAIT_V(6); PG8_BAR;
    } else {
        PG8_STAGE(PG8_SB(0, 0), cB, voffB); PG8_STAGE(PG8_SA(0, 0), cA, voffA); PG8_STAGE(PG8_SB(0, 1), cB + hstep, voffB); PG8_STAGE(PG8_SA(0, 1), cA + hstep, voffA);
        if (wr == 1) PG8_BAR;
        PG8_WAIT_V(4); PG8_BAR;
        PG8_STAGE(PG8_SB(1, 0), cB + kstep, voffB); PG8_STAGE(PG8_SA(1, 0), cA + kstep, voffA); PG8_STAGE(PG8_SB(1, 1), cB + hstep + kstep, voffB);
        PG8_WAIT_V(6); PG8_BAR;
    }
    for (;;) {
        const bool has_next = S.next(ui + 1, nxt);
        const char* nA = has_next ? (const char*)g.A + (size_t)nxt.pm * tstep : cA; const char* nB = has_next ? (const char*)g.Bt + (size_t)nxt.pn * tstep : cB;
        for (int t = 0; t < nt; t += 2) {
            const bool last = (t == nt - 2);
            const char* a1 = cA + (size_t)(t + 1) * kstep;
            const char* a2 = last ? nA : cA + (size_t)(t + 2) * kstep; const char* b2 = last ? nB : cB + (size_t)(t + 2) * kstep;
            const char* a3 = a2 + kstep; const char* b3 = b2 + kstep;
            if (last && has_next) S.a_ready(nxt);
            if constexpr (SP2) {
            PG8_LDB(B0, 0, 0); PG8_LDB(B1, 0, 1); PG8_SCHED; PG8_LDA(At, 0, 0); PG8_STAGE(PG8_SA(1, 1), a1 + hstep, voffA);
            PG8_WAIT_V(8); PG8_WAIT_L(0); PG8_BAR; PG8_MMA(0, 0, At, B0); PG8_MMA(0, 1, At, B1); PG8_BAR; PG8_SCHED;
            PG8_LDA(At, 0, 1); PG8_STAGE(PG8_SB(0, 0), b2, voffB); PG8_STAGE(PG8_SB(0, 1), b2 + hstep, voffB); PG8_STAGE(PG8_SA(0, 0), a2, voffA);
            PG8_WAIT_V(8); PG8_WAIT_L(0); PG8_BAR; PG8_MMA(1, 0, At, B0); PG8_MMA(1, 1, At, B1); PG8_BAR; PG8_SCHED;
            PG8_LDB(B0, 1, 0); PG8_LDB(B1, 1, 1); PG8_SCHED; PG8_LDA(At, 1, 0); PG8_STAGE(PG8_SA(0, 1), a2 + hstep, voffA);
            PG8_WAIT_V(8); PG8_WAIT_L(0); PG8_BAR; PG8_MMA(0, 0, At, B0); PG8_MMA(0, 1, At, B1); PG8_BAR; PG8_SCHED;
            PG8_LDA(At, 1, 1); PG8_STAGE(PG8_SB(1, 0), b3, voffB); PG8_STAGE(PG8_SB(1, 1), b3 + hstep, voffB); PG8_STAGE(PG8_SA(1, 0), a3, voffA);
            PG8_WAIT_V(8); PG8_WAIT_L(0); PG8_BAR; PG8_MMA(1, 0, At, B0); PG8_MMA(1, 1, At, B1); PG8_BAR; PG8_SCHED;
            } else {
            PG8_LDB(B0, 0, 0); PG8_SCHED; PG8_LDA(At, 0, 0); PG8_STAGE(PG8_SA(1, 1), a1 + hstep, voffA);
            PG8_WAIT_L(8); PG8_BAR; PG8_WAIT_L(0); PG8_MMA(0, 0, At, B0); PG8_BAR; PG8_SCHED;
            PG8_LDB(B1, 0, 1); PG8_STAGE(PG8_SB(0, 0), b2, voffB);
            PG8_BAR; PG8_WAIT_L(0); PG8_MMA(0, 1, At, B1); PG8_BAR;
            PG8_LDA(At, 0, 1); PG8_STAGE(PG8_SA(0, 0), a2, voffA);
            PG8_BAR; PG8_WAIT_L(0); PG8_MMA(1, 0, At, B0); PG8_BAR; PG8_SCHED;
            PG8_STAGE(PG8_SB(0, 1), b2 + hstep, voffB);
            PG8_WAIT_V(6); PG8_BAR; PG8_MMA(1, 1, At, B1); PG8_BAR;
            PG8_LDB(B0, 1, 0); PG8_SCHED; PG8_LDA(At, 1, 0); PG8_STAGE(PG8_SA(0, 1), a2 + hstep, voffA);
            PG8_WAIT_L(8); PG8_BAR; PG8_WAIT_L(0); PG8_MMA(0, 0, At, B0); PG8_BAR; PG8_SCHED;
            PG8_LDB(B1, 1, 1); PG8_STAGE(PG8_SB(1, 0), b3, voffB);
            PG8_BAR; PG8_WAIT_L(0); PG8_MMA(0, 1, At, B1); PG8_BAR;
            PG8_LDA(At, 1, 1); PG8_STAGE(PG8_SA(1, 0), a3, voffA);
            PG8_BAR; PG8_WAIT_L(0); PG8_MMA(1, 0, At, B0); PG8_BAR; PG8_SCHED;
            PG8_STAGE(PG8_SB(1, 1), b3 + hstep, voffB);
            PG8_WAIT_V(6); PG8_BAR; PG8_MMA(1, 1, At, B1); PG8_BAR;
            }
        }
        if constexpr (ALIGN_EPI) { if (wr == 0) PG8_BAR; }
        if constexpr (!Epi::AFTER_DRAIN) { E(acc, cur, wr, wc, fr, fq); S.done(cur); }
        if (!has_next) break;
#pragma unroll
        for (int a = 0; a < 2; ++a)
#pragma unroll
            for (int b = 0; b < 2; ++b)
#pragma unroll
                for (int m = 0; m < 4; ++m)
#pragma unroll
                    for (int n = 0; n < 2; ++n) acc[a][b][m][n] = (f32x4){0.f, 0.f, 0.f, 0.f};
        cur = nxt; cA = nA; cB = nB; ++ui;
        if constexpr (ALIGN_EPI) { if (wr == 1) PG8_BAR; }
    }
    PG8_WAIT_V(0);
    if constexpr (!ALIGN_EPI) { if (wr == 0) PG8_BAR; }
    PG8_BAR;
    if constexpr (Epi::AFTER_DRAIN) { E.fused(acc, cur, wr, wc, fr, fq, lds, wid, lane); S.done(cur); }
#undef PG8_SA
#undef PG8_SB
#undef PG8_STAGE
#undef PG8_LDA
#undef PG8_LDB
#undef PG8_MMA
#undef PG8_WAIT_V
#undef PG8_WAIT_L
#undef PG8_BAR
#undef PG8_SCHED
}
}

__device__ __forceinline__ float gamma_log2(int h) { return log2f(1.f - exp2f(-5.f - (float)h)); }

__device__ __forceinline__ void phase_prologue(LAS unsigned char* lds, const float* const* in, unsigned char* ws) {
    const int tid = threadIdx.x, lane = tid & 63, wave = tid >> 6;
    const int gw = blockIdx.x * NWAVES + wave, NGW = gridDim.x * NWAVES;
    LAS float* scr = (LAS float*)(lds + wave * 16384);
    constexpr int I_ABIN = (D / 64) * (AB_IN / 32), I_SQ = (D / 64) * (D / 32), I_CIN = (D / 64) * (C_IN / 32), I_WQ = (D / 64) * (2048 / 32);
    constexpr int NITEMS = I_ABIN + I_SQ + I_CIN + I_SQ + 2 * I_WQ;
    for (int it = gw; it < NITEMS; it += NGW) {
        int r = it;
        if (r < I_ABIN) { p0_transpose_item(in[1], D, AB_IN, (bf16*)(ws + WS_WABIN), scr, r, lane); continue; } r -= I_ABIN;
        if (r < I_SQ) { p0_transpose_item(in[5], D, D, (bf16*)(ws + WS_WABOUT), scr, r, lane); continue; } r -= I_SQ;
        if (r < I_CIN) { p0_transpose_item(in[6], D, C_IN, (bf16*)(ws + WS_WCIN), scr, r, lane); continue; } r -= I_CIN;
        if (r < I_SQ) { p0_transpose_item(in[9], D, D, (bf16*)(ws + WS_WCOUT), scr, r, lane); continue; } r -= I_SQ;
        if (r < I_WQ) { p0_transpose_item(in[10], D, 2048, (bf16*)(ws + WS_WQ), scr, r, lane); continue; } r -= I_WQ;
        p0_transpose_item(in[10] + (size_t)D * 2048, D, 2048, (bf16*)(ws + WS_WQ) + (size_t)2048 * D, scr, r, lane);
    }
    for (int it = gw; it < 32; it += NGW) p0_transpose_item(in[2] + (size_t)(it >> 3) * 16384, 128, 128, (bf16*)(ws + WS_POOLWT) + (size_t)(it >> 3) * 16384, scr, it & 7, lane);
    const size_t gt = (size_t)blockIdx.x * NTHR + tid, NT = (size_t)gridDim.x * NTHR;
    { const float* x = in[0]; bf16* xb = (bf16*)(ws + WS_XB);
      for (size_t i = gt; i < (size_t)T * D / 8; i += NT) { const f32x4 a = *(const GAS f32x4*)(x + i * 8), b = *(const GAS f32x4*)(x + i * 8 + 4);
          v4u o; o.x = pk2(a.x, a.y); o.y = pk2(a.z, a.w); o.z = pk2(b.x, b.y); o.w = pk2(b.z, b.w); *(GAS v4u*)(xb + i * 8) = o; } }
    { const float* k = in[11]; bf16* kb = (bf16*)(ws + WS_KEYS);
      for (size_t i = gt; i < (size_t)2 * 8 * 2 * 128 * 128 / 8; i += NT) { const f32x4 a = *(const GAS f32x4*)(k + i * 8), b = *(const GAS f32x4*)(k + i * 8 + 4);
          v4u o; o.x = pk2(a.x, a.y); o.y = pk2(a.z, a.w); o.z = pk2(b.x, b.y); o.w = pk2(b.z, b.w); *(GAS v4u*)(kb + i * 8) = o; } }
    { float* ct = (float*)(ws + WS_ROPE); float* st = ct + 4096 * 32;
      for (size_t i = gt; i < (size_t)4096 * 32; i += NT) { const int pos = (int)(i >> 5), f = (int)(i & 31);
          const double inv = exp(-log(10000.0) * ((double)f / 31.0)); const double ang = (double)pos * inv;
          ct[i] = (float)cos(ang); st[i] = (float)sin(ang); } }
    { const float* l = in[7]; float* lb = (float*)(ws + WS_LB);
      for (size_t i = gt; i < 1024; i += NT) { const float a = l[i], b = l[1024 + i]; const float m = fmaxf(a, b); const float ea = expf(a - m), eb = expf(b - m); lb[i] = eb / (ea + eb); } }
}

__device__ __forceinline__ void phase_ret_local(LAS unsigned char* lds, unsigned char* ws) {
    const int tid = threadIdx.x;
    const bf16* H0 = (const bf16*)(ws + WS_H0); float* LST = (float*)(ws + WS_LST);
    const float* ct = (const float*)(ws + WS_ROPE); const float* st = ct + 4096 * 32;
    LAS float* kd = (LAS float*)lds;
    LAS float* vv = (LAS float*)(lds + 32768);
    for (int item = blockIdx.x; item < 1024; item += gridDim.x) {
        const int n = item & 31, h = (item >> 5) & 3, b = item >> 7;
        const size_t t0 = (size_t)b * SEQ + n * 128; const float lg = gamma_log2(h);
        for (int idx = tid; idx < 4096; idx += NTHR) { const int s = idx >> 5, i = idx & 31, pos = n * 128 + s;
            const bf16* row = H0 + (t0 + s) * AB_IN + 768 + h * 64;
            const float x1 = bf2f(row[i]), x2 = bf2f(row[i + 32]); const float c = ct[pos * 32 + i], sn = st[pos * 32 + i];
            const float dec = exp2f((float)(127 - s) * lg) * 0.125f;
            kd[s * 64 + i] = (x1 * c - x2 * sn) * dec; kd[s * 64 + i + 32] = (x2 * c + x1 * sn) * dec; }
        for (int idx = tid; idx < 16384; idx += NTHR) { const int s = idx >> 7, e = idx & 127; vv[idx] = bf2f(H0[(t0 + s) * AB_IN + 1024 + h * 128 + e]); }
        __syncthreads();
        const int e = tid & 127, dg = tid >> 7;
        float acc[16];
#pragma unroll
        for (int j = 0; j < 16; ++j) acc[j] = 0.f;
        for (int s = 0; s < 128; ++s) { const float v = vv[s * 128 + e];
#pragma unroll
            for (int j = 0; j < 16; ++j) acc[j] += kd[s * 64 + dg * 16 + j] * v; }
#pragma unroll
        for (int j = 0; j < 16; ++j) LST[(size_t)item * 8192 + (dg * 16 + j) * 128 + e] = acc[j];
        __syncthreads();
    }
}
__device__ __forceinline__ void phase_ret_prefix(unsigned char* ws) {
    float* LST = (float*)(ws + WS_LST);
    const size_t gt = (size_t)blockIdx.x * NTHR + threadIdx.x, NT = (size_t)gridDim.x * NTHR;
    for (size_t idx = gt; idx < (size_t)32 * 8192; idx += NT) { const int bh = (int)(idx >> 13), el = (int)(idx & 8191), h = bh & 3;
        const float g128 = exp2f(128.f * gamma_log2(h)); float S = 0.f;
        for (int n = 0; n < 32; ++n) { float* p = LST + ((size_t)(bh * 32 + n) * 8192 + el); const float tmp = *p; *p = S; S = S * g128 + tmp; } }
}
__device__ __forceinline__ void phase_ret_out_pool(LAS unsigned char* lds, const float* const* in, unsigned char* ws) {
    const int tid = threadIdx.x;
    const bf16* H0 = (const bf16*)(ws + WS_H0); const float* LST = (const float*)(ws + WS_LST); bf16* Y = (bf16*)(ws + WS_Y);
    const float* ct = (const float*)(ws + WS_ROPE); const float* st = ct + 4096 * 32;
    const float* pool_w = in[2]; const float* pool_scale = in[3]; const float* ret_g = in[4];
    LAS float* qs = (LAS float*)lds;
    LAS float* ks = qs + 128 * 65;
    LAS float* R2 = (LAS float*)(lds + 66560);
    LAS float* PA = (LAS float*)lds;
    LAS float* PB = (LAS float*)(lds + 66048);
    for (int item = blockIdx.x; item < 256; item += gridDim.x) {
        const int n = item & 31, b = item >> 5; const size_t t0 = (size_t)b * SEQ + n * 128;
        const int c = tid >> 2, eg = tid & 3;
        for (int h = 0; h < 4; ++h) {
            const float lg = gamma_log2(h);
            for (int idx = tid; idx < 4096; idx += NTHR) { const int s = idx >> 5, i = idx & 31, pos = n * 128 + s;
                const bf16* rq = H0 + (t0 + s) * AB_IN + 512 + h * 64; const bf16* rk = H0 + (t0 + s) * AB_IN + 768 + h * 64;
                const float cs = ct[pos * 32 + i], sn = st[pos * 32 + i];
                const float q1 = bf2f(rq[i]), q2 = bf2f(rq[i + 32]), k1 = bf2f(rk[i]), k2 = bf2f(rk[i + 32]);
                qs[s * 65 + i] = q1 * cs - q2 * sn; qs[s * 65 + i + 32] = q2 * cs + q1 * sn;
                ks[s * 65 + i] = (k1 * cs - k2 * sn) * 0.125f; ks[s * 65 + i + 32] = (k2 * cs + k1 * sn) * 0.125f; }
            { const float* Sg = LST + (size_t)((b * 4 + h) * 32 + n) * 8192;
              for (int idx = tid; idx < 8192; idx += NTHR) R2[idx] = Sg[idx]; }
            __syncthreads();
            float o[32];
#pragma unroll
            for (int j = 0; j < 32; ++j) o[j] = 0.f;
            for (int d = 0; d < 64; ++d) { const float qv = qs[c * 65 + d];
#pragma unroll
                for (int j = 0; j < 32; ++j) o[j] += qv * R2[d * 128 + eg * 32 + j]; }
            { const float qd = exp2f((float)(c + 1) * lg);
#pragma unroll
              for (int j = 0; j < 32; ++j) o[j] *= qd; }
            __syncthreads();
            for (int idx = tid; idx < 16384; idx += NTHR) { const int s = idx >> 7, e = idx & 127; R2[idx] = bf2f(H0[(t0 + s) * AB_IN + 1024 + h * 128 + e]); }
            __syncthreads();
            for (int s = 0; s <= c; ++s) {
                float dot = 0.f;
#pragma unroll 16
                for (int d = 0; d < 64; ++d) dot += qs[c * 65 + d] * ks[s * 65 + d];
                const float w = dot * exp2f((float)(c - s) * lg);
#pragma unroll
                for (int j = 0; j < 32; ++j) o[j] += w * R2[s * 128 + eg * 32 + j];
            }
            float sum = 0.f;
#pragma unroll
            for (int j = 0; j < 32; ++j) sum += o[j];
            sum += __shfl_xor(sum, 1); sum += __shfl_xor(sum, 2);
            const float mean = sum * (1.f / 128.f); float sq = 0.f;
#pragma unroll
            for (int j = 0; j < 32; ++j) { const float dl = o[j] - mean; sq += dl * dl; }
            sq += __shfl_xor(sq, 1); sq += __shfl_xor(sq, 2);
            const float rstd = 1.f / sqrtf(sq * (1.f / 128.f) + LN_EPS);
            { const bf16* rg = H0 + (t0 + c) * AB_IN + 1536 + h * 128 + eg * 32; bf16* yo = Y + (t0 + c) * D + 512 + h * 128 + eg * 32;
#pragma unroll
              for (int j = 0; j < 32; ++j) { const float g = bf2f(rg[j]); const float sg = g / (1.f + expf(-g));
                  yo[j] = (bf16)f2bf((o[j] - mean) * rstd * ret_g[h * 128 + eg * 32 + j] * sg); } }
            __syncthreads();
        }
        for (int gi = 0; gi < 4; ++gi) {
            const int w = 2 << gi;
            for (int idx = tid; idx < 16384; idx += NTHR) { const int s = idx >> 7, cc = idx & 127, pos = n * 128 + s; const int cnt = (pos + 1 < w) ? pos + 1 : w;
                float sum = 0.f; for (int j = 0; j < cnt; ++j) sum += bf2f(H0[(t0 + s - j) * AB_IN + gi * 128 + cc]);
                PA[s * 129 + cc] = sum / (float)cnt - bf2f(H0[(t0 + s) * AB_IN + gi * 128 + cc]); }
            for (int idx = tid; idx < 16384; idx += NTHR) PB[idx] = pool_w[gi * 16384 + idx];
            __syncthreads();
            float o[32];
#pragma unroll
            for (int j = 0; j < 32; ++j) o[j] = 0.f;
            for (int cc = 0; cc < 128; ++cc) { const float pv = PA[c * 129 + cc];
#pragma unroll
                for (int j = 0; j < 32; ++j) o[j] += pv * PB[cc * 128 + eg * 32 + j]; }
            { bf16* yo = Y + (t0 + c) * D + gi * 128 + eg * 32;
#pragma unroll
              for (int j = 0; j < 32; ++j) yo[j] = (bf16)f2bf(o[j] * pool_scale[gi * 128 + eg * 32 + j]); }
            __syncthreads();
        }
    }
}

__device__ __forceinline__ void unpack8(const v4u w, float (&x)[8]) { x[0] = bflo(w.x); x[1] = bfhi(w.x); x[2] = bflo(w.y); x[3] = bfhi(w.y); x[4] = bflo(w.z); x[5] = bfhi(w.z); x[6] = bflo(w.w); x[7] = bfhi(w.w); }
__device__ __forceinline__ v4u pack8(const float (&x)[8]) { v4u w; w.x = pk2(x[0], x[1]); w.y = pk2(x[2], x[3]); w.z = pk2(x[4], x[5]); w.w = pk2(x[6], x[7]); return w; }
__device__ __forceinline__ void phase_ret_out_pool_fast(LAS unsigned char* lds, const float* const* in, unsigned char* ws) {
    const int tid = threadIdx.x, lane = tid & 63, wave = __builtin_amdgcn_readfirstlane(tid >> 6);
    const int c = lane & 31, hh = lane >> 5, cbk = wave & 3, eh = wave >> 2;
    const bf16* H0 = (const bf16*)(ws + WS_H0); const float* LST = (const float*)(ws + WS_LST); bf16* Y = (bf16*)(ws + WS_Y);
    const float* ct = (const float*)(ws + WS_ROPE); const float* st = ct + 4096 * 32;
    const float* pool_scale = in[3]; const float* ret_g = in[4]; const bf16* PWT = (const bf16*)(ws + WS_POOLWT);
    constexpr int O_QP = 0, O_KP = 18432, O_VT = 36864, O_ST = 71680, O_PI = 90112, O_RED = 124928, O_PT = 0, O_WT = 34816;
    for (int item = blockIdx.x; item < 256; item += gridDim.x) {
        const int n = item & 31, b = item >> 5; const size_t t0 = (size_t)b * SEQ + n * 128;
        for (int h = 0; h < 4; ++h) {
            const float lg = gamma_log2(h);
            __syncthreads();
            { const int s = tid >> 2, grp = tid & 3, pos = n * 128 + s;
              const bf16* rq = H0 + (t0 + s) * AB_IN + 512 + h * 64 + 8 * grp; const bf16* rk = H0 + (t0 + s) * AB_IN + 768 + h * 64 + 8 * grp;
              float q1[8], q2[8], k1[8], k2[8], cs[8], sn[8];
              unpack8(*(const GAS v4u*)rq, q1); unpack8(*(const GAS v4u*)(rq + 32), q2); unpack8(*(const GAS v4u*)rk, k1); unpack8(*(const GAS v4u*)(rk + 32), k2);
              { const f32x4 a = *(const GAS f32x4*)(ct + pos * 32 + 8 * grp), bq = *(const GAS f32x4*)(ct + pos * 32 + 8 * grp + 4);
                cs[0] = a.x; cs[1] = a.y; cs[2] = a.z; cs[3] = a.w; cs[4] = bq.x; cs[5] = bq.y; cs[6] = bq.z; cs[7] = bq.w; }
              { const f32x4 a = *(const GAS f32x4*)(st + pos * 32 + 8 * grp), bq = *(const GAS f32x4*)(st + pos * 32 + 8 * grp + 4);
                sn[0] = a.x; sn[1] = a.y; sn[2] = a.z; sn[3] = a.w; sn[4] = bq.x; sn[5] = bq.y; sn[6] = bq.z; sn[7] = bq.w; }
              const float gq = exp2f((float)(s + 1) * lg), gk = 0.125f * exp2f(-(float)(s + 1) * lg);
              float qa[8], qb[8], ka[8], kb[8];
#pragma unroll
              for (int j = 0; j < 8; ++j) { qa[j] = (q1[j] * cs[j] - q2[j] * sn[j]) * gq; qb[j] = (q2[j] * cs[j] + q1[j] * sn[j]) * gq;
                                            ka[j] = (k1[j] * cs[j] - k2[j] * sn[j]) * gk; kb[j] = (k2[j] * cs[j] + k1[j] * sn[j]) * gk; }
              *(LAS v4u*)(lds + O_QP + s * 144 + 16 * grp) = pack8(qa); *(LAS v4u*)(lds + O_QP + s * 144 + 64 + 16 * grp) = pack8(qb);
              *(LAS v4u*)(lds + O_KP + s * 144 + 16 * grp) = pack8(ka); *(LAS v4u*)(lds + O_KP + s * 144 + 64 + 16 * grp) = pack8(kb); }
#pragma unroll
            for (int i = 0; i < 4; ++i) { const int task = tid + 512 * i, e8 = task >> 7, s = task & 127;
                const v4u w = *(const GAS v4u*)(H0 + (t0 + s) * AB_IN + 1024 + h * 128 + 8 * e8);
                LAS bf16* d = (LAS bf16*)(lds + O_VT + (8 * e8) * 272 + 2 * s);
                d[0 * 136] = (bf16)(w.x & 0xffffu); d[1 * 136] = (bf16)(w.x >> 16); d[2 * 136] = (bf16)(w.y & 0xffffu); d[3 * 136] = (bf16)(w.y >> 16);
                d[4 * 136] = (bf16)(w.z & 0xffffu); d[5 * 136] = (bf16)(w.z >> 16); d[6 * 136] = (bf16)(w.w & 0xffffu); d[7 * 136] = (bf16)(w.w >> 16); }
            { const float* Sg = LST + (size_t)((b * 4 + h) * 32 + n) * 8192;
#pragma unroll
              for (int i = 0; i < 4; ++i) { const int task = tid + 512 * i, e4 = task >> 6, d = task & 63;
                  const f32x4 sv = *(const GAS f32x4*)(Sg + d * 128 + 4 * e4);
                  LAS bf16* o = (LAS bf16*)(lds + O_ST + (4 * e4) * 144 + 2 * d);
                  o[0 * 72] = (bf16)f2bf(sv.x); o[1 * 72] = (bf16)f2bf(sv.y); o[2 * 72] = (bf16)f2bf(sv.z); o[3 * 72] = (bf16)f2bf(sv.w); } }
            __syncthreads();
            bf16x8 qf[4];
#pragma unroll
            for (int ks = 0; ks < 4; ++ks) qf[ks] = *(const LAS bf16x8*)(lds + O_QP + (32 * cbk + c) * 144 + (16 * ks + 8 * hh) * 2);
            for (int sb = 0; sb <= cbk; ++sb) {
                f32x16 sc;
#pragma unroll
                for (int r = 0; r < 16; ++r) sc[r] = 0.f;
#pragma unroll
                for (int ks = 0; ks < 4; ++ks) { const bf16x8 kf = *(const LAS bf16x8*)(lds + O_KP + (32 * sb + c) * 144 + (16 * ks + 8 * hh) * 2);
                    sc = __builtin_amdgcn_mfma_f32_32x32x16_bf16(kf, qf[ks], sc, 0, 0, 0); }
#pragma unroll
                for (int g4 = 0; g4 < 4; ++g4) { float m[4];
#pragma unroll
                    for (int q = 0; q < 4; ++q) { const float sv = sc[4 * g4 + q]; m[q] = (sb < cbk || 8 * g4 + 4 * hh + q <= c) ? sv : 0.f; }
                    *(LAS v2u*)(lds + O_PI + cbk * 8704 + c * 272 + (32 * sb + 8 * g4 + 4 * hh) * 2) = (v2u){pk2(m[0], m[1]), pk2(m[2], m[3])}; }
            }
            f32x16 acc[2];
#pragma unroll
            for (int j = 0; j < 2; ++j) {
#pragma unroll
                for (int r = 0; r < 16; ++r) acc[j][r] = 0.f;
                const int eb = 2 * eh + j;
                for (int sb = 0; sb <= cbk; ++sb) {
#pragma unroll
                    for (int ks = 0; ks < 2; ++ks) { const bf16x8 af = *(const LAS bf16x8*)(lds + O_VT + (32 * eb + c) * 272 + (32 * sb + 16 * ks + 8 * hh) * 2);
                        const bf16x8 pf = *(const LAS bf16x8*)(lds + O_PI + cbk * 8704 + c * 272 + (32 * sb + 16 * ks + 8 * hh) * 2);
                        acc[j] = __builtin_amdgcn_mfma_f32_32x32x16_bf16(af, pf, acc[j], 0, 0, 0); }
                }
#pragma unroll
                for (int ks = 0; ks < 4; ++ks) { const bf16x8 sf = *(const LAS bf16x8*)(lds + O_ST + (32 * eb + c) * 144 + (16 * ks + 8 * hh) * 2);
                    acc[j] = __builtin_amdgcn_mfma_f32_32x32x16_bf16(sf, qf[ks], acc[j], 0, 0, 0); }
            }
            float sum = 0.f, sq = 0.f;
#pragma unroll
            for (int j = 0; j < 2; ++j)
#pragma unroll
                for (int r = 0; r < 16; ++r) { const float ov = acc[j][r]; sum += ov; sq += ov * ov; }
            sum += __shfl_xor(sum, 32); sq += __shfl_xor(sq, 32);
            LAS float* red = (LAS float*)(lds + O_RED);
            if (hh == 0) { red[(eh * 128 + 32 * cbk + c) * 2] = sum; red[(eh * 128 + 32 * cbk + c) * 2 + 1] = sq; }
            __syncthreads();
            sum += red[((eh ^ 1) * 128 + 32 * cbk + c) * 2]; sq += red[((eh ^ 1) * 128 + 32 * cbk + c) * 2 + 1];
            const float mean = sum * (1.f / 128.f); const float var = fmaxf(sq * (1.f / 128.f) - mean * mean, 0.f);
            const float rstd = 1.f / sqrtf(var + LN_EPS);
            { const size_t row = t0 + 32 * cbk + c;
#pragma unroll
              for (int j = 0; j < 2; ++j)
#pragma unroll
                  for (int g4 = 0; g4 < 4; ++g4) { const int e = 32 * (2 * eh + j) + 8 * g4 + 4 * hh;
                      const v2u gw2 = *(const GAS v2u*)(H0 + row * AB_IN + 1536 + h * 128 + e); const f32x4 gm = *(const GAS f32x4*)(ret_g + h * 128 + e);
                      const float g0 = bflo(gw2.x), g1 = bfhi(gw2.x), g2 = bflo(gw2.y), g3 = bfhi(gw2.y);
                      const float o0 = acc[j][4 * g4 + 0], o1 = acc[j][4 * g4 + 1], o2 = acc[j][4 * g4 + 2], o3 = acc[j][4 * g4 + 3];
                      const float y0 = (o0 - mean) * rstd * gm.x * (g0 / (1.f + __expf(-g0))), y1 = (o1 - mean) * rstd * gm.y * (g1 / (1.f + __expf(-g1)));
                      const float y2 = (o2 - mean) * rstd * gm.z * (g2 / (1.f + __expf(-g2))), y3 = (o3 - mean) * rstd * gm.w * (g3 / (1.f + __expf(-g3)));
                      *(GAS v2u*)(Y + row * D + 512 + h * 128 + e) = (v2u){pk2(y0, y1), pk2(y2, y3)}; } }
        }
        for (int gi = 0; gi < 4; ++gi) {
            const int w = 2 << gi;
            __syncthreads();
#pragma unroll
            for (int i = 0; i < 4; ++i) { const int task = tid + 512 * i, t = task >> 4, c8 = task & 15, pos = n * 128 + t; const int cnt = (pos + 1 < w) ? pos + 1 : w;
                const bf16* ur = H0 + (t0 + t) * AB_IN + gi * 128 + 8 * c8;
                float u0[8], sm[8]; unpack8(*(const GAS v4u*)ur, u0);
#pragma unroll
                for (int q = 0; q < 8; ++q) sm[q] = u0[q];
                for (int j = 1; j < cnt; ++j) { float uj[8]; unpack8(*(const GAS v4u*)(ur - (size_t)j * AB_IN), uj);
#pragma unroll
                    for (int q = 0; q < 8; ++q) sm[q] += uj[q]; }
                const float ic = 1.f / (float)cnt; float pv[8];
#pragma unroll
                for (int q = 0; q < 8; ++q) pv[q] = sm[q] * ic - u0[q];
                *(LAS v4u*)(lds + O_PT + t * 272 + 16 * c8) = pack8(pv); }
#pragma unroll
            for (int i = 0; i < 4; ++i) { const int piece = tid + 512 * i, d = piece >> 4, c16 = piece & 15;
                *(LAS v4u*)(lds + O_WT + d * 272 + 16 * c16) = *(const GAS v4u*)(PWT + (size_t)(gi * 128 + d) * 128 + 8 * c16); }
            __syncthreads();
            bf16x8 pfr[8];
#pragma unroll
            for (int ks = 0; ks < 8; ++ks) pfr[ks] = *(const LAS bf16x8*)(lds + O_PT + (32 * cbk + c) * 272 + (16 * ks + 8 * hh) * 2);
#pragma unroll
            for (int j = 0; j < 2; ++j) { const int db = 2 * eh + j;
                f32x16 a2;
#pragma unroll
                for (int r = 0; r < 16; ++r) a2[r] = 0.f;
#pragma unroll
                for (int ks = 0; ks < 8; ++ks) { const bf16x8 wf = *(const LAS bf16x8*)(lds + O_WT + (32 * db + c) * 272 + (16 * ks + 8 * hh) * 2);
                    a2 = __builtin_amdgcn_mfma_f32_32x32x16_bf16(wf, pfr[ks], a2, 0, 0, 0); }
#pragma unroll
                for (int g4 = 0; g4 < 4; ++g4) { const int d0 = 32 * db + 8 * g4 + 4 * hh; const f32x4 ps = *(const GAS f32x4*)(pool_scale + gi * 128 + d0);
                    const float y0 = a2[4 * g4 + 0] * ps.x, y1 = a2[4 * g4 + 1] * ps.y, y2 = a2[4 * g4 + 2] * ps.z, y3 = a2[4 * g4 + 3] * ps.w;
                    *(GAS v2u*)(Y + (t0 + 32 * cbk + c) * D + gi * 128 + d0) = (v2u){pk2(y0, y1), pk2(y2, y3)}; }
            }
        }
    }
    __syncthreads();
}
__device__ __forceinline__ void phase_ln(const float* Z, bf16* O, const float* g, const float* bb) {
    const int tid = threadIdx.x, lane = tid & 63, wave = tid >> 6;
    const int gw = blockIdx.x * NWAVES + wave, NGW = gridDim.x * NWAVES;
    for (int m = gw; m < T; m += NGW) {
        const GAS f32x4* zr = (const GAS f32x4*)(Z + (size_t)m * D) + lane;
        f32x4 v[4]; float s = 0.f;
#pragma unroll
        for (int j = 0; j < 4; ++j) { v[j] = zr[64 * j]; s += (v[j].x + v[j].y) + (v[j].z + v[j].w); }
        const float mean = wave_sum(s) * (1.f / D); float s2 = 0.f;
#pragma unroll
        for (int j = 0; j < 4; ++j) { v[j] = v[j] - mean; s2 += (v[j].x * v[j].x + v[j].y * v[j].y) + (v[j].z * v[j].z + v[j].w * v[j].w); }
        const float rstd = 1.f / sqrtf(wave_sum(s2) * (1.f / D) + LN_EPS);
        GAS v2u* o8 = (GAS v2u*)(O + (size_t)m * D) + lane;
#pragma unroll
        for (int j = 0; j < 4; ++j) { const f32x4 gg = *((const GAS f32x4*)g + lane + 64 * j), b4 = *((const GAS f32x4*)bb + lane + 64 * j);
            v2u o; o.x = pk2(v[j].x * rstd * gg.x + b4.x, v[j].y * rstd * gg.y + b4.y); o.y = pk2(v[j].z * rstd * gg.z + b4.z, v[j].w * rstd * gg.w + b4.w); o8[64 * j] = o; }
    }
}
__device__ __forceinline__ void wave_argmax(float& bv, int& bi) {
#pragma unroll
    for (int off = 32; off >= 1; off >>= 1) { const float ov = __shfl_xor(bv, off); const int oi = __shfl_xor(bi, off);
        if (ov > bv || (ov == bv && oi < bi)) { bv = ov; bi = oi; } }
}
__device__ __forceinline__ void phase_topk(LAS unsigned char* lds, const bf16* Q, const float* keys  , int* EID, float* GATE) {
    const int tid = threadIdx.x, lane = tid & 63, wave = tid >> 6;
    LAS float* kl = (LAS float*)lds;
    LAS float* qt = (LAS float*)(lds + 66048);
    LAS float* sc = (LAS float*)(lds + 82560);
    for (int item = blockIdx.x; item < (T / 32) * 8; item += gridDim.x) {
        const int h = item & 7, tile = item >> 3; const size_t tok0 = (size_t)tile * 32;
        for (int p = 0; p < 2; ++p) {
            const float* kg = keys + (size_t)((h * 2 + p) * 128) * 128;
            for (int idx = tid; idx < 16384; idx += NTHR) { const int k = idx >> 7, d = idx & 127; kl[k * 129 + d] = kg[idx]; }
            for (int idx = tid; idx < 4096; idx += NTHR) { const int t = idx >> 7, d = idx & 127; qt[t * 129 + d] = bf2f(Q[(tok0 + t) * 2048 + h * 256 + p * 128 + d]); }
            __syncthreads();
            { const int t = tid >> 4, kg16 = tid & 15;
              for (int jj = 0; jj < 8; ++jj) { const int k = kg16 + 16 * jj; float dot = 0.f;
#pragma unroll 16
                  for (int d = 0; d < 128; ++d) dot += qt[t * 129 + d] * kl[k * 129 + d];
                  sc[(t * 2 + p) * 128 + k] = dot; } }
            __syncthreads();
        }
        for (int tt = 0; tt < 4; ++tt) {
            const int t = wave * 4 + tt;
            float tv[2]; int ti[2];
#pragma unroll
            for (int p = 0; p < 2; ++p) {
                float v0 = sc[(t * 2 + p) * 128 + lane], v1 = sc[(t * 2 + p) * 128 + lane + 64];
                float mv = 0.f; int mi = 0;
                for (int j = 0; j < 16; ++j) {
                    float bv; int bi; if (v0 >= v1) { bv = v0; bi = lane; } else { bv = v1; bi = lane + 64; }
                    wave_argmax(bv, bi);
                    if (lane == j) { mv = bv; mi = bi; }
                    if (bi == lane) v0 = -INFINITY; if (bi == lane + 64) v1 = -INFINITY;
                }
                tv[p] = mv; ti[p] = mi;
            }
            float cv[4];
#pragma unroll
            for (int m = 0; m < 4; ++m) { const int cidx = lane + 64 * m; cv[m] = __shfl(tv[0], cidx >> 4) + __shfl(tv[1], cidx & 15); }
            float bestv = 0.f; int bestc = 0;
            for (int j = 0; j < 16; ++j) {
                float bv = cv[0]; int bi = lane;
#pragma unroll
                for (int m = 1; m < 4; ++m) if (cv[m] > bv) { bv = cv[m]; bi = lane + 64 * m; }
                wave_argmax(bv, bi);
                if (lane == j) { bestv = bv; bestc = bi; }
#pragma unroll
                for (int m = 0; m < 4; ++m) if (bi == lane + 64 * m) cv[m] = -INFINITY;
            }
            const float mx = __shfl(bestv, 0);
            const float ex = (lane < 16) ? expf(bestv - mx) : 0.f;
            const float den = wave_sum(ex);
            const int ia = __shfl(ti[0], bestc >> 4), ib = __shfl(ti[1], bestc & 15);
            if (lane < 16) { const size_t o = (tok0 + t) * 128 + h * 16 + lane; EID[o] = ia * 128 + ib; GATE[o] = ex / den; }
        }
        __syncthreads();
    }
}

#define CEF_D(a, b) { const float hi_ = fmaxf((a), (b)), lo_ = fminf((a), (b)); (a) = hi_; (b) = lo_; }
#define CEF_A(a, b) { const float hi_ = fmaxf((a), (b)), lo_ = fminf((a), (b)); (a) = lo_; (b) = hi_; }
#define CEP_D(ka, pa, kb, pb) { const bool sw_ = (kb) > (ka); const float k0_ = sw_ ? (kb) : (ka), k1_ = sw_ ? (ka) : (kb); const int p0_ = sw_ ? (pb) : (pa), p1_ = sw_ ? (pa) : (pb); (ka) = k0_; (kb) = k1_; (pa) = p0_; (pb) = p1_; }
template <int OFF, int NV> __device__ __forceinline__ void bsort16_desc(float (&v)[NV]) {
#pragma unroll
    for (int k = 2; k <= 16; k <<= 1) {
#pragma unroll
        for (int j = k >> 1; j > 0; j >>= 1) {
#pragma unroll
            for (int i = 0; i < 16; ++i) { const int l = i ^ j;
                if (l > i) { if ((i & k) == 0) CEF_D(v[OFF + i], v[OFF + l]) else CEF_A(v[OFF + i], v[OFF + l]) } }
        }
    }
}
template <int OA, int NV> __device__ __forceinline__ void bmerge16_desc(float (&v)[NV]) {
#pragma unroll
    for (int j = 8; j > 0; j >>= 1) {
#pragma unroll
        for (int i = 0; i < 16; ++i) { const int l = i ^ j; if (l > i) CEF_D(v[OA + i], v[OA + l]) }
    }
}
template <int OA, int OB, int NV> __device__ __forceinline__ void merge_top16(float (&v)[NV]) {
#pragma unroll
    for (int i = 0; i < 16; ++i) v[OA + i] = fmaxf(v[OA + i], v[OB + 15 - i]);
    bmerge16_desc<OA, NV>(v);
}
template <int OFF, int NV> __device__ __forceinline__ void bsort16p_desc(float (&v)[NV], int (&q)[NV]) {
#pragma unroll
    for (int k = 2; k <= 16; k <<= 1) {
#pragma unroll
        for (int j = k >> 1; j > 0; j >>= 1) {
#pragma unroll
            for (int i = 0; i < 16; ++i) { const int l = i ^ j;
                if (l > i) { if ((i & k) == 0) CEP_D(v[OFF + i], q[OFF + i], v[OFF + l], q[OFF + l]) else CEP_D(v[OFF + l], q[OFF + l], v[OFF + i], q[OFF + i]) } }
        }
    }
}
template <int OA, int NV> __device__ __forceinline__ void bmerge16p_desc(float (&v)[NV], int (&q)[NV]) {
#pragma unroll
    for (int j = 8; j > 0; j >>= 1) {
#pragma unroll
        for (int i = 0; i < 16; ++i) { const int l = i ^ j; if (l > i) CEP_D(v[OA + i], q[OA + i], v[OA + l], q[OA + l]) }
    }
}
__host__ __device__ constexpr int pair_i(int s) { return s < 16 ? 0 : s < 24 ? 1 : s < 29 ? 2 : s < 33 ? 3 : s < 36 ? 4 : s < 38 ? 5 : s < 40 ? 6 : s < 42 ? 7 : (s - 42 + 8); }
__host__ __device__ constexpr int pair_j(int s) { return s < 16 ? s : s < 24 ? s - 16 : s < 29 ? s - 24 : s < 33 ? s - 29 : s < 36 ? s - 33 : s < 38 ? s - 36 : s < 40 ? s - 38 : s < 42 ? s - 40 : 0; }
__device__ __forceinline__ void phase_topk_fast(LAS unsigned char* lds, const bf16* Q, const bf16* keysb  , int* EID, float* GATE) {
    const int tid = threadIdx.x, lane = tid & 63, wave = __builtin_amdgcn_readfirstlane(tid >> 6);
    const int c = lane & 31, hh = lane >> 5;
    for (int hi = blockIdx.x; hi < 256; hi += gridDim.x) {
        const int h = hi & 7, rank = hi >> 3;
        __syncthreads();
        for (int idx = tid; idx < 2 * 128 * 16; idx += NTHR) { const int rowi = idx >> 4, ch = idx & 15;
            const v4u kv = *(const GAS v4u*)(keysb + (size_t)h * 32768 + rowi * 128 + ch * 8);
            *(LAS v4u*)(lds + rowi * 272 + ch * 16) = kv; }
        __syncthreads();
        for (int it = 0; it < 4; ++it) {
            const int tile = rank * 8 + wave + 256 * it;
            const size_t tok0 = (size_t)tile * 32;
            float ta[16], tb[16];
#pragma unroll
            for (int p = 0; p < 2; ++p) {
                bf16x8 bq[8];
                const bf16* qrow = Q + (tok0 + c) * 2048 + h * 256 + p * 128 + 8 * hh;
#pragma unroll
                for (int ks = 0; ks < 8; ++ks) bq[ks] = *(const GAS bf16x8*)(qrow + 16 * ks);
                f32x16 acc[4];
#pragma unroll
                for (int blk = 0; blk < 4; ++blk) {
#pragma unroll
                    for (int r = 0; r < 16; ++r) acc[blk][r] = 0.f;
#pragma unroll
                    for (int ks = 0; ks < 8; ++ks) { const bf16x8 a = *(const LAS bf16x8*)(lds + (p * 128 + 32 * blk + c) * 272 + (16 * ks + 8 * hh) * 2);
                        acc[blk] = __builtin_amdgcn_mfma_f32_32x32x16_bf16(a, bq[ks], acc[blk], 0, 0, 0); }
                }
                float v[64];
#pragma unroll
                for (int blk = 0; blk < 4; ++blk)
#pragma unroll
                    for (int r = 0; r < 16; ++r)
                    { const float sv = acc[blk][r]; v[blk * 16 + r] = __uint_as_float((__float_as_uint(sv) & ~127u) | (unsigned)(32 * blk + (r & 3) + 8 * (r >> 2)) | (unsigned)(hh << 2)); }
                __builtin_amdgcn_sched_barrier(0);
                bsort16_desc<0, 64>(v); bsort16_desc<16, 64>(v); bsort16_desc<32, 64>(v); bsort16_desc<48, 64>(v);
                merge_top16<0, 16, 64>(v); merge_top16<32, 48, 64>(v); merge_top16<0, 32, 64>(v);
                float o[16];
#pragma unroll
                for (int i = 0; i < 16; ++i) o[i] = __shfl_xor(v[i], 32);
#pragma unroll
                for (int i = 0; i < 16; ++i) v[i] = fmaxf(v[i], o[15 - i]);
                bmerge16_desc<0, 64>(v);
#pragma unroll
                for (int i = 0; i < 16; ++i) { if (p == 0) ta[i] = v[i]; else tb[i] = v[i]; }
                __builtin_amdgcn_sched_barrier(0);
            }
            float av[16], bv[16]; int ai[16], bi[16];
#pragma unroll
            for (int i = 0; i < 16; ++i) { const unsigned ua = __builtin_bit_cast(unsigned, ta[i]), ub = __builtin_bit_cast(unsigned, tb[i]);
                av[i] = __builtin_bit_cast(float, ua & ~127u); ai[i] = (int)(ua & 127u); bv[i] = __builtin_bit_cast(float, ub & ~127u); bi[i] = (int)(ub & 127u); }
            float ck[32]; int cp[32];
#pragma unroll
            for (int s2 = 0; s2 < 32; ++s2) {
                const float k0 = av[pair_i(s2)] + bv[pair_j(s2)]; const int p0 = (ai[pair_i(s2)] << 7) | bi[pair_j(s2)];
                float k1 = -INFINITY; int p1 = 0;
                if (s2 + 32 < 50) { k1 = av[pair_i(s2 + 32 < 50 ? s2 + 32 : 0)] + bv[pair_j(s2 + 32 < 50 ? s2 + 32 : 0)]; p1 = (ai[pair_i(s2 + 32 < 50 ? s2 + 32 : 0)] << 7) | bi[pair_j(s2 + 32 < 50 ? s2 + 32 : 0)]; }
                ck[s2] = hh ? k1 : k0; cp[s2] = hh ? p1 : p0;
            }
            __builtin_amdgcn_sched_barrier(0);
            bsort16p_desc<0, 32>(ck, cp); bsort16p_desc<16, 32>(ck, cp);
#pragma unroll
            for (int i = 0; i < 16; ++i) { if (ck[16 + 15 - i] > ck[i]) { ck[i] = ck[16 + 15 - i]; cp[i] = cp[16 + 15 - i]; } }
            bmerge16p_desc<0, 32>(ck, cp);
            { float ok[16]; int op[16];
#pragma unroll
              for (int i = 0; i < 16; ++i) { ok[i] = __shfl_xor(ck[i], 32); op[i] = __shfl_xor(cp[i], 32); }
#pragma unroll
              for (int i = 0; i < 16; ++i) { if (ok[15 - i] > ck[i]) { ck[i] = ok[15 - i]; cp[i] = op[15 - i]; } } }
            bmerge16p_desc<0, 32>(ck, cp);
            float ex[16]; float sum = 0.f;
#pragma unroll
            for (int i = 0; i < 16; ++i) { ex[i] = __expf(ck[i] - ck[0]); sum += ex[i]; }
            const float inv = 1.f / sum;
            if (hh == 0) {
                int* eo = EID + (tok0 + c) * 128 + h * 16; float* go = GATE + (tok0 + c) * 128 + h * 16;
#pragma unroll
                for (int i = 0; i < 4; ++i) { *(GAS v4u*)(eo + 4 * i) = (v4u){(unsigned)cp[4 * i], (unsigned)cp[4 * i + 1], (unsigned)cp[4 * i + 2], (unsigned)cp[4 * i + 3]};
                    *(GAS f32x4*)(go + 4 * i) = (f32x4){ex[4 * i] * inv, ex[4 * i + 1] * inv, ex[4 * i + 2] * inv, ex[4 * i + 3] * inv}; }
            }
        }
    }
    __syncthreads();
}
template <bool FINAL>
__device__ __forceinline__ void phase_gather(const bf16* X, const int* EID, const float* GATE, const float* U, const float* V, const float* g, const float* bb, bf16* Ob, float* Of) {
    const int tid = threadIdx.x, lane = tid & 63, wave = tid >> 6;
    const int gw = blockIdx.x * NWAVES + wave, NGW = gridDim.x * NWAVES;
    for (int t = gw; t < T; t += NGW) {
        f32x4 x[4], acc[4];
#pragma unroll
        for (int j = 0; j < 4; ++j) { const v2u w = *((const GAS v2u*)(X + (size_t)t * D) + lane + 64 * j);
            x[j] = (f32x4){bflo(w.x), bfhi(w.x), bflo(w.y), bfhi(w.y)}; acc[j] = (f32x4){0.f, 0.f, 0.f, 0.f}; }
        const int e0 = EID[(size_t)t * 128 + lane], e1 = EID[(size_t)t * 128 + 64 + lane];
        const float g0 = GATE[(size_t)t * 128 + lane], g1 = GATE[(size_t)t * 128 + 64 + lane];
#pragma unroll 2
        for (int k = 0; k < 128; ++k) {
            const int e = (k < 64) ? __shfl(e0, k) : __shfl(e1, k - 64);
            const float gt = (k < 64) ? __shfl(g0, k) : __shfl(g1, k - 64);
            const GAS f32x4* ur = (const GAS f32x4*)(U + (size_t)e * D) + lane;
            float dot = 0.f;
#pragma unroll
            for (int j = 0; j < 4; ++j) { const f32x4 u = ur[64 * j]; dot += (x[j].x * u.x + x[j].y * u.y) + (x[j].z * u.z + x[j].w * u.w); }
            dot = wave_sum(dot);
            const float a = 0.5f * dot * (1.f + erff(dot * 0.70710678118654752f));
            const float cf = gt * a;
            const GAS f32x4* vr = (const GAS f32x4*)(V + (size_t)e * D) + lane;
#pragma unroll
            for (int j = 0; j < 4; ++j) { const f32x4 v = vr[64 * j]; acc[j] += cf * v; }
        }
        float s = 0.f;
#pragma unroll
        for (int j = 0; j < 4; ++j) { acc[j] = ALPHA * x[j] + acc[j]; s += (acc[j].x + acc[j].y) + (acc[j].z + acc[j].w); }
        const float mean = wave_sum(s) * (1.f / D); float s2 = 0.f;
#pragma unroll
        for (int j = 0; j < 4; ++j) { acc[j] = acc[j] - mean; s2 += (acc[j].x * acc[j].x + acc[j].y * acc[j].y) + (acc[j].z * acc[j].z + acc[j].w * acc[j].w); }
        const float rstd = 1.f / sqrtf(wave_sum(s2) * (1.f / D) + LN_EPS);
#pragma unroll
        for (int j = 0; j < 4; ++j) { const f32x4 gg = *((const GAS f32x4*)g + lane + 64 * j), b4 = *((const GAS f32x4*)bb + lane + 64 * j);
            const f32x4 o = acc[j] * rstd * gg + b4;
            if (FINAL) *((GAS f32x4*)(Of + (size_t)t * D) + lane + 64 * j) = o;
            else { v2u w; w.x = pk2(o.x, o.y); w.y = pk2(o.z, o.w); *((GAS v2u*)(Ob + (size_t)t * D) + lane + 64 * j) = w; } }
    }
}

typedef float f32x2 __attribute__((ext_vector_type(2)));
__device__ __forceinline__ void phase_convert_tables(const float* U, const float* V, unsigned char* ws) {
    const int tid = threadIdx.x, lane = tid & 63, wave = tid >> 6;
    const int gw = blockIdx.x * NWAVES + wave, NGW = gridDim.x * NWAVES;
    for (int row = gw; row < 4 * NEXP; row += NGW) {
        const bool isv = row >= 2 * NEXP; const int r = row & (2 * NEXP - 1);
        const GAS f32x4* src = (const GAS f32x4*)((isv ? V : U) + (size_t)r * D) + lane;
        f32x4 v[4]; float m = 0.f;
#pragma unroll
        for (int j = 0; j < 4; ++j) { v[j] = src[64 * j]; m = fmaxf(fmaxf(m, fmaxf(fabsf(v[j].x), fabsf(v[j].y))), fmaxf(fabsf(v[j].z), fabsf(v[j].w))); }
#pragma unroll
        for (int o = 1; o < 64; o <<= 1) m = fmaxf(m, __shfl_xor(m, o));
        m = fmaxf(m, 1e-30f);
        const float sc = 400.f / m;
        v4u w;
        { int t0 = __builtin_amdgcn_cvt_pk_fp8_f32(v[0].x * sc, v[0].y * sc, 0, false); t0 = __builtin_amdgcn_cvt_pk_fp8_f32(v[0].z * sc, v[0].w * sc, t0, true); w.x = (unsigned)t0; }
        { int t0 = __builtin_amdgcn_cvt_pk_fp8_f32(v[1].x * sc, v[1].y * sc, 0, false); t0 = __builtin_amdgcn_cvt_pk_fp8_f32(v[1].z * sc, v[1].w * sc, t0, true); w.y = (unsigned)t0; }
        { int t0 = __builtin_amdgcn_cvt_pk_fp8_f32(v[2].x * sc, v[2].y * sc, 0, false); t0 = __builtin_amdgcn_cvt_pk_fp8_f32(v[2].z * sc, v[2].w * sc, t0, true); w.z = (unsigned)t0; }
        { int t0 = __builtin_amdgcn_cvt_pk_fp8_f32(v[3].x * sc, v[3].y * sc, 0, false); t0 = __builtin_amdgcn_cvt_pk_fp8_f32(v[3].z * sc, v[3].w * sc, t0, true); w.w = (unsigned)t0; }
        *((GAS v4u*)(ws + (isv ? WS_V8 : WS_U8) + (size_t)r * 1024) + lane) = w;
        if (lane == 0) ((float*)(ws + (isv ? WS_DQV : WS_DQU)))[r] = m * (1.f / 400.f);
    }
}
__host__ __device__ constexpr int rev4(int i) { return ((i & 1) << 3) | ((i & 2) << 1) | ((i & 4) >> 1) | ((i & 8) >> 3); }
#define FMA2(a, b, c) __builtin_elementwise_fma((a), (b), (c))
#define CVT8(w, hi) __builtin_amdgcn_cvt_pk_f32_fp8((int)(w), (hi))
template <bool FINAL>
__device__ __forceinline__ void phase_gather8(const bf16* X, const int* EID, const float* GATE, const unsigned char* U8, const unsigned char* V8, const float* DQU, const float* DQV,
                                              const float* g, const float* bb, bf16* Ob, float* Of) {
    const int tid = threadIdx.x, lane = tid & 63, wave = tid >> 6;
    const int gw = blockIdx.x * NWAVES + wave, NGW = gridDim.x * NWAVES;
    const bool b0 = (lane & 1) != 0, b1 = (lane & 2) != 0, b2 = (lane & 4) != 0, b3 = (lane & 8) != 0; const int myrow = lane >> 4;
    for (int t = gw; t < T; t += NGW) {
        f32x2 x[8];
#pragma unroll
        for (int j = 0; j < 4; ++j) { const v2u w = *((const GAS v2u*)(X + (size_t)t * D) + lane + 64 * j);
            x[2 * j] = (f32x2){bflo(w.x), bfhi(w.x)}; x[2 * j + 1] = (f32x2){bflo(w.y), bfhi(w.y)}; }
        const int e0 = EID[(size_t)t * 128 + lane], e1 = EID[(size_t)t * 128 + 64 + lane];
        const float gt0 = GATE[(size_t)t * 128 + lane], gt1 = GATE[(size_t)t * 128 + 64 + lane];
        const float dqu0 = DQU[e0], dqu1 = DQU[e1], dqv0 = DQV[e0], dqv1 = DQV[e1];
        float act0 = 0.f, act1 = 0.f;
#pragma unroll
        for (int r = 0; r < 2; ++r) {
            const int er = r ? e1 : e0;
            for (int row = 0; row < 4; ++row) {
                v4u w[16];
#pragma unroll
                for (int i = 0; i < 16; ++i) { const int e = __builtin_amdgcn_readlane(er, row * 16 + rev4(i)); w[i] = *((const GAS v4u*)(U8 + (size_t)e * 1024) + lane); }
                float p[16];
#pragma unroll
                for (int i = 0; i < 16; ++i) { f32x2 a = (f32x2){0.f, 0.f};
                    a = FMA2(x[0], CVT8(w[i].x, false), a); a = FMA2(x[1], CVT8(w[i].x, true), a);
                    a = FMA2(x[2], CVT8(w[i].y, false), a); a = FMA2(x[3], CVT8(w[i].y, true), a);
                    a = FMA2(x[4], CVT8(w[i].z, false), a); a = FMA2(x[5], CVT8(w[i].z, true), a);
                    a = FMA2(x[6], CVT8(w[i].w, false), a); a = FMA2(x[7], CVT8(w[i].w, true), a);
                    p[i] = a.x + a.y; }
                float r8[8], r4[4], r2[2];
#pragma unroll
                for (int i = 0; i < 8; ++i) { const float keep = b0 ? p[8 + i] : p[i], send = b0 ? p[i] : p[8 + i]; r8[i] = keep + __shfl_xor(send, 1); }
#pragma unroll
                for (int i = 0; i < 4; ++i) { const float keep = b1 ? r8[4 + i] : r8[i], send = b1 ? r8[i] : r8[4 + i]; r4[i] = keep + __shfl_xor(send, 2); }
#pragma unroll
                for (int i = 0; i < 2; ++i) { const float keep = b2 ? r4[2 + i] : r4[i], send = b2 ? r4[i] : r4[2 + i]; r2[i] = keep + __shfl_xor(send, 4); }
                float r1 = (b3 ? r2[1] : r2[0]) + __shfl_xor(b3 ? r2[0] : r2[1], 8);
                r1 += __shfl_xor(r1, 16); r1 += __shfl_xor(r1, 32);
                if (myrow == row) { if (r == 0) act0 = r1; else act1 = r1; }
            }
        }
        float c0, c1;
        { const float a0 = act0 * dqu0, a1 = act1 * dqu1;
          c0 = gt0 * (0.5f * a0 * (1.f + erff(a0 * 0.70710678118654752f))) * dqv0;
          c1 = gt1 * (0.5f * a1 * (1.f + erff(a1 * 0.70710678118654752f))) * dqv1; }
        f32x2 acc[8];
#pragma unroll
        for (int j = 0; j < 8; ++j) acc[j] = (f32x2){0.f, 0.f};
#pragma unroll
        for (int r = 0; r < 2; ++r) {
            const int er = r ? e1 : e0; const int cr = __builtin_bit_cast(int, r ? c1 : c0);
            for (int row = 0; row < 4; ++row) {
                v4u w[16];
#pragma unroll
                for (int i = 0; i < 16; ++i) { const int e = __builtin_amdgcn_readlane(er, row * 16 + i); w[i] = *((const GAS v4u*)(V8 + (size_t)e * 1024) + lane); }
#pragma unroll
                for (int i = 0; i < 16; ++i) { const float cf = __builtin_bit_cast(float, __builtin_amdgcn_readlane(cr, row * 16 + i)); const f32x2 c2 = (f32x2){cf, cf};
                    acc[0] = FMA2(c2, CVT8(w[i].x, false), acc[0]); acc[1] = FMA2(c2, CVT8(w[i].x, true), acc[1]);
                    acc[2] = FMA2(c2, CVT8(w[i].y, false), acc[2]); acc[3] = FMA2(c2, CVT8(w[i].y, true), acc[3]);
                    acc[4] = FMA2(c2, CVT8(w[i].z, false), acc[4]); acc[5] = FMA2(c2, CVT8(w[i].z, true), acc[5]);
                    acc[6] = FMA2(c2, CVT8(w[i].w, false), acc[6]); acc[7] = FMA2(c2, CVT8(w[i].w, true), acc[7]); }
            }
        }
        float s = 0.f;
#pragma unroll
        for (int j = 0; j < 8; ++j) { acc[j] = x[j] * ALPHA + acc[j]; s += acc[j].x + acc[j].y; }
        const float mean = wave_sum(s) * (1.f / D); float s2 = 0.f;
#pragma unroll
        for (int j = 0; j < 8; ++j) { acc[j] = acc[j] - mean; s2 += acc[j].x * acc[j].x + acc[j].y * acc[j].y; }
        const float rstd = 1.f / sqrtf(wave_sum(s2) * (1.f / D) + LN_EPS);
#pragma unroll
        for (int j = 0; j < 4; ++j) { const f32x4 gg = *((const GAS f32x4*)g + lane + 64 * j), b4 = *((const GAS f32x4*)bb + lane + 64 * j);
            const f32x4 o = (f32x4){acc[2 * j].x, acc[2 * j].y, acc[2 * j + 1].x, acc[2 * j + 1].y} * rstd * gg + b4;
            if (FINAL) *((GAS f32x4*)(Of + (size_t)t * D) + lane + 64 * j) = o;
            else { v2u w; w.x = pk2(o.x, o.y); w.y = pk2(o.z, o.w); *((GAS v2u*)(Ob + (size_t)t * D) + lane + 64 * j) = w; } }
    }
}
__device__ __forceinline__ void phase_hgrn(LAS unsigned char* lds, unsigned char* ws) {
    const int tid = threadIdx.x;
    const bf16* CQ = (const bf16*)(ws + WS_CQ); const bf16* CK = (const bf16*)(ws + WS_CK); const bf16* CV = (const bf16*)(ws + WS_CV); bf16* O = (bf16*)(ws + WS_O);
    LAS float* fL = (LAS float*)lds;
    LAS float* kL = fL + 4096; LAS float* qL = kL + 4096;
    LAS float* vL = qL + 4096;
    LAS float* part = vL + 1024;
    for (int item = blockIdx.x; item < 256; item += gridDim.x) {
        const int es = item & 3, h = (item >> 2) & 7, b = item >> 5;
        const int e = tid & 31, dg = tid >> 5;
        float S[8];
#pragma unroll
        for (int j = 0; j < 8; ++j) S[j] = 0.f;
        for (int blk = 0; blk < SEQ / 32; ++blk) {
            const size_t t0 = (size_t)b * SEQ + blk * 32;
            for (int idx = tid; idx < 4096; idx += NTHR) { const int s = idx >> 7, d = idx & 127; const size_t o = (t0 + s) * D + h * 128 + d;
                const float kk = bf2f(CK[o]); kL[idx] = kk; fL[idx] = 1.f - kk; qL[idx] = bf2f(CQ[o]); }
            for (int idx = tid; idx < 1024; idx += NTHR) { const int s = idx >> 5, ee = idx & 31; vL[idx] = bf2f(CV[(t0 + s) * D + h * 128 + es * 32 + ee]); }
            __syncthreads();
            for (int s = 0; s < 32; ++s) { const float v = vL[s * 32 + e]; float po = 0.f;
#pragma unroll
                for (int j = 0; j < 8; ++j) { const int d = dg * 8 + j; S[j] = fL[s * 128 + d] * S[j] + kL[s * 128 + d] * v; po += qL[s * 128 + d] * S[j]; }
                part[(s * 16 + dg) * 32 + e] = po; }
            __syncthreads();
            for (int idx = tid; idx < 1024; idx += NTHR) { const int s = idx >> 5, ee = idx & 31; float o = 0.f;
#pragma unroll
                for (int g = 0; g < 16; ++g) o += part[(s * 16 + g) * 32 + ee];
                O[(t0 + s) * D + h * 128 + es * 32 + ee] = (bf16)f2bf(o); }
            __syncthreads();
        }
    }
}

__device__ __forceinline__ void phase_hgrn_prep(unsigned char* ws, float* scratch  ) {
    const int tid = threadIdx.x, lane = tid & 63, wave = tid >> 6;
    const int gw = blockIdx.x * NWAVES + wave, NGW = gridDim.x * NWAVES;
    bf16* CQ = (bf16*)(ws + WS_CQ); bf16* CK = (bf16*)(ws + WS_CK); const bf16* CV = (const bf16*)(ws + WS_CV);
    bf16* KOT = (bf16*)scratch; bf16* VT = (bf16*)scratch + (size_t)T * D; float* DEC = (float*)(ws + WS_DEC);
    for (int item = gw; item < 1024 * 8; item += NGW) {
        const int g = item >> 3, h = item & 7; const size_t t0 = (size_t)g * 32;
        float k0[32], k1[32], b0[32], b1[32]; float c0 = 0.f, c1 = 0.f;
#pragma unroll
        for (int s2 = 0; s2 < 32; ++s2) { const size_t o = (t0 + s2) * D + h * 128 + 2 * lane;
            const unsigned kw = *(const GAS unsigned*)(CK + o), qw = *(const GAS unsigned*)(CQ + o);
            const float ka = bflo(kw), kb = bfhi(kw);
            c0 += __logf(1.f - ka); c1 += __logf(1.f - kb);
            k0[s2] = ka; k1[s2] = kb; b0[s2] = c0; b1[s2] = c1;
            *(GAS unsigned*)(CQ + o) = pk2(bflo(qw) * __expf(c0), bfhi(qw) * __expf(c1));
            *(GAS unsigned*)(CK + o) = pk2(ka * __expf(-c0), kb * __expf(-c1)); }
        { GAS v4u* r0 = (GAS v4u*)(KOT + ((size_t)g * 1024 + h * 128 + 2 * lane) * 32);
#pragma unroll
          for (int j = 0; j < 4; ++j) { v4u w;
              w.x = pk2(k0[8 * j + 0] * __expf(c0 - b0[8 * j + 0]), k0[8 * j + 1] * __expf(c0 - b0[8 * j + 1])); w.y = pk2(k0[8 * j + 2] * __expf(c0 - b0[8 * j + 2]), k0[8 * j + 3] * __expf(c0 - b0[8 * j + 3]));
              w.z = pk2(k0[8 * j + 4] * __expf(c0 - b0[8 * j + 4]), k0[8 * j + 5] * __expf(c0 - b0[8 * j + 5])); w.w = pk2(k0[8 * j + 6] * __expf(c0 - b0[8 * j + 6]), k0[8 * j + 7] * __expf(c0 - b0[8 * j + 7]));
              r0[j] = w; }
#pragma unroll
          for (int j = 0; j < 4; ++j) { v4u w;
              w.x = pk2(k1[8 * j + 0] * __expf(c1 - b1[8 * j + 0]), k1[8 * j + 1] * __expf(c1 - b1[8 * j + 1])); w.y = pk2(k1[8 * j + 2] * __expf(c1 - b1[8 * j + 2]), k1[8 * j + 3] * __expf(c1 - b1[8 * j + 3]));
              w.z = pk2(k1[8 * j + 4] * __expf(c1 - b1[8 * j + 4]), k1[8 * j + 5] * __expf(c1 - b1[8 * j + 5])); w.w = pk2(k1[8 * j + 6] * __expf(c1 - b1[8 * j + 6]), k1[8 * j + 7] * __expf(c1 - b1[8 * j + 7]));
              r0[4 + j] = w; } }
        *(GAS v2u*)(DEC + (size_t)g * 1024 + h * 128 + 2 * lane) = (v2u){__float_as_uint(__expf(c0)), __float_as_uint(__expf(c1))};
        { unsigned va[16], vb[16];
#pragma unroll
          for (int j = 0; j < 16; ++j) { const unsigned w0 = *(const GAS unsigned*)(CV + (t0 + 2 * j) * D + h * 128 + 2 * lane), w1 = *(const GAS unsigned*)(CV + (t0 + 2 * j + 1) * D + h * 128 + 2 * lane);
              va[j] = (w0 & 0xffffu) | (w1 << 16); vb[j] = (w0 >> 16) | (w1 & 0xffff0000u); }
          GAS v4u* r0 = (GAS v4u*)(VT + ((size_t)g * 1024 + h * 128 + 2 * lane) * 32);
#pragma unroll
          for (int j = 0; j < 4; ++j) { r0[j] = (v4u){va[4 * j], va[4 * j + 1], va[4 * j + 2], va[4 * j + 3]}; r0[4 + j] = (v4u){vb[4 * j], vb[4 * j + 1], vb[4 * j + 2], vb[4 * j + 3]}; } }
    }
}
__device__ __forceinline__ void phase_hgrn_scan(LAS unsigned char* lds, unsigned char* ws, const float* scratch) {
    const int tid = threadIdx.x, lane = tid & 63, wave = __builtin_amdgcn_readfirstlane(tid >> 6);
    const int c = lane & 31, hh = lane >> 5;
    const bf16* QI = (const bf16*)(ws + WS_CQ); const bf16* KI = (const bf16*)(ws + WS_CK);
    const bf16* KOT = (const bf16*)scratch; const bf16* VT = (const bf16*)scratch + (size_t)T * D; const float* DEC = (const float*)(ws + WS_DEC);
    bf16* O = (bf16*)(ws + WS_O);
    constexpr int BUF = 30720, O_KI = 0, O_QI = 8704, O_KOT = 17408, O_VT = 27648, O_DEC = 30208, O_ST = 61440, O_P = 70144;
    for (int item = blockIdx.x; item < 256; item += gridDim.x) {
        const int es = item & 3, h = (item >> 2) & 7, b = item >> 5;
        __syncthreads();
        for (int i = tid; i < 8704 / 16; i += NTHR) *(LAS v4u*)(lds + O_ST + i * 16) = (v4u){0u, 0u, 0u, 0u};
        f32x16 S[4];
#pragma unroll
        for (int blk = 0; blk < 4; ++blk)
#pragma unroll
            for (int r = 0; r < 16; ++r) S[blk][r] = 0.f;
        v4u rk, rq, ro, rx;
        auto load_chunk = [&](int n) {
            const size_t gch = (size_t)b * 128 + n, t0 = gch * 32;
            rk = *(const GAS v4u*)(KI + (t0 + (tid >> 4)) * D + h * 128 + 8 * (tid & 15));
            rq = *(const GAS v4u*)(QI + (t0 + (tid >> 4)) * D + h * 128 + 8 * (tid & 15));
            ro = *(const GAS v4u*)(KOT + (gch * 1024 + h * 128 + (tid >> 2)) * 32 + 8 * (tid & 3));
            if (tid < 128) rx = *(const GAS v4u*)(VT + (gch * 1024 + h * 128 + es * 32 + (tid >> 2)) * 32 + 8 * (tid & 3));
            else if (tid < 160) rx = *(const GAS v4u*)(DEC + gch * 1024 + h * 128 + 4 * (tid - 128));
        };
        auto store_chunk = [&](int bufi) {
            LAS unsigned char* bp = lds + bufi * BUF;
            *(LAS v4u*)(bp + O_KI + (tid >> 4) * 272 + (tid & 15) * 16) = rk;
            *(LAS v4u*)(bp + O_QI + (tid >> 4) * 272 + (tid & 15) * 16) = rq;
            *(LAS v4u*)(bp + O_KOT + (tid >> 2) * 80 + (tid & 3) * 16) = ro;
            if (tid < 128) *(LAS v4u*)(bp + O_VT + (tid >> 2) * 80 + (tid & 3) * 16) = rx;
            else if (tid < 160) *(LAS v4u*)(bp + O_DEC + (tid - 128) * 16) = rx;
        };
        load_chunk(0); store_chunk(0); load_chunk(1);
        __syncthreads();
        for (int n = 0; n < 128; ++n) {
            if (n + 1 < 128) store_chunk((n + 1) & 1);
            if (n + 2 < 128) load_chunk(n + 2);
            if (wave == 0) {
                LAS unsigned char* bp = lds + (n & 1) * BUF;
                const size_t t0 = ((size_t)b * 128 + n) * 32;
                bf16x8 qf[8];
                f32x16 sc;
#pragma unroll
                for (int r = 0; r < 16; ++r) sc[r] = 0.f;
#pragma unroll
                for (int ks = 0; ks < 8; ++ks) { const bf16x8 kf = *(const LAS bf16x8*)(bp + O_KI + c * 272 + (16 * ks + 8 * hh) * 2);
                    qf[ks] = *(const LAS bf16x8*)(bp + O_QI + c * 272 + (16 * ks + 8 * hh) * 2);
                    sc = __builtin_amdgcn_mfma_f32_32x32x16_bf16(kf, qf[ks], sc, 0, 0, 0); }
#pragma unroll
                for (int g4 = 0; g4 < 4; ++g4) { float m[4];
#pragma unroll
                    for (int q = 0; q < 4; ++q) { const float sv = sc[4 * g4 + q]; m[q] = (8 * g4 + 4 * hh + q <= c) ? sv : 0.f; }
                    *(LAS v2u*)(lds + O_P + c * 80 + (8 * g4 + 4 * hh) * 2) = (v2u){pk2(m[0], m[1]), pk2(m[2], m[3])}; }
                bf16x8 vf[2];
                f32x16 o;
#pragma unroll
                for (int r = 0; r < 16; ++r) o[r] = 0.f;
#pragma unroll
                for (int ks = 0; ks < 2; ++ks) { const bf16x8 pf = *(const LAS bf16x8*)(lds + O_P + c * 80 + (16 * ks + 8 * hh) * 2);
                    vf[ks] = *(const LAS bf16x8*)(bp + O_VT + c * 80 + (16 * ks + 8 * hh) * 2);
                    o = __builtin_amdgcn_mfma_f32_32x32x16_bf16(pf, vf[ks], o, 0, 0, 0); }
#pragma unroll
                for (int ks = 0; ks < 8; ++ks) { const bf16x8 sf = *(const LAS bf16x8*)(lds + O_ST + c * 272 + (16 * ks + 8 * hh) * 2);
                    o = __builtin_amdgcn_mfma_f32_32x32x16_bf16(qf[ks], sf, o, 0, 0, 0); }
#pragma unroll
                for (int r = 0; r < 16; ++r) { const float ov = o[r]; O[(t0 + (r & 3) + 8 * (r >> 2) + 4 * hh) * D + h * 128 + es * 32 + c] = (bf16)f2bf(ov); }
#pragma unroll
                for (int blk = 0; blk < 4; ++blk) {
#pragma unroll
                    for (int g4 = 0; g4 < 4; ++g4) { const f32x4 dv = *(const LAS f32x4*)(bp + O_DEC + (32 * blk + 8 * g4 + 4 * hh) * 4);
                        S[blk][4 * g4 + 0] *= dv.x; S[blk][4 * g4 + 1] *= dv.y; S[blk][4 * g4 + 2] *= dv.z; S[blk][4 * g4 + 3] *= dv.w; }
#pragma unroll
                    for (int ks = 0; ks < 2; ++ks) { const bf16x8 af = *(const LAS bf16x8*)(bp + O_KOT + (32 * blk + c) * 80 + (16 * ks + 8 * hh) * 2);
                        S[blk] = __builtin_amdgcn_mfma_f32_32x32x16_bf16(af, vf[ks], S[blk], 0, 0, 0); }
#pragma unroll
                    for (int g4 = 0; g4 < 4; ++g4) { const float s0 = S[blk][4 * g4 + 0], s1 = S[blk][4 * g4 + 1], s2 = S[blk][4 * g4 + 2], s3 = S[blk][4 * g4 + 3];
                        *(LAS v2u*)(lds + O_ST + c * 272 + (32 * blk + 8 * g4 + 4 * hh) * 2) = (v2u){pk2(s0, s1), pk2(s2, s3)}; }
                }
            }
            __syncthreads();
        }
    }
}
__device__ __forceinline__ void phase_hgrn_norm(const float* norm_g, unsigned char* ws) {
    const int tid = threadIdx.x, lane = tid & 63, wave = tid >> 6;
    const int gw = blockIdx.x * NWAVES + wave, NGW = gridDim.x * NWAVES;
    const bf16* O = (const bf16*)(ws + WS_O); const bf16* CG = (const bf16*)(ws + WS_CG); bf16* Y2 = (bf16*)(ws + WS_Y2);
    for (int t = gw; t < T; t += NGW) {
        const v4u a0 = *((const GAS v4u*)(O + (size_t)t * D) + lane * 2), a1 = *((const GAS v4u*)(O + (size_t)t * D) + lane * 2 + 1);
        const v4u g0 = *((const GAS v4u*)(CG + (size_t)t * D) + lane * 2), g1 = *((const GAS v4u*)(CG + (size_t)t * D) + lane * 2 + 1);
        float o[16], gv[16];
        o[0] = bflo(a0.x); o[1] = bfhi(a0.x); o[2] = bflo(a0.y); o[3] = bfhi(a0.y); o[4] = bflo(a0.z); o[5] = bfhi(a0.z); o[6] = bflo(a0.w); o[7] = bfhi(a0.w);
        o[8] = bflo(a1.x); o[9] = bfhi(a1.x); o[10] = bflo(a1.y); o[11] = bfhi(a1.y); o[12] = bflo(a1.z); o[13] = bfhi(a1.z); o[14] = bflo(a1.w); o[15] = bfhi(a1.w);
        gv[0] = bflo(g0.x); gv[1] = bfhi(g0.x); gv[2] = bflo(g0.y); gv[3] = bfhi(g0.y); gv[4] = bflo(g0.z); gv[5] = bfhi(g0.z); gv[6] = bflo(g0.w); gv[7] = bfhi(g0.w);
        gv[8] = bflo(g1.x); gv[9] = bfhi(g1.x); gv[10] = bflo(g1.y); gv[11] = bfhi(g1.y); gv[12] = bflo(g1.z); gv[13] = bfhi(g1.z); gv[14] = bflo(g1.w); gv[15] = bfhi(g1.w);
        float sq = 0.f;
#pragma unroll
        for (int j = 0; j < 16; ++j) sq += o[j] * o[j];
        sq += __shfl_xor(sq, 1); sq += __shfl_xor(sq, 2); sq += __shfl_xor(sq, 4);
        const float r = 1.f / sqrtf(sq * (1.f / 128.f) + LN_EPS);
        float y[16];
#pragma unroll
        for (int j = 0; j < 16; ++j) { const float sg = gv[j] / (1.f + expf(-gv[j])); y[j] = o[j] * r * norm_g[lane * 16 + j] * sg; }
        v4u w0, w1; w0.x = pk2(y[0], y[1]); w0.y = pk2(y[2], y[3]); w0.z = pk2(y[4], y[5]); w0.w = pk2(y[6], y[7]);
        w1.x = pk2(y[8], y[9]); w1.y = pk2(y[10], y[11]); w1.z = pk2(y[12], y[13]); w1.w = pk2(y[14], y[15]);
        *((GAS v4u*)(Y2 + (size_t)t * D) + lane * 2) = w0; *((GAS v4u*)(Y2 + (size_t)t * D) + lane * 2 + 1) = w1;
    }
}

struct Args { const float* in[16]; float* out; unsigned char* ws; int ph_lo, ph_hi, li, pad; };
__global__ void __launch_bounds__(NTHR, 2) mk_fwd(Args args) {
    extern __shared__ __attribute__((aligned(16))) unsigned char lds_raw[];
    LAS unsigned char* lds = (LAS unsigned char*)lds_raw;
    volatile LAS unsigned* MISC = (volatile LAS unsigned*)(lds + MISC_OFF);
    const int tid = threadIdx.x;
    unsigned char* ws = args.ws;
    gu32* ctl = (gu32*)(ws + WS_CTL);
    if (tid < 32) ((LAS unsigned*)(lds + MISC_OFF))[tid] = 0u;
    __syncthreads();
    XcdBarrier bar; bar.bar = (unsigned*)ctl + CW_BAR; bar.x = 0; bar.st = nullptr;
    if (N_LAUNCHES == 1) bar = xcd_barrier_post((unsigned*)ctl + CW_BAR, MISC + 8);
    const int lo = args.ph_lo, hi = args.ph_hi;
#define IN(k) (lo <= (k) && (k) < hi)
#define SEAM(k) do { if (IN(k) && IN((k) + 1)) xcd_barrier(bar); } while (0)
    const float* const* in = args.in;
    bf16* XB = (bf16*)(ws + WS_XB); bf16* H0 = (bf16*)(ws + WS_H0); bf16* Y = (bf16*)(ws + WS_Y); bf16* H1 = (bf16*)(ws + WS_H1);
    int* EID = (int*)(ws + WS_EID); float* GATE = (float*)(ws + WS_GATE);
    float* Z = args.out;

    if (IN(0)) for (int rep_ = 0; rep_ < 1 + (int)((DUP_MASK >> 0) & 1u); ++rep_) { phase_prologue(lds, in, ws); phase_convert_tables(in[12], in[13], ws); } SEAM(0);
    if (IN(1)) for (int rep_ = 0; rep_ < 1 + (int)((DUP_MASK >> 1) & 1u); ++rep_) { pg8::Gemm g{XB, (const bf16*)(ws + WS_WABIN), T, AB_IN, D}; pg8::StaticOrder S; S.init(T, AB_IN, (int)gridDim.x, (int)blockIdx.x); pg8::EpiBf16<0> E{H0, AB_IN, nullptr, 0, 0, 1.f};
                 pg8::gemm_phase<pg8::EpiBf16<0>, pg8::StaticOrder, true, true>(lds, g, S, E); } SEAM(1);
    if (IN(2)) for (int rep_ = 0; rep_ < 1 + (int)((DUP_MASK >> 2) & 1u); ++rep_) { phase_ret_local(lds, ws); } SEAM(2);
    if (IN(3)) for (int rep_ = 0; rep_ < 1 + (int)((DUP_MASK >> 3) & 1u); ++rep_) { phase_ret_prefix(ws); } SEAM(3);
    if (IN(4)) for (int rep_ = 0; rep_ < 1 + (int)((DUP_MASK >> 4) & 1u); ++rep_) { phase_ret_out_pool_fast(lds, in, ws); } SEAM(4);
    if (IN(5)) for (int rep_ = 0; rep_ < 1 + (int)((DUP_MASK >> 5) & 1u); ++rep_) { pg8::Gemm g{Y, (const bf16*)(ws + WS_WABOUT), T, D, D}; pg8::StaticOrder S; S.init(T, D, (int)gridDim.x, (int)blockIdx.x); pg8::EpiResidF32 E{XB, Z};
                 pg8::gemm_phase<pg8::EpiResidF32, pg8::StaticOrder, true, true>(lds, g, S, E); } SEAM(5);
    if (IN(6)) for (int rep_ = 0; rep_ < 1 + (int)((DUP_MASK >> 6) & 1u); ++rep_) { phase_ln(Z, H1, in[14], in[15]); } SEAM(6);
    if (IN(7)) for (int rep_ = 0; rep_ < 1 + (int)((DUP_MASK >> 7) & 1u); ++rep_) { pg8::Gemm g{H1, (const bf16*)(ws + WS_WQ), T, 2048, D}; pg8::StaticOrder S; S.init(T, 2048, (int)gridDim.x, (int)blockIdx.x); pg8::EpiBf16<0> E{H0  , 2048, nullptr, 0, 0, 1.f};
                 pg8::gemm_phase<pg8::EpiBf16<0>, pg8::StaticOrder, true, true>(lds, g, S, E); } SEAM(7);
    if (IN(8)) for (int rep_ = 0; rep_ < 1 + (int)((DUP_MASK >> 8) & 1u); ++rep_) { phase_topk_fast(lds, H0, (const bf16*)(ws + WS_KEYS), EID, GATE); } SEAM(8);
    if (IN(9)) for (int rep_ = 0; rep_ < 1 + (int)((DUP_MASK >> 9) & 1u); ++rep_) { phase_gather8<false>(H1, EID, GATE, ws + WS_U8, ws + WS_V8, (const float*)(ws + WS_DQU), (const float*)(ws + WS_DQV), in[14] + D, in[15] + D, XB  , nullptr); } SEAM(9);
    if (IN(10)) for (int rep_ = 0; rep_ < 1 + (int)((DUP_MASK >> 10) & 1u); ++rep_) { EpiCIn E{(bf16*)(ws + WS_CQ), (bf16*)(ws + WS_CK), (bf16*)(ws + WS_CV), (bf16*)(ws + WS_CG), (const float*)(ws + WS_LB)};
                  (void)E; pg8::Gemm g{XB, (const bf16*)(ws + WS_WCIN), T, C_IN, D}; pg8::StaticOrder S; S.init(T, C_IN, (int)gridDim.x, (int)blockIdx.x);
                  pg8::EpiCInF E2{(bf16*)(ws + WS_CQ), (bf16*)(ws + WS_CK), (bf16*)(ws + WS_CV), (bf16*)(ws + WS_CG), (const float*)(ws + WS_LB)};
                  pg8::gemm_phase<pg8::EpiCInF, pg8::StaticOrder, true, true>(lds, g, S, E2); } SEAM(10);
    if (IN(11)) for (int rep_ = 0; rep_ < 1 + (int)((DUP_MASK >> 11) & 1u); ++rep_) { phase_hgrn_prep(ws, args.out); } SEAM(11);
    if (IN(12)) for (int rep_ = 0; rep_ < 1 + (int)((DUP_MASK >> 12) & 1u); ++rep_) { phase_hgrn_scan(lds, ws, args.out); } SEAM(12);
    if (IN(13)) for (int rep_ = 0; rep_ < 1 + (int)((DUP_MASK >> 13) & 1u); ++rep_) { phase_hgrn_norm(in[8], ws); } SEAM(13);
    if (IN(14)) for (int rep_ = 0; rep_ < 1 + (int)((DUP_MASK >> 14) & 1u); ++rep_) { pg8::Gemm g{(const bf16*)(ws + WS_Y2), (const bf16*)(ws + WS_WCOUT), T, D, D}; pg8::StaticOrder S; S.init(T, D, (int)gridDim.x, (int)blockIdx.x); pg8::EpiResidF32 E{XB, Z};
                  pg8::gemm_phase<pg8::EpiResidF32, pg8::StaticOrder, true, true>(lds, g, S, E); } SEAM(14);
    if (IN(15)) for (int rep_ = 0; rep_ < 1 + (int)((DUP_MASK >> 15) & 1u); ++rep_) { phase_ln(Z, H1  , in[14] + 2 * D, in[15] + 2 * D); } SEAM(15);
    if (IN(16)) for (int rep_ = 0; rep_ < 1 + (int)((DUP_MASK >> 16) & 1u); ++rep_) { pg8::Gemm g{H1, (const bf16*)(ws + WS_WQ) + (size_t)2048 * D, T, 2048, D}; pg8::StaticOrder S; S.init(T, 2048, (int)gridDim.x, (int)blockIdx.x); pg8::EpiBf16<0> E{(bf16*)(ws + WS_Q1), 2048, nullptr, 0, 0, 1.f};
                  pg8::gemm_phase<pg8::EpiBf16<0>, pg8::StaticOrder, true, true>(lds, g, S, E); } SEAM(16);
    if (IN(17)) for (int rep_ = 0; rep_ < 1 + (int)((DUP_MASK >> 17) & 1u); ++rep_) { phase_topk_fast(lds, (const bf16*)(ws + WS_Q1), (const bf16*)(ws + WS_KEYS) + (size_t)8 * 2 * 128 * 128, EID, GATE); } SEAM(17);
    if (IN(18)) for (int rep_ = 0; rep_ < 1 + (int)((DUP_MASK >> 18) & 1u); ++rep_) { phase_gather8<true>(H1, EID, GATE, ws + WS_U8 + (size_t)NEXP * 1024, ws + WS_V8 + (size_t)NEXP * 1024, (const float*)(ws + WS_DQU) + NEXP, (const float*)(ws + WS_DQV) + NEXP, in[14] + 3 * D, in[15] + 3 * D, nullptr, args.out); }
#undef IN
#undef SEAM
}

extern "C" void kernel_launch(void* const* d_in, const int* in_sizes, int n_in, void* d_out, int out_size, void* d_ws, size_t ws_size, hipStream_t stream) {
    static int grid = 0;
    if (grid == 0) {
        if (n_in != 16 || in_sizes[0] != T * D || out_size != T * D || ws_size < WS_END) { fprintf(stderr, "kernel_launch: unexpected problem (n_in %d, in0 %d, out %d, ws %zu); nothing launched\n", n_in, n_in > 0 ? in_sizes[0] : -1, out_size, ws_size); grid = -1; return; }
        int dev = 0, cus = 0;
        if (hipGetDevice(&dev) != hipSuccess || hipDeviceGetAttribute(&cus, hipDeviceAttributeMultiprocessorCount, dev) != hipSuccess) { grid = -1; return; }
        if (hipFuncSetAttribute((const void*)mk_fwd, hipFuncAttributeMaxDynamicSharedMemorySize, LDS_BYTES) != hipSuccess) { fprintf(stderr, "kernel_launch: hipFuncSetAttribute failed\n"); grid = -1; return; }
        (void)hipGetLastError();
        grid = cus;
    }
    if (grid < 0) return;
    if (hipMemsetAsync((char*)d_ws + WS_CTL, 0, CTL_ZERO_BYTES, stream) != hipSuccess) return;
    Args a{};
    for (int i = 0; i < 16; ++i) a.in[i] = (const float*)d_in[i];
    a.out = (float*)d_out; a.ws = (unsigned char*)d_ws;
    for (int li = 0; li < N_LAUNCHES; ++li) {
        a.ph_lo = (N_LAUNCHES == 1) ? 0 : li; a.ph_hi = (N_LAUNCHES == 1) ? NPHASE : li + 1; a.li = li;
        hipLaunchKernelGGL(mk_fwd, dim3(grid), dim3(NTHR), LDS_BYTES, stream, a);
        if (hipPeekAtLastError() != hipSuccess) { fprintf(stderr, "kernel_launch: launch %d failed\n", li); break; }
    }
}
```

```cpp
#include <hip/hip_runtime.h>
#include <cstdio>
#include <cstdint>

#ifndef MK_N_LAUNCHES
#define MK_N_LAUNCHES 1
#endif
constexpr int NPHASE = 21;
#ifndef DUP_MASK
#define DUP_MASK 0u
#endif
constexpr int N_LAUNCHES = MK_N_LAUNCHES;

constexpr int BATCH = 8, SEQ = 4096, D = 1024, T = BATCH * SEQ;
constexpr int AB_IN = 2048, C_IN = 4096, NEXP = 16384;
constexpr float LN_EPS = 1e-5f;
constexpr float ALPHA = 1.41421356237309515f;
constexpr int NWAVES = 8, NTHR = 512;

constexpr size_t MiB = 1u << 20;
constexpr size_t WS_CTL = 0, CTL_ZERO_BYTES = 1 * MiB;
constexpr size_t WS_LB = 1 * MiB;
constexpr size_t WS_ROPE = 2 * MiB;
constexpr size_t WS_WABIN = 4 * MiB;
constexpr size_t WS_WABOUT = 8 * MiB;
constexpr size_t WS_WCIN = 10 * MiB;
constexpr size_t WS_WCOUT = 18 * MiB;
constexpr size_t WS_WQ = 20 * MiB;
constexpr size_t WS_KEYS = 28 * MiB;
constexpr size_t WS_DQU = 29 * MiB;
constexpr size_t WS_DQV = 29 * MiB + 131072;
constexpr size_t WS_U8 = 32 * MiB;
constexpr size_t WS_V8 = 64 * MiB;
constexpr size_t WS_POOLWT = 30 * MiB;
constexpr size_t WS_XB = 96 * MiB;
constexpr size_t WS_H0 = 160 * MiB;
constexpr size_t WS_LST = 288 * MiB;
constexpr size_t WS_Y = 320 * MiB;
constexpr size_t WS_H1 = 384 * MiB;
constexpr size_t WS_EID = 448 * MiB;
constexpr size_t WS_GATE = 464 * MiB;
constexpr size_t WS_CQ = 160 * MiB, WS_CK = 224 * MiB, WS_CV = 288 * MiB, WS_CG = 352 * MiB;
constexpr size_t WS_O = 416 * MiB;
constexpr size_t WS_Y2 = 160 * MiB;
constexpr size_t WS_Q1 = 224 * MiB;
constexpr size_t WS_DEC = 480 * MiB;
constexpr size_t WS_END = 484 * MiB;

constexpr int CW_BAR = 4096;
constexpr int LDS_BYTES = 147456;
constexpr int MISC_OFF = LDS_BYTES - 128;

#define GAS __attribute__((address_space(1)))
#define LAS __attribute__((address_space(3)))
typedef unsigned short bf16;
typedef unsigned v4u __attribute__((ext_vector_type(4)));
typedef unsigned v2u __attribute__((ext_vector_type(2)));
typedef float f32x4 __attribute__((ext_vector_type(4)));
typedef GAS unsigned gu32;
typedef short bf16x8 __attribute__((ext_vector_type(8)));
typedef float f32x16 __attribute__((ext_vector_type(16)));
#define RLX_AGENT __ATOMIC_RELAXED, __HIP_MEMORY_SCOPE_AGENT
#define LDS_WAIT() asm volatile("s_waitcnt lgkmcnt(0)" ::: "memory")
__device__ __forceinline__ unsigned f2bf(float f) { unsigned u = __builtin_bit_cast(unsigned, f); return (u + 0x7fffu + ((u >> 16) & 1u)) >> 16; }
__device__ __forceinline__ unsigned pk2(float lo, float hi) { return f2bf(lo) | (f2bf(hi) << 16); }
__device__ __forceinline__ float bf2f(unsigned b) { return __builtin_bit_cast(float, b << 16); }
__device__ __forceinline__ float bflo(unsigned w) { return __builtin_bit_cast(float, w << 16); }
__device__ __forceinline__ float bfhi(unsigned w) { return __builtin_bit_cast(float, w & 0xffff0000u); }
__device__ __forceinline__ float wave_sum(float v) {
#pragma unroll
    for (int o = 1; o < 64; o <<= 1) v += __shfl_xor(v, o);
    return v;
}

#define XB_TMO      128
#define XB_XCNT(j)  (256  + 64 * (j))
#define XB_XSUB(j)  (1280 + 64 * (j))
#define XB_XGEN(j)  (2304 + 64 * (j))
#define XB_TOP      3328
#define XB_TOPGEN   3392
#define XCD_BAR_WORDS 3456
#define XB_SPIN_CAP (1u << 21)
__device__ __forceinline__ unsigned xb_ld(unsigned* p)              { return __hip_atomic_load(p, __ATOMIC_RELAXED, __HIP_MEMORY_SCOPE_AGENT); }
__device__ __forceinline__ unsigned xb_add(unsigned* p, unsigned v) { return __hip_atomic_fetch_add(p, v, __ATOMIC_RELAXED, __HIP_MEMORY_SCOPE_AGENT); }
__device__ __forceinline__ unsigned xb_xcc_id() { return (unsigned)__builtin_amdgcn_s_getreg((3 << 11) | 20) & 0xFu; }
#define XB_SPIN(cond, bar) do { unsigned _sp = 0; while (cond) { __builtin_amdgcn_s_sleep(1); \
    if ((++_sp & 255u) == 0u) { if (xb_ld(&(bar)[XB_TMO])) break; if (_sp > XB_SPIN_CAP) { atomicAdd(&(bar)[XB_TMO], 1u); break; } } } } while (0)
struct XcdBarrier { unsigned* bar; unsigned x; volatile LAS unsigned* st; };
__device__ __forceinline__ XcdBarrier xcd_barrier_post(unsigned* bar, volatile LAS unsigned* st) {
    XcdBarrier b; b.bar = bar; b.x = xb_xcc_id(); b.st = st;
    if (threadIdx.x == 0) (void)xb_add(&bar[XB_XCNT(b.x)], 1u);
    return b;
}
__device__ __forceinline__ void xcd_barrier_complete(unsigned* bar, unsigned x, unsigned& nloc, unsigned& nx) {
    const unsigned G = gridDim.x * gridDim.y * gridDim.z;
    unsigned sum, cnt, mine, sp = 0u;
    for (;;) {
        sum = 0u; cnt = 0u; mine = 0u;
#pragma unroll
        for (unsigned j = 0; j < 16; ++j) { const unsigned c = xb_ld(&bar[XB_XCNT(j)]); sum += c; cnt += (c > 0u) ? 1u : 0u; mine = (j == x) ? c : mine; }
        if (sum == G) break;
        __builtin_amdgcn_s_sleep(1);
        if ((++sp & 255u) == 0u) { if (xb_ld(&bar[XB_TMO])) break; if (sp > XB_SPIN_CAP) { atomicAdd(&bar[XB_TMO], 1u); break; } }
    }
    nloc = mine > 0u ? mine : 1u; nx = cnt > 0u ? cnt : 1u;
}
__device__ __forceinline__ void xcd_barrier(const XcdBarrier& b) {
    asm volatile("s_waitcnt vmcnt(0)" ::: "memory");
    __syncthreads();
    if (threadIdx.x == 0) {
        unsigned* bar = b.bar;
        __builtin_amdgcn_s_waitcnt(0);
        unsigned nloc = b.st[0], nx = b.st[1];
        if (nloc == 0u) { xcd_barrier_complete(bar, b.x, nloc, nx); b.st[0] = nloc; b.st[1] = nx; }
        const unsigned old = xb_add(&bar[XB_XSUB(b.x)], 1u);
        const unsigned gen = old / nloc;
        if (old + 1u == (gen + 1u) * nloc) {
            __builtin_amdgcn_fence(__ATOMIC_RELEASE, "agent");
            asm volatile("s_waitcnt vmcnt(0)" ::: "memory");
            const unsigned og = xb_add(&bar[XB_TOP], 1u);
            const unsigned tg = og / nx;
            if (og + 1u == (tg + 1u) * nx) xb_add(&bar[XB_TOPGEN], 1u);
            else XB_SPIN(xb_ld(&bar[XB_TOPGEN]) == tg, bar);
            __builtin_amdgcn_fence(__ATOMIC_ACQUIRE, "agent");
            xb_add(&bar[XB_XGEN(b.x)], 1u);
            asm volatile("s_waitcnt vmcnt(0)" ::: "memory");
        } else {
            XB_SPIN(xb_ld(&bar[XB_XGEN(b.x)]) == gen, bar);
            __builtin_amdgcn_fence(__ATOMIC_ACQUIRE, "agent");
            asm volatile("s_waitcnt vmcnt(0)" ::: "memory");
        }
    }
    __syncthreads();
}

__device__ __forceinline__ void p0_transpose_item(const float* W, int K, int N, bf16* WT, LAS float* scr, int item, int lane) {
    const int nblk = N / 32, kb = item / nblk, nb = item % nblk, k0 = 64 * kb, n0 = 32 * nb;
#pragma unroll 8
    for (int i = 0; i < 32; ++i) { const int kk = 2 * i + (lane >> 5); scr[kk * 33 + (lane & 31)] = W[(size_t)(k0 + kk) * N + n0 + (lane & 31)]; }
    LDS_WAIT(); asm volatile("" ::: "memory");
    const int c = lane & 7;
#pragma unroll
    for (int j = 0; j < 4; ++j) { const int n = (lane >> 3) + 8 * j; const LAS float* s = scr + (8 * c) * 33 + n;
        v4u o; o.x = pk2(s[0 * 33], s[1 * 33]); o.y = pk2(s[2 * 33], s[3 * 33]); o.z = pk2(s[4 * 33], s[5 * 33]); o.w = pk2(s[6 * 33], s[7 * 33]);
        *(GAS v4u*)(WT + (size_t)(n0 + n) * K + k0 + 8 * c) = o; }
    LDS_WAIT(); asm volatile("" ::: "memory");
}

template <class Epi>
__device__ __forceinline__ void gemm_naive(LAS unsigned char* lds, const bf16* A, const bf16* Bt, int M, int N, int K, const Epi& E) {
    LAS float* As = (LAS float*)lds;
    LAS float* Bs = As + 128 * 33;
    const int tid = threadIdx.x, tx = tid & 15, ty = tid >> 4;
    const int ntn = N / 128, ntiles = (M / 128) * ntn;
    for (int tile = blockIdx.x; tile < ntiles; tile += gridDim.x) {
        const int tm = tile / ntn, tn = tile % ntn;
        float acc[4][8];
#pragma unroll
        for (int i = 0; i < 4; ++i)
#pragma unroll
            for (int j = 0; j < 8; ++j) acc[i][j] = 0.f;
        for (int k0 = 0; k0 < K; k0 += 32) {
            { const int r = tid >> 2, kc = (tid & 3) * 8;
              const v4u va = *(const GAS v4u*)(A + (size_t)(tm * 128 + r) * K + k0 + kc);
              const v4u vb = *(const GAS v4u*)(Bt + (size_t)(tn * 128 + r) * K + k0 + kc);
              LAS float* pa = As + r * 33 + kc; LAS float* pb = Bs + r * 33 + kc;
              pa[0] = bflo(va.x); pa[1] = bfhi(va.x); pa[2] = bflo(va.y); pa[3] = bfhi(va.y); pa[4] = bflo(va.z); pa[5] = bfhi(va.z); pa[6] = bflo(va.w); pa[7] = bfhi(va.w);
              pb[0] = bflo(vb.x); pb[1] = bfhi(vb.x); pb[2] = bflo(vb.y); pb[3] = bfhi(vb.y); pb[4] = bflo(vb.z); pb[5] = bfhi(vb.z); pb[6] = bflo(vb.w); pb[7] = bfhi(vb.w); }
            __syncthreads();
#pragma unroll 8
            for (int kk = 0; kk < 32; ++kk) {
                float a[4], b[8];
#pragma unroll
                for (int i = 0; i < 4; ++i) a[i] = As[(ty * 4 + i) * 33 + kk];
#pragma unroll
                for (int j = 0; j < 8; ++j) b[j] = Bs[(tx + 16 * j) * 33 + kk];
#pragma unroll
                for (int i = 0; i < 4; ++i)
#pragma unroll
                    for (int j = 0; j < 8; ++j) acc[i][j] += a[i] * b[j];
            }
            __syncthreads();
        }
#pragma unroll
        for (int i = 0; i < 4; ++i)
#pragma unroll
            for (int j = 0; j < 8; ++j) E(tm * 128 + ty * 4 + i, tn * 128 + tx + 16 * j, acc[i][j]);
    }
}
struct EpiStore { bf16* O; int ldc;
    __device__ __forceinline__ void operator()(int r, int c, float v) const { O[(size_t)r * ldc + c] = (bf16)f2bf(v); } };
struct EpiResid { const bf16* X; float* Z;
    __device__ __forceinline__ void operator()(int r, int c, float v) const { Z[(size_t)r * D + c] = ALPHA * bf2f(X[(size_t)r * D + c]) + v; } };
struct EpiCIn { bf16 *CQ, *CK, *CV, *CG; const float* lb;
    __device__ __forceinline__ void operator()(int r, int c, float v) const {
        const int seg = c >> 10, cc = c & 1023; const size_t o = (size_t)r * D + cc;
        if (seg == 0) CQ[o] = (bf16)f2bf(v);
        else if (seg == 1) { const float k = (1.f - lb[cc]) / (1.f + expf(v)); CK[o] = (bf16)f2bf(k); }
        else if (seg == 2) CV[o] = (bf16)f2bf(v);
        else CG[o] = (bf16)f2bf(v);
    } };

namespace pg8 {
#define PG8_LAS __attribute__((address_space(3)))
typedef unsigned short bf16_t;
typedef short bf16x8 __attribute__((ext_vector_type(8)));
typedef float f32x4 __attribute__((ext_vector_type(4)));
typedef unsigned u32x4 __attribute__((ext_vector_type(4)));
constexpr int BM = 256, BK = 64, HALF = 128, HTB = HALF * BK * 2  , STAGE_BYTES = 8 * HTB, NXCD = 8, WGM = 8;

__host__ __device__ __forceinline__ int lds_byte(int r, int c) { const int st = (r >> 4) * 2 + (c >> 5), rr = r & 15, cc = c & 31, ob = rr * 64 + cc * 2; return st * 1024 + (ob ^ (((ob >> 9) & 1) << 5)); }
__host__ __device__ __forceinline__ void stage_rc(int b, int& R, int& C) { const int st = b / 1024, sb = b % 1024, swz = sb ^ (((sb >> 9) & 1) << 5); R = (st >> 1) * 16 + swz / 64; C = (st & 1) * 32 + (swz % 64) / 2; }
__host__ __device__ __forceinline__ int perm32(int rho) { const int n = rho >> 4, i = rho & 15; return 8 * (i >> 2) + 4 * n + (i & 3); }

struct Unit { int pm, pn; };
struct Gemm { const bf16_t* A; const bf16_t* Bt; int M, N, K; };

struct StaticOrder {
    int nM, nN, nwg, G, c;
    __host__ __device__ void init(int M, int N, int G_, int c_) { nM = M / BM; nN = N / BM; nwg = nM * nN; G = G_; c = c_; }
    __host__ __device__ bool next(int i, Unit& u) const {
        const long L = (long)i * G + c; if (L >= nwg) return false;
        int wgid = (int)L; { const int q = nwg / NXCD, r = nwg % NXCD, xcd = wgid % NXCD, off = wgid / NXCD; wgid = (xcd < r ? xcd * (q + 1) : r * (q + 1) + (xcd - r) * q) + off; }
        const int nig = WGM * nN, gid = wgid / nig, fm = gid * WGM, gsz = (nM - fm) < WGM ? (nM - fm) : WGM;
        u.pm = fm + ((wgid % nig) % gsz); u.pn = (wgid % nig) / gsz; return true;
    }
    __device__ __forceinline__ void a_ready(const Unit&) const {}
    __device__ __forceinline__ void done(const Unit&) const {}
};

__device__ __forceinline__ unsigned cvt_pk_bf16(float lo, float hi) { unsigned r; asm volatile("v_cvt_pk_bf16_f32 %0, %1, %2" : "=v"(r) : "v"(lo), "v"(hi)); return r; }
typedef float f32x2 __attribute__((ext_vector_type(2)));
__device__ __forceinline__ f32x2 gelu_pk(f32x2 v) {
    const f32x2 av = __builtin_elementwise_abs(v), d = av * 0.2316418882f + 1.0f;
    f32x2 t; t.x = __builtin_amdgcn_rcpf(d.x); t.y = __builtin_amdgcn_rcpf(d.y);
    f32x2 q = t * 0.5307027145f + (-0.7265760135f); q = q * t + 0.7107068705f; q = q * t + (-0.142248368f); q = q * t + 0.127414796f; q = q * t;
    const f32x2 s = (v * v) * (-0.72134752044f);
    f32x2 e; e.x = __builtin_amdgcn_exp2f(s.x); e.y = __builtin_amdgcn_exp2f(s.y);
    const f32x2 m = v * (q * e), r = v - m;
    f32x2 o; o.x = v.x < 0.f ? m.x : r.x; o.y = v.y < 0.f ? m.y : r.y; return o;
}

template <int ACT  > struct EpiBf16 {
    static constexpr bool PERM = true, AFTER_DRAIN = false; static_assert(ACT == 0 || ACT == 1, "EpiBf16: ACT is 0 (none) or 1 (gelu_pk)");
    bf16_t* O; int ldc; const float* bias; int split_cols; size_t split_stride; float scale0;
    __device__ __forceinline__ void operator()(const f32x4 (&acc)[2][2][4][2], const Unit& u, int wr, int wc, int fr, int fq) const {
        const int row0 = u.pm * BM + wr * 64 + fr; int colt = u.pn * BM; bf16_t* base = O;
        float sc = 1.f; if (split_cols) { const int t = colt / split_cols; base += (size_t)t * split_stride; colt -= t * split_cols; if (t == 0) sc = scale0; }
        const int col0 = colt + wc * 32 + 8 * fq, bcol0 = u.pn * BM + wc * 32 + 8 * fq;
        f32x4 bv[2][2];
#pragma unroll
        for (int bj = 0; bj < 2; ++bj)
#pragma unroll
            for (int n = 0; n < 2; ++n) bv[bj][n] = bias ? *(const f32x4*)(bias + bcol0 + bj * HALF + 4 * n) : (f32x4){0.f, 0.f, 0.f, 0.f};
#pragma unroll
        for (int ai = 0; ai < 2; ++ai)
#pragma unroll
            for (int m = 0; m < 4; ++m) { bf16_t* rowp = base + (size_t)(row0 + ai * HALF + m * 16) * ldc + col0;
#pragma unroll
                for (int bj = 0; bj < 2; ++bj) { f32x4 v0 = acc[ai][bj][m][0] + bv[bj][0], v1 = acc[ai][bj][m][1] + bv[bj][1];
                    if (ACT == 1) { f32x2 a = gelu_pk((f32x2){v0[0], v0[1]}), b = gelu_pk((f32x2){v0[2], v0[3]}), c = gelu_pk((f32x2){v1[0], v1[1]}), d = gelu_pk((f32x2){v1[2], v1[3]});
                        v0 = (f32x4){a.x, a.y, b.x, b.y}; v1 = (f32x4){c.x, c.y, d.x, d.y}; }
                    v0 = v0 * sc; v1 = v1 * sc; u32x4 w; w.x = cvt_pk_bf16(v0[0], v0[1]); w.y = cvt_pk_bf16(v0[2], v0[3]); w.z = cvt_pk_bf16(v1[0], v1[1]); w.w = cvt_pk_bf16(v1[2], v1[3]);
                    *(u32x4*)(rowp + bj * HALF) = w; } }
    }
};

struct EpiResidF32 {
    static constexpr bool PERM = false, AFTER_DRAIN = false;
    const bf16_t* X; float* Z;
    __device__ __forceinline__ void operator()(const f32x4 (&acc)[2][2][4][2], const Unit& u, int wr, int wc, int fr, int fq) const {
        typedef unsigned u32x2 __attribute__((ext_vector_type(2)));
        const int row0 = u.pm * BM + wr * 64 + fr, col0 = u.pn * BM + wc * 32 + 4 * fq;
#pragma unroll
        for (int ai = 0; ai < 2; ++ai)
#pragma unroll
            for (int m = 0; m < 4; ++m) { const size_t ro = (size_t)(row0 + ai * HALF + m * 16) * 1024;
#pragma unroll
                for (int bj = 0; bj < 2; ++bj)
#pragma unroll
                    for (int n = 0; n < 2; ++n) { const int c = col0 + bj * HALF + n * 16; const u32x2 xw = *(const u32x2*)(X + ro + c);
                        f32x4 xv; xv[0] = __builtin_bit_cast(float, xw.x << 16); xv[1] = __builtin_bit_cast(float, xw.x & 0xffff0000u); xv[2] = __builtin_bit_cast(float, xw.y << 16); xv[3] = __builtin_bit_cast(float, xw.y & 0xffff0000u);
                        *(f32x4*)(Z + ro + c) = xv * 1.41421356237309515f + acc[ai][bj][m][n]; } }
    }
};
struct EpiCInF {
    static constexpr bool PERM = true, AFTER_DRAIN = false;
    bf16_t *CQ, *CK, *CV, *CG; const float* lb;
    __device__ __forceinline__ void operator()(const f32x4 (&acc)[2][2][4][2], const Unit& u, int wr, int wc, int fr, int fq) const {
        const int seg = u.pn >> 2, colt = (u.pn & 3) * BM;
        bf16_t* base = seg == 0 ? CQ : (seg == 1 ? CK : (seg == 2 ? CV : CG));
        const int row0 = u.pm * BM + wr * 64 + fr, col0 = colt + wc * 32 + 8 * fq;
        f32x4 om[2][2];
#pragma unroll
        for (int bj = 0; bj < 2; ++bj)
#pragma unroll
            for (int n = 0; n < 2; ++n) { const f32x4 l = *(const f32x4*)(lb + col0 + bj * HALF + 4 * n); om[bj][n] = 1.0f - l; }
#pragma unroll
        for (int ai = 0; ai < 2; ++ai)
#pragma unroll
            for (int m = 0; m < 4; ++m) { bf16_t* rowp = base + (size_t)(row0 + ai * HALF + m * 16) * 1024 + col0;
#pragma unroll
                for (int bj = 0; bj < 2; ++bj) { f32x4 v0 = acc[ai][bj][m][0], v1 = acc[ai][bj][m][1];
                    if (seg == 1) {
#pragma unroll
                        for (int q = 0; q < 4; ++q) { v0[q] = om[bj][0][q] / (1.0f + __expf(v0[q])); v1[q] = om[bj][1][q] / (1.0f + __expf(v1[q])); } }
                    u32x4 w; w.x = cvt_pk_bf16(v0[0], v0[1]); w.y = cvt_pk_bf16(v0[2], v0[3]); w.z = cvt_pk_bf16(v1[0], v1[1]); w.w = cvt_pk_bf16(v1[2], v1[3]);
                    *(u32x4*)(rowp + bj * HALF) = w; } }
    }
};
template <class Epi, class Sched, bool ALIGN_EPI = false, bool SP2 = false>
__device__ __forceinline__ void gemm_phase(PG8_LAS unsigned char* lds, const Gemm g, const Sched& S, const Epi& E) {
    const int tid = threadIdx.x, wid = __builtin_amdgcn_readfirstlane(tid >> 6), lane = tid & 63, wr = wid >> 2, wc = wid & 3, fr = lane & 15, fq = lane >> 4;
    const int K = g.K, nt = K / BK;
    unsigned voffA[2], voffB[2];
#pragma unroll
    for (int i = 0; i < 2; ++i) { int R, C; stage_rc(tid * 16 + i * 8192, R, C); const int Rb = Epi::PERM ? ((R & ~31) + perm32(R & 31)) : R;
        voffA[i] = (unsigned)(R * K + C) * 2u; voffB[i] = (unsigned)(Rb * K + C) * 2u; }
    const size_t kstep = (size_t)(BK * 2);
    const size_t hstep = (size_t)HALF * K * 2;
    const size_t tstep = 2 * hstep;
    const unsigned ldsw = (unsigned)wid * 1024u;
    const int aoff = lds_byte(wr * 64 + fr, fq * 8), boff = lds_byte(wc * 32 + fr, fq * 8);
#define PG8_SA(b, h) (((b) * 2 + (h)) * HTB)
#define PG8_SB(b, h) ((4 + (b) * 2 + (h)) * HTB)
#define PG8_STAGE(bufoff, gbase, voff) do { _Pragma("unroll") for (int _i = 0; _i < 2; ++_i) \
        __builtin_amdgcn_global_load_lds((const unsigned*)((const char*)(gbase) + (voff)[_i]), (PG8_LAS unsigned*)(lds + (bufoff) + ldsw + _i * 8192), 16, 0, 0); } while (0)
#define PG8_LDA(dst, b, h) do { _Pragma("unroll") for (int m = 0; m < 4; ++m) _Pragma("unroll") for (int k = 0; k < 2; ++k) dst[m][k] = *(const PG8_LAS bf16x8*)(lds + PG8_SA(b, h) + aoff + m * 2048 + k * 1024); } while (0)
#define PG8_LDB(dst, b, h) do { _Pragma("unroll") for (int n = 0; n < 2; ++n) _Pragma("unroll") for (int k = 0; k < 2; ++k) dst[n][k] = *(const PG8_LAS bf16x8*)(lds + PG8_SB(b, h) + boff + n * 2048 + k * 1024); } while (0)
#define PG8_MMA(ai, bj, At, Bt) do { __builtin_amdgcn_s_setprio(1); _Pragma("unroll") for (int m = 0; m < 4; ++m) _Pragma("unroll") for (int n = 0; n < 2; ++n) _Pragma("unroll") for (int k = 0; k < 2; ++k) \
        acc[ai][bj][m][n] = __builtin_amdgcn_mfma_f32_16x16x32_bf16(Bt[n][k], At[m][k], acc[ai][bj][m][n], 0, 0, 0); __builtin_amdgcn_s_setprio(0); } while (0)
#define PG8_WAIT_V(n) asm volatile("s_waitcnt vmcnt(" #n ")" ::: "memory")
#define PG8_WAIT_L(n) asm volatile("s_waitcnt lgkmcnt(" #n ")" ::: "memory")
#define PG8_BAR __builtin_amdgcn_s_barrier()
#define PG8_SCHED __builtin_amdgcn_sched_barrier(0)
    Unit cur, nxt; int ui = 0;
    if (!S.next(0, cur)) return;
    f32x4 acc[2][2][4][2];
#pragma unroll
    for (int a = 0; a < 2; ++a)
#pragma unroll
        for (int b = 0; b < 2; ++b)
#pragma unroll
            for (int m = 0; m < 4; ++m)
#pragma unroll
                for (int n = 0; n < 2; ++n) acc[a][b][m][n] = (f32x4){0.f, 0.f, 0.f, 0.f};
    bf16x8 At[4][2], B0[2][2], B1[2][2];
    const char* cA = (const char*)g.A + (size_t)cur.pm * tstep; const char* cB = (const char*)g.Bt + (size_t)cur.pn * tstep;
    S.a_ready(cur);
    if constexpr (SP2) {
        PG8_STAGE(PG8_SB(0, 0), cB, voffB); PG8_STAGE(PG8_SB(0, 1), cB + hstep, voffB); PG8_STAGE(PG8_SA(0, 0), cA, voffA); PG8_STAGE(PG8_SA(0, 1), cA + hstep, voffA);
        if (wr == 1) PG8_BAR;
        PG8_WAIT_V(2); PG8_BAR;
        PG8_STAGE(PG8_SB(1, 0), cB + kstep, voffB); PG8_STAGE(PG8_SA(1, 0), cA + kstep, voffA); PG8_STAGE(PG8_SB(1, 1), cB + hstep + kstep, voffB);
        PG8_WAIT_V(6); PG8_BAR;
    } else {
        PG8_STAGE(PG8_SB(0, 0), cB, voffB); PG8_STAGE(PG8_SA(0, 0), cA, voffA); PG8_STAGE(PG8_SB(0, 1), cB + hstep, voffB); PG8_STAGE(PG8_SA(0, 1), cA + hstep, voffA);
        if (wr == 1) PG8_BAR;
        PG8_WAIT_V(4); PG8_BAR;
        PG8_STAGE(PG8_SB(1, 0), cB + kstep, voffB); PG8_STAGE(PG8_SA(1, 0), cA + kstep, voffA); PG8_STAGE(PG8_SB(1, 1), cB + hstep + kstep, voffB);
        PG8_WAIT_V(6); PG8_BAR;
    }
    for (;;) {
        const bool has_next = S.next(ui + 1, nxt);
        const char* nA = has_next ? (const char*)g.A + (size_t)nxt.pm * tstep : cA; const char* nB = has_next ? (const char*)g.Bt + (size_t)nxt.pn * tstep : cB;
        for (int t = 0; t < nt; t += 2) {
            const bool last = (t == nt - 2);
            const char* a1 = cA + (size_t)(t + 1) * kstep;
            const char* a2 = last ? nA : cA + (size_t)(t + 2) * kstep; const char* b2 = last ? nB : cB + (size_t)(t + 2) * kstep;
            const char* a3 = a2 + kstep; const char* b3 = b2 + kstep;
            if (last && has_next) S.a_ready(nxt);
            if constexpr (SP2) {
            PG8_LDB(B0, 0, 0); PG8_LDB(B1, 0, 1); PG8_SCHED; PG8_LDA(At, 0, 0); PG8_STAGE(PG8_SA(1, 1), a1 + hstep, voffA);
            PG8_WAIT_V(8); PG8_WAIT_L(0); PG8_BAR; PG8_MMA(0, 0, At, B0); PG8_MMA(0, 1, At, B1); PG8_BAR; PG8_SCHED;
            PG8_LDA(At, 0, 1); PG8_STAGE(PG8_SB(0, 0), b2, voffB); PG8_STAGE(PG8_SB(0, 1), b2 + hstep, voffB); PG8_STAGE(PG8_SA(0, 0), a2, voffA);
            PG8_WAIT_V(8); PG8_WAIT_L(0); PG8_BAR; PG8_MMA(1, 0, At, B0); PG8_MMA(1, 1, At, B1); PG8_BAR; PG8_SCHED;
            PG8_LDB(B0, 1, 0); PG8_LDB(B1, 1, 1); PG8_SCHED; PG8_LDA(At, 1, 0); PG8_STAGE(PG8_SA(0, 1), a2 + hstep, voffA);
            PG8_WAIT_V(8); PG8_WAIT_L(0); PG8_BAR; PG8_MMA(0, 0, At, B0); PG8_MMA(0, 1, At, B1); PG8_BAR; PG8_SCHED;
            PG8_LDA(At, 1, 1); PG8_STAGE(PG8_SB(1, 0), b3, voffB); PG8_STAGE(PG8_SB(1, 1), b3 + hstep, voffB); PG8_STAGE(PG8_SA(1, 0), a3, voffA);
            PG8_WAIT_V(8); PG8_WAIT_L(0); PG8_BAR; PG8_MMA(1, 0, At, B0); PG8_MMA(1, 1, At, B1); PG8_BAR; PG8_SCHED;
            } else {
            PG8_LDB(B0, 0, 0); PG8_SCHED; PG8_LDA(At, 0, 0); PG8_STAGE(PG8_SA(1, 1), a1 + hstep, voffA);
            PG8_WAIT_L(8); PG8_BAR; PG8_WAIT_L(0); PG8_MMA(0, 0, At, B0); PG8_BAR; PG8_SCHED;
            PG8_LDB(B1, 0, 1); PG8_STAGE(PG8_SB(0, 0), b2, voffB);
            PG8_BAR; PG8_WAIT_L(0); PG8_MMA(0, 1, At, B1); PG8_BAR;
            PG8_LDA(At, 0, 1); PG8_STAGE(PG8_SA(0, 0), a2, voffA);
            PG8_BAR; PG8_WAIT_L(0); PG8_MMA(1, 0, At, B0); PG8_BAR; PG8_SCHED;
            PG8_STAGE(PG8_SB(0, 1), b2 + hstep, voffB);
            PG8_WAIT_V(6); PG8_BAR; PG8_MMA(1, 1, At, B1); PG8_BAR;
            PG8_LDB(B0, 1, 0); PG8_SCHED; PG8_LDA(At, 1, 0); PG8_STAGE(PG8_SA(0, 1), a2 + hstep, voffA);
            PG8_WAIT_L(8); PG8_BAR; PG8_WAIT_L(0); PG8_MMA(0, 0, At, B0); PG8_BAR; PG8_SCHED;
            PG8_LDB(B1, 1, 1); PG8_STAGE(PG8_SB(1, 0), b3, voffB);
            PG8_BAR; PG8_WAIT_L(0); PG8_MMA(0, 1, At, B1); PG8_BAR;
            PG8_LDA(At, 1, 1); PG8_STAGE(PG8_SA(1, 0), a3, voffA);
            PG8_BAR; PG8_WAIT_L(0); PG8_MMA(1, 0, At, B0); PG8_BAR; PG8_SCHED;
            PG8_STAGE(PG8_SB(1, 1), b3 + hstep, voffB);
            PG8_WAIT_V(6); PG8_BAR; PG8_MMA(1, 1, At, B1); PG8_BAR;
            }
        }
        if constexpr (ALIGN_EPI) { if (wr == 0) PG8_BAR; }
        if constexpr (!Epi::AFTER_DRAIN) { E(acc, cur, wr, wc, fr, fq); S.done(cur); }
        if (!has_next) break;
#pragma unroll
        for (int a = 0; a < 2; ++a)
#pragma unroll
            for (int b = 0; b < 2; ++b)
#pragma unroll
                for (int m = 0; m < 4; ++m)
#pragma unroll
                    for (int n = 0; n < 2; ++n) acc[a][b][m][n] = (f32x4){0.f, 0.f, 0.f, 0.f};
        cur = nxt; cA = nA; cB = nB; ++ui;
        if constexpr (ALIGN_EPI) { if (wr == 1) PG8_BAR; }
    }
    PG8_WAIT_V(0);
    if constexpr (!ALIGN_EPI) { if (wr == 0) PG8_BAR; }
    PG8_BAR;
    if constexpr (Epi::AFTER_DRAIN) { E.fused(acc, cur, wr, wc, fr, fq, lds, wid, lane); S.done(cur); }
#undef PG8_SA
#undef PG8_SB
#undef PG8_STAGE
#undef PG8_LDA
#undef PG8_LDB
#undef PG8_MMA
#undef PG8_WAIT_V
#undef PG8_WAIT_L
#undef PG8_BAR
#undef PG8_SCHED
}
}

__device__ __forceinline__ float gamma_log2(int h) { return log2f(1.f - exp2f(-5.f - (float)h)); }

__device__ __forceinline__ void phase_prologue(LAS unsigned char* lds, const float* const* in, unsigned char* ws) {
    const int tid = threadIdx.x, lane = tid & 63, wave = tid >> 6;
    const int gw = blockIdx.x * NWAVES + wave, NGW = gridDim.x * NWAVES;
    LAS float* scr = (LAS float*)(lds + wave * 16384);
    constexpr int I_ABIN = (D / 64) * (AB_IN / 32), I_SQ = (D / 64) * (D / 32), I_CIN = (D / 64) * (C_IN / 32), I_WQ = (D / 64) * (2048 / 32);
    constexpr int NITEMS = I_ABIN + I_SQ + I_CIN + I_SQ + 2 * I_WQ;
    for (int it = gw; it < NITEMS; it += NGW) {
        int r = it;
        if (r < I_ABIN) { p0_transpose_item(in[1], D, AB_IN, (bf16*)(ws + WS_WABIN), scr, r, lane); continue; } r -= I_ABIN;
        if (r < I_SQ) { p0_transpose_item(in[5], D, D, (bf16*)(ws + WS_WABOUT), scr, r, lane); continue; } r -= I_SQ;
        if (r < I_CIN) { p0_transpose_item(in[6], D, C_IN, (bf16*)(ws + WS_WCIN), scr, r, lane); continue; } r -= I_CIN;
        if (r < I_SQ) { p0_transpose_item(in[9], D, D, (bf16*)(ws + WS_WCOUT), scr, r, lane); continue; } r -= I_SQ;
        if (r < I_WQ) { p0_transpose_item(in[10], D, 2048, (bf16*)(ws + WS_WQ), scr, r, lane); continue; } r -= I_WQ;
        p0_transpose_item(in[10] + (size_t)D * 2048, D, 2048, (bf16*)(ws + WS_WQ) + (size_t)2048 * D, scr, r, lane);
    }
    for (int it = gw; it < 32; it += NGW) p0_transpose_item(in[2] + (size_t)(it >> 3) * 16384, 128, 128, (bf16*)(ws + WS_POOLWT) + (size_t)(it >> 3) * 16384, scr, it & 7, lane);
    const size_t gt = (size_t)blockIdx.x * NTHR + tid, NT = (size_t)gridDim.x * NTHR;
    { const float* x = in[0]; bf16* xb = (bf16*)(ws + WS_XB);
      for (size_t i = gt; i < (size_t)T * D / 8; i += NT) { const f32x4 a = *(const GAS f32x4*)(x + i * 8), b = *(const GAS f32x4*)(x + i * 8 + 4);
          v4u o; o.x = pk2(a.x, a.y); o.y = pk2(a.z, a.w); o.z = pk2(b.x, b.y); o.w = pk2(b.z, b.w); *(GAS v4u*)(xb + i * 8) = o; } }
    { const float* k = in[11]; bf16* kb = (bf16*)(ws + WS_KEYS);
      for (size_t i = gt; i < (size_t)2 * 8 * 2 * 128 * 128 / 8; i += NT) { const f32x4 a = *(const GAS f32x4*)(k + i * 8), b = *(const GAS f32x4*)(k + i * 8 + 4);
          v4u o; o.x = pk2(a.x, a.y); o.y = pk2(a.z, a.w); o.z = pk2(b.x, b.y); o.w = pk2(b.z, b.w); *(GAS v4u*)(kb + i * 8) = o; } }
    { float* ct = (float*)(ws + WS_ROPE); float* st = ct + 4096 * 32;
      for (size_t i = gt; i < (size_t)4096 * 32; i += NT) { const int pos = (int)(i >> 5), f = (int)(i & 31);
          const double inv = exp(-log(10000.0) * ((double)f / 31.0)); const double ang = (double)pos * inv;
          ct[i] = (float)cos(ang); st[i] = (float)sin(ang); } }
    { const float* l = in[7]; float* lb = (float*)(ws + WS_LB);
      for (size_t i = gt; i < 1024; i += NT) { const float a = l[i], b = l[1024 + i]; const float m = fmaxf(a, b); const float ea = expf(a - m), eb = expf(b - m); lb[i] = eb / (ea + eb); } }
}

__device__ __forceinline__ void phase_ret_local(LAS unsigned char* lds, unsigned char* ws) {
    const int tid = threadIdx.x;
    const bf16* H0 = (const bf16*)(ws + WS_H0); float* LST = (float*)(ws + WS_LST);
    const float* ct = (const float*)(ws + WS_ROPE); const float* st = ct + 4096 * 32;
    LAS float* kd = (LAS float*)lds;
    LAS float* vv = (LAS float*)(lds + 32768);
    for (int item = blockIdx.x; item < 1024; item += gridDim.x) {
        const int n = item & 31, h = (item >> 5) & 3, b = item >> 7;
        const size_t t0 = (size_t)b * SEQ + n * 128; const float lg = gamma_log2(h);
        for (int idx = tid; idx < 4096; idx += NTHR) { const int s = idx >> 5, i = idx & 31, pos = n * 128 + s;
            const bf16* row = H0 + (t0 + s) * AB_IN + 768 + h * 64;
            const float x1 = bf2f(row[i]), x2 = bf2f(row[i + 32]); const float c = ct[pos * 32 + i], sn = st[pos * 32 + i];
            const float dec = exp2f((float)(127 - s) * lg) * 0.125f;
            kd[s * 64 + i] = (x1 * c - x2 * sn) * dec; kd[s * 64 + i + 32] = (x2 * c + x1 * sn) * dec; }
        for (int idx = tid; idx < 16384; idx += NTHR) { const int s = idx >> 7, e = idx & 127; vv[idx] = bf2f(H0[(t0 + s) * AB_IN + 1024 + h * 128 + e]); }
        __syncthreads();
        const int e = tid & 127, dg = tid >> 7;
        float acc[16];
#pragma unroll
        for (int j = 0; j < 16; ++j) acc[j] = 0.f;
        for (int s = 0; s < 128; ++s) { const float v = vv[s * 128 + e];
#pragma unroll
            for (int j = 0; j < 16; ++j) acc[j] += kd[s * 64 + dg * 16 + j] * v; }
#pragma unroll
        for (int j = 0; j < 16; ++j) LST[(size_t)item * 8192 + (dg * 16 + j) * 128 + e] = acc[j];
        __syncthreads();
    }
}
__device__ __forceinline__ void phase_ret_prefix(unsigned char* ws) {
    float* LST = (float*)(ws + WS_LST);
    const size_t gt = (size_t)blockIdx.x * NTHR + threadIdx.x, NT = (size_t)gridDim.x * NTHR;
    for (size_t idx = gt; idx < (size_t)32 * 8192; idx += NT) { const int bh = (int)(idx >> 13), el = (int)(idx & 8191), h = bh & 3;
        const float g128 = exp2f(128.f * gamma_log2(h)); float S = 0.f;
        for (int n = 0; n < 32; ++n) { float* p = LST + ((size_t)(bh * 32 + n) * 8192 + el); const float tmp = *p; *p = S; S = S * g128 + tmp; } }
}
__device__ __forceinline__ void phase_ret_out_pool(LAS unsigned char* lds, const float* const* in, unsigned char* ws) {
    const int tid = threadIdx.x;
    const bf16* H0 = (const bf16*)(ws + WS_H0); const float* LST = (const float*)(ws + WS_LST); bf16* Y = (bf16*)(ws + WS_Y);
    const float* ct = (const float*)(ws + WS_ROPE); const float* st = ct + 4096 * 32;
    const float* pool_w = in[2]; const float* pool_scale = in[3]; const float* ret_g = in[4];
    LAS float* qs = (LAS float*)lds;
    LAS float* ks = qs + 128 * 65;
    LAS float* R2 = (LAS float*)(lds + 66560);
    LAS float* PA = (LAS float*)lds;
    LAS float* PB = (LAS float*)(lds + 66048);
    for (int item = blockIdx.x; item < 256; item += gridDim.x) {
        const int n = item & 31, b = item >> 5; const size_t t0 = (size_t)b * SEQ + n * 128;
        const int c = tid >> 2, eg = tid & 3;
        for (int h = 0; h < 4; ++h) {
            const float lg = gamma_log2(h);
            for (int idx = tid; idx < 4096; idx += NTHR) { const int s = idx >> 5, i = idx & 31, pos = n * 128 + s;
                const bf16* rq = H0 + (t0 + s) * AB_IN + 512 + h * 64; const bf16* rk = H0 + (t0 + s) * AB_IN + 768 + h * 64;
                const float cs = ct[pos * 32 + i], sn = st[pos * 32 + i];
                const float q1 = bf2f(rq[i]), q2 = bf2f(rq[i + 32]), k1 = bf2f(rk[i]), k2 = bf2f(rk[i + 32]);
                qs[s * 65 + i] = q1 * cs - q2 * sn; qs[s * 65 + i + 32] = q2 * cs + q1 * sn;
                ks[s * 65 + i] = (k1 * cs - k2 * sn) * 0.125f; ks[s * 65 + i + 32] = (k2 * cs + k1 * sn) * 0.125f; }
            { const float* Sg = LST + (size_t)((b * 4 + h) * 32 + n) * 8192;
              for (int idx = tid; idx < 8192; idx += NTHR) R2[idx] = Sg[idx]; }
            __syncthreads();
            float o[32];
#pragma unroll
            for (int j = 0; j < 32; ++j) o[j] = 0.f;
            for (int d = 0; d < 64; ++d) { const float qv = qs[c * 65 + d];
#pragma unroll
                for (int j = 0; j < 32; ++j) o[j] += qv * R2[d * 128 + eg * 32 + j]; }
            { const float qd = exp2f((float)(c + 1) * lg);
#pragma unroll
              for (int j = 0; j < 32; ++j) o[j] *= qd; }
            __syncthreads();
            for (int idx = tid; idx < 16384; idx += NTHR) { const int s = idx >> 7, e = idx & 127; R2[idx] = bf2f(H0[(t0 + s) * AB_IN + 1024 + h * 128 + e]); }
            __syncthreads();
            for (int s = 0; s <= c; ++s) {
                float dot = 0.f;
#pragma unroll 16
                for (int d = 0; d < 64; ++d) dot += qs[c * 65 + d] * ks[s * 65 + d];
                const float w = dot * exp2f((float)(c - s) * lg);
#pragma unroll
                for (int j = 0; j < 32; ++j) o[j] += w * R2[s * 128 + eg * 32 + j];
            }
            float sum = 0.f;
#pragma unroll
            for (int j = 0; j < 32; ++j) sum += o[j];
            sum += __shfl_xor(sum, 1); sum += __shfl_xor(sum, 2);
            const float mean = sum * (1.f / 128.f); float sq = 0.f;
#pragma unroll
            for (int j = 0; j < 32; ++j) { const float dl = o[j] - mean; sq += dl * dl; }
            sq += __shfl_xor(sq, 1); sq += __shfl_xor(sq, 2);
            const float rstd = 1.f / sqrtf(sq * (1.f / 128.f) + LN_EPS);
            { const bf16* rg = H0 + (t0 + c) * AB_IN + 1536 + h * 128 + eg * 32; bf16* yo = Y + (t0 + c) * D + 512 + h * 128 + eg * 32;
#pragma unroll
              for (int j = 0; j < 32; ++j) { const float g = bf2f(rg[j]); const float sg = g / (1.f + expf(-g));
                  yo[j] = (bf16)f2bf((o[j] - mean) * rstd * ret_g[h * 128 + eg * 32 + j] * sg); } }
            __syncthreads();
        }
        for (int gi = 0; gi < 4; ++gi) {
            const int w = 2 << gi;
            for (int idx = tid; idx < 16384; idx += NTHR) { const int s = idx >> 7, cc = idx & 127, pos = n * 128 + s; const int cnt = (pos + 1 < w) ? pos + 1 : w;
                float sum = 0.f; for (int j = 0; j < cnt; ++j) sum += bf2f(H0[(t0 + s - j) * AB_IN + gi * 128 + cc]);
                PA[s * 129 + cc] = sum / (float)cnt - bf2f(H0[(t0 + s) * AB_IN + gi * 128 + cc]); }
            for (int idx = tid; idx < 16384; idx += NTHR) PB[idx] = pool_w[gi * 16384 + idx];
            __syncthreads();
            float o[32];
#pragma unroll
            for (int j = 0; j < 32; ++j) o[j] = 0.f;
            for (int cc = 0; cc < 128; ++cc) { const float pv = PA[c * 129 + cc];
#pragma unroll
                for (int j = 0; j < 32; ++j) o[j] += pv * PB[cc * 128 + eg * 32 + j]; }
            { bf16* yo = Y + (t0 + c) * D + gi * 128 + eg * 32;
#pragma unroll
              for (int j = 0; j < 32; ++j) yo[j] = (bf16)f2bf(o[j] * pool_scale[gi * 128 + eg * 32 + j]); }
            __syncthreads();
        }
    }
}

__device__ __forceinline__ void unpack8(const v4u w, float (&x)[8]) { x[0] = bflo(w.x); x[1] = bfhi(w.x); x[2] = bflo(w.y); x[3] = bfhi(w.y); x[4] = bflo(w.z); x[5] = bfhi(w.z); x[6] = bflo(w.w); x[7] = bfhi(w.w); }
__device__ __forceinline__ v4u pack8(const float (&x)[8]) { v4u w; w.x = pk2(x[0], x[1]); w.y = pk2(x[2], x[3]); w.z = pk2(x[4], x[5]); w.w = pk2(x[6], x[7]); return w; }
__device__ __forceinline__ void phase_ret_out_pool_fast(LAS unsigned char* lds, const float* const* in, unsigned char* ws) {
    const int tid = threadIdx.x, lane = tid & 63, wave = __builtin_amdgcn_readfirstlane(tid >> 6);
    const int c = lane & 31, hh = lane >> 5, cbk = wave & 3, eh = wave >> 2;
    const bf16* H0 = (const bf16*)(ws + WS_H0); const float* LST = (const float*)(ws + WS_LST); bf16* Y = (bf16*)(ws + WS_Y);
    const float* ct = (const float*)(ws + WS_ROPE); const float* st = ct + 4096 * 32;
    const float* pool_scale = in[3]; const float* ret_g = in[4]; const bf16* PWT = (const bf16*)(ws + WS_POOLWT);
    constexpr int O_QP = 0, O_KP = 18432, O_VT = 36864, O_ST = 71680, O_PI = 90112, O_RED = 124928, O_PT = 0, O_WT = 34816;
    for (int item = blockIdx.x; item < 256; item += gridDim.x) {
        const int n = item & 31, b = item >> 5; const size_t t0 = (size_t)b * SEQ + n * 128;
        for (int h = 0; h < 4; ++h) {
            const float lg = gamma_log2(h);
            __syncthreads();
            { const int s = tid >> 2, grp = tid & 3, pos = n * 128 + s;
              const bf16* rq = H0 + (t0 + s) * AB_IN + 512 + h * 64 + 8 * grp; const bf16* rk = H0 + (t0 + s) * AB_IN + 768 + h * 64 + 8 * grp;
              float q1[8], q2[8], k1[8], k2[8], cs[8], sn[8];
              unpack8(*(const GAS v4u*)rq, q1); unpack8(*(const GAS v4u*)(rq + 32), q2); unpack8(*(const GAS v4u*)rk, k1); unpack8(*(const GAS v4u*)(rk + 32), k2);
              { const f32x4 a = *(const GAS f32x4*)(ct + pos * 32 + 8 * grp), bq = *(const GAS f32x4*)(ct + pos * 32 + 8 * grp + 4);
                cs[0] = a.x; cs[1] = a.y; cs[2] = a.z; cs[3] = a.w; cs[4] = bq.x; cs[5] = bq.y; cs[6] = bq.z; cs[7] = bq.w; }
              { const f32x4 a = *(const GAS f32x4*)(st + pos * 32 + 8 * grp), bq = *(const GAS f32x4*)(st + pos * 32 + 8 * grp + 4);
                sn[0] = a.x; sn[1] = a.y; sn[2] = a.z; sn[3] = a.w; sn[4] = bq.x; sn[5] = bq.y; sn[6] = bq.z; sn[7] = bq.w; }
              const float gq = exp2f((float)(s + 1) * lg), gk = 0.125f * exp2f(-(float)(s + 1) * lg);
              float qa[8], qb[8], ka[8], kb[8];
#pragma unroll
              for (int j = 0; j < 8; ++j) { qa[j] = (q1[j] * cs[j] - q2[j] * sn[j]) * gq; qb[j] = (q2[j] * cs[j] + q1[j] * sn[j]) * gq;
                                            ka[j] = (k1[j] * cs[j] - k2[j] * sn[j]) * gk; kb[j] = (k2[j] * cs[j] + k1[j] * sn[j]) * gk; }
              *(LAS v4u*)(lds + O_QP + s * 144 + 16 * grp) = pack8(qa); *(LAS v4u*)(lds + O_QP + s * 144 + 64 + 16 * grp) = pack8(qb);
              *(LAS v4u*)(lds + O_KP + s * 144 + 16 * grp) = pack8(ka); *(LAS v4u*)(lds + O_KP + s * 144 + 64 + 16 * grp) = pack8(kb); }
#pragma unroll
            for (int i = 0; i < 4; ++i) { const int task = tid + 512 * i, e8 = task >> 7, s = task & 127;
                const v4u w = *(const GAS v4u*)(H0 + (t0 + s) * AB_IN + 1024 + h * 128 + 8 * e8);
                LAS bf16* d = (LAS bf16*)(lds + O_VT + (8 * e8) * 272 + 2 * s);
                d[0 * 136] = (bf16)(w.x & 0xffffu); d[1 * 136] = (bf16)(w.x >> 16); d[2 * 136] = (bf16)(w.y & 0xffffu); d[3 * 136] = (bf16)(w.y >> 16);
                d[4 * 136] = (bf16)(w.z & 0xffffu); d[5 * 136] = (bf16)(w.z >> 16); d[6 * 136] = (bf16)(w.w & 0xffffu); d[7 * 136] = (bf16)(w.w >> 16); }
            { const float* Sg = LST + (size_t)((b * 4 + h) * 32 + n) * 8192;
#pragma unroll
              for (int i = 0; i < 4; ++i) { const int task = tid + 512 * i, e4 = task >> 6, d = task & 63;
                  const f32x4 sv = *(const GAS f32x4*)(Sg + d * 128 + 4 * e4);
                  LAS bf16* o = (LAS bf16*)(lds + O_ST + (4 * e4) * 144 + 2 * d);
                  o[0 * 72] = (bf16)f2bf(sv.x); o[1 * 72] = (bf16)f2bf(sv.y); o[2 * 72] = (bf16)f2bf(sv.z); o[3 * 72] = (bf16)f2bf(sv.w); } }
            __syncthreads();
            bf16x8 qf[4];
#pragma unroll
            for (int ks = 0; ks < 4; ++ks) qf[ks] = *(const LAS bf16x8*)(lds + O_QP + (32 * cbk + c) * 144 + (16 * ks + 8 * hh) * 2);
            for (int sb = 0; sb <= cbk; ++sb) {
                f32x16 sc;
#pragma unroll
                for (int r = 0; r < 16; ++r) sc[r] = 0.f;
#pragma unroll
                for (int ks = 0; ks < 4; ++ks) { const bf16x8 kf = *(const LAS bf16x8*)(lds + O_KP + (32 * sb + c) * 144 + (16 * ks + 8 * hh) * 2);
                    sc = __builtin_amdgcn_mfma_f32_32x32x16_bf16(kf, qf[ks], sc, 0, 0, 0); }
#pragma unroll
                for (int g4 = 0; g4 < 4; ++g4) { float m[4];
#pragma unroll
                    for (int q = 0; q < 4; ++q) { const float sv = sc[4 * g4 + q]; m[q] = (sb < cbk || 8 * g4 + 4 * hh + q <= c) ? sv : 0.f; }
                    *(LAS v2u*)(lds + O_PI + cbk * 8704 + c * 272 + (32 * sb + 8 * g4 + 4 * hh) * 2) = (v2u){pk2(m[0], m[1]), pk2(m[2], m[3])}; }
            }
            f32x16 acc[2];
#pragma unroll
            for (int j = 0; j < 2; ++j) {
#pragma unroll
                for (int r = 0; r < 16; ++r) acc[j][r] = 0.f;
                const int eb = 2 * eh + j;
                for (int sb = 0; sb <= cbk; ++sb) {
#pragma unroll
                    for (int ks = 0; ks < 2; ++ks) { const bf16x8 af = *(const LAS bf16x8*)(lds + O_VT + (32 * eb + c) * 272 + (32 * sb + 16 * ks + 8 * hh) * 2);
                        const bf16x8 pf = *(const LAS bf16x8*)(lds + O_PI + cbk * 8704 + c * 272 + (32 * sb + 16 * ks + 8 * hh) * 2);
                        acc[j] = __builtin_amdgcn_mfma_f32_32x32x16_bf16(af, pf, acc[j], 0, 0, 0); }
                }
#pragma unroll
                for (int ks = 0; ks < 4; ++ks) { const bf16x8 sf = *(const LAS bf16x8*)(lds + O_ST + (32 * eb + c) * 144 + (16 * ks + 8 * hh) * 2);
                    acc[j] = __builtin_amdgcn_mfma_f32_32x32x16_bf16(sf, qf[ks], acc[j], 0, 0, 0); }
            }
            float sum = 0.f, sq = 0.f;
#pragma unroll
            for (int j = 0; j < 2; ++j)
#pragma unroll
                for (int r = 0; r < 16; ++r) { const float ov = acc[j][r]; sum += ov; sq += ov * ov; }
            sum += __shfl_xor(sum, 32); sq += __shfl_xor(sq, 32);
            LAS float* red = (LAS float*)(lds + O_RED);
            if (hh == 0) { red[(eh * 128 + 32 * cbk + c) * 2] = sum; red[(eh * 128 + 32 * cbk + c) * 2 + 1] = sq; }
            __syncthreads();
            sum += red[((eh ^ 1) * 128 + 32 * cbk + c) * 2]; sq += red[((eh ^ 1) * 128 + 32 * cbk + c) * 2 + 1];
            const float mean = sum * (1.f / 128.f); const float var = fmaxf(sq * (1.f / 128.f) - mean * mean, 0.f);
            const float rstd = 1.f / sqrtf(var + LN_EPS);
            { const size_t row = t0 + 32 * cbk + c;
#pragma unroll
              for (int j = 0; j < 2; ++j)
#pragma unroll
                  for (int g4 = 0; g4 < 4; ++g4) { const int e = 32 * (2 * eh + j) + 8 * g4 + 4 * hh;
                      const v2u gw2 = *(const GAS v2u*)(H0 + row * AB_IN + 1536 + h * 128 + e); const f32x4 gm = *(const GAS f32x4*)(ret_g + h * 128 + e);
                      const float g0 = bflo(gw2.x), g1 = bfhi(gw2.x), g2 = bflo(gw2.y), g3 = bfhi(gw2.y);
                      const float o0 = acc[j][4 * g4 + 0], o1 = acc[j][4 * g4 + 1], o2 = acc[j][4 * g4 + 2], o3 = acc[j][4 * g4 + 3];
                      const float y0 = (o0 - mean) * rstd * gm.x * (g0 / (1.f + __expf(-g0))), y1 = (o1 - mean) * rstd * gm.y * (g1 / (1.f + __expf(-g1)));
                      const float y2 = (o2 - mean) * rstd * gm.z * (g2 / (1.f + __expf(-g2))), y3 = (o3 - mean) * rstd * gm.w * (g3 / (1.f + __expf(-g3)));
                      *(GAS v2u*)(Y + row * D + 512 + h * 128 + e) = (v2u){pk2(y0, y1), pk2(y2, y3)}; } }
        }
        for (int gi = 0; gi < 4; ++gi) {
            const int w = 2 << gi;
            __syncthreads();
#pragma unroll
            for (int i = 0; i < 4; ++i) { const int task = tid + 512 * i, t = task >> 4, c8 = task & 15, pos = n * 128 + t; const int cnt = (pos + 1 < w) ? pos + 1 : w;
                const bf16* ur = H0 + (t0 + t) * AB_IN + gi * 128 + 8 * c8;
                float u0[8], sm[8]; unpack8(*(const GAS v4u*)ur, u0);
#pragma unroll
                for (int q = 0; q < 8; ++q) sm[q] = u0[q];
                for (int j = 1; j < cnt; ++j) { float uj[8]; unpack8(*(const GAS v4u*)(ur - (size_t)j * AB_IN), uj);
#pragma unroll
                    for (int q = 0; q < 8; ++q) sm[q] += uj[q]; }
                const float ic = 1.f / (float)cnt; float pv[8];
#pragma unroll
                for (int q = 0; q < 8; ++q) pv[q] = sm[q] * ic - u0[q];
                *(LAS v4u*)(lds + O_PT + t * 272 + 16 * c8) = pack8(pv); }
#pragma unroll
            for (int i = 0; i < 4; ++i) { const int piece = tid + 512 * i, d = piece >> 4, c16 = piece & 15;
                *(LAS v4u*)(lds + O_WT + d * 272 + 16 * c16) = *(const GAS v4u*)(PWT + (size_t)(gi * 128 + d) * 128 + 8 * c16); }
            __syncthreads();
            bf16x8 pfr[8];
#pragma unroll
            for (int ks = 0; ks < 8; ++ks) pfr[ks] = *(const LAS bf16x8*)(lds + O_PT + (32 * cbk + c) * 272 + (16 * ks + 8 * hh) * 2);
#pragma unroll
            for (int j = 0; j < 2; ++j) { const int db = 2 * eh + j;
                f32x16 a2;
#pragma unroll
                for (int r = 0; r < 16; ++r) a2[r] = 0.f;
#pragma unroll
                for (int ks = 0; ks < 8; ++ks) { const bf16x8 wf = *(const LAS bf16x8*)(lds + O_WT + (32 * db + c) * 272 + (16 * ks + 8 * hh) * 2);
                    a2 = __builtin_amdgcn_mfma_f32_32x32x16_bf16(wf, pfr[ks], a2, 0, 0, 0); }
#pragma unroll
                for (int g4 = 0; g4 < 4; ++g4) { const int d0 = 32 * db + 8 * g4 + 4 * hh; const f32x4 ps = *(const GAS f32x4*)(pool_scale + gi * 128 + d0);
                    const float y0 = a2[4 * g4 + 0] * ps.x, y1 = a2[4 * g4 + 1] * ps.y, y2 = a2[4 * g4 + 2] * ps.z, y3 = a2[4 * g4 + 3] * ps.w;
                    *(GAS v2u*)(Y + (t0 + 32 * cbk + c) * D + gi * 128 + d0) = (v2u){pk2(y0, y1), pk2(y2, y3)}; }
            }
        }
    }
    __syncthreads();
}
__device__ __forceinline__ void phase_ln(const float* Z, bf16* O, const float* g, const float* bb) {
    const int tid = threadIdx.x, lane = tid & 63, wave = tid >> 6;
    const int gw = blockIdx.x * NWAVES + wave, NGW = gridDim.x * NWAVES;
    for (int m = gw; m < T; m += NGW) {
        const GAS f32x4* zr = (const GAS f32x4*)(Z + (size_t)m * D) + lane;
        f32x4 v[4]; float s = 0.f;
#pragma unroll
        for (int j = 0; j < 4; ++j) { v[j] = zr[64 * j]; s += (v[j].x + v[j].y) + (v[j].z + v[j].w); }
        const float mean = wave_sum(s) * (1.f / D); float s2 = 0.f;
#pragma unroll
        for (int j = 0; j < 4; ++j) { v[j] = v[j] - mean; s2 += (v[j].x * v[j].x + v[j].y * v[j].y) + (v[j].z * v[j].z + v[j].w * v[j].w); }
        const float rstd = 1.f / sqrtf(wave_sum(s2) * (1.f / D) + LN_EPS);
        GAS v2u* o8 = (GAS v2u*)(O + (size_t)m * D) + lane;
#pragma unroll
        for (int j = 0; j < 4; ++j) { const f32x4 gg = *((const GAS f32x4*)g + lane + 64 * j), b4 = *((const GAS f32x4*)bb + lane + 64 * j);
            v2u o; o.x = pk2(v[j].x * rstd * gg.x + b4.x, v[j].y * rstd * gg.y + b4.y); o.y = pk2(v[j].z * rstd * gg.z + b4.z, v[j].w * rstd * gg.w + b4.w); o8[64 * j] = o; }
    }
}
__device__ __forceinline__ void wave_argmax(float& bv, int& bi) {
#pragma unroll
    for (int off = 32; off >= 1; off >>= 1) { const float ov = __shfl_xor(bv, off); const int oi = __shfl_xor(bi, off);
        if (ov > bv || (ov == bv && oi < bi)) { bv = ov; bi = oi; } }
}
__device__ __forceinline__ void phase_topk(LAS unsigned char* lds, const bf16* Q, const float* keys  , int* EID, float* GATE) {
    const int tid = threadIdx.x, lane = tid & 63, wave = tid >> 6;
    LAS float* kl = (LAS float*)lds;
    LAS float* qt = (LAS float*)(lds + 66048);
    LAS float* sc = (LAS float*)(lds + 82560);
    for (int item = blockIdx.x; item < (T / 32) * 8; item += gridDim.x) {
        const int h = item & 7, tile = item >> 3; const size_t tok0 = (size_t)tile * 32;
        for (int p = 0; p < 2; ++p) {
            const float* kg = keys + (size_t)((h * 2 + p) * 128) * 128;
            for (int idx = tid; idx < 16384; idx += NTHR) { const int k = idx >> 7, d = idx & 127; kl[k * 129 + d] = kg[idx]; }
            for (int idx = tid; idx < 4096; idx += NTHR) { const int t = idx >> 7, d = idx & 127; qt[t * 129 + d] = bf2f(Q[(tok0 + t) * 2048 + h * 256 + p * 128 + d]); }
            __syncthreads();
            { const int t = tid >> 4, kg16 = tid & 15;
              for (int jj = 0; jj < 8; ++jj) { const int k = kg16 + 16 * jj; float dot = 0.f;
#pragma unroll 16
                  for (int d = 0; d < 128; ++d) dot += qt[t * 129 + d] * kl[k * 129 + d];
                  sc[(t * 2 + p) * 128 + k] = dot; } }
            __syncthreads();
        }
        for (int tt = 0; tt < 4; ++tt) {
            const int t = wave * 4 + tt;
            float tv[2]; int ti[2];
#pragma unroll
            for (int p = 0; p < 2; ++p) {
                float v0 = sc[(t * 2 + p) * 128 + lane], v1 = sc[(t * 2 + p) * 128 + lane + 64];
                float mv = 0.f; int mi = 0;
                for (int j = 0; j < 16; ++j) {
                    float bv; int bi; if (v0 >= v1) { bv = v0; bi = lane; } else { bv = v1; bi = lane + 64; }
                    wave_argmax(bv, bi);
                    if (lane == j) { mv = bv; mi = bi; }
                    if (bi == lane) v0 = -INFINITY; if (bi == lane + 64) v1 = -INFINITY;
                }
                tv[p] = mv; ti[p] = mi;
            }
            float cv[4];
#pragma unroll
            for (int m = 0; m < 4; ++m) { const int cidx = lane + 64 * m; cv[m] = __shfl(tv[0], cidx >> 4) + __shfl(tv[1], cidx & 15); }
            float bestv = 0.f; int bestc = 0;
            for (int j = 0; j < 16; ++j) {
                float bv = cv[0]; int bi = lane;
#pragma unroll
                for (int m = 1; m < 4; ++m) if (cv[m] > bv) { bv = cv[m]; bi = lane + 64 * m; }
                wave_argmax(bv, bi);
                if (lane == j) { bestv = bv; bestc = bi; }
#pragma unroll
                for (int m = 0; m < 4; ++m) if (bi == lane + 64 * m) cv[m] = -INFINITY;
            }
            const float mx = __shfl(bestv, 0);
            const float ex = (lane < 16) ? expf(bestv - mx) : 0.f;
            const float den = wave_sum(ex);
            const int ia = __shfl(ti[0], bestc >> 4), ib = __shfl(ti[1], bestc & 15);
            if (lane < 16) { const size_t o = (tok0 + t) * 128 + h * 16 + lane; EID[o] = ia * 128 + ib; GATE[o] = ex / den; }
        }
        __syncthreads();
    }
}

#define CEF_D(a, b) { const float hi_ = fmaxf((a), (b)), lo_ = fminf((a), (b)); (a) = hi_; (b) = lo_; }
#define CEF_A(a, b) { const float hi_ = fmaxf((a), (b)), lo_ = fminf((a), (b)); (a) = lo_; (b) = hi_; }
#define CEP_D(ka, pa, kb, pb) { const bool sw_ = (kb) > (ka); const float k0_ = sw_ ? (kb) : (ka), k1_ = sw_ ? (ka) : (kb); const int p0_ = sw_ ? (pb) : (pa), p1_ = sw_ ? (pa) : (pb); (ka) = k0_; (kb) = k1_; (pa) = p0_; (pb) = p1_; }
template <int OFF, int NV> __device__ __forceinline__ void bsort16_desc(float (&v)[NV]) {
#pragma unroll
    for (int k = 2; k <= 16; k <<= 1) {
#pragma unroll
        for (int j = k >> 1; j > 0; j >>= 1) {
#pragma unroll
            for (int i = 0; i < 16; ++i) { const int l = i ^ j;
                if (l > i) { if ((i & k) == 0) CEF_D(v[OFF + i], v[OFF + l]) else CEF_A(v[OFF + i], v[OFF + l]) } }
        }
    }
}
template <int OA, int NV> __device__ __forceinline__ void bmerge16_desc(float (&v)[NV]) {
#pragma unroll
    for (int j = 8; j > 0; j >>= 1) {
#pragma unroll
        for (int i = 0; i < 16; ++i) { const int l = i ^ j; if (l > i) CEF_D(v[OA + i], v[OA + l]) }
    }
}
template <int OA, int OB, int NV> __device__ __forceinline__ void merge_top16(float (&v)[NV]) {
#pragma unroll
    for (int i = 0; i < 16; ++i) v[OA + i] = fmaxf(v[OA + i], v[OB + 15 - i]);
    bmerge16_desc<OA, NV>(v);
}
template <int OFF, int NV> __device__ __forceinline__ void bsort16p_desc(float (&v)[NV], int (&q)[NV]) {
#pragma unroll
    for (int k = 2; k <= 16; k <<= 1) {
#pragma unroll
        for (int j = k >> 1; j > 0; j >>= 1) {
#pragma unroll
            for (int i = 0; i < 16; ++i) { const int l = i ^ j;
                if (l > i) { if ((i & k) == 0) CEP_D(v[OFF + i], q[OFF + i], v[OFF + l], q[OFF + l]) else CEP_D(v[OFF + l], q[OFF + l], v[OFF + i], q[OFF + i]) } }
        }
    }
}
template <int OA, int NV> __device__ __forceinline__ void bmerge16p_desc(float (&v)[NV], int (&q)[NV]) {
#pragma unroll
    for (int j = 8; j > 0; j >>= 1) {
#pragma unroll
        for (int i = 0; i < 16; ++i) { const int l = i ^ j; if (l > i) CEP_D(v[OA + i], q[OA + i], v[OA + l], q[OA + l]) }
    }
}
__host__ __device__ constexpr int pair_i(int s) { return s < 16 ? 0 : s < 24 ? 1 : s < 29 ? 2 : s < 33 ? 3 : s < 36 ? 4 : s < 38 ? 5 : s < 40 ? 6 : s < 42 ? 7 : (s - 42 + 8); }
__host__ __device__ constexpr int pair_j(int s) { return s < 16 ? s : s < 24 ? s - 16 : s < 29 ? s - 24 : s < 33 ? s - 29 : s < 36 ? s - 33 : s < 38 ? s - 36 : s < 40 ? s - 38 : s < 42 ? s - 40 : 0; }
__device__ __forceinline__ void phase_topk_fast(LAS unsigned char* lds, const bf16* Q, const bf16* keysb  , int* EID, float* GATE) {
    const int tid = threadIdx.x, lane = tid & 63, wave = __builtin_amdgcn_readfirstlane(tid >> 6);
    const int c = lane & 31, hh = lane >> 5;
    for (int hi = blockIdx.x; hi < 256; hi += gridDim.x) {
        const int h = hi & 7, rank = hi >> 3;
        __syncthreads();
        for (int idx = tid; idx < 2 * 128 * 16; idx += NTHR) { const int rowi = idx >> 4, ch = idx & 15;
            const v4u kv = *(const GAS v4u*)(keysb + (size_t)h * 32768 + rowi * 128 + ch * 8);
            *(LAS v4u*)(lds + rowi * 272 + ch * 16) = kv; }
        __syncthreads();
        for (int it = 0; it < 4; ++it) {
            const int tile = rank * 8 + wave + 256 * it;
            const size_t tok0 = (size_t)tile * 32;
            float ta[16], tb[16];
#pragma unroll
            for (int p = 0; p < 2; ++p) {
                bf16x8 bq[8];
                const bf16* qrow = Q + (tok0 + c) * 2048 + h * 256 + p * 128 + 8 * hh;
#pragma unroll
                for (int ks = 0; ks < 8; ++ks) bq[ks] = *(const GAS bf16x8*)(qrow + 16 * ks);
                f32x16 acc[4];
#pragma unroll
                for (int blk = 0; blk < 4; ++blk) {
#pragma unroll
                    for (int r = 0; r < 16; ++r) acc[blk][r] = 0.f;
#pragma unroll
                    for (int ks = 0; ks < 8; ++ks) { const bf16x8 a = *(const LAS bf16x8*)(lds + (p * 128 + 32 * blk + c) * 272 + (16 * ks + 8 * hh) * 2);
                        acc[blk] = __builtin_amdgcn_mfma_f32_32x32x16_bf16(a, bq[ks], acc[blk], 0, 0, 0); }
                }
                float v[64];
#pragma unroll
                for (int blk = 0; blk < 4; ++blk)
#pragma unroll
                    for (int r = 0; r < 16; ++r)
                    { const float sv = acc[blk][r]; v[blk * 16 + r] = __uint_as_float((__float_as_uint(sv) & ~127u) | (unsigned)(32 * blk + (r & 3) + 8 * (r >> 2)) | (unsigned)(hh << 2)); }
                __builtin_amdgcn_sched_barrier(0);
                bsort16_desc<0, 64>(v); bsort16_desc<16, 64>(v); bsort16_desc<32, 64>(v); bsort16_desc<48, 64>(v);
                merge_top16<0, 16, 64>(v); merge_top16<32, 48, 64>(v); merge_top16<0, 32, 64>(v);
                float o[16];
#pragma unroll
                for (int i = 0; i < 16; ++i) o[i] = __shfl_xor(v[i], 32);
#pragma unroll
                for (int i = 0; i < 16; ++i) v[i] = fmaxf(v[i], o[15 - i]);
                bmerge16_desc<0, 64>(v);
#pragma unroll
                for (int i = 0; i < 16; ++i) { if (p == 0) ta[i] = v[i]; else tb[i] = v[i]; }
                __builtin_amdgcn_sched_barrier(0);
            }
            float av[16], bv[16]; int ai[16], bi[16];
#pragma unroll
            for (int i = 0; i < 16; ++i) { const unsigned ua = __builtin_bit_cast(unsigned, ta[i]), ub = __builtin_bit_cast(unsigned, tb[i]);
                av[i] = __builtin_bit_cast(float, ua & ~127u); ai[i] = (int)(ua & 127u); bv[i] = __builtin_bit_cast(float, ub & ~127u); bi[i] = (int)(ub & 127u); }
            float ck[32]; int cp[32];
#pragma unroll
            for (int s2 = 0; s2 < 32; ++s2) {
                const float k0 = av[pair_i(s2)] + bv[pair_j(s2)]; const int p0 = (ai[pair_i(s2)] << 7) | bi[pair_j(s2)];
                float k1 = -INFINITY; int p1 = 0;
                if (s2 + 32 < 50) { k1 = av[pair_i(s2 + 32 < 50 ? s2 + 32 : 0)] + bv[pair_j(s2 + 32 < 50 ? s2 + 32 : 0)]; p1 = (ai[pair_i(s2 + 32 < 50 ? s2 + 32 : 0)] << 7) | bi[pair_j(s2 + 32 < 50 ? s2 + 32 : 0)]; }
                ck[s2] = hh ? k1 : k0; cp[s2] = hh ? p1 : p0;
            }
            __builtin_amdgcn_sched_barrier(0);
            bsort16p_desc<0, 32>(ck, cp); bsort16p_desc<16, 32>(ck, cp);
#pragma unroll
            for (int i = 0; i < 16; ++i) { if (ck[16 + 15 - i] > ck[i]) { ck[i] = ck[16 + 15 - i]; cp[i] = cp[16 + 15 - i]; } }
            bmerge16p_desc<0, 32>(ck, cp);
            { float ok[16]; int op[16];
#pragma unroll
              for (int i = 0; i < 16; ++i) { ok[i] = __shfl_xor(ck[i], 32); op[i] = __shfl_xor(cp[i], 32); }
#pragma unroll
              for (int i = 0; i < 16; ++i) { if (ok[15 - i] > ck[i]) { ck[i] = ok[15 - i]; cp[i] = op[15 - i]; } } }
            bmerge16p_desc<0, 32>(ck, cp);
            float ex[16]; float sum = 0.f;
#pragma unroll
            for (int i = 0; i < 16; ++i) { ex[i] = __expf(ck[i] - ck[0]); sum += ex[i]; }
            const float inv = 1.f / sum;
            if (hh == 0) {
                int* eo = EID + (tok0 + c) * 128 + h * 16; float* go = GATE + (tok0 + c) * 128 + h * 16;
#pragma unroll
                for (int i = 0; i < 4; ++i) { *(GAS v4u*)(eo + 4 * i) = (v4u){(unsigned)cp[4 * i], (unsigned)cp[4 * i + 1], (unsigned)cp[4 * i + 2], (unsigned)cp[4 * i + 3]};
                    *(GAS f32x4*)(go + 4 * i) = (f32x4){ex[4 * i] * inv, ex[4 * i + 1] * inv, ex[4 * i + 2] * inv, ex[4 * i + 3] * inv}; }
            }
        }
    }
    __syncthreads();
}
template <bool FINAL>
__device__ __forceinline__ void phase_gather(const bf16* X, const int* EID, const float* GATE, const float* U, const float* V, const float* g, const float* bb, bf16* Ob, float* Of) {
    const int tid = threadIdx.x, lane = tid & 63, wave = tid >> 6;
    const int gw = blockIdx.x * NWAVES + wave, NGW = gridDim.x * NWAVES;
    for (int t = gw; t < T; t += NGW) {
        f32x4 x[4], acc[4];
#pragma unroll
        for (int j = 0; j < 4; ++j) { const v2u w = *((const GAS v2u*)(X + (size_t)t * D) + lane + 64 * j);
            x[j] = (f32x4){bflo(w.x), bfhi(w.x), bflo(w.y), bfhi(w.y)}; acc[j] = (f32x4){0.f, 0.f, 0.f, 0.f}; }
        const int e0 = EID[(size_t)t * 128 + lane], e1 = EID[(size_t)t * 128 + 64 + lane];
        const float g0 = GATE[(size_t)t * 128 + lane], g1 = GATE[(size_t)t * 128 + 64 + lane];
#pragma unroll 2
        for (int k = 0; k < 128; ++k) {
            const int e = (k < 64) ? __shfl(e0, k) : __shfl(e1, k - 64);
            const float gt = (k < 64) ? __shfl(g0, k) : __shfl(g1, k - 64);
            const GAS f32x4* ur = (const GAS f32x4*)(U + (size_t)e * D) + lane;
            float dot = 0.f;
#pragma unroll
            for (int j = 0; j < 4; ++j) { const f32x4 u = ur[64 * j]; dot += (x[j].x * u.x + x[j].y * u.y) + (x[j].z * u.z + x[j].w * u.w); }
            dot = wave_sum(dot);
            const float a = 0.5f * dot * (1.f + erff(dot * 0.70710678118654752f));
            const float cf = gt * a;
            const GAS f32x4* vr = (const GAS f32x4*)(V + (size_t)e * D) + lane;
#pragma unroll
            for (int j = 0; j < 4; ++j) { const f32x4 v = vr[64 * j]; acc[j] += cf * v; }
        }
        float s = 0.f;
#pragma unroll
        for (int j = 0; j < 4; ++j) { acc[j] = ALPHA * x[j] + acc[j]; s += (acc[j].x + acc[j].y) + (acc[j].z + acc[j].w); }
        const float mean = wave_sum(s) * (1.f / D); float s2 = 0.f;
#pragma unroll
        for (int j = 0; j < 4; ++j) { acc[j] = acc[j] - mean; s2 += (acc[j].x * acc[j].x + acc[j].y * acc[j].y) + (acc[j].z * acc[j].z + acc[j].w * acc[j].w); }
        const float rstd = 1.f / sqrtf(wave_sum(s2) * (1.f / D) + LN_EPS);
#pragma unroll
        for (int j = 0; j < 4; ++j) { const f32x4 gg = *((const GAS f32x4*)g + lane + 64 * j), b4 = *((const GAS f32x4*)bb + lane + 64 * j);
            const f32x4 o = acc[j] * rstd * gg + b4;
            if (FINAL) *((GAS f32x4*)(Of + (size_t)t * D) + lane + 64 * j) = o;
            else { v2u w; w.x = pk2(o.x, o.y); w.y = pk2(o.z, o.w); *((GAS v2u*)(Ob + (size_t)t * D) + lane + 64 * j) = w; } }
    }
}

typedef float f32x2 __attribute__((ext_vector_type(2)));
__device__ __forceinline__ void phase_convert_tables(const float* U, const float* V, unsigned char* ws) {
    const int tid = threadIdx.x, lane = tid & 63, wave = tid >> 6;
    const int gw = blockIdx.x * NWAVES + wave, NGW = gridDim.x * NWAVES;
    for (int row = gw; row < 4 * NEXP; row += NGW) {
        const bool isv = row >= 2 * NEXP; const int r = row & (2 * NEXP - 1);
        const GAS f32x4* src = (const GAS f32x4*)((isv ? V : U) + (size_t)r * D) + lane;
        f32x4 v[4]; float m = 0.f;
#pragma unroll
        for (int j = 0; j < 4; ++j) { v[j] = src[64 * j]; m = fmaxf(fmaxf(m, fmaxf(fabsf(v[j].x), fabsf(v[j].y))), fmaxf(fabsf(v[j].z), fabsf(v[j].w))); }
#pragma unroll
        for (int o = 1; o < 64; o <<= 1) m = fmaxf(m, __shfl_xor(m, o));
        m = fmaxf(m, 1e-30f);
        const float sc = 400.f / m;
        v4u w;
        { int t0 = __builtin_amdgcn_cvt_pk_fp8_f32(v[0].x * sc, v[0].y * sc, 0, false); t0 = __builtin_amdgcn_cvt_pk_fp8_f32(v[0].z * sc, v[0].w * sc, t0, true); w.x = (unsigned)t0; }
        { int t0 = __builtin_amdgcn_cvt_pk_fp8_f32(v[1].x * sc, v[1].y * sc, 0, false); t0 = __builtin_amdgcn_cvt_pk_fp8_f32(v[1].z * sc, v[1].w * sc, t0, true); w.y = (unsigned)t0; }
        { int t0 = __builtin_amdgcn_cvt_pk_fp8_f32(v[2].x * sc, v[2].y * sc, 0, false); t0 = __builtin_amdgcn_cvt_pk_fp8_f32(v[2].z * sc, v[2].w * sc, t0, true); w.z = (unsigned)t0; }
        { int t0 = __builtin_amdgcn_cvt_pk_fp8_f32(v[3].x * sc, v[3].y * sc, 0, false); t0 = __builtin_amdgcn_cvt_pk_fp8_f32(v[3].z * sc, v[3].w * sc, t0, true); w.w = (unsigned)t0; }
        *((GAS v4u*)(ws + (isv ? WS_V8 : WS_U8) + (size_t)r * 1024) + lane) = w;
        if (lane == 0) ((float*)(ws + (isv ? WS_DQV : WS_DQU)))[r] = m * (1.f / 400.f);
    }
}
__host__ __device__ constexpr int rev4(int i) { return ((i & 1) << 3) | ((i & 2) << 1) | ((i & 4) >> 1) | ((i & 8) >> 3); }
#define FMA2(a, b, c) __builtin_elementwise_fma((a), (b), (c))
#define CVT8(w, hi) __builtin_amdgcn_cvt_pk_f32_fp8((int)(w), (hi))
template <bool FINAL, int MODE  >
__device__ __forceinline__ void phase_gather8(const bf16* X, const int* EID, float* GATE, const unsigned char* U8, const unsigned char* V8, const float* DQU, const float* DQV,
                                              const float* g, const float* bb, bf16* Ob, float* Of) {
    const int tid = threadIdx.x, lane = tid & 63, wave = tid >> 6;
    const int gw = blockIdx.x * NWAVES + wave, NGW = gridDim.x * NWAVES;
    const bool b0 = (lane & 1) != 0, b1 = (lane & 2) != 0, b2 = (lane & 4) != 0, b3 = (lane & 8) != 0; const int myrow = lane >> 4;
    for (int t = gw; t < T; t += NGW) {
        f32x2 x[8];
#pragma unroll
        for (int j = 0; j < 4; ++j) { const v2u w = *((const GAS v2u*)(X + (size_t)t * D) + lane + 64 * j);
            x[2 * j] = (f32x2){bflo(w.x), bfhi(w.x)}; x[2 * j + 1] = (f32x2){bflo(w.y), bfhi(w.y)}; }
        const int e0 = EID[(size_t)t * 128 + lane], e1 = EID[(size_t)t * 128 + 64 + lane];
        const float gt0 = GATE[(size_t)t * 128 + lane], gt1 = GATE[(size_t)t * 128 + 64 + lane];
        const float dqu0 = DQU[e0], dqu1 = DQU[e1], dqv0 = DQV[e0], dqv1 = DQV[e1];
        float act0 = 0.f, act1 = 0.f;
        if (MODE != 2) {
#pragma unroll
        for (int r = 0; r < 2; ++r) {
            const int er = r ? e1 : e0;
            for (int row = 0; row < 4; ++row) {
                v4u w[16];
#pragma unroll
                for (int i = 0; i < 16; ++i) { const int e = __builtin_amdgcn_readlane(er, row * 16 + rev4(i)); w[i] = *((const GAS v4u*)(U8 + (size_t)e * 1024) + lane); }
                float p[16];
#pragma unroll
                for (int i = 0; i < 16; ++i) { f32x2 a = (f32x2){0.f, 0.f};
                    a = FMA2(x[0], CVT8(w[i].x, false), a); a = FMA2(x[1], CVT8(w[i].x, true), a);
                    a = FMA2(x[2], CVT8(w[i].y, false), a); a = FMA2(x[3], CVT8(w[i].y, true), a);
                    a = FMA2(x[4], CVT8(w[i].z, false), a); a = FMA2(x[5], CVT8(w[i].z, true), a);
                    a = FMA2(x[6], CVT8(w[i].w, false), a); a = FMA2(x[7], CVT8(w[i].w, true), a);
                    p[i] = a.x + a.y; }
                float r8[8], r4[4], r2[2];
#pragma unroll
                for (int i = 0; i < 8; ++i) { const float keep = b0 ? p[8 + i] : p[i], send = b0 ? p[i] : p[8 + i]; r8[i] = keep + __shfl_xor(send, 1); }
#pragma unroll
                for (int i = 0; i < 4; ++i) { const float keep = b1 ? r8[4 + i] : r8[i], send = b1 ? r8[i] : r8[4 + i]; r4[i] = keep + __shfl_xor(send, 2); }
#pragma unroll
                for (int i = 0; i < 2; ++i) { const float keep = b2 ? r4[2 + i] : r4[i], send = b2 ? r4[i] : r4[2 + i]; r2[i] = keep + __shfl_xor(send, 4); }
                float r1 = (b3 ? r2[1] : r2[0]) + __shfl_xor(b3 ? r2[0] : r2[1], 8);
                r1 += __shfl_xor(r1, 16); r1 += __shfl_xor(r1, 32);
                if (myrow == row) { if (r == 0) act0 = r1; else act1 = r1; }
            }
        }
        }
        float c0, c1;
        if (MODE != 2) { const float a0 = act0 * dqu0, a1 = act1 * dqu1;
          c0 = gt0 * (0.5f * a0 * (1.f + erff(a0 * 0.70710678118654752f))) * dqv0;
          c1 = gt1 * (0.5f * a1 * (1.f + erff(a1 * 0.70710678118654752f))) * dqv1; }
        else { c0 = gt0; c1 = gt1; }
        if (MODE == 1) { GATE[(size_t)t * 128 + lane] = c0; GATE[(size_t)t * 128 + 64 + lane] = c1; continue; }
        f32x2 acc[8];
#pragma unroll
        for (int j = 0; j < 8; ++j) acc[j] = (f32x2){0.f, 0.f};
#pragma unroll
        for (int r = 0; r < 2; ++r) {
            const int er = r ? e1 : e0; const int cr = __builtin_bit_cast(int, r ? c1 : c0);
            for (int row = 0; row < 4; ++row) {
                v4u w[16];
#pragma unroll
                for (int i = 0; i < 16; ++i) { const int e = __builtin_amdgcn_readlane(er, row * 16 + i); w[i] = *((const GAS v4u*)(V8 + (size_t)e * 1024) + lane); }
#pragma unroll
                for (int i = 0; i < 16; ++i) { const float cf = __builtin_bit_cast(float, __builtin_amdgcn_readlane(cr, row * 16 + i)); const f32x2 c2 = (f32x2){cf, cf};
                    acc[0] = FMA2(c2, CVT8(w[i].x, false), acc[0]); acc[1] = FMA2(c2, CVT8(w[i].x, true), acc[1]);
                    acc[2] = FMA2(c2, CVT8(w[i].y, false), acc[2]); acc[3] = FMA2(c2, CVT8(w[i].y, true), acc[3]);
                    acc[4] = FMA2(c2, CVT8(w[i].z, false), acc[4]); acc[5] = FMA2(c2, CVT8(w[i].z, true), acc[5]);
                    acc[6] = FMA2(c2, CVT8(w[i].w, false), acc[6]); acc[7] = FMA2(c2, CVT8(w[i].w, true), acc[7]); }
            }
        }
        float s = 0.f;
#pragma unroll
        for (int j = 0; j < 8; ++j) { acc[j] = x[j] * ALPHA + acc[j]; s += acc[j].x + acc[j].y; }
        const float mean = wave_sum(s) * (1.f / D); float s2 = 0.f;
#pragma unroll
        for (int j = 0; j < 8; ++j) { acc[j] = acc[j] - mean; s2 += acc[j].x * acc[j].x + acc[j].y * acc[j].y; }
        const float rstd = 1.f / sqrtf(wave_sum(s2) * (1.f / D) + LN_EPS);
#pragma unroll
        for (int j = 0; j < 4; ++j) { const f32x4 gg = *((const GAS f32x4*)g + lane + 64 * j), b4 = *((const GAS f32x4*)bb + lane + 64 * j);
            const f32x4 o = (f32x4){acc[2 * j].x, acc[2 * j].y, acc[2 * j + 1].x, acc[2 * j + 1].y} * rstd * gg + b4;
            if (FINAL) *((GAS f32x4*)(Of + (size_t)t * D) + lane + 64 * j) = o;
            else { v2u w; w.x = pk2(o.x, o.y); w.y = pk2(o.z, o.w); *((GAS v2u*)(Ob + (size_t)t * D) + lane + 64 * j) = w; } }
    }
}
__device__ __forceinline__ void phase_hgrn(LAS unsigned char* lds, unsigned char* ws) {
    const int tid = threadIdx.x;
    const bf16* CQ = (const bf16*)(ws + WS_CQ); const bf16* CK = (const bf16*)(ws + WS_CK); const bf16* CV = (const bf16*)(ws + WS_CV); bf16* O = (bf16*)(ws + WS_O);
    LAS float* fL = (LAS float*)lds;
    LAS float* kL = fL + 4096; LAS float* qL = kL + 4096;
    LAS float* vL = qL + 4096;
    LAS float* part = vL + 1024;
    for (int item = blockIdx.x; item < 256; item += gridDim.x) {
        const int es = item & 3, h = (item >> 2) & 7, b = item >> 5;
        const int e = tid & 31, dg = tid >> 5;
        float S[8];
#pragma unroll
        for (int j = 0; j < 8; ++j) S[j] = 0.f;
        for (int blk = 0; blk < SEQ / 32; ++blk) {
            const size_t t0 = (size_t)b * SEQ + blk * 32;
            for (int idx = tid; idx < 4096; idx += NTHR) { const int s = idx >> 7, d = idx & 127; const size_t o = (t0 + s) * D + h * 128 + d;
                const float kk = bf2f(CK[o]); kL[idx] = kk; fL[idx] = 1.f - kk; qL[idx] = bf2f(CQ[o]); }
            for (int idx = tid; idx < 1024; idx += NTHR) { const int s = idx >> 5, ee = idx & 31; vL[idx] = bf2f(CV[(t0 + s) * D + h * 128 + es * 32 + ee]); }
            __syncthreads();
            for (int s = 0; s < 32; ++s) { const float v = vL[s * 32 + e]; float po = 0.f;
#pragma unroll
                for (int j = 0; j < 8; ++j) { const int d = dg * 8 + j; S[j] = fL[s * 128 + d] * S[j] + kL[s * 128 + d] * v; po += qL[s * 128 + d] * S[j]; }
                part[(s * 16 + dg) * 32 + e] = po; }
            __syncthreads();
            for (int idx = tid; idx < 1024; idx += NTHR) { const int s = idx >> 5, ee = idx & 31; float o = 0.f;
#pragma unroll
                for (int g = 0; g < 16; ++g) o += part[(s * 16 + g) * 32 + ee];
                O[(t0 + s) * D + h * 128 + es * 32 + ee] = (bf16)f2bf(o); }
            __syncthreads();
        }
    }
}

__device__ __forceinline__ void phase_hgrn_prep(unsigned char* ws, float* scratch  ) {
    const int tid = threadIdx.x, lane = tid & 63, wave = tid >> 6;
    const int gw = blockIdx.x * NWAVES + wave, NGW = gridDim.x * NWAVES;
    bf16* CQ = (bf16*)(ws + WS_CQ); bf16* CK = (bf16*)(ws + WS_CK); const bf16* CV = (const bf16*)(ws + WS_CV);
    bf16* KOT = (bf16*)scratch; bf16* VT = (bf16*)scratch + (size_t)T * D; float* DEC = (float*)(ws + WS_DEC);
    for (int item = gw; item < 1024 * 8; item += NGW) {
        const int g = item >> 3, h = item & 7; const size_t t0 = (size_t)g * 32;
        float k0[32], k1[32], b0[32], b1[32]; float c0 = 0.f, c1 = 0.f;
#pragma unroll
        for (int s2 = 0; s2 < 32; ++s2) { const size_t o = (t0 + s2) * D + h * 128 + 2 * lane;
            const unsigned kw = *(const GAS unsigned*)(CK + o), qw = *(const GAS unsigned*)(CQ + o);
            const float ka = bflo(kw), kb = bfhi(kw);
            c0 += __logf(1.f - ka); c1 += __logf(1.f - kb);
            k0[s2] = ka; k1[s2] = kb; b0[s2] = c0; b1[s2] = c1;
            *(GAS unsigned*)(CQ + o) = pk2(bflo(qw) * __expf(c0), bfhi(qw) * __expf(c1));
            *(GAS unsigned*)(CK + o) = pk2(ka * __expf(-c0), kb * __expf(-c1)); }
        { GAS v4u* r0 = (GAS v4u*)(KOT + ((size_t)g * 1024 + h * 128 + 2 * lane) * 32);
#pragma unroll
          for (int j = 0; j < 4; ++j) { v4u w;
              w.x = pk2(k0[8 * j + 0] * __expf(c0 - b0[8 * j + 0]), k0[8 * j + 1] * __expf(c0 - b0[8 * j + 1])); w.y = pk2(k0[8 * j + 2] * __expf(c0 - b0[8 * j + 2]), k0[8 * j + 3] * __expf(c0 - b0[8 * j + 3]));
              w.z = pk2(k0[8 * j + 4] * __expf(c0 - b0[8 * j + 4]), k0[8 * j + 5] * __expf(c0 - b0[8 * j + 5])); w.w = pk2(k0[8 * j + 6] * __expf(c0 - b0[8 * j + 6]), k0[8 * j + 7] * __expf(c0 - b0[8 * j + 7]));
              r0[j] = w; }
#pragma unroll
          for (int j = 0; j < 4; ++j) { v4u w;
              w.x = pk2(k1[8 * j + 0] * __expf(c1 - b1[8 * j + 0]), k1[8 * j + 1] * __expf(c1 - b1[8 * j + 1])); w.y = pk2(k1[8 * j + 2] * __expf(c1 - b1[8 * j + 2]), k1[8 * j + 3] * __expf(c1 - b1[8 * j + 3]));
              w.z = pk2(k1[8 * j + 4] * __expf(c1 - b1[8 * j + 4]), k1[8 * j + 5] * __expf(c1 - b1[8 * j + 5])); w.w = pk2(k1[8 * j + 6] * __expf(c1 - b1[8 * j + 6]), k1[8 * j + 7] * __expf(c1 - b1[8 * j + 7]));
              r0[4 + j] = w; } }
        *(GAS v2u*)(DEC + (size_t)g * 1024 + h * 128 + 2 * lane) = (v2u){__float_as_uint(__expf(c0)), __float_as_uint(__expf(c1))};
        { unsigned va[16], vb[16];
#pragma unroll
          for (int j = 0; j < 16; ++j) { const unsigned w0 = *(const GAS unsigned*)(CV + (t0 + 2 * j) * D + h * 128 + 2 * lane), w1 = *(const GAS unsigned*)(CV + (t0 + 2 * j + 1) * D + h * 128 + 2 * lane);
              va[j] = (w0 & 0xffffu) | (w1 << 16); vb[j] = (w0 >> 16) | (w1 & 0xffff0000u); }
          GAS v4u* r0 = (GAS v4u*)(VT + ((size_t)g * 1024 + h * 128 + 2 * lane) * 32);
#pragma unroll
          for (int j = 0; j < 4; ++j) { r0[j] = (v4u){va[4 * j], va[4 * j + 1], va[4 * j + 2], va[4 * j + 3]}; r0[4 + j] = (v4u){vb[4 * j], vb[4 * j + 1], vb[4 * j + 2], vb[4 * j + 3]}; } }
    }
}
__device__ __forceinline__ void phase_hgrn_scan(LAS unsigned char* lds, unsigned char* ws, const float* scratch) {
    const int tid = threadIdx.x, lane = tid & 63, wave = __builtin_amdgcn_readfirstlane(tid >> 6);
    const int c = lane & 31, hh = lane >> 5;
    const bf16* QI = (const bf16*)(ws + WS_CQ); const bf16* KI = (const bf16*)(ws + WS_CK);
    const bf16* KOT = (const bf16*)scratch; const bf16* VT = (const bf16*)scratch + (size_t)T * D; const float* DEC = (const float*)(ws + WS_DEC);
    bf16* O = (bf16*)(ws + WS_O);
    constexpr int BUF = 30720, O_KI = 0, O_QI = 8704, O_KOT = 17408, O_VT = 27648, O_DEC = 30208, O_ST = 61440, O_P = 70144;
    for (int item = blockIdx.x; item < 256; item += gridDim.x) {
        const int es = item & 3, h = (item >> 2) & 7, b = item >> 5;
        __syncthreads();
        for (int i = tid; i < 8704 / 16; i += NTHR) *(LAS v4u*)(lds + O_ST + i * 16) = (v4u){0u, 0u, 0u, 0u};
        f32x16 S[4];
#pragma unroll
        for (int blk = 0; blk < 4; ++blk)
#pragma unroll
            for (int r = 0; r < 16; ++r) S[blk][r] = 0.f;
        v4u rk, rq, ro, rx;
        auto load_chunk = [&](int n) {
            const size_t gch = (size_t)b * 128 + n, t0 = gch * 32;
            rk = *(const GAS v4u*)(KI + (t0 + (tid >> 4)) * D + h * 128 + 8 * (tid & 15));
            rq = *(const GAS v4u*)(QI + (t0 + (tid >> 4)) * D + h * 128 + 8 * (tid & 15));
            ro = *(const GAS v4u*)(KOT + (gch * 1024 + h * 128 + (tid >> 2)) * 32 + 8 * (tid & 3));
            if (tid < 128) rx = *(const GAS v4u*)(VT + (gch * 1024 + h * 128 + es * 32 + (tid >> 2)) * 32 + 8 * (tid & 3));
            else if (tid < 160) rx = *(const GAS v4u*)(DEC + gch * 1024 + h * 128 + 4 * (tid - 128));
        };
        auto store_chunk = [&](int bufi) {
            LAS unsigned char* bp = lds + bufi * BUF;
            *(LAS v4u*)(bp + O_KI + (tid >> 4) * 272 + (tid & 15) * 16) = rk;
            *(LAS v4u*)(bp + O_QI + (tid >> 4) * 272 + (tid & 15) * 16) = rq;
            *(LAS v4u*)(bp + O_KOT + (tid >> 2) * 80 + (tid & 3) * 16) = ro;
            if (tid < 128) *(LAS v4u*)(bp + O_VT + (tid >> 2) * 80 + (tid & 3) * 16) = rx;
            else if (tid < 160) *(LAS v4u*)(bp + O_DEC + (tid - 128) * 16) = rx;
        };
        load_chunk(0); store_chunk(0); load_chunk(1);
        __syncthreads();
        for (int n = 0; n < 128; ++n) {
            if (n + 1 < 128) store_chunk((n + 1) & 1);
            if (n + 2 < 128) load_chunk(n + 2);
            if (wave == 0) {
                LAS unsigned char* bp = lds + (n & 1) * BUF;
                const size_t t0 = ((size_t)b * 128 + n) * 32;
                bf16x8 qf[8];
                f32x16 sc;
#pragma unroll
                for (int r = 0; r < 16; ++r) sc[r] = 0.f;
#pragma unroll
                for (int ks = 0; ks < 8; ++ks) { const bf16x8 kf = *(const LAS bf16x8*)(bp + O_KI + c * 272 + (16 * ks + 8 * hh) * 2);
                    qf[ks] = *(const LAS bf16x8*)(bp + O_QI + c * 272 + (16 * ks + 8 * hh) * 2);
                    sc = __builtin_amdgcn_mfma_f32_32x32x16_bf16(kf, qf[ks], sc, 0, 0, 0); }
#pragma unroll
                for (int g4 = 0; g4 < 4; ++g4) { float m[4];
#pragma unroll
                    for (int q = 0; q < 4; ++q) { const float sv = sc[4 * g4 + q]; m[q] = (8 * g4 + 4 * hh + q <= c) ? sv : 0.f; }
                    *(LAS v2u*)(lds + O_P + c * 80 + (8 * g4 + 4 * hh) * 2) = (v2u){pk2(m[0], m[1]), pk2(m[2], m[3])}; }
                bf16x8 vf[2];
                f32x16 o;
#pragma unroll
                for (int r = 0; r < 16; ++r) o[r] = 0.f;
#pragma unroll
                for (int ks = 0; ks < 2; ++ks) { const bf16x8 pf = *(const LAS bf16x8*)(lds + O_P + c * 80 + (16 * ks + 8 * hh) * 2);
                    vf[ks] = *(const LAS bf16x8*)(bp + O_VT + c * 80 + (16 * ks + 8 * hh) * 2);
                    o = __builtin_amdgcn_mfma_f32_32x32x16_bf16(pf, vf[ks], o, 0, 0, 0); }
#pragma unroll
                for (int ks = 0; ks < 8; ++ks) { const bf16x8 sf = *(const LAS bf16x8*)(lds + O_ST + c * 272 + (16 * ks + 8 * hh) * 2);
                    o = __builtin_amdgcn_mfma_f32_32x32x16_bf16(qf[ks], sf, o, 0, 0, 0); }
#pragma unroll
                for (int r = 0; r < 16; ++r) { const float ov = o[r]; O[(t0 + (r & 3) + 8 * (r >> 2) + 4 * hh) * D + h * 128 + es * 32 + c] = (bf16)f2bf(ov); }
#pragma unroll
                for (int blk = 0; blk < 4; ++blk) {
#pragma unroll
                    for (int g4 = 0; g4 < 4; ++g4) { const f32x4 dv = *(const LAS f32x4*)(bp + O_DEC + (32 * blk + 8 * g4 + 4 * hh) * 4);
                        S[blk][4 * g4 + 0] *= dv.x; S[blk][4 * g4 + 1] *= dv.y; S[blk][4 * g4 + 2] *= dv.z; S[blk][4 * g4 + 3] *= dv.w; }
#pragma unroll
                    for (int ks = 0; ks < 2; ++ks) { const bf16x8 af = *(const LAS bf16x8*)(bp + O_KOT + (32 * blk + c) * 80 + (16 * ks + 8 * hh) * 2);
                        S[blk] = __builtin_amdgcn_mfma_f32_32x32x16_bf16(af, vf[ks], S[blk], 0, 0, 0); }
#pragma unroll
                    for (int g4 = 0; g4 < 4; ++g4) { const float s0 = S[blk][4 * g4 + 0], s1 = S[blk][4 * g4 + 1], s2 = S[blk][4 * g4 + 2], s3 = S[blk][4 * g4 + 3];
                        *(LAS v2u*)(lds + O_ST + c * 272 + (32 * blk + 8 * g4 + 4 * hh) * 2) = (v2u){pk2(s0, s1), pk2(s2, s3)}; }
                }
            }
            __syncthreads();
        }
    }
}
__device__ __forceinline__ void phase_hgrn_norm(const float* norm_g, unsigned char* ws) {
    const int tid = threadIdx.x, lane = tid & 63, wave = tid >> 6;
    const int gw = blockIdx.x * NWAVES + wave, NGW = gridDim.x * NWAVES;
    const bf16* O = (const bf16*)(ws + WS_O); const bf16* CG = (const bf16*)(ws + WS_CG); bf16* Y2 = (bf16*)(ws + WS_Y2);
    for (int t = gw; t < T; t += NGW) {
        const v4u a0 = *((const GAS v4u*)(O + (size_t)t * D) + lane * 2), a1 = *((const GAS v4u*)(O + (size_t)t * D) + lane * 2 + 1);
        const v4u g0 = *((const GAS v4u*)(CG + (size_t)t * D) + lane * 2), g1 = *((const GAS v4u*)(CG + (size_t)t * D) + lane * 2 + 1);
        float o[16], gv[16];
        o[0] = bflo(a0.x); o[1] = bfhi(a0.x); o[2] = bflo(a0.y); o[3] = bfhi(a0.y); o[4] = bflo(a0.z); o[5] = bfhi(a0.z); o[6] = bflo(a0.w); o[7] = bfhi(a0.w);
        o[8] = bflo(a1.x); o[9] = bfhi(a1.x); o[10] = bflo(a1.y); o[11] = bfhi(a1.y); o[12] = bflo(a1.z); o[13] = bfhi(a1.z); o[14] = bflo(a1.w); o[15] = bfhi(a1.w);
        gv[0] = bflo(g0.x); gv[1] = bfhi(g0.x); gv[2] = bflo(g0.y); gv[3] = bfhi(g0.y); gv[4] = bflo(g0.z); gv[5] = bfhi(g0.z); gv[6] = bflo(g0.w); gv[7] = bfhi(g0.w);
        gv[8] = bflo(g1.x); gv[9] = bfhi(g1.x); gv[10] = bflo(g1.y); gv[11] = bfhi(g1.y); gv[12] = bflo(g1.z); gv[13] = bfhi(g1.z); gv[14] = bflo(g1.w); gv[15] = bfhi(g1.w);
        float sq = 0.f;
#pragma unroll
        for (int j = 0; j < 16; ++j) sq += o[j] * o[j];
        sq += __shfl_xor(sq, 1); sq += __shfl_xor(sq, 2); sq += __shfl_xor(sq, 4);
        const float r = 1.f / sqrtf(sq * (1.f / 128.f) + LN_EPS);
        float y[16];
#pragma unroll
        for (int j = 0; j < 16; ++j) { const float sg = gv[j] / (1.f + expf(-gv[j])); y[j] = o[j] * r * norm_g[lane * 16 + j] * sg; }
        v4u w0, w1; w0.x = pk2(y[0], y[1]); w0.y = pk2(y[2], y[3]); w0.z = pk2(y[4], y[5]); w0.w = pk2(y[6], y[7]);
        w1.x = pk2(y[8], y[9]); w1.y = pk2(y[10], y[11]); w1.z = pk2(y[12], y[13]); w1.w = pk2(y[14], y[15]);
        *((GAS v4u*)(Y2 + (size_t)t * D) + lane * 2) = w0; *((GAS v4u*)(Y2 + (size_t)t * D) + lane * 2 + 1) = w1;
    }
}

struct Args { const float* in[16]; float* out; unsigned char* ws; int ph_lo, ph_hi, li, pad; };
__global__ void __launch_bounds__(NTHR, 2) mk_fwd(Args args) {
    extern __shared__ __attribute__((aligned(16))) unsigned char lds_raw[];
    LAS unsigned char* lds = (LAS unsigned char*)lds_raw;
    volatile LAS unsigned* MISC = (volatile LAS unsigned*)(lds + MISC_OFF);
    const int tid = threadIdx.x;
    unsigned char* ws = args.ws;
    gu32* ctl = (gu32*)(ws + WS_CTL);
    if (tid < 32) ((LAS unsigned*)(lds + MISC_OFF))[tid] = 0u;
    __syncthreads();
    XcdBarrier bar; bar.bar = (unsigned*)ctl + CW_BAR; bar.x = 0; bar.st = nullptr;
    if (N_LAUNCHES == 1) bar = xcd_barrier_post((unsigned*)ctl + CW_BAR, MISC + 8);
    const int lo = args.ph_lo, hi = args.ph_hi;
#define IN(k) (lo <= (k) && (k) < hi)
#define SEAM(k) do { if (IN(k) && IN((k) + 1)) xcd_barrier(bar); } while (0)
    const float* const* in = args.in;
    bf16* XB = (bf16*)(ws + WS_XB); bf16* H0 = (bf16*)(ws + WS_H0); bf16* Y = (bf16*)(ws + WS_Y); bf16* H1 = (bf16*)(ws + WS_H1);
    int* EID = (int*)(ws + WS_EID); float* GATE = (float*)(ws + WS_GATE);
    float* Z = args.out;

    int ph_ = 0;
#define PH_BEGIN if (lo <= ph_ && ph_ < hi) for (int rep_ = 0; rep_ < 1 + (int)((DUP_MASK >> ph_) & 1u); ++rep_) {
#define PH_END } if (lo <= ph_ && ph_ + 1 < hi) xcd_barrier(bar); ++ph_;
      PH_BEGIN phase_prologue(lds, in, ws); phase_convert_tables(in[12], in[13], ws); PH_END
      PH_BEGIN pg8::Gemm g{XB, (const bf16*)(ws + WS_WABIN), T, AB_IN, D}; pg8::StaticOrder S; S.init(T, AB_IN, (int)gridDim.x, (int)blockIdx.x); pg8::EpiBf16<0> E{H0, AB_IN, nullptr, 0, 0, 1.f};
                     pg8::gemm_phase<pg8::EpiBf16<0>, pg8::StaticOrder, true, true>(lds, g, S, E); PH_END
      PH_BEGIN phase_ret_local(lds, ws); PH_END
      PH_BEGIN phase_ret_prefix(ws); PH_END
      PH_BEGIN phase_ret_out_pool_fast(lds, in, ws); PH_END
      PH_BEGIN pg8::Gemm g{Y, (const bf16*)(ws + WS_WABOUT), T, D, D}; pg8::StaticOrder S; S.init(T, D, (int)gridDim.x, (int)blockIdx.x); pg8::EpiResidF32 E{XB, Z};
                     pg8::gemm_phase<pg8::EpiResidF32, pg8::StaticOrder, true, true>(lds, g, S, E); PH_END
      PH_BEGIN phase_ln(Z, H1, in[14], in[15]); PH_END
      PH_BEGIN pg8::Gemm g{H1, (const bf16*)(ws + WS_WQ), T, 2048, D}; pg8::StaticOrder S; S.init(T, 2048, (int)gridDim.x, (int)blockIdx.x); pg8::EpiBf16<0> E{H0  , 2048, nullptr, 0, 0, 1.f};
                     pg8::gemm_phase<pg8::EpiBf16<0>, pg8::StaticOrder, true, true>(lds, g, S, E); PH_END
      PH_BEGIN phase_topk_fast(lds, H0, (const bf16*)(ws + WS_KEYS), EID, GATE); PH_END
      PH_BEGIN phase_gather8<false, 1>(H1, EID, GATE, ws + WS_U8, ws + WS_V8, (const float*)(ws + WS_DQU), (const float*)(ws + WS_DQV), in[14] + D, in[15] + D, XB  , nullptr); PH_END
      PH_BEGIN phase_gather8<false, 2>(H1, EID, GATE, ws + WS_U8, ws + WS_V8, (const float*)(ws + WS_DQU), (const float*)(ws + WS_DQV), in[14] + D, in[15] + D, XB  , nullptr); PH_END
      PH_BEGIN pg8::Gemm g{XB, (const bf16*)(ws + WS_WCIN), T, C_IN, D}; pg8::StaticOrder S; S.init(T, C_IN, (int)gridDim.x, (int)blockIdx.x);
                      pg8::EpiCInF E2{(bf16*)(ws + WS_CQ), (bf16*)(ws + WS_CK), (bf16*)(ws + WS_CV), (bf16*)(ws + WS_CG), (const float*)(ws + WS_LB)};
                      pg8::gemm_phase<pg8::EpiCInF, pg8::StaticOrder, true, true>(lds, g, S, E2); PH_END
      PH_BEGIN phase_hgrn_prep(ws, args.out); PH_END
      PH_BEGIN phase_hgrn_scan(lds, ws, args.out); PH_END
      PH_BEGIN phase_hgrn_norm(in[8], ws); PH_END
      PH_BEGIN pg8::Gemm g{(const bf16*)(ws + WS_Y2), (const bf16*)(ws + WS_WCOUT), T, D, D}; pg8::StaticOrder S; S.init(T, D, (int)gridDim.x, (int)blockIdx.x); pg8::EpiResidF32 E{XB, Z};
                      pg8::gemm_phase<pg8::EpiResidF32, pg8::StaticOrder, true, true>(lds, g, S, E); PH_END
      PH_BEGIN phase_ln(Z, H1  , in[14] + 2 * D, in[15] + 2 * D); PH_END
      PH_BEGIN pg8::Gemm g{H1, (const bf16*)(ws + WS_WQ) + (size_t)2048 * D, T, 2048, D}; pg8::StaticOrder S; S.init(T, 2048, (int)gridDim.x, (int)blockIdx.x); pg8::EpiBf16<0> E{(bf16*)(ws + WS_Q1), 2048, nullptr, 0, 0, 1.f};
                      pg8::gemm_phase<pg8::EpiBf16<0>, pg8::StaticOrder, true, true>(lds, g, S, E); PH_END
      PH_BEGIN phase_topk_fast(lds, (const bf16*)(ws + WS_Q1), (const bf16*)(ws + WS_KEYS) + (size_t)8 * 2 * 128 * 128, EID, GATE); PH_END
      PH_BEGIN phase_gather8<true, 1>(H1, EID, GATE, ws + WS_U8 + (size_t)NEXP * 1024, ws + WS_V8 + (size_t)NEXP * 1024, (const float*)(ws + WS_DQU) + NEXP, (const float*)(ws + WS_DQV) + NEXP, in[14] + 3 * D, in[15] + 3 * D, nullptr, args.out); PH_END
      PH_BEGIN phase_gather8<true, 2>(H1, EID, GATE, ws + WS_U8 + (size_t)NEXP * 1024, ws + WS_V8 + (size_t)NEXP * 1024, (const float*)(ws + WS_DQU) + NEXP, (const float*)(ws + WS_DQV) + NEXP, in[14] + 3 * D, in[15] + 3 * D, nullptr, args.out); PH_END
#undef PH_BEGIN
#undef PH_END
#undef IN
#undef SEAM
}

extern "C" void kernel_launch(void* const* d_in, const int* in_sizes, int n_in, void* d_out, int out_size, void* d_ws, size_t ws_size, hipStream_t stream) {
    static int grid = 0;
    if (grid == 0) {
        if (n_in != 16 || in_sizes[0] != T * D || out_size != T * D || ws_size < WS_END) { fprintf(stderr, "kernel_launch: unexpected problem (n_in %d, in0 %d, out %d, ws %zu); nothing launched\n", n_in, n_in > 0 ? in_sizes[0] : -1, out_size, ws_size); grid = -1; return; }
        int dev = 0, cus = 0;
        if (hipGetDevice(&dev) != hipSuccess || hipDeviceGetAttribute(&cus, hipDeviceAttributeMultiprocessorCount, dev) != hipSuccess) { grid = -1; return; }
        if (hipFuncSetAttribute((const void*)mk_fwd, hipFuncAttributeMaxDynamicSharedMemorySize, LDS_BYTES) != hipSuccess) { fprintf(stderr, "kernel_launch: hipFuncSetAttribute failed\n"); grid = -1; return; }
        (void)hipGetLastError();
        grid = cus;
    }
    if (grid < 0) return;
    if (hipMemsetAsync((char*)d_ws + WS_CTL, 0, CTL_ZERO_BYTES, stream) != hipSuccess) return;
    Args a{};
    for (int i = 0; i < 16; ++i) a.in[i] = (const float*)d_in[i];
    a.out = (float*)d_out; a.ws = (unsigned char*)d_ws;
    for (int li = 0; li < N_LAUNCHES; ++li) {
        a.ph_lo = (N_LAUNCHES == 1) ? 0 : li; a.ph_hi = (N_LAUNCHES == 1) ? NPHASE : li + 1; a.li = li;
        hipLaunchKernelGGL(mk_fwd, dim3(grid), dim3(NTHR), LDS_BYTES, stream, a);
        if (hipPeekAtLastError() != hipSuccess) { fprintf(stderr, "kernel_launch: launch %d failed\n", li); break; }
    }
}
```

```cpp
#include <hip/hip_runtime.h>
#include <cstdio>
#include <cstdint>

#ifndef MK_N_LAUNCHES
#define MK_N_LAUNCHES 1
#endif
constexpr int NPHASE = 21;
#ifndef DUP_MASK
#define DUP_MASK 0u
#endif
constexpr int N_LAUNCHES = MK_N_LAUNCHES;

constexpr int BATCH = 8, SEQ = 4096, D = 1024, T = BATCH * SEQ;
constexpr int AB_IN = 2048, C_IN = 4096, NEXP = 16384;
constexpr float LN_EPS = 1e-5f;
constexpr float ALPHA = 1.41421356237309515f;
constexpr int NWAVES = 8, NTHR = 512;

constexpr size_t MiB = 1u << 20;
constexpr size_t WS_CTL = 0, CTL_ZERO_BYTES = 1 * MiB;
constexpr size_t WS_LB = 1 * MiB;
constexpr size_t WS_ROPE = 2 * MiB;
constexpr size_t WS_WABIN = 4 * MiB;
constexpr size_t WS_WABOUT = 8 * MiB;
constexpr size_t WS_WCIN = 10 * MiB;
constexpr size_t WS_WCOUT = 18 * MiB;
constexpr size_t WS_WQ = 20 * MiB;
constexpr size_t WS_KEYS = 28 * MiB;
constexpr size_t WS_DQU = 29 * MiB;
constexpr size_t WS_DQV = 29 * MiB + 131072;
constexpr size_t WS_U8 = 32 * MiB;
constexpr size_t WS_V8 = 64 * MiB;
constexpr size_t WS_POOLWT = 30 * MiB;
constexpr size_t WS_XB = 96 * MiB;
constexpr size_t WS_H0 = 160 * MiB;
constexpr size_t WS_LST = 288 * MiB;
constexpr size_t WS_Y = 320 * MiB;
constexpr size_t WS_H1 = 384 * MiB;
constexpr size_t WS_EID = 448 * MiB;
constexpr size_t WS_GATE = 464 * MiB;
constexpr size_t WS_CQ = 160 * MiB, WS_CK = 224 * MiB, WS_CV = 288 * MiB, WS_CG = 352 * MiB;
constexpr size_t WS_O = 416 * MiB;
constexpr size_t WS_Y2 = 160 * MiB;
constexpr size_t WS_Q1 = 224 * MiB;
constexpr size_t WS_DEC = 480 * MiB;
constexpr size_t WS_END = 484 * MiB;

constexpr int CW_BAR = 4096;
constexpr int LDS_BYTES = 147456;
constexpr int MISC_OFF = LDS_BYTES - 128;

#define GAS __attribute__((address_space(1)))
#define LAS __attribute__((address_space(3)))
typedef unsigned short bf16;
typedef unsigned v4u __attribute__((ext_vector_type(4)));
typedef unsigned v2u __attribute__((ext_vector_type(2)));
typedef float f32x4 __attribute__((ext_vector_type(4)));
typedef GAS unsigned gu32;
typedef short bf16x8 __attribute__((ext_vector_type(8)));
typedef float f32x16 __attribute__((ext_vector_type(16)));
#define RLX_AGENT __ATOMIC_RELAXED, __HIP_MEMORY_SCOPE_AGENT
#define LDS_WAIT() asm volatile("s_waitcnt lgkmcnt(0)" ::: "memory")
__device__ __forceinline__ unsigned f2bf(float f) { unsigned u = __builtin_bit_cast(unsigned, f); return (u + 0x7fffu + ((u >> 16) & 1u)) >> 16; }
__device__ __forceinline__ unsigned pk2(float lo, float hi) { return f2bf(lo) | (f2bf(hi) << 16); }
__device__ __forceinline__ float bf2f(unsigned b) { return __builtin_bit_cast(float, b << 16); }
__device__ __forceinline__ float bflo(unsigned w) { return __builtin_bit_cast(float, w << 16); }
__device__ __forceinline__ float bfhi(unsigned w) { return __builtin_bit_cast(float, w & 0xffff0000u); }
__device__ __forceinline__ float wave_sum(float v) {
#pragma unroll
    for (int o = 1; o < 64; o <<= 1) v += __shfl_xor(v, o);
    return v;
}

#define XB_TMO      128
#define XB_XCNT(j)  (256  + 64 * (j))
#define XB_XSUB(j)  (1280 + 64 * (j))
#define XB_XGEN(j)  (2304 + 64 * (j))
#define XB_TOP      3328
#define XB_TOPGEN   3392
#define XCD_BAR_WORDS 3456
#define XB_SPIN_CAP (1u << 21)
__device__ __forceinline__ unsigned xb_ld(unsigned* p)              { return __hip_atomic_load(p, __ATOMIC_RELAXED, __HIP_MEMORY_SCOPE_AGENT); }
__device__ __forceinline__ unsigned xb_add(unsigned* p, unsigned v) { return __hip_atomic_fetch_add(p, v, __ATOMIC_RELAXED, __HIP_MEMORY_SCOPE_AGENT); }
__device__ __forceinline__ unsigned xb_xcc_id() { return (unsigned)__builtin_amdgcn_s_getreg((3 << 11) | 20) & 0xFu; }
#define XB_SPIN(cond, bar) do { unsigned _sp = 0; while (cond) { __builtin_amdgcn_s_sleep(1); \
    if ((++_sp & 255u) == 0u) { if (xb_ld(&(bar)[XB_TMO])) break; if (_sp > XB_SPIN_CAP) { atomicAdd(&(bar)[XB_TMO], 1u); break; } } } } while (0)
struct XcdBarrier { unsigned* bar; unsigned x; volatile LAS unsigned* st; };
__device__ __forceinline__ XcdBarrier xcd_barrier_post(unsigned* bar, volatile LAS unsigned* st) {
    XcdBarrier b; b.bar = bar; b.x = xb_xcc_id(); b.st = st;
    if (threadIdx.x == 0) (void)xb_add(&bar[XB_XCNT(b.x)], 1u);
    return b;
}
__device__ __forceinline__ void xcd_barrier_complete(unsigned* bar, unsigned x, unsigned& nloc, unsigned& nx) {
    const unsigned G = gridDim.x * gridDim.y * gridDim.z;
    unsigned sum, cnt, mine, sp = 0u;
    for (;;) {
        sum = 0u; cnt = 0u; mine = 0u;
#pragma unroll
        for (unsigned j = 0; j < 16; ++j) { const unsigned c = xb_ld(&bar[XB_XCNT(j)]); sum += c; cnt += (c > 0u) ? 1u : 0u; mine = (j == x) ? c : mine; }
        if (sum == G) break;
        __builtin_amdgcn_s_sleep(1);
        if ((++sp & 255u) == 0u) { if (xb_ld(&bar[XB_TMO])) break; if (sp > XB_SPIN_CAP) { atomicAdd(&bar[XB_TMO], 1u); break; } }
    }
    nloc = mine > 0u ? mine : 1u; nx = cnt > 0u ? cnt : 1u;
}
__device__ __forceinline__ void xcd_barrier(const XcdBarrier& b) {
    asm volatile("s_waitcnt vmcnt(0)" ::: "memory");
    __syncthreads();
    if (threadIdx.x == 0) {
        unsigned* bar = b.bar;
        __builtin_amdgcn_s_waitcnt(0);
        unsigned nloc = b.st[0], nx = b.st[1];
        if (nloc == 0u) { xcd_barrier_complete(bar, b.x, nloc, nx); b.st[0] = nloc; b.st[1] = nx; }
        const unsigned old = xb_add(&bar[XB_XSUB(b.x)], 1u);
        const unsigned gen = old / nloc;
        if (old + 1u == (gen + 1u) * nloc) {
            __builtin_amdgcn_fence(__ATOMIC_RELEASE, "agent");
            asm volatile("s_waitcnt vmcnt(0)" ::: "memory");
            const unsigned og = xb_add(&bar[XB_TOP], 1u);
            const unsigned tg = og / nx;
            if (og + 1u == (tg + 1u) * nx) xb_add(&bar[XB_TOPGEN], 1u);
            else XB_SPIN(xb_ld(&bar[XB_TOPGEN]) == tg, bar);
            __builtin_amdgcn_fence(__ATOMIC_ACQUIRE, "agent");
            xb_add(&bar[XB_XGEN(b.x)], 1u);
            asm volatile("s_waitcnt vmcnt(0)" ::: "memory");
        } else {
            XB_SPIN(xb_ld(&bar[XB_XGEN(b.x)]) == gen, bar);
            __builtin_amdgcn_fence(__ATOMIC_ACQUIRE, "agent");
            asm volatile("s_waitcnt vmcnt(0)" ::: "memory");
        }
    }
    __syncthreads();
}

__device__ __forceinline__ void p0_transpose_item(const float* W, int K, int N, bf16* WT, LAS float* scr, int item, int lane) {
    const int nblk = N / 32, kb = item / nblk, nb = item % nblk, k0 = 64 * kb, n0 = 32 * nb;
#pragma unroll 8
    for (int i = 0; i < 32; ++i) { const int kk = 2 * i + (lane >> 5); scr[kk * 33 + (lane & 31)] = W[(size_t)(k0 + kk) * N + n0 + (lane & 31)]; }
    LDS_WAIT(); asm volatile("" ::: "memory");
    const int c = lane & 7;
#pragma unroll
    for (int j = 0; j < 4; ++j) { const int n = (lane >> 3) + 8 * j; const LAS float* s = scr + (8 * c) * 33 + n;
        v4u o; o.x = pk2(s[0 * 33], s[1 * 33]); o.y = pk2(s[2 * 33], s[3 * 33]); o.z = pk2(s[4 * 33], s[5 * 33]); o.w = pk2(s[6 * 33], s[7 * 33]);
        *(GAS v4u*)(WT + (size_t)(n0 + n) * K + k0 + 8 * c) = o; }
    LDS_WAIT(); asm volatile("" ::: "memory");
}

template <class Epi>
__device__ __forceinline__ void gemm_naive(LAS unsigned char* lds, const bf16* A, const bf16* Bt, int M, int N, int K, const Epi& E) {
    LAS float* As = (LAS float*)lds;
    LAS float* Bs = As + 128 * 33;
    const int tid = threadIdx.x, tx = tid & 15, ty = tid >> 4;
    const int ntn = N / 128, ntiles = (M / 128) * ntn;
    for (int tile = blockIdx.x; tile < ntiles; tile += gridDim.x) {
        const int tm = tile / ntn, tn = tile % ntn;
        float acc[4][8];
#pragma unroll
        for (int i = 0; i < 4; ++i)
#pragma unroll
            for (int j = 0; j < 8; ++j) acc[i][j] = 0.f;
        for (int k0 = 0; k0 < K; k0 += 32) {
            { const int r = tid >> 2, kc = (tid & 3) * 8;
              const v4u va = *(const GAS v4u*)(A + (size_t)(tm * 128 + r) * K + k0 + kc);
              const v4u vb = *(const GAS v4u*)(Bt + (size_t)(tn * 128 + r) * K + k0 + kc);
              LAS float* pa = As + r * 33 + kc; LAS float* pb = Bs + r * 33 + kc;
              pa[0] = bflo(va.x); pa[1] = bfhi(va.x); pa[2] = bflo(va.y); pa[3] = bfhi(va.y); pa[4] = bflo(va.z); pa[5] = bfhi(va.z); pa[6] = bflo(va.w); pa[7] = bfhi(va.w);
              pb[0] = bflo(vb.x); pb[1] = bfhi(vb.x); pb[2] = bflo(vb.y); pb[3] = bfhi(vb.y); pb[4] = bflo(vb.z); pb[5] = bfhi(vb.z); pb[6] = bflo(vb.w); pb[7] = bfhi(vb.w); }
            __syncthreads();
#pragma unroll 8
            for (int kk = 0; kk < 32; ++kk) {
                float a[4], b[8];
#pragma unroll
                for (int i = 0; i < 4; ++i) a[i] = As[(ty * 4 + i) * 33 + kk];
#pragma unroll
                for (int j = 0; j < 8; ++j) b[j] = Bs[(tx + 16 * j) * 33 + kk];
#pragma unroll
                for (int i = 0; i < 4; ++i)
#pragma unroll
                    for (int j = 0; j < 8; ++j) acc[i][j] += a[i] * b[j];
            }
            __syncthreads();
        }
#pragma unroll
        for (int i = 0; i < 4; ++i)
#pragma unroll
            for (int j = 0; j < 8; ++j) E(tm * 128 + ty * 4 + i, tn * 128 + tx + 16 * j, acc[i][j]);
    }
}
struct EpiStore { bf16* O; int ldc;
    __device__ __forceinline__ void operator()(int r, int c, float v) const { O[(size_t)r * ldc + c] = (bf16)f2bf(v); } };
struct EpiResid { const bf16* X; float* Z;
    __device__ __forceinline__ void operator()(int r, int c, float v) const { Z[(size_t)r * D + c] = ALPHA * bf2f(X[(size_t)r * D + c]) + v; } };
struct EpiCIn { bf16 *CQ, *CK, *CV, *CG; const float* lb;
    __device__ __forceinline__ void operator()(int r, int c, float v) const {
        const int seg = c >> 10, cc = c & 1023; const size_t o = (size_t)r * D + cc;
        if (seg == 0) CQ[o] = (bf16)f2bf(v);
        else if (seg == 1) { const float k = (1.f - lb[cc]) / (1.f + expf(v)); CK[o] = (bf16)f2bf(k); }
        else if (seg == 2) CV[o] = (bf16)f2bf(v);
        else CG[o] = (bf16)f2bf(v);
    } };

namespace pg8 {
#define PG8_LAS __attribute__((address_space(3)))
typedef unsigned short bf16_t;
typedef short bf16x8 __attribute__((ext_vector_type(8)));
typedef float f32x4 __attribute__((ext_vector_type(4)));
typedef unsigned u32x4 __attribute__((ext_vector_type(4)));
constexpr int BM = 256, BK = 64, HALF = 128, HTB = HALF * BK * 2  , STAGE_BYTES = 8 * HTB, NXCD = 8, WGM = 8;

__host__ __device__ __forceinline__ int lds_byte(int r, int c) { const int st = (r >> 4) * 2 + (c >> 5), rr = r & 15, cc = c & 31, ob = rr * 64 + cc * 2; return st * 1024 + (ob ^ (((ob >> 9) & 1) << 5)); }
__host__ __device__ __forceinline__ void stage_rc(int b, int& R, int& C) { const int st = b / 1024, sb = b % 1024, swz = sb ^ (((sb >> 9) & 1) << 5); R = (st >> 1) * 16 + swz / 64; C = (st & 1) * 32 + (swz % 64) / 2; }
__host__ __device__ __forceinline__ int perm32(int rho) { const int n = rho >> 4, i = rho & 15; return 8 * (i >> 2) + 4 * n + (i & 3); }

struct Unit { int pm, pn; };
struct Gemm { const bf16_t* A; const bf16_t* Bt; int M, N, K; };

struct StaticOrder {
    int nM, nN, nwg, G, c;
    __host__ __device__ void init(int M, int N, int G_, int c_) { nM = M / BM; nN = N / BM; nwg = nM * nN; G = G_; c = c_; }
    __host__ __device__ bool next(int i, Unit& u) const {
        const long L = (long)i * G + c; if (L >= nwg) return false;
        int wgid = (int)L; { const int q = nwg / NXCD, r = nwg % NXCD, xcd = wgid % NXCD, off = wgid / NXCD; wgid = (xcd < r ? xcd * (q + 1) : r * (q + 1) + (xcd - r) * q) + off; }
        const int nig = WGM * nN, gid = wgid / nig, fm = gid * WGM, gsz = (nM - fm) < WGM ? (nM - fm) : WGM;
        u.pm = fm + ((wgid % nig) % gsz); u.pn = (wgid % nig) / gsz; return true;
    }
    __device__ __forceinline__ void a_ready(const Unit&) const {}
    __device__ __forceinline__ void done(const Unit&) const {}
};

__device__ __forceinline__ unsigned cvt_pk_bf16(float lo, float hi) { unsigned r; asm volatile("v_cvt_pk_bf16_f32 %0, %1, %2" : "=v"(r) : "v"(lo), "v"(hi)); return r; }
typedef float f32x2 __attribute__((ext_vector_type(2)));
__device__ __forceinline__ f32x2 gelu_pk(f32x2 v) {
    const f32x2 av = __builtin_elementwise_abs(v), d = av * 0.2316418882f + 1.0f;
    f32x2 t; t.x = __builtin_amdgcn_rcpf(d.x); t.y = __builtin_amdgcn_rcpf(d.y);
    f32x2 q = t * 0.5307027145f + (-0.7265760135f); q = q * t + 0.7107068705f; q = q * t + (-0.142248368f); q = q * t + 0.127414796f; q = q * t;
    const f32x2 s = (v * v) * (-0.72134752044f);
    f32x2 e; e.x = __builtin_amdgcn_exp2f(s.x); e.y = __builtin_amdgcn_exp2f(s.y);
    const f32x2 m = v * (q * e), r = v - m;
    f32x2 o; o.x = v.x < 0.f ? m.x : r.x; o.y = v.y < 0.f ? m.y : r.y; return o;
}

template <int ACT  > struct EpiBf16 {
    static constexpr bool PERM = true, AFTER_DRAIN = false; static_assert(ACT == 0 || ACT == 1, "EpiBf16: ACT is 0 (none) or 1 (gelu_pk)");
    bf16_t* O; int ldc; const float* bias; int split_cols; size_t split_stride; float scale0;
    __device__ __forceinline__ void operator()(const f32x4 (&acc)[2][2][4][2], const Unit& u, int wr, int wc, int fr, int fq) const {
        const int row0 = u.pm * BM + wr * 64 + fr; int colt = u.pn * BM; bf16_t* base = O;
        float sc = 1.f; if (split_cols) { const int t = colt / split_cols; base += (size_t)t * split_stride; colt -= t * split_cols; if (t == 0) sc = scale0; }
        const int col0 = colt + wc * 32 + 8 * fq, bcol0 = u.pn * BM + wc * 32 + 8 * fq;
        f32x4 bv[2][2];
#pragma unroll
        for (int bj = 0; bj < 2; ++bj)
#pragma unroll
            for (int n = 0; n < 2; ++n) bv[bj][n] = bias ? *(const f32x4*)(bias + bcol0 + bj * HALF + 4 * n) : (f32x4){0.f, 0.f, 0.f, 0.f};
#pragma unroll
        for (int ai = 0; ai < 2; ++ai)
#pragma unroll
            for (int m = 0; m < 4; ++m) { bf16_t* rowp = base + (size_t)(row0 + ai * HALF + m * 16) * ldc + col0;
#pragma unroll
                for (int bj = 0; bj < 2; ++bj) { f32x4 v0 = acc[ai][bj][m][0] + bv[bj][0], v1 = acc[ai][bj][m][1] + bv[bj][1];
                    if (ACT == 1) { f32x2 a = gelu_pk((f32x2){v0[0], v0[1]}), b = gelu_pk((f32x2){v0[2], v0[3]}), c = gelu_pk((f32x2){v1[0], v1[1]}), d = gelu_pk((f32x2){v1[2], v1[3]});
                        v0 = (f32x4){a.x, a.y, b.x, b.y}; v1 = (f32x4){c.x, c.y, d.x, d.y}; }
                    v0 = v0 * sc; v1 = v1 * sc; u32x4 w; w.x = cvt_pk_bf16(v0[0], v0[1]); w.y = cvt_pk_bf16(v0[2], v0[3]); w.z = cvt_pk_bf16(v1[0], v1[1]); w.w = cvt_pk_bf16(v1[2], v1[3]);
                    *(u32x4*)(rowp + bj * HALF) = w; } }
    }
};

struct EpiResidF32 {
    static constexpr bool PERM = false, AFTER_DRAIN = false;
    const bf16_t* X; float* Z;
    __device__ __forceinline__ void operator()(const f32x4 (&acc)[2][2][4][2], const Unit& u, int wr, int wc, int fr, int fq) const {
        typedef unsigned u32x2 __attribute__((ext_vector_type(2)));
        const int row0 = u.pm * BM + wr * 64 + fr, col0 = u.pn * BM + wc * 32 + 4 * fq;
#pragma unroll
        for (int ai = 0; ai < 2; ++ai)
#pragma unroll
            for (int m = 0; m < 4; ++m) { const size_t ro = (size_t)(row0 + ai * HALF + m * 16) * 1024;
#pragma unroll
                for (int bj = 0; bj < 2; ++bj)
#pragma unroll
                    for (int n = 0; n < 2; ++n) { const int c = col0 + bj * HALF + n * 16; const u32x2 xw = *(const u32x2*)(X + ro + c);
                        f32x4 xv; xv[0] = __builtin_bit_cast(float, xw.x << 16); xv[1] = __builtin_bit_cast(float, xw.x & 0xffff0000u); xv[2] = __builtin_bit_cast(float, xw.y << 16); xv[3] = __builtin_bit_cast(float, xw.y & 0xffff0000u);
                        *(f32x4*)(Z + ro + c) = xv * 1.41421356237309515f + acc[ai][bj][m][n]; } }
    }
};
struct EpiCInF {
    static constexpr bool PERM = true, AFTER_DRAIN = false;
    bf16_t *CQ, *CK, *CV, *CG; const float* lb;
    __device__ __forceinline__ void operator()(const f32x4 (&acc)[2][2][4][2], const Unit& u, int wr, int wc, int fr, int fq) const {
        const int seg = u.pn >> 2, colt = (u.pn & 3) * BM;
        bf16_t* base = seg == 0 ? CQ : (seg == 1 ? CK : (seg == 2 ? CV : CG));
        const int row0 = u.pm * BM + wr * 64 + fr, col0 = colt + wc * 32 + 8 * fq;
        f32x4 om[2][2];
#pragma unroll
        for (int bj = 0; bj < 2; ++bj)
#pragma unroll
            for (int n = 0; n < 2; ++n) { const f32x4 l = *(const f32x4*)(lb + col0 + bj * HALF + 4 * n); om[bj][n] = 1.0f - l; }
#pragma unroll
        for (int ai = 0; ai < 2; ++ai)
#pragma unroll
            for (int m = 0; m < 4; ++m) { bf16_t* rowp = base + (size_t)(row0 + ai * HALF + m * 16) * 1024 + col0;
#pragma unroll
                for (int bj = 0; bj < 2; ++bj) { f32x4 v0 = acc[ai][bj][m][0], v1 = acc[ai][bj][m][1];
                    if (seg == 1) {
#pragma unroll
                        for (int q = 0; q < 4; ++q) { v0[q] = om[bj][0][q] / (1.0f + __expf(v0[q])); v1[q] = om[bj][1][q] / (1.0f + __expf(v1[q])); } }
                    u32x4 w; w.x = cvt_pk_bf16(v0[0], v0[1]); w.y = cvt_pk_bf16(v0[2], v0[3]); w.z = cvt_pk_bf16(v1[0], v1[1]); w.w = cvt_pk_bf16(v1[2], v1[3]);
                    *(u32x4*)(rowp + bj * HALF) = w; } }
    }
};
template <class Epi, class Sched, bool ALIGN_EPI = false, bool SP2 = false>
__device__ __forceinline__ void gemm_phase(PG8_LAS unsigned char* lds, const Gemm g, const Sched& S, const Epi& E) {
    const int tid = threadIdx.x, wid = __builtin_amdgcn_readfirstlane(tid >> 6), lane = tid & 63, wr = wid >> 2, wc = wid & 3, fr = lane & 15, fq = lane >> 4;
    const int K = g.K, nt = K / BK;
    unsigned voffA[2], voffB[2];
#pragma unroll
    for (int i = 0; i < 2; ++i) { int R, C; stage_rc(tid * 16 + i * 8192, R, C); const int Rb = Epi::PERM ? ((R & ~31) + perm32(R & 31)) : R;
        voffA[i] = (unsigned)(R * K + C) * 2u; voffB[i] = (unsigned)(Rb * K + C) * 2u; }
    const size_t kstep = (size_t)(BK * 2);
    const size_t hstep = (size_t)HALF * K * 2;
    const size_t tstep = 2 * hstep;
    const unsigned ldsw = (unsigned)wid * 1024u;
    const int aoff = lds_byte(wr * 64 + fr, fq * 8), boff = lds_byte(wc * 32 + fr, fq * 8);
#define PG8_SA(b, h) (((b) * 2 + (h)) * HTB)
#define PG8_SB(b, h) ((4 + (b) * 2 + (h)) * HTB)
#define PG8_STAGE(bufoff, gbase, voff) do { _Pragma("unroll") for (int _i = 0; _i < 2; ++_i) \
        __builtin_amdgcn_global_load_lds((const unsigned*)((const char*)(gbase) + (voff)[_i]), (PG8_LAS unsigned*)(lds + (bufoff) + ldsw + _i * 8192), 16, 0, 0); } while (0)
#define PG8_LDA(dst, b, h) do { _Pragma("unroll") for (int m = 0; m < 4; ++m) _Pragma("unroll") for (int k = 0; k < 2; ++k) dst[m][k] = *(const PG8_LAS bf16x8*)(lds + PG8_SA(b, h) + aoff + m * 2048 + k * 1024); } while (0)
#define PG8_LDB(dst, b, h) do { _Pragma("unroll") for (int n = 0; n < 2; ++n) _Pragma("unroll") for (int k = 0; k < 2; ++k) dst[n][k] = *(const PG8_LAS bf16x8*)(lds + PG8_SB(b, h) + boff + n * 2048 + k * 1024); } while (0)
#define PG8_MMA(ai, bj, At, Bt) do { __builtin_amdgcn_s_setprio(1); _Pragma("unroll") for (int m = 0; m < 4; ++m) _Pragma("unroll") for (int n = 0; n < 2; ++n) _Pragma("unroll") for (int k = 0; k < 2; ++k) \
        acc[ai][bj][m][n] = __builtin_amdgcn_mfma_f32_16x16x32_bf16(Bt[n][k], At[m][k], acc[ai][bj][m][n], 0, 0, 0); __builtin_amdgcn_s_setprio(0); } while (0)
#define PG8_WAIT_V(n) asm volatile("s_waitcnt vmcnt(" #n ")" ::: "memory")
#define PG8_WAIT_L(n) asm volatile("s_waitcnt lgkmcnt(" #n ")" ::: "memory")
#define PG8_BAR __builtin_amdgcn_s_barrier()
#define PG8_SCHED __builtin_amdgcn_sched_barrier(0)
    Unit cur, nxt; int ui = 0;
    if (!S.next(0, cur)) return;
    f32x4 acc[2][2][4][2];
#pragma unroll
    for (int a = 0; a < 2; ++a)
#pragma unroll
        for (int b = 0; b < 2; ++b)
#pragma unroll
            for (int m = 0; m < 4; ++m)
#pragma unroll
                for (int n = 0; n < 2; ++n) acc[a][b][m][n] = (f32x4){0.f, 0.f, 0.f, 0.f};
    bf16x8 At[4][2], B0[2][2], B1[2][2];
    const char* cA = (const char*)g.A + (size_t)cur.pm * tstep; const char* cB = (const char*)g.Bt + (size_t)cur.pn * tstep;
    S.a_ready(cur);
    if constexpr (SP2) {
        PG8_STAGE(PG8_SB(0, 0), cB, voffB); PG8_STAGE(PG8_SB(0, 1), cB + hstep, voffB); PG8_STAGE(PG8_SA(0, 0), cA, voffA); PG8_STAGE(PG8_SA(0, 1), cA + hstep, voffA);
        if (wr == 1) PG8_BAR;
        PG8_WAIT_V(2); PG8_BAR;
        PG8_STAGE(PG8_SB(1, 0), cB + kstep, voffB); PG8_STAGE(PG8_SA(1, 0), cA + kstep, voffA); PG8_STAGE(PG8_SB(1, 1), cB + hstep + kstep, voffB);
        PG8_WAIT_V(6); PG8_BAR;
    } else {
        PG8_STAGE(PG8_SB(0, 0), cB, voffB); PG8_STAGE(PG8_SA(0, 0), cA, voffA); PG8_STAGE(PG8_SB(0, 1), cB + hstep, voffB); PG8_STAGE(PG8_SA(0, 1), cA + hstep, voffA);
        if (wr == 1) PG8_BAR;
        PG8_WAIT_V(4); PG8_BAR;
        PG8_STAGE(PG8_SB(1, 0), cB + kstep, voffB); PG8_STAGE(PG8_SA(1, 0), cA + kstep, voffA); PG8_STAGE(PG8_SB(1, 1), cB + hstep + kstep, voffB);
        PG8_WAIT_V(6); PG8_BAR;
    }
    for (;;) {
        const bool has_next = S.next(ui + 1, nxt);
        const char* nA = has_next ? (const char*)g.A + (size_t)nxt.pm * tstep : cA; const char* nB = has_next ? (const char*)g.Bt + (size_t)nxt.pn * tstep : cB;
        for (int t = 0; t < nt; t += 2) {
            const bool last = (t == nt - 2);
            const char* a1 = cA + (size_t)(t + 1) * kstep;
            const char* a2 = last ? nA : cA + (size_t)(t + 2) * kstep; const char* b2 = last ? nB : cB + (size_t)(t + 2) * kstep;
            const char* a3 = a2 + kstep; const char* b3 = b2 + kstep;
            if (last && has_next) S.a_ready(nxt);
            if constexpr (SP2) {
            PG8_LDB(B0, 0, 0); PG8_LDB(B1, 0, 1); PG8_SCHED; PG8_LDA(At, 0, 0); PG8_STAGE(PG8_SA(1, 1), a1 + hstep, voffA);
            PG8_WAIT_V(8); PG8_WAIT_L(0); PG8_BAR; PG8_MMA(0, 0, At, B0); PG8_MMA(0, 1, At, B1); PG8_BAR; PG8_SCHED;
            PG8_LDA(At, 0, 1); PG8_STAGE(PG8_SB(0, 0), b2, voffB); PG8_STAGE(PG8_SB(0, 1), b2 + hstep, voffB); PG8_STAGE(PG8_SA(0, 0), a2, voffA);
            PG8_WAIT_V(8); PG8_WAIT_L(0); PG8_BAR; PG8_MMA(1, 0, At, B0); PG8_MMA(1, 1, At, B1); PG8_BAR; PG8_SCHED;
            PG8_LDB(B0, 1, 0); PG8_LDB(B1, 1, 1); PG8_SCHED; PG8_LDA(At, 1, 0); PG8_STAGE(PG8_SA(0, 1), a2 + hstep, voffA);
            PG8_WAIT_V(8); PG8_WAIT_L(0); PG8_BAR; PG8_MMA(0, 0, At, B0); PG8_MMA(0, 1, At, B1); PG8_BAR; PG8_SCHED;
            PG8_LDA(At, 1, 1); PG8_STAGE(PG8_SB(1, 0), b3, voffB); PG8_STAGE(PG8_SB(1, 1), b3 + hstep, voffB); PG8_STAGE(PG8_SA(1, 0), a3, voffA);
            PG8_WAIT_V(8); PG8_WAIT_L(0); PG8_BAR; PG8_MMA(1, 0, At, B0); PG8_MMA(1, 1, At, B1); PG8_BAR; PG8_SCHED;
            } else {
            PG8_LDB(B0, 0, 0); PG8_SCHED; PG8_LDA(At, 0, 0); PG8_STAGE(PG8_SA(1, 1), a1 + hstep, voffA);
            PG8_WAIT_L(8); PG8_BAR; PG8_WAIT_L(0); PG8_MMA(0, 0, At, B0); PG8_BAR; PG8_SCHED;
            PG8_LDB(B1, 0, 1); PG8_STAGE(PG8_SB(0, 0), b2, voffB);
            PG8_BAR; PG8_WAIT_L(0); PG8_MMA(0, 1, At, B1); PG8_BAR;
            PG8_LDA(At, 0, 1); PG8_STAGE(PG8_SA(0, 0), a2, voffA);
            PG8_BAR; PG8_WAIT_L(0); PG8_MMA(1, 0, At, B0); PG8_BAR; PG8_SCHED;
            PG8_STAGE(PG8_SB(0, 1), b2 + hstep, voffB);
            PG8_WAIT_V(6); PG8_BAR; PG8_MMA(1, 1, At, B1); PG8_BAR;
            PG8_LDB(B0, 1, 0); PG8_SCHED; PG8_LDA(At, 1, 0); PG8_STAGE(PG8_SA(0, 1), a2 + hstep, voffA);
            PG8_WAIT_L(8); PG8_BAR; PG8_WAIT_L(0); PG8_MMA(0, 0, At, B0); PG8_BAR; PG8_SCHED;
            PG8_LDB(B1, 1, 1); PG8_STAGE(PG8_SB(1, 0), b3, voffB);
            PG8_BAR; PG8_WAIT_L(0); PG8_MMA(0, 1, At, B1); PG8_BAR;
            PG8_LDA(At, 1, 1); PG8_STAGE(PG8_SA(1, 0), a3, voffA);
            PG8_BAR; PG8_WAIT_L(0); PG8_MMA(1, 0, At, B0); PG8_BAR; PG8_SCHED;
            PG8_STAGE(PG8_SB(1, 1), b3 + hstep, voffB);
            PG8_WAIT_V(6); PG8_BAR; PG8_MMA(1, 1, At, B1); PG8_BAR;
            }
        }
        if constexpr (ALIGN_EPI) { if (wr == 0) PG8_BAR; }
        if constexpr (!Epi::AFTER_DRAIN) { E(acc, cur, wr, wc, fr, fq); S.done(cur); }
        if (!has_next) break;
#pragma unroll
        for (int a = 0; a < 2; ++a)
#pragma unroll
            for (int b = 0; b < 2; ++b)
#pragma unroll
                for (int m = 0; m < 4; ++m)
#pragma unroll
                    for (int n = 0; n < 2; ++n) acc[a][b][m][n] = (f32x4){0.f, 0.f, 0.f, 0.f};
        cur = nxt; cA = nA; cB = nB; ++ui;
        if constexpr (ALIGN_EPI) { if (wr == 1) PG8_BAR; }
    }
    PG8_WAIT_V(0);
    if constexpr (!ALIGN_EPI) { if (wr == 0) PG8_BAR; }
    PG8_BAR;
    if constexpr (Epi::AFTER_DRAIN) { E.fused(acc, cur, wr, wc, fr, fq, lds, wid, lane); S.done(cur); }
#undef PG8_SA
#undef PG8_SB
#undef PG8_STAGE
#undef PG8_LDA
#undef PG8_LDB
#undef PG8_MMA
#undef PG8_WAIT_V
#undef PG8_WAIT_L
#undef PG8_BAR
#undef PG8_SCHED
}
}

__device__ __forceinline__ float gamma_log2(int h) { return log2f(1.f - exp2f(-5.f - (float)h)); }

__device__ __forceinline__ void phase_prologue(LAS unsigned char* lds, const float* const* in, unsigned char* ws) {
    const int tid = threadIdx.x, lane = tid & 63, wave = tid >> 6;
    const int gw = blockIdx.x * NWAVES + wave, NGW = gridDim.x * NWAVES;
    LAS float* scr = (LAS float*)(lds + wave * 16384);
    constexpr int I_ABIN = (D / 64) * (AB_IN / 32), I_SQ = (D / 64) * (D / 32), I_CIN = (D / 64) * (C_IN / 32), I_WQ = (D / 64) * (2048 / 32);
    constexpr int NITEMS = I_ABIN + I_SQ + I_CIN + I_SQ + 2 * I_WQ;
    for (int it = gw; it < NITEMS; it += NGW) {
        int r = it;
        if (r < I_ABIN) { p0_transpose_item(in[1], D, AB_IN, (bf16*)(ws + WS_WABIN), scr, r, lane); continue; } r -= I_ABIN;
        if (r < I_SQ) { p0_transpose_item(in[5], D, D, (bf16*)(ws + WS_WABOUT), scr, r, lane); continue; } r -= I_SQ;
        if (r < I_CIN) { p0_transpose_item(in[6], D, C_IN, (bf16*)(ws + WS_WCIN), scr, r, lane); continue; } r -= I_CIN;
        if (r < I_SQ) { p0_transpose_item(in[9], D, D, (bf16*)(ws + WS_WCOUT), scr, r, lane); continue; } r -= I_SQ;
        if (r < I_WQ) { p0_transpose_item(in[10], D, 2048, (bf16*)(ws + WS_WQ), scr, r, lane); continue; } r -= I_WQ;
        p0_transpose_item(in[10] + (size_t)D * 2048, D, 2048, (bf16*)(ws + WS_WQ) + (size_t)2048 * D, scr, r, lane);
    }
    for (int it = gw; it < 32; it += NGW) p0_transpose_item(in[2] + (size_t)(it >> 3) * 16384, 128, 128, (bf16*)(ws + WS_POOLWT) + (size_t)(it >> 3) * 16384, scr, it & 7, lane);
    const size_t gt = (size_t)blockIdx.x * NTHR + tid, NT = (size_t)gridDim.x * NTHR;
    { const float* x = in[0]; bf16* xb = (bf16*)(ws + WS_XB);
      for (size_t i = gt; i < (size_t)T * D / 8; i += NT) { const f32x4 a = *(const GAS f32x4*)(x + i * 8), b = *(const GAS f32x4*)(x + i * 8 + 4);
          v4u o; o.x = pk2(a.x, a.y); o.y = pk2(a.z, a.w); o.z = pk2(b.x, b.y); o.w = pk2(b.z, b.w); *(GAS v4u*)(xb + i * 8) = o; } }
    { const float* k = in[11]; bf16* kb = (bf16*)(ws + WS_KEYS);
      for (size_t i = gt; i < (size_t)2 * 8 * 2 * 128 * 128 / 8; i += NT) { const f32x4 a = *(const GAS f32x4*)(k + i * 8), b = *(const GAS f32x4*)(k + i * 8 + 4);
          v4u o; o.x = pk2(a.x, a.y); o.y = pk2(a.z, a.w); o.z = pk2(b.x, b.y); o.w = pk2(b.z, b.w); *(GAS v4u*)(kb + i * 8) = o; } }
    { float* ct = (float*)(ws + WS_ROPE); float* st = ct + 4096 * 32;
      for (size_t i = gt; i < (size_t)4096 * 32; i += NT) { const int pos = (int)(i >> 5), f = (int)(i & 31);
          const double inv = exp(-log(10000.0) * ((double)f / 31.0)); const double ang = (double)pos * inv;
          ct[i] = (float)cos(ang); st[i] = (float)sin(ang); } }
    { const float* l = in[7]; float* lb = (float*)(ws + WS_LB);
      for (size_t i = gt; i < 1024; i += NT) { const float a = l[i], b = l[1024 + i]; const float m = fmaxf(a, b); const float ea = expf(a - m), eb = expf(b - m); lb[i] = eb / (ea + eb); } }
}

__device__ __forceinline__ void phase_ret_local(LAS unsigned char* lds, unsigned char* ws) {
    const int tid = threadIdx.x;
    const bf16* H0 = (const bf16*)(ws + WS_H0); float* LST = (float*)(ws + WS_LST);
    const float* ct = (const float*)(ws + WS_ROPE); const float* st = ct + 4096 * 32;
    LAS float* kd = (LAS float*)lds;
    LAS float* vv = (LAS float*)(lds + 32768);
    for (int item = blockIdx.x; item < 1024; item += gridDim.x) {
        const int n = item & 31, h = (item >> 5) & 3, b = item >> 7;
        const size_t t0 = (size_t)b * SEQ + n * 128; const float lg = gamma_log2(h);
        for (int idx = tid; idx < 4096; idx += NTHR) { const int s = idx >> 5, i = idx & 31, pos = n * 128 + s;
            const bf16* row = H0 + (t0 + s) * AB_IN + 768 + h * 64;
            const float x1 = bf2f(row[i]), x2 = bf2f(row[i + 32]); const float c = ct[pos * 32 + i], sn = st[pos * 32 + i];
            const float dec = exp2f((float)(127 - s) * lg) * 0.125f;
            kd[s * 64 + i] = (x1 * c - x2 * sn) * dec; kd[s * 64 + i + 32] = (x2 * c + x1 * sn) * dec; }
        for (int idx = tid; idx < 16384; idx += NTHR) { const int s = idx >> 7, e = idx & 127; vv[idx] = bf2f(H0[(t0 + s) * AB_IN + 1024 + h * 128 + e]); }
        __syncthreads();
        const int e = tid & 127, dg = tid >> 7;
        float acc[16];
#pragma unroll
        for (int j = 0; j < 16; ++j) acc[j] = 0.f;
        for (int s = 0; s < 128; ++s) { const float v = vv[s * 128 + e];
#pragma unroll
            for (int j = 0; j < 16; ++j) acc[j] += kd[s * 64 + dg * 16 + j] * v; }
#pragma unroll
        for (int j = 0; j < 16; ++j) LST[(size_t)item * 8192 + (dg * 16 + j) * 128 + e] = acc[j];
        __syncthreads();
    }
}
__device__ __forceinline__ void phase_ret_prefix(unsigned char* ws) {
    float* LST = (float*)(ws + WS_LST);
    const size_t gt = (size_t)blockIdx.x * NTHR + threadIdx.x, NT = (size_t)gridDim.x * NTHR;
    for (size_t idx = gt; idx < (size_t)32 * 8192; idx += NT) { const int bh = (int)(idx >> 13), el = (int)(idx & 8191), h = bh & 3;
        const float g128 = exp2f(128.f * gamma_log2(h)); float S = 0.f;
        for (int n = 0; n < 32; ++n) { float* p = LST + ((size_t)(bh * 32 + n) * 8192 + el); const float tmp = *p; *p = S; S = S * g128 + tmp; } }
}
__device__ __forceinline__ void phase_ret_out_pool(LAS unsigned char* lds, const float* const* in, unsigned char* ws) {
    const int tid = threadIdx.x;
    const bf16* H0 = (const bf16*)(ws + WS_H0); const float* LST = (const float*)(ws + WS_LST); bf16* Y = (bf16*)(ws + WS_Y);
    const float* ct = (const float*)(ws + WS_ROPE); const float* st = ct + 4096 * 32;
    const float* pool_w = in[2]; const float* pool_scale = in[3]; const float* ret_g = in[4];
    LAS float* qs = (LAS float*)lds;
    LAS float* ks = qs + 128 * 65;
    LAS float* R2 = (LAS float*)(lds + 66560);
    LAS float* PA = (LAS float*)lds;
    LAS float* PB = (LAS float*)(lds + 66048);
    for (int item = blockIdx.x; item < 256; item += gridDim.x) {
        const int n = item & 31, b = item >> 5; const size_t t0 = (size_t)b * SEQ + n * 128;
        const int c = tid >> 2, eg = tid & 3;
        for (int h = 0; h < 4; ++h) {
            const float lg = gamma_log2(h);
            for (int idx = tid; idx < 4096; idx += NTHR) { const int s = idx >> 5, i = idx & 31, pos = n * 128 + s;
                const bf16* rq = H0 + (t0 + s) * AB_IN + 512 + h * 64; const bf16* rk = H0 + (t0 + s) * AB_IN + 768 + h * 64;
                const float cs = ct[pos * 32 + i], sn = st[pos * 32 + i];
                const float q1 = bf2f(rq[i]), q2 = bf2f(rq[i + 32]), k1 = bf2f(rk[i]), k2 = bf2f(rk[i + 32]);
                qs[s * 65 + i] = q1 * cs - q2 * sn; qs[s * 65 + i + 32] = q2 * cs + q1 * sn;
                ks[s * 65 + i] = (k1 * cs - k2 * sn) * 0.125f; ks[s * 65 + i + 32] = (k2 * cs + k1 * sn) * 0.125f; }
            { const float* Sg = LST + (size_t)((b * 4 + h) * 32 + n) * 8192;
              for (int idx = tid; idx < 8192; idx += NTHR) R2[idx] = Sg[idx]; }
            __syncthreads();
            float o[32];
#pragma unroll
            for (int j = 0; j < 32; ++j) o[j] = 0.f;
            for (int d = 0; d < 64; ++d) { const float qv = qs[c * 65 + d];
#pragma unroll
                for (int j = 0; j < 32; ++j) o[j] += qv * R2[d * 128 + eg * 32 + j]; }
            { const float qd = exp2f((float)(c + 1) * lg);
#pragma unroll
              for (int j = 0; j < 32; ++j) o[j] *= qd; }
            __syncthreads();
            for (int idx = tid; idx < 16384; idx += NTHR) { const int s = idx >> 7, e = idx & 127; R2[idx] = bf2f(H0[(t0 + s) * AB_IN + 1024 + h * 128 + e]); }
            __syncthreads();
            for (int s = 0; s <= c; ++s) {
                float dot = 0.f;
#pragma unroll 16
                for (int d = 0; d < 64; ++d) dot += qs[c * 65 + d] * ks[s * 65 + d];
                const float w = dot * exp2f((float)(c - s) * lg);
#pragma unroll
                for (int j = 0; j < 32; ++j) o[j] += w * R2[s * 128 + eg * 32 + j];
            }
            float sum = 0.f;
#pragma unroll
            for (int j = 0; j < 32; ++j) sum += o[j];
            sum += __shfl_xor(sum, 1); sum += __shfl_xor(sum, 2);
            const float mean = sum * (1.f / 128.f); float sq = 0.f;
#pragma unroll
            for (int j = 0; j < 32; ++j) { const float dl = o[j] - mean; sq += dl * dl; }
            sq += __shfl_xor(sq, 1); sq += __shfl_xor(sq, 2);
            const float rstd = 1.f / sqrtf(sq * (1.f / 128.f) + LN_EPS);
            { const bf16* rg = H0 + (t0 + c) * AB_IN + 1536 + h * 128 + eg * 32; bf16* yo = Y + (t0 + c) * D + 512 + h * 128 + eg * 32;
#pragma unroll
              for (int j = 0; j < 32; ++j) { const float g = bf2f(rg[j]); const float sg = g / (1.f + expf(-g));
                  yo[j] = (bf16)f2bf((o[j] - mean) * rstd * ret_g[h * 128 + eg * 32 + j] * sg); } }
            __syncthreads();
        }
        for (int gi = 0; gi < 4; ++gi) {
            const int w = 2 << gi;
            for (int idx = tid; idx < 16384; idx += NTHR) { const int s = idx >> 7, cc = idx & 127, pos = n * 128 + s; const int cnt = (pos + 1 < w) ? pos + 1 : w;
                float sum = 0.f; for (int j = 0; j < cnt; ++j) sum += bf2f(H0[(t0 + s - j) * AB_IN + gi * 128 + cc]);
                PA[s * 129 + cc] = sum / (float)cnt - bf2f(H0[(t0 + s) * AB_IN + gi * 128 + cc]); }
            for (int idx = tid; idx < 16384; idx += NTHR) PB[idx] = pool_w[gi * 16384 + idx];
            __syncthreads();
            float o[32];
#pragma unroll
            for (int j = 0; j < 32; ++j) o[j] = 0.f;
            for (int cc = 0; cc < 128; ++cc) { const float pv = PA[c * 129 + cc];
#pragma unroll
                for (int j = 0; j < 32; ++j) o[j] += pv * PB[cc * 128 + eg * 32 + j]; }
            { bf16* yo = Y + (t0 + c) * D + gi * 128 + eg * 32;
#pragma unroll
              for (int j = 0; j < 32; ++j) yo[j] = (bf16)f2bf(o[j] * pool_scale[gi * 128 + eg * 32 + j]); }
            __syncthreads();
        }
    }
}

__device__ __forceinline__ void unpack8(const v4u w, float (&x)[8]) { x[0] = bflo(w.x); x[1] = bfhi(w.x); x[2] = bflo(w.y); x[3] = bfhi(w.y); x[4] = bflo(w.z); x[5] = bfhi(w.z); x[6] = bflo(w.w); x[7] = bfhi(w.w); }
__device__ __forceinline__ v4u pack8(const float (&x)[8]) { v4u w; w.x = pk2(x[0], x[1]); w.y = pk2(x[2], x[3]); w.z = pk2(x[4], x[5]); w.w = pk2(x[6], x[7]); return w; }
__device__ __forceinline__ void phase_ret_out_pool_fast(LAS unsigned char* lds, const float* const* in, unsigned char* ws) {
    const int tid = threadIdx.x, lane = tid & 63, wave = __builtin_amdgcn_readfirstlane(tid >> 6);
    const int c = lane & 31, hh = lane >> 5, cbk = wave & 3, eh = wave >> 2;
    const bf16* H0 = (const bf16*)(ws + WS_H0); const float* LST = (const float*)(ws + WS_LST); bf16* Y = (bf16*)(ws + WS_Y);
    const float* ct = (const float*)(ws + WS_ROPE); const float* st = ct + 4096 * 32;
    const float* pool_scale = in[3]; const float* ret_g = in[4]; const bf16* PWT = (const bf16*)(ws + WS_POOLWT);
    constexpr int O_QP = 0, O_KP = 18432, O_VT = 36864, O_ST = 71680, O_PI = 90112, O_RED = 124928, O_PT = 0, O_WT = 34816;
    for (int item = blockIdx.x; item < 256; item += gridDim.x) {
        const int n = item & 31, b = item >> 5; const size_t t0 = (size_t)b * SEQ + n * 128;
        for (int h = 0; h < 4; ++h) {
            const float lg = gamma_log2(h);
            __syncthreads();
            { const int s = tid >> 2, grp = tid & 3, pos = n * 128 + s;
              const bf16* rq = H0 + (t0 + s) * AB_IN + 512 + h * 64 + 8 * grp; const bf16* rk = H0 + (t0 + s) * AB_IN + 768 + h * 64 + 8 * grp;
              float q1[8], q2[8], k1[8], k2[8], cs[8], sn[8];
              unpack8(*(const GAS v4u*)rq, q1); unpack8(*(const GAS v4u*)(rq + 32), q2); unpack8(*(const GAS v4u*)rk, k1); unpack8(*(const GAS v4u*)(rk + 32), k2);
              { const f32x4 a = *(const GAS f32x4*)(ct + pos * 32 + 8 * grp), bq = *(const GAS f32x4*)(ct + pos * 32 + 8 * grp + 4);
                cs[0] = a.x; cs[1] = a.y; cs[2] = a.z; cs[3] = a.w; cs[4] = bq.x; cs[5] = bq.y; cs[6] = bq.z; cs[7] = bq.w; }
              { const f32x4 a = *(const GAS f32x4*)(st + pos * 32 + 8 * grp), bq = *(const GAS f32x4*)(st + pos * 32 + 8 * grp + 4);
                sn[0] = a.x; sn[1] = a.y; sn[2] = a.z; sn[3] = a.w; sn[4] = bq.x; sn[5] = bq.y; sn[6] = bq.z; sn[7] = bq.w; }
              const float gq = exp2f((float)(s + 1) * lg), gk = 0.125f * exp2f(-(float)(s + 1) * lg);
              float qa[8], qb[8], ka[8], kb[8];
#pragma unroll
              for (int j = 0; j < 8; ++j) { qa[j] = (q1[j] * cs[j] - q2[j] * sn[j]) * gq; qb[j] = (q2[j] * cs[j] + q1[j] * sn[j]) * gq;
                                            ka[j] = (k1[j] * cs[j] - k2[j] * sn[j]) * gk; kb[j] = (k2[j] * cs[j] + k1[j] * sn[j]) * gk; }
              *(LAS v4u*)(lds + O_QP + s * 144 + 16 * grp) = pack8(qa); *(LAS v4u*)(lds + O_QP + s * 144 + 64 + 16 * grp) = pack8(qb);
              *(LAS v4u*)(lds + O_KP + s * 144 + 16 * grp) = pack8(ka); *(LAS v4u*)(lds + O_KP + s * 144 + 64 + 16 * grp) = pack8(kb); }
#pragma unroll
            for (int i = 0; i < 4; ++i) { const int task = tid + 512 * i, e8 = task >> 7, s = task & 127;
                const v4u w = *(const GAS v4u*)(H0 + (t0 + s) * AB_IN + 1024 + h * 128 + 8 * e8);
                LAS bf16* d = (LAS bf16*)(lds + O_VT + (8 * e8) * 272 + 2 * s);
                d[0 * 136] = (bf16)(w.x & 0xffffu); d[1 * 136] = (bf16)(w.x >> 16); d[2 * 136] = (bf16)(w.y & 0xffffu); d[3 * 136] = (bf16)(w.y >> 16);
                d[4 * 136] = (bf16)(w.z & 0xffffu); d[5 * 136] = (bf16)(w.z >> 16); d[6 * 136] = (bf16)(w.w & 0xffffu); d[7 * 136] = (bf16)(w.w >> 16); }
            { const float* Sg = LST + (size_t)((b * 4 + h) * 32 + n) * 8192;
#pragma unroll
              for (int i = 0; i < 4; ++i) { const int task = tid + 512 * i, e4 = task >> 6, d = task & 63;
                  const f32x4 sv = *(const GAS f32x4*)(Sg + d * 128 + 4 * e4);
                  LAS bf16* o = (LAS bf16*)(lds + O_ST + (4 * e4) * 144 + 2 * d);
                  o[0 * 72] = (bf16)f2bf(sv.x); o[1 * 72] = (bf16)f2bf(sv.y); o[2 * 72] = (bf16)f2bf(sv.z); o[3 * 72] = (bf16)f2bf(sv.w); } }
            __syncthreads();
            bf16x8 qf[4];
#pragma unroll
            for (int ks = 0; ks < 4; ++ks) qf[ks] = *(const LAS bf16x8*)(lds + O_QP + (32 * cbk + c) * 144 + (16 * ks + 8 * hh) * 2);
            for (int sb = 0; sb <= cbk; ++sb) {
                f32x16 sc;
#pragma unroll
                for (int r = 0; r < 16; ++r) sc[r] = 0.f;
#pragma unroll
                for (int ks = 0; ks < 4; ++ks) { const bf16x8 kf = *(const LAS bf16x8*)(lds + O_KP + (32 * sb + c) * 144 + (16 * ks + 8 * hh) * 2);
                    sc = __builtin_amdgcn_mfma_f32_32x32x16_bf16(kf, qf[ks], sc, 0, 0, 0); }
#pragma unroll
                for (int g4 = 0; g4 < 4; ++g4) { float m[4];
#pragma unroll
                    for (int q = 0; q < 4; ++q) { const float sv = sc[4 * g4 + q]; m[q] = (sb < cbk || 8 * g4 + 4 * hh + q <= c) ? sv : 0.f; }
                    *(LAS v2u*)(lds + O_PI + cbk * 8704 + c * 272 + (32 * sb + 8 * g4 + 4 * hh) * 2) = (v2u){pk2(m[0], m[1]), pk2(m[2], m[3])}; }
            }
            f32x16 acc[2];
#pragma unroll
            for (int j = 0; j < 2; ++j) {
#pragma unroll
                for (int r = 0; r < 16; ++r) acc[j][r] = 0.f;
                const int eb = 2 * eh + j;
                for (int sb = 0; sb <= cbk; ++sb) {
#pragma unroll
                    for (int ks = 0; ks < 2; ++ks) { const bf16x8 af = *(const LAS bf16x8*)(lds + O_VT + (32 * eb + c) * 272 + (32 * sb + 16 * ks + 8 * hh) * 2);
                        const bf16x8 pf = *(const LAS bf16x8*)(lds + O_PI + cbk * 8704 + c * 272 + (32 * sb + 16 * ks + 8 * hh) * 2);
                        acc[j] = __builtin_amdgcn_mfma_f32_32x32x16_bf16(af, pf, acc[j], 0, 0, 0); }
                }
#pragma unroll
                for (int ks = 0; ks < 4; ++ks) { const bf16x8 sf = *(const LAS bf16x8*)(lds + O_ST + (32 * eb + c) * 144 + (16 * ks + 8 * hh) * 2);
                    acc[j] = __builtin_amdgcn_mfma_f32_32x32x16_bf16(sf, qf[ks], acc[j], 0, 0, 0); }
            }
            float sum = 0.f, sq = 0.f;
#pragma unroll
            for (int j = 0; j < 2; ++j)
#pragma unroll
                for (int r = 0; r < 16; ++r) { const float ov = acc[j][r]; sum += ov; sq += ov * ov; }
            sum += __shfl_xor(sum, 32); sq += __shfl_xor(sq, 32);
            LAS float* red = (LAS float*)(lds + O_RED);
            if (hh == 0) { red[(eh * 128 + 32 * cbk + c) * 2] = sum; red[(eh * 128 + 32 * cbk + c) * 2 + 1] = sq; }
            __syncthreads();
            sum += red[((eh ^ 1) * 128 + 32 * cbk + c) * 2]; sq += red[((eh ^ 1) * 128 + 32 * cbk + c) * 2 + 1];
            const float mean = sum * (1.f / 128.f); const float var = fmaxf(sq * (1.f / 128.f) - mean * mean, 0.f);
            const float rstd = 1.f / sqrtf(var + LN_EPS);
            { const size_t row = t0 + 32 * cbk + c;
#pragma unroll
              for (int j = 0; j < 2; ++j)
#pragma unroll
                  for (int g4 = 0; g4 < 4; ++g4) { const int e = 32 * (2 * eh + j) + 8 * g4 + 4 * hh;
                      const v2u gw2 = *(const GAS v2u*)(H0 + row * AB_IN + 1536 + h * 128 + e); const f32x4 gm = *(const GAS f32x4*)(ret_g + h * 128 + e);
                      const float g0 = bflo(gw2.x), g1 = bfhi(gw2.x), g2 = bflo(gw2.y), g3 = bfhi(gw2.y);
                      const float o0 = acc[j][4 * g4 + 0], o1 = acc[j][4 * g4 + 1], o2 = acc[j][4 * g4 + 2], o3 = acc[j][4 * g4 + 3];
                      const float y0 = (o0 - mean) * rstd * gm.x * (g0 / (1.f + __expf(-g0))), y1 = (o1 - mean) * rstd * gm.y * (g1 / (1.f + __expf(-g1)));
                      const float y2 = (o2 - mean) * rstd * gm.z * (g2 / (1.f + __expf(-g2))), y3 = (o3 - mean) * rstd * gm.w * (g3 / (1.f + __expf(-g3)));
                      *(GAS v2u*)(Y + row * D + 512 + h * 128 + e) = (v2u){pk2(y0, y1), pk2(y2, y3)}; } }
        }
        for (int gi = 0; gi < 4; ++gi) {
            const int w = 2 << gi;
            __syncthreads();
#pragma unroll
            for (int i = 0; i < 4; ++i) { const int task = tid + 512 * i, t = task >> 4, c8 = task & 15, pos = n * 128 + t; const int cnt = (pos + 1 < w) ? pos + 1 : w;
                const bf16* ur = H0 + (t0 + t) * AB_IN + gi * 128 + 8 * c8;
                float u0[8], sm[8]; unpack8(*(const GAS v4u*)ur, u0);
#pragma unroll
                for (int q = 0; q < 8; ++q) sm[q] = u0[q];
                for (int j = 1; j < cnt; ++j) { float uj[8]; unpack8(*(const GAS v4u*)(ur - (size_t)j * AB_IN), uj);
#pragma unroll
                    for (int q = 0; q < 8; ++q) sm[q] += uj[q]; }
                const float ic = 1.f / (float)cnt; float pv[8];
#pragma unroll
                for (int q = 0; q < 8; ++q) pv[q] = sm[q] * ic - u0[q];
                *(LAS v4u*)(lds + O_PT + t * 272 + 16 * c8) = pack8(pv); }
#pragma unroll
            for (int i = 0; i < 4; ++i) { const int piece = tid + 512 * i, d = piece >> 4, c16 = piece & 15;
                *(LAS v4u*)(lds + O_WT + d * 272 + 16 * c16) = *(const GAS v4u*)(PWT + (size_t)(gi * 128 + d) * 128 + 8 * c16); }
            __syncthreads();
            bf16x8 pfr[8];
#pragma unroll
            for (int ks = 0; ks < 8; ++ks) pfr[ks] = *(const LAS bf16x8*)(lds + O_PT + (32 * cbk + c) * 272 + (16 * ks + 8 * hh) * 2);
#pragma unroll
            for (int j = 0; j < 2; ++j) { const int db = 2 * eh + j;
                f32x16 a2;
#pragma unroll
                for (int r = 0; r < 16; ++r) a2[r] = 0.f;
#pragma unroll
                for (int ks = 0; ks < 8; ++ks) { const bf16x8 wf = *(const LAS bf16x8*)(lds + O_WT + (32 * db + c) * 272 + (16 * ks + 8 * hh) * 2);
                    a2 = __builtin_amdgcn_mfma_f32_32x32x16_bf16(wf, pfr[ks], a2, 0, 0, 0); }
#pragma unroll
                for (int g4 = 0; g4 < 4; ++g4) { const int d0 = 32 * db + 8 * g4 + 4 * hh; const f32x4 ps = *(const GAS f32x4*)(pool_scale + gi * 128 + d0);
                    const float y0 = a2[4 * g4 + 0] * ps.x, y1 = a2[4 * g4 + 1] * ps.y, y2 = a2[4 * g4 + 2] * ps.z, y3 = a2[4 * g4 + 3] * ps.w;
                    *(GAS v2u*)(Y + (t0 + 32 * cbk + c) * D + gi * 128 + d0) = (v2u){pk2(y0, y1), pk2(y2, y3)}; }
            }
        }
    }
    __syncthreads();
}
__device__ __forceinline__ void phase_ln(const float* Z, bf16* O, const float* g, const float* bb) {
    const int tid = threadIdx.x, lane = tid & 63, wave = tid >> 6;
    const int gw = blockIdx.x * NWAVES + wave, NGW = gridDim.x * NWAVES;
    for (int m = gw; m < T; m += NGW) {
        const GAS f32x4* zr = (const GAS f32x4*)(Z + (size_t)m * D) + lane;
        f32x4 v[4]; float s = 0.f;
#pragma unroll
        for (int j = 0; j < 4; ++j) { v[j] = zr[64 * j]; s += (v[j].x + v[j].y) + (v[j].z + v[j].w); }
        const float mean = wave_sum(s) * (1.f / D); float s2 = 0.f;
#pragma unroll
        for (int j = 0; j < 4; ++j) { v[j] = v[j] - mean; s2 += (v[j].x * v[j].x + v[j].y * v[j].y) + (v[j].z * v[j].z + v[j].w * v[j].w); }
        const float rstd = 1.f / sqrtf(wave_sum(s2) * (1.f / D) + LN_EPS);
        GAS v2u* o8 = (GAS v2u*)(O + (size_t)m * D) + lane;
#pragma unroll
        for (int j = 0; j < 4; ++j) { const f32x4 gg = *((const GAS f32x4*)g + lane + 64 * j), b4 = *((const GAS f32x4*)bb + lane + 64 * j);
            v2u o; o.x = pk2(v[j].x * rstd * gg.x + b4.x, v[j].y * rstd * gg.y + b4.y); o.y = pk2(v[j].z * rstd * gg.z + b4.z, v[j].w * rstd * gg.w + b4.w); o8[64 * j] = o; }
    }
}
__device__ __forceinline__ void wave_argmax(float& bv, int& bi) {
#pragma unroll
    for (int off = 32; off >= 1; off >>= 1) { const float ov = __shfl_xor(bv, off); const int oi = __shfl_xor(bi, off);
        if (ov > bv || (ov == bv && oi < bi)) { bv = ov; bi = oi; } }
}
__device__ __forceinline__ void phase_topk(LAS unsigned char* lds, const bf16* Q, const float* keys  , int* EID, float* GATE) {
    const int tid = threadIdx.x, lane = tid & 63, wave = tid >> 6;
    LAS float* kl = (LAS float*)lds;
    LAS float* qt = (LAS float*)(lds + 66048);
    LAS float* sc = (LAS float*)(lds + 82560);
    for (int item = blockIdx.x; item < (T / 32) * 8; item += gridDim.x) {
        const int h = item & 7, tile = item >> 3; const size_t tok0 = (size_t)tile * 32;
        for (int p = 0; p < 2; ++p) {
            const float* kg = keys + (size_t)((h * 2 + p) * 128) * 128;
            for (int idx = tid; idx < 16384; idx += NTHR) { const int k = idx >> 7, d = idx & 127; kl[k * 129 + d] = kg[idx]; }
            for (int idx = tid; idx < 4096; idx += NTHR) { const int t = idx >> 7, d = idx & 127; qt[t * 129 + d] = bf2f(Q[(tok0 + t) * 2048 + h * 256 + p * 128 + d]); }
            __syncthreads();
            { const int t = tid >> 4, kg16 = tid & 15;
              for (int jj = 0; jj < 8; ++jj) { const int k = kg16 + 16 * jj; float dot = 0.f;
#pragma unroll 16
                  for (int d = 0; d < 128; ++d) dot += qt[t * 129 + d] * kl[k * 129 + d];
                  sc[(t * 2 + p) * 128 + k] = dot; } }
            __syncthreads();
        }
        for (int tt = 0; tt < 4; ++tt) {
            const int t = wave * 4 + tt;
            float tv[2]; int ti[2];
#pragma unroll
            for (int p = 0; p < 2; ++p) {
                float v0 = sc[(t * 2 + p) * 128 + lane], v1 = sc[(t * 2 + p) * 128 + lane + 64];
                float mv = 0.f; int mi = 0;
                for (int j = 0; j < 16; ++j) {
                    float bv; int bi; if (v0 >= v1) { bv = v0; bi = lane; } else { bv = v1; bi = lane + 64; }
                    wave_argmax(bv, bi);
                    if (lane == j) { mv = bv; mi = bi; }
                    if (bi == lane) v0 = -INFINITY; if (bi == lane + 64) v1 = -INFINITY;
                }
                tv[p] = mv; ti[p] = mi;
            }
            float cv[4];
#pragma unroll
            for (int m = 0; m < 4; ++m) { const int cidx = lane + 64 * m; cv[m] = __shfl(tv[0], cidx >> 4) + __shfl(tv[1], cidx & 15); }
            float bestv = 0.f; int bestc = 0;
            for (int j = 0; j < 16; ++j) {
                float bv = cv[0]; int bi = lane;
#pragma unroll
                for (int m = 1; m < 4; ++m) if (cv[m] > bv) { bv = cv[m]; bi = lane + 64 * m; }
                wave_argmax(bv, bi);
                if (lane == j) { bestv = bv; bestc = bi; }
#pragma unroll
                for (int m = 0; m < 4; ++m) if (bi == lane + 64 * m) cv[m] = -INFINITY;
            }
            const float mx = __shfl(bestv, 0);
            const float ex = (lane < 16) ? expf(bestv - mx) : 0.f;
            const float den = wave_sum(ex);
            const int ia = __shfl(ti[0], bestc >> 4), ib = __shfl(ti[1], bestc & 15);
            if (lane < 16) { const size_t o = (tok0 + t) * 128 + h * 16 + lane; EID[o] = ia * 128 + ib; GATE[o] = ex / den; }
        }
        __syncthreads();
    }
}

#define CEF_D(a, b) { const float hi_ = fmaxf((a), (b)), lo_ = fminf((a), (b)); (a) = hi_; (b) = lo_; }
#define CEF_A(a, b) { const float hi_ = fmaxf((a), (b)), lo_ = fminf((a), (b)); (a) = lo_; (b) = hi_; }
#define CEP_D(ka, pa, kb, pb) { const bool sw_ = (kb) > (ka); const float k0_ = sw_ ? (kb) : (ka), k1_ = sw_ ? (ka) : (kb); const int p0_ = sw_ ? (pb) : (pa), p1_ = sw_ ? (pa) : (pb); (ka) = k0_; (kb) = k1_; (pa) = p0_; (pb) = p1_; }
template <int OFF, int NV> __device__ __forceinline__ void bsort16_desc(float (&v)[NV]) {
#pragma unroll
    for (int k = 2; k <= 16; k <<= 1) {
#pragma unroll
        for (int j = k >> 1; j > 0; j >>= 1) {
#pragma unroll
            for (int i = 0; i < 16; ++i) { const int l = i ^ j;
                if (l > i) { if ((i & k) == 0) CEF_D(v[OFF + i], v[OFF + l]) else CEF_A(v[OFF + i], v[OFF + l]) } }
        }
    }
}
template <int OA, int NV> __device__ __forceinline__ void bmerge16_desc(float (&v)[NV]) {
#pragma unroll
    for (int j = 8; j > 0; j >>= 1) {
#pragma unroll
        for (int i = 0; i < 16; ++i) { const int l = i ^ j; if (l > i) CEF_D(v[OA + i], v[OA + l]) }
    }
}
template <int OA, int OB, int NV> __device__ __forceinline__ void merge_top16(float (&v)[NV]) {
#pragma unroll
    for (int i = 0; i < 16; ++i) v[OA + i] = fmaxf(v[OA + i], v[OB + 15 - i]);
    bmerge16_desc<OA, NV>(v);
}
template <int OFF, int NV> __device__ __forceinline__ void bsort16p_desc(float (&v)[NV], int (&q)[NV]) {
#pragma unroll
    for (int k = 2; k <= 16; k <<= 1) {
#pragma unroll
        for (int j = k >> 1; j > 0; j >>= 1) {
#pragma unroll
            for (int i = 0; i < 16; ++i) { const int l = i ^ j;
                if (l > i) { if ((i & k) == 0) CEP_D(v[OFF + i], q[OFF + i], v[OFF + l], q[OFF + l]) else CEP_D(v[OFF + l], q[OFF + l], v[OFF + i], q[OFF + i]) } }
        }
    }
}
template <int OA, int NV> __device__ __forceinline__ void bmerge16p_desc(float (&v)[NV], int (&q)[NV]) {
#pragma unroll
    for (int j = 8; j > 0; j >>= 1) {
#pragma unroll
        for (int i = 0; i < 16; ++i) { const int l = i ^ j; if (l > i) CEP_D(v[OA + i], q[OA + i], v[OA + l], q[OA + l]) }
    }
}
__host__ __device__ constexpr int pair_i(int s) { return s < 16 ? 0 : s < 24 ? 1 : s < 29 ? 2 : s < 33 ? 3 : s < 36 ? 4 : s < 38 ? 5 : s < 40 ? 6 : s < 42 ? 7 : (s - 42 + 8); }
__host__ __device__ constexpr int pair_j(int s) { return s < 16 ? s : s < 24 ? s - 16 : s < 29 ? s - 24 : s < 33 ? s - 29 : s < 36 ? s - 33 : s < 38 ? s - 36 : s < 40 ? s - 38 : s < 42 ? s - 40 : 0; }
__device__ __forceinline__ void phase_topk_fast(LAS unsigned char* lds, const bf16* Q, const bf16* keysb  , int* EID, float* GATE) {
    const int tid = threadIdx.x, lane = tid & 63, wave = __builtin_amdgcn_readfirstlane(tid >> 6);
    const int c = lane & 31, hh = lane >> 5;
    for (int hi = blockIdx.x; hi < 256; hi += gridDim.x) {
        const int h = hi & 7, rank = hi >> 3;
        __syncthreads();
        for (int idx = tid; idx < 2 * 128 * 16; idx += NTHR) { const int rowi = idx >> 4, ch = idx & 15;
            const v4u kv = *(const GAS v4u*)(keysb + (size_t)h * 32768 + rowi * 128 + ch * 8);
            *(LAS v4u*)(lds + rowi * 272 + ch * 16) = kv; }
        __syncthreads();
        for (int it = 0; it < 4; ++it) {
            const int tile = rank * 8 + wave + 256 * it;
            const size_t tok0 = (size_t)tile * 32;
            float ta[16], tb[16];
#pragma unroll
            for (int p = 0; p < 2; ++p) {
                bf16x8 bq[8];
                const bf16* qrow = Q + (tok0 + c) * 2048 + h * 256 + p * 128 + 8 * hh;
#pragma unroll
                for (int ks = 0; ks < 8; ++ks) bq[ks] = *(const GAS bf16x8*)(qrow + 16 * ks);
                f32x16 acc[4];
#pragma unroll
                for (int blk = 0; blk < 4; ++blk) {
#pragma unroll
                    for (int r = 0; r < 16; ++r) acc[blk][r] = 0.f;
#pragma unroll
                    for (int ks = 0; ks < 8; ++ks) { const bf16x8 a = *(const LAS bf16x8*)(lds + (p * 128 + 32 * blk + c) * 272 + (16 * ks + 8 * hh) * 2);
                        acc[blk] = __builtin_amdgcn_mfma_f32_32x32x16_bf16(a, bq[ks], acc[blk], 0, 0, 0); }
                }
                float v[64];
#pragma unroll
                for (int blk = 0; blk < 4; ++blk)
#pragma unroll
                    for (int r = 0; r < 16; ++r)
                    { const float sv = acc[blk][r]; v[blk * 16 + r] = __uint_as_float((__float_as_uint(sv) & ~127u) | (unsigned)(32 * blk + (r & 3) + 8 * (r >> 2)) | (unsigned)(hh << 2)); }
                __builtin_amdgcn_sched_barrier(0);
                bsort16_desc<0, 64>(v); bsort16_desc<16, 64>(v); bsort16_desc<32, 64>(v); bsort16_desc<48, 64>(v);
                merge_top16<0, 16, 64>(v); merge_top16<32, 48, 64>(v); merge_top16<0, 32, 64>(v);
                float o[16];
#pragma unroll
                for (int i = 0; i < 16; ++i) o[i] = __shfl_xor(v[i], 32);
#pragma unroll
                for (int i = 0; i < 16; ++i) v[i] = fmaxf(v[i], o[15 - i]);
                bmerge16_desc<0, 64>(v);
#pragma unroll
                for (int i = 0; i < 16; ++i) { if (p == 0) ta[i] = v[i]; else tb[i] = v[i]; }
                __builtin_amdgcn_sched_barrier(0);
            }
            float av[16], bv[16]; int ai[16], bi[16];
#pragma unroll
            for (int i = 0; i < 16; ++i) { const unsigned ua = __builtin_bit_cast(unsigned, ta[i]), ub = __builtin_bit_cast(unsigned, tb[i]);
                av[i] = __builtin_bit_cast(float, ua & ~127u); ai[i] = (int)(ua & 127u); bv[i] = __builtin_bit_cast(float, ub & ~127u); bi[i] = (int)(ub & 127u); }
            float ck[32]; int cp[32];
#pragma unroll
            for (int s2 = 0; s2 < 32; ++s2) {
                const float k0 = av[pair_i(s2)] + bv[pair_j(s2)]; const int p0 = (ai[pair_i(s2)] << 7) | bi[pair_j(s2)];
                float k1 = -INFINITY; int p1 = 0;
                if (s2 + 32 < 50) { k1 = av[pair_i(s2 + 32 < 50 ? s2 + 32 : 0)] + bv[pair_j(s2 + 32 < 50 ? s2 + 32 : 0)]; p1 = (ai[pair_i(s2 + 32 < 50 ? s2 + 32 : 0)] << 7) | bi[pair_j(s2 + 32 < 50 ? s2 + 32 : 0)]; }
                ck[s2] = hh ? k1 : k0; cp[s2] = hh ? p1 : p0;
            }
            __builtin_amdgcn_sched_barrier(0);
            bsort16p_desc<0, 32>(ck, cp); bsort16p_desc<16, 32>(ck, cp);
#pragma unroll
            for (int i = 0; i < 16; ++i) { if (ck[16 + 15 - i] > ck[i]) { ck[i] = ck[16 + 15 - i]; cp[i] = cp[16 + 15 - i]; } }
            bmerge16p_desc<0, 32>(ck, cp);
            { float ok[16]; int op[16];
#pragma unroll
              for (int i = 0; i < 16; ++i) { ok[i] = __shfl_xor(ck[i], 32); op[i] = __shfl_xor(cp[i], 32); }
#pragma unroll
              for (int i = 0; i < 16; ++i) { if (ok[15 - i] > ck[i]) { ck[i] = ok[15 - i]; cp[i] = op[15 - i]; } } }
            bmerge16p_desc<0, 32>(ck, cp);
            float ex[16]; float sum = 0.f;
#pragma unroll
            for (int i = 0; i < 16; ++i) { ex[i] = __expf(ck[i] - ck[0]); sum += ex[i]; }
            const float inv = 1.f / sum;
            if (hh == 0) {
                int* eo = EID + (tok0 + c) * 128 + h * 16; float* go = GATE + (tok0 + c) * 128 + h * 16;
#pragma unroll
                for (int i = 0; i < 4; ++i) { *(GAS v4u*)(eo + 4 * i) = (v4u){(unsigned)cp[4 * i], (unsigned)cp[4 * i + 1], (unsigned)cp[4 * i + 2], (unsigned)cp[4 * i + 3]};
                    *(GAS f32x4*)(go + 4 * i) = (f32x4){ex[4 * i] * inv, ex[4 * i + 1] * inv, ex[4 * i + 2] * inv, ex[4 * i + 3] * inv}; }
            }
        }
    }
    __syncthreads();
}
template <bool FINAL>
__device__ __forceinline__ void phase_gather(const bf16* X, const int* EID, const float* GATE, const float* U, const float* V, const float* g, const float* bb, bf16* Ob, float* Of) {
    const int tid = threadIdx.x, lane = tid & 63, wave = tid >> 6;
    const int gw = blockIdx.x * NWAVES + wave, NGW = gridDim.x * NWAVES;
    for (int t = gw; t < T; t += NGW) {
        f32x4 x[4], acc[4];
#pragma unroll
        for (int j = 0; j < 4; ++j) { const v2u w = *((const GAS v2u*)(X + (size_t)t * D) + lane + 64 * j);
            x[j] = (f32x4){bflo(w.x), bfhi(w.x), bflo(w.y), bfhi(w.y)}; acc[j] = (f32x4){0.f, 0.f, 0.f, 0.f}; }
        const int e0 = EID[(size_t)t * 128 + lane], e1 = EID[(size_t)t * 128 + 64 + lane];
        const float g0 = GATE[(size_t)t * 128 + lane], g1 = GATE[(size_t)t * 128 + 64 + lane];
#pragma unroll 2
        for (int k = 0; k < 128; ++k) {
            const int e = (k < 64) ? __shfl(e0, k) : __shfl(e1, k - 64);
            const float gt = (k < 64) ? __shfl(g0, k) : __shfl(g1, k - 64);
            const GAS f32x4* ur = (const GAS f32x4*)(U + (size_t)e * D) + lane;
            float dot = 0.f;
#pragma unroll
            for (int j = 0; j < 4; ++j) { const f32x4 u = ur[64 * j]; dot += (x[j].x * u.x + x[j].y * u.y) + (x[j].z * u.z + x[j].w * u.w); }
            dot = wave_sum(dot);
            const float a = 0.5f * dot * (1.f + erff(dot * 0.70710678118654752f));
            const float cf = gt * a;
            const GAS f32x4* vr = (const GAS f32x4*)(V + (size_t)e * D) + lane;
#pragma unroll
            for (int j = 0; j < 4; ++j) { const f32x4 v = vr[64 * j]; acc[j] += cf * v; }
        }
        float s = 0.f;
#pragma unroll
        for (int j = 0; j < 4; ++j) { acc[j] = ALPHA * x[j] + acc[j]; s += (acc[j].x + acc[j].y) + (acc[j].z + acc[j].w); }
        const float mean = wave_sum(s) * (1.f / D); float s2 = 0.f;
#pragma unroll
        for (int j = 0; j < 4; ++j) { acc[j] = acc[j] - mean; s2 += (acc[j].x * acc[j].x + acc[j].y * acc[j].y) + (acc[j].z * acc[j].z + acc[j].w * acc[j].w); }
        const float rstd = 1.f / sqrtf(wave_sum(s2) * (1.f / D) + LN_EPS);
#pragma unroll
        for (int j = 0; j < 4; ++j) { const f32x4 gg = *((const GAS f32x4*)g + lane + 64 * j), b4 = *((const GAS f32x4*)bb + lane + 64 * j);
            const f32x4 o = acc[j] * rstd * gg + b4;
            if (FINAL) *((GAS f32x4*)(Of + (size_t)t * D) + lane + 64 * j) = o;
            else { v2u w; w.x = pk2(o.x, o.y); w.y = pk2(o.z, o.w); *((GAS v2u*)(Ob + (size_t)t * D) + lane + 64 * j) = w; } }
    }
}

typedef float f32x2 __attribute__((ext_vector_type(2)));
__device__ __forceinline__ void phase_convert_tables(const float* U, const float* V, unsigned char* ws) {
    const int tid = threadIdx.x, lane = tid & 63, wave = tid >> 6;
    const int gw = blockIdx.x * NWAVES + wave, NGW = gridDim.x * NWAVES;
    for (int row = gw; row < 4 * NEXP; row += NGW) {
        const bool isv = row >= 2 * NEXP; const int r = row & (2 * NEXP - 1);
        const GAS f32x4* src = (const GAS f32x4*)((isv ? V : U) + (size_t)r * D) + lane;
        f32x4 v[4]; float m = 0.f;
#pragma unroll
        for (int j = 0; j < 4; ++j) { v[j] = src[64 * j]; m = fmaxf(fmaxf(m, fmaxf(fabsf(v[j].x), fabsf(v[j].y))), fmaxf(fabsf(v[j].z), fabsf(v[j].w))); }
#pragma unroll
        for (int o = 1; o < 64; o <<= 1) m = fmaxf(m, __shfl_xor(m, o));
        m = fmaxf(m, 1e-30f);
        const float sc = 7.f / m;
        unsigned w0 = 0u, w1 = 0u;
#define Q4(x) fminf(fmaxf((x) * sc, -6.f), 6.f)
        w0 = __builtin_amdgcn_cvt_scalef32_pk_fp4_f32(w0, Q4(v[0].x), Q4(v[0].y), 1.0f, 0); w0 = __builtin_amdgcn_cvt_scalef32_pk_fp4_f32(w0, Q4(v[0].z), Q4(v[0].w), 1.0f, 1);
        w0 = __builtin_amdgcn_cvt_scalef32_pk_fp4_f32(w0, Q4(v[1].x), Q4(v[1].y), 1.0f, 2); w0 = __builtin_amdgcn_cvt_scalef32_pk_fp4_f32(w0, Q4(v[1].z), Q4(v[1].w), 1.0f, 3);
        w1 = __builtin_amdgcn_cvt_scalef32_pk_fp4_f32(w1, Q4(v[2].x), Q4(v[2].y), 1.0f, 0); w1 = __builtin_amdgcn_cvt_scalef32_pk_fp4_f32(w1, Q4(v[2].z), Q4(v[2].w), 1.0f, 1);
        w1 = __builtin_amdgcn_cvt_scalef32_pk_fp4_f32(w1, Q4(v[3].x), Q4(v[3].y), 1.0f, 2); w1 = __builtin_amdgcn_cvt_scalef32_pk_fp4_f32(w1, Q4(v[3].z), Q4(v[3].w), 1.0f, 3);
#undef Q4
        *((GAS v2u*)(ws + (isv ? WS_V8 : WS_U8) + (size_t)r * 512) + lane) = (v2u){w0, w1};
        if (lane == 0) ((float*)(ws + (isv ? WS_DQV : WS_DQU)))[r] = m * (1.f / 7.f);
    }
}
__host__ __device__ constexpr int rev4(int i) { return ((i & 1) << 3) | ((i & 2) << 1) | ((i & 4) >> 1) | ((i & 8) >> 3); }
#define FMA2(a, b, c) __builtin_elementwise_fma((a), (b), (c))
#define CVT8(w, hi) __builtin_amdgcn_cvt_pk_f32_fp8((int)(w), (hi))
template <bool FINAL, int MODE  >
__device__ __forceinline__ void phase_gather8(const bf16* X, const int* EID, float* GATE, const unsigned char* U8, const unsigned char* V8, const float* DQU, const float* DQV,
                                              const float* g, const float* bb, bf16* Ob, float* Of) {
    const int tid = threadIdx.x, lane = tid & 63, wave = tid >> 6;
    const int gw = blockIdx.x * NWAVES + wave, NGW = gridDim.x * NWAVES;
    const bool b0 = (lane & 1) != 0, b1 = (lane & 2) != 0, b2 = (lane & 4) != 0, b3 = (lane & 8) != 0; const int myrow = lane >> 4;
    for (int t = gw; t < T; t += NGW) {
        f32x2 x[8];
#pragma unroll
        for (int j = 0; j < 4; ++j) { const v2u w = *((const GAS v2u*)(X + (size_t)t * D) + lane + 64 * j);
            x[2 * j] = (f32x2){bflo(w.x), bfhi(w.x)}; x[2 * j + 1] = (f32x2){bflo(w.y), bfhi(w.y)}; }
        const int e0 = EID[(size_t)t * 128 + lane], e1 = EID[(size_t)t * 128 + 64 + lane];
        const float gt0 = GATE[(size_t)t * 128 + lane], gt1 = GATE[(size_t)t * 128 + 64 + lane];
        const float dqu0 = DQU[e0], dqu1 = DQU[e1], dqv0 = DQV[e0], dqv1 = DQV[e1];
        float act0 = 0.f, act1 = 0.f;
        if (MODE != 2) {
#pragma unroll
        for (int r = 0; r < 2; ++r) {
            const int er = r ? e1 : e0;
            for (int row = 0; row < 4; ++row) {
                v4u w[16];
#pragma unroll
                for (int i = 0; i < 16; ++i) { const int e = __builtin_amdgcn_readlane(er, row * 16 + rev4(i)); w[i] = *((const GAS v4u*)(U8 + (size_t)e * 1024) + lane); }
                float p[16];
#pragma unroll
                for (int i = 0; i < 16; ++i) { f32x2 a = (f32x2){0.f, 0.f};
                    a = FMA2(x[0], CVT8(w[i].x, false), a); a = FMA2(x[1], CVT8(w[i].x, true), a);
                    a = FMA2(x[2], CVT8(w[i].y, false), a); a = FMA2(x[3], CVT8(w[i].y, true), a);
                    a = FMA2(x[4], CVT8(w[i].z, false), a); a = FMA2(x[5], CVT8(w[i].z, true), a);
                    a = FMA2(x[6], CVT8(w[i].w, false), a); a = FMA2(x[7], CVT8(w[i].w, true), a);
                    p[i] = a.x + a.y; }
                float r8[8], r4[4], r2[2];
#pragma unroll
                for (int i = 0; i < 8; ++i) { const float keep = b0 ? p[8 + i] : p[i], send = b0 ? p[i] : p[8 + i]; r8[i] = keep + __shfl_xor(send, 1); }
#pragma unroll
                for (int i = 0; i < 4; ++i) { const float keep = b1 ? r8[4 + i] : r8[i], send = b1 ? r8[i] : r8[4 + i]; r4[i] = keep + __shfl_xor(send, 2); }
#pragma unroll
                for (int i = 0; i < 2; ++i) { const float keep = b2 ? r4[2 + i] : r4[i], send = b2 ? r4[i] : r4[2 + i]; r2[i] = keep + __shfl_xor(send, 4); }
                float r1 = (b3 ? r2[1] : r2[0]) + __shfl_xor(b3 ? r2[0] : r2[1], 8);
                r1 += __shfl_xor(r1, 16); r1 += __shfl_xor(r1, 32);
                if (myrow == row) { if (r == 0) act0 = r1; else act1 = r1; }
            }
        }
        }
        float c0, c1;
        if (MODE != 2) { const float a0 = act0 * dqu0, a1 = act1 * dqu1;
          c0 = gt0 * (0.5f * a0 * (1.f + erff(a0 * 0.70710678118654752f))) * dqv0;
          c1 = gt1 * (0.5f * a1 * (1.f + erff(a1 * 0.70710678118654752f))) * dqv1; }
        else { c0 = gt0; c1 = gt1; }
        if (MODE == 1) { GATE[(size_t)t * 128 + lane] = c0; GATE[(size_t)t * 128 + 64 + lane] = c1; continue; }
        f32x2 acc[8];
#pragma unroll
        for (int j = 0; j < 8; ++j) acc[j] = (f32x2){0.f, 0.f};
#pragma unroll
        for (int r = 0; r < 2; ++r) {
            const int er = r ? e1 : e0; const int cr = __builtin_bit_cast(int, r ? c1 : c0);
            for (int row = 0; row < 4; ++row) {
                v4u w[16];
#pragma unroll
                for (int i = 0; i < 16; ++i) { const int e = __builtin_amdgcn_readlane(er, row * 16 + i); w[i] = *((const GAS v4u*)(V8 + (size_t)e * 1024) + lane); }
#pragma unroll
                for (int i = 0; i < 16; ++i) { const float cf = __builtin_bit_cast(float, __builtin_amdgcn_readlane(cr, row * 16 + i)); const f32x2 c2 = (f32x2){cf, cf};
                    acc[0] = FMA2(c2, CVT8(w[i].x, false), acc[0]); acc[1] = FMA2(c2, CVT8(w[i].x, true), acc[1]);
                    acc[2] = FMA2(c2, CVT8(w[i].y, false), acc[2]); acc[3] = FMA2(c2, CVT8(w[i].y, true), acc[3]);
                    acc[4] = FMA2(c2, CVT8(w[i].z, false), acc[4]); acc[5] = FMA2(c2, CVT8(w[i].z, true), acc[5]);
                    acc[6] = FMA2(c2, CVT8(w[i].w, false), acc[6]); acc[7] = FMA2(c2, CVT8(w[i].w, true), acc[7]); }
            }
        }
        float s = 0.f;
#pragma unroll
        for (int j = 0; j < 8; ++j) { acc[j] = x[j] * ALPHA + acc[j]; s += acc[j].x + acc[j].y; }
        const float mean = wave_sum(s) * (1.f / D); float s2 = 0.f;
#pragma unroll
        for (int j = 0; j < 8; ++j) { acc[j] = acc[j] - mean; s2 += acc[j].x * acc[j].x + acc[j].y * acc[j].y; }
        const float rstd = 1.f / sqrtf(wave_sum(s2) * (1.f / D) + LN_EPS);
#pragma unroll
        for (int j = 0; j < 4; ++j) { const f32x4 gg = *((const GAS f32x4*)g + lane + 64 * j), b4 = *((const GAS f32x4*)bb + lane + 64 * j);
            const f32x4 o = (f32x4){acc[2 * j].x, acc[2 * j].y, acc[2 * j + 1].x, acc[2 * j + 1].y} * rstd * gg + b4;
            if (FINAL) *((GAS f32x4*)(Of + (size_t)t * D) + lane + 64 * j) = o;
            else { v2u w; w.x = pk2(o.x, o.y); w.y = pk2(o.z, o.w); *((GAS v2u*)(Ob + (size_t)t * D) + lane + 64 * j) = w; } }
    }
}
__device__ __forceinline__ void phase_hgrn(LAS unsigned char* lds, unsigned char* ws) {
    const int tid = threadIdx.x;
    const bf16* CQ = (const bf16*)(ws + WS_CQ); const bf16* CK = (const bf16*)(ws + WS_CK); const bf16* CV = (const bf16*)(ws + WS_CV); bf16* O = (bf16*)(ws + WS_O);
    LAS float* fL = (LAS float*)lds;
    LAS float* kL = fL + 4096; LAS float* qL = kL + 4096;
    LAS float* vL = qL + 4096;
    LAS float* part = vL + 1024;
    for (int item = blockIdx.x; item < 256; item += gridDim.x) {
        const int es = item & 3, h = (item >> 2) & 7, b = item >> 5;
        const int e = tid & 31, dg = tid >> 5;
        float S[8];
#pragma unroll
        for (int j = 0; j < 8; ++j) S[j] = 0.f;
        for (int blk = 0; blk < SEQ / 32; ++blk) {
            const size_t t0 = (size_t)b * SEQ + blk * 32;
            for (int idx = tid; idx < 4096; idx += NTHR) { const int s = idx >> 7, d = idx & 127; const size_t o = (t0 + s) * D + h * 128 + d;
                const float kk = bf2f(CK[o]); kL[idx] = kk; fL[idx] = 1.f - kk; qL[idx] = bf2f(CQ[o]); }
            for (int idx = tid; idx < 1024; idx += NTHR) { const int s = idx >> 5, ee = idx & 31; vL[idx] = bf2f(CV[(t0 + s) * D + h * 128 + es * 32 + ee]); }
            __syncthreads();
            for (int s = 0; s < 32; ++s) { const float v = vL[s * 32 + e]; float po = 0.f;
#pragma unroll
                for (int j = 0; j < 8; ++j) { const int d = dg * 8 + j; S[j] = fL[s * 128 + d] * S[j] + kL[s * 128 + d] * v; po += qL[s * 128 + d] * S[j]; }
                part[(s * 16 + dg) * 32 + e] = po; }
            __syncthreads();
            for (int idx = tid; idx < 1024; idx += NTHR) { const int s = idx >> 5, ee = idx & 31; float o = 0.f;
#pragma unroll
                for (int g = 0; g < 16; ++g) o += part[(s * 16 + g) * 32 + ee];
                O[(t0 + s) * D + h * 128 + es * 32 + ee] = (bf16)f2bf(o); }
            __syncthreads();
        }
    }
}


#define GROW(i_, tab, ereg, lsel) w[i_] = *((const GAS v2u*)((tab) + (size_t)__builtin_amdgcn_readlane((ereg), (lsel)) * 512) + lane)
#define CVT4(wd, bs) __builtin_amdgcn_cvt_scalef32_pk_f32_fp4((wd), 1.0f, (bs))
__device__ __forceinline__ void phase_gather_u(const bf16* X, const int* EID, float* GATE, const unsigned char* U8, const float* DQU, const float* DQV) {
    const int tid = threadIdx.x, lane = tid & 63, wave = tid >> 6;
    const int gw = blockIdx.x * NWAVES + wave, NGW = gridDim.x * NWAVES;
    const bool b0 = (lane & 1) != 0, b1 = (lane & 2) != 0, b2 = (lane & 4) != 0, b3 = (lane & 8) != 0; const int myrow = lane >> 4;
    int t = gw;
    if (t < T) {
    v2u xr[4]; int e0, e1; float gt0, gt1;
#pragma unroll
    for (int j = 0; j < 4; ++j) xr[j] = *((const GAS v2u*)(X + (size_t)t * D) + lane + 64 * j);
    e0 = EID[(size_t)t * 128 + lane]; e1 = EID[(size_t)t * 128 + 64 + lane]; gt0 = GATE[(size_t)t * 128 + lane]; gt1 = GATE[(size_t)t * 128 + 64 + lane];
    v2u w[16];
#pragma unroll
    for (int i = 0; i < 16; ++i) GROW(i, U8, e0, rev4(i));
    for (;;) {
        const int tn = t + NGW; const bool has_next = tn < T;
        v2u nxr[4]; int ne0 = e0, ne1 = e1; float ngt0 = 0.f, ngt1 = 0.f;
        if (has_next) {
#pragma unroll
            for (int j = 0; j < 4; ++j) nxr[j] = *((const GAS v2u*)(X + (size_t)tn * D) + lane + 64 * j);
            ne0 = EID[(size_t)tn * 128 + lane]; ne1 = EID[(size_t)tn * 128 + 64 + lane]; ngt0 = GATE[(size_t)tn * 128 + lane]; ngt1 = GATE[(size_t)tn * 128 + 64 + lane];
        }
        const float dqu0 = DQU[e0], dqu1 = DQU[e1], dqv0 = DQV[e0], dqv1 = DQV[e1];
        f32x2 x[8];
#pragma unroll
        for (int j = 0; j < 4; ++j) { x[2 * j] = (f32x2){bflo(xr[j].x), bfhi(xr[j].x)}; x[2 * j + 1] = (f32x2){bflo(xr[j].y), bfhi(xr[j].y)}; }
        float act0 = 0.f, act1 = 0.f;
#define UBATCH(R, ROW, NEREG, NBASE) { float p[16]; \
            _Pragma("unroll") for (int i = 0; i < 16; ++i) { f32x2 a = (f32x2){0.f, 0.f}; \
                a = FMA2(x[0], CVT4(w[i].x, 0), a); a = FMA2(x[1], CVT4(w[i].x, 1), a); \
                a = FMA2(x[2], CVT4(w[i].x, 2), a); a = FMA2(x[3], CVT4(w[i].x, 3), a); \
                a = FMA2(x[4], CVT4(w[i].y, 0), a); a = FMA2(x[5], CVT4(w[i].y, 1), a); \
                a = FMA2(x[6], CVT4(w[i].y, 2), a); a = FMA2(x[7], CVT4(w[i].y, 3), a); \
                p[i] = a.x + a.y; GROW(i, U8, NEREG, (NBASE) + rev4(i)); if ((i & 3) == 3) __builtin_amdgcn_sched_barrier(0); } \
            float r8[8], r4[4], r2[2]; \
            _Pragma("unroll") for (int i = 0; i < 8; ++i) { const float keep = b0 ? p[8 + i] : p[i], send = b0 ? p[i] : p[8 + i]; r8[i] = keep + __shfl_xor(send, 1); } \
            _Pragma("unroll") for (int i = 0; i < 4; ++i) { const float keep = b1 ? r8[4 + i] : r8[i], send = b1 ? r8[i] : r8[4 + i]; r4[i] = keep + __shfl_xor(send, 2); } \
            _Pragma("unroll") for (int i = 0; i < 2; ++i) { const float keep = b2 ? r4[2 + i] : r4[i], send = b2 ? r4[i] : r4[2 + i]; r2[i] = keep + __shfl_xor(send, 4); } \
            float r1 = (b3 ? r2[1] : r2[0]) + __shfl_xor(b3 ? r2[0] : r2[1], 8); \
            r1 += __shfl_xor(r1, 16); r1 += __shfl_xor(r1, 32); \
            if (myrow == (ROW)) { if ((R) == 0) act0 = r1; else act1 = r1; } }
        UBATCH(0, 0, e0, 16) UBATCH(0, 1, e0, 32) UBATCH(0, 2, e0, 48) UBATCH(0, 3, e1, 0)
        UBATCH(1, 0, e1, 16) UBATCH(1, 1, e1, 32) UBATCH(1, 2, e1, 48) UBATCH(1, 3, ne0, 0)
#undef UBATCH
        { const float a0 = act0 * dqu0, a1 = act1 * dqu1;
          GATE[(size_t)t * 128 + lane] = gt0 * (0.5f * a0 * (1.f + erff(a0 * 0.70710678118654752f))) * dqv0;
          GATE[(size_t)t * 128 + 64 + lane] = gt1 * (0.5f * a1 * (1.f + erff(a1 * 0.70710678118654752f))) * dqv1; }
        if (!has_next) break;
        t = tn; e0 = ne0; e1 = ne1; gt0 = ngt0; gt1 = ngt1;
#pragma unroll
        for (int j = 0; j < 4; ++j) xr[j] = nxr[j];
    }
    }
}
template <bool FINAL>
__device__ __forceinline__ void phase_gather_v(const bf16* X, const int* EID, const float* COEF, const unsigned char* V8, const float* g, const float* bb, bf16* Ob, float* Of) {
    const int tid = threadIdx.x, lane = tid & 63, wave = tid >> 6;
    const int gw = blockIdx.x * NWAVES + wave, NGW = gridDim.x * NWAVES;
    int t = gw;
    if (t < T) {
    v2u xr[4]; int e0, e1; float c0, c1;
#pragma unroll
    for (int j = 0; j < 4; ++j) xr[j] = *((const GAS v2u*)(X + (size_t)t * D) + lane + 64 * j);
    e0 = EID[(size_t)t * 128 + lane]; e1 = EID[(size_t)t * 128 + 64 + lane]; c0 = COEF[(size_t)t * 128 + lane]; c1 = COEF[(size_t)t * 128 + 64 + lane];
    v2u w[16];
#pragma unroll
    for (int i = 0; i < 16; ++i) GROW(i, V8, e0, i);
    for (;;) {
        const int tn = t + NGW; const bool has_next = tn < T;
        v2u nxr[4]; int ne0 = e0, ne1 = e1; float nc0 = 0.f, nc1 = 0.f;
        if (has_next) {
#pragma unroll
            for (int j = 0; j < 4; ++j) nxr[j] = *((const GAS v2u*)(X + (size_t)tn * D) + lane + 64 * j);
            ne0 = EID[(size_t)tn * 128 + lane]; ne1 = EID[(size_t)tn * 128 + 64 + lane]; nc0 = COEF[(size_t)tn * 128 + lane]; nc1 = COEF[(size_t)tn * 128 + 64 + lane];
        }
        f32x2 acc[8];
#pragma unroll
        for (int j = 0; j < 8; ++j) acc[j] = (f32x2){0.f, 0.f};
#define VBATCH(CREG, BASE, NEREG, NBASE) { const int cr_ = __builtin_bit_cast(int, (CREG)); \
            _Pragma("unroll") for (int i = 0; i < 16; ++i) { const float cf = __builtin_bit_cast(float, __builtin_amdgcn_readlane(cr_, (BASE) + i)); const f32x2 c2 = (f32x2){cf, cf}; \
                acc[0] = FMA2(c2, CVT4(w[i].x, 0), acc[0]); acc[1] = FMA2(c2, CVT4(w[i].x, 1), acc[1]); \
                acc[2] = FMA2(c2, CVT4(w[i].x, 2), acc[2]); acc[3] = FMA2(c2, CVT4(w[i].x, 3), acc[3]); \
                acc[4] = FMA2(c2, CVT4(w[i].y, 0), acc[4]); acc[5] = FMA2(c2, CVT4(w[i].y, 1), acc[5]); \
                acc[6] = FMA2(c2, CVT4(w[i].y, 2), acc[6]); acc[7] = FMA2(c2, CVT4(w[i].y, 3), acc[7]); \
                GROW(i, V8, NEREG, (NBASE) + i); if ((i & 3) == 3) __builtin_amdgcn_sched_barrier(0); } }
        VBATCH(c0, 0, e0, 16) VBATCH(c0, 16, e0, 32) VBATCH(c0, 32, e0, 48) VBATCH(c0, 48, e1, 0)
        VBATCH(c1, 0, e1, 16) VBATCH(c1, 16, e1, 32) VBATCH(c1, 32, e1, 48) VBATCH(c1, 48, ne0, 0)
#undef VBATCH
        float sm = 0.f;
#pragma unroll
        for (int j = 0; j < 4; ++j) { acc[2 * j] = (f32x2){bflo(xr[j].x), bfhi(xr[j].x)} * ALPHA + acc[2 * j]; acc[2 * j + 1] = (f32x2){bflo(xr[j].y), bfhi(xr[j].y)} * ALPHA + acc[2 * j + 1];
            sm += (acc[2 * j].x + acc[2 * j].y) + (acc[2 * j + 1].x + acc[2 * j + 1].y); }
        const float mean = wave_sum(sm) * (1.f / D); float s2 = 0.f;
#pragma unroll
        for (int j = 0; j < 8; ++j) { acc[j] = acc[j] - mean; s2 += acc[j].x * acc[j].x + acc[j].y * acc[j].y; }
        const float rstd = 1.f / sqrtf(wave_sum(s2) * (1.f / D) + LN_EPS);
#pragma unroll
        for (int j = 0; j < 4; ++j) { const f32x4 gg = *((const GAS f32x4*)g + lane + 64 * j), b4 = *((const GAS f32x4*)bb + lane + 64 * j);
            const f32x4 o = (f32x4){acc[2 * j].x, acc[2 * j].y, acc[2 * j + 1].x, acc[2 * j + 1].y} * rstd * gg + b4;
            if (FINAL) *((GAS f32x4*)(Of + (size_t)t * D) + lane + 64 * j) = o;
            else { v2u wo; wo.x = pk2(o.x, o.y); wo.y = pk2(o.z, o.w); *((GAS v2u*)(Ob + (size_t)t * D) + lane + 64 * j) = wo; } }
        if (!has_next) break;
        t = tn; e0 = ne0; e1 = ne1; c0 = nc0; c1 = nc1;
#pragma unroll
        for (int j = 0; j < 4; ++j) xr[j] = nxr[j];
    }
    }
}
__device__ __forceinline__ void phase_hgrn_prep(unsigned char* ws, float* scratch  ) {
    const int tid = threadIdx.x, lane = tid & 63, wave = tid >> 6;
    const int gw = blockIdx.x * NWAVES + wave, NGW = gridDim.x * NWAVES;
    bf16* CQ = (bf16*)(ws + WS_CQ); bf16* CK = (bf16*)(ws + WS_CK); const bf16* CV = (const bf16*)(ws + WS_CV);
    bf16* KOT = (bf16*)scratch; bf16* VT = (bf16*)scratch + (size_t)T * D; float* DEC = (float*)(ws + WS_DEC);
    for (int item = gw; item < 1024 * 8; item += NGW) {
        const int g = item >> 3, h = item & 7; const size_t t0 = (size_t)g * 32;
        float k0[32], k1[32], b0[32], b1[32]; float c0 = 0.f, c1 = 0.f;
#pragma unroll
        for (int s2 = 0; s2 < 32; ++s2) { const size_t o = (t0 + s2) * D + h * 128 + 2 * lane;
            const unsigned kw = *(const GAS unsigned*)(CK + o), qw = *(const GAS unsigned*)(CQ + o);
            const float ka = bflo(kw), kb = bfhi(kw);
            c0 += __logf(1.f - ka); c1 += __logf(1.f - kb);
            k0[s2] = ka; k1[s2] = kb; b0[s2] = c0; b1[s2] = c1;
            *(GAS unsigned*)(CQ + o) = pk2(bflo(qw) * __expf(c0), bfhi(qw) * __expf(c1));
            *(GAS unsigned*)(CK + o) = pk2(ka * __expf(-c0), kb * __expf(-c1)); }
        { GAS v4u* r0 = (GAS v4u*)(KOT + ((size_t)g * 1024 + h * 128 + 2 * lane) * 32);
#pragma unroll
          for (int j = 0; j < 4; ++j) { v4u w;
              w.x = pk2(k0[8 * j + 0] * __expf(c0 - b0[8 * j + 0]), k0[8 * j + 1] * __expf(c0 - b0[8 * j + 1])); w.y = pk2(k0[8 * j + 2] * __expf(c0 - b0[8 * j + 2]), k0[8 * j + 3] * __expf(c0 - b0[8 * j + 3]));
              w.z = pk2(k0[8 * j + 4] * __expf(c0 - b0[8 * j + 4]), k0[8 * j + 5] * __expf(c0 - b0[8 * j + 5])); w.w = pk2(k0[8 * j + 6] * __expf(c0 - b0[8 * j + 6]), k0[8 * j + 7] * __expf(c0 - b0[8 * j + 7]));
              r0[j] = w; }
#pragma unroll
          for (int j = 0; j < 4; ++j) { v4u w;
              w.x = pk2(k1[8 * j + 0] * __expf(c1 - b1[8 * j + 0]), k1[8 * j + 1] * __expf(c1 - b1[8 * j + 1])); w.y = pk2(k1[8 * j + 2] * __expf(c1 - b1[8 * j + 2]), k1[8 * j + 3] * __expf(c1 - b1[8 * j + 3]));
              w.z = pk2(k1[8 * j + 4] * __expf(c1 - b1[8 * j + 4]), k1[8 * j + 5] * __expf(c1 - b1[8 * j + 5])); w.w = pk2(k1[8 * j + 6] * __expf(c1 - b1[8 * j + 6]), k1[8 * j + 7] * __expf(c1 - b1[8 * j + 7]));
              r0[4 + j] = w; } }
        *(GAS v2u*)(DEC + (size_t)g * 1024 + h * 128 + 2 * lane) = (v2u){__float_as_uint(__expf(c0)), __float_as_uint(__expf(c1))};
        { unsigned va[16], vb[16];
#pragma unroll
          for (int j = 0; j < 16; ++j) { const unsigned w0 = *(const GAS unsigned*)(CV + (t0 + 2 * j) * D + h * 128 + 2 * lane), w1 = *(const GAS unsigned*)(CV + (t0 + 2 * j + 1) * D + h * 128 + 2 * lane);
              va[j] = (w0 & 0xffffu) | (w1 << 16); vb[j] = (w0 >> 16) | (w1 & 0xffff0000u); }
          GAS v4u* r0 = (GAS v4u*)(VT + ((size_t)g * 1024 + h * 128 + 2 * lane) * 32);
#pragma unroll
          for (int j = 0; j < 4; ++j) { r0[j] = (v4u){va[4 * j], va[4 * j + 1], va[4 * j + 2], va[4 * j + 3]}; r0[4 + j] = (v4u){vb[4 * j], vb[4 * j + 1], vb[4 * j + 2], vb[4 * j + 3]}; } }
    }
}
__device__ __forceinline__ void phase_hgrn_scan(LAS unsigned char* lds, unsigned char* ws, const float* scratch) {
    const int tid = threadIdx.x, lane = tid & 63, wave = __builtin_amdgcn_readfirstlane(tid >> 6);
    const int c = lane & 31, hh = lane >> 5;
    const bf16* QI = (const bf16*)(ws + WS_CQ); const bf16* KI = (const bf16*)(ws + WS_CK);
    const bf16* KOT = (const bf16*)scratch; const bf16* VT = (const bf16*)scratch + (size_t)T * D; const float* DEC = (const float*)(ws + WS_DEC);
    bf16* O = (bf16*)(ws + WS_O);
    constexpr int BUF = 30720, O_KI = 0, O_QI = 8704, O_KOT = 17408, O_VT = 27648, O_DEC = 30208, O_ST = 61440, O_P = 70144;
    for (int item = blockIdx.x; item < 256; item += gridDim.x) {
        const int es = item & 3, h = (item >> 2) & 7, b = item >> 5;
        __syncthreads();
        for (int i = tid; i < 8704 / 16; i += NTHR) *(LAS v4u*)(lds + O_ST + i * 16) = (v4u){0u, 0u, 0u, 0u};
        f32x16 S[4];
#pragma unroll
        for (int blk = 0; blk < 4; ++blk)
#pragma unroll
            for (int r = 0; r < 16; ++r) S[blk][r] = 0.f;
        v4u rk, rq, ro, rx;
        auto load_chunk = [&](int n) {
            const size_t gch = (size_t)b * 128 + n, t0 = gch * 32;
            rk = *(const GAS v4u*)(KI + (t0 + (tid >> 4)) * D + h * 128 + 8 * (tid & 15));
            rq = *(const GAS v4u*)(QI + (t0 + (tid >> 4)) * D + h * 128 + 8 * (tid & 15));
            ro = *(const GAS v4u*)(KOT + (gch * 1024 + h * 128 + (tid >> 2)) * 32 + 8 * (tid & 3));
            if (tid < 128) rx = *(const GAS v4u*)(VT + (gch * 1024 + h * 128 + es * 32 + (tid >> 2)) * 32 + 8 * (tid & 3));
            else if (tid < 160) rx = *(const GAS v4u*)(DEC + gch * 1024 + h * 128 + 4 * (tid - 128));
        };
        auto store_chunk = [&](int bufi) {
            LAS unsigned char* bp = lds + bufi * BUF;
            *(LAS v4u*)(bp + O_KI + (tid >> 4) * 272 + (tid & 15) * 16) = rk;
            *(LAS v4u*)(bp + O_QI + (tid >> 4) * 272 + (tid & 15) * 16) = rq;
            *(LAS v4u*)(bp + O_KOT + (tid >> 2) * 80 + (tid & 3) * 16) = ro;
            if (tid < 128) *(LAS v4u*)(bp + O_VT + (tid >> 2) * 80 + (tid & 3) * 16) = rx;
            else if (tid < 160) *(LAS v4u*)(bp + O_DEC + (tid - 128) * 16) = rx;
        };
        load_chunk(0); store_chunk(0); load_chunk(1);
        __syncthreads();
        for (int n = 0; n < 128; ++n) {
            if (n + 1 < 128) store_chunk((n + 1) & 1);
            if (n + 2 < 128) load_chunk(n + 2);
            if (wave == 0) {
                LAS unsigned char* bp = lds + (n & 1) * BUF;
                const size_t t0 = ((size_t)b * 128 + n) * 32;
                bf16x8 qf[8];
                f32x16 sc;
#pragma unroll
                for (int r = 0; r < 16; ++r) sc[r] = 0.f;
#pragma unroll
                for (int ks = 0; ks < 8; ++ks) { const bf16x8 kf = *(const LAS bf16x8*)(bp + O_KI + c * 272 + (16 * ks + 8 * hh) * 2);
                    qf[ks] = *(const LAS bf16x8*)(bp + O_QI + c * 272 + (16 * ks + 8 * hh) * 2);
                    sc = __builtin_amdgcn_mfma_f32_32x32x16_bf16(kf, qf[ks], sc, 0, 0, 0); }
#pragma unroll
                for (int g4 = 0; g4 < 4; ++g4) { float m[4];
#pragma unroll
                    for (int q = 0; q < 4; ++q) { const float sv = sc[4 * g4 + q]; m[q] = (8 * g4 + 4 * hh + q <= c) ? sv : 0.f; }
                    *(LAS v2u*)(lds + O_P + c * 80 + (8 * g4 + 4 * hh) * 2) = (v2u){pk2(m[0], m[1]), pk2(m[2], m[3])}; }
                bf16x8 vf[2];
                f32x16 o;
#pragma unroll
                for (int r = 0; r < 16; ++r) o[r] = 0.f;
#pragma unroll
                for (int ks = 0; ks < 2; ++ks) { const bf16x8 pf = *(const LAS bf16x8*)(lds + O_P + c * 80 + (16 * ks + 8 * hh) * 2);
                    vf[ks] = *(const LAS bf16x8*)(bp + O_VT + c * 80 + (16 * ks + 8 * hh) * 2);
                    o = __builtin_amdgcn_mfma_f32_32x32x16_bf16(pf, vf[ks], o, 0, 0, 0); }
#pragma unroll
                for (int ks = 0; ks < 8; ++ks) { const bf16x8 sf = *(const LAS bf16x8*)(lds + O_ST + c * 272 + (16 * ks + 8 * hh) * 2);
                    o = __builtin_amdgcn_mfma_f32_32x32x16_bf16(qf[ks], sf, o, 0, 0, 0); }
#pragma unroll
                for (int r = 0; r < 16; ++r) { const float ov = o[r]; O[(t0 + (r & 3) + 8 * (r >> 2) + 4 * hh) * D + h * 128 + es * 32 + c] = (bf16)f2bf(ov); }
#pragma unroll
                for (int blk = 0; blk < 4; ++blk) {
#pragma unroll
                    for (int g4 = 0; g4 < 4; ++g4) { const f32x4 dv = *(const LAS f32x4*)(bp + O_DEC + (32 * blk + 8 * g4 + 4 * hh) * 4);
                        S[blk][4 * g4 + 0] *= dv.x; S[blk][4 * g4 + 1] *= dv.y; S[blk][4 * g4 + 2] *= dv.z; S[blk][4 * g4 + 3] *= dv.w; }
#pragma unroll
                    for (int ks = 0; ks < 2; ++ks) { const bf16x8 af = *(const LAS bf16x8*)(bp + O_KOT + (32 * blk + c) * 80 + (16 * ks + 8 * hh) * 2);
                        S[blk] = __builtin_amdgcn_mfma_f32_32x32x16_bf16(af, vf[ks], S[blk], 0, 0, 0); }
#pragma unroll
                    for (int g4 = 0; g4 < 4; ++g4) { const float s0 = S[blk][4 * g4 + 0], s1 = S[blk][4 * g4 + 1], s2 = S[blk][4 * g4 + 2], s3 = S[blk][4 * g4 + 3];
                        *(LAS v2u*)(lds + O_ST + c * 272 + (32 * blk + 8 * g4 + 4 * hh) * 2) = (v2u){pk2(s0, s1), pk2(s2, s3)}; }
                }
            }
            __syncthreads();
        }
    }
}
__device__ __forceinline__ void phase_hgrn_norm(const float* norm_g, unsigned char* ws) {
    const int tid = threadIdx.x, lane = tid & 63, wave = tid >> 6;
    const int gw = blockIdx.x * NWAVES + wave, NGW = gridDim.x * NWAVES;
    const bf16* O = (const bf16*)(ws + WS_O); const bf16* CG = (const bf16*)(ws + WS_CG); bf16* Y2 = (bf16*)(ws + WS_Y2);
    for (int t = gw; t < T; t += NGW) {
        const v4u a0 = *((const GAS v4u*)(O + (size_t)t * D) + lane * 2), a1 = *((const GAS v4u*)(O + (size_t)t * D) + lane * 2 + 1);
        const v4u g0 = *((const GAS v4u*)(CG + (size_t)t * D) + lane * 2), g1 = *((const GAS v4u*)(CG + (size_t)t * D) + lane * 2 + 1);
        float o[16], gv[16];
        o[0] = bflo(a0.x); o[1] = bfhi(a0.x); o[2] = bflo(a0.y); o[3] = bfhi(a0.y); o[4] = bflo(a0.z); o[5] = bfhi(a0.z); o[6] = bflo(a0.w); o[7] = bfhi(a0.w);
        o[8] = bflo(a1.x); o[9] = bfhi(a1.x); o[10] = bflo(a1.y); o[11] = bfhi(a1.y); o[12] = bflo(a1.z); o[13] = bfhi(a1.z); o[14] = bflo(a1.w); o[15] = bfhi(a1.w);
        gv[0] = bflo(g0.x); gv[1] = bfhi(g0.x); gv[2] = bflo(g0.y); gv[3] = bfhi(g0.y); gv[4] = bflo(g0.z); gv[5] = bfhi(g0.z); gv[6] = bflo(g0.w); gv[7] = bfhi(g0.w);
        gv[8] = bflo(g1.x); gv[9] = bfhi(g1.x); gv[10] = bflo(g1.y); gv[11] = bfhi(g1.y); gv[12] = bflo(g1.z); gv[13] = bfhi(g1.z); gv[14] = bflo(g1.w); gv[15] = bfhi(g1.w);
        float sq = 0.f;
#pragma unroll
        for (int j = 0; j < 16; ++j) sq += o[j] * o[j];
        sq += __shfl_xor(sq, 1); sq += __shfl_xor(sq, 2); sq += __shfl_xor(sq, 4);
        const float r = 1.f / sqrtf(sq * (1.f / 128.f) + LN_EPS);
        float y[16];
#pragma unroll
        for (int j = 0; j < 16; ++j) { const float sg = gv[j] / (1.f + expf(-gv[j])); y[j] = o[j] * r * norm_g[lane * 16 + j] * sg; }
        v4u w0, w1; w0.x = pk2(y[0], y[1]); w0.y = pk2(y[2], y[3]); w0.z = pk2(y[4], y[5]); w0.w = pk2(y[6], y[7]);
        w1.x = pk2(y[8], y[9]); w1.y = pk2(y[10], y[11]); w1.z = pk2(y[12], y[13]); w1.w = pk2(y[14], y[15]);
        *((GAS v4u*)(Y2 + (size_t)t * D) + lane * 2) = w0; *((GAS v4u*)(Y2 + (size_t)t * D) + lane * 2 + 1) = w1;
    }
}

struct Args { const float* in[16]; float* out; unsigned char* ws; int ph_lo, ph_hi, li, pad; };
__global__ void __launch_bounds__(NTHR, 2) mk_fwd(Args args) {
    extern __shared__ __attribute__((aligned(16))) unsigned char lds_raw[];
    LAS unsigned char* lds = (LAS unsigned char*)lds_raw;
    volatile LAS unsigned* MISC = (volatile LAS unsigned*)(lds + MISC_OFF);
    const int tid = threadIdx.x;
    unsigned char* ws = args.ws;
    gu32* ctl = (gu32*)(ws + WS_CTL);
    if (tid < 32) ((LAS unsigned*)(lds + MISC_OFF))[tid] = 0u;
    __syncthreads();
    XcdBarrier bar; bar.bar = (unsigned*)ctl + CW_BAR; bar.x = 0; bar.st = nullptr;
    if (N_LAUNCHES == 1) bar = xcd_barrier_post((unsigned*)ctl + CW_BAR, MISC + 8);
    const int lo = args.ph_lo, hi = args.ph_hi;
#define IN(k) (lo <= (k) && (k) < hi)
#define SEAM(k) do { if (IN(k) && IN((k) + 1)) xcd_barrier(bar); } while (0)
    const float* const* in = args.in;
    bf16* XB = (bf16*)(ws + WS_XB); bf16* H0 = (bf16*)(ws + WS_H0); bf16* Y = (bf16*)(ws + WS_Y); bf16* H1 = (bf16*)(ws + WS_H1);
    int* EID = (int*)(ws + WS_EID); float* GATE = (float*)(ws + WS_GATE);
    float* Z = args.out;

    int ph_ = 0;
#define PH_BEGIN if (lo <= ph_ && ph_ < hi) for (int rep_ = 0; rep_ < 1 + (int)((DUP_MASK >> ph_) & 1u); ++rep_) {
#define PH_END } if (lo <= ph_ && ph_ + 1 < hi) xcd_barrier(bar); ++ph_;
      PH_BEGIN phase_prologue(lds, in, ws); phase_convert_tables(in[12], in[13], ws); PH_END
      PH_BEGIN pg8::Gemm g{XB, (const bf16*)(ws + WS_WABIN), T, AB_IN, D}; pg8::StaticOrder S; S.init(T, AB_IN, (int)gridDim.x, (int)blockIdx.x); pg8::EpiBf16<0> E{H0, AB_IN, nullptr, 0, 0, 1.f};
                     pg8::gemm_phase<pg8::EpiBf16<0>, pg8::StaticOrder, true, true>(lds, g, S, E); PH_END
      PH_BEGIN phase_ret_local(lds, ws); PH_END
      PH_BEGIN phase_ret_prefix(ws); PH_END
      PH_BEGIN phase_ret_out_pool_fast(lds, in, ws); PH_END
      PH_BEGIN pg8::Gemm g{Y, (const bf16*)(ws + WS_WABOUT), T, D, D}; pg8::StaticOrder S; S.init(T, D, (int)gridDim.x, (int)blockIdx.x); pg8::EpiResidF32 E{XB, Z};
                     pg8::gemm_phase<pg8::EpiResidF32, pg8::StaticOrder, true, true>(lds, g, S, E); PH_END
      PH_BEGIN phase_ln(Z, H1, in[14], in[15]); PH_END
      PH_BEGIN pg8::Gemm g{H1, (const bf16*)(ws + WS_WQ), T, 2048, D}; pg8::StaticOrder S; S.init(T, 2048, (int)gridDim.x, (int)blockIdx.x); pg8::EpiBf16<0> E{H0  , 2048, nullptr, 0, 0, 1.f};
                     pg8::gemm_phase<pg8::EpiBf16<0>, pg8::StaticOrder, true, true>(lds, g, S, E); PH_END
      PH_BEGIN phase_topk_fast(lds, H0, (const bf16*)(ws + WS_KEYS), EID, GATE); PH_END
      PH_BEGIN phase_gather_u(H1, EID, GATE, ws + WS_U8, (const float*)(ws + WS_DQU), (const float*)(ws + WS_DQV)); PH_END
      PH_BEGIN phase_gather_v<false>(H1, EID, GATE, ws + WS_V8, in[14] + D, in[15] + D, XB  , nullptr); PH_END
      PH_BEGIN pg8::Gemm g{XB, (const bf16*)(ws + WS_WCIN), T, C_IN, D}; pg8::StaticOrder S; S.init(T, C_IN, (int)gridDim.x, (int)blockIdx.x);
                      pg8::EpiCInF E2{(bf16*)(ws + WS_CQ), (bf16*)(ws + WS_CK), (bf16*)(ws + WS_CV), (bf16*)(ws + WS_CG), (const float*)(ws + WS_LB)};
                      pg8::gemm_phase<pg8::EpiCInF, pg8::StaticOrder, true, true>(lds, g, S, E2); PH_END
      PH_BEGIN phase_hgrn_prep(ws, args.out); PH_END
      PH_BEGIN phase_hgrn_scan(lds, ws, args.out); PH_END
      PH_BEGIN phase_hgrn_norm(in[8], ws); PH_END
      PH_BEGIN pg8::Gemm g{(const bf16*)(ws + WS_Y2), (const bf16*)(ws + WS_WCOUT), T, D, D}; pg8::StaticOrder S; S.init(T, D, (int)gridDim.x, (int)blockIdx.x); pg8::EpiResidF32 E{XB, Z};
                      pg8::gemm_phase<pg8::EpiResidF32, pg8::StaticOrder, true, true>(lds, g, S, E); PH_END
      PH_BEGIN phase_ln(Z, H1  , in[14] + 2 * D, in[15] + 2 * D); PH_END
      PH_BEGIN pg8::Gemm g{H1, (const bf16*)(ws + WS_WQ) + (size_t)2048 * D, T, 2048, D}; pg8::StaticOrder S; S.init(T, 2048, (int)gridDim.x, (int)blockIdx.x); pg8::EpiBf16<0> E{(bf16*)(ws + WS_Q1), 2048, nullptr, 0, 0, 1.f};
                      pg8::gemm_phase<pg8::EpiBf16<0>, pg8::StaticOrder, true, true>(lds, g, S, E); PH_END
      PH_BEGIN phase_topk_fast(lds, (const bf16*)(ws + WS_Q1), (const bf16*)(ws + WS_KEYS) + (size_t)8 * 2 * 128 * 128, EID, GATE); PH_END
      PH_BEGIN phase_gather_u(H1, EID, GATE, ws + WS_U8 + (size_t)NEXP * 512, (const float*)(ws + WS_DQU) + NEXP, (const float*)(ws + WS_DQV) + NEXP); PH_END
      PH_BEGIN phase_gather_v<true>(H1, EID, GATE, ws + WS_V8 + (size_t)NEXP * 512, in[14] + 3 * D, in[15] + 3 * D, nullptr, args.out); PH_END
#undef PH_BEGIN
#undef PH_END
#undef IN
#undef SEAM
}

extern "C" void kernel_launch(void* const* d_in, const int* in_sizes, int n_in, void* d_out, int out_size, void* d_ws, size_t ws_size, hipStream_t stream) {
    static int grid = 0;
    if (grid == 0) {
        if (n_in != 16 || in_sizes[0] != T * D || out_size != T * D || ws_size < WS_END) { fprintf(stderr, "kernel_launch: unexpected problem (n_in %d, in0 %d, out %d, ws %zu); nothing launched\n", n_in, n_in > 0 ? in_sizes[0] : -1, out_size, ws_size); grid = -1; return; }
        int dev = 0, cus = 0;
        if (hipGetDevice(&dev) != hipSuccess || hipDeviceGetAttribute(&cus, hipDeviceAttributeMultiprocessorCount, dev) != hipSuccess) { grid = -1; return; }
        if (hipFuncSetAttribute((const void*)mk_fwd, hipFuncAttributeMaxDynamicSharedMemorySize, LDS_BYTES) != hipSuccess) { fprintf(stderr, "kernel_launch: hipFuncSetAttribute failed\n"); grid = -1; return; }
        (void)hipGetLastError();
        grid = cus;
    }
    if (grid < 0) return;
    if (hipMemsetAsync((char*)d_ws + WS_CTL, 0, CTL_ZERO_BYTES, stream) != hipSuccess) return;
    Args a{};
    for (int i = 0; i < 16; ++i) a.in[i] = (const float*)d_in[i];
    a.out = (float*)d_out; a.ws = (unsigned char*)d_ws;
    for (int li = 0; li < N_LAUNCHES; ++li) {
        a.ph_lo = (N_LAUNCHES == 1) ? 0 : li; a.ph_hi = (N_LAUNCHES == 1) ? NPHASE : li + 1; a.li = li;
        hipLaunchKernelGGL(mk_fwd, dim3(grid), dim3(NTHR), LDS_BYTES, stream, a);
        if (hipPeekAtLastError() != hipSuccess) { fprintf(stderr, "kernel_launch: launch %d failed\n", li); break; }
    }
}
```

```cpp
#include <hip/hip_runtime.h>
#include <cstdio>
#include <cstdint>

#ifndef MK_N_LAUNCHES
#define MK_N_LAUNCHES 1
#endif
#ifdef PROBE_L2
constexpr int NPHASE = 22;
#else
constexpr int NPHASE = 21;
#endif
#ifndef DUP_MASK
#define DUP_MASK 0u
#endif
constexpr int N_LAUNCHES = MK_N_LAUNCHES;

constexpr int BATCH = 8, SEQ = 4096, D = 1024, T = BATCH * SEQ;
constexpr int AB_IN = 2048, C_IN = 4096, NEXP = 16384;
constexpr float LN_EPS = 1e-5f;
constexpr float ALPHA = 1.41421356237309515f;
constexpr int NWAVES = 8, NTHR = 512;

constexpr size_t MiB = 1u << 20;
constexpr size_t WS_CTL = 0, CTL_ZERO_BYTES = 1 * MiB;
constexpr size_t WS_LB = 1 * MiB;
constexpr size_t WS_ROPE = 2 * MiB;
constexpr size_t WS_WABIN = 4 * MiB;
constexpr size_t WS_WABOUT = 8 * MiB;
constexpr size_t WS_WCIN = 10 * MiB;
constexpr size_t WS_WCOUT = 18 * MiB;
constexpr size_t WS_WQ = 20 * MiB;
constexpr size_t WS_KEYS = 28 * MiB;
constexpr size_t WS_DQU = 29 * MiB;
constexpr size_t WS_DQV = 29 * MiB + 131072;
constexpr size_t WS_U8 = 32 * MiB;
constexpr size_t WS_V8 = 64 * MiB;
constexpr size_t WS_POOLWT = 30 * MiB;
constexpr size_t WS_XB = 96 * MiB;
constexpr size_t WS_H0 = 160 * MiB;
constexpr size_t WS_LST = 288 * MiB;
constexpr size_t WS_Y = 320 * MiB;
constexpr size_t WS_H1 = 384 * MiB;
constexpr size_t WS_EID = 448 * MiB;
constexpr size_t WS_GATE = 464 * MiB;
constexpr size_t WS_CQ = 160 * MiB, WS_CK = 224 * MiB, WS_CV = 288 * MiB, WS_CG = 352 * MiB;
constexpr size_t WS_O = 416 * MiB;
constexpr size_t WS_Y2 = 160 * MiB;
constexpr size_t WS_Q1 = 224 * MiB;
constexpr size_t WS_DEC = 480 * MiB;
constexpr size_t WS_END = 484 * MiB;

constexpr int CW_BAR = 4096;
constexpr int LDS_BYTES = 147456;
constexpr int MISC_OFF = LDS_BYTES - 128;

#define GAS __attribute__((address_space(1)))
#define LAS __attribute__((address_space(3)))
typedef unsigned short bf16;
typedef unsigned v4u __attribute__((ext_vector_type(4)));
typedef unsigned v2u __attribute__((ext_vector_type(2)));
typedef float f32x4 __attribute__((ext_vector_type(4)));
typedef GAS unsigned gu32;
typedef short bf16x8 __attribute__((ext_vector_type(8)));
typedef int v8i __attribute__((ext_vector_type(8)));
typedef float f32x16 __attribute__((ext_vector_type(16)));
#define RLX_AGENT __ATOMIC_RELAXED, __HIP_MEMORY_SCOPE_AGENT
#define LDS_WAIT() asm volatile("s_waitcnt lgkmcnt(0)" ::: "memory")
__device__ __forceinline__ unsigned f2bf(float f) { unsigned u = __builtin_bit_cast(unsigned, f); return (u + 0x7fffu + ((u >> 16) & 1u)) >> 16; }
__device__ __forceinline__ unsigned pk2(float lo, float hi) { return f2bf(lo) | (f2bf(hi) << 16); }
__device__ __forceinline__ float bf2f(unsigned b) { return __builtin_bit_cast(float, b << 16); }
__device__ __forceinline__ float bflo(unsigned w) { return __builtin_bit_cast(float, w << 16); }
__device__ __forceinline__ float bfhi(unsigned w) { return __builtin_bit_cast(float, w & 0xffff0000u); }
__device__ __forceinline__ float wave_sum(float v) {
#pragma unroll
    for (int o = 1; o < 64; o <<= 1) v += __shfl_xor(v, o);
    return v;
}

#define XB_TMO      128
#define XB_XCNT(j)  (256  + 64 * (j))
#define XB_XSUB(j)  (1280 + 64 * (j))
#define XB_XGEN(j)  (2304 + 64 * (j))
#define XB_TOP      3328
#define XB_TOPGEN   3392
#define XCD_BAR_WORDS 3456
#define XB_SPIN_CAP (1u << 21)
__device__ __forceinline__ unsigned xb_ld(unsigned* p)              { return __hip_atomic_load(p, __ATOMIC_RELAXED, __HIP_MEMORY_SCOPE_AGENT); }
__device__ __forceinline__ unsigned xb_add(unsigned* p, unsigned v) { return __hip_atomic_fetch_add(p, v, __ATOMIC_RELAXED, __HIP_MEMORY_SCOPE_AGENT); }
__device__ __forceinline__ unsigned xb_xcc_id() { return (unsigned)__builtin_amdgcn_s_getreg((3 << 11) | 20) & 0xFu; }
#define XB_SPIN(cond, bar) do { unsigned _sp = 0; while (cond) { __builtin_amdgcn_s_sleep(1); \
    if ((++_sp & 255u) == 0u) { if (xb_ld(&(bar)[XB_TMO])) break; if (_sp > XB_SPIN_CAP) { atomicAdd(&(bar)[XB_TMO], 1u); break; } } } } while (0)
struct XcdBarrier { unsigned* bar; unsigned x; volatile LAS unsigned* st; };
__device__ __forceinline__ XcdBarrier xcd_barrier_post(unsigned* bar, volatile LAS unsigned* st) {
    XcdBarrier b; b.bar = bar; b.x = xb_xcc_id(); b.st = st;
    if (threadIdx.x == 0) (void)xb_add(&bar[XB_XCNT(b.x)], 1u);
    return b;
}
__device__ __forceinline__ void xcd_barrier_complete(unsigned* bar, unsigned x, unsigned& nloc, unsigned& nx) {
    const unsigned G = gridDim.x * gridDim.y * gridDim.z;
    unsigned sum, cnt, mine, sp = 0u;
    for (;;) {
        sum = 0u; cnt = 0u; mine = 0u;
#pragma unroll
        for (unsigned j = 0; j < 16; ++j) { const unsigned c = xb_ld(&bar[XB_XCNT(j)]); sum += c; cnt += (c > 0u) ? 1u : 0u; mine = (j == x) ? c : mine; }
        if (sum == G) break;
        __builtin_amdgcn_s_sleep(1);
        if ((++sp & 255u) == 0u) { if (xb_ld(&bar[XB_TMO])) break; if (sp > XB_SPIN_CAP) { atomicAdd(&bar[XB_TMO], 1u); break; } }
    }
    nloc = mine > 0u ? mine : 1u; nx = cnt > 0u ? cnt : 1u;
}
__device__ __forceinline__ void xcd_barrier(const XcdBarrier& b) {
    asm volatile("s_waitcnt vmcnt(0)" ::: "memory");
    __syncthreads();
    if (threadIdx.x == 0) {
        unsigned* bar = b.bar;
        __builtin_amdgcn_s_waitcnt(0);
        unsigned nloc = b.st[0], nx = b.st[1];
        if (nloc == 0u) { xcd_barrier_complete(bar, b.x, nloc, nx); b.st[0] = nloc; b.st[1] = nx; }
        const unsigned old = xb_add(&bar[XB_XSUB(b.x)], 1u);
        const unsigned gen = old / nloc;
        if (old + 1u == (gen + 1u) * nloc) {
            __builtin_amdgcn_fence(__ATOMIC_RELEASE, "agent");
            asm volatile("s_waitcnt vmcnt(0)" ::: "memory");
            const unsigned og = xb_add(&bar[XB_TOP], 1u);
            const unsigned tg = og / nx;
            if (og + 1u == (tg + 1u) * nx) xb_add(&bar[XB_TOPGEN], 1u);
            else XB_SPIN(xb_ld(&bar[XB_TOPGEN]) == tg, bar);
            __builtin_amdgcn_fence(__ATOMIC_ACQUIRE, "agent");
            xb_add(&bar[XB_XGEN(b.x)], 1u);
            asm volatile("s_waitcnt vmcnt(0)" ::: "memory");
        } else {
            XB_SPIN(xb_ld(&bar[XB_XGEN(b.x)]) == gen, bar);
            __builtin_amdgcn_fence(__ATOMIC_ACQUIRE, "agent");
            asm volatile("s_waitcnt vmcnt(0)" ::: "memory");
        }
    }
    __syncthreads();
}

__device__ __forceinline__ void p0_transpose_item(const float* W, int K, int N, bf16* WT, LAS float* scr, int item, int lane) {
    const int nblk = N / 32, kb = item / nblk, nb = item % nblk, k0 = 64 * kb, n0 = 32 * nb;
#pragma unroll 8
    for (int i = 0; i < 32; ++i) { const int kk = 2 * i + (lane >> 5); scr[kk * 33 + (lane & 31)] = W[(size_t)(k0 + kk) * N + n0 + (lane & 31)]; }
    LDS_WAIT(); asm volatile("" ::: "memory");
    const int c = lane & 7;
#pragma unroll
    for (int j = 0; j < 4; ++j) { const int n = (lane >> 3) + 8 * j; const LAS float* s = scr + (8 * c) * 33 + n;
        v4u o; o.x = pk2(s[0 * 33], s[1 * 33]); o.y = pk2(s[2 * 33], s[3 * 33]); o.z = pk2(s[4 * 33], s[5 * 33]); o.w = pk2(s[6 * 33], s[7 * 33]);
        *(GAS v4u*)(WT + (size_t)(n0 + n) * K + k0 + 8 * c) = o; }
    LDS_WAIT(); asm volatile("" ::: "memory");
}

template <class Epi>
__device__ __forceinline__ void gemm_naive(LAS unsigned char* lds, const bf16* A, const bf16* Bt, int M, int N, int K, const Epi& E) {
    LAS float* As = (LAS float*)lds;
    LAS float* Bs = As + 128 * 33;
    const int tid = threadIdx.x, tx = tid & 15, ty = tid >> 4;
    const int ntn = N / 128, ntiles = (M / 128) * ntn;
    for (int tile = blockIdx.x; tile < ntiles; tile += gridDim.x) {
        const int tm = tile / ntn, tn = tile % ntn;
        float acc[4][8];
#pragma unroll
        for (int i = 0; i < 4; ++i)
#pragma unroll
            for (int j = 0; j < 8; ++j) acc[i][j] = 0.f;
        for (int k0 = 0; k0 < K; k0 += 32) {
            { const int r = tid >> 2, kc = (tid & 3) * 8;
              const v4u va = *(const GAS v4u*)(A + (size_t)(tm * 128 + r) * K + k0 + kc);
              const v4u vb = *(const GAS v4u*)(Bt + (size_t)(tn * 128 + r) * K + k0 + kc);
              LAS float* pa = As + r * 33 + kc; LAS float* pb = Bs + r * 33 + kc;
              pa[0] = bflo(va.x); pa[1] = bfhi(va.x); pa[2] = bflo(va.y); pa[3] = bfhi(va.y); pa[4] = bflo(va.z); pa[5] = bfhi(va.z); pa[6] = bflo(va.w); pa[7] = bfhi(va.w);
              pb[0] = bflo(vb.x); pb[1] = bfhi(vb.x); pb[2] = bflo(vb.y); pb[3] = bfhi(vb.y); pb[4] = bflo(vb.z); pb[5] = bfhi(vb.z); pb[6] = bflo(vb.w); pb[7] = bfhi(vb.w); }
            __syncthreads();
#pragma unroll 8
            for (int kk = 0; kk < 32; ++kk) {
                float a[4], b[8];
#pragma unroll
                for (int i = 0; i < 4; ++i) a[i] = As[(ty * 4 + i) * 33 + kk];
#pragma unroll
                for (int j = 0; j < 8; ++j) b[j] = Bs[(tx + 16 * j) * 33 + kk];
#pragma unroll
                for (int i = 0; i < 4; ++i)
#pragma unroll
                    for (int j = 0; j < 8; ++j) acc[i][j] += a[i] * b[j];
            }
            __syncthreads();
        }
#pragma unroll
        for (int i = 0; i < 4; ++i)
#pragma unroll
            for (int j = 0; j < 8; ++j) E(tm * 128 + ty * 4 + i, tn * 128 + tx + 16 * j, acc[i][j]);
    }
}
struct EpiStore { bf16* O; int ldc;
    __device__ __forceinline__ void operator()(int r, int c, float v) const { O[(size_t)r * ldc + c] = (bf16)f2bf(v); } };
struct EpiResid { const bf16* X; float* Z;
    __device__ __forceinline__ void operator()(int r, int c, float v) const { Z[(size_t)r * D + c] = ALPHA * bf2f(X[(size_t)r * D + c]) + v; } };
struct EpiCIn { bf16 *CQ, *CK, *CV, *CG; const float* lb;
    __device__ __forceinline__ void operator()(int r, int c, float v) const {
        const int seg = c >> 10, cc = c & 1023; const size_t o = (size_t)r * D + cc;
        if (seg == 0) CQ[o] = (bf16)f2bf(v);
        else if (seg == 1) { const float k = (1.f - lb[cc]) / (1.f + expf(v)); CK[o] = (bf16)f2bf(k); }
        else if (seg == 2) CV[o] = (bf16)f2bf(v);
        else CG[o] = (bf16)f2bf(v);
    } };

namespace pg8 {
#define PG8_LAS __attribute__((address_space(3)))
typedef unsigned short bf16_t;
typedef short bf16x8 __attribute__((ext_vector_type(8)));
typedef float f32x4 __attribute__((ext_vector_type(4)));
typedef unsigned u32x4 __attribute__((ext_vector_type(4)));
constexpr int BM = 256, BK = 64, HALF = 128, HTB = HALF * BK * 2  , STAGE_BYTES = 8 * HTB, NXCD = 8, WGM = 8;

__host__ __device__ __forceinline__ int lds_byte(int r, int c) { const int st = (r >> 4) * 2 + (c >> 5), rr = r & 15, cc = c & 31, ob = rr * 64 + cc * 2; return st * 1024 + (ob ^ (((ob >> 9) & 1) << 5)); }
__host__ __device__ __forceinline__ void stage_rc(int b, int& R, int& C) { const int st = b / 1024, sb = b % 1024, swz = sb ^ (((sb >> 9) & 1) << 5); R = (st >> 1) * 16 + swz / 64; C = (st & 1) * 32 + (swz % 64) / 2; }
__host__ __device__ __forceinline__ int perm32(int rho) { const int n = rho >> 4, i = rho & 15; return 8 * (i >> 2) + 4 * n + (i & 3); }

struct Unit { int pm, pn; };
struct Gemm { const bf16_t* A; const bf16_t* Bt; int M, N, K; };

struct StaticOrder {
    int nM, nN, nwg, G, c;
    __host__ __device__ void init(int M, int N, int G_, int c_) { nM = M / BM; nN = N / BM; nwg = nM * nN; G = G_; c = c_; }
    __host__ __device__ bool next(int i, Unit& u) const {
        const long L = (long)i * G + c; if (L >= nwg) return false;
        int wgid = (int)L; { const int q = nwg / NXCD, r = nwg % NXCD, xcd = wgid % NXCD, off = wgid / NXCD; wgid = (xcd < r ? xcd * (q + 1) : r * (q + 1) + (xcd - r) * q) + off; }
        const int nig = WGM * nN, gid = wgid / nig, fm = gid * WGM, gsz = (nM - fm) < WGM ? (nM - fm) : WGM;
        u.pm = fm + ((wgid % nig) % gsz); u.pn = (wgid % nig) / gsz; return true;
    }
    __device__ __forceinline__ void a_ready(const Unit&) const {}
    __device__ __forceinline__ void done(const Unit&) const {}
};

__device__ __forceinline__ unsigned cvt_pk_bf16(float lo, float hi) { unsigned r; asm volatile("v_cvt_pk_bf16_f32 %0, %1, %2" : "=v"(r) : "v"(lo), "v"(hi)); return r; }
typedef float f32x2 __attribute__((ext_vector_type(2)));
__device__ __forceinline__ f32x2 gelu_pk(f32x2 v) {
    const f32x2 av = __builtin_elementwise_abs(v), d = av * 0.2316418882f + 1.0f;
    f32x2 t; t.x = __builtin_amdgcn_rcpf(d.x); t.y = __builtin_amdgcn_rcpf(d.y);
    f32x2 q = t * 0.5307027145f + (-0.7265760135f); q = q * t + 0.7107068705f; q = q * t + (-0.142248368f); q = q * t + 0.127414796f; q = q * t;
    const f32x2 s = (v * v) * (-0.72134752044f);
    f32x2 e; e.x = __builtin_amdgcn_exp2f(s.x); e.y = __builtin_amdgcn_exp2f(s.y);
    const f32x2 m = v * (q * e), r = v - m;
    f32x2 o; o.x = v.x < 0.f ? m.x : r.x; o.y = v.y < 0.f ? m.y : r.y; return o;
}

template <int ACT  > struct EpiBf16 {
    static constexpr bool PERM = true, AFTER_DRAIN = false; static_assert(ACT == 0 || ACT == 1, "EpiBf16: ACT is 0 (none) or 1 (gelu_pk)");
    bf16_t* O; int ldc; const float* bias; int split_cols; size_t split_stride; float scale0;
    __device__ __forceinline__ void operator()(const f32x4 (&acc)[2][2][4][2], const Unit& u, int wr, int wc, int fr, int fq) const {
        const int row0 = u.pm * BM + wr * 64 + fr; int colt = u.pn * BM; bf16_t* base = O;
        float sc = 1.f; if (split_cols) { const int t = colt / split_cols; base += (size_t)t * split_stride; colt -= t * split_cols; if (t == 0) sc = scale0; }
        const int col0 = colt + wc * 32 + 8 * fq, bcol0 = u.pn * BM + wc * 32 + 8 * fq;
        f32x4 bv[2][2];
#pragma unroll
        for (int bj = 0; bj < 2; ++bj)
#pragma unroll
            for (int n = 0; n < 2; ++n) bv[bj][n] = bias ? *(const f32x4*)(bias + bcol0 + bj * HALF + 4 * n) : (f32x4){0.f, 0.f, 0.f, 0.f};
#pragma unroll
        for (int ai = 0; ai < 2; ++ai)
#pragma unroll
            for (int m = 0; m < 4; ++m) { bf16_t* rowp = base + (size_t)(row0 + ai * HALF + m * 16) * ldc + col0;
#pragma unroll
                for (int bj = 0; bj < 2; ++bj) { f32x4 v0 = acc[ai][bj][m][0] + bv[bj][0], v1 = acc[ai][bj][m][1] + bv[bj][1];
                    if (ACT == 1) { f32x2 a = gelu_pk((f32x2){v0[0], v0[1]}), b = gelu_pk((f32x2){v0[2], v0[3]}), c = gelu_pk((f32x2){v1[0], v1[1]}), d = gelu_pk((f32x2){v1[2], v1[3]});
                        v0 = (f32x4){a.x, a.y, b.x, b.y}; v1 = (f32x4){c.x, c.y, d.x, d.y}; }
                    v0 = v0 * sc; v1 = v1 * sc; u32x4 w; w.x = cvt_pk_bf16(v0[0], v0[1]); w.y = cvt_pk_bf16(v0[2], v0[3]); w.z = cvt_pk_bf16(v1[0], v1[1]); w.w = cvt_pk_bf16(v1[2], v1[3]);
                    *(u32x4*)(rowp + bj * HALF) = w; } }
    }
};

struct EpiResidF32 {
    static constexpr bool PERM = false, AFTER_DRAIN = false;
    const bf16_t* X; float* Z;
    __device__ __forceinline__ void operator()(const f32x4 (&acc)[2][2][4][2], const Unit& u, int wr, int wc, int fr, int fq) const {
        typedef unsigned u32x2 __attribute__((ext_vector_type(2)));
        const int row0 = u.pm * BM + wr * 64 + fr, col0 = u.pn * BM + wc * 32 + 4 * fq;
#pragma unroll
        for (int ai = 0; ai < 2; ++ai)
#pragma unroll
            for (int m = 0; m < 4; ++m) { const size_t ro = (size_t)(row0 + ai * HALF + m * 16) * 1024;
#pragma unroll
                for (int bj = 0; bj < 2; ++bj)
#pragma unroll
                    for (int n = 0; n < 2; ++n) { const int c = col0 + bj * HALF + n * 16; const u32x2 xw = *(const u32x2*)(X + ro + c);
                        f32x4 xv; xv[0] = __builtin_bit_cast(float, xw.x << 16); xv[1] = __builtin_bit_cast(float, xw.x & 0xffff0000u); xv[2] = __builtin_bit_cast(float, xw.y << 16); xv[3] = __builtin_bit_cast(float, xw.y & 0xffff0000u);
                        *(f32x4*)(Z + ro + c) = xv * 1.41421356237309515f + acc[ai][bj][m][n]; } }
    }
};
struct EpiCInF {
    static constexpr bool PERM = true, AFTER_DRAIN = false;
    bf16_t *CQ, *CK, *CV, *CG; const float* lb;
    __device__ __forceinline__ void operator()(const f32x4 (&acc)[2][2][4][2], const Unit& u, int wr, int wc, int fr, int fq) const {
        const int seg = u.pn >> 2, colt = (u.pn & 3) * BM;
        bf16_t* base = seg == 0 ? CQ : (seg == 1 ? CK : (seg == 2 ? CV : CG));
        const int row0 = u.pm * BM + wr * 64 + fr, col0 = colt + wc * 32 + 8 * fq;
        f32x4 om[2][2];
#pragma unroll
        for (int bj = 0; bj < 2; ++bj)
#pragma unroll
            for (int n = 0; n < 2; ++n) { const f32x4 l = *(const f32x4*)(lb + col0 + bj * HALF + 4 * n); om[bj][n] = 1.0f - l; }
#pragma unroll
        for (int ai = 0; ai < 2; ++ai)
#pragma unroll
            for (int m = 0; m < 4; ++m) { bf16_t* rowp = base + (size_t)(row0 + ai * HALF + m * 16) * 1024 + col0;
#pragma unroll
                for (int bj = 0; bj < 2; ++bj) { f32x4 v0 = acc[ai][bj][m][0], v1 = acc[ai][bj][m][1];
                    if (seg == 1) {
#pragma unroll
                        for (int q = 0; q < 4; ++q) { v0[q] = om[bj][0][q] / (1.0f + __expf(v0[q])); v1[q] = om[bj][1][q] / (1.0f + __expf(v1[q])); } }
                    u32x4 w; w.x = cvt_pk_bf16(v0[0], v0[1]); w.y = cvt_pk_bf16(v0[2], v0[3]); w.z = cvt_pk_bf16(v1[0], v1[1]); w.w = cvt_pk_bf16(v1[2], v1[3]);
                    *(u32x4*)(rowp + bj * HALF) = w; } }
    }
};
template <class Epi, class Sched, bool ALIGN_EPI = false, bool SP2 = false>
__device__ __forceinline__ void gemm_phase(PG8_LAS unsigned char* lds, const Gemm g, const Sched& S, const Epi& E) {
    const int tid = threadIdx.x, wid = __builtin_amdgcn_readfirstlane(tid >> 6), lane = tid & 63, wr = wid >> 2, wc = wid & 3, fr = lane & 15, fq = lane >> 4;
    const int K = g.K, nt = K / BK;
    unsigned voffA[2], voffB[2];
#pragma unroll
    for (int i = 0; i < 2; ++i) { int R, C; stage_rc(tid * 16 + i * 8192, R, C); const int Rb = Epi::PERM ? ((R & ~31) + perm32(R & 31)) : R;
        voffA[i] = (unsigned)(R * K + C) * 2u; voffB[i] = (unsigned)(Rb * K + C) * 2u; }
    const size_t kstep = (size_t)(BK * 2);
    const size_t hstep = (size_t)HALF * K * 2;
    const size_t tstep = 2 * hstep;
    const unsigned ldsw = (unsigned)wid * 1024u;
    const int aoff = lds_byte(wr * 64 + fr, fq * 8), boff = lds_byte(wc * 32 + fr, fq * 8);
#define PG8_SA(b, h) (((b) * 2 + (h)) * HTB)
#define PG8_SB(b, h) ((4 + (b) * 2 + (h)) * HTB)
#define PG8_STAGE(bufoff, gbase, voff) do { _Pragma("unroll") for (int _i = 0; _i < 2; ++_i) \
        __builtin_amdgcn_global_load_lds((const unsigned*)((const char*)(gbase) + (voff)[_i]), (PG8_LAS unsigned*)(lds + (bufoff) + ldsw + _i * 8192), 16, 0, 0); } while (0)
#define PG8_LDA(dst, b, h) do { _Pragma("unroll") for (int m = 0; m < 4; ++m) _Pragma("unroll") for (int k = 0; k < 2; ++k) dst[m][k] = *(const PG8_LAS bf16x8*)(lds + PG8_SA(b, h) + aoff + m * 2048 + k * 1024); } while (0)
#define PG8_LDB(dst, b, h) do { _Pragma("unroll") for (int n = 0; n < 2; ++n) _Pragma("unroll") for (int k = 0; k < 2; ++k) dst[n][k] = *(const PG8_LAS bf16x8*)(lds + PG8_SB(b, h) + boff + n * 2048 + k * 1024); } while (0)
#define PG8_MMA(ai, bj, At, Bt) do { __builtin_amdgcn_s_setprio(1); _Pragma("unroll") for (int m = 0; m < 4; ++m) _Pragma("unroll") for (int n = 0; n < 2; ++n) _Pragma("unroll") for (int k = 0; k < 2; ++k) \
        acc[ai][bj][m][n] = __builtin_amdgcn_mfma_f32_16x16x32_bf16(Bt[n][k], At[m][k], acc[ai][bj][m][n], 0, 0, 0); __builtin_amdgcn_s_setprio(0); } while (0)
#define PG8_WAIT_V(n) asm volatile("s_waitcnt vmcnt(" #n ")" ::: "memory")
#define PG8_WAIT_L(n) asm volatile("s_waitcnt lgkmcnt(" #n ")" ::: "memory")
#define PG8_BAR __builtin_amdgcn_s_barrier()
#define PG8_SCHED __builtin_amdgcn_sched_barrier(0)
    Unit cur, nxt; int ui = 0;
    if (!S.next(0, cur)) return;
    f32x4 acc[2][2][4][2];
#pragma unroll
    for (int a = 0; a < 2; ++a)
#pragma unroll
        for (int b = 0; b < 2; ++b)
#pragma unroll
            for (int m = 0; m < 4; ++m)
#pragma unroll
                for (int n = 0; n < 2; ++n) acc[a][b][m][n] = (f32x4){0.f, 0.f, 0.f, 0.f};
    bf16x8 At[4][2], B0[2][2], B1[2][2];
    const char* cA = (const char*)g.A + (size_t)cur.pm * tstep; const char* cB = (const char*)g.Bt + (size_t)cur.pn * tstep;
    S.a_ready(cur);
    if constexpr (SP2) {
        PG8_STAGE(PG8_SB(0, 0), cB, voffB); PG8_STAGE(PG8_SB(0, 1), cB + hstep, voffB); PG8_STAGE(PG8_SA(0, 0), cA, voffA); PG8_STAGE(PG8_SA(0, 1), cA + hstep, voffA);
        if (wr == 1) PG8_BAR;
        PG8_WAIT_V(2); PG8_BAR;
        PG8_STAGE(PG8_SB(1, 0), cB + kstep, voffB); PG8_STAGE(PG8_SA(1, 0), cA + kstep, voffA); PG8_STAGE(PG8_SB(1, 1), cB + hstep + kstep, voffB);
        PG8_WAIT_V(6); PG8_BAR;
    } else {
        PG8_STAGE(PG8_SB(0, 0), cB, voffB); PG8_STAGE(PG8_SA(0, 0), cA, voffA); PG8_STAGE(PG8_SB(0, 1), cB + hstep, voffB); PG8_STAGE(PG8_SA(0, 1), cA + hstep, voffA);
        if (wr == 1) PG8_BAR;
        PG8_WAIT_V(4); PG8_BAR;
        PG8_STAGE(PG8_SB(1, 0), cB + kstep, voffB); PG8_STAGE(PG8_SA(1, 0), cA + kstep, voffA); PG8_STAGE(PG8_SB(1, 1), cB + hstep + kstep, voffB);
        PG8_WAIT_V(6); PG8_BAR;
    }
    for (;;) {
        const bool has_next = S.next(ui + 1, nxt);
        const char* nA = has_next ? (const char*)g.A + (size_t)nxt.pm * tstep : cA; const char* nB = has_next ? (const char*)g.Bt + (size_t)nxt.pn * tstep : cB;
        for (int t = 0; t < nt; t += 2) {
            const bool last = (t == nt - 2);
            const char* a1 = cA + (size_t)(t + 1) * kstep;
            const char* a2 = last ? nA : cA + (size_t)(t + 2) * kstep; const char* b2 = last ? nB : cB + (size_t)(t + 2) * kstep;
            const char* a3 = a2 + kstep; const char* b3 = b2 + kstep;
            if (last && has_next) S.a_ready(nxt);
            if constexpr (SP2) {
            PG8_LDB(B0, 0, 0); PG8_LDB(B1, 0, 1); PG8_SCHED; PG8_LDA(At, 0, 0); PG8_STAGE(PG8_SA(1, 1), a1 + hstep, voffA);
            PG8_WAIT_V(8); PG8_WAIT_L(0); PG8_BAR; PG8_MMA(0, 0, At, B0); PG8_MMA(0, 1, At, B1); PG8_BAR; PG8_SCHED;
            PG8_LDA(At, 0, 1); PG8_STAGE(PG8_SB(0, 0), b2, voffB); PG8_STAGE(PG8_SB(0, 1), b2 + hstep, voffB); PG8_STAGE(PG8_SA(0, 0), a2, voffA);
            PG8_WAIT_V(8); PG8_WAIT_L(0); PG8_BAR; PG8_MMA(1, 0, At, B0); PG8_MMA(1, 1, At, B1); PG8_BAR; PG8_SCHED;
            PG8_LDB(B0, 1, 0); PG8_LDB(B1, 1, 1); PG8_SCHED; PG8_LDA(At, 1, 0); PG8_STAGE(PG8_SA(0, 1), a2 + hstep, voffA);
            PG8_WAIT_V(8); PG8_WAIT_L(0); PG8_BAR; PG8_MMA(0, 0, At, B0); PG8_MMA(0, 1, At, B1); PG8_BAR; PG8_SCHED;
            PG8_LDA(At, 1, 1); PG8_STAGE(PG8_SB(1, 0), b3, voffB); PG8_STAGE(PG8_SB(1, 1), b3 + hstep, voffB); PG8_STAGE(PG8_SA(1, 0), a3, voffA);
            PG8_WAIT_V(8); PG8_WAIT_L(0); PG8_BAR; PG8_MMA(1, 0, At, B0); PG8_MMA(1, 1, At, B1); PG8_BAR; PG8_SCHED;
            } else {
            PG8_LDB(B0, 0, 0); PG8_SCHED; PG8_LDA(At, 0, 0); PG8_STAGE(PG8_SA(1, 1), a1 + hstep, voffA);
            PG8_WAIT_L(8); PG8_BAR; PG8_WAIT_L(0); PG8_MMA(0, 0, At, B0); PG8_BAR; PG8_SCHED;
            PG8_LDB(B1, 0, 1); PG8_STAGE(PG8_SB(0, 0), b2, voffB);
            PG8_BAR; PG8_WAIT_L(0); PG8_MMA(0, 1, At, B1); PG8_BAR;
            PG8_LDA(At, 0, 1); PG8_STAGE(PG8_SA(0, 0), a2, voffA);
            PG8_BAR; PG8_WAIT_L(0); PG8_MMA(1, 0, At, B0); PG8_BAR; PG8_SCHED;
            PG8_STAGE(PG8_SB(0, 1), b2 + hstep, voffB);
            PG8_WAIT_V(6); PG8_BAR; PG8_MMA(1, 1, At, B1); PG8_BAR;
            PG8_LDB(B0, 1, 0); PG8_SCHED; PG8_LDA(At, 1, 0); PG8_STAGE(PG8_SA(0, 1), a2 + hstep, voffA);
            PG8_WAIT_L(8); PG8_BAR; PG8_WAIT_L(0); PG8_MMA(0, 0, At, B0); PG8_BAR; PG8_SCHED;
            PG8_LDB(B1, 1, 1); PG8_STAGE(PG8_SB(1, 0), b3, voffB);
            PG8_BAR; PG8_WAIT_L(0); PG8_MMA(0, 1, At, B1); PG8_BAR;
            PG8_LDA(At, 1, 1); PG8_STAGE(PG8_SA(1, 0), a3, voffA);
            PG8_BAR; PG8_WAIT_L(0); PG8_MMA(1, 0, At, B0); PG8_BAR; PG8_SCHED;
            PG8_STAGE(PG8_SB(1, 1), b3 + hstep, voffB);
            PG8_WAIT_V(6); PG8_BAR; PG8_MMA(1, 1, At, B1); PG8_BAR;
            }
        }
        if constexpr (ALIGN_EPI) { if (wr == 0) PG8_BAR; }
        if constexpr (!Epi::AFTER_DRAIN) { E(acc, cur, wr, wc, fr, fq); S.done(cur); }
        if (!has_next) break;
#pragma unroll
        for (int a = 0; a < 2; ++a)
#pragma unroll
            for (int b = 0; b < 2; ++b)
#pragma unroll
                for (int m = 0; m < 4; ++m)
#pragma unroll
                    for (int n = 0; n < 2; ++n) acc[a][b][m][n] = (f32x4){0.f, 0.f, 0.f, 0.f};
        cur = nxt; cA = nA; cB = nB; ++ui;
        if constexpr (ALIGN_EPI) { if (wr == 1) PG8_BAR; }
    }
    PG8_WAIT_V(0);
    if constexpr (!ALIGN_EPI) { if (wr == 0) PG8_BAR; }
    PG8_BAR;
    if constexpr (Epi::AFTER_DRAIN) { E.fused(acc, cur, wr, wc, fr, fq, lds, wid, lane); S.done(cur); }
#undef PG8_SA
#undef PG8_SB
#undef PG8_STAGE
#undef PG8_LDA
#undef PG8_LDB
#undef PG8_MMA
#undef PG8_WAIT_V
#undef PG8_WAIT_L
#undef PG8_BAR
#undef PG8_SCHED
}
}

__device__ __forceinline__ float gamma_log2(int h) { return log2f(1.f - exp2f(-5.f - (float)h)); }

__device__ __forceinline__ void phase_prologue(LAS unsigned char* lds, const float* const* in, unsigned char* ws) {
    const int tid = threadIdx.x, lane = tid & 63, wave = tid >> 6;
    const int gw = blockIdx.x * NWAVES + wave, NGW = gridDim.x * NWAVES;
    LAS float* scr = (LAS float*)(lds + wave * 16384);
    constexpr int I_ABIN = (D / 64) * (AB_IN / 32), I_SQ = (D / 64) * (D / 32), I_CIN = (D / 64) * (C_IN / 32), I_WQ = (D / 64) * (2048 / 32);
    constexpr int NITEMS = I_ABIN + I_SQ + I_CIN + I_SQ + 2 * I_WQ;
    for (int it = gw; it < NITEMS; it += NGW) {
        int r = it;
        if (r < I_ABIN) { p0_transpose_item(in[1], D, AB_IN, (bf16*)(ws + WS_WABIN), scr, r, lane); continue; } r -= I_ABIN;
        if (r < I_SQ) { p0_transpose_item(in[5], D, D, (bf16*)(ws + WS_WABOUT), scr, r, lane); continue; } r -= I_SQ;
        if (r < I_CIN) { p0_transpose_item(in[6], D, C_IN, (bf16*)(ws + WS_WCIN), scr, r, lane); continue; } r -= I_CIN;
        if (r < I_SQ) { p0_transpose_item(in[9], D, D, (bf16*)(ws + WS_WCOUT), scr, r, lane); continue; } r -= I_SQ;
        if (r < I_WQ) { p0_transpose_item(in[10], D, 2048, (bf16*)(ws + WS_WQ), scr, r, lane); continue; } r -= I_WQ;
        p0_transpose_item(in[10] + (size_t)D * 2048, D, 2048, (bf16*)(ws + WS_WQ) + (size_t)2048 * D, scr, r, lane);
    }
    for (int it = gw; it < 32; it += NGW) p0_transpose_item(in[2] + (size_t)(it >> 3) * 16384, 128, 128, (bf16*)(ws + WS_POOLWT) + (size_t)(it >> 3) * 16384, scr, it & 7, lane);
    const size_t gt = (size_t)blockIdx.x * NTHR + tid, NT = (size_t)gridDim.x * NTHR;
    { const float* x = in[0]; bf16* xb = (bf16*)(ws + WS_XB);
      for (size_t i = gt; i < (size_t)T * D / 8; i += NT) { const f32x4 a = *(const GAS f32x4*)(x + i * 8), b = *(const GAS f32x4*)(x + i * 8 + 4);
          v4u o; o.x = pk2(a.x, a.y); o.y = pk2(a.z, a.w); o.z = pk2(b.x, b.y); o.w = pk2(b.z, b.w); *(GAS v4u*)(xb + i * 8) = o; } }
    { const float* k = in[11]; bf16* kb = (bf16*)(ws + WS_KEYS);
      for (size_t i = gt; i < (size_t)2 * 8 * 2 * 128 * 128 / 8; i += NT) { const f32x4 a = *(const GAS f32x4*)(k + i * 8), b = *(const GAS f32x4*)(k + i * 8 + 4);
          v4u o; o.x = pk2(a.x, a.y); o.y = pk2(a.z, a.w); o.z = pk2(b.x, b.y); o.w = pk2(b.z, b.w); *(GAS v4u*)(kb + i * 8) = o; } }
    { float* ct = (float*)(ws + WS_ROPE); float* st = ct + 4096 * 32;
      for (size_t i = gt; i < (size_t)4096 * 32; i += NT) { const int pos = (int)(i >> 5), f = (int)(i & 31);
          const double inv = exp(-log(10000.0) * ((double)f / 31.0)); const double ang = (double)pos * inv;
          ct[i] = (float)cos(ang); st[i] = (float)sin(ang); } }
    { const float* l = in[7]; float* lb = (float*)(ws + WS_LB);
      for (size_t i = gt; i < 1024; i += NT) { const float a = l[i], b = l[1024 + i]; const float m = fmaxf(a, b); const float ea = expf(a - m), eb = expf(b - m); lb[i] = eb / (ea + eb); } }
}

__device__ __forceinline__ void phase_ret_local(LAS unsigned char* lds, unsigned char* ws) {
    const int tid = threadIdx.x;
    const bf16* H0 = (const bf16*)(ws + WS_H0); float* LST = (float*)(ws + WS_LST);
    const float* ct = (const float*)(ws + WS_ROPE); const float* st = ct + 4096 * 32;
    LAS float* kd = (LAS float*)lds;
    LAS float* vv = (LAS float*)(lds + 32768);
    for (int item = blockIdx.x; item < 1024; item += gridDim.x) {
        const int n = item & 31, h = (item >> 5) & 3, b = item >> 7;
        const size_t t0 = (size_t)b * SEQ + n * 128; const float lg = gamma_log2(h);
        for (int idx = tid; idx < 4096; idx += NTHR) { const int s = idx >> 5, i = idx & 31, pos = n * 128 + s;
            const bf16* row = H0 + (t0 + s) * AB_IN + 768 + h * 64;
            const float x1 = bf2f(row[i]), x2 = bf2f(row[i + 32]); const float c = ct[pos * 32 + i], sn = st[pos * 32 + i];
            const float dec = exp2f((float)(127 - s) * lg) * 0.125f;
            kd[s * 64 + i] = (x1 * c - x2 * sn) * dec; kd[s * 64 + i + 32] = (x2 * c + x1 * sn) * dec; }
        for (int idx = tid; idx < 16384; idx += NTHR) { const int s = idx >> 7, e = idx & 127; vv[idx] = bf2f(H0[(t0 + s) * AB_IN + 1024 + h * 128 + e]); }
        __syncthreads();
        const int e = tid & 127, dg = tid >> 7;
        float acc[16];
#pragma unroll
        for (int j = 0; j < 16; ++j) acc[j] = 0.f;
        for (int s = 0; s < 128; ++s) { const float v = vv[s * 128 + e];
#pragma unroll
            for (int j = 0; j < 16; ++j) acc[j] += kd[s * 64 + dg * 16 + j] * v; }
#pragma unroll
        for (int j = 0; j < 16; ++j) LST[(size_t)item * 8192 + (dg * 16 + j) * 128 + e] = acc[j];
        __syncthreads();
    }
}
__device__ __forceinline__ void phase_ret_prefix(unsigned char* ws) {
    float* LST = (float*)(ws + WS_LST);
    const size_t gt = (size_t)blockIdx.x * NTHR + threadIdx.x, NT = (size_t)gridDim.x * NTHR;
    for (size_t idx = gt; idx < (size_t)32 * 8192; idx += NT) { const int bh = (int)(idx >> 13), el = (int)(idx & 8191), h = bh & 3;
        const float g128 = exp2f(128.f * gamma_log2(h)); float S = 0.f;
        for (int n = 0; n < 32; ++n) { float* p = LST + ((size_t)(bh * 32 + n) * 8192 + el); const float tmp = *p; *p = S; S = S * g128 + tmp; } }
}
__device__ __forceinline__ void phase_ret_out_pool(LAS unsigned char* lds, const float* const* in, unsigned char* ws) {
    const int tid = threadIdx.x;
    const bf16* H0 = (const bf16*)(ws + WS_H0); const float* LST = (const float*)(ws + WS_LST); bf16* Y = (bf16*)(ws + WS_Y);
    const float* ct = (const float*)(ws + WS_ROPE); const float* st = ct + 4096 * 32;
    const float* pool_w = in[2]; const float* pool_scale = in[3]; const float* ret_g = in[4];
    LAS float* qs = (LAS float*)lds;
    LAS float* ks = qs + 128 * 65;
    LAS float* R2 = (LAS float*)(lds + 66560);
    LAS float* PA = (LAS float*)lds;
    LAS float* PB = (LAS float*)(lds + 66048);
    for (int item = blockIdx.x; item < 256; item += gridDim.x) {
        const int n = item & 31, b = item >> 5; const size_t t0 = (size_t)b * SEQ + n * 128;
        const int c = tid >> 2, eg = tid & 3;
        for (int h = 0; h < 4; ++h) {
            const float lg = gamma_log2(h);
            for (int idx = tid; idx < 4096; idx += NTHR) { const int s = idx >> 5, i = idx & 31, pos = n * 128 + s;
                const bf16* rq = H0 + (t0 + s) * AB_IN + 512 + h * 64; const bf16* rk = H0 + (t0 + s) * AB_IN + 768 + h * 64;
                const float cs = ct[pos * 32 + i], sn = st[pos * 32 + i];
                const float q1 = bf2f(rq[i]), q2 = bf2f(rq[i + 32]), k1 = bf2f(rk[i]), k2 = bf2f(rk[i + 32]);
                qs[s * 65 + i] = q1 * cs - q2 * sn; qs[s * 65 + i + 32] = q2 * cs + q1 * sn;
                ks[s * 65 + i] = (k1 * cs - k2 * sn) * 0.125f; ks[s * 65 + i + 32] = (k2 * cs + k1 * sn) * 0.125f; }
            { const float* Sg = LST + (size_t)((b * 4 + h) * 32 + n) * 8192;
              for (int idx = tid; idx < 8192; idx += NTHR) R2[idx] = Sg[idx]; }
            __syncthreads();
            float o[32];
#pragma unroll
            for (int j = 0; j < 32; ++j) o[j] = 0.f;
            for (int d = 0; d < 64; ++d) { const float qv = qs[c * 65 + d];
#pragma unroll
                for (int j = 0; j < 32; ++j) o[j] += qv * R2[d * 128 + eg * 32 + j]; }
            { const float qd = exp2f((float)(c + 1) * lg);
#pragma unroll
              for (int j = 0; j < 32; ++j) o[j] *= qd; }
            __syncthreads();
            for (int idx = tid; idx < 16384; idx += NTHR) { const int s = idx >> 7, e = idx & 127; R2[idx] = bf2f(H0[(t0 + s) * AB_IN + 1024 + h * 128 + e]); }
            __syncthreads();
            for (int s = 0; s <= c; ++s) {
                float dot = 0.f;
#pragma unroll 16
                for (int d = 0; d < 64; ++d) dot += qs[c * 65 + d] * ks[s * 65 + d];
                const float w = dot * exp2f((float)(c - s) * lg);
#pragma unroll
                for (int j = 0; j < 32; ++j) o[j] += w * R2[s * 128 + eg * 32 + j];
            }
            float sum = 0.f;
#pragma unroll
            for (int j = 0; j < 32; ++j) sum += o[j];
            sum += __shfl_xor(sum, 1); sum += __shfl_xor(sum, 2);
            const float mean = sum * (1.f / 128.f); float sq = 0.f;
#pragma unroll
            for (int j = 0; j < 32; ++j) { const float dl = o[j] - mean; sq += dl * dl; }
            sq += __shfl_xor(sq, 1); sq += __shfl_xor(sq, 2);
            const float rstd = 1.f / sqrtf(sq * (1.f / 128.f) + LN_EPS);
            { const bf16* rg = H0 + (t0 + c) * AB_IN + 1536 + h * 128 + eg * 32; bf16* yo = Y + (t0 + c) * D + 512 + h * 128 + eg * 32;
#pragma unroll
              for (int j = 0; j < 32; ++j) { const float g = bf2f(rg[j]); const float sg = g / (1.f + expf(-g));
                  yo[j] = (bf16)f2bf((o[j] - mean) * rstd * ret_g[h * 128 + eg * 32 + j] * sg); } }
            __syncthreads();
        }
        for (int gi = 0; gi < 4; ++gi) {
            const int w = 2 << gi;
            for (int idx = tid; idx < 16384; idx += NTHR) { const int s = idx >> 7, cc = idx & 127, pos = n * 128 + s; const int cnt = (pos + 1 < w) ? pos + 1 : w;
                float sum = 0.f; for (int j = 0; j < cnt; ++j) sum += bf2f(H0[(t0 + s - j) * AB_IN + gi * 128 + cc]);
                PA[s * 129 + cc] = sum / (float)cnt - bf2f(H0[(t0 + s) * AB_IN + gi * 128 + cc]); }
            for (int idx = tid; idx < 16384; idx += NTHR) PB[idx] = pool_w[gi * 16384 + idx];
            __syncthreads();
            float o[32];
#pragma unroll
            for (int j = 0; j < 32; ++j) o[j] = 0.f;
            for (int cc = 0; cc < 128; ++cc) { const float pv = PA[c * 129 + cc];
#pragma unroll
                for (int j = 0; j < 32; ++j) o[j] += pv * PB[cc * 128 + eg * 32 + j]; }
            { bf16* yo = Y + (t0 + c) * D + gi * 128 + eg * 32;
#pragma unroll
              for (int j = 0; j < 32; ++j) yo[j] = (bf16)f2bf(o[j] * pool_scale[gi * 128 + eg * 32 + j]); }
            __syncthreads();
        }
    }
}

__device__ __forceinline__ void unpack8(const v4u w, float (&x)[8]) { x[0] = bflo(w.x); x[1] = bfhi(w.x); x[2] = bflo(w.y); x[3] = bfhi(w.y); x[4] = bflo(w.z); x[5] = bfhi(w.z); x[6] = bflo(w.w); x[7] = bfhi(w.w); }
__device__ __forceinline__ v4u pack8(const float (&x)[8]) { v4u w; w.x = pk2(x[0], x[1]); w.y = pk2(x[2], x[3]); w.z = pk2(x[4], x[5]); w.w = pk2(x[6], x[7]); return w; }
__device__ __forceinline__ void phase_ret_out_pool_fast(LAS unsigned char* lds, const float* const* in, unsigned char* ws) {
    const int tid = threadIdx.x, lane = tid & 63, wave = __builtin_amdgcn_readfirstlane(tid >> 6);
    const int c = lane & 31, hh = lane >> 5, cbk = wave & 3, eh = wave >> 2;
    const bf16* H0 = (const bf16*)(ws + WS_H0); const float* LST = (const float*)(ws + WS_LST); bf16* Y = (bf16*)(ws + WS_Y);
    const float* ct = (const float*)(ws + WS_ROPE); const float* st = ct + 4096 * 32;
    const float* pool_scale = in[3]; const float* ret_g = in[4]; const bf16* PWT = (const bf16*)(ws + WS_POOLWT);
    constexpr int O_QP = 0, O_KP = 18432, O_VT = 36864, O_ST = 71680, O_PI = 90112, O_RED = 124928, O_PT = 0, O_WT = 34816;
    for (int item = blockIdx.x; item < 256; item += gridDim.x) {
        const int n = item & 31, b = item >> 5; const size_t t0 = (size_t)b * SEQ + n * 128;
        for (int h = 0; h < 4; ++h) {
            const float lg = gamma_log2(h);
            __syncthreads();
            { const int s = tid >> 2, grp = tid & 3, pos = n * 128 + s;
              const bf16* rq = H0 + (t0 + s) * AB_IN + 512 + h * 64 + 8 * grp; const bf16* rk = H0 + (t0 + s) * AB_IN + 768 + h * 64 + 8 * grp;
              float q1[8], q2[8], k1[8], k2[8], cs[8], sn[8];
              unpack8(*(const GAS v4u*)rq, q1); unpack8(*(const GAS v4u*)(rq + 32), q2); unpack8(*(const GAS v4u*)rk, k1); unpack8(*(const GAS v4u*)(rk + 32), k2);
              { const f32x4 a = *(const GAS f32x4*)(ct + pos * 32 + 8 * grp), bq = *(const GAS f32x4*)(ct + pos * 32 + 8 * grp + 4);
                cs[0] = a.x; cs[1] = a.y; cs[2] = a.z; cs[3] = a.w; cs[4] = bq.x; cs[5] = bq.y; cs[6] = bq.z; cs[7] = bq.w; }
              { const f32x4 a = *(const GAS f32x4*)(st + pos * 32 + 8 * grp), bq = *(const GAS f32x4*)(st + pos * 32 + 8 * grp + 4);
                sn[0] = a.x; sn[1] = a.y; sn[2] = a.z; sn[3] = a.w; sn[4] = bq.x; sn[5] = bq.y; sn[6] = bq.z; sn[7] = bq.w; }
              const float gq = exp2f((float)(s + 1) * lg), gk = 0.125f * exp2f(-(float)(s + 1) * lg);
              float qa[8], qb[8], ka[8], kb[8];
#pragma unroll
              for (int j = 0; j < 8; ++j) { qa[j] = (q1[j] * cs[j] - q2[j] * sn[j]) * gq; qb[j] = (q2[j] * cs[j] + q1[j] * sn[j]) * gq;
                                            ka[j] = (k1[j] * cs[j] - k2[j] * sn[j]) * gk; kb[j] = (k2[j] * cs[j] + k1[j] * sn[j]) * gk; }
              *(LAS v4u*)(lds + O_QP + s * 144 + 16 * grp) = pack8(qa); *(LAS v4u*)(lds + O_QP + s * 144 + 64 + 16 * grp) = pack8(qb);
              *(LAS v4u*)(lds + O_KP + s * 144 + 16 * grp) = pack8(ka); *(LAS v4u*)(lds + O_KP + s * 144 + 64 + 16 * grp) = pack8(kb); }
#pragma unroll
            for (int i = 0; i < 4; ++i) { const int task = tid + 512 * i, e8 = task >> 7, s = task & 127;
                const v4u w = *(const GAS v4u*)(H0 + (t0 + s) * AB_IN + 1024 + h * 128 + 8 * e8);
                LAS bf16* d = (LAS bf16*)(lds + O_VT + (8 * e8) * 272 + 2 * s);
                d[0 * 136] = (bf16)(w.x & 0xffffu); d[1 * 136] = (bf16)(w.x >> 16); d[2 * 136] = (bf16)(w.y & 0xffffu); d[3 * 136] = (bf16)(w.y >> 16);
                d[4 * 136] = (bf16)(w.z & 0xffffu); d[5 * 136] = (bf16)(w.z >> 16); d[6 * 136] = (bf16)(w.w & 0xffffu); d[7 * 136] = (bf16)(w.w >> 16); }
            { const float* Sg = LST + (size_t)((b * 4 + h) * 32 + n) * 8192;
#pragma unroll
              for (int i = 0; i < 4; ++i) { const int task = tid + 512 * i, e4 = task >> 6, d = task & 63;
                  const f32x4 sv = *(const GAS f32x4*)(Sg + d * 128 + 4 * e4);
                  LAS bf16* o = (LAS bf16*)(lds + O_ST + (4 * e4) * 144 + 2 * d);
                  o[0 * 72] = (bf16)f2bf(sv.x); o[1 * 72] = (bf16)f2bf(sv.y); o[2 * 72] = (bf16)f2bf(sv.z); o[3 * 72] = (bf16)f2bf(sv.w); } }
            __syncthreads();
            bf16x8 qf[4];
#pragma unroll
            for (int ks = 0; ks < 4; ++ks) qf[ks] = *(const LAS bf16x8*)(lds + O_QP + (32 * cbk + c) * 144 + (16 * ks + 8 * hh) * 2);
            for (int sb = 0; sb <= cbk; ++sb) {
                f32x16 sc;
#pragma unroll
                for (int r = 0; r < 16; ++r) sc[r] = 0.f;
#pragma unroll
                for (int ks = 0; ks < 4; ++ks) { const bf16x8 kf = *(const LAS bf16x8*)(lds + O_KP + (32 * sb + c) * 144 + (16 * ks + 8 * hh) * 2);
                    sc = __builtin_amdgcn_mfma_f32_32x32x16_bf16(kf, qf[ks], sc, 0, 0, 0); }
#pragma unroll
                for (int g4 = 0; g4 < 4; ++g4) { float m[4];
#pragma unroll
                    for (int q = 0; q < 4; ++q) { const float sv = sc[4 * g4 + q]; m[q] = (sb < cbk || 8 * g4 + 4 * hh + q <= c) ? sv : 0.f; }
                    *(LAS v2u*)(lds + O_PI + cbk * 8704 + c * 272 + (32 * sb + 8 * g4 + 4 * hh) * 2) = (v2u){pk2(m[0], m[1]), pk2(m[2], m[3])}; }
            }
            f32x16 acc[2];
#pragma unroll
            for (int j = 0; j < 2; ++j) {
#pragma unroll
                for (int r = 0; r < 16; ++r) acc[j][r] = 0.f;
                const int eb = 2 * eh + j;
                for (int sb = 0; sb <= cbk; ++sb) {
#pragma unroll
                    for (int ks = 0; ks < 2; ++ks) { const bf16x8 af = *(const LAS bf16x8*)(lds + O_VT + (32 * eb + c) * 272 + (32 * sb + 16 * ks + 8 * hh) * 2);
                        const bf16x8 pf = *(const LAS bf16x8*)(lds + O_PI + cbk * 8704 + c * 272 + (32 * sb + 16 * ks + 8 * hh) * 2);
                        acc[j] = __builtin_amdgcn_mfma_f32_32x32x16_bf16(af, pf, acc[j], 0, 0, 0); }
                }
#pragma unroll
                for (int ks = 0; ks < 4; ++ks) { const bf16x8 sf = *(const LAS bf16x8*)(lds + O_ST + (32 * eb + c) * 144 + (16 * ks + 8 * hh) * 2);
                    acc[j] = __builtin_amdgcn_mfma_f32_32x32x16_bf16(sf, qf[ks], acc[j], 0, 0, 0); }
            }
            float sum = 0.f, sq = 0.f;
#pragma unroll
            for (int j = 0; j < 2; ++j)
#pragma unroll
                for (int r = 0; r < 16; ++r) { const float ov = acc[j][r]; sum += ov; sq += ov * ov; }
            sum += __shfl_xor(sum, 32); sq += __shfl_xor(sq, 32);
            LAS float* red = (LAS float*)(lds + O_RED);
            if (hh == 0) { red[(eh * 128 + 32 * cbk + c) * 2] = sum; red[(eh * 128 + 32 * cbk + c) * 2 + 1] = sq; }
            __syncthreads();
            sum += red[((eh ^ 1) * 128 + 32 * cbk + c) * 2]; sq += red[((eh ^ 1) * 128 + 32 * cbk + c) * 2 + 1];
            const float mean = sum * (1.f / 128.f); const float var = fmaxf(sq * (1.f / 128.f) - mean * mean, 0.f);
            const float rstd = 1.f / sqrtf(var + LN_EPS);
            { const size_t row = t0 + 32 * cbk + c;
#pragma unroll
              for (int j = 0; j < 2; ++j)
#pragma unroll
                  for (int g4 = 0; g4 < 4; ++g4) { const int e = 32 * (2 * eh + j) + 8 * g4 + 4 * hh;
                      const v2u gw2 = *(const GAS v2u*)(H0 + row * AB_IN + 1536 + h * 128 + e); const f32x4 gm = *(const GAS f32x4*)(ret_g + h * 128 + e);
                      const float g0 = bflo(gw2.x), g1 = bfhi(gw2.x), g2 = bflo(gw2.y), g3 = bfhi(gw2.y);
                      const float o0 = acc[j][4 * g4 + 0], o1 = acc[j][4 * g4 + 1], o2 = acc[j][4 * g4 + 2], o3 = acc[j][4 * g4 + 3];
                      const float y0 = (o0 - mean) * rstd * gm.x * (g0 / (1.f + __expf(-g0))), y1 = (o1 - mean) * rstd * gm.y * (g1 / (1.f + __expf(-g1)));
                      const float y2 = (o2 - mean) * rstd * gm.z * (g2 / (1.f + __expf(-g2))), y3 = (o3 - mean) * rstd * gm.w * (g3 / (1.f + __expf(-g3)));
                      *(GAS v2u*)(Y + row * D + 512 + h * 128 + e) = (v2u){pk2(y0, y1), pk2(y2, y3)}; } }
        }
        for (int gi = 0; gi < 4; ++gi) {
            const int w = 2 << gi;
            __syncthreads();
#pragma unroll
            for (int i = 0; i < 4; ++i) { const int task = tid + 512 * i, t = task >> 4, c8 = task & 15, pos = n * 128 + t; const int cnt = (pos + 1 < w) ? pos + 1 : w;
                const bf16* ur = H0 + (t0 + t) * AB_IN + gi * 128 + 8 * c8;
                float u0[8], sm[8]; unpack8(*(const GAS v4u*)ur, u0);
#pragma unroll
                for (int q = 0; q < 8; ++q) sm[q] = u0[q];
                for (int j = 1; j < cnt; ++j) { float uj[8]; unpack8(*(const GAS v4u*)(ur - (size_t)j * AB_IN), uj);
#pragma unroll
                    for (int q = 0; q < 8; ++q) sm[q] += uj[q]; }
                const float ic = 1.f / (float)cnt; float pv[8];
#pragma unroll
                for (int q = 0; q < 8; ++q) pv[q] = sm[q] * ic - u0[q];
                *(LAS v4u*)(lds + O_PT + t * 272 + 16 * c8) = pack8(pv); }
#pragma unroll
            for (int i = 0; i < 4; ++i) { const int piece = tid + 512 * i, d = piece >> 4, c16 = piece & 15;
                *(LAS v4u*)(lds + O_WT + d * 272 + 16 * c16) = *(const GAS v4u*)(PWT + (size_t)(gi * 128 + d) * 128 + 8 * c16); }
            __syncthreads();
            bf16x8 pfr[8];
#pragma unroll
            for (int ks = 0; ks < 8; ++ks) pfr[ks] = *(const LAS bf16x8*)(lds + O_PT + (32 * cbk + c) * 272 + (16 * ks + 8 * hh) * 2);
#pragma unroll
            for (int j = 0; j < 2; ++j) { const int db = 2 * eh + j;
                f32x16 a2;
#pragma unroll
                for (int r = 0; r < 16; ++r) a2[r] = 0.f;
#pragma unroll
                for (int ks = 0; ks < 8; ++ks) { const bf16x8 wf = *(const LAS bf16x8*)(lds + O_WT + (32 * db + c) * 272 + (16 * ks + 8 * hh) * 2);
                    a2 = __builtin_amdgcn_mfma_f32_32x32x16_bf16(wf, pfr[ks], a2, 0, 0, 0); }
#pragma unroll
                for (int g4 = 0; g4 < 4; ++g4) { const int d0 = 32 * db + 8 * g4 + 4 * hh; const f32x4 ps = *(const GAS f32x4*)(pool_scale + gi * 128 + d0);
                    const float y0 = a2[4 * g4 + 0] * ps.x, y1 = a2[4 * g4 + 1] * ps.y, y2 = a2[4 * g4 + 2] * ps.z, y3 = a2[4 * g4 + 3] * ps.w;
                    *(GAS v2u*)(Y + (t0 + 32 * cbk + c) * D + gi * 128 + d0) = (v2u){pk2(y0, y1), pk2(y2, y3)}; }
            }
        }
    }
    __syncthreads();
}
__device__ __forceinline__ void phase_ln(const float* Z, bf16* O, const float* g, const float* bb) {
    const int tid = threadIdx.x, lane = tid & 63, wave = tid >> 6;
    const int gw = blockIdx.x * NWAVES + wave, NGW = gridDim.x * NWAVES;
    for (int m = gw; m < T; m += NGW) {
        const GAS f32x4* zr = (const GAS f32x4*)(Z + (size_t)m * D) + lane;
        f32x4 v[4]; float s = 0.f;
#pragma unroll
        for (int j = 0; j < 4; ++j) { v[j] = zr[64 * j]; s += (v[j].x + v[j].y) + (v[j].z + v[j].w); }
        const float mean = wave_sum(s) * (1.f / D); float s2 = 0.f;
#pragma unroll
        for (int j = 0; j < 4; ++j) { v[j] = v[j] - mean; s2 += (v[j].x * v[j].x + v[j].y * v[j].y) + (v[j].z * v[j].z + v[j].w * v[j].w); }
        const float rstd = 1.f / sqrtf(wave_sum(s2) * (1.f / D) + LN_EPS);
        GAS v2u* o8 = (GAS v2u*)(O + (size_t)m * D) + lane;
#pragma unroll
        for (int j = 0; j < 4; ++j) { const f32x4 gg = *((const GAS f32x4*)g + lane + 64 * j), b4 = *((const GAS f32x4*)bb + lane + 64 * j);
            v2u o; o.x = pk2(v[j].x * rstd * gg.x + b4.x, v[j].y * rstd * gg.y + b4.y); o.y = pk2(v[j].z * rstd * gg.z + b4.z, v[j].w * rstd * gg.w + b4.w); o8[64 * j] = o; }
    }
}
__device__ __forceinline__ void wave_argmax(float& bv, int& bi) {
#pragma unroll
    for (int off = 32; off >= 1; off >>= 1) { const float ov = __shfl_xor(bv, off); const int oi = __shfl_xor(bi, off);
        if (ov > bv || (ov == bv && oi < bi)) { bv = ov; bi = oi; } }
}
__device__ __forceinline__ void phase_topk(LAS unsigned char* lds, const bf16* Q, const float* keys  , int* EID, float* GATE) {
    const int tid = threadIdx.x, lane = tid & 63, wave = tid >> 6;
    LAS float* kl = (LAS float*)lds;
    LAS float* qt = (LAS float*)(lds + 66048);
    LAS float* sc = (LAS float*)(lds + 82560);
    for (int item = blockIdx.x; item < (T / 32) * 8; item += gridDim.x) {
        const int h = item & 7, tile = item >> 3; const size_t tok0 = (size_t)tile * 32;
        for (int p = 0; p < 2; ++p) {
            const float* kg = keys + (size_t)((h * 2 + p) * 128) * 128;
            for (int idx = tid; idx < 16384; idx += NTHR) { const int k = idx >> 7, d = idx & 127; kl[k * 129 + d] = kg[idx]; }
            for (int idx = tid; idx < 4096; idx += NTHR) { const int t = idx >> 7, d = idx & 127; qt[t * 129 + d] = bf2f(Q[(tok0 + t) * 2048 + h * 256 + p * 128 + d]); }
            __syncthreads();
            { const int t = tid >> 4, kg16 = tid & 15;
              for (int jj = 0; jj < 8; ++jj) { const int k = kg16 + 16 * jj; float dot = 0.f;
#pragma unroll 16
                  for (int d = 0; d < 128; ++d) dot += qt[t * 129 + d] * kl[k * 129 + d];
                  sc[(t * 2 + p) * 128 + k] = dot; } }
            __syncthreads();
        }
        for (int tt = 0; tt < 4; ++tt) {
            const int t = wave * 4 + tt;
            float tv[2]; int ti[2];
#pragma unroll
            for (int p = 0; p < 2; ++p) {
                float v0 = sc[(t * 2 + p) * 128 + lane], v1 = sc[(t * 2 + p) * 128 + lane + 64];
                float mv = 0.f; int mi = 0;
                for (int j = 0; j < 16; ++j) {
                    float bv; int bi; if (v0 >= v1) { bv = v0; bi = lane; } else { bv = v1; bi = lane + 64; }
                    wave_argmax(bv, bi);
                    if (lane == j) { mv = bv; mi = bi; }
                    if (bi == lane) v0 = -INFINITY; if (bi == lane + 64) v1 = -INFINITY;
                }
                tv[p] = mv; ti[p] = mi;
            }
            float cv[4];
#pragma unroll
            for (int m = 0; m < 4; ++m) { const int cidx = lane + 64 * m; cv[m] = __shfl(tv[0], cidx >> 4) + __shfl(tv[1], cidx & 15); }
            float bestv = 0.f; int bestc = 0;
            for (int j = 0; j < 16; ++j) {
                float bv = cv[0]; int bi = lane;
#pragma unroll
                for (int m = 1; m < 4; ++m) if (cv[m] > bv) { bv = cv[m]; bi = lane + 64 * m; }
                wave_argmax(bv, bi);
                if (lane == j) { bestv = bv; bestc = bi; }
#pragma unroll
                for (int m = 0; m < 4; ++m) if (bi == lane + 64 * m) cv[m] = -INFINITY;
            }
            const float mx = __shfl(bestv, 0);
            const float ex = (lane < 16) ? expf(bestv - mx) : 0.f;
            const float den = wave_sum(ex);
            const int ia = __shfl(ti[0], bestc >> 4), ib = __shfl(ti[1], bestc & 15);
            if (lane < 16) { const size_t o = (tok0 + t) * 128 + h * 16 + lane; EID[o] = ia * 128 + ib; GATE[o] = ex / den; }
        }
        __syncthreads();
    }
}

#define CEF_D(a, b) { const float hi_ = fmaxf((a), (b)), lo_ = fminf((a), (b)); (a) = hi_; (b) = lo_; }
#define CEF_A(a, b) { const float hi_ = fmaxf((a), (b)), lo_ = fminf((a), (b)); (a) = lo_; (b) = hi_; }
#define CEP_D(ka, pa, kb, pb) { const bool sw_ = (kb) > (ka); const float k0_ = sw_ ? (kb) : (ka), k1_ = sw_ ? (ka) : (kb); const int p0_ = sw_ ? (pb) : (pa), p1_ = sw_ ? (pa) : (pb); (ka) = k0_; (kb) = k1_; (pa) = p0_; (pb) = p1_; }
template <int OFF, int NV> __device__ __forceinline__ void bsort16_desc(float (&v)[NV]) {
#pragma unroll
    for (int k = 2; k <= 16; k <<= 1) {
#pragma unroll
        for (int j = k >> 1; j > 0; j >>= 1) {
#pragma unroll
            for (int i = 0; i < 16; ++i) { const int l = i ^ j;
                if (l > i) { if ((i & k) == 0) CEF_D(v[OFF + i], v[OFF + l]) else CEF_A(v[OFF + i], v[OFF + l]) } }
        }
    }
}
template <int OA, int NV> __device__ __forceinline__ void bmerge16_desc(float (&v)[NV]) {
#pragma unroll
    for (int j = 8; j > 0; j >>= 1) {
#pragma unroll
        for (int i = 0; i < 16; ++i) { const int l = i ^ j; if (l > i) CEF_D(v[OA + i], v[OA + l]) }
    }
}
template <int OA, int OB, int NV> __device__ __forceinline__ void merge_top16(float (&v)[NV]) {
#pragma unroll
    for (int i = 0; i < 16; ++i) v[OA + i] = fmaxf(v[OA + i], v[OB + 15 - i]);
    bmerge16_desc<OA, NV>(v);
}
template <int OFF, int NV> __device__ __forceinline__ void bsort16p_desc(float (&v)[NV], int (&q)[NV]) {
#pragma unroll
    for (int k = 2; k <= 16; k <<= 1) {
#pragma unroll
        for (int j = k >> 1; j > 0; j >>= 1) {
#pragma unroll
            for (int i = 0; i < 16; ++i) { const int l = i ^ j;
                if (l > i) { if ((i & k) == 0) CEP_D(v[OFF + i], q[OFF + i], v[OFF + l], q[OFF + l]) else CEP_D(v[OFF + l], q[OFF + l], v[OFF + i], q[OFF + i]) } }
        }
    }
}
template <int OA, int NV> __device__ __forceinline__ void bmerge16p_desc(float (&v)[NV], int (&q)[NV]) {
#pragma unroll
    for (int j = 8; j > 0; j >>= 1) {
#pragma unroll
        for (int i = 0; i < 16; ++i) { const int l = i ^ j; if (l > i) CEP_D(v[OA + i], q[OA + i], v[OA + l], q[OA + l]) }
    }
}
__host__ __device__ constexpr int pair_i(int s) { return s < 16 ? 0 : s < 24 ? 1 : s < 29 ? 2 : s < 33 ? 3 : s < 36 ? 4 : s < 38 ? 5 : s < 40 ? 6 : s < 42 ? 7 : (s - 42 + 8); }
__host__ __device__ constexpr int pair_j(int s) { return s < 16 ? s : s < 24 ? s - 16 : s < 29 ? s - 24 : s < 33 ? s - 29 : s < 36 ? s - 33 : s < 38 ? s - 36 : s < 40 ? s - 38 : s < 42 ? s - 40 : 0; }
__device__ __forceinline__ void phase_topk_fast(LAS unsigned char* lds, const bf16* Q, const bf16* keysb  , int* EID, float* GATE) {
    const int tid = threadIdx.x, lane = tid & 63, wave = __builtin_amdgcn_readfirstlane(tid >> 6);
    const int c = lane & 31, hh = lane >> 5;
    for (int hi = blockIdx.x; hi < 256; hi += gridDim.x) {
        const int h = hi & 7, rank = hi >> 3;
        __syncthreads();
        for (int idx = tid; idx < 2 * 128 * 16; idx += NTHR) { const int rowi = idx >> 4, ch = idx & 15;
            const v4u kv = *(const GAS v4u*)(keysb + (size_t)h * 32768 + rowi * 128 + ch * 8);
            *(LAS v4u*)(lds + rowi * 272 + ch * 16) = kv; }
        __syncthreads();
        for (int it = 0; it < 4; ++it) {
            const int tile = rank * 8 + wave + 256 * it;
            const size_t tok0 = (size_t)tile * 32;
            float ta[16], tb[16];
#pragma unroll
            for (int p = 0; p < 2; ++p) {
                bf16x8 bq[8];
                const bf16* qrow = Q + (tok0 + c) * 2048 + h * 256 + p * 128 + 8 * hh;
#pragma unroll
                for (int ks = 0; ks < 8; ++ks) bq[ks] = *(const GAS bf16x8*)(qrow + 16 * ks);
                f32x16 acc[4];
#pragma unroll
                for (int blk = 0; blk < 4; ++blk) {
#pragma unroll
                    for (int r = 0; r < 16; ++r) acc[blk][r] = 0.f;
#pragma unroll
                    for (int ks = 0; ks < 8; ++ks) { const bf16x8 a = *(const LAS bf16x8*)(lds + (p * 128 + 32 * blk + c) * 272 + (16 * ks + 8 * hh) * 2);
                        acc[blk] = __builtin_amdgcn_mfma_f32_32x32x16_bf16(a, bq[ks], acc[blk], 0, 0, 0); }
                }
                float v[64];
#pragma unroll
                for (int blk = 0; blk < 4; ++blk)
#pragma unroll
                    for (int r = 0; r < 16; ++r)
                    { const float sv = acc[blk][r]; v[blk * 16 + r] = __uint_as_float((__float_as_uint(sv) & ~127u) | (unsigned)(32 * blk + (r & 3) + 8 * (r >> 2)) | (unsigned)(hh << 2)); }
                __builtin_amdgcn_sched_barrier(0);
                bsort16_desc<0, 64>(v); bsort16_desc<16, 64>(v); bsort16_desc<32, 64>(v); bsort16_desc<48, 64>(v);
                merge_top16<0, 16, 64>(v); merge_top16<32, 48, 64>(v); merge_top16<0, 32, 64>(v);
                float o[16];
#pragma unroll
                for (int i = 0; i < 16; ++i) o[i] = __shfl_xor(v[i], 32);
#pragma unroll
                for (int i = 0; i < 16; ++i) v[i] = fmaxf(v[i], o[15 - i]);
                bmerge16_desc<0, 64>(v);
#pragma unroll
                for (int i = 0; i < 16; ++i) { if (p == 0) ta[i] = v[i]; else tb[i] = v[i]; }
                __builtin_amdgcn_sched_barrier(0);
            }
            float av[16], bv[16]; int ai[16], bi[16];
#pragma unroll
            for (int i = 0; i < 16; ++i) { const unsigned ua = __builtin_bit_cast(unsigned, ta[i]), ub = __builtin_bit_cast(unsigned, tb[i]);
                av[i] = __builtin_bit_cast(float, ua & ~127u); ai[i] = (int)(ua & 127u); bv[i] = __builtin_bit_cast(float, ub & ~127u); bi[i] = (int)(ub & 127u); }
            float ck[32]; int cp[32];
#pragma unroll
            for (int s2 = 0; s2 < 32; ++s2) {
                const float k0 = av[pair_i(s2)] + bv[pair_j(s2)]; const int p0 = (ai[pair_i(s2)] << 7) | bi[pair_j(s2)];
                float k1 = -INFINITY; int p1 = 0;
                if (s2 + 32 < 50) { k1 = av[pair_i(s2 + 32 < 50 ? s2 + 32 : 0)] + bv[pair_j(s2 + 32 < 50 ? s2 + 32 : 0)]; p1 = (ai[pair_i(s2 + 32 < 50 ? s2 + 32 : 0)] << 7) | bi[pair_j(s2 + 32 < 50 ? s2 + 32 : 0)]; }
                ck[s2] = hh ? k1 : k0; cp[s2] = hh ? p1 : p0;
            }
            __builtin_amdgcn_sched_barrier(0);
            bsort16p_desc<0, 32>(ck, cp); bsort16p_desc<16, 32>(ck, cp);
#pragma unroll
            for (int i = 0; i < 16; ++i) { if (ck[16 + 15 - i] > ck[i]) { ck[i] = ck[16 + 15 - i]; cp[i] = cp[16 + 15 - i]; } }
            bmerge16p_desc<0, 32>(ck, cp);
            { float ok[16]; int op[16];
#pragma unroll
              for (int i = 0; i < 16; ++i) { ok[i] = __shfl_xor(ck[i], 32); op[i] = __shfl_xor(cp[i], 32); }
#pragma unroll
              for (int i = 0; i < 16; ++i) { if (ok[15 - i] > ck[i]) { ck[i] = ok[15 - i]; cp[i] = op[15 - i]; } } }
            bmerge16p_desc<0, 32>(ck, cp);
            float ex[16]; float sum = 0.f;
#pragma unroll
            for (int i = 0; i < 16; ++i) { ex[i] = __expf(ck[i] - ck[0]); sum += ex[i]; }
            const float inv = 1.f / sum;
            if (hh == 0) {
                int* eo = EID + (tok0 + c) * 128 + h * 16; float* go = GATE + (tok0 + c) * 128 + h * 16;
#pragma unroll
                for (int i = 0; i < 4; ++i) { *(GAS v4u*)(eo + 4 * i) = (v4u){(unsigned)cp[4 * i], (unsigned)cp[4 * i + 1], (unsigned)cp[4 * i + 2], (unsigned)cp[4 * i + 3]};
                    *(GAS f32x4*)(go + 4 * i) = (f32x4){ex[4 * i] * inv, ex[4 * i + 1] * inv, ex[4 * i + 2] * inv, ex[4 * i + 3] * inv}; }
            }
        }
    }
    __syncthreads();
}
template <bool FINAL>
__device__ __forceinline__ void phase_gather(const bf16* X, const int* EID, const float* GATE, const float* U, const float* V, const float* g, const float* bb, bf16* Ob, float* Of) {
    const int tid = threadIdx.x, lane = tid & 63, wave = tid >> 6;
    const int gw = blockIdx.x * NWAVES + wave, NGW = gridDim.x * NWAVES;
    for (int t = gw; t < T; t += NGW) {
        f32x4 x[4], acc[4];
#pragma unroll
        for (int j = 0; j < 4; ++j) { const v2u w = *((const GAS v2u*)(X + (size_t)t * D) + lane + 64 * j);
            x[j] = (f32x4){bflo(w.x), bfhi(w.x), bflo(w.y), bfhi(w.y)}; acc[j] = (f32x4){0.f, 0.f, 0.f, 0.f}; }
        const int e0 = EID[(size_t)t * 128 + lane], e1 = EID[(size_t)t * 128 + 64 + lane];
        const float g0 = GATE[(size_t)t * 128 + lane], g1 = GATE[(size_t)t * 128 + 64 + lane];
#pragma unroll 2
        for (int k = 0; k < 128; ++k) {
            const int e = (k < 64) ? __shfl(e0, k) : __shfl(e1, k - 64);
            const float gt = (k < 64) ? __shfl(g0, k) : __shfl(g1, k - 64);
            const GAS f32x4* ur = (const GAS f32x4*)(U + (size_t)e * D) + lane;
            float dot = 0.f;
#pragma unroll
            for (int j = 0; j < 4; ++j) { const f32x4 u = ur[64 * j]; dot += (x[j].x * u.x + x[j].y * u.y) + (x[j].z * u.z + x[j].w * u.w); }
            dot = wave_sum(dot);
            const float a = 0.5f * dot * (1.f + erff(dot * 0.70710678118654752f));
            const float cf = gt * a;
            const GAS f32x4* vr = (const GAS f32x4*)(V + (size_t)e * D) + lane;
#pragma unroll
            for (int j = 0; j < 4; ++j) { const f32x4 v = vr[64 * j]; acc[j] += cf * v; }
        }
        float s = 0.f;
#pragma unroll
        for (int j = 0; j < 4; ++j) { acc[j] = ALPHA * x[j] + acc[j]; s += (acc[j].x + acc[j].y) + (acc[j].z + acc[j].w); }
        const float mean = wave_sum(s) * (1.f / D); float s2 = 0.f;
#pragma unroll
        for (int j = 0; j < 4; ++j) { acc[j] = acc[j] - mean; s2 += (acc[j].x * acc[j].x + acc[j].y * acc[j].y) + (acc[j].z * acc[j].z + acc[j].w * acc[j].w); }
        const float rstd = 1.f / sqrtf(wave_sum(s2) * (1.f / D) + LN_EPS);
#pragma unroll
        for (int j = 0; j < 4; ++j) { const f32x4 gg = *((const GAS f32x4*)g + lane + 64 * j), b4 = *((const GAS f32x4*)bb + lane + 64 * j);
            const f32x4 o = acc[j] * rstd * gg + b4;
            if (FINAL) *((GAS f32x4*)(Of + (size_t)t * D) + lane + 64 * j) = o;
            else { v2u w; w.x = pk2(o.x, o.y); w.y = pk2(o.z, o.w); *((GAS v2u*)(Ob + (size_t)t * D) + lane + 64 * j) = w; } }
    }
}

typedef float f32x2 __attribute__((ext_vector_type(2)));
__device__ __forceinline__ void phase_convert_tables(const float* U, const float* V, unsigned char* ws) {
    const int tid = threadIdx.x, lane = tid & 63, wave = tid >> 6;
    const int gw = blockIdx.x * NWAVES + wave, NGW = gridDim.x * NWAVES;
    for (int row = gw; row < 4 * NEXP; row += NGW) {
        const bool isv = row >= 2 * NEXP; const int r = row & (2 * NEXP - 1);
        const GAS f32x4* src = (const GAS f32x4*)((isv ? V : U) + (size_t)r * D) + (isv ? 4 * lane : lane); const int sstep = isv ? 1 : 64;
        f32x4 v[4]; float m = 0.f;
#pragma unroll
        for (int j = 0; j < 4; ++j) { v[j] = src[sstep * j]; m = fmaxf(fmaxf(m, fmaxf(fabsf(v[j].x), fabsf(v[j].y))), fmaxf(fabsf(v[j].z), fabsf(v[j].w))); }
#pragma unroll
        for (int o = 1; o < 64; o <<= 1) m = fmaxf(m, __shfl_xor(m, o));
        m = fmaxf(m, 1e-30f);
        const float sc = 7.f / m;
        unsigned w0 = 0u, w1 = 0u;
#define Q4(x) fminf(fmaxf((x) * sc, -6.f), 6.f)
        w0 = __builtin_amdgcn_cvt_scalef32_pk_fp4_f32(w0, Q4(v[0].x), Q4(v[0].y), 1.0f, 0); w0 = __builtin_amdgcn_cvt_scalef32_pk_fp4_f32(w0, Q4(v[0].z), Q4(v[0].w), 1.0f, 1);
        w0 = __builtin_amdgcn_cvt_scalef32_pk_fp4_f32(w0, Q4(v[1].x), Q4(v[1].y), 1.0f, 2); w0 = __builtin_amdgcn_cvt_scalef32_pk_fp4_f32(w0, Q4(v[1].z), Q4(v[1].w), 1.0f, 3);
        w1 = __builtin_amdgcn_cvt_scalef32_pk_fp4_f32(w1, Q4(v[2].x), Q4(v[2].y), 1.0f, 0); w1 = __builtin_amdgcn_cvt_scalef32_pk_fp4_f32(w1, Q4(v[2].z), Q4(v[2].w), 1.0f, 1);
        w1 = __builtin_amdgcn_cvt_scalef32_pk_fp4_f32(w1, Q4(v[3].x), Q4(v[3].y), 1.0f, 2); w1 = __builtin_amdgcn_cvt_scalef32_pk_fp4_f32(w1, Q4(v[3].z), Q4(v[3].w), 1.0f, 3);
#undef Q4
        *((GAS v2u*)(ws + (isv ? WS_V8 : WS_U8) + (size_t)r * 512) + lane) = (v2u){w0, w1};
        if (lane == 0) ((float*)(ws + (isv ? WS_DQV : WS_DQU)))[r] = m * (1.f / 7.f);
    }
}
__host__ __device__ constexpr int rev4(int i) { return ((i & 1) << 3) | ((i & 2) << 1) | ((i & 4) >> 1) | ((i & 8) >> 3); }
#define FMA2(a, b, c) __builtin_elementwise_fma((a), (b), (c))
#define CVT8(w, hi) __builtin_amdgcn_cvt_pk_f32_fp8((int)(w), (hi))
template <bool FINAL, int MODE  >
__device__ __forceinline__ void phase_gather8(const bf16* X, const int* EID, float* GATE, const unsigned char* U8, const unsigned char* V8, const float* DQU, const float* DQV,
                                              const float* g, const float* bb, bf16* Ob, float* Of) {
    const int tid = threadIdx.x, lane = tid & 63, wave = tid >> 6;
    const int gw = blockIdx.x * NWAVES + wave, NGW = gridDim.x * NWAVES;
    const bool b0 = (lane & 1) != 0, b1 = (lane & 2) != 0, b2 = (lane & 4) != 0, b3 = (lane & 8) != 0; const int myrow = lane >> 4;
    for (int t = gw; t < T; t += NGW) {
        f32x2 x[8];
#pragma unroll
        for (int j = 0; j < 4; ++j) { const v2u w = *((const GAS v2u*)(X + (size_t)t * D) + lane + 64 * j);
            x[2 * j] = (f32x2){bflo(w.x), bfhi(w.x)}; x[2 * j + 1] = (f32x2){bflo(w.y), bfhi(w.y)}; }
        const int e0 = EID[(size_t)t * 128 + lane], e1 = EID[(size_t)t * 128 + 64 + lane];
        const float gt0 = GATE[(size_t)t * 128 + lane], gt1 = GATE[(size_t)t * 128 + 64 + lane];
        const float dqu0 = DQU[e0], dqu1 = DQU[e1], dqv0 = DQV[e0], dqv1 = DQV[e1];
        float act0 = 0.f, act1 = 0.f;
        if (MODE != 2) {
#pragma unroll
        for (int r = 0; r < 2; ++r) {
            const int er = r ? e1 : e0;
            for (int row = 0; row < 4; ++row) {
                v4u w[16];
#pragma unroll
                for (int i = 0; i < 16; ++i) { const int e = __builtin_amdgcn_readlane(er, row * 16 + rev4(i)); w[i] = *((const GAS v4u*)(U8 + (size_t)e * 1024) + lane); }
                float p[16];
#pragma unroll
                for (int i = 0; i < 16; ++i) { f32x2 a = (f32x2){0.f, 0.f};
                    a = FMA2(x[0], CVT8(w[i].x, false), a); a = FMA2(x[1], CVT8(w[i].x, true), a);
                    a = FMA2(x[2], CVT8(w[i].y, false), a); a = FMA2(x[3], CVT8(w[i].y, true), a);
                    a = FMA2(x[4], CVT8(w[i].z, false), a); a = FMA2(x[5], CVT8(w[i].z, true), a);
                    a = FMA2(x[6], CVT8(w[i].w, false), a); a = FMA2(x[7], CVT8(w[i].w, true), a);
                    p[i] = a.x + a.y; }
                float r8[8], r4[4], r2[2];
#pragma unroll
                for (int i = 0; i < 8; ++i) { const float keep = b0 ? p[8 + i] : p[i], send = b0 ? p[i] : p[8 + i]; r8[i] = keep + __shfl_xor(send, 1); }
#pragma unroll
                for (int i = 0; i < 4; ++i) { const float keep = b1 ? r8[4 + i] : r8[i], send = b1 ? r8[i] : r8[4 + i]; r4[i] = keep + __shfl_xor(send, 2); }
#pragma unroll
                for (int i = 0; i < 2; ++i) { const float keep = b2 ? r4[2 + i] : r4[i], send = b2 ? r4[i] : r4[2 + i]; r2[i] = keep + __shfl_xor(send, 4); }
                float r1 = (b3 ? r2[1] : r2[0]) + __shfl_xor(b3 ? r2[0] : r2[1], 8);
                r1 += __shfl_xor(r1, 16); r1 += __shfl_xor(r1, 32);
                if (myrow == row) { if (r == 0) act0 = r1; else act1 = r1; }
            }
        }
        }
        float c0, c1;
        if (MODE != 2) { const float a0 = act0 * dqu0, a1 = act1 * dqu1;
          c0 = gt0 * (0.5f * a0 * (1.f + erff(a0 * 0.70710678118654752f))) * dqv0;
          c1 = gt1 * (0.5f * a1 * (1.f + erff(a1 * 0.70710678118654752f))) * dqv1; }
        else { c0 = gt0; c1 = gt1; }
        if (MODE == 1) { GATE[(size_t)t * 128 + lane] = c0; GATE[(size_t)t * 128 + 64 + lane] = c1; continue; }
        f32x2 acc[8];
#pragma unroll
        for (int j = 0; j < 8; ++j) acc[j] = (f32x2){0.f, 0.f};
#pragma unroll
        for (int r = 0; r < 2; ++r) {
            const int er = r ? e1 : e0; const int cr = __builtin_bit_cast(int, r ? c1 : c0);
            for (int row = 0; row < 4; ++row) {
                v4u w[16];
#pragma unroll
                for (int i = 0; i < 16; ++i) { const int e = __builtin_amdgcn_readlane(er, row * 16 + i); w[i] = *((const GAS v4u*)(V8 + (size_t)e * 1024) + lane); }
#pragma unroll
                for (int i = 0; i < 16; ++i) { const float cf = __builtin_bit_cast(float, __builtin_amdgcn_readlane(cr, row * 16 + i)); const f32x2 c2 = (f32x2){cf, cf};
                    acc[0] = FMA2(c2, CVT8(w[i].x, false), acc[0]); acc[1] = FMA2(c2, CVT8(w[i].x, true), acc[1]);
                    acc[2] = FMA2(c2, CVT8(w[i].y, false), acc[2]); acc[3] = FMA2(c2, CVT8(w[i].y, true), acc[3]);
                    acc[4] = FMA2(c2, CVT8(w[i].z, false), acc[4]); acc[5] = FMA2(c2, CVT8(w[i].z, true), acc[5]);
                    acc[6] = FMA2(c2, CVT8(w[i].w, false), acc[6]); acc[7] = FMA2(c2, CVT8(w[i].w, true), acc[7]); }
            }
        }
        float s = 0.f;
#pragma unroll
        for (int j = 0; j < 8; ++j) { acc[j] = x[j] * ALPHA + acc[j]; s += acc[j].x + acc[j].y; }
        const float mean = wave_sum(s) * (1.f / D); float s2 = 0.f;
#pragma unroll
        for (int j = 0; j < 8; ++j) { acc[j] = acc[j] - mean; s2 += acc[j].x * acc[j].x + acc[j].y * acc[j].y; }
        const float rstd = 1.f / sqrtf(wave_sum(s2) * (1.f / D) + LN_EPS);
#pragma unroll
        for (int j = 0; j < 4; ++j) { const f32x4 gg = *((const GAS f32x4*)g + lane + 64 * j), b4 = *((const GAS f32x4*)bb + lane + 64 * j);
            const f32x4 o = (f32x4){acc[2 * j].x, acc[2 * j].y, acc[2 * j + 1].x, acc[2 * j + 1].y} * rstd * gg + b4;
            if (FINAL) *((GAS f32x4*)(Of + (size_t)t * D) + lane + 64 * j) = o;
            else { v2u w; w.x = pk2(o.x, o.y); w.y = pk2(o.z, o.w); *((GAS v2u*)(Ob + (size_t)t * D) + lane + 64 * j) = w; } }
    }
}
__device__ __forceinline__ void phase_hgrn(LAS unsigned char* lds, unsigned char* ws) {
    const int tid = threadIdx.x;
    const bf16* CQ = (const bf16*)(ws + WS_CQ); const bf16* CK = (const bf16*)(ws + WS_CK); const bf16* CV = (const bf16*)(ws + WS_CV); bf16* O = (bf16*)(ws + WS_O);
    LAS float* fL = (LAS float*)lds;
    LAS float* kL = fL + 4096; LAS float* qL = kL + 4096;
    LAS float* vL = qL + 4096;
    LAS float* part = vL + 1024;
    for (int item = blockIdx.x; item < 256; item += gridDim.x) {
        const int es = item & 3, h = (item >> 2) & 7, b = item >> 5;
        const int e = tid & 31, dg = tid >> 5;
        float S[8];
#pragma unroll
        for (int j = 0; j < 8; ++j) S[j] = 0.f;
        for (int blk = 0; blk < SEQ / 32; ++blk) {
            const size_t t0 = (size_t)b * SEQ + blk * 32;
            for (int idx = tid; idx < 4096; idx += NTHR) { const int s = idx >> 7, d = idx & 127; const size_t o = (t0 + s) * D + h * 128 + d;
                const float kk = bf2f(CK[o]); kL[idx] = kk; fL[idx] = 1.f - kk; qL[idx] = bf2f(CQ[o]); }
            for (int idx = tid; idx < 1024; idx += NTHR) { const int s = idx >> 5, ee = idx & 31; vL[idx] = bf2f(CV[(t0 + s) * D + h * 128 + es * 32 + ee]); }
            __syncthreads();
            for (int s = 0; s < 32; ++s) { const float v = vL[s * 32 + e]; float po = 0.f;
#pragma unroll
                for (int j = 0; j < 8; ++j) { const int d = dg * 8 + j; S[j] = fL[s * 128 + d] * S[j] + kL[s * 128 + d] * v; po += qL[s * 128 + d] * S[j]; }
                part[(s * 16 + dg) * 32 + e] = po; }
            __syncthreads();
            for (int idx = tid; idx < 1024; idx += NTHR) { const int s = idx >> 5, ee = idx & 31; float o = 0.f;
#pragma unroll
                for (int g = 0; g < 16; ++g) o += part[(s * 16 + g) * 32 + ee];
                O[(t0 + s) * D + h * 128 + es * 32 + ee] = (bf16)f2bf(o); }
            __syncthreads();
        }
    }
}


#define GROW(wb, i_, tab, ereg, lsel) (wb)[i_] = *((const GAS v2u*)((tab) + (size_t)__builtin_amdgcn_readlane((ereg), (lsel)) * 512) + lane)
#define CVT4(wd, bs) __builtin_amdgcn_cvt_scalef32_pk_f32_fp4((wd), 1.0f, (bs))
__device__ __forceinline__ void phase_gather_u(const bf16* X, const int* EID, float* GATE, const unsigned char* U8, const float* DQU, const float* DQV) {
    const int tid = threadIdx.x, lane = tid & 63, wave = tid >> 6;
    const int gw = blockIdx.x * NWAVES + wave, NGW = gridDim.x * NWAVES;
    const bool b0 = (lane & 1) != 0, b1 = (lane & 2) != 0, b2 = (lane & 4) != 0, b3 = (lane & 8) != 0; const int myrow = lane >> 4;
    int t = gw;
    if (t < T) {
    v2u xr[4]; int e0, e1; float gt0, gt1;
#pragma unroll
    for (int j = 0; j < 4; ++j) xr[j] = *((const GAS v2u*)(X + (size_t)t * D) + lane + 64 * j);
    e0 = EID[(size_t)t * 128 + lane]; e1 = EID[(size_t)t * 128 + 64 + lane]; gt0 = GATE[(size_t)t * 128 + lane]; gt1 = GATE[(size_t)t * 128 + 64 + lane];
    v2u wA[16], wB[16];
#pragma unroll
    for (int i = 0; i < 16; ++i) GROW(wA, i, U8, e0, rev4(i));
#pragma unroll
    for (int i = 0; i < 16; ++i) GROW(wB, i, U8, e0, 16 + rev4(i));
    for (;;) {
        const int tn = t + NGW; const bool has_next = tn < T;
        v2u nxr[4]; int ne0 = e0, ne1 = e1; float ngt0 = 0.f, ngt1 = 0.f;
        if (has_next) {
#pragma unroll
            for (int j = 0; j < 4; ++j) nxr[j] = *((const GAS v2u*)(X + (size_t)tn * D) + lane + 64 * j);
            ne0 = EID[(size_t)tn * 128 + lane]; ne1 = EID[(size_t)tn * 128 + 64 + lane]; ngt0 = GATE[(size_t)tn * 128 + lane]; ngt1 = GATE[(size_t)tn * 128 + 64 + lane];
        }
        const float dqu0 = DQU[e0], dqu1 = DQU[e1], dqv0 = DQV[e0], dqv1 = DQV[e1];
        f32x2 x[8];
#pragma unroll
        for (int j = 0; j < 4; ++j) { x[2 * j] = (f32x2){bflo(xr[j].x), bfhi(xr[j].x)}; x[2 * j + 1] = (f32x2){bflo(xr[j].y), bfhi(xr[j].y)}; }
        float act0 = 0.f, act1 = 0.f;
#define UBATCH(w, R, ROW, NEREG, NBASE) { float p[16]; \
            _Pragma("unroll") for (int i = 0; i < 16; ++i) { f32x2 a = (f32x2){0.f, 0.f}; \
                a = FMA2(x[0], CVT4(w[i].x, 0), a); a = FMA2(x[1], CVT4(w[i].x, 1), a); \
                a = FMA2(x[2], CVT4(w[i].x, 2), a); a = FMA2(x[3], CVT4(w[i].x, 3), a); \
                a = FMA2(x[4], CVT4(w[i].y, 0), a); a = FMA2(x[5], CVT4(w[i].y, 1), a); \
                a = FMA2(x[6], CVT4(w[i].y, 2), a); a = FMA2(x[7], CVT4(w[i].y, 3), a); \
                p[i] = a.x + a.y; GROW(w, i, U8, NEREG, (NBASE) + rev4(i)); if ((i & 3) == 3) __builtin_amdgcn_sched_barrier(0); } \
            float r8[8], r4[4], r2[2]; \
            _Pragma("unroll") for (int i = 0; i < 8; ++i) { const float keep = b0 ? p[8 + i] : p[i], send = b0 ? p[i] : p[8 + i]; r8[i] = keep + __shfl_xor(send, 1); } \
            _Pragma("unroll") for (int i = 0; i < 4; ++i) { const float keep = b1 ? r8[4 + i] : r8[i], send = b1 ? r8[i] : r8[4 + i]; r4[i] = keep + __shfl_xor(send, 2); } \
            _Pragma("unroll") for (int i = 0; i < 2; ++i) { const float keep = b2 ? r4[2 + i] : r4[i], send = b2 ? r4[i] : r4[2 + i]; r2[i] = keep + __shfl_xor(send, 4); } \
            float r1 = (b3 ? r2[1] : r2[0]) + __shfl_xor(b3 ? r2[0] : r2[1], 8); \
            r1 += __shfl_xor(r1, 16); r1 += __shfl_xor(r1, 32); \
            if (myrow == (ROW)) { if ((R) == 0) act0 = r1; else act1 = r1; } }
        UBATCH(wA, 0, 0, e0, 32) UBATCH(wB, 0, 1, e0, 48) UBATCH(wA, 0, 2, e1, 0) UBATCH(wB, 0, 3, e1, 16)
        UBATCH(wA, 1, 0, e1, 32) UBATCH(wB, 1, 1, e1, 48) UBATCH(wA, 1, 2, ne0, 0) UBATCH(wB, 1, 3, ne0, 16)
#undef UBATCH
        { const float a0 = act0 * dqu0, a1 = act1 * dqu1;
          GATE[(size_t)t * 128 + lane] = gt0 * (0.5f * a0 * (1.f + erff(a0 * 0.70710678118654752f))) * dqv0;
          GATE[(size_t)t * 128 + 64 + lane] = gt1 * (0.5f * a1 * (1.f + erff(a1 * 0.70710678118654752f))) * dqv1; }
        if (!has_next) break;
        t = tn; e0 = ne0; e1 = ne1; gt0 = ngt0; gt1 = ngt1;
#pragma unroll
        for (int j = 0; j < 4; ++j) xr[j] = nxr[j];
    }
    }
}
template <bool FINAL, int EMASK = 0x7fffffff>
__device__ __forceinline__ void phase_gather_v(const bf16* X, const int* EID, const float* COEF, const unsigned char* V8, const float* g, const float* bb, bf16* Ob, float* Of) {
    const int tid = threadIdx.x, lane = tid & 63, wave = tid >> 6;
    const int gw = blockIdx.x * NWAVES + wave, NGW = gridDim.x * NWAVES;
    int t = gw;
    if (t < T) {
    v2u xr[4]; int e0, e1; float c0, c1;
#pragma unroll
    for (int j = 0; j < 4; ++j) xr[j] = *((const GAS v2u*)(X + (size_t)t * D) + lane + 64 * j);
    e0 = EID[(size_t)t * 128 + lane] & EMASK; e1 = EID[(size_t)t * 128 + 64 + lane] & EMASK; c0 = COEF[(size_t)t * 128 + lane]; c1 = COEF[(size_t)t * 128 + 64 + lane];
    v2u wA[16], wB[16];
#pragma unroll
    for (int i = 0; i < 16; ++i) GROW(wA, i, V8, e0, i);
#pragma unroll
    for (int i = 0; i < 16; ++i) GROW(wB, i, V8, e0, 16 + i);
    for (;;) {
        const int tn = t + NGW; const bool has_next = tn < T;
        v2u nxr[4]; int ne0 = e0, ne1 = e1; float nc0 = 0.f, nc1 = 0.f;
        if (has_next) {
#pragma unroll
            for (int j = 0; j < 4; ++j) nxr[j] = *((const GAS v2u*)(X + (size_t)tn * D) + lane + 64 * j);
            ne0 = EID[(size_t)tn * 128 + lane] & EMASK; ne1 = EID[(size_t)tn * 128 + 64 + lane] & EMASK; nc0 = COEF[(size_t)tn * 128 + lane]; nc1 = COEF[(size_t)tn * 128 + 64 + lane];
        }
        f32x2 acc[8];
#pragma unroll
        for (int j = 0; j < 8; ++j) acc[j] = (f32x2){0.f, 0.f};
#define VBATCH(w, CREG, BASE, NEREG, NBASE) { const int cr_ = __builtin_bit_cast(int, (CREG)); \
            _Pragma("unroll") for (int i = 0; i < 16; ++i) { const float cf = __builtin_bit_cast(float, __builtin_amdgcn_readlane(cr_, (BASE) + i)); const f32x2 c2 = (f32x2){cf, cf}; \
                acc[0] = FMA2(c2, CVT4(w[i].x, 0), acc[0]); acc[1] = FMA2(c2, CVT4(w[i].x, 1), acc[1]); \
                acc[2] = FMA2(c2, CVT4(w[i].x, 2), acc[2]); acc[3] = FMA2(c2, CVT4(w[i].x, 3), acc[3]); \
                acc[4] = FMA2(c2, CVT4(w[i].y, 0), acc[4]); acc[5] = FMA2(c2, CVT4(w[i].y, 1), acc[5]); \
                acc[6] = FMA2(c2, CVT4(w[i].y, 2), acc[6]); acc[7] = FMA2(c2, CVT4(w[i].y, 3), acc[7]); \
                GROW(w, i, V8, NEREG, (NBASE) + i); if ((i & 3) == 3) __builtin_amdgcn_sched_barrier(0); } }
        VBATCH(wA, c0, 0, e0, 32) VBATCH(wB, c0, 16, e0, 48) VBATCH(wA, c0, 32, e1, 0) VBATCH(wB, c0, 48, e1, 16)
        VBATCH(wA, c1, 0, e1, 32) VBATCH(wB, c1, 16, e1, 48) VBATCH(wA, c1, 32, ne0, 0) VBATCH(wB, c1, 48, ne0, 16)
#undef VBATCH
        float sm = 0.f;
#pragma unroll
        for (int j = 0; j < 4; ++j) { acc[2 * j] = (f32x2){bflo(xr[j].x), bfhi(xr[j].x)} * ALPHA + acc[2 * j]; acc[2 * j + 1] = (f32x2){bflo(xr[j].y), bfhi(xr[j].y)} * ALPHA + acc[2 * j + 1];
            sm += (acc[2 * j].x + acc[2 * j].y) + (acc[2 * j + 1].x + acc[2 * j + 1].y); }
        const float mean = wave_sum(sm) * (1.f / D); float s2 = 0.f;
#pragma unroll
        for (int j = 0; j < 8; ++j) { acc[j] = acc[j] - mean; s2 += acc[j].x * acc[j].x + acc[j].y * acc[j].y; }
        const float rstd = 1.f / sqrtf(wave_sum(s2) * (1.f / D) + LN_EPS);
#pragma unroll
        for (int j = 0; j < 4; ++j) { const f32x4 gg = *((const GAS f32x4*)g + lane + 64 * j), b4 = *((const GAS f32x4*)bb + lane + 64 * j);
            const f32x4 o = (f32x4){acc[2 * j].x, acc[2 * j].y, acc[2 * j + 1].x, acc[2 * j + 1].y} * rstd * gg + b4;
            if (FINAL) *((GAS f32x4*)(Of + (size_t)t * D) + lane + 64 * j) = o;
            else { v2u wo; wo.x = pk2(o.x, o.y); wo.y = pk2(o.z, o.w); *((GAS v2u*)(Ob + (size_t)t * D) + lane + 64 * j) = wo; } }
        if (!has_next) break;
        t = tn; e0 = ne0; e1 = ne1; c0 = nc0; c1 = nc1;
#pragma unroll
        for (int j = 0; j < 4; ++j) xr[j] = nxr[j];
    }
    }
}


template <bool FINAL>
__device__ __forceinline__ void phase_gather_v_mfma(const bf16* X, const int* EID, const float* COEF, const unsigned char* V4, const float* g, const float* bb, bf16* Ob, float* Of) {
    const int tid = threadIdx.x, lane = tid & 63, wave = tid >> 6;
    const int gw = blockIdx.x * NWAVES + wave, NGW = gridDim.x * NWAVES;
    const int n = lane & 31, hh = lane >> 5;
    unsigned mask[4];
#pragma unroll
    for (int d = 0; d < 4; ++d) mask[d] = (hh == (n >> 4) && d == ((n & 15) >> 2)) ? (0xFFu << (8 * (n & 3))) : 0u;
    float gl[16], bl[16];
#pragma unroll
    for (int r = 0; r < 16; ++r) { const int col = 32 * ((r & 3) + 8 * (r >> 2) + 4 * hh) + n; gl[r] = g[col]; bl[r] = bb[col]; }
    const unsigned laneoff = 16u * (unsigned)n;
    int t = gw;
    if (t < T) {
    int e0 = EID[(size_t)t * 128 + lane], e1 = EID[(size_t)t * 128 + 64 + lane];
    float c0 = COEF[(size_t)t * 128 + lane], c1 = COEF[(size_t)t * 128 + 64 + lane];
    v4u ring[16];
#define VLOADA(slot, ereg, lsel) { const int el_ = __shfl((ereg), (lsel) + hh); ring[slot] = *(const GAS v4u*)(V4 + (((unsigned)el_ << 9) + laneoff)); }
#pragma unroll
    for (int j = 0; j < 16; ++j) VLOADA(j, e0, 2 * j)
    for (;;) {
        const int tn = t + NGW; const bool has_next = tn < T;
        int ne0 = e0, ne1 = e1; float nc0 = 0.f, nc1 = 0.f;
        if (has_next) { ne0 = EID[(size_t)tn * 128 + lane]; ne1 = EID[(size_t)tn * 128 + 64 + lane]; nc0 = COEF[(size_t)tn * 128 + lane]; nc1 = COEF[(size_t)tn * 128 + 64 + lane]; }
        unsigned short xs[16];
#pragma unroll
        for (int r = 0; r < 16; ++r) xs[r] = X[(size_t)t * D + 32 * ((r & 3) + 8 * (r >> 2) + 4 * hh) + n];
        float cm = fmaxf(fabsf(c0), fabsf(c1));
#pragma unroll
        for (int o = 1; o < 64; o <<= 1) cm = fmaxf(cm, __shfl_xor(cm, o));
        unsigned ex = (__float_as_uint(cm) >> 23) & 0xffu; ex = ex < 8u ? 8u : ex;
        const float S = __uint_as_float((261u - ex) << 23), invS = __uint_as_float((ex - 7u) << 23);
        const unsigned wq = (unsigned)__builtin_amdgcn_cvt_pk_fp8_f32(c0 * S, c1 * S, 0, false);
        const int rep0 = (int)((wq & 0xffu) * 0x01010101u), rep1 = (int)(((wq >> 8) & 0xffu) * 0x01010101u);
        f32x16 acc;
#pragma unroll
        for (int r = 0; r < 16; ++r) acc[r] = 0.f;
#pragma unroll
        for (int J = 0; J < 64; ++J) {
            const int ra = __builtin_amdgcn_readlane((J >> 5) ? rep1 : rep0, (2 * J) & 63), rb = __builtin_amdgcn_readlane((J >> 5) ? rep1 : rep0, ((2 * J) & 63) + 1);
            v8i A, B;
            A[0] = (int)ring[J & 15].x; A[1] = (int)ring[J & 15].y; A[2] = (int)ring[J & 15].z; A[3] = (int)ring[J & 15].w; A[4] = 0; A[5] = 0; A[6] = 0; A[7] = 0;
#pragma unroll
            for (int d = 0; d < 4; ++d) { B[d] = ra & (int)mask[d]; B[4 + d] = rb & (int)mask[d]; }
            acc = __builtin_amdgcn_mfma_scale_f32_32x32x64_f8f6f4(A, B, acc, 4, 0, 0, 0x7f7f7f7f, 0, 0x7f7f7f7f);
            if (J + 16 < 64) { VLOADA(J & 15, ((J + 16) >> 5) ? e1 : e0, (2 * (J + 16)) & 63) }
            else { VLOADA(J & 15, ne0, 2 * (J + 16 - 64)) }
            if ((J & 3) == 3) __builtin_amdgcn_sched_barrier(0);
        }
        float z[16]; float sm = 0.f;
#pragma unroll
        for (int r = 0; r < 16; ++r) { const float av = acc[r]; z[r] = ALPHA * bf2f(xs[r]) + av * invS; sm += z[r]; }
        const float mean = wave_sum(sm) * (1.f / D); float s2 = 0.f;
#pragma unroll
        for (int r = 0; r < 16; ++r) { z[r] -= mean; s2 += z[r] * z[r]; }
        const float rstd = 1.f / sqrtf(wave_sum(s2) * (1.f / D) + LN_EPS);
#pragma unroll
        for (int r = 0; r < 16; ++r) { const int col = 32 * ((r & 3) + 8 * (r >> 2) + 4 * hh) + n; const float o = z[r] * rstd * gl[r] + bl[r];
            if (FINAL) Of[(size_t)t * D + col] = o; else Ob[(size_t)t * D + col] = (bf16)f2bf(o); }
        if (!has_next) break;
        t = tn; e0 = ne0; e1 = ne1; c0 = nc0; c1 = nc1;
    }
#undef VLOADA
    }
}
__device__ __forceinline__ void phase_hgrn_prep(unsigned char* ws, float* scratch  ) {
    const int tid = threadIdx.x, lane = tid & 63, wave = tid >> 6;
    const int gw = blockIdx.x * NWAVES + wave, NGW = gridDim.x * NWAVES;
    bf16* CQ = (bf16*)(ws + WS_CQ); bf16* CK = (bf16*)(ws + WS_CK); const bf16* CV = (const bf16*)(ws + WS_CV);
    bf16* KOT = (bf16*)scratch; bf16* VT = (bf16*)scratch + (size_t)T * D; float* DEC = (float*)(ws + WS_DEC);
    for (int item = gw; item < 1024 * 8; item += NGW) {
        const int g = item >> 3, h = item & 7; const size_t t0 = (size_t)g * 32;
        float k0[32], k1[32], b0[32], b1[32]; float c0 = 0.f, c1 = 0.f;
#pragma unroll
        for (int s2 = 0; s2 < 32; ++s2) { const size_t o = (t0 + s2) * D + h * 128 + 2 * lane;
            const unsigned kw = *(const GAS unsigned*)(CK + o), qw = *(const GAS unsigned*)(CQ + o);
            const float ka = bflo(kw), kb = bfhi(kw);
            c0 += __logf(1.f - ka); c1 += __logf(1.f - kb);
            k0[s2] = ka; k1[s2] = kb; b0[s2] = c0; b1[s2] = c1;
            *(GAS unsigned*)(CQ + o) = pk2(bflo(qw) * __expf(c0), bfhi(qw) * __expf(c1));
            *(GAS unsigned*)(CK + o) = pk2(ka * __expf(-c0), kb * __expf(-c1)); }
        { GAS v4u* r0 = (GAS v4u*)(KOT + ((size_t)g * 1024 + h * 128 + 2 * lane) * 32);
#pragma unroll
          for (int j = 0; j < 4; ++j) { v4u w;
              w.x = pk2(k0[8 * j + 0] * __expf(c0 - b0[8 * j + 0]), k0[8 * j + 1] * __expf(c0 - b0[8 * j + 1])); w.y = pk2(k0[8 * j + 2] * __expf(c0 - b0[8 * j + 2]), k0[8 * j + 3] * __expf(c0 - b0[8 * j + 3]));
              w.z = pk2(k0[8 * j + 4] * __expf(c0 - b0[8 * j + 4]), k0[8 * j + 5] * __expf(c0 - b0[8 * j + 5])); w.w = pk2(k0[8 * j + 6] * __expf(c0 - b0[8 * j + 6]), k0[8 * j + 7] * __expf(c0 - b0[8 * j + 7]));
              r0[j] = w; }
#pragma unroll
          for (int j = 0; j < 4; ++j) { v4u w;
              w.x = pk2(k1[8 * j + 0] * __expf(c1 - b1[8 * j + 0]), k1[8 * j + 1] * __expf(c1 - b1[8 * j + 1])); w.y = pk2(k1[8 * j + 2] * __expf(c1 - b1[8 * j + 2]), k1[8 * j + 3] * __expf(c1 - b1[8 * j + 3]));
              w.z = pk2(k1[8 * j + 4] * __expf(c1 - b1[8 * j + 4]), k1[8 * j + 5] * __expf(c1 - b1[8 * j + 5])); w.w = pk2(k1[8 * j + 6] * __expf(c1 - b1[8 * j + 6]), k1[8 * j + 7] * __expf(c1 - b1[8 * j + 7]));
              r0[4 + j] = w; } }
        *(GAS v2u*)(DEC + (size_t)g * 1024 + h * 128 + 2 * lane) = (v2u){__float_as_uint(__expf(c0)), __float_as_uint(__expf(c1))};
        { unsigned va[16], vb[16];
#pragma unroll
          for (int j = 0; j < 16; ++j) { const unsigned w0 = *(const GAS unsigned*)(CV + (t0 + 2 * j) * D + h * 128 + 2 * lane), w1 = *(const GAS unsigned*)(CV + (t0 + 2 * j + 1) * D + h * 128 + 2 * lane);
              va[j] = (w0 & 0xffffu) | (w1 << 16); vb[j] = (w0 >> 16) | (w1 & 0xffff0000u); }
          GAS v4u* r0 = (GAS v4u*)(VT + ((size_t)g * 1024 + h * 128 + 2 * lane) * 32);
#pragma unroll
          for (int j = 0; j < 4; ++j) { r0[j] = (v4u){va[4 * j], va[4 * j + 1], va[4 * j + 2], va[4 * j + 3]}; r0[4 + j] = (v4u){vb[4 * j], vb[4 * j + 1], vb[4 * j + 2], vb[4 * j + 3]}; } }
    }
}
__device__ __forceinline__ void phase_hgrn_scan(LAS unsigned char* lds, unsigned char* ws, const float* scratch) {
    const int tid = threadIdx.x, lane = tid & 63, wave = __builtin_amdgcn_readfirstlane(tid >> 6);
    const int c = lane & 31, hh = lane >> 5;
    const bf16* QI = (const bf16*)(ws + WS_CQ); const bf16* KI = (const bf16*)(ws + WS_CK);
    const bf16* KOT = (const bf16*)scratch; const bf16* VT = (const bf16*)scratch + (size_t)T * D; const float* DEC = (const float*)(ws + WS_DEC);
    bf16* O = (bf16*)(ws + WS_O);
    constexpr int BUF = 30720, O_KI = 0, O_QI = 8704, O_KOT = 17408, O_VT = 27648, O_DEC = 30208, O_ST = 61440, O_P = 70144;
    for (int item = blockIdx.x; item < 256; item += gridDim.x) {
        const int es = item & 3, h = (item >> 2) & 7, b = item >> 5;
        __syncthreads();
        for (int i = tid; i < 8704 / 16; i += NTHR) *(LAS v4u*)(lds + O_ST + i * 16) = (v4u){0u, 0u, 0u, 0u};
        f32x16 S[4];
#pragma unroll
        for (int blk = 0; blk < 4; ++blk)
#pragma unroll
            for (int r = 0; r < 16; ++r) S[blk][r] = 0.f;
        v4u rk, rq, ro, rx;
        auto load_chunk = [&](int n) {
            const size_t gch = (size_t)b * 128 + n, t0 = gch * 32;
            rk = *(const GAS v4u*)(KI + (t0 + (tid >> 4)) * D + h * 128 + 8 * (tid & 15));
            rq = *(const GAS v4u*)(QI + (t0 + (tid >> 4)) * D + h * 128 + 8 * (tid & 15));
            ro = *(const GAS v4u*)(KOT + (gch * 1024 + h * 128 + (tid >> 2)) * 32 + 8 * (tid & 3));
            if (tid < 128) rx = *(const GAS v4u*)(VT + (gch * 1024 + h * 128 + es * 32 + (tid >> 2)) * 32 + 8 * (tid & 3));
            else if (tid < 160) rx = *(const GAS v4u*)(DEC + gch * 1024 + h * 128 + 4 * (tid - 128));
        };
        auto store_chunk = [&](int bufi) {
            LAS unsigned char* bp = lds + bufi * BUF;
            *(LAS v4u*)(bp + O_KI + (tid >> 4) * 272 + (tid & 15) * 16) = rk;
            *(LAS v4u*)(bp + O_QI + (tid >> 4) * 272 + (tid & 15) * 16) = rq;
            *(LAS v4u*)(bp + O_KOT + (tid >> 2) * 80 + (tid & 3) * 16) = ro;
            if (tid < 128) *(LAS v4u*)(bp + O_VT + (tid >> 2) * 80 + (tid & 3) * 16) = rx;
            else if (tid < 160) *(LAS v4u*)(bp + O_DEC + (tid - 128) * 16) = rx;
        };
        load_chunk(0); store_chunk(0); load_chunk(1);
        __syncthreads();
        for (int n = 0; n < 128; ++n) {
            if (n + 1 < 128) store_chunk((n + 1) & 1);
            if (n + 2 < 128) load_chunk(n + 2);
            if (wave == 0) {
                LAS unsigned char* bp = lds + (n & 1) * BUF;
                const size_t t0 = ((size_t)b * 128 + n) * 32;
                bf16x8 qf[8];
                f32x16 sc;
#pragma unroll
                for (int r = 0; r < 16; ++r) sc[r] = 0.f;
#pragma unroll
                for (int ks = 0; ks < 8; ++ks) { const bf16x8 kf = *(const LAS bf16x8*)(bp + O_KI + c * 272 + (16 * ks + 8 * hh) * 2);
                    qf[ks] = *(const LAS bf16x8*)(bp + O_QI + c * 272 + (16 * ks + 8 * hh) * 2);
                    sc = __builtin_amdgcn_mfma_f32_32x32x16_bf16(kf, qf[ks], sc, 0, 0, 0); }
#pragma unroll
                for (int g4 = 0; g4 < 4; ++g4) { float m[4];
#pragma unroll
                    for (int q = 0; q < 4; ++q) { const float sv = sc[4 * g4 + q]; m[q] = (8 * g4 + 4 * hh + q <= c) ? sv : 0.f; }
                    *(LAS v2u*)(lds + O_P + c * 80 + (8 * g4 + 4 * hh) * 2) = (v2u){pk2(m[0], m[1]), pk2(m[2], m[3])}; }
                bf16x8 vf[2];
                f32x16 o;
#pragma unroll
                for (int r = 0; r < 16; ++r) o[r] = 0.f;
#pragma unroll
                for (int ks = 0; ks < 2; ++ks) { const bf16x8 pf = *(const LAS bf16x8*)(lds + O_P + c * 80 + (16 * ks + 8 * hh) * 2);
                    vf[ks] = *(const LAS bf16x8*)(bp + O_VT + c * 80 + (16 * ks + 8 * hh) * 2);
                    o = __builtin_amdgcn_mfma_f32_32x32x16_bf16(pf, vf[ks], o, 0, 0, 0); }
#pragma unroll
                for (int ks = 0; ks < 8; ++ks) { const bf16x8 sf = *(const LAS bf16x8*)(lds + O_ST + c * 272 + (16 * ks + 8 * hh) * 2);
                    o = __builtin_amdgcn_mfma_f32_32x32x16_bf16(qf[ks], sf, o, 0, 0, 0); }
#pragma unroll
                for (int r = 0; r < 16; ++r) { const float ov = o[r]; O[(t0 + (r & 3) + 8 * (r >> 2) + 4 * hh) * D + h * 128 + es * 32 + c] = (bf16)f2bf(ov); }
#pragma unroll
                for (int blk = 0; blk < 4; ++blk) {
#pragma unroll
                    for (int g4 = 0; g4 < 4; ++g4) { const f32x4 dv = *(const LAS f32x4*)(bp + O_DEC + (32 * blk + 8 * g4 + 4 * hh) * 4);
                        S[blk][4 * g4 + 0] *= dv.x; S[blk][4 * g4 + 1] *= dv.y; S[blk][4 * g4 + 2] *= dv.z; S[blk][4 * g4 + 3] *= dv.w; }
#pragma unroll
                    for (int ks = 0; ks < 2; ++ks) { const bf16x8 af = *(const LAS bf16x8*)(bp + O_KOT + (32 * blk + c) * 80 + (16 * ks + 8 * hh) * 2);
                        S[blk] = __builtin_amdgcn_mfma_f32_32x32x16_bf16(af, vf[ks], S[blk], 0, 0, 0); }
#pragma unroll
                    for (int g4 = 0; g4 < 4; ++g4) { const float s0 = S[blk][4 * g4 + 0], s1 = S[blk][4 * g4 + 1], s2 = S[blk][4 * g4 + 2], s3 = S[blk][4 * g4 + 3];
                        *(LAS v2u*)(lds + O_ST + c * 272 + (32 * blk + 8 * g4 + 4 * hh) * 2) = (v2u){pk2(s0, s1), pk2(s2, s3)}; }
                }
            }
            __syncthreads();
        }
    }
}
__device__ __forceinline__ void phase_hgrn_norm(const float* norm_g, unsigned char* ws) {
    const int tid = threadIdx.x, lane = tid & 63, wave = tid >> 6;
    const int gw = blockIdx.x * NWAVES + wave, NGW = gridDim.x * NWAVES;
    const bf16* O = (const bf16*)(ws + WS_O); const bf16* CG = (const bf16*)(ws + WS_CG); bf16* Y2 = (bf16*)(ws + WS_Y2);
    for (int t = gw; t < T; t += NGW) {
        const v4u a0 = *((const GAS v4u*)(O + (size_t)t * D) + lane * 2), a1 = *((const GAS v4u*)(O + (size_t)t * D) + lane * 2 + 1);
        const v4u g0 = *((const GAS v4u*)(CG + (size_t)t * D) + lane * 2), g1 = *((const GAS v4u*)(CG + (size_t)t * D) + lane * 2 + 1);
        float o[16], gv[16];
        o[0] = bflo(a0.x); o[1] = bfhi(a0.x); o[2] = bflo(a0.y); o[3] = bfhi(a0.y); o[4] = bflo(a0.z); o[5] = bfhi(a0.z); o[6] = bflo(a0.w); o[7] = bfhi(a0.w);
        o[8] = bflo(a1.x); o[9] = bfhi(a1.x); o[10] = bflo(a1.y); o[11] = bfhi(a1.y); o[12] = bflo(a1.z); o[13] = bfhi(a1.z); o[14] = bflo(a1.w); o[15] = bfhi(a1.w);
        gv[0] = bflo(g0.x); gv[1] = bfhi(g0.x); gv[2] = bflo(g0.y); gv[3] = bfhi(g0.y); gv[4] = bflo(g0.z); gv[5] = bfhi(g0.z); gv[6] = bflo(g0.w); gv[7] = bfhi(g0.w);
        gv[8] = bflo(g1.x); gv[9] = bfhi(g1.x); gv[10] = bflo(g1.y); gv[11] = bfhi(g1.y); gv[12] = bflo(g1.z); gv[13] = bfhi(g1.z); gv[14] = bflo(g1.w); gv[15] = bfhi(g1.w);
        float sq = 0.f;
#pragma unroll
        for (int j = 0; j < 16; ++j) sq += o[j] * o[j];
        sq += __shfl_xor(sq, 1); sq += __shfl_xor(sq, 2); sq += __shfl_xor(sq, 4);
        const float r = 1.f / sqrtf(sq * (1.f / 128.f) + LN_EPS);
        float y[16];
#pragma unroll
        for (int j = 0; j < 16; ++j) { const float sg = gv[j] / (1.f + expf(-gv[j])); y[j] = o[j] * r * norm_g[lane * 16 + j] * sg; }
        v4u w0, w1; w0.x = pk2(y[0], y[1]); w0.y = pk2(y[2], y[3]); w0.z = pk2(y[4], y[5]); w0.w = pk2(y[6], y[7]);
        w1.x = pk2(y[8], y[9]); w1.y = pk2(y[10], y[11]); w1.z = pk2(y[12], y[13]); w1.w = pk2(y[14], y[15]);
        *((GAS v4u*)(Y2 + (size_t)t * D) + lane * 2) = w0; *((GAS v4u*)(Y2 + (size_t)t * D) + lane * 2 + 1) = w1;
    }
}

struct Args { const float* in[16]; float* out; unsigned char* ws; int ph_lo, ph_hi, li, pad; };
__global__ void __launch_bounds__(NTHR, 2) mk_fwd(Args args) {
    extern __shared__ __attribute__((aligned(16))) unsigned char lds_raw[];
    LAS unsigned char* lds = (LAS unsigned char*)lds_raw;
    volatile LAS unsigned* MISC = (volatile LAS unsigned*)(lds + MISC_OFF);
    const int tid = threadIdx.x;
    unsigned char* ws = args.ws;
    gu32* ctl = (gu32*)(ws + WS_CTL);
    if (tid < 32) ((LAS unsigned*)(lds + MISC_OFF))[tid] = 0u;
    __syncthreads();
    XcdBarrier bar; bar.bar = (unsigned*)ctl + CW_BAR; bar.x = 0; bar.st = nullptr;
    if (N_LAUNCHES == 1) bar = xcd_barrier_post((unsigned*)ctl + CW_BAR, MISC + 8);
    const int lo = args.ph_lo, hi = args.ph_hi;
#define IN(k) (lo <= (k) && (k) < hi)
#define SEAM(k) do { if (IN(k) && IN((k) + 1)) xcd_barrier(bar); } while (0)
    const float* const* in = args.in;
    bf16* XB = (bf16*)(ws + WS_XB); bf16* H0 = (bf16*)(ws + WS_H0); bf16* Y = (bf16*)(ws + WS_Y); bf16* H1 = (bf16*)(ws + WS_H1);
    int* EID = (int*)(ws + WS_EID); float* GATE = (float*)(ws + WS_GATE);
    float* Z = args.out;

    int ph_ = 0;
#define PH_BEGIN if (lo <= ph_ && ph_ < hi) for (int rep_ = 0; rep_ < 1 + (int)((DUP_MASK >> ph_) & 1u); ++rep_) {
#define PH_END } if (lo <= ph_ && ph_ + 1 < hi) xcd_barrier(bar); ++ph_;
      PH_BEGIN phase_prologue(lds, in, ws); phase_convert_tables(in[12], in[13], ws); PH_END
      PH_BEGIN pg8::Gemm g{XB, (const bf16*)(ws + WS_WABIN), T, AB_IN, D}; pg8::StaticOrder S; S.init(T, AB_IN, (int)gridDim.x, (int)blockIdx.x); pg8::EpiBf16<0> E{H0, AB_IN, nullptr, 0, 0, 1.f};
                     pg8::gemm_phase<pg8::EpiBf16<0>, pg8::StaticOrder, true, true>(lds, g, S, E); PH_END
      PH_BEGIN phase_ret_local(lds, ws); PH_END
      PH_BEGIN phase_ret_prefix(ws); PH_END
      PH_BEGIN phase_ret_out_pool_fast(lds, in, ws); PH_END
      PH_BEGIN pg8::Gemm g{Y, (const bf16*)(ws + WS_WABOUT), T, D, D}; pg8::StaticOrder S; S.init(T, D, (int)gridDim.x, (int)blockIdx.x); pg8::EpiResidF32 E{XB, Z};
                     pg8::gemm_phase<pg8::EpiResidF32, pg8::StaticOrder, true, true>(lds, g, S, E); PH_END
      PH_BEGIN phase_ln(Z, H1, in[14], in[15]); PH_END
      PH_BEGIN pg8::Gemm g{H1, (const bf16*)(ws + WS_WQ), T, 2048, D}; pg8::StaticOrder S; S.init(T, 2048, (int)gridDim.x, (int)blockIdx.x); pg8::EpiBf16<0> E{H0  , 2048, nullptr, 0, 0, 1.f};
                     pg8::gemm_phase<pg8::EpiBf16<0>, pg8::StaticOrder, true, true>(lds, g, S, E); PH_END
      PH_BEGIN phase_topk_fast(lds, H0, (const bf16*)(ws + WS_KEYS), EID, GATE); PH_END
      PH_BEGIN phase_gather_u(H1, EID, GATE, ws + WS_U8, (const float*)(ws + WS_DQU), (const float*)(ws + WS_DQV)); PH_END
      PH_BEGIN phase_gather_v_mfma<false>(H1, EID, GATE, ws + WS_V8, in[14] + D, in[15] + D, XB  , nullptr); PH_END
#ifdef PROBE_L2
    PH_BEGIN phase_gather_v<false, PROBE_L2>(H1, EID, GATE, ws + WS_V8, in[14] + D, in[15] + D, Y  , nullptr); PH_END
#endif
      PH_BEGIN pg8::Gemm g{XB, (const bf16*)(ws + WS_WCIN), T, C_IN, D}; pg8::StaticOrder S; S.init(T, C_IN, (int)gridDim.x, (int)blockIdx.x);
                      pg8::EpiCInF E2{(bf16*)(ws + WS_CQ), (bf16*)(ws + WS_CK), (bf16*)(ws + WS_CV), (bf16*)(ws + WS_CG), (const float*)(ws + WS_LB)};
                      pg8::gemm_phase<pg8::EpiCInF, pg8::StaticOrder, true, true>(lds, g, S, E2); PH_END
      PH_BEGIN phase_hgrn_prep(ws, args.out); PH_END
      PH_BEGIN phase_hgrn_scan(lds, ws, args.out); PH_END
      PH_BEGIN phase_hgrn_norm(in[8], ws); PH_END
      PH_BEGIN pg8::Gemm g{(const bf16*)(ws + WS_Y2), (const bf16*)(ws + WS_WCOUT), T, D, D}; pg8::StaticOrder S; S.init(T, D, (int)gridDim.x, (int)blockIdx.x); pg8::EpiResidF32 E{XB, Z};
                      pg8::gemm_phase<pg8::EpiResidF32, pg8::StaticOrder, true, true>(lds, g, S, E); PH_END
      PH_BEGIN phase_ln(Z, H1  , in[14] + 2 * D, in[15] + 2 * D); PH_END
      PH_BEGIN pg8::Gemm g{H1, (const bf16*)(ws + WS_WQ) + (size_t)2048 * D, T, 2048, D}; pg8::StaticOrder S; S.init(T, 2048, (int)gridDim.x, (int)blockIdx.x); pg8::EpiBf16<0> E{(bf16*)(ws + WS_Q1), 2048, nullptr, 0, 0, 1.f};
                      pg8::gemm_phase<pg8::EpiBf16<0>, pg8::StaticOrder, true, true>(lds, g, S, E); PH_END
      PH_BEGIN phase_topk_fast(lds, (const bf16*)(ws + WS_Q1), (const bf16*)(ws + WS_KEYS) + (size_t)8 * 2 * 128 * 128, EID, GATE); PH_END
      PH_BEGIN phase_gather_u(H1, EID, GATE, ws + WS_U8 + (size_t)NEXP * 512, (const float*)(ws + WS_DQU) + NEXP, (const float*)(ws + WS_DQV) + NEXP); PH_END
      PH_BEGIN phase_gather_v_mfma<true>(H1, EID, GATE, ws + WS_V8 + (size_t)NEXP * 512, in[14] + 3 * D, in[15] + 3 * D, nullptr, args.out); PH_END
#undef PH_BEGIN
#undef PH_END
#undef IN
#undef SEAM
}

extern "C" void kernel_launch(void* const* d_in, const int* in_sizes, int n_in, void* d_out, int out_size, void* d_ws, size_t ws_size, hipStream_t stream) {
    static int grid = 0;
    if (grid == 0) {
        if (n_in != 16 || in_sizes[0] != T * D || out_size != T * D || ws_size < WS_END) { fprintf(stderr, "kernel_launch: unexpected problem (n_in %d, in0 %d, out %d, ws %zu); nothing launched\n", n_in, n_in > 0 ? in_sizes[0] : -1, out_size, ws_size); grid = -1; return; }
        int dev = 0, cus = 0;
        if (hipGetDevice(&dev) != hipSuccess || hipDeviceGetAttribute(&cus, hipDeviceAttributeMultiprocessorCount, dev) != hipSuccess) { grid = -1; return; }
        if (hipFuncSetAttribute((const void*)mk_fwd, hipFuncAttributeMaxDynamicSharedMemorySize, LDS_BYTES) != hipSuccess) { fprintf(stderr, "kernel_launch: hipFuncSetAttribute failed\n"); grid = -1; return; }
        (void)hipGetLastError();
        grid = cus;
    }
    if (grid < 0) return;
    if (hipMemsetAsync((char*)d_ws + WS_CTL, 0, CTL_ZERO_BYTES, stream) != hipSuccess) return;
    Args a{};
    for (int i = 0; i < 16; ++i) a.in[i] = (const float*)d_in[i];
    a.out = (float*)d_out; a.ws = (unsigned char*)d_ws;
    for (int li = 0; li < N_LAUNCHES; ++li) {
        a.ph_lo = (N_LAUNCHES == 1) ? 0 : li; a.ph_hi = (N_LAUNCHES == 1) ? NPHASE : li + 1; a.li = li;
        hipLaunchKernelGGL(mk_fwd, dim3(grid), dim3(NTHR), LDS_BYTES, stream, a);
        if (hipPeekAtLastError() != hipSuccess) { fprintf(stderr, "kernel_launch: launch %d failed\n", li); break; }
    }
}
```

```cpp
#include <hip/hip_runtime.h>
#include <cstdio>
#include <cstdint>

#ifndef MK_N_LAUNCHES
#define MK_N_LAUNCHES 1
#endif
#ifdef PROBE_L2
constexpr int NPHASE = 22;
#else
constexpr int NPHASE = 21;
#endif
#ifndef DUP_MASK
#define DUP_MASK 0u
#endif
constexpr int N_LAUNCHES = MK_N_LAUNCHES;

constexpr int BATCH = 8, SEQ = 4096, D = 1024, T = BATCH * SEQ;
constexpr int AB_IN = 2048, C_IN = 4096, NEXP = 16384;
constexpr float LN_EPS = 1e-5f;
constexpr float ALPHA = 1.41421356237309515f;
constexpr int NWAVES = 8, NTHR = 512;

constexpr size_t MiB = 1u << 20;
constexpr size_t WS_CTL = 0, CTL_ZERO_BYTES = 1 * MiB;
constexpr size_t WS_LB = 1 * MiB;
constexpr size_t WS_ROPE = 2 * MiB;
constexpr size_t WS_WABIN = 4 * MiB;
constexpr size_t WS_WABOUT = 8 * MiB;
constexpr size_t WS_WCIN = 10 * MiB;
constexpr size_t WS_WCOUT = 18 * MiB;
constexpr size_t WS_WQ = 20 * MiB;
constexpr size_t WS_KEYS = 28 * MiB;
constexpr size_t WS_DQU = 29 * MiB;
constexpr size_t WS_DQV = 29 * MiB + 131072;
constexpr size_t WS_U8 = 32 * MiB;
constexpr size_t WS_V8 = 64 * MiB;
constexpr size_t WS_POOLWT = 30 * MiB;
constexpr size_t WS_XB = 96 * MiB;
constexpr size_t WS_H0 = 160 * MiB;
constexpr size_t WS_LST = 288 * MiB;
constexpr size_t WS_Y = 320 * MiB;
constexpr size_t WS_H1 = 384 * MiB;
constexpr size_t WS_EID = 448 * MiB;
constexpr size_t WS_GATE = 464 * MiB;
constexpr size_t WS_CQ = 160 * MiB, WS_CK = 224 * MiB, WS_CV = 288 * MiB, WS_CG = 352 * MiB;
constexpr size_t WS_O = 416 * MiB;
constexpr size_t WS_Y2 = 160 * MiB;
constexpr size_t WS_Q1 = 224 * MiB;
constexpr size_t WS_DEC = 480 * MiB;
constexpr size_t WS_END = 484 * MiB;

constexpr int CW_BAR = 4096;
constexpr int LDS_BYTES = 147456;
constexpr int MISC_OFF = LDS_BYTES - 128;

#define GAS __attribute__((address_space(1)))
#define LAS __attribute__((address_space(3)))
typedef unsigned short bf16;
typedef unsigned v4u __attribute__((ext_vector_type(4)));
typedef unsigned v2u __attribute__((ext_vector_type(2)));
typedef float f32x4 __attribute__((ext_vector_type(4)));
typedef GAS unsigned gu32;
typedef short bf16x8 __attribute__((ext_vector_type(8)));
typedef int v8i __attribute__((ext_vector_type(8)));
typedef float f32x16 __attribute__((ext_vector_type(16)));
#define RLX_AGENT __ATOMIC_RELAXED, __HIP_MEMORY_SCOPE_AGENT
#define LDS_WAIT() asm volatile("s_waitcnt lgkmcnt(0)" ::: "memory")
typedef __bf16 hwbf16x2 __attribute__((ext_vector_type(2)));
typedef float hwf32x2 __attribute__((ext_vector_type(2)));
__device__ __forceinline__ unsigned pk2(float lo, float hi) { const hwf32x2 v = {lo, hi}; const hwbf16x2 b = __builtin_convertvector(v, hwbf16x2); return __builtin_bit_cast(unsigned, b); }
__device__ __forceinline__ unsigned f2bf(float f) { return pk2(f, 0.f) & 0xffffu; }
__device__ __forceinline__ float bf2f(unsigned b) { return __builtin_bit_cast(float, b << 16); }
__device__ __forceinline__ float bflo(unsigned w) { return __builtin_bit_cast(float, w << 16); }
__device__ __forceinline__ float bfhi(unsigned w) { return __builtin_bit_cast(float, w & 0xffff0000u); }
__device__ __forceinline__ float wave_sum(float v) {
#pragma unroll
    for (int o = 1; o < 64; o <<= 1) v += __shfl_xor(v, o);
    return v;
}

#define XB_TMO      128
#define XB_XCNT(j)  (256  + 64 * (j))
#define XB_XSUB(j)  (1280 + 64 * (j))
#define XB_XGEN(j)  (2304 + 64 * (j))
#define XB_TOP      3328
#define XB_TOPGEN   3392
#define XCD_BAR_WORDS 3456
#define XB_SPIN_CAP (1u << 21)
__device__ __forceinline__ unsigned xb_ld(unsigned* p)              { return __hip_atomic_load(p, __ATOMIC_RELAXED, __HIP_MEMORY_SCOPE_AGENT); }
__device__ __forceinline__ unsigned xb_add(unsigned* p, unsigned v) { return __hip_atomic_fetch_add(p, v, __ATOMIC_RELAXED, __HIP_MEMORY_SCOPE_AGENT); }
__device__ __forceinline__ unsigned xb_xcc_id() { return (unsigned)__builtin_amdgcn_s_getreg((3 << 11) | 20) & 0xFu; }
#define XB_SPIN(cond, bar) do { unsigned _sp = 0; while (cond) { __builtin_amdgcn_s_sleep(1); \
    if ((++_sp & 255u) == 0u) { if (xb_ld(&(bar)[XB_TMO])) break; if (_sp > XB_SPIN_CAP) { atomicAdd(&(bar)[XB_TMO], 1u); break; } } } } while (0)
struct XcdBarrier { unsigned* bar; unsigned x; volatile LAS unsigned* st; };
__device__ __forceinline__ XcdBarrier xcd_barrier_post(unsigned* bar, volatile LAS unsigned* st) {
    XcdBarrier b; b.bar = bar; b.x = xb_xcc_id(); b.st = st;
    if (threadIdx.x == 0) (void)xb_add(&bar[XB_XCNT(b.x)], 1u);
    return b;
}
__device__ __forceinline__ void xcd_barrier_complete(unsigned* bar, unsigned x, unsigned& nloc, unsigned& nx) {
    const unsigned G = gridDim.x * gridDim.y * gridDim.z;
    unsigned sum, cnt, mine, sp = 0u;
    for (;;) {
        sum = 0u; cnt = 0u; mine = 0u;
#pragma unroll
        for (unsigned j = 0; j < 16; ++j) { const unsigned c = xb_ld(&bar[XB_XCNT(j)]); sum += c; cnt += (c > 0u) ? 1u : 0u; mine = (j == x) ? c : mine; }
        if (sum == G) break;
        __builtin_amdgcn_s_sleep(1);
        if ((++sp & 255u) == 0u) { if (xb_ld(&bar[XB_TMO])) break; if (sp > XB_SPIN_CAP) { atomicAdd(&bar[XB_TMO], 1u); break; } }
    }
    nloc = mine > 0u ? mine : 1u; nx = cnt > 0u ? cnt : 1u;
}
__device__ __forceinline__ void xcd_barrier(const XcdBarrier& b) {
    asm volatile("s_waitcnt vmcnt(0)" ::: "memory");
    __syncthreads();
    if (threadIdx.x == 0) {
        unsigned* bar = b.bar;
        __builtin_amdgcn_s_waitcnt(0);
        unsigned nloc = b.st[0], nx = b.st[1];
        if (nloc == 0u) { xcd_barrier_complete(bar, b.x, nloc, nx); b.st[0] = nloc; b.st[1] = nx; }
        const unsigned old = xb_add(&bar[XB_XSUB(b.x)], 1u);
        const unsigned gen = old / nloc;
        if (old + 1u == (gen + 1u) * nloc) {
            __builtin_amdgcn_fence(__ATOMIC_RELEASE, "agent");
            asm volatile("s_waitcnt vmcnt(0)" ::: "memory");
            const unsigned og = xb_add(&bar[XB_TOP], 1u);
            const unsigned tg = og / nx;
            if (og + 1u == (tg + 1u) * nx) xb_add(&bar[XB_TOPGEN], 1u);
            else XB_SPIN(xb_ld(&bar[XB_TOPGEN]) == tg, bar);
            __builtin_amdgcn_fence(__ATOMIC_ACQUIRE, "agent");
            xb_add(&bar[XB_XGEN(b.x)], 1u);
            asm volatile("s_waitcnt vmcnt(0)" ::: "memory");
        } else {
            XB_SPIN(xb_ld(&bar[XB_XGEN(b.x)]) == gen, bar);
            __builtin_amdgcn_fence(__ATOMIC_ACQUIRE, "agent");
            asm volatile("s_waitcnt vmcnt(0)" ::: "memory");
        }
    }
    __syncthreads();
}

__device__ __forceinline__ void p0_transpose_item(const float* W, int K, int N, bf16* WT, LAS float* scr, int item, int lane) {
    const int nblk = N / 32, kb = item / nblk, nb = item % nblk, k0 = 64 * kb, n0 = 32 * nb;
#pragma unroll 8
    for (int i = 0; i < 32; ++i) { const int kk = 2 * i + (lane >> 5); scr[kk * 33 + (lane & 31)] = W[(size_t)(k0 + kk) * N + n0 + (lane & 31)]; }
    LDS_WAIT(); asm volatile("" ::: "memory");
    const int c = lane & 7;
#pragma unroll
    for (int j = 0; j < 4; ++j) { const int n = (lane >> 3) + 8 * j; const LAS float* s = scr + (8 * c) * 33 + n;
        v4u o; o.x = pk2(s[0 * 33], s[1 * 33]); o.y = pk2(s[2 * 33], s[3 * 33]); o.z = pk2(s[4 * 33], s[5 * 33]); o.w = pk2(s[6 * 33], s[7 * 33]);
        *(GAS v4u*)(WT + (size_t)(n0 + n) * K + k0 + 8 * c) = o; }
    LDS_WAIT(); asm volatile("" ::: "memory");
}

template <class Epi>
__device__ __forceinline__ void gemm_naive(LAS unsigned char* lds, const bf16* A, const bf16* Bt, int M, int N, int K, const Epi& E) {
    LAS float* As = (LAS float*)lds;
    LAS float* Bs = As + 128 * 33;
    const int tid = threadIdx.x, tx = tid & 15, ty = tid >> 4;
    const int ntn = N / 128, ntiles = (M / 128) * ntn;
    for (int tile = blockIdx.x; tile < ntiles; tile += gridDim.x) {
        const int tm = tile / ntn, tn = tile % ntn;
        float acc[4][8];
#pragma unroll
        for (int i = 0; i < 4; ++i)
#pragma unroll
            for (int j = 0; j < 8; ++j) acc[i][j] = 0.f;
        for (int k0 = 0; k0 < K; k0 += 32) {
            { const int r = tid >> 2, kc = (tid & 3) * 8;
              const v4u va = *(const GAS v4u*)(A + (size_t)(tm * 128 + r) * K + k0 + kc);
              const v4u vb = *(const GAS v4u*)(Bt + (size_t)(tn * 128 + r) * K + k0 + kc);
              LAS float* pa = As + r * 33 + kc; LAS float* pb = Bs + r * 33 + kc;
              pa[0] = bflo(va.x); pa[1] = bfhi(va.x); pa[2] = bflo(va.y); pa[3] = bfhi(va.y); pa[4] = bflo(va.z); pa[5] = bfhi(va.z); pa[6] = bflo(va.w); pa[7] = bfhi(va.w);
              pb[0] = bflo(vb.x); pb[1] = bfhi(vb.x); pb[2] = bflo(vb.y); pb[3] = bfhi(vb.y); pb[4] = bflo(vb.z); pb[5] = bfhi(vb.z); pb[6] = bflo(vb.w); pb[7] = bfhi(vb.w); }
            __syncthreads();
#pragma unroll 8
            for (int kk = 0; kk < 32; ++kk) {
                float a[4], b[8];
#pragma unroll
                for (int i = 0; i < 4; ++i) a[i] = As[(ty * 4 + i) * 33 + kk];
#pragma unroll
                for (int j = 0; j < 8; ++j) b[j] = Bs[(tx + 16 * j) * 33 + kk];
#pragma unroll
                for (int i = 0; i < 4; ++i)
#pragma unroll
                    for (int j = 0; j < 8; ++j) acc[i][j] += a[i] * b[j];
            }
            __syncthreads();
        }
#pragma unroll
        for (int i = 0; i < 4; ++i)
#pragma unroll
            for (int j = 0; j < 8; ++j) E(tm * 128 + ty * 4 + i, tn * 128 + tx + 16 * j, acc[i][j]);
    }
}
struct EpiStore { bf16* O; int ldc;
    __device__ __forceinline__ void operator()(int r, int c, float v) const { O[(size_t)r * ldc + c] = (bf16)f2bf(v); } };
struct EpiResid { const bf16* X; float* Z;
    __device__ __forceinline__ void operator()(int r, int c, float v) const { Z[(size_t)r * D + c] = ALPHA * bf2f(X[(size_t)r * D + c]) + v; } };
struct EpiCIn { bf16 *CQ, *CK, *CV, *CG; const float* lb;
    __device__ __forceinline__ void operator()(int r, int c, float v) const {
        const int seg = c >> 10, cc = c & 1023; const size_t o = (size_t)r * D + cc;
        if (seg == 0) CQ[o] = (bf16)f2bf(v);
        else if (seg == 1) { const float k = (1.f - lb[cc]) / (1.f + expf(v)); CK[o] = (bf16)f2bf(k); }
        else if (seg == 2) CV[o] = (bf16)f2bf(v);
        else CG[o] = (bf16)f2bf(v);
    } };

namespace pg8 {
#define PG8_LAS __attribute__((address_space(3)))
typedef unsigned short bf16_t;
typedef short bf16x8 __attribute__((ext_vector_type(8)));
typedef float f32x4 __attribute__((ext_vector_type(4)));
typedef unsigned u32x4 __attribute__((ext_vector_type(4)));
constexpr int BM = 256, BK = 64, HALF = 128, HTB = HALF * BK * 2  , STAGE_BYTES = 8 * HTB, NXCD = 8, WGM = 8;

__host__ __device__ __forceinline__ int lds_byte(int r, int c) { const int st = (r >> 4) * 2 + (c >> 5), rr = r & 15, cc = c & 31, ob = rr * 64 + cc * 2; return st * 1024 + (ob ^ (((ob >> 9) & 1) << 5)); }
__host__ __device__ __forceinline__ void stage_rc(int b, int& R, int& C) { const int st = b / 1024, sb = b % 1024, swz = sb ^ (((sb >> 9) & 1) << 5); R = (st >> 1) * 16 + swz / 64; C = (st & 1) * 32 + (swz % 64) / 2; }
__host__ __device__ __forceinline__ int perm32(int rho) { const int n = rho >> 4, i = rho & 15; return 8 * (i >> 2) + 4 * n + (i & 3); }

struct Unit { int pm, pn; };
struct Gemm { const bf16_t* A; const bf16_t* Bt; int M, N, K; };

struct StaticOrder {
    int nM, nN, nwg, G, c;
    __host__ __device__ void init(int M, int N, int G_, int c_) { nM = M / BM; nN = N / BM; nwg = nM * nN; G = G_; c = c_; }
    __host__ __device__ bool next(int i, Unit& u) const {
        const long L = (long)i * G + c; if (L >= nwg) return false;
        int wgid = (int)L; { const int q = nwg / NXCD, r = nwg % NXCD, xcd = wgid % NXCD, off = wgid / NXCD; wgid = (xcd < r ? xcd * (q + 1) : r * (q + 1) + (xcd - r) * q) + off; }
        const int nig = WGM * nN, gid = wgid / nig, fm = gid * WGM, gsz = (nM - fm) < WGM ? (nM - fm) : WGM;
        u.pm = fm + ((wgid % nig) % gsz); u.pn = (wgid % nig) / gsz; return true;
    }
    __device__ __forceinline__ void a_ready(const Unit&) const {}
    __device__ __forceinline__ void done(const Unit&) const {}
};

__device__ __forceinline__ unsigned cvt_pk_bf16(float lo, float hi) { unsigned r; asm volatile("v_cvt_pk_bf16_f32 %0, %1, %2" : "=v"(r) : "v"(lo), "v"(hi)); return r; }
typedef float f32x2 __attribute__((ext_vector_type(2)));
__device__ __forceinline__ f32x2 gelu_pk(f32x2 v) {
    const f32x2 av = __builtin_elementwise_abs(v), d = av * 0.2316418882f + 1.0f;
    f32x2 t; t.x = __builtin_amdgcn_rcpf(d.x); t.y = __builtin_amdgcn_rcpf(d.y);
    f32x2 q = t * 0.5307027145f + (-0.7265760135f); q = q * t + 0.7107068705f; q = q * t + (-0.142248368f); q = q * t + 0.127414796f; q = q * t;
    const f32x2 s = (v * v) * (-0.72134752044f);
    f32x2 e; e.x = __builtin_amdgcn_exp2f(s.x); e.y = __builtin_amdgcn_exp2f(s.y);
    const f32x2 m = v * (q * e), r = v - m;
    f32x2 o; o.x = v.x < 0.f ? m.x : r.x; o.y = v.y < 0.f ? m.y : r.y; return o;
}

template <int ACT  > struct EpiBf16 {
    static constexpr bool PERM = true, AFTER_DRAIN = false; static_assert(ACT == 0 || ACT == 1, "EpiBf16: ACT is 0 (none) or 1 (gelu_pk)");
    bf16_t* O; int ldc; const float* bias; int split_cols; size_t split_stride; float scale0;
    __device__ __forceinline__ void operator()(const f32x4 (&acc)[2][2][4][2], const Unit& u, int wr, int wc, int fr, int fq) const {
        const int row0 = u.pm * BM + wr * 64 + fr; int colt = u.pn * BM; bf16_t* base = O;
        float sc = 1.f; if (split_cols) { const int t = colt / split_cols; base += (size_t)t * split_stride; colt -= t * split_cols; if (t == 0) sc = scale0; }
        const int col0 = colt + wc * 32 + 8 * fq, bcol0 = u.pn * BM + wc * 32 + 8 * fq;
        f32x4 bv[2][2];
#pragma unroll
        for (int bj = 0; bj < 2; ++bj)
#pragma unroll
            for (int n = 0; n < 2; ++n) bv[bj][n] = bias ? *(const f32x4*)(bias + bcol0 + bj * HALF + 4 * n) : (f32x4){0.f, 0.f, 0.f, 0.f};
#pragma unroll
        for (int ai = 0; ai < 2; ++ai)
#pragma unroll
            for (int m = 0; m < 4; ++m) { bf16_t* rowp = base + (size_t)(row0 + ai * HALF + m * 16) * ldc + col0;
#pragma unroll
                for (int bj = 0; bj < 2; ++bj) { f32x4 v0 = acc[ai][bj][m][0] + bv[bj][0], v1 = acc[ai][bj][m][1] + bv[bj][1];
                    if (ACT == 1) { f32x2 a = gelu_pk((f32x2){v0[0], v0[1]}), b = gelu_pk((f32x2){v0[2], v0[3]}), c = gelu_pk((f32x2){v1[0], v1[1]}), d = gelu_pk((f32x2){v1[2], v1[3]});
                        v0 = (f32x4){a.x, a.y, b.x, b.y}; v1 = (f32x4){c.x, c.y, d.x, d.y}; }
                    v0 = v0 * sc; v1 = v1 * sc; u32x4 w; w.x = cvt_pk_bf16(v0[0], v0[1]); w.y = cvt_pk_bf16(v0[2], v0[3]); w.z = cvt_pk_bf16(v1[0], v1[1]); w.w = cvt_pk_bf16(v1[2], v1[3]);
                    *(u32x4*)(rowp + bj * HALF) = w; } }
    }
};

struct EpiResidF32 {
    static constexpr bool PERM = false, AFTER_DRAIN = false;
    const bf16_t* X; float* Z;
    __device__ __forceinline__ void operator()(const f32x4 (&acc)[2][2][4][2], const Unit& u, int wr, int wc, int fr, int fq) const {
        typedef unsigned u32x2 __attribute__((ext_vector_type(2)));
        const int row0 = u.pm * BM + wr * 64 + fr, col0 = u.pn * BM + wc * 32 + 4 * fq;
#pragma unroll
        for (int ai = 0; ai < 2; ++ai)
#pragma unroll
            for (int m = 0; m < 4; ++m) { const size_t ro = (size_t)(row0 + ai * HALF + m * 16) * 1024;
#pragma unroll
                for (int bj = 0; bj < 2; ++bj)
#pragma unroll
                    for (int n = 0; n < 2; ++n) { const int c = col0 + bj * HALF + n * 16; const u32x2 xw = *(const u32x2*)(X + ro + c);
                        f32x4 xv; xv[0] = __builtin_bit_cast(float, xw.x << 16); xv[1] = __builtin_bit_cast(float, xw.x & 0xffff0000u); xv[2] = __builtin_bit_cast(float, xw.y << 16); xv[3] = __builtin_bit_cast(float, xw.y & 0xffff0000u);
                        *(f32x4*)(Z + ro + c) = xv * 1.41421356237309515f + acc[ai][bj][m][n]; } }
    }
};
struct EpiCInF {
    static constexpr bool PERM = true, AFTER_DRAIN = false;
    bf16_t *CQ, *CK, *CV, *CG; const float* lb;
    __device__ __forceinline__ void operator()(const f32x4 (&acc)[2][2][4][2], const Unit& u, int wr, int wc, int fr, int fq) const {
        const int seg = u.pn >> 2, colt = (u.pn & 3) * BM;
        bf16_t* base = seg == 0 ? CQ : (seg == 1 ? CK : (seg == 2 ? CV : CG));
        const int row0 = u.pm * BM + wr * 64 + fr, col0 = colt + wc * 32 + 8 * fq;
        f32x4 om[2][2];
#pragma unroll
        for (int bj = 0; bj < 2; ++bj)
#pragma unroll
            for (int n = 0; n < 2; ++n) { const f32x4 l = *(const f32x4*)(lb + col0 + bj * HALF + 4 * n); om[bj][n] = 1.0f - l; }
#pragma unroll
        for (int ai = 0; ai < 2; ++ai)
#pragma unroll
            for (int m = 0; m < 4; ++m) { bf16_t* rowp = base + (size_t)(row0 + ai * HALF + m * 16) * 1024 + col0;
#pragma unroll
                for (int bj = 0; bj < 2; ++bj) { f32x4 v0 = acc[ai][bj][m][0], v1 = acc[ai][bj][m][1];
                    if (seg == 1) {
#pragma unroll
                        for (int q = 0; q < 4; ++q) { v0[q] = om[bj][0][q] / (1.0f + __expf(v0[q])); v1[q] = om[bj][1][q] / (1.0f + __expf(v1[q])); } }
                    u32x4 w; w.x = cvt_pk_bf16(v0[0], v0[1]); w.y = cvt_pk_bf16(v0[2], v0[3]); w.z = cvt_pk_bf16(v1[0], v1[1]); w.w = cvt_pk_bf16(v1[2], v1[3]);
                    *(u32x4*)(rowp + bj * HALF) = w; } }
    }
};
template <class Epi, class Sched, bool ALIGN_EPI = false, bool SP2 = false>
__device__ __forceinline__ void gemm_phase(PG8_LAS unsigned char* lds, const Gemm g, const Sched& S, const Epi& E) {
    const int tid = threadIdx.x, wid = __builtin_amdgcn_readfirstlane(tid >> 6), lane = tid & 63, wr = wid >> 2, wc = wid & 3, fr = lane & 15, fq = lane >> 4;
    const int K = g.K, nt = K / BK;
    unsigned voffA[2], voffB[2];
#pragma unroll
    for (int i = 0; i < 2; ++i) { int R, C; stage_rc(tid * 16 + i * 8192, R, C); const int Rb = Epi::PERM ? ((R & ~31) + perm32(R & 31)) : R;
        voffA[i] = (unsigned)(R * K + C) * 2u; voffB[i] = (unsigned)(Rb * K + C) * 2u; }
    const size_t kstep = (size_t)(BK * 2);
    const size_t hstep = (size_t)HALF * K * 2;
    const size_t tstep = 2 * hstep;
    const unsigned ldsw = (unsigned)wid * 1024u;
    const int aoff = lds_byte(wr * 64 + fr, fq * 8), boff = lds_byte(wc * 32 + fr, fq * 8);
#define PG8_SA(b, h) (((b) * 2 + (h)) * HTB)
#define PG8_SB(b, h) ((4 + (b) * 2 + (h)) * HTB)
#define PG8_STAGE(bufoff, gbase, voff) do { _Pragma("unroll") for (int _i = 0; _i < 2; ++_i) \
        __builtin_amdgcn_global_load_lds((const unsigned*)((const char*)(gbase) + (voff)[_i]), (PG8_LAS unsigned*)(lds + (bufoff) + ldsw + _i * 8192), 16, 0, 0); } while (0)
#define PG8_LDA(dst, b, h) do { _Pragma("unroll") for (int m = 0; m < 4; ++m) _Pragma("unroll") for (int k = 0; k < 2; ++k) dst[m][k] = *(const PG8_LAS bf16x8*)(lds + PG8_SA(b, h) + aoff + m * 2048 + k * 1024); } while (0)
#define PG8_LDB(dst, b, h) do { _Pragma("unroll") for (int n = 0; n < 2; ++n) _Pragma("unroll") for (int k = 0; k < 2; ++k) dst[n][k] = *(const PG8_LAS bf16x8*)(lds + PG8_SB(b, h) + boff + n * 2048 + k * 1024); } while (0)
#define PG8_MMA(ai, bj, At, Bt) do { __builtin_amdgcn_s_setprio(1); _Pragma("unroll") for (int m = 0; m < 4; ++m) _Pragma("unroll") for (int n = 0; n < 2; ++n) _Pragma("unroll") for (int k = 0; k < 2; ++k) \
        acc[ai][bj][m][n] = __builtin_amdgcn_mfma_f32_16x16x32_bf16(Bt[n][k], At[m][k], acc[ai][bj][m][n], 0, 0, 0); __builtin_amdgcn_s_setprio(0); } while (0)
#define PG8_WAIT_V(n) asm volatile("s_waitcnt vmcnt(" #n ")" ::: "memory")
#define PG8_WAIT_L(n) asm volatile("s_waitcnt lgkmcnt(" #n ")" ::: "memory")
#define PG8_BAR __builtin_amdgcn_s_barrier()
#define PG8_SCHED __builtin_amdgcn_sched_barrier(0)
    Unit cur, nxt; int ui = 0;
    if (!S.next(0, cur)) return;
    f32x4 acc[2][2][4][2];
#pragma unroll
    for (int a = 0; a < 2; ++a)
#pragma unroll
        for (int b = 0; b < 2; ++b)
#pragma unroll
            for (int m = 0; m < 4; ++m)
#pragma unroll
                for (int n = 0; n < 2; ++n) acc[a][b][m][n] = (f32x4){0.f, 0.f, 0.f, 0.f};
    bf16x8 At[4][2], B0[2][2], B1[2][2];
    const char* cA = (const char*)g.A + (size_t)cur.pm * tstep; const char* cB = (const char*)g.Bt + (size_t)cur.pn * tstep;
    S.a_ready(cur);
    if constexpr (SP2) {
        PG8_STAGE(PG8_SB(0, 0), cB, voffB); PG8_STAGE(PG8_SB(0, 1), cB + hstep, voffB); PG8_STAGE(PG8_SA(0, 0), cA, voffA); PG8_STAGE(PG8_SA(0, 1), cA + hstep, voffA);
        if (wr == 1) PG8_BAR;
        PG8_WAIT_V(2); PG8_BAR;
        PG8_STAGE(PG8_SB(1, 0), cB + kstep, voffB); PG8_STAGE(PG8_SA(1, 0), cA + kstep, voffA); PG8_STAGE(PG8_SB(1, 1), cB + hstep + kstep, voffB);
        PG8_WAIT_V(6); PG8_BAR;
    } else {
        PG8_STAGE(PG8_SB(0, 0), cB, voffB); PG8_STAGE(PG8_SA(0, 0), cA, voffA); PG8_STAGE(PG8_SB(0, 1), cB + hstep, voffB); PG8_STAGE(PG8_SA(0, 1), cA + hstep, voffA);
        if (wr == 1) PG8_BAR;
        PG8_WAIT_V(4); PG8_BAR;
        PG8_STAGE(PG8_SB(1, 0), cB + kstep, voffB); PG8_STAGE(PG8_SA(1, 0), cA + kstep, voffA); PG8_STAGE(PG8_SB(1, 1), cB + hstep + kstep, voffB);
        PG8_WAIT_V(6); PG8_BAR;
    }
    for (;;) {
        const bool has_next = S.next(ui + 1, nxt);
        const char* nA = has_next ? (const char*)g.A + (size_t)nxt.pm * tstep : cA; const char* nB = has_next ? (const char*)g.Bt + (size_t)nxt.pn * tstep : cB;
        for (int t = 0; t < nt; t += 2) {
            const bool last = (t == nt - 2);
            const char* a1 = cA + (size_t)(t + 1) * kstep;
            const char* a2 = last ? nA : cA + (size_t)(t + 2) * kstep; const char* b2 = last ? nB : cB + (size_t)(t + 2) * kstep;
            const char* a3 = a2 + kstep; const char* b3 = b2 + kstep;
            if (last && has_next) S.a_ready(nxt);
            if constexpr (SP2) {
            PG8_LDB(B0, 0, 0); PG8_LDB(B1, 0, 1); PG8_SCHED; PG8_LDA(At, 0, 0); PG8_STAGE(PG8_SA(1, 1), a1 + hstep, voffA);
            PG8_WAIT_V(8); PG8_WAIT_L(0); PG8_BAR; PG8_MMA(0, 0, At, B0); PG8_MMA(0, 1, At, B1); PG8_BAR; PG8_SCHED;
            PG8_LDA(At, 0, 1); PG8_STAGE(PG8_SB(0, 0), b2, voffB); PG8_STAGE(PG8_SB(0, 1), b2 + hstep, voffB); PG8_STAGE(PG8_SA(0, 0), a2, voffA);
            PG8_WAIT_V(8); PG8_WAIT_L(0); PG8_BAR; PG8_MMA(1, 0, At, B0); PG8_MMA(1, 1, At, B1); PG8_BAR; PG8_SCHED;
            PG8_LDB(B0, 1, 0); PG8_LDB(B1, 1, 1); PG8_SCHED; PG8_LDA(At, 1, 0); PG8_STAGE(PG8_SA(0, 1), a2 + hstep, voffA);
            PG8_WAIT_V(8); PG8_WAIT_L(0); PG8_BAR; PG8_MMA(0, 0, At, B0); PG8_MMA(0, 1, At, B1); PG8_BAR; PG8_SCHED;
            PG8_LDA(At, 1, 1); PG8_STAGE(PG8_SB(1, 0), b3, voffB); PG8_STAGE(PG8_SB(1, 1), b3 + hstep, voffB); PG8_STAGE(PG8_SA(1, 0), a3, voffA);
            PG8_WAIT_V(8); PG8_WAIT_L(0); PG8_BAR; PG8_MMA(1, 0, At, B0); PG8_MMA(1, 1, At, B1); PG8_BAR; PG8_SCHED;
            } else {
            PG8_LDB(B0, 0, 0); PG8_SCHED; PG8_LDA(At, 0, 0); PG8_STAGE(PG8_SA(1, 1), a1 + hstep, voffA);
            PG8_WAIT_L(8); PG8_BAR; PG8_WAIT_L(0); PG8_MMA(0, 0, At, B0); PG8_BAR; PG8_SCHED;
            PG8_LDB(B1, 0, 1); PG8_STAGE(PG8_SB(0, 0), b2, voffB);
            PG8_BAR; PG8_WAIT_L(0); PG8_MMA(0, 1, At, B1); PG8_BAR;
            PG8_LDA(At, 0, 1); PG8_STAGE(PG8_SA(0, 0), a2, voffA);
            PG8_BAR; PG8_WAIT_L(0); PG8_MMA(1, 0, At, B0); PG8_BAR; PG8_SCHED;
            PG8_STAGE(PG8_SB(0, 1), b2 + hstep, voffB);
            PG8_WAIT_V(6); PG8_BAR; PG8_MMA(1, 1, At, B1); PG8_BAR;
            PG8_LDB(B0, 1, 0); PG8_SCHED; PG8_LDA(At, 1, 0); PG8_STAGE(PG8_SA(0, 1), a2 + hstep, voffA);
            PG8_WAIT_L(8); PG8_BAR; PG8_WAIT_L(0); PG8_MMA(0, 0, At, B0); PG8_BAR; PG8_SCHED;
            PG8_LDB(B1, 1, 1); PG8_STAGE(PG8_SB(1, 0), b3, voffB);
            PG8_BAR; PG8_WAIT_L(0); PG8_MMA(0, 1, At, B1); PG8_BAR;
            PG8_LDA(At, 1, 1); PG8_STAGE(PG8_SA(1, 0), a3, voffA);
            PG8_BAR; PG8_WAIT_L(0); PG8_MMA(1, 0, At, B0); PG8_BAR; PG8_SCHED;
            PG8_STAGE(PG8_SB(1, 1), b3 + hstep, voffB);
            PG8_WAIT_V(6); PG8_BAR; PG8_MMA(1, 1, At, B1); PG8_BAR;
            }
        }
        if constexpr (ALIGN_EPI) { if (wr == 0) PG8_BAR; }
        if constexpr (!Epi::AFTER_DRAIN) { E(acc, cur, wr, wc, fr, fq); S.done(cur); }
        if (!has_next) break;
#pragma unroll
        for (int a = 0; a < 2; ++a)
#pragma unroll
            for (int b = 0; b < 2; ++b)
#pragma unroll
                for (int m = 0; m < 4; ++m)
#pragma unroll
                    for (int n = 0; n < 2; ++n) acc[a][b][m][n] = (f32x4){0.f, 0.f, 0.f, 0.f};
        cur = nxt; cA = nA; cB = nB; ++ui;
        if constexpr (ALIGN_EPI) { if (wr == 1) PG8_BAR; }
    }
    PG8_WAIT_V(0);
    if constexpr (!ALIGN_EPI) { if (wr == 0) PG8_BAR; }
    PG8_BAR;
    if constexpr (Epi::AFTER_DRAIN) { E.fused(acc, cur, wr, wc, fr, fq, lds, wid, lane); S.done(cur); }
#undef PG8_SA
#undef PG8_SB
#undef PG8_STAGE
#undef PG8_LDA
#undef PG8_LDB
#undef PG8_MMA
#undef PG8_WAIT_V
#undef PG8_WAIT_L
#undef PG8_BAR
#undef PG8_SCHED
}
}

__device__ __forceinline__ float gamma_log2(int h) { return log2f(1.f - exp2f(-5.f - (float)h)); }

__device__ __forceinline__ void phase_prologue(LAS unsigned char* lds, const float* const* in, unsigned char* ws) {
    const int tid = threadIdx.x, lane = tid & 63, wave = tid >> 6;
    const int gw = blockIdx.x * NWAVES + wave, NGW = gridDim.x * NWAVES;
    LAS float* scr = (LAS float*)(lds + wave * 16384);
    constexpr int I_ABIN = (D / 64) * (AB_IN / 32), I_SQ = (D / 64) * (D / 32), I_CIN = (D / 64) * (C_IN / 32), I_WQ = (D / 64) * (2048 / 32);
    constexpr int NITEMS = I_ABIN + I_SQ + I_CIN + I_SQ + 2 * I_WQ;
    for (int it = gw; it < NITEMS; it += NGW) {
        int r = it;
        if (r < I_ABIN) { p0_transpose_item(in[1], D, AB_IN, (bf16*)(ws + WS_WABIN), scr, r, lane); continue; } r -= I_ABIN;
        if (r < I_SQ) { p0_transpose_item(in[5], D, D, (bf16*)(ws + WS_WABOUT), scr, r, lane); continue; } r -= I_SQ;
        if (r < I_CIN) { p0_transpose_item(in[6], D, C_IN, (bf16*)(ws + WS_WCIN), scr, r, lane); continue; } r -= I_CIN;
        if (r < I_SQ) { p0_transpose_item(in[9], D, D, (bf16*)(ws + WS_WCOUT), scr, r, lane); continue; } r -= I_SQ;
        if (r < I_WQ) { p0_transpose_item(in[10], D, 2048, (bf16*)(ws + WS_WQ), scr, r, lane); continue; } r -= I_WQ;
        p0_transpose_item(in[10] + (size_t)D * 2048, D, 2048, (bf16*)(ws + WS_WQ) + (size_t)2048 * D, scr, r, lane);
    }
    for (int it = gw; it < 32; it += NGW) p0_transpose_item(in[2] + (size_t)(it >> 3) * 16384, 128, 128, (bf16*)(ws + WS_POOLWT) + (size_t)(it >> 3) * 16384, scr, it & 7, lane);
    const size_t gt = (size_t)blockIdx.x * NTHR + tid, NT = (size_t)gridDim.x * NTHR;
    { const float* x = in[0]; bf16* xb = (bf16*)(ws + WS_XB);
      for (size_t i = gt; i < (size_t)T * D / 8; i += NT) { const f32x4 a = *(const GAS f32x4*)(x + i * 8), b = *(const GAS f32x4*)(x + i * 8 + 4);
          v4u o; o.x = pk2(a.x, a.y); o.y = pk2(a.z, a.w); o.z = pk2(b.x, b.y); o.w = pk2(b.z, b.w); *(GAS v4u*)(xb + i * 8) = o; } }
    { const float* k = in[11]; bf16* kb = (bf16*)(ws + WS_KEYS);
      for (size_t i = gt; i < (size_t)2 * 8 * 2 * 128 * 128 / 8; i += NT) { const f32x4 a = *(const GAS f32x4*)(k + i * 8), b = *(const GAS f32x4*)(k + i * 8 + 4);
          v4u o; o.x = pk2(a.x, a.y); o.y = pk2(a.z, a.w); o.z = pk2(b.x, b.y); o.w = pk2(b.z, b.w); *(GAS v4u*)(kb + i * 8) = o; } }
    { float* ct = (float*)(ws + WS_ROPE); float* st = ct + 4096 * 32;
      for (size_t i = gt; i < (size_t)4096 * 32; i += NT) { const int pos = (int)(i >> 5), f = (int)(i & 31);
          const double inv = exp(-log(10000.0) * ((double)f / 31.0)); const double ang = (double)pos * inv;
          ct[i] = (float)cos(ang); st[i] = (float)sin(ang); } }
    { const float* l = in[7]; float* lb = (float*)(ws + WS_LB);
      for (size_t i = gt; i < 1024; i += NT) { const float a = l[i], b = l[1024 + i]; const float m = fmaxf(a, b); const float ea = expf(a - m), eb = expf(b - m); lb[i] = eb / (ea + eb); } }
}

__device__ __forceinline__ void phase_ret_local(LAS unsigned char* lds, unsigned char* ws) {
    const int tid = threadIdx.x;
    const bf16* H0 = (const bf16*)(ws + WS_H0); float* LST = (float*)(ws + WS_LST);
    const float* ct = (const float*)(ws + WS_ROPE); const float* st = ct + 4096 * 32;
    LAS float* kd = (LAS float*)lds;
    LAS float* vv = (LAS float*)(lds + 32768);
    for (int item = blockIdx.x; item < 1024; item += gridDim.x) {
        const int n = item & 31, h = (item >> 5) & 3, b = item >> 7;
        const size_t t0 = (size_t)b * SEQ + n * 128; const float lg = gamma_log2(h);
        for (int idx = tid; idx < 4096; idx += NTHR) { const int s = idx >> 5, i = idx & 31, pos = n * 128 + s;
            const bf16* row = H0 + (t0 + s) * AB_IN + 768 + h * 64;
            const float x1 = bf2f(row[i]), x2 = bf2f(row[i + 32]); const float c = ct[pos * 32 + i], sn = st[pos * 32 + i];
            const float dec = exp2f((float)(127 - s) * lg) * 0.125f;
            kd[s * 64 + i] = (x1 * c - x2 * sn) * dec; kd[s * 64 + i + 32] = (x2 * c + x1 * sn) * dec; }
        for (int idx = tid; idx < 16384; idx += NTHR) { const int s = idx >> 7, e = idx & 127; vv[idx] = bf2f(H0[(t0 + s) * AB_IN + 1024 + h * 128 + e]); }
        __syncthreads();
        const int e = tid & 127, dg = tid >> 7;
        float acc[16];
#pragma unroll
        for (int j = 0; j < 16; ++j) acc[j] = 0.f;
        for (int s = 0; s < 128; ++s) { const float v = vv[s * 128 + e];
#pragma unroll
            for (int j = 0; j < 16; ++j) acc[j] += kd[s * 64 + dg * 16 + j] * v; }
#pragma unroll
        for (int j = 0; j < 16; ++j) LST[(size_t)item * 8192 + (dg * 16 + j) * 128 + e] = acc[j];
        __syncthreads();
    }
}
__device__ __forceinline__ void phase_ret_prefix(unsigned char* ws) {
    float* LST = (float*)(ws + WS_LST);
    const size_t gt = (size_t)blockIdx.x * NTHR + threadIdx.x, NT = (size_t)gridDim.x * NTHR;
    for (size_t idx = gt; idx < (size_t)32 * 8192; idx += NT) { const int bh = (int)(idx >> 13), el = (int)(idx & 8191), h = bh & 3;
        const float g128 = exp2f(128.f * gamma_log2(h)); float S = 0.f;
        for (int n = 0; n < 32; ++n) { float* p = LST + ((size_t)(bh * 32 + n) * 8192 + el); const float tmp = *p; *p = S; S = S * g128 + tmp; } }
}
__device__ __forceinline__ void phase_ret_out_pool(LAS unsigned char* lds, const float* const* in, unsigned char* ws) {
    const int tid = threadIdx.x;
    const bf16* H0 = (const bf16*)(ws + WS_H0); const float* LST = (const float*)(ws + WS_LST); bf16* Y = (bf16*)(ws + WS_Y);
    const float* ct = (const float*)(ws + WS_ROPE); const float* st = ct + 4096 * 32;
    const float* pool_w = in[2]; const float* pool_scale = in[3]; const float* ret_g = in[4];
    LAS float* qs = (LAS float*)lds;
    LAS float* ks = qs + 128 * 65;
    LAS float* R2 = (LAS float*)(lds + 66560);
    LAS float* PA = (LAS float*)lds;
    LAS float* PB = (LAS float*)(lds + 66048);
    for (int item = blockIdx.x; item < 256; item += gridDim.x) {
        const int n = item & 31, b = item >> 5; const size_t t0 = (size_t)b * SEQ + n * 128;
        const int c = tid >> 2, eg = tid & 3;
        for (int h = 0; h < 4; ++h) {
            const float lg = gamma_log2(h);
            for (int idx = tid; idx < 4096; idx += NTHR) { const int s = idx >> 5, i = idx & 31, pos = n * 128 + s;
                const bf16* rq = H0 + (t0 + s) * AB_IN + 512 + h * 64; const bf16* rk = H0 + (t0 + s) * AB_IN + 768 + h * 64;
                const float cs = ct[pos * 32 + i], sn = st[pos * 32 + i];
                const float q1 = bf2f(rq[i]), q2 = bf2f(rq[i + 32]), k1 = bf2f(rk[i]), k2 = bf2f(rk[i + 32]);
                qs[s * 65 + i] = q1 * cs - q2 * sn; qs[s * 65 + i + 32] = q2 * cs + q1 * sn;
                ks[s * 65 + i] = (k1 * cs - k2 * sn) * 0.125f; ks[s * 65 + i + 32] = (k2 * cs + k1 * sn) * 0.125f; }
            { const float* Sg = LST + (size_t)((b * 4 + h) * 32 + n) * 8192;
              for (int idx = tid; idx < 8192; idx += NTHR) R2[idx] = Sg[idx]; }
            __syncthreads();
            float o[32];
#pragma unroll
            for (int j = 0; j < 32; ++j) o[j] = 0.f;
            for (int d = 0; d < 64; ++d) { const float qv = qs[c * 65 + d];
#pragma unroll
                for (int j = 0; j < 32; ++j) o[j] += qv * R2[d * 128 + eg * 32 + j]; }
            { const float qd = exp2f((float)(c + 1) * lg);
#pragma unroll
              for (int j = 0; j < 32; ++j) o[j] *= qd; }
            __syncthreads();
            for (int idx = tid; idx < 16384; idx += NTHR) { const int s = idx >> 7, e = idx & 127; R2[idx] = bf2f(H0[(t0 + s) * AB_IN + 1024 + h * 128 + e]); }
            __syncthreads();
            for (int s = 0; s <= c; ++s) {
                float dot = 0.f;
#pragma unroll 16
                for (int d = 0; d < 64; ++d) dot += qs[c * 65 + d] * ks[s * 65 + d];
                const float w = dot * exp2f((float)(c - s) * lg);
#pragma unroll
                for (int j = 0; j < 32; ++j) o[j] += w * R2[s * 128 + eg * 32 + j];
            }
            float sum = 0.f;
#pragma unroll
            for (int j = 0; j < 32; ++j) sum += o[j];
            sum += __shfl_xor(sum, 1); sum += __shfl_xor(sum, 2);
            const float mean = sum * (1.f / 128.f); float sq = 0.f;
#pragma unroll
            for (int j = 0; j < 32; ++j) { const float dl = o[j] - mean; sq += dl * dl; }
            sq += __shfl_xor(sq, 1); sq += __shfl_xor(sq, 2);
            const float rstd = 1.f / sqrtf(sq * (1.f / 128.f) + LN_EPS);
            { const bf16* rg = H0 + (t0 + c) * AB_IN + 1536 + h * 128 + eg * 32; bf16* yo = Y + (t0 + c) * D + 512 + h * 128 + eg * 32;
#pragma unroll
              for (int j = 0; j < 32; ++j) { const float g = bf2f(rg[j]); const float sg = g / (1.f + expf(-g));
                  yo[j] = (bf16)f2bf((o[j] - mean) * rstd * ret_g[h * 128 + eg * 32 + j] * sg); } }
            __syncthreads();
        }
        for (int gi = 0; gi < 4; ++gi) {
            const int w = 2 << gi;
            for (int idx = tid; idx < 16384; idx += NTHR) { const int s = idx >> 7, cc = idx & 127, pos = n * 128 + s; const int cnt = (pos + 1 < w) ? pos + 1 : w;
                float sum = 0.f; for (int j = 0; j < cnt; ++j) sum += bf2f(H0[(t0 + s - j) * AB_IN + gi * 128 + cc]);
                PA[s * 129 + cc] = sum / (float)cnt - bf2f(H0[(t0 + s) * AB_IN + gi * 128 + cc]); }
            for (int idx = tid; idx < 16384; idx += NTHR) PB[idx] = pool_w[gi * 16384 + idx];
            __syncthreads();
            float o[32];
#pragma unroll
            for (int j = 0; j < 32; ++j) o[j] = 0.f;
            for (int cc = 0; cc < 128; ++cc) { const float pv = PA[c * 129 + cc];
#pragma unroll
                for (int j = 0; j < 32; ++j) o[j] += pv * PB[cc * 128 + eg * 32 + j]; }
            { bf16* yo = Y + (t0 + c) * D + gi * 128 + eg * 32;
#pragma unroll
              for (int j = 0; j < 32; ++j) yo[j] = (bf16)f2bf(o[j] * pool_scale[gi * 128 + eg * 32 + j]); }
            __syncthreads();
        }
    }
}

__device__ __forceinline__ void unpack8(const v4u w, float (&x)[8]) { x[0] = bflo(w.x); x[1] = bfhi(w.x); x[2] = bflo(w.y); x[3] = bfhi(w.y); x[4] = bflo(w.z); x[5] = bfhi(w.z); x[6] = bflo(w.w); x[7] = bfhi(w.w); }
__device__ __forceinline__ v4u pack8(const float (&x)[8]) { v4u w; w.x = pk2(x[0], x[1]); w.y = pk2(x[2], x[3]); w.z = pk2(x[4], x[5]); w.w = pk2(x[6], x[7]); return w; }
__device__ __forceinline__ void phase_ret_out_pool_fast(LAS unsigned char* lds, const float* const* in, unsigned char* ws) {
    const int tid = threadIdx.x, lane = tid & 63, wave = __builtin_amdgcn_readfirstlane(tid >> 6);
    const int c = lane & 31, hh = lane >> 5, cbk = wave & 3, eh = wave >> 2;
    const bf16* H0 = (const bf16*)(ws + WS_H0); const float* LST = (const float*)(ws + WS_LST); bf16* Y = (bf16*)(ws + WS_Y);
    const float* ct = (const float*)(ws + WS_ROPE); const float* st = ct + 4096 * 32;
    const float* pool_scale = in[3]; const float* ret_g = in[4]; const bf16* PWT = (const bf16*)(ws + WS_POOLWT);
    constexpr int O_QP = 0, O_KP = 18432, O_VT = 36864, O_ST = 71680, O_PI = 90112, O_RED = 124928, O_PT = 0, O_WT = 34816;
    for (int item = blockIdx.x; item < 256; item += gridDim.x) {
        const int n = item & 31, b = item >> 5; const size_t t0 = (size_t)b * SEQ + n * 128;
        for (int h = 0; h < 4; ++h) {
            const float lg = gamma_log2(h);
            __syncthreads();
            { const int s = tid >> 2, grp = tid & 3, pos = n * 128 + s;
              const bf16* rq = H0 + (t0 + s) * AB_IN + 512 + h * 64 + 8 * grp; const bf16* rk = H0 + (t0 + s) * AB_IN + 768 + h * 64 + 8 * grp;
              float q1[8], q2[8], k1[8], k2[8], cs[8], sn[8];
              unpack8(*(const GAS v4u*)rq, q1); unpack8(*(const GAS v4u*)(rq + 32), q2); unpack8(*(const GAS v4u*)rk, k1); unpack8(*(const GAS v4u*)(rk + 32), k2);
              { const f32x4 a = *(const GAS f32x4*)(ct + pos * 32 + 8 * grp), bq = *(const GAS f32x4*)(ct + pos * 32 + 8 * grp + 4);
                cs[0] = a.x; cs[1] = a.y; cs[2] = a.z; cs[3] = a.w; cs[4] = bq.x; cs[5] = bq.y; cs[6] = bq.z; cs[7] = bq.w; }
              { const f32x4 a = *(const GAS f32x4*)(st + pos * 32 + 8 * grp), bq = *(const GAS f32x4*)(st + pos * 32 + 8 * grp + 4);
                sn[0] = a.x; sn[1] = a.y; sn[2] = a.z; sn[3] = a.w; sn[4] = bq.x; sn[5] = bq.y; sn[6] = bq.z; sn[7] = bq.w; }
              const float gq = exp2f((float)(s + 1) * lg), gk = 0.125f * exp2f(-(float)(s + 1) * lg);
              float qa[8], qb[8], ka[8], kb[8];
#pragma unroll
              for (int j = 0; j < 8; ++j) { qa[j] = (q1[j] * cs[j] - q2[j] * sn[j]) * gq; qb[j] = (q2[j] * cs[j] + q1[j] * sn[j]) * gq;
                                            ka[j] = (k1[j] * cs[j] - k2[j] * sn[j]) * gk; kb[j] = (k2[j] * cs[j] + k1[j] * sn[j]) * gk; }
              *(LAS v4u*)(lds + O_QP + s * 144 + 16 * grp) = pack8(qa); *(LAS v4u*)(lds + O_QP + s * 144 + 64 + 16 * grp) = pack8(qb);
              *(LAS v4u*)(lds + O_KP + s * 144 + 16 * grp) = pack8(ka); *(LAS v4u*)(lds + O_KP + s * 144 + 64 + 16 * grp) = pack8(kb); }
#pragma unroll
            for (int i = 0; i < 4; ++i) { const int task = tid + 512 * i, e8 = task >> 7, s = task & 127;
                const v4u w = *(const GAS v4u*)(H0 + (t0 + s) * AB_IN + 1024 + h * 128 + 8 * e8);
                LAS bf16* d = (LAS bf16*)(lds + O_VT + (8 * e8) * 272 + 2 * s);
                d[0 * 136] = (bf16)(w.x & 0xffffu); d[1 * 136] = (bf16)(w.x >> 16); d[2 * 136] = (bf16)(w.y & 0xffffu); d[3 * 136] = (bf16)(w.y >> 16);
                d[4 * 136] = (bf16)(w.z & 0xffffu); d[5 * 136] = (bf16)(w.z >> 16); d[6 * 136] = (bf16)(w.w & 0xffffu); d[7 * 136] = (bf16)(w.w >> 16); }
            { const float* Sg = LST + (size_t)((b * 4 + h) * 32 + n) * 8192;
#pragma unroll
              for (int i = 0; i < 4; ++i) { const int task = tid + 512 * i, e4 = task >> 6, d = task & 63;
                  const f32x4 sv = *(const GAS f32x4*)(Sg + d * 128 + 4 * e4);
                  LAS bf16* o = (LAS bf16*)(lds + O_ST + (4 * e4) * 144 + 2 * d);
                  o[0 * 72] = (bf16)f2bf(sv.x); o[1 * 72] = (bf16)f2bf(sv.y); o[2 * 72] = (bf16)f2bf(sv.z); o[3 * 72] = (bf16)f2bf(sv.w); } }
            __syncthreads();
            bf16x8 qf[4];
#pragma unroll
            for (int ks = 0; ks < 4; ++ks) qf[ks] = *(const LAS bf16x8*)(lds + O_QP + (32 * cbk + c) * 144 + (16 * ks + 8 * hh) * 2);
            for (int sb = 0; sb <= cbk; ++sb) {
                f32x16 sc;
#pragma unroll
                for (int r = 0; r < 16; ++r) sc[r] = 0.f;
#pragma unroll
                for (int ks = 0; ks < 4; ++ks) { const bf16x8 kf = *(const LAS bf16x8*)(lds + O_KP + (32 * sb + c) * 144 + (16 * ks + 8 * hh) * 2);
                    sc = __builtin_amdgcn_mfma_f32_32x32x16_bf16(kf, qf[ks], sc, 0, 0, 0); }
#pragma unroll
                for (int g4 = 0; g4 < 4; ++g4) { float m[4];
#pragma unroll
                    for (int q = 0; q < 4; ++q) { const float sv = sc[4 * g4 + q]; m[q] = (sb < cbk || 8 * g4 + 4 * hh + q <= c) ? sv : 0.f; }
                    *(LAS v2u*)(lds + O_PI + cbk * 8704 + c * 272 + (32 * sb + 8 * g4 + 4 * hh) * 2) = (v2u){pk2(m[0], m[1]), pk2(m[2], m[3])}; }
            }
            f32x16 acc[2];
#pragma unroll
            for (int j = 0; j < 2; ++j) {
#pragma unroll
                for (int r = 0; r < 16; ++r) acc[j][r] = 0.f;
                const int eb = 2 * eh + j;
                for (int sb = 0; sb <= cbk; ++sb) {
#pragma unroll
                    for (int ks = 0; ks < 2; ++ks) { const bf16x8 af = *(const LAS bf16x8*)(lds + O_VT + (32 * eb + c) * 272 + (32 * sb + 16 * ks + 8 * hh) * 2);
                        const bf16x8 pf = *(const LAS bf16x8*)(lds + O_PI + cbk * 8704 + c * 272 + (32 * sb + 16 * ks + 8 * hh) * 2);
                        acc[j] = __builtin_amdgcn_mfma_f32_32x32x16_bf16(af, pf, acc[j], 0, 0, 0); }
                }
#pragma unroll
                for (int ks = 0; ks < 4; ++ks) { const bf16x8 sf = *(const LAS bf16x8*)(lds + O_ST + (32 * eb + c) * 144 + (16 * ks + 8 * hh) * 2);
                    acc[j] = __builtin_amdgcn_mfma_f32_32x32x16_bf16(sf, qf[ks], acc[j], 0, 0, 0); }
            }
            float sum = 0.f, sq = 0.f;
#pragma unroll
            for (int j = 0; j < 2; ++j)
#pragma unroll
                for (int r = 0; r < 16; ++r) { const float ov = acc[j][r]; sum += ov; sq += ov * ov; }
            sum += __shfl_xor(sum, 32); sq += __shfl_xor(sq, 32);
            LAS float* red = (LAS float*)(lds + O_RED);
            if (hh == 0) { red[(eh * 128 + 32 * cbk + c) * 2] = sum; red[(eh * 128 + 32 * cbk + c) * 2 + 1] = sq; }
            __syncthreads();
            sum += red[((eh ^ 1) * 128 + 32 * cbk + c) * 2]; sq += red[((eh ^ 1) * 128 + 32 * cbk + c) * 2 + 1];
            const float mean = sum * (1.f / 128.f); const float var = fmaxf(sq * (1.f / 128.f) - mean * mean, 0.f);
            const float rstd = 1.f / sqrtf(var + LN_EPS);
            { const size_t row = t0 + 32 * cbk + c;
#pragma unroll
              for (int j = 0; j < 2; ++j)
#pragma unroll
                  for (int g4 = 0; g4 < 4; ++g4) { const int e = 32 * (2 * eh + j) + 8 * g4 + 4 * hh;
                      const v2u gw2 = *(const GAS v2u*)(H0 + row * AB_IN + 1536 + h * 128 + e); const f32x4 gm = *(const GAS f32x4*)(ret_g + h * 128 + e);
                      const float g0 = bflo(gw2.x), g1 = bfhi(gw2.x), g2 = bflo(gw2.y), g3 = bfhi(gw2.y);
                      const float o0 = acc[j][4 * g4 + 0], o1 = acc[j][4 * g4 + 1], o2 = acc[j][4 * g4 + 2], o3 = acc[j][4 * g4 + 3];
                      const float y0 = (o0 - mean) * rstd * gm.x * (g0 / (1.f + __expf(-g0))), y1 = (o1 - mean) * rstd * gm.y * (g1 / (1.f + __expf(-g1)));
                      const float y2 = (o2 - mean) * rstd * gm.z * (g2 / (1.f + __expf(-g2))), y3 = (o3 - mean) * rstd * gm.w * (g3 / (1.f + __expf(-g3)));
                      *(GAS v2u*)(Y + row * D + 512 + h * 128 + e) = (v2u){pk2(y0, y1), pk2(y2, y3)}; } }
        }
        for (int gi = 0; gi < 4; ++gi) {
            const int w = 2 << gi;
            __syncthreads();
#pragma unroll
            for (int i = 0; i < 4; ++i) { const int task = tid + 512 * i, t = task >> 4, c8 = task & 15, pos = n * 128 + t; const int cnt = (pos + 1 < w) ? pos + 1 : w;
                const bf16* ur = H0 + (t0 + t) * AB_IN + gi * 128 + 8 * c8;
                float u0[8], sm[8]; unpack8(*(const GAS v4u*)ur, u0);
#pragma unroll
                for (int q = 0; q < 8; ++q) sm[q] = u0[q];
                for (int j = 1; j < cnt; ++j) { float uj[8]; unpack8(*(const GAS v4u*)(ur - (size_t)j * AB_IN), uj);
#pragma unroll
                    for (int q = 0; q < 8; ++q) sm[q] += uj[q]; }
                const float ic = 1.f / (float)cnt; float pv[8];
#pragma unroll
                for (int q = 0; q < 8; ++q) pv[q] = sm[q] * ic - u0[q];
                *(LAS v4u*)(lds + O_PT + t * 272 + 16 * c8) = pack8(pv); }
#pragma unroll
            for (int i = 0; i < 4; ++i) { const int piece = tid + 512 * i, d = piece >> 4, c16 = piece & 15;
                *(LAS v4u*)(lds + O_WT + d * 272 + 16 * c16) = *(const GAS v4u*)(PWT + (size_t)(gi * 128 + d) * 128 + 8 * c16); }
            __syncthreads();
            bf16x8 pfr[8];
#pragma unroll
            for (int ks = 0; ks < 8; ++ks) pfr[ks] = *(const LAS bf16x8*)(lds + O_PT + (32 * cbk + c) * 272 + (16 * ks + 8 * hh) * 2);
#pragma unroll
            for (int j = 0; j < 2; ++j) { const int db = 2 * eh + j;
                f32x16 a2;
#pragma unroll
                for (int r = 0; r < 16; ++r) a2[r] = 0.f;
#pragma unroll
                for (int ks = 0; ks < 8; ++ks) { const bf16x8 wf = *(const LAS bf16x8*)(lds + O_WT + (32 * db + c) * 272 + (16 * ks + 8 * hh) * 2);
                    a2 = __builtin_amdgcn_mfma_f32_32x32x16_bf16(wf, pfr[ks], a2, 0, 0, 0); }
#pragma unroll
                for (int g4 = 0; g4 < 4; ++g4) { const int d0 = 32 * db + 8 * g4 + 4 * hh; const f32x4 ps = *(const GAS f32x4*)(pool_scale + gi * 128 + d0);
                    const float y0 = a2[4 * g4 + 0] * ps.x, y1 = a2[4 * g4 + 1] * ps.y, y2 = a2[4 * g4 + 2] * ps.z, y3 = a2[4 * g4 + 3] * ps.w;
                    *(GAS v2u*)(Y + (t0 + 32 * cbk + c) * D + gi * 128 + d0) = (v2u){pk2(y0, y1), pk2(y2, y3)}; }
            }
        }
    }
    __syncthreads();
}
__device__ __forceinline__ void phase_ln(const float* Z, bf16* O, const float* g, const float* bb) {
    const int tid = threadIdx.x, lane = tid & 63, wave = tid >> 6;
    const int gw = blockIdx.x * NWAVES + wave, NGW = gridDim.x * NWAVES;
    for (int m = gw; m < T; m += NGW) {
        const GAS f32x4* zr = (const GAS f32x4*)(Z + (size_t)m * D) + lane;
        f32x4 v[4]; float s = 0.f;
#pragma unroll
        for (int j = 0; j < 4; ++j) { v[j] = zr[64 * j]; s += (v[j].x + v[j].y) + (v[j].z + v[j].w); }
        const float mean = wave_sum(s) * (1.f / D); float s2 = 0.f;
#pragma unroll
        for (int j = 0; j < 4; ++j) { v[j] = v[j] - mean; s2 += (v[j].x * v[j].x + v[j].y * v[j].y) + (v[j].z * v[j].z + v[j].w * v[j].w); }
        const float rstd = 1.f / sqrtf(wave_sum(s2) * (1.f / D) + LN_EPS);
        GAS v2u* o8 = (GAS v2u*)(O + (size_t)m * D) + lane;
#pragma unroll
        for (int j = 0; j < 4; ++j) { const f32x4 gg = *((const GAS f32x4*)g + lane + 64 * j), b4 = *((const GAS f32x4*)bb + lane + 64 * j);
            v2u o; o.x = pk2(v[j].x * rstd * gg.x + b4.x, v[j].y * rstd * gg.y + b4.y); o.y = pk2(v[j].z * rstd * gg.z + b4.z, v[j].w * rstd * gg.w + b4.w); o8[64 * j] = o; }
    }
}
__device__ __forceinline__ void wave_argmax(float& bv, int& bi) {
#pragma unroll
    for (int off = 32; off >= 1; off >>= 1) { const float ov = __shfl_xor(bv, off); const int oi = __shfl_xor(bi, off);
        if (ov > bv || (ov == bv && oi < bi)) { bv = ov; bi = oi; } }
}
__device__ __forceinline__ void phase_topk(LAS unsigned char* lds, const bf16* Q, const float* keys  , int* EID, float* GATE) {
    const int tid = threadIdx.x, lane = tid & 63, wave = tid >> 6;
    LAS float* kl = (LAS float*)lds;
    LAS float* qt = (LAS float*)(lds + 66048);
    LAS float* sc = (LAS float*)(lds + 82560);
    for (int item = blockIdx.x; item < (T / 32) * 8; item += gridDim.x) {
        const int h = item & 7, tile = item >> 3; const size_t tok0 = (size_t)tile * 32;
        for (int p = 0; p < 2; ++p) {
            const float* kg = keys + (size_t)((h * 2 + p) * 128) * 128;
            for (int idx = tid; idx < 16384; idx += NTHR) { const int k = idx >> 7, d = idx & 127; kl[k * 129 + d] = kg[idx]; }
            for (int idx = tid; idx < 4096; idx += NTHR) { const int t = idx >> 7, d = idx & 127; qt[t * 129 + d] = bf2f(Q[(tok0 + t) * 2048 + h * 256 + p * 128 + d]); }
            __syncthreads();
            { const int t = tid >> 4, kg16 = tid & 15;
              for (int jj = 0; jj < 8; ++jj) { const int k = kg16 + 16 * jj; float dot = 0.f;
#pragma unroll 16
                  for (int d = 0; d < 128; ++d) dot += qt[t * 129 + d] * kl[k * 129 + d];
                  sc[(t * 2 + p) * 128 + k] = dot; } }
            __syncthreads();
        }
        for (int tt = 0; tt < 4; ++tt) {
            const int t = wave * 4 + tt;
            float tv[2]; int ti[2];
#pragma unroll
            for (int p = 0; p < 2; ++p) {
                float v0 = sc[(t * 2 + p) * 128 + lane], v1 = sc[(t * 2 + p) * 128 + lane + 64];
                float mv = 0.f; int mi = 0;
                for (int j = 0; j < 16; ++j) {
                    float bv; int bi; if (v0 >= v1) { bv = v0; bi = lane; } else { bv = v1; bi = lane + 64; }
                    wave_argmax(bv, bi);
                    if (lane == j) { mv = bv; mi = bi; }
                    if (bi == lane) v0 = -INFINITY; if (bi == lane + 64) v1 = -INFINITY;
                }
                tv[p] = mv; ti[p] = mi;
            }
            float cv[4];
#pragma unroll
            for (int m = 0; m < 4; ++m) { const int cidx = lane + 64 * m; cv[m] = __shfl(tv[0], cidx >> 4) + __shfl(tv[1], cidx & 15); }
            float bestv = 0.f; int bestc = 0;
            for (int j = 0; j < 16; ++j) {
                float bv = cv[0]; int bi = lane;
#pragma unroll
                for (int m = 1; m < 4; ++m) if (cv[m] > bv) { bv = cv[m]; bi = lane + 64 * m; }
                wave_argmax(bv, bi);
                if (lane == j) { bestv = bv; bestc = bi; }
#pragma unroll
                for (int m = 0; m < 4; ++m) if (bi == lane + 64 * m) cv[m] = -INFINITY;
            }
            const float mx = __shfl(bestv, 0);
            const float ex = (lane < 16) ? expf(bestv - mx) : 0.f;
            const float den = wave_sum(ex);
            const int ia = __shfl(ti[0], bestc >> 4), ib = __shfl(ti[1], bestc & 15);
            if (lane < 16) { const size_t o = (tok0 + t) * 128 + h * 16 + lane; EID[o] = ia * 128 + ib; GATE[o] = ex / den; }
        }
        __syncthreads();
    }
}

#define CEF_D(a, b) { const float hi_ = fmaxf((a), (b)), lo_ = fminf((a), (b)); (a) = hi_; (b) = lo_; }
#define CEF_A(a, b) { const float hi_ = fmaxf((a), (b)), lo_ = fminf((a), (b)); (a) = lo_; (b) = hi_; }
#define CEP_D(ka, pa, kb, pb) { const bool sw_ = (kb) > (ka); const float k0_ = sw_ ? (kb) : (ka), k1_ = sw_ ? (ka) : (kb); const int p0_ = sw_ ? (pb) : (pa), p1_ = sw_ ? (pa) : (pb); (ka) = k0_; (kb) = k1_; (pa) = p0_; (pb) = p1_; }
template <int OFF, int NV> __device__ __forceinline__ void bsort16_desc(float (&v)[NV]) {
#pragma unroll
    for (int k = 2; k <= 16; k <<= 1) {
#pragma unroll
        for (int j = k >> 1; j > 0; j >>= 1) {
#pragma unroll
            for (int i = 0; i < 16; ++i) { const int l = i ^ j;
                if (l > i) { if ((i & k) == 0) CEF_D(v[OFF + i], v[OFF + l]) else CEF_A(v[OFF + i], v[OFF + l]) } }
        }
    }
}
template <int OA, int NV> __device__ __forceinline__ void bmerge16_desc(float (&v)[NV]) {
#pragma unroll
    for (int j = 8; j > 0; j >>= 1) {
#pragma unroll
        for (int i = 0; i < 16; ++i) { const int l = i ^ j; if (l > i) CEF_D(v[OA + i], v[OA + l]) }
    }
}
template <int OA, int OB, int NV> __device__ __forceinline__ void merge_top16(float (&v)[NV]) {
#pragma unroll
    for (int i = 0; i < 16; ++i) v[OA + i] = fmaxf(v[OA + i], v[OB + 15 - i]);
    bmerge16_desc<OA, NV>(v);
}
template <int OFF, int NV> __device__ __forceinline__ void bsort16p_desc(float (&v)[NV], int (&q)[NV]) {
#pragma unroll
    for (int k = 2; k <= 16; k <<= 1) {
#pragma unroll
        for (int j = k >> 1; j > 0; j >>= 1) {
#pragma unroll
            for (int i = 0; i < 16; ++i) { const int l = i ^ j;
                if (l > i) { if ((i & k) == 0) CEP_D(v[OFF + i], q[OFF + i], v[OFF + l], q[OFF + l]) else CEP_D(v[OFF + l], q[OFF + l], v[OFF + i], q[OFF + i]) } }
        }
    }
}
template <int OA, int NV> __device__ __forceinline__ void bmerge16p_desc(float (&v)[NV], int (&q)[NV]) {
#pragma unroll
    for (int j = 8; j > 0; j >>= 1) {
#pragma unroll
        for (int i = 0; i < 16; ++i) { const int l = i ^ j; if (l > i) CEP_D(v[OA + i], q[OA + i], v[OA + l], q[OA + l]) }
    }
}
__host__ __device__ constexpr int pair_i(int s) { return s < 16 ? 0 : s < 24 ? 1 : s < 29 ? 2 : s < 33 ? 3 : s < 36 ? 4 : s < 38 ? 5 : s < 40 ? 6 : s < 42 ? 7 : (s - 42 + 8); }
__host__ __device__ constexpr int pair_j(int s) { return s < 16 ? s : s < 24 ? s - 16 : s < 29 ? s - 24 : s < 33 ? s - 29 : s < 36 ? s - 33 : s < 38 ? s - 36 : s < 40 ? s - 38 : s < 42 ? s - 40 : 0; }
__device__ __forceinline__ void phase_topk_fast(LAS unsigned char* lds, const bf16* Q, const bf16* keysb  , int* EID, float* GATE) {
    const int tid = threadIdx.x, lane = tid & 63, wave = __builtin_amdgcn_readfirstlane(tid >> 6);
    const int c = lane & 31, hh = lane >> 5;
    for (int hi = blockIdx.x; hi < 256; hi += gridDim.x) {
        const int h = hi & 7, rank = hi >> 3;
        __syncthreads();
        for (int idx = tid; idx < 2 * 128 * 16; idx += NTHR) { const int rowi = idx >> 4, ch = idx & 15;
            const v4u kv = *(const GAS v4u*)(keysb + (size_t)h * 32768 + rowi * 128 + ch * 8);
            *(LAS v4u*)(lds + rowi * 272 + ch * 16) = kv; }
        __syncthreads();
        for (int it = 0; it < 4; ++it) {
            const int tile = rank * 8 + wave + 256 * it;
            const size_t tok0 = (size_t)tile * 32;
            float ta[16], tb[16];
#pragma unroll
            for (int p = 0; p < 2; ++p) {
                bf16x8 bq[8];
                const bf16* qrow = Q + (tok0 + c) * 2048 + h * 256 + p * 128 + 8 * hh;
#pragma unroll
                for (int ks = 0; ks < 8; ++ks) bq[ks] = *(const GAS bf16x8*)(qrow + 16 * ks);
                f32x16 acc[4];
#pragma unroll
                for (int blk = 0; blk < 4; ++blk) {
#pragma unroll
                    for (int r = 0; r < 16; ++r) acc[blk][r] = 0.f;
#pragma unroll
                    for (int ks = 0; ks < 8; ++ks) { const bf16x8 a = *(const LAS bf16x8*)(lds + (p * 128 + 32 * blk + c) * 272 + (16 * ks + 8 * hh) * 2);
                        acc[blk] = __builtin_amdgcn_mfma_f32_32x32x16_bf16(a, bq[ks], acc[blk], 0, 0, 0); }
                }
                float v[64];
#pragma unroll
                for (int blk = 0; blk < 4; ++blk)
#pragma unroll
                    for (int r = 0; r < 16; ++r)
                    { const float sv = acc[blk][r]; v[blk * 16 + r] = __uint_as_float((__float_as_uint(sv) & ~127u) | (unsigned)(32 * blk + (r & 3) + 8 * (r >> 2)) | (unsigned)(hh << 2)); }
                __builtin_amdgcn_sched_barrier(0);
                bsort16_desc<0, 64>(v); bsort16_desc<16, 64>(v); bsort16_desc<32, 64>(v); bsort16_desc<48, 64>(v);
                merge_top16<0, 16, 64>(v); merge_top16<32, 48, 64>(v); merge_top16<0, 32, 64>(v);
                float o[16];
#pragma unroll
                for (int i = 0; i < 16; ++i) o[i] = __shfl_xor(v[i], 32);
#pragma unroll
                for (int i = 0; i < 16; ++i) v[i] = fmaxf(v[i], o[15 - i]);
                bmerge16_desc<0, 64>(v);
#pragma unroll
                for (int i = 0; i < 16; ++i) { if (p == 0) ta[i] = v[i]; else tb[i] = v[i]; }
                __builtin_amdgcn_sched_barrier(0);
            }
            float av[16], bv[16]; int ai[16], bi[16];
#pragma unroll
            for (int i = 0; i < 16; ++i) { const unsigned ua = __builtin_bit_cast(unsigned, ta[i]), ub = __builtin_bit_cast(unsigned, tb[i]);
                av[i] = __builtin_bit_cast(float, ua & ~127u); ai[i] = (int)(ua & 127u); bv[i] = __builtin_bit_cast(float, ub & ~127u); bi[i] = (int)(ub & 127u); }
            float ck[32]; int cp[32];
#pragma unroll
            for (int s2 = 0; s2 < 32; ++s2) {
                const float k0 = av[pair_i(s2)] + bv[pair_j(s2)]; const int p0 = (ai[pair_i(s2)] << 7) | bi[pair_j(s2)];
                float k1 = -INFINITY; int p1 = 0;
                if (s2 + 32 < 50) { k1 = av[pair_i(s2 + 32 < 50 ? s2 + 32 : 0)] + bv[pair_j(s2 + 32 < 50 ? s2 + 32 : 0)]; p1 = (ai[pair_i(s2 + 32 < 50 ? s2 + 32 : 0)] << 7) | bi[pair_j(s2 + 32 < 50 ? s2 + 32 : 0)]; }
                ck[s2] = hh ? k1 : k0; cp[s2] = hh ? p1 : p0;
            }
            __builtin_amdgcn_sched_barrier(0);
            bsort16p_desc<0, 32>(ck, cp); bsort16p_desc<16, 32>(ck, cp);
#pragma unroll
            for (int i = 0; i < 16; ++i) { if (ck[16 + 15 - i] > ck[i]) { ck[i] = ck[16 + 15 - i]; cp[i] = cp[16 + 15 - i]; } }
            bmerge16p_desc<0, 32>(ck, cp);
            { float ok[16]; int op[16];
#pragma unroll
              for (int i = 0; i < 16; ++i) { ok[i] = __shfl_xor(ck[i], 32); op[i] = __shfl_xor(cp[i], 32); }
#pragma unroll
              for (int i = 0; i < 16; ++i) { if (ok[15 - i] > ck[i]) { ck[i] = ok[15 - i]; cp[i] = op[15 - i]; } } }
            bmerge16p_desc<0, 32>(ck, cp);
            float ex[16]; float sum = 0.f;
#pragma unroll
            for (int i = 0; i < 16; ++i) { ex[i] = __expf(ck[i] - ck[0]); sum += ex[i]; }
            const float inv = 1.f / sum;
            if (hh == 0) {
                int* eo = EID + (tok0 + c) * 128 + h * 16; float* go = GATE + (tok0 + c) * 128 + h * 16;
#pragma unroll
                for (int i = 0; i < 4; ++i) { *(GAS v4u*)(eo + 4 * i) = (v4u){(unsigned)cp[4 * i], (unsigned)cp[4 * i + 1], (unsigned)cp[4 * i + 2], (unsigned)cp[4 * i + 3]};
                    *(GAS f32x4*)(go + 4 * i) = (f32x4){ex[4 * i] * inv, ex[4 * i + 1] * inv, ex[4 * i + 2] * inv, ex[4 * i + 3] * inv}; }
            }
        }
    }
    __syncthreads();
}
template <bool FINAL>
__device__ __forceinline__ void phase_gather(const bf16* X, const int* EID, const float* GATE, const float* U, const float* V, const float* g, const float* bb, bf16* Ob, float* Of) {
    const int tid = threadIdx.x, lane = tid & 63, wave = tid >> 6;
    const int gw = blockIdx.x * NWAVES + wave, NGW = gridDim.x * NWAVES;
    for (int t = gw; t < T; t += NGW) {
        f32x4 x[4], acc[4];
#pragma unroll
        for (int j = 0; j < 4; ++j) { const v2u w = *((const GAS v2u*)(X + (size_t)t * D) + lane + 64 * j);
            x[j] = (f32x4){bflo(w.x), bfhi(w.x), bflo(w.y), bfhi(w.y)}; acc[j] = (f32x4){0.f, 0.f, 0.f, 0.f}; }
        const int e0 = EID[(size_t)t * 128 + lane], e1 = EID[(size_t)t * 128 + 64 + lane];
        const float g0 = GATE[(size_t)t * 128 + lane], g1 = GATE[(size_t)t * 128 + 64 + lane];
#pragma unroll 2
        for (int k = 0; k < 128; ++k) {
            const int e = (k < 64) ? __shfl(e0, k) : __shfl(e1, k - 64);
            const float gt = (k < 64) ? __shfl(g0, k) : __shfl(g1, k - 64);
            const GAS f32x4* ur = (const GAS f32x4*)(U + (size_t)e * D) + lane;
            float dot = 0.f;
#pragma unroll
            for (int j = 0; j < 4; ++j) { const f32x4 u = ur[64 * j]; dot += (x[j].x * u.x + x[j].y * u.y) + (x[j].z * u.z + x[j].w * u.w); }
            dot = wave_sum(dot);
            const float a = 0.5f * dot * (1.f + erff(dot * 0.70710678118654752f));
            const float cf = gt * a;
            const GAS f32x4* vr = (const GAS f32x4*)(V + (size_t)e * D) + lane;
#pragma unroll
            for (int j = 0; j < 4; ++j) { const f32x4 v = vr[64 * j]; acc[j] += cf * v; }
        }
        float s = 0.f;
#pragma unroll
        for (int j = 0; j < 4; ++j) { acc[j] = ALPHA * x[j] + acc[j]; s += (acc[j].x + acc[j].y) + (acc[j].z + acc[j].w); }
        const float mean = wave_sum(s) * (1.f / D); float s2 = 0.f;
#pragma unroll
        for (int j = 0; j < 4; ++j) { acc[j] = acc[j] - mean; s2 += (acc[j].x * acc[j].x + acc[j].y * acc[j].y) + (acc[j].z * acc[j].z + acc[j].w * acc[j].w); }
        const float rstd = 1.f / sqrtf(wave_sum(s2) * (1.f / D) + LN_EPS);
#pragma unroll
        for (int j = 0; j < 4; ++j) { const f32x4 gg = *((const GAS f32x4*)g + lane + 64 * j), b4 = *((const GAS f32x4*)bb + lane + 64 * j);
            const f32x4 o = acc[j] * rstd * gg + b4;
            if (FINAL) *((GAS f32x4*)(Of + (size_t)t * D) + lane + 64 * j) = o;
            else { v2u w; w.x = pk2(o.x, o.y); w.y = pk2(o.z, o.w); *((GAS v2u*)(Ob + (size_t)t * D) + lane + 64 * j) = w; } }
    }
}

typedef float f32x2 __attribute__((ext_vector_type(2)));
__device__ __forceinline__ void phase_convert_tables(const float* U, const float* V, unsigned char* ws) {
    const int tid = threadIdx.x, lane = tid & 63, wave = tid >> 6;
    const int gw = blockIdx.x * NWAVES + wave, NGW = gridDim.x * NWAVES;
    for (int row = gw; row < 4 * NEXP; row += NGW) {
        const bool isv = row >= 2 * NEXP; const int r = row & (2 * NEXP - 1);
        const GAS f32x4* src = (const GAS f32x4*)((isv ? V : U) + (size_t)r * D) + (isv ? 4 * lane : lane); const int sstep = isv ? 1 : 64;
        f32x4 v[4]; float m = 0.f;
#pragma unroll
        for (int j = 0; j < 4; ++j) { v[j] = src[sstep * j]; m = fmaxf(fmaxf(m, fmaxf(fabsf(v[j].x), fabsf(v[j].y))), fmaxf(fabsf(v[j].z), fabsf(v[j].w))); }
#pragma unroll
        for (int o = 1; o < 64; o <<= 1) m = fmaxf(m, __shfl_xor(m, o));
        m = fmaxf(m, 1e-30f);
        const float sc = 7.f / m;
        unsigned w0 = 0u, w1 = 0u;
#define Q4(x) fminf(fmaxf((x) * sc, -6.f), 6.f)
        w0 = __builtin_amdgcn_cvt_scalef32_pk_fp4_f32(w0, Q4(v[0].x), Q4(v[0].y), 1.0f, 0); w0 = __builtin_amdgcn_cvt_scalef32_pk_fp4_f32(w0, Q4(v[0].z), Q4(v[0].w), 1.0f, 1);
        w0 = __builtin_amdgcn_cvt_scalef32_pk_fp4_f32(w0, Q4(v[1].x), Q4(v[1].y), 1.0f, 2); w0 = __builtin_amdgcn_cvt_scalef32_pk_fp4_f32(w0, Q4(v[1].z), Q4(v[1].w), 1.0f, 3);
        w1 = __builtin_amdgcn_cvt_scalef32_pk_fp4_f32(w1, Q4(v[2].x), Q4(v[2].y), 1.0f, 0); w1 = __builtin_amdgcn_cvt_scalef32_pk_fp4_f32(w1, Q4(v[2].z), Q4(v[2].w), 1.0f, 1);
        w1 = __builtin_amdgcn_cvt_scalef32_pk_fp4_f32(w1, Q4(v[3].x), Q4(v[3].y), 1.0f, 2); w1 = __builtin_amdgcn_cvt_scalef32_pk_fp4_f32(w1, Q4(v[3].z), Q4(v[3].w), 1.0f, 3);
#undef Q4
        *((GAS v2u*)(ws + (isv ? WS_V8 : WS_U8) + (size_t)r * 512) + lane) = (v2u){w0, w1};
        if (lane == 0) ((float*)(ws + (isv ? WS_DQV : WS_DQU)))[r] = m * (1.f / 7.f);
    }
}
__host__ __device__ constexpr int rev4(int i) { return ((i & 1) << 3) | ((i & 2) << 1) | ((i & 4) >> 1) | ((i & 8) >> 3); }
#define FMA2(a, b, c) __builtin_elementwise_fma((a), (b), (c))
#define CVT8(w, hi) __builtin_amdgcn_cvt_pk_f32_fp8((int)(w), (hi))
template <bool FINAL, int MODE  >
__device__ __forceinline__ void phase_gather8(const bf16* X, const int* EID, float* GATE, const unsigned char* U8, const unsigned char* V8, const float* DQU, const float* DQV,
                                              const float* g, const float* bb, bf16* Ob, float* Of) {
    const int tid = threadIdx.x, lane = tid & 63, wave = tid >> 6;
    const int gw = blockIdx.x * NWAVES + wave, NGW = gridDim.x * NWAVES;
    const bool b0 = (lane & 1) != 0, b1 = (lane & 2) != 0, b2 = (lane & 4) != 0, b3 = (lane & 8) != 0; const int myrow = lane >> 4;
    for (int t = gw; t < T; t += NGW) {
        f32x2 x[8];
#pragma unroll
        for (int j = 0; j < 4; ++j) { const v2u w = *((const GAS v2u*)(X + (size_t)t * D) + lane + 64 * j);
            x[2 * j] = (f32x2){bflo(w.x), bfhi(w.x)}; x[2 * j + 1] = (f32x2){bflo(w.y), bfhi(w.y)}; }
        const int e0 = EID[(size_t)t * 128 + lane], e1 = EID[(size_t)t * 128 + 64 + lane];
        const float gt0 = GATE[(size_t)t * 128 + lane], gt1 = GATE[(size_t)t * 128 + 64 + lane];
        const float dqu0 = DQU[e0], dqu1 = DQU[e1], dqv0 = DQV[e0], dqv1 = DQV[e1];
        float act0 = 0.f, act1 = 0.f;
        if (MODE != 2) {
#pragma unroll
        for (int r = 0; r < 2; ++r) {
            const int er = r ? e1 : e0;
            for (int row = 0; row < 4; ++row) {
                v4u w[16];
#pragma unroll
                for (int i = 0; i < 16; ++i) { const int e = __builtin_amdgcn_readlane(er, row * 16 + rev4(i)); w[i] = *((const GAS v4u*)(U8 + (size_t)e * 1024) + lane); }
                float p[16];
#pragma unroll
                for (int i = 0; i < 16; ++i) { f32x2 a = (f32x2){0.f, 0.f};
                    a = FMA2(x[0], CVT8(w[i].x, false), a); a = FMA2(x[1], CVT8(w[i].x, true), a);
                    a = FMA2(x[2], CVT8(w[i].y, false), a); a = FMA2(x[3], CVT8(w[i].y, true), a);
                    a = FMA2(x[4], CVT8(w[i].z, false), a); a = FMA2(x[5], CVT8(w[i].z, true), a);
                    a = FMA2(x[6], CVT8(w[i].w, false), a); a = FMA2(x[7], CVT8(w[i].w, true), a);
                    p[i] = a.x + a.y; }
                float r8[8], r4[4], r2[2];
#pragma unroll
                for (int i = 0; i < 8; ++i) { const float keep = b0 ? p[8 + i] : p[i], send = b0 ? p[i] : p[8 + i]; r8[i] = keep + __shfl_xor(send, 1); }
#pragma unroll
                for (int i = 0; i < 4; ++i) { const float keep = b1 ? r8[4 + i] : r8[i], send = b1 ? r8[i] : r8[4 + i]; r4[i] = keep + __shfl_xor(send, 2); }
#pragma unroll
                for (int i = 0; i < 2; ++i) { const float keep = b2 ? r4[2 + i] : r4[i], send = b2 ? r4[i] : r4[2 + i]; r2[i] = keep + __shfl_xor(send, 4); }
                float r1 = (b3 ? r2[1] : r2[0]) + __shfl_xor(b3 ? r2[0] : r2[1], 8);
                r1 += __shfl_xor(r1, 16); r1 += __shfl_xor(r1, 32);
                if (myrow == row) { if (r == 0) act0 = r1; else act1 = r1; }
            }
        }
        }
        float c0, c1;
        if (MODE != 2) { const float a0 = act0 * dqu0, a1 = act1 * dqu1;
          c0 = gt0 * (0.5f * a0 * (1.f + erff(a0 * 0.70710678118654752f))) * dqv0;
          c1 = gt1 * (0.5f * a1 * (1.f + erff(a1 * 0.70710678118654752f))) * dqv1; }
        else { c0 = gt0; c1 = gt1; }
        if (MODE == 1) { GATE[(size_t)t * 128 + lane] = c0; GATE[(size_t)t * 128 + 64 + lane] = c1; continue; }
        f32x2 acc[8];
#pragma unroll
        for (int j = 0; j < 8; ++j) acc[j] = (f32x2){0.f, 0.f};
#pragma unroll
        for (int r = 0; r < 2; ++r) {
            const int er = r ? e1 : e0; const int cr = __builtin_bit_cast(int, r ? c1 : c0);
            for (int row = 0; row < 4; ++row) {
                v4u w[16];
#pragma unroll
                for (int i = 0; i < 16; ++i) { const int e = __builtin_amdgcn_readlane(er, row * 16 + i); w[i] = *((const GAS v4u*)(V8 + (size_t)e * 1024) + lane); }
#pragma unroll
                for (int i = 0; i < 16; ++i) { const float cf = __builtin_bit_cast(float, __builtin_amdgcn_readlane(cr, row * 16 + i)); const f32x2 c2 = (f32x2){cf, cf};
                    acc[0] = FMA2(c2, CVT8(w[i].x, false), acc[0]); acc[1] = FMA2(c2, CVT8(w[i].x, true), acc[1]);
                    acc[2] = FMA2(c2, CVT8(w[i].y, false), acc[2]); acc[3] = FMA2(c2, CVT8(w[i].y, true), acc[3]);
                    acc[4] = FMA2(c2, CVT8(w[i].z, false), acc[4]); acc[5] = FMA2(c2, CVT8(w[i].z, true), acc[5]);
                    acc[6] = FMA2(c2, CVT8(w[i].w, false), acc[6]); acc[7] = FMA2(c2, CVT8(w[i].w, true), acc[7]); }
            }
        }
        float s = 0.f;
#pragma unroll
        for (int j = 0; j < 8; ++j) { acc[j] = x[j] * ALPHA + acc[j]; s += acc[j].x + acc[j].y; }
        const float mean = wave_sum(s) * (1.f / D); float s2 = 0.f;
#pragma unroll
        for (int j = 0; j < 8; ++j) { acc[j] = acc[j] - mean; s2 += acc[j].x * acc[j].x + acc[j].y * acc[j].y; }
        const float rstd = 1.f / sqrtf(wave_sum(s2) * (1.f / D) + LN_EPS);
#pragma unroll
        for (int j = 0; j < 4; ++j) { const f32x4 gg = *((const GAS f32x4*)g + lane + 64 * j), b4 = *((const GAS f32x4*)bb + lane + 64 * j);
            const f32x4 o = (f32x4){acc[2 * j].x, acc[2 * j].y, acc[2 * j + 1].x, acc[2 * j + 1].y} * rstd * gg + b4;
            if (FINAL) *((GAS f32x4*)(Of + (size_t)t * D) + lane + 64 * j) = o;
            else { v2u w; w.x = pk2(o.x, o.y); w.y = pk2(o.z, o.w); *((GAS v2u*)(Ob + (size_t)t * D) + lane + 64 * j) = w; } }
    }
}
__device__ __forceinline__ void phase_hgrn(LAS unsigned char* lds, unsigned char* ws) {
    const int tid = threadIdx.x;
    const bf16* CQ = (const bf16*)(ws + WS_CQ); const bf16* CK = (const bf16*)(ws + WS_CK); const bf16* CV = (const bf16*)(ws + WS_CV); bf16* O = (bf16*)(ws + WS_O);
    LAS float* fL = (LAS float*)lds;
    LAS float* kL = fL + 4096; LAS float* qL = kL + 4096;
    LAS float* vL = qL + 4096;
    LAS float* part = vL + 1024;
    for (int item = blockIdx.x; item < 256; item += gridDim.x) {
        const int es = item & 3, h = (item >> 2) & 7, b = item >> 5;
        const int e = tid & 31, dg = tid >> 5;
        float S[8];
#pragma unroll
        for (int j = 0; j < 8; ++j) S[j] = 0.f;
        for (int blk = 0; blk < SEQ / 32; ++blk) {
            const size_t t0 = (size_t)b * SEQ + blk * 32;
            for (int idx = tid; idx < 4096; idx += NTHR) { const int s = idx >> 7, d = idx & 127; const size_t o = (t0 + s) * D + h * 128 + d;
                const float kk = bf2f(CK[o]); kL[idx] = kk; fL[idx] = 1.f - kk; qL[idx] = bf2f(CQ[o]); }
            for (int idx = tid; idx < 1024; idx += NTHR) { const int s = idx >> 5, ee = idx & 31; vL[idx] = bf2f(CV[(t0 + s) * D + h * 128 + es * 32 + ee]); }
            __syncthreads();
            for (int s = 0; s < 32; ++s) { const float v = vL[s * 32 + e]; float po = 0.f;
#pragma unroll
                for (int j = 0; j < 8; ++j) { const int d = dg * 8 + j; S[j] = fL[s * 128 + d] * S[j] + kL[s * 128 + d] * v; po += qL[s * 128 + d] * S[j]; }
                part[(s * 16 + dg) * 32 + e] = po; }
            __syncthreads();
            for (int idx = tid; idx < 1024; idx += NTHR) { const int s = idx >> 5, ee = idx & 31; float o = 0.f;
#pragma unroll
                for (int g = 0; g < 16; ++g) o += part[(s * 16 + g) * 32 + ee];
                O[(t0 + s) * D + h * 128 + es * 32 + ee] = (bf16)f2bf(o); }
            __syncthreads();
        }
    }
}


#define GROW(wb, i_, tab, ereg, lsel) (wb)[i_] = *((const GAS v2u*)((tab) + (size_t)__builtin_amdgcn_readlane((ereg), (lsel)) * 512) + lane)
#define CVT4(wd, bs) __builtin_amdgcn_cvt_scalef32_pk_f32_fp4((wd), 1.0f, (bs))
__device__ __forceinline__ void phase_gather_u(const bf16* X, const int* EID, float* GATE, const unsigned char* U8, const float* DQU, const float* DQV) {
    const int tid = threadIdx.x, lane = tid & 63, wave = tid >> 6;
    const int gw = blockIdx.x * NWAVES + wave, NGW = gridDim.x * NWAVES;
    const bool b0 = (lane & 1) != 0, b1 = (lane & 2) != 0, b2 = (lane & 4) != 0, b3 = (lane & 8) != 0; const int myrow = lane >> 4;
    int t = gw;
    if (t < T) {
    v2u xr[4]; int e0, e1; float gt0, gt1;
#pragma unroll
    for (int j = 0; j < 4; ++j) xr[j] = *((const GAS v2u*)(X + (size_t)t * D) + lane + 64 * j);
    e0 = EID[(size_t)t * 128 + lane]; e1 = EID[(size_t)t * 128 + 64 + lane]; gt0 = GATE[(size_t)t * 128 + lane]; gt1 = GATE[(size_t)t * 128 + 64 + lane];
    v2u wA[16], wB[16];
#pragma unroll
    for (int i = 0; i < 16; ++i) GROW(wA, i, U8, e0, rev4(i));
#pragma unroll
    for (int i = 0; i < 16; ++i) GROW(wB, i, U8, e0, 16 + rev4(i));
    for (;;) {
        const int tn = t + NGW; const bool has_next = tn < T;
        v2u nxr[4]; int ne0 = e0, ne1 = e1; float ngt0 = 0.f, ngt1 = 0.f;
        if (has_next) {
#pragma unroll
            for (int j = 0; j < 4; ++j) nxr[j] = *((const GAS v2u*)(X + (size_t)tn * D) + lane + 64 * j);
            ne0 = EID[(size_t)tn * 128 + lane]; ne1 = EID[(size_t)tn * 128 + 64 + lane]; ngt0 = GATE[(size_t)tn * 128 + lane]; ngt1 = GATE[(size_t)tn * 128 + 64 + lane];
        }
        const float dqu0 = DQU[e0], dqu1 = DQU[e1], dqv0 = DQV[e0], dqv1 = DQV[e1];
        f32x2 x[8];
#pragma unroll
        for (int j = 0; j < 4; ++j) { x[2 * j] = (f32x2){bflo(xr[j].x), bfhi(xr[j].x)}; x[2 * j + 1] = (f32x2){bflo(xr[j].y), bfhi(xr[j].y)}; }
        float act0 = 0.f, act1 = 0.f;
#define UBATCH(w, R, ROW, NEREG, NBASE) { float p[16]; \
            _Pragma("unroll") for (int i = 0; i < 16; ++i) { f32x2 a = (f32x2){0.f, 0.f}; \
                a = FMA2(x[0], CVT4(w[i].x, 0), a); a = FMA2(x[1], CVT4(w[i].x, 1), a); \
                a = FMA2(x[2], CVT4(w[i].x, 2), a); a = FMA2(x[3], CVT4(w[i].x, 3), a); \
                a = FMA2(x[4], CVT4(w[i].y, 0), a); a = FMA2(x[5], CVT4(w[i].y, 1), a); \
                a = FMA2(x[6], CVT4(w[i].y, 2), a); a = FMA2(x[7], CVT4(w[i].y, 3), a); \
                p[i] = a.x + a.y; GROW(w, i, U8, NEREG, (NBASE) + rev4(i)); if ((i & 3) == 3) __builtin_amdgcn_sched_barrier(0); } \
            float r8[8], r4[4], r2[2]; \
            _Pragma("unroll") for (int i = 0; i < 8; ++i) { const float keep = b0 ? p[8 + i] : p[i], send = b0 ? p[i] : p[8 + i]; r8[i] = keep + __shfl_xor(send, 1); } \
            _Pragma("unroll") for (int i = 0; i < 4; ++i) { const float keep = b1 ? r8[4 + i] : r8[i], send = b1 ? r8[i] : r8[4 + i]; r4[i] = keep + __shfl_xor(send, 2); } \
            _Pragma("unroll") for (int i = 0; i < 2; ++i) { const float keep = b2 ? r4[2 + i] : r4[i], send = b2 ? r4[i] : r4[2 + i]; r2[i] = keep + __shfl_xor(send, 4); } \
            float r1 = (b3 ? r2[1] : r2[0]) + __shfl_xor(b3 ? r2[0] : r2[1], 8); \
            r1 += __shfl_xor(r1, 16); r1 += __shfl_xor(r1, 32); \
            if (myrow == (ROW)) { if ((R) == 0) act0 = r1; else act1 = r1; } }
        UBATCH(wA, 0, 0, e0, 32) UBATCH(wB, 0, 1, e0, 48) UBATCH(wA, 0, 2, e1, 0) UBATCH(wB, 0, 3, e1, 16)
        UBATCH(wA, 1, 0, e1, 32) UBATCH(wB, 1, 1, e1, 48) UBATCH(wA, 1, 2, ne0, 0) UBATCH(wB, 1, 3, ne0, 16)
#undef UBATCH
        { const float a0 = act0 * dqu0, a1 = act1 * dqu1;
          GATE[(size_t)t * 128 + lane] = gt0 * (0.5f * a0 * (1.f + erff(a0 * 0.70710678118654752f))) * dqv0;
          GATE[(size_t)t * 128 + 64 + lane] = gt1 * (0.5f * a1 * (1.f + erff(a1 * 0.70710678118654752f))) * dqv1; }
        if (!has_next) break;
        t = tn; e0 = ne0; e1 = ne1; gt0 = ngt0; gt1 = ngt1;
#pragma unroll
        for (int j = 0; j < 4; ++j) xr[j] = nxr[j];
    }
    }
}
template <bool FINAL, int EMASK = 0x7fffffff>
__device__ __forceinline__ void phase_gather_v(const bf16* X, const int* EID, const float* COEF, const unsigned char* V8, const float* g, const float* bb, bf16* Ob, float* Of) {
    const int tid = threadIdx.x, lane = tid & 63, wave = tid >> 6;
    const int gw = blockIdx.x * NWAVES + wave, NGW = gridDim.x * NWAVES;
    int t = gw;
    if (t < T) {
    v2u xr[4]; int e0, e1; float c0, c1;
#pragma unroll
    for (int j = 0; j < 4; ++j) xr[j] = *((const GAS v2u*)(X + (size_t)t * D) + lane + 64 * j);
    e0 = EID[(size_t)t * 128 + lane] & EMASK; e1 = EID[(size_t)t * 128 + 64 + lane] & EMASK; c0 = COEF[(size_t)t * 128 + lane]; c1 = COEF[(size_t)t * 128 + 64 + lane];
    v2u wA[16], wB[16];
#pragma unroll
    for (int i = 0; i < 16; ++i) GROW(wA, i, V8, e0, i);
#pragma unroll
    for (int i = 0; i < 16; ++i) GROW(wB, i, V8, e0, 16 + i);
    for (;;) {
        const int tn = t + NGW; const bool has_next = tn < T;
        v2u nxr[4]; int ne0 = e0, ne1 = e1; float nc0 = 0.f, nc1 = 0.f;
        if (has_next) {
#pragma unroll
            for (int j = 0; j < 4; ++j) nxr[j] = *((const GAS v2u*)(X + (size_t)tn * D) + lane + 64 * j);
            ne0 = EID[(size_t)tn * 128 + lane] & EMASK; ne1 = EID[(size_t)tn * 128 + 64 + lane] & EMASK; nc0 = COEF[(size_t)tn * 128 + lane]; nc1 = COEF[(size_t)tn * 128 + 64 + lane];
        }
        f32x2 acc[8];
#pragma unroll
        for (int j = 0; j < 8; ++j) acc[j] = (f32x2){0.f, 0.f};
#define VBATCH(w, CREG, BASE, NEREG, NBASE) { const int cr_ = __builtin_bit_cast(int, (CREG)); \
            _Pragma("unroll") for (int i = 0; i < 16; ++i) { const float cf = __builtin_bit_cast(float, __builtin_amdgcn_readlane(cr_, (BASE) + i)); const f32x2 c2 = (f32x2){cf, cf}; \
                acc[0] = FMA2(c2, CVT4(w[i].x, 0), acc[0]); acc[1] = FMA2(c2, CVT4(w[i].x, 1), acc[1]); \
                acc[2] = FMA2(c2, CVT4(w[i].x, 2), acc[2]); acc[3] = FMA2(c2, CVT4(w[i].x, 3), acc[3]); \
                acc[4] = FMA2(c2, CVT4(w[i].y, 0), acc[4]); acc[5] = FMA2(c2, CVT4(w[i].y, 1), acc[5]); \
                acc[6] = FMA2(c2, CVT4(w[i].y, 2), acc[6]); acc[7] = FMA2(c2, CVT4(w[i].y, 3), acc[7]); \
                GROW(w, i, V8, NEREG, (NBASE) + i); if ((i & 3) == 3) __builtin_amdgcn_sched_barrier(0); } }
        VBATCH(wA, c0, 0, e0, 32) VBATCH(wB, c0, 16, e0, 48) VBATCH(wA, c0, 32, e1, 0) VBATCH(wB, c0, 48, e1, 16)
        VBATCH(wA, c1, 0, e1, 32) VBATCH(wB, c1, 16, e1, 48) VBATCH(wA, c1, 32, ne0, 0) VBATCH(wB, c1, 48, ne0, 16)
#undef VBATCH
        float sm = 0.f;
#pragma unroll
        for (int j = 0; j < 4; ++j) { acc[2 * j] = (f32x2){bflo(xr[j].x), bfhi(xr[j].x)} * ALPHA + acc[2 * j]; acc[2 * j + 1] = (f32x2){bflo(xr[j].y), bfhi(xr[j].y)} * ALPHA + acc[2 * j + 1];
            sm += (acc[2 * j].x + acc[2 * j].y) + (acc[2 * j + 1].x + acc[2 * j + 1].y); }
        const float mean = wave_sum(sm) * (1.f / D); float s2 = 0.f;
#pragma unroll
        for (int j = 0; j < 8; ++j) { acc[j] = acc[j] - mean; s2 += acc[j].x * acc[j].x + acc[j].y * acc[j].y; }
        const float rstd = 1.f / sqrtf(wave_sum(s2) * (1.f / D) + LN_EPS);
#pragma unroll
        for (int j = 0; j < 4; ++j) { const f32x4 gg = *((const GAS f32x4*)g + lane + 64 * j), b4 = *((const GAS f32x4*)bb + lane + 64 * j);
            const f32x4 o = (f32x4){acc[2 * j].x, acc[2 * j].y, acc[2 * j + 1].x, acc[2 * j + 1].y} * rstd * gg + b4;
            if (FINAL) *((GAS f32x4*)(Of + (size_t)t * D) + lane + 64 * j) = o;
            else { v2u wo; wo.x = pk2(o.x, o.y); wo.y = pk2(o.z, o.w); *((GAS v2u*)(Ob + (size_t)t * D) + lane + 64 * j) = wo; } }
        if (!has_next) break;
        t = tn; e0 = ne0; e1 = ne1; c0 = nc0; c1 = nc1;
#pragma unroll
        for (int j = 0; j < 4; ++j) xr[j] = nxr[j];
    }
    }
}


template <bool FINAL>
__device__ __forceinline__ void phase_gather_v_mfma(const bf16* X, const int* EID, const float* COEF, const unsigned char* V4, const float* g, const float* bb, bf16* Ob, float* Of) {
    const int tid = threadIdx.x, lane = tid & 63, wave = tid >> 6;
    const int gw = blockIdx.x * NWAVES + wave, NGW = gridDim.x * NWAVES;
    const int n = lane & 31, hh = lane >> 5;
    unsigned mask[4];
#pragma unroll
    for (int d = 0; d < 4; ++d) mask[d] = (hh == (n >> 4) && d == ((n & 15) >> 2)) ? (0xFFu << (8 * (n & 3))) : 0u;
    float gl[16], bl[16];
#pragma unroll
    for (int r = 0; r < 16; ++r) { const int col = 32 * ((r & 3) + 8 * (r >> 2) + 4 * hh) + n; gl[r] = g[col]; bl[r] = bb[col]; }
    const unsigned laneoff = 16u * (unsigned)n;
    int t = gw;
    if (t < T) {
    int e0 = EID[(size_t)t * 128 + lane], e1 = EID[(size_t)t * 128 + 64 + lane];
    float c0 = COEF[(size_t)t * 128 + lane], c1 = COEF[(size_t)t * 128 + 64 + lane];
    v4u ring[16];
#define VLOADA(slot, ereg, lsel) { const int el_ = __shfl((ereg), (lsel) + hh); ring[slot] = *(const GAS v4u*)(V4 + (((unsigned)el_ << 9) + laneoff)); }
#pragma unroll
    for (int j = 0; j < 16; ++j) VLOADA(j, e0, 2 * j)
    for (;;) {
        const int tn = t + NGW; const bool has_next = tn < T;
        int ne0 = e0, ne1 = e1; float nc0 = 0.f, nc1 = 0.f;
        if (has_next) { ne0 = EID[(size_t)tn * 128 + lane]; ne1 = EID[(size_t)tn * 128 + 64 + lane]; nc0 = COEF[(size_t)tn * 128 + lane]; nc1 = COEF[(size_t)tn * 128 + 64 + lane]; }
        unsigned short xs[16];
#pragma unroll
        for (int r = 0; r < 16; ++r) xs[r] = X[(size_t)t * D + 32 * ((r & 3) + 8 * (r >> 2) + 4 * hh) + n];
        float cm = fmaxf(fabsf(c0), fabsf(c1));
#pragma unroll
        for (int o = 1; o < 64; o <<= 1) cm = fmaxf(cm, __shfl_xor(cm, o));
        unsigned ex = (__float_as_uint(cm) >> 23) & 0xffu; ex = ex < 8u ? 8u : ex;
        const float S = __uint_as_float((261u - ex) << 23), invS = __uint_as_float((ex - 7u) << 23);
        const unsigned wq = (unsigned)__builtin_amdgcn_cvt_pk_fp8_f32(c0 * S, c1 * S, 0, false);
        const int rep0 = (int)((wq & 0xffu) * 0x01010101u), rep1 = (int)(((wq >> 8) & 0xffu) * 0x01010101u);
        f32x16 acc;
#pragma unroll
        for (int r = 0; r < 16; ++r) acc[r] = 0.f;
#pragma unroll
        for (int J = 0; J < 64; ++J) {
            const int ra = __builtin_amdgcn_readlane((J >> 5) ? rep1 : rep0, (2 * J) & 63), rb = __builtin_amdgcn_readlane((J >> 5) ? rep1 : rep0, ((2 * J) & 63) + 1);
            v8i A, B;
            A[0] = (int)ring[J & 15].x; A[1] = (int)ring[J & 15].y; A[2] = (int)ring[J & 15].z; A[3] = (int)ring[J & 15].w; A[4] = 0; A[5] = 0; A[6] = 0; A[7] = 0;
#pragma unroll
            for (int d = 0; d < 4; ++d) { B[d] = ra & (int)mask[d]; B[4 + d] = rb & (int)mask[d]; }
            acc = __builtin_amdgcn_mfma_scale_f32_32x32x64_f8f6f4(A, B, acc, 4, 0, 0, 0x7f7f7f7f, 0, 0x7f7f7f7f);
            if (J + 16 < 64) { VLOADA(J & 15, ((J + 16) >> 5) ? e1 : e0, (2 * (J + 16)) & 63) }
            else { VLOADA(J & 15, ne0, 2 * (J + 16 - 64)) }
            if ((J & 3) == 3) __builtin_amdgcn_sched_barrier(0);
        }
        float z[16]; float sm = 0.f;
#pragma unroll
        for (int r = 0; r < 16; ++r) { const float av = acc[r]; z[r] = ALPHA * bf2f(xs[r]) + av * invS; sm += z[r]; }
        const float mean = wave_sum(sm) * (1.f / D); float s2 = 0.f;
#pragma unroll
        for (int r = 0; r < 16; ++r) { z[r] -= mean; s2 += z[r] * z[r]; }
        const float rstd = 1.f / sqrtf(wave_sum(s2) * (1.f / D) + LN_EPS);
#pragma unroll
        for (int r = 0; r < 16; ++r) { const int col = 32 * ((r & 3) + 8 * (r >> 2) + 4 * hh) + n; const float o = z[r] * rstd * gl[r] + bl[r];
            if (FINAL) Of[(size_t)t * D + col] = o; else Ob[(size_t)t * D + col] = (bf16)f2bf(o); }
        if (!has_next) break;
        t = tn; e0 = ne0; e1 = ne1; c0 = nc0; c1 = nc1;
    }
#undef VLOADA
    }
}
__device__ __forceinline__ void phase_hgrn_prep(unsigned char* ws, float* scratch  ) {
    const int tid = threadIdx.x, lane = tid & 63, wave = tid >> 6;
    const int gw = blockIdx.x * NWAVES + wave, NGW = gridDim.x * NWAVES;
    bf16* CQ = (bf16*)(ws + WS_CQ); bf16* CK = (bf16*)(ws + WS_CK); const bf16* CV = (const bf16*)(ws + WS_CV);
    bf16* KOT = (bf16*)scratch; bf16* VT = (bf16*)scratch + (size_t)T * D; float* DEC = (float*)(ws + WS_DEC);
    for (int item = gw; item < 1024 * 8; item += NGW) {
        const int g = item >> 3, h = item & 7; const size_t t0 = (size_t)g * 32;
        float k0[32], k1[32], b0[32], b1[32]; float c0 = 0.f, c1 = 0.f;
#pragma unroll
        for (int s2 = 0; s2 < 32; ++s2) { const size_t o = (t0 + s2) * D + h * 128 + 2 * lane;
            const unsigned kw = *(const GAS unsigned*)(CK + o), qw = *(const GAS unsigned*)(CQ + o);
            const float ka = bflo(kw), kb = bfhi(kw);
            c0 += __logf(1.f - ka); c1 += __logf(1.f - kb);
            k0[s2] = ka; k1[s2] = kb; b0[s2] = c0; b1[s2] = c1;
            *(GAS unsigned*)(CQ + o) = pk2(bflo(qw) * __expf(c0), bfhi(qw) * __expf(c1));
            *(GAS unsigned*)(CK + o) = pk2(ka * __expf(-c0), kb * __expf(-c1)); }
        { GAS v4u* r0 = (GAS v4u*)(KOT + ((size_t)g * 1024 + h * 128 + 2 * lane) * 32);
#pragma unroll
          for (int j = 0; j < 4; ++j) { v4u w;
              w.x = pk2(k0[8 * j + 0] * __expf(c0 - b0[8 * j + 0]), k0[8 * j + 1] * __expf(c0 - b0[8 * j + 1])); w.y = pk2(k0[8 * j + 2] * __expf(c0 - b0[8 * j + 2]), k0[8 * j + 3] * __expf(c0 - b0[8 * j + 3]));
              w.z = pk2(k0[8 * j + 4] * __expf(c0 - b0[8 * j + 4]), k0[8 * j + 5] * __expf(c0 - b0[8 * j + 5])); w.w = pk2(k0[8 * j + 6] * __expf(c0 - b0[8 * j + 6]), k0[8 * j + 7] * __expf(c0 - b0[8 * j + 7]));
              r0[j] = w; }
#pragma unroll
          for (int j = 0; j < 4; ++j) { v4u w;
              w.x = pk2(k1[8 * j + 0] * __expf(c1 - b1[8 * j + 0]), k1[8 * j + 1] * __expf(c1 - b1[8 * j + 1])); w.y = pk2(k1[8 * j + 2] * __expf(c1 - b1[8 * j + 2]), k1[8 * j + 3] * __expf(c1 - b1[8 * j + 3]));
              w.z = pk2(k1[8 * j + 4] * __expf(c1 - b1[8 * j + 4]), k1[8 * j + 5] * __expf(c1 - b1[8 * j + 5])); w.w = pk2(k1[8 * j + 6] * __expf(c1 - b1[8 * j + 6]), k1[8 * j + 7] * __expf(c1 - b1[8 * j + 7]));
              r0[4 + j] = w; } }
        *(GAS v2u*)(DEC + (size_t)g * 1024 + h * 128 + 2 * lane) = (v2u){__float_as_uint(__expf(c0)), __float_as_uint(__expf(c1))};
        { unsigned va[16], vb[16];
#pragma unroll
          for (int j = 0; j < 16; ++j) { const unsigned w0 = *(const GAS unsigned*)(CV + (t0 + 2 * j) * D + h * 128 + 2 * lane), w1 = *(const GAS unsigned*)(CV + (t0 + 2 * j + 1) * D + h * 128 + 2 * lane);
              va[j] = (w0 & 0xffffu) | (w1 << 16); vb[j] = (w0 >> 16) | (w1 & 0xffff0000u); }
          GAS v4u* r0 = (GAS v4u*)(VT + ((size_t)g * 1024 + h * 128 + 2 * lane) * 32);
#pragma unroll
          for (int j = 0; j < 4; ++j) { r0[j] = (v4u){va[4 * j], va[4 * j + 1], va[4 * j + 2], va[4 * j + 3]}; r0[4 + j] = (v4u){vb[4 * j], vb[4 * j + 1], vb[4 * j + 2], vb[4 * j + 3]}; } }
    }
}
__device__ __forceinline__ void phase_hgrn_scan(LAS unsigned char* lds, unsigned char* ws, const float* scratch) {
    const int tid = threadIdx.x, lane = tid & 63, wave = __builtin_amdgcn_readfirstlane(tid >> 6);
    const int c = lane & 31, hh = lane >> 5;
    const bf16* QI = (const bf16*)(ws + WS_CQ); const bf16* KI = (const bf16*)(ws + WS_CK);
    const bf16* KOT = (const bf16*)scratch; const bf16* VT = (const bf16*)scratch + (size_t)T * D; const float* DEC = (const float*)(ws + WS_DEC);
    bf16* O = (bf16*)(ws + WS_O);
    constexpr int BUF = 30720, O_KI = 0, O_QI = 8704, O_KOT = 17408, O_VT = 27648, O_DEC = 30208, O_ST = 3 * BUF, O_P = O_ST + 8704, NPIECE = 1696;
    for (int item = blockIdx.x; item < 256; item += gridDim.x) {
        const int es = item & 3, h = (item >> 2) & 7, b = item >> 5;
        __syncthreads();
        for (int i = tid; i < 8704 / 16; i += NTHR) *(LAS v4u*)(lds + O_ST + i * 16) = (v4u){0u, 0u, 0u, 0u};
        f32x16 S[4];
#pragma unroll
        for (int blk = 0; blk < 4; ++blk)
#pragma unroll
            for (int r = 0; r < 16; ++r) S[blk][r] = 0.f;
        v4u rg[5];
        const int lt = tid - 128;
        auto piece_src = [&](int n, int q) -> const GAS v4u* {
            const size_t gch = (size_t)b * 128 + n, t0 = gch * 32;
            if (q < 512) return (const GAS v4u*)(KI + (t0 + (q >> 4)) * D + h * 128 + 8 * (q & 15));
            if (q < 1024) { const int u = q - 512; return (const GAS v4u*)(QI + (t0 + (u >> 4)) * D + h * 128 + 8 * (u & 15)); }
            if (q < 1536) { const int u = q - 1024; return (const GAS v4u*)(KOT + (gch * 1024 + h * 128 + (u >> 2)) * 32 + 8 * (u & 3)); }
            if (q < 1664) { const int u = q - 1536; return (const GAS v4u*)(VT + (gch * 1024 + h * 128 + es * 32 + (u >> 2)) * 32 + 8 * (u & 3)); }
            return (const GAS v4u*)(DEC + gch * 1024 + h * 128 + 4 * (q - 1664));
        };
        auto piece_dst = [&](int q) -> int {
            if (q < 512) return O_KI + (q >> 4) * 272 + (q & 15) * 16;
            if (q < 1024) { const int u = q - 512; return O_QI + (u >> 4) * 272 + (u & 15) * 16; }
            if (q < 1536) { const int u = q - 1024; return O_KOT + (u >> 2) * 80 + (u & 3) * 16; }
            if (q < 1664) { const int u = q - 1536; return O_VT + (u >> 2) * 80 + (u & 3) * 16; }
            return O_DEC + (q - 1664) * 16;
        };
        auto load_chunk = [&](int n) {
            if (lt >= 0) {
#pragma unroll
                for (int i = 0; i < 5; ++i) { const int q = lt + 384 * i; if (q < NPIECE) rg[i] = *piece_src(n, q); }
            }
        };
        auto store_chunk = [&](int bufi) {
            if (lt >= 0) {
#pragma unroll
                for (int i = 0; i < 5; ++i) { const int q = lt + 384 * i; if (q < NPIECE) *(LAS v4u*)(lds + bufi * BUF + piece_dst(q)) = rg[i]; }
            }
        };
        auto scores = [&](int n) {
            LAS unsigned char* bp = lds + (n % 3) * BUF; LAS unsigned char* pi = lds + O_P + (n & 1) * 2560;
            f32x16 sc;
#pragma unroll
            for (int r = 0; r < 16; ++r) sc[r] = 0.f;
#pragma unroll
            for (int ks = 0; ks < 8; ++ks) { const bf16x8 kf = *(const LAS bf16x8*)(bp + O_KI + c * 272 + (16 * ks + 8 * hh) * 2);
                const bf16x8 qf = *(const LAS bf16x8*)(bp + O_QI + c * 272 + (16 * ks + 8 * hh) * 2);
                sc = __builtin_amdgcn_mfma_f32_32x32x16_bf16(kf, qf, sc, 0, 0, 0); }
#pragma unroll
            for (int g4 = 0; g4 < 4; ++g4) { float m[4];
#pragma unroll
                for (int q = 0; q < 4; ++q) { const float sv = sc[4 * g4 + q]; m[q] = (8 * g4 + 4 * hh + q <= c) ? sv : 0.f; }
                *(LAS v2u*)(pi + c * 80 + (8 * g4 + 4 * hh) * 2) = (v2u){pk2(m[0], m[1]), pk2(m[2], m[3])}; }
        };
        load_chunk(0); store_chunk(0); load_chunk(1); store_chunk(1); load_chunk(2);
        __syncthreads();
        if (wave == 1) scores(0);
        __syncthreads();
        for (int n = 0; n < 128; ++n) {
            if (n + 2 < 128) store_chunk((n + 2) % 3);
            if (n + 3 < 128) load_chunk(n + 3);
            if (wave == 1 && n + 1 < 128) scores(n + 1);
            if (wave == 0) {
                LAS unsigned char* bp = lds + (n % 3) * BUF; LAS unsigned char* pi = lds + O_P + (n & 1) * 2560;
                const size_t t0 = ((size_t)b * 128 + n) * 32;
                bf16x8 vf[2];
                f32x16 o;
#pragma unroll
                for (int r = 0; r < 16; ++r) o[r] = 0.f;
#pragma unroll
                for (int ks = 0; ks < 2; ++ks) { const bf16x8 pf = *(const LAS bf16x8*)(pi + c * 80 + (16 * ks + 8 * hh) * 2);
                    vf[ks] = *(const LAS bf16x8*)(bp + O_VT + c * 80 + (16 * ks + 8 * hh) * 2);
                    o = __builtin_amdgcn_mfma_f32_32x32x16_bf16(pf, vf[ks], o, 0, 0, 0); }
#pragma unroll
                for (int ks = 0; ks < 8; ++ks) { const bf16x8 qf = *(const LAS bf16x8*)(bp + O_QI + c * 272 + (16 * ks + 8 * hh) * 2);
                    const bf16x8 sf = *(const LAS bf16x8*)(lds + O_ST + c * 272 + (16 * ks + 8 * hh) * 2);
                    o = __builtin_amdgcn_mfma_f32_32x32x16_bf16(qf, sf, o, 0, 0, 0); }
#pragma unroll
                for (int r = 0; r < 16; ++r) { const float ov = o[r]; O[(t0 + (r & 3) + 8 * (r >> 2) + 4 * hh) * D + h * 128 + es * 32 + c] = (bf16)f2bf(ov); }
#pragma unroll
                for (int blk = 0; blk < 4; ++blk) {
#pragma unroll
                    for (int g4 = 0; g4 < 4; ++g4) { const f32x4 dv = *(const LAS f32x4*)(bp + O_DEC + (32 * blk + 8 * g4 + 4 * hh) * 4);
                        S[blk][4 * g4 + 0] *= dv.x; S[blk][4 * g4 + 1] *= dv.y; S[blk][4 * g4 + 2] *= dv.z; S[blk][4 * g4 + 3] *= dv.w; }
#pragma unroll
                    for (int ks = 0; ks < 2; ++ks) { const bf16x8 af = *(const LAS bf16x8*)(bp + O_KOT + (32 * blk + c) * 80 + (16 * ks + 8 * hh) * 2);
                        S[blk] = __builtin_amdgcn_mfma_f32_32x32x16_bf16(af, vf[ks], S[blk], 0, 0, 0); }
#pragma unroll
                    for (int g4 = 0; g4 < 4; ++g4) { const float s0 = S[blk][4 * g4 + 0], s1 = S[blk][4 * g4 + 1], s2 = S[blk][4 * g4 + 2], s3 = S[blk][4 * g4 + 3];
                        *(LAS v2u*)(lds + O_ST + c * 272 + (32 * blk + 8 * g4 + 4 * hh) * 2) = (v2u){pk2(s0, s1), pk2(s2, s3)}; }
                }
            }
            __syncthreads();
        }
    }
}
__device__ __forceinline__ void phase_hgrn_norm(const float* norm_g, unsigned char* ws) {
    const int tid = threadIdx.x, lane = tid & 63, wave = tid >> 6;
    const int gw = blockIdx.x * NWAVES + wave, NGW = gridDim.x * NWAVES;
    const bf16* O = (const bf16*)(ws + WS_O); const bf16* CG = (const bf16*)(ws + WS_CG); bf16* Y2 = (bf16*)(ws + WS_Y2);
    for (int t = gw; t < T; t += NGW) {
        const v4u a0 = *((const GAS v4u*)(O + (size_t)t * D) + lane * 2), a1 = *((const GAS v4u*)(O + (size_t)t * D) + lane * 2 + 1);
        const v4u g0 = *((const GAS v4u*)(CG + (size_t)t * D) + lane * 2), g1 = *((const GAS v4u*)(CG + (size_t)t * D) + lane * 2 + 1);
        float o[16], gv[16];
        o[0] = bflo(a0.x); o[1] = bfhi(a0.x); o[2] = bflo(a0.y); o[3] = bfhi(a0.y); o[4] = bflo(a0.z); o[5] = bfhi(a0.z); o[6] = bflo(a0.w); o[7] = bfhi(a0.w);
        o[8] = bflo(a1.x); o[9] = bfhi(a1.x); o[10] = bflo(a1.y); o[11] = bfhi(a1.y); o[12] = bflo(a1.z); o[13] = bfhi(a1.z); o[14] = bflo(a1.w); o[15] = bfhi(a1.w);
        gv[0] = bflo(g0.x); gv[1] = bfhi(g0.x); gv[2] = bflo(g0.y); gv[3] = bfhi(g0.y); gv[4] = bflo(g0.z); gv[5] = bfhi(g0.z); gv[6] = bflo(g0.w); gv[7] = bfhi(g0.w);
        gv[8] = bflo(g1.x); gv[9] = bfhi(g1.x); gv[10] = bflo(g1.y); gv[11] = bfhi(g1.y); gv[12] = bflo(g1.z); gv[13] = bfhi(g1.z); gv[14] = bflo(g1.w); gv[15] = bfhi(g1.w);
        float sq = 0.f;
#pragma unroll
        for (int j = 0; j < 16; ++j) sq += o[j] * o[j];
        sq += __shfl_xor(sq, 1); sq += __shfl_xor(sq, 2); sq += __shfl_xor(sq, 4);
        const float r = 1.f / sqrtf(sq * (1.f / 128.f) + LN_EPS);
        float y[16];
#pragma unroll
        for (int j = 0; j < 16; ++j) { const float sg = gv[j] / (1.f + expf(-gv[j])); y[j] = o[j] * r * norm_g[lane * 16 + j] * sg; }
        v4u w0, w1; w0.x = pk2(y[0], y[1]); w0.y = pk2(y[2], y[3]); w0.z = pk2(y[4], y[5]); w0.w = pk2(y[6], y[7]);
        w1.x = pk2(y[8], y[9]); w1.y = pk2(y[10], y[11]); w1.z = pk2(y[12], y[13]); w1.w = pk2(y[14], y[15]);
        *((GAS v4u*)(Y2 + (size_t)t * D) + lane * 2) = w0; *((GAS v4u*)(Y2 + (size_t)t * D) + lane * 2 + 1) = w1;
    }
}

struct Args { const float* in[16]; float* out; unsigned char* ws; int ph_lo, ph_hi, li, pad; };
__global__ void __launch_bounds__(NTHR, 2) mk_fwd(Args args) {
    extern __shared__ __attribute__((aligned(16))) unsigned char lds_raw[];
    LAS unsigned char* lds = (LAS unsigned char*)lds_raw;
    volatile LAS unsigned* MISC = (volatile LAS unsigned*)(lds + MISC_OFF);
    const int tid = threadIdx.x;
    unsigned char* ws = args.ws;
    gu32* ctl = (gu32*)(ws + WS_CTL);
    if (tid < 32) ((LAS unsigned*)(lds + MISC_OFF))[tid] = 0u;
    __syncthreads();
    XcdBarrier bar; bar.bar = (unsigned*)ctl + CW_BAR; bar.x = 0; bar.st = nullptr;
    if (N_LAUNCHES == 1) bar = xcd_barrier_post((unsigned*)ctl + CW_BAR, MISC + 8);
    const int lo = args.ph_lo, hi = args.ph_hi;
#define IN(k) (lo <= (k) && (k) < hi)
#define SEAM(k) do { if (IN(k) && IN((k) + 1)) xcd_barrier(bar); } while (0)
    const float* const* in = args.in;
    bf16* XB = (bf16*)(ws + WS_XB); bf16* H0 = (bf16*)(ws + WS_H0); bf16* Y = (bf16*)(ws + WS_Y); bf16* H1 = (bf16*)(ws + WS_H1);
    int* EID = (int*)(ws + WS_EID); float* GATE = (float*)(ws + WS_GATE);
    float* Z = args.out;

    int ph_ = 0;
#define PH_BEGIN if (lo <= ph_ && ph_ < hi) for (int rep_ = 0; rep_ < 1 + (int)((DUP_MASK >> ph_) & 1u); ++rep_) {
#define PH_END } if (lo <= ph_ && ph_ + 1 < hi) xcd_barrier(bar); ++ph_;
      PH_BEGIN phase_prologue(lds, in, ws); phase_convert_tables(in[12], in[13], ws); PH_END
      PH_BEGIN pg8::Gemm g{XB, (const bf16*)(ws + WS_WABIN), T, AB_IN, D}; pg8::StaticOrder S; S.init(T, AB_IN, (int)gridDim.x, (int)blockIdx.x); pg8::EpiBf16<0> E{H0, AB_IN, nullptr, 0, 0, 1.f};
                     pg8::gemm_phase<pg8::EpiBf16<0>, pg8::StaticOrder, true, true>(lds, g, S, E); PH_END
      PH_BEGIN phase_ret_local(lds, ws); PH_END
      PH_BEGIN phase_ret_prefix(ws); PH_END
      PH_BEGIN phase_ret_out_pool_fast(lds, in, ws); PH_END
      PH_BEGIN pg8::Gemm g{Y, (const bf16*)(ws + WS_WABOUT), T, D, D}; pg8::StaticOrder S; S.init(T, D, (int)gridDim.x, (int)blockIdx.x); pg8::EpiResidF32 E{XB, Z};
                     pg8::gemm_phase<pg8::EpiResidF32, pg8::StaticOrder, true, true>(lds, g, S, E); PH_END
      PH_BEGIN phase_ln(Z, H1, in[14], in[15]); PH_END
      PH_BEGIN pg8::Gemm g{H1, (const bf16*)(ws + WS_WQ), T, 2048, D}; pg8::StaticOrder S; S.init(T, 2048, (int)gridDim.x, (int)blockIdx.x); pg8::EpiBf16<0> E{H0  , 2048, nullptr, 0, 0, 1.f};
                     pg8::gemm_phase<pg8::EpiBf16<0>, pg8::StaticOrder, true, true>(lds, g, S, E); PH_END
      PH_BEGIN phase_topk_fast(lds, H0, (const bf16*)(ws + WS_KEYS), EID, GATE); PH_END
      PH_BEGIN phase_gather_u(H1, EID, GATE, ws + WS_U8, (const float*)(ws + WS_DQU), (const float*)(ws + WS_DQV)); PH_END
      PH_BEGIN phase_gather_v_mfma<false>(H1, EID, GATE, ws + WS_V8, in[14] + D, in[15] + D, XB  , nullptr); PH_END
#ifdef PROBE_L2
    PH_BEGIN phase_gather_v<false, PROBE_L2>(H1, EID, GATE, ws + WS_V8, in[14] + D, in[15] + D, Y  , nullptr); PH_END
#endif
      PH_BEGIN pg8::Gemm g{XB, (const bf16*)(ws + WS_WCIN), T, C_IN, D}; pg8::StaticOrder S; S.init(T, C_IN, (int)gridDim.x, (int)blockIdx.x);
                      pg8::EpiCInF E2{(bf16*)(ws + WS_CQ), (bf16*)(ws + WS_CK), (bf16*)(ws + WS_CV), (bf16*)(ws + WS_CG), (const float*)(ws + WS_LB)};
                      pg8::gemm_phase<pg8::EpiCInF, pg8::StaticOrder, true, true>(lds, g, S, E2); PH_END
      PH_BEGIN phase_hgrn_prep(ws, args.out); PH_END
      PH_BEGIN phase_hgrn_scan(lds, ws, args.out); PH_END
      PH_BEGIN phase_hgrn_norm(in[8], ws); PH_END
      PH_BEGIN pg8::Gemm g{(const bf16*)(ws + WS_Y2), (const bf16*)(ws + WS_WCOUT), T, D, D}; pg8::StaticOrder S; S.init(T, D, (int)gridDim.x, (int)blockIdx.x); pg8::EpiResidF32 E{XB, Z};
                      pg8::gemm_phase<pg8::EpiResidF32, pg8::StaticOrder, true, true>(lds, g, S, E); PH_END
      PH_BEGIN phase_ln(Z, H1  , in[14] + 2 * D, in[15] + 2 * D); PH_END
      PH_BEGIN pg8::Gemm g{H1, (const bf16*)(ws + WS_WQ) + (size_t)2048 * D, T, 2048, D}; pg8::StaticOrder S; S.init(T, 2048, (int)gridDim.x, (int)blockIdx.x); pg8::EpiBf16<0> E{(bf16*)(ws + WS_Q1), 2048, nullptr, 0, 0, 1.f};
                      pg8::gemm_phase<pg8::EpiBf16<0>, pg8::StaticOrder, true, true>(lds, g, S, E); PH_END
      PH_BEGIN phase_topk_fast(lds, (const bf16*)(ws + WS_Q1), (const bf16*)(ws + WS_KEYS) + (size_t)8 * 2 * 128 * 128, EID, GATE); PH_END
      PH_BEGIN phase_gather_u(H1, EID, GATE, ws + WS_U8 + (size_t)NEXP * 512, (const float*)(ws + WS_DQU) + NEXP, (const float*)(ws + WS_DQV) + NEXP); PH_END
      PH_BEGIN phase_gather_v_mfma<true>(H1, EID, GATE, ws + WS_V8 + (size_t)NEXP * 512, in[14] + 3 * D, in[15] + 3 * D, nullptr, args.out); PH_END
#undef PH_BEGIN
#undef PH_END
#undef IN
#undef SEAM
}

extern "C" void kernel_launch(void* const* d_in, const int* in_sizes, int n_in, void* d_out, int out_size, void* d_ws, size_t ws_size, hipStream_t stream) {
    static int grid = 0;
    if (grid == 0) {
        if (n_in != 16 || in_sizes[0] != T * D || out_size != T * D || ws_size < WS_END) { fprintf(stderr, "kernel_launch: unexpected problem (n_in %d, in0 %d, out %d, ws %zu); nothing launched\n", n_in, n_in > 0 ? in_sizes[0] : -1, out_size, ws_size); grid = -1; return; }
        int dev = 0, cus = 0;
        if (hipGetDevice(&dev) != hipSuccess || hipDeviceGetAttribute(&cus, hipDeviceAttributeMultiprocessorCount, dev) != hipSuccess) { grid = -1; return; }
        if (hipFuncSetAttribute((const void*)mk_fwd, hipFuncAttributeMaxDynamicSharedMemorySize, LDS_BYTES) != hipSuccess) { fprintf(stderr, "kernel_launch: hipFuncSetAttribute failed\n"); grid = -1; return; }
        (void)hipGetLastError();
        grid = cus;
    }
    if (grid < 0) return;
    if (hipMemsetAsync((char*)d_ws + WS_CTL, 0, CTL_ZERO_BYTES, stream) != hipSuccess) return;
    Args a{};
    for (int i = 0; i < 16; ++i) a.in[i] = (const float*)d_in[i];
    a.out = (float*)d_out; a.ws = (unsigned char*)d_ws;
    for (int li = 0; li < N_LAUNCHES; ++li) {
        a.ph_lo = (N_LAUNCHES == 1) ? 0 : li; a.ph_hi = (N_LAUNCHES == 1) ? NPHASE : li + 1; a.li = li;
        hipLaunchKernelGGL(mk_fwd, dim3(grid), dim3(NTHR), LDS_BYTES, stream, a);
        if (hipPeekAtLastError() != hipSuccess) { fprintf(stderr, "kernel_launch: launch %d failed\n", li); break; }
    }
}
```

```cpp
#include <hip/hip_runtime.h>
#include <cstdio>
#include <cstdint>

#ifndef MK_N_LAUNCHES
#define MK_N_LAUNCHES 1
#endif
#ifdef PROBE_L2
constexpr int NPHASE = 22;
#else
constexpr int NPHASE = 21;
#endif
#ifndef DUP_MASK
#define DUP_MASK 0u
#endif
constexpr int N_LAUNCHES = MK_N_LAUNCHES;

constexpr int BATCH = 8, SEQ = 4096, D = 1024, T = BATCH * SEQ;
constexpr int AB_IN = 2048, C_IN = 4096, NEXP = 16384;
constexpr float LN_EPS = 1e-5f;
constexpr float ALPHA = 1.41421356237309515f;
constexpr int NWAVES = 8, NTHR = 512;

constexpr size_t MiB = 1u << 20;
constexpr size_t WS_CTL = 0, CTL_ZERO_BYTES = 1 * MiB;
constexpr size_t WS_LB = 1 * MiB;
constexpr size_t WS_ROPE = 2 * MiB;
constexpr size_t WS_WABIN = 4 * MiB;
constexpr size_t WS_WABOUT = 8 * MiB;
constexpr size_t WS_WCIN = 10 * MiB;
constexpr size_t WS_WCOUT = 18 * MiB;
constexpr size_t WS_WQ = 20 * MiB;
constexpr size_t WS_KEYS = 28 * MiB;
constexpr size_t WS_DQU = 29 * MiB;
constexpr size_t WS_DQV = 29 * MiB + 131072;
constexpr size_t WS_U8 = 32 * MiB;
constexpr size_t WS_V8 = 64 * MiB;
constexpr size_t WS_POOLWT = 30 * MiB;
constexpr size_t WS_XB = 96 * MiB;
constexpr size_t WS_H0 = 160 * MiB;
constexpr size_t WS_LST = 288 * MiB;
constexpr size_t WS_Y = 320 * MiB;
constexpr size_t WS_H1 = 384 * MiB;
constexpr size_t WS_EID = 448 * MiB;
constexpr size_t WS_GATE = 464 * MiB;
constexpr size_t WS_CQ = 160 * MiB, WS_CK = 224 * MiB, WS_CV = 288 * MiB, WS_CG = 352 * MiB;
constexpr size_t WS_O = 416 * MiB;
constexpr size_t WS_Y2 = 160 * MiB;
constexpr size_t WS_Q1 = 224 * MiB;
constexpr size_t WS_DEC = 480 * MiB;
constexpr size_t WS_END = 484 * MiB;

constexpr int CW_BAR = 4096;
constexpr int LDS_BYTES = 147456;
constexpr int MISC_OFF = LDS_BYTES - 128;

#define GAS __attribute__((address_space(1)))
#define LAS __attribute__((address_space(3)))
typedef unsigned short bf16;
typedef unsigned v4u __attribute__((ext_vector_type(4)));
typedef unsigned v2u __attribute__((ext_vector_type(2)));
typedef float f32x4 __attribute__((ext_vector_type(4)));
typedef GAS unsigned gu32;
typedef short bf16x8 __attribute__((ext_vector_type(8)));
typedef int v8i __attribute__((ext_vector_type(8)));
typedef float f32x16 __attribute__((ext_vector_type(16)));
#define RLX_AGENT __ATOMIC_RELAXED, __HIP_MEMORY_SCOPE_AGENT
#define LDS_WAIT() asm volatile("s_waitcnt lgkmcnt(0)" ::: "memory")
typedef __bf16 hwbf16x2 __attribute__((ext_vector_type(2)));
typedef float hwf32x2 __attribute__((ext_vector_type(2)));
__device__ __forceinline__ unsigned pk2(float lo, float hi) { const hwf32x2 v = {lo, hi}; const hwbf16x2 b = __builtin_convertvector(v, hwbf16x2); return __builtin_bit_cast(unsigned, b); }
__device__ __forceinline__ unsigned f2bf(float f) { return pk2(f, 0.f) & 0xffffu; }
__device__ __forceinline__ float bf2f(unsigned b) { return __builtin_bit_cast(float, b << 16); }
__device__ __forceinline__ float bflo(unsigned w) { return __builtin_bit_cast(float, w << 16); }
__device__ __forceinline__ float bfhi(unsigned w) { return __builtin_bit_cast(float, w & 0xffff0000u); }
__device__ __forceinline__ float wave_sum(float v) {
#pragma unroll
    for (int o = 1; o < 64; o <<= 1) v += __shfl_xor(v, o);
    return v;
}

#define XB_TMO      128
#define XB_XCNT(j)  (256  + 64 * (j))
#define XB_XSUB(j)  (1280 + 64 * (j))
#define XB_XGEN(j)  (2304 + 64 * (j))
#define XB_TOP      3328
#define XB_TOPGEN   3392
#define XCD_BAR_WORDS 3456
#define XB_SPIN_CAP (1u << 21)
__device__ __forceinline__ unsigned xb_ld(unsigned* p)              { return __hip_atomic_load(p, __ATOMIC_RELAXED, __HIP_MEMORY_SCOPE_AGENT); }
__device__ __forceinline__ unsigned xb_add(unsigned* p, unsigned v) { return __hip_atomic_fetch_add(p, v, __ATOMIC_RELAXED, __HIP_MEMORY_SCOPE_AGENT); }
__device__ __forceinline__ unsigned xb_xcc_id() { return (unsigned)__builtin_amdgcn_s_getreg((3 << 11) | 20) & 0xFu; }
#define XB_SPIN(cond, bar) do { unsigned _sp = 0; while (cond) { __builtin_amdgcn_s_sleep(1); \
    if ((++_sp & 255u) == 0u) { if (xb_ld(&(bar)[XB_TMO])) break; if (_sp > XB_SPIN_CAP) { atomicAdd(&(bar)[XB_TMO], 1u); break; } } } } while (0)
struct XcdBarrier { unsigned* bar; unsigned x; volatile LAS unsigned* st; };
__device__ __forceinline__ XcdBarrier xcd_barrier_post(unsigned* bar, volatile LAS unsigned* st) {
    XcdBarrier b; b.bar = bar; b.x = xb_xcc_id(); b.st = st;
    if (threadIdx.x == 0) (void)xb_add(&bar[XB_XCNT(b.x)], 1u);
    return b;
}
__device__ __forceinline__ void xcd_barrier_complete(unsigned* bar, unsigned x, unsigned& nloc, unsigned& nx) {
    const unsigned G = gridDim.x * gridDim.y * gridDim.z;
    unsigned sum, cnt, mine, sp = 0u;
    for (;;) {
        sum = 0u; cnt = 0u; mine = 0u;
#pragma unroll
        for (unsigned j = 0; j < 16; ++j) { const unsigned c = xb_ld(&bar[XB_XCNT(j)]); sum += c; cnt += (c > 0u) ? 1u : 0u; mine = (j == x) ? c : mine; }
        if (sum == G) break;
        __builtin_amdgcn_s_sleep(1);
        if ((++sp & 255u) == 0u) { if (xb_ld(&bar[XB_TMO])) break; if (sp > XB_SPIN_CAP) { atomicAdd(&bar[XB_TMO], 1u); break; } }
    }
    nloc = mine > 0u ? mine : 1u; nx = cnt > 0u ? cnt : 1u;
}
__device__ __forceinline__ void xcd_barrier(const XcdBarrier& b) {
    asm volatile("s_waitcnt vmcnt(0)" ::: "memory");
    __syncthreads();
    if (threadIdx.x == 0) {
        unsigned* bar = b.bar;
        __builtin_amdgcn_s_waitcnt(0);
        unsigned nloc = b.st[0], nx = b.st[1];
        if (nloc == 0u) { xcd_barrier_complete(bar, b.x, nloc, nx); b.st[0] = nloc; b.st[1] = nx; }
        const unsigned old = xb_add(&bar[XB_XSUB(b.x)], 1u);
        const unsigned gen = old / nloc;
        if (old + 1u == (gen + 1u) * nloc) {
            __builtin_amdgcn_fence(__ATOMIC_RELEASE, "agent");
            asm volatile("s_waitcnt vmcnt(0)" ::: "memory");
            const unsigned og = xb_add(&bar[XB_TOP], 1u);
            const unsigned tg = og / nx;
            if (og + 1u == (tg + 1u) * nx) xb_add(&bar[XB_TOPGEN], 1u);
            else XB_SPIN(xb_ld(&bar[XB_TOPGEN]) == tg, bar);
            __builtin_amdgcn_fence(__ATOMIC_ACQUIRE, "agent");
            xb_add(&bar[XB_XGEN(b.x)], 1u);
            asm volatile("s_waitcnt vmcnt(0)" ::: "memory");
        } else {
            XB_SPIN(xb_ld(&bar[XB_XGEN(b.x)]) == gen, bar);
            __builtin_amdgcn_fence(__ATOMIC_ACQUIRE, "agent");
            asm volatile("s_waitcnt vmcnt(0)" ::: "memory");
        }
    }
    __syncthreads();
}

__device__ __forceinline__ void p0_transpose_item(const float* W, int K, int N, bf16* WT, LAS float* scr, int item, int lane) {
    const int nblk = N / 32, kb = item / nblk, nb = item % nblk, k0 = 64 * kb, n0 = 32 * nb;
#pragma unroll 8
    for (int i = 0; i < 32; ++i) { const int kk = 2 * i + (lane >> 5); scr[kk * 33 + (lane & 31)] = W[(size_t)(k0 + kk) * N + n0 + (lane & 31)]; }
    LDS_WAIT(); asm volatile("" ::: "memory");
    const int c = lane & 7;
#pragma unroll
    for (int j = 0; j < 4; ++j) { const int n = (lane >> 3) + 8 * j; const LAS float* s = scr + (8 * c) * 33 + n;
        v4u o; o.x = pk2(s[0 * 33], s[1 * 33]); o.y = pk2(s[2 * 33], s[3 * 33]); o.z = pk2(s[4 * 33], s[5 * 33]); o.w = pk2(s[6 * 33], s[7 * 33]);
        *(GAS v4u*)(WT + (size_t)(n0 + n) * K + k0 + 8 * c) = o; }
    LDS_WAIT(); asm volatile("" ::: "memory");
}

template <class Epi>
__device__ __forceinline__ void gemm_naive(LAS unsigned char* lds, const bf16* A, const bf16* Bt, int M, int N, int K, const Epi& E) {
    LAS float* As = (LAS float*)lds;
    LAS float* Bs = As + 128 * 33;
    const int tid = threadIdx.x, tx = tid & 15, ty = tid >> 4;
    const int ntn = N / 128, ntiles = (M / 128) * ntn;
    for (int tile = blockIdx.x; tile < ntiles; tile += gridDim.x) {
        const int tm = tile / ntn, tn = tile % ntn;
        float acc[4][8];
#pragma unroll
        for (int i = 0; i < 4; ++i)
#pragma unroll
            for (int j = 0; j < 8; ++j) acc[i][j] = 0.f;
        for (int k0 = 0; k0 < K; k0 += 32) {
            { const int r = tid >> 2, kc = (tid & 3) * 8;
              const v4u va = *(const GAS v4u*)(A + (size_t)(tm * 128 + r) * K + k0 + kc);
              const v4u vb = *(const GAS v4u*)(Bt + (size_t)(tn * 128 + r) * K + k0 + kc);
              LAS float* pa = As + r * 33 + kc; LAS float* pb = Bs + r * 33 + kc;
              pa[0] = bflo(va.x); pa[1] = bfhi(va.x); pa[2] = bflo(va.y); pa[3] = bfhi(va.y); pa[4] = bflo(va.z); pa[5] = bfhi(va.z); pa[6] = bflo(va.w); pa[7] = bfhi(va.w);
              pb[0] = bflo(vb.x); pb[1] = bfhi(vb.x); pb[2] = bflo(vb.y); pb[3] = bfhi(vb.y); pb[4] = bflo(vb.z); pb[5] = bfhi(vb.z); pb[6] = bflo(vb.w); pb[7] = bfhi(vb.w); }
            __syncthreads();
#pragma unroll 8
            for (int kk = 0; kk < 32; ++kk) {
                float a[4], b[8];
#pragma unroll
                for (int i = 0; i < 4; ++i) a[i] = As[(ty * 4 + i) * 33 + kk];
#pragma unroll
                for (int j = 0; j < 8; ++j) b[j] = Bs[(tx + 16 * j) * 33 + kk];
#pragma unroll
                for (int i = 0; i < 4; ++i)
#pragma unroll
                    for (int j = 0; j < 8; ++j) acc[i][j] += a[i] * b[j];
            }
            __syncthreads();
        }
#pragma unroll
        for (int i = 0; i < 4; ++i)
#pragma unroll
            for (int j = 0; j < 8; ++j) E(tm * 128 + ty * 4 + i, tn * 128 + tx + 16 * j, acc[i][j]);
    }
}
struct EpiStore { bf16* O; int ldc;
    __device__ __forceinline__ void operator()(int r, int c, float v) const { O[(size_t)r * ldc + c] = (bf16)f2bf(v); } };
struct EpiResid { const bf16* X; float* Z;
    __device__ __forceinline__ void operator()(int r, int c, float v) const { Z[(size_t)r * D + c] = ALPHA * bf2f(X[(size_t)r * D + c]) + v; } };
struct EpiCIn { bf16 *CQ, *CK, *CV, *CG; const float* lb;
    __device__ __forceinline__ void operator()(int r, int c, float v) const {
        const int seg = c >> 10, cc = c & 1023; const size_t o = (size_t)r * D + cc;
        if (seg == 0) CQ[o] = (bf16)f2bf(v);
        else if (seg == 1) { const float k = (1.f - lb[cc]) / (1.f + expf(v)); CK[o] = (bf16)f2bf(k); }
        else if (seg == 2) CV[o] = (bf16)f2bf(v);
        else CG[o] = (bf16)f2bf(v);
    } };

namespace pg8 {
#define PG8_LAS __attribute__((address_space(3)))
typedef unsigned short bf16_t;
typedef short bf16x8 __attribute__((ext_vector_type(8)));
typedef float f32x4 __attribute__((ext_vector_type(4)));
typedef unsigned u32x4 __attribute__((ext_vector_type(4)));
constexpr int BM = 256, BK = 64, HALF = 128, HTB = HALF * BK * 2  , STAGE_BYTES = 8 * HTB, NXCD = 8, WGM = 8;

__host__ __device__ __forceinline__ int lds_byte(int r, int c) { const int st = (r >> 4) * 2 + (c >> 5), rr = r & 15, cc = c & 31, ob = rr * 64 + cc * 2; return st * 1024 + (ob ^ (((ob >> 9) & 1) << 5)); }
__host__ __device__ __forceinline__ void stage_rc(int b, int& R, int& C) { const int st = b / 1024, sb = b % 1024, swz = sb ^ (((sb >> 9) & 1) << 5); R = (st >> 1) * 16 + swz / 64; C = (st & 1) * 32 + (swz % 64) / 2; }
__host__ __device__ __forceinline__ int perm32(int rho) { const int n = rho >> 4, i = rho & 15; return 8 * (i >> 2) + 4 * n + (i & 3); }

struct Unit { int pm, pn; };
struct Gemm { const bf16_t* A; const bf16_t* Bt; int M, N, K; };

struct StaticOrder {
    int nM, nN, nwg, G, c;
    __host__ __device__ void init(int M, int N, int G_, int c_) { nM = M / BM; nN = N / BM; nwg = nM * nN; G = G_; c = c_; }
    __host__ __device__ bool next(int i, Unit& u) const {
        const long L = (long)i * G + c; if (L >= nwg) return false;
        int wgid = (int)L; { const int q = nwg / NXCD, r = nwg % NXCD, xcd = wgid % NXCD, off = wgid / NXCD; wgid = (xcd < r ? xcd * (q + 1) : r * (q + 1) + (xcd - r) * q) + off; }
        const int nig = WGM * nN, gid = wgid / nig, fm = gid * WGM, gsz = (nM - fm) < WGM ? (nM - fm) : WGM;
        u.pm = fm + ((wgid % nig) % gsz); u.pn = (wgid % nig) / gsz; return true;
    }
    __device__ __forceinline__ void a_ready(const Unit&) const {}
    __device__ __forceinline__ void done(const Unit&) const {}
};

__device__ __forceinline__ unsigned cvt_pk_bf16(float lo, float hi) { unsigned r; asm volatile("v_cvt_pk_bf16_f32 %0, %1, %2" : "=v"(r) : "v"(lo), "v"(hi)); return r; }
typedef float f32x2 __attribute__((ext_vector_type(2)));
__device__ __forceinline__ f32x2 gelu_pk(f32x2 v) {
    const f32x2 av = __builtin_elementwise_abs(v), d = av * 0.2316418882f + 1.0f;
    f32x2 t; t.x = __builtin_amdgcn_rcpf(d.x); t.y = __builtin_amdgcn_rcpf(d.y);
    f32x2 q = t * 0.5307027145f + (-0.7265760135f); q = q * t + 0.7107068705f; q = q * t + (-0.142248368f); q = q * t + 0.127414796f; q = q * t;
    const f32x2 s = (v * v) * (-0.72134752044f);
    f32x2 e; e.x = __builtin_amdgcn_exp2f(s.x); e.y = __builtin_amdgcn_exp2f(s.y);
    const f32x2 m = v * (q * e), r = v - m;
    f32x2 o; o.x = v.x < 0.f ? m.x : r.x; o.y = v.y < 0.f ? m.y : r.y; return o;
}

template <int ACT  > struct EpiBf16 {
    static constexpr bool PERM = true, AFTER_DRAIN = false; static_assert(ACT == 0 || ACT == 1, "EpiBf16: ACT is 0 (none) or 1 (gelu_pk)");
    bf16_t* O; int ldc; const float* bias; int split_cols; size_t split_stride; float scale0;
    __device__ __forceinline__ void operator()(const f32x4 (&acc)[2][2][4][2], const Unit& u, int wr, int wc, int fr, int fq) const {
        const int row0 = u.pm * BM + wr * 64 + fr; int colt = u.pn * BM; bf16_t* base = O;
        float sc = 1.f; if (split_cols) { const int t = colt / split_cols; base += (size_t)t * split_stride; colt -= t * split_cols; if (t == 0) sc = scale0; }
        const int col0 = colt + wc * 32 + 8 * fq, bcol0 = u.pn * BM + wc * 32 + 8 * fq;
        f32x4 bv[2][2];
#pragma unroll
        for (int bj = 0; bj < 2; ++bj)
#pragma unroll
            for (int n = 0; n < 2; ++n) bv[bj][n] = bias ? *(const f32x4*)(bias + bcol0 + bj * HALF + 4 * n) : (f32x4){0.f, 0.f, 0.f, 0.f};
#pragma unroll
        for (int ai = 0; ai < 2; ++ai)
#pragma unroll
            for (int m = 0; m < 4; ++m) { bf16_t* rowp = base + (size_t)(row0 + ai * HALF + m * 16) * ldc + col0;
#pragma unroll
                for (int bj = 0; bj < 2; ++bj) { f32x4 v0 = acc[ai][bj][m][0] + bv[bj][0], v1 = acc[ai][bj][m][1] + bv[bj][1];
                    if (ACT == 1) { f32x2 a = gelu_pk((f32x2){v0[0], v0[1]}), b = gelu_pk((f32x2){v0[2], v0[3]}), c = gelu_pk((f32x2){v1[0], v1[1]}), d = gelu_pk((f32x2){v1[2], v1[3]});
                        v0 = (f32x4){a.x, a.y, b.x, b.y}; v1 = (f32x4){c.x, c.y, d.x, d.y}; }
                    v0 = v0 * sc; v1 = v1 * sc; u32x4 w; w.x = cvt_pk_bf16(v0[0], v0[1]); w.y = cvt_pk_bf16(v0[2], v0[3]); w.z = cvt_pk_bf16(v1[0], v1[1]); w.w = cvt_pk_bf16(v1[2], v1[3]);
                    *(u32x4*)(rowp + bj * HALF) = w; } }
    }
};

struct EpiResidF32 {
    static constexpr bool PERM = false, AFTER_DRAIN = false;
    const bf16_t* X; float* Z;
    __device__ __forceinline__ void operator()(const f32x4 (&acc)[2][2][4][2], const Unit& u, int wr, int wc, int fr, int fq) const {
        typedef unsigned u32x2 __attribute__((ext_vector_type(2)));
        const int row0 = u.pm * BM + wr * 64 + fr, col0 = u.pn * BM + wc * 32 + 4 * fq;
#pragma unroll
        for (int ai = 0; ai < 2; ++ai)
#pragma unroll
            for (int m = 0; m < 4; ++m) { const size_t ro = (size_t)(row0 + ai * HALF + m * 16) * 1024;
#pragma unroll
                for (int bj = 0; bj < 2; ++bj)
#pragma unroll
                    for (int n = 0; n < 2; ++n) { const int c = col0 + bj * HALF + n * 16; const u32x2 xw = *(const u32x2*)(X + ro + c);
                        f32x4 xv; xv[0] = __builtin_bit_cast(float, xw.x << 16); xv[1] = __builtin_bit_cast(float, xw.x & 0xffff0000u); xv[2] = __builtin_bit_cast(float, xw.y << 16); xv[3] = __builtin_bit_cast(float, xw.y & 0xffff0000u);
                        *(f32x4*)(Z + ro + c) = xv * 1.41421356237309515f + acc[ai][bj][m][n]; } }
    }
};
struct EpiCInF {
    static constexpr bool PERM = true, AFTER_DRAIN = false;
    bf16_t *CQ, *CK, *CV, *CG; const float* lb;
    __device__ __forceinline__ void operator()(const f32x4 (&acc)[2][2][4][2], const Unit& u, int wr, int wc, int fr, int fq) const {
        const int seg = u.pn >> 2, colt = (u.pn & 3) * BM;
        bf16_t* base = seg == 0 ? CQ : (seg == 1 ? CK : (seg == 2 ? CV : CG));
        const int row0 = u.pm * BM + wr * 64 + fr, col0 = colt + wc * 32 + 8 * fq;
        f32x4 om[2][2];
#pragma unroll
        for (int bj = 0; bj < 2; ++bj)
#pragma unroll
            for (int n = 0; n < 2; ++n) { const f32x4 l = *(const f32x4*)(lb + col0 + bj * HALF + 4 * n); om[bj][n] = 1.0f - l; }
#pragma unroll
        for (int ai = 0; ai < 2; ++ai)
#pragma unroll
            for (int m = 0; m < 4; ++m) { bf16_t* rowp = base + (size_t)(row0 + ai * HALF + m * 16) * 1024 + col0;
#pragma unroll
                for (int bj = 0; bj < 2; ++bj) { f32x4 v0 = acc[ai][bj][m][0], v1 = acc[ai][bj][m][1];
                    if (seg == 1) {
#pragma unroll
                        for (int q = 0; q < 4; ++q) { v0[q] = om[bj][0][q] / (1.0f + __expf(v0[q])); v1[q] = om[bj][1][q] / (1.0f + __expf(v1[q])); } }
                    u32x4 w; w.x = cvt_pk_bf16(v0[0], v0[1]); w.y = cvt_pk_bf16(v0[2], v0[3]); w.z = cvt_pk_bf16(v1[0], v1[1]); w.w = cvt_pk_bf16(v1[2], v1[3]);
                    *(u32x4*)(rowp + bj * HALF) = w; } }
    }
};
template <class Epi, class Sched, bool ALIGN_EPI = false, bool SP2 = false>
__device__ __forceinline__ void gemm_phase(PG8_LAS unsigned char* lds, const Gemm g, const Sched& S, const Epi& E) {
    const int tid = threadIdx.x, wid = __builtin_amdgcn_readfirstlane(tid >> 6), lane = tid & 63, wr = wid >> 2, wc = wid & 3, fr = lane & 15, fq = lane >> 4;
    const int K = g.K, nt = K / BK;
    unsigned voffA[2], voffB[2];
#pragma unroll
    for (int i = 0; i < 2; ++i) { int R, C; stage_rc(tid * 16 + i * 8192, R, C); const int Rb = Epi::PERM ? ((R & ~31) + perm32(R & 31)) : R;
        voffA[i] = (unsigned)(R * K + C) * 2u; voffB[i] = (unsigned)(Rb * K + C) * 2u; }
    const size_t kstep = (size_t)(BK * 2);
    const size_t hstep = (size_t)HALF * K * 2;
    const size_t tstep = 2 * hstep;
    const unsigned ldsw = (unsigned)wid * 1024u;
    const int aoff = lds_byte(wr * 64 + fr, fq * 8), boff = lds_byte(wc * 32 + fr, fq * 8);
#define PG8_SA(b, h) (((b) * 2 + (h)) * HTB)
#define PG8_SB(b, h) ((4 + (b) * 2 + (h)) * HTB)
#define PG8_STAGE(bufoff, gbase, voff) do { _Pragma("unroll") for (int _i = 0; _i < 2; ++_i) \
        __builtin_amdgcn_global_load_lds((const unsigned*)((const char*)(gbase) + (voff)[_i]), (PG8_LAS unsigned*)(lds + (bufoff) + ldsw + _i * 8192), 16, 0, 0); } while (0)
#define PG8_LDA(dst, b, h) do { _Pragma("unroll") for (int m = 0; m < 4; ++m) _Pragma("unroll") for (int k = 0; k < 2; ++k) dst[m][k] = *(const PG8_LAS bf16x8*)(lds + PG8_SA(b, h) + aoff + m * 2048 + k * 1024); } while (0)
#define PG8_LDB(dst, b, h) do { _Pragma("unroll") for (int n = 0; n < 2; ++n) _Pragma("unroll") for (int k = 0; k < 2; ++k) dst[n][k] = *(const PG8_LAS bf16x8*)(lds + PG8_SB(b, h) + boff + n * 2048 + k * 1024); } while (0)
#define PG8_MMA(ai, bj, At, Bt) do { __builtin_amdgcn_s_setprio(1); _Pragma("unroll") for (int m = 0; m < 4; ++m) _Pragma("unroll") for (int n = 0; n < 2; ++n) _Pragma("unroll") for (int k = 0; k < 2; ++k) \
        acc[ai][bj][m][n] = __builtin_amdgcn_mfma_f32_16x16x32_bf16(Bt[n][k], At[m][k], acc[ai][bj][m][n], 0, 0, 0); __builtin_amdgcn_s_setprio(0); } while (0)
#define PG8_WAIT_V(n) asm volatile("s_waitcnt vmcnt(" #n ")" ::: "memory")
#define PG8_WAIT_L(n) asm volatile("s_waitcnt lgkmcnt(" #n ")" ::: "memory")
#define PG8_BAR __builtin_amdgcn_s_barrier()
#define PG8_SCHED __builtin_amdgcn_sched_barrier(0)
    Unit cur, nxt; int ui = 0;
    if (!S.next(0, cur)) return;
    f32x4 acc[2][2][4][2];
#pragma unroll
    for (int a = 0; a < 2; ++a)
#pragma unroll
        for (int b = 0; b < 2; ++b)
#pragma unroll
            for (int m = 0; m < 4; ++m)
#pragma unroll
                for (int n = 0; n < 2; ++n) acc[a][b][m][n] = (f32x4){0.f, 0.f, 0.f, 0.f};
    bf16x8 At[4][2], B0[2][2], B1[2][2];
    const char* cA = (const char*)g.A + (size_t)cur.pm * tstep; const char* cB = (const char*)g.Bt + (size_t)cur.pn * tstep;
    S.a_ready(cur);
    if constexpr (SP2) {
        PG8_STAGE(PG8_SB(0, 0), cB, voffB); PG8_STAGE(PG8_SB(0, 1), cB + hstep, voffB); PG8_STAGE(PG8_SA(0, 0), cA, voffA); PG8_STAGE(PG8_SA(0, 1), cA + hstep, voffA);
        if (wr == 1) PG8_BAR;
        PG8_WAIT_V(2); PG8_BAR;
        PG8_STAGE(PG8_SB(1, 0), cB + kstep, voffB); PG8_STAGE(PG8_SA(1, 0), cA + kstep, voffA); PG8_STAGE(PG8_SB(1, 1), cB + hstep + kstep, voffB);
        PG8_WAIT_V(6); PG8_BAR;
    } else {
        PG8_STAGE(PG8_SB(0, 0), cB, voffB); PG8_STAGE(PG8_SA(0, 0), cA, voffA); PG8_STAGE(PG8_SB(0, 1), cB + hstep, voffB); PG8_STAGE(PG8_SA(0, 1), cA + hstep, voffA);
        if (wr == 1) PG8_BAR;
        PG8_WAIT_V(4); PG8_BAR;
        PG8_STAGE(PG8_SB(1, 0), cB + kstep, voffB); PG8_STAGE(PG8_SA(1, 0), cA + kstep, voffA); PG8_STAGE(PG8_SB(1, 1), cB + hstep + kstep, voffB);
        PG8_WAIT_V(6); PG8_BAR;
    }
    for (;;) {
        const bool has_next = S.next(ui + 1, nxt);
        const char* nA = has_next ? (const char*)g.A + (size_t)nxt.pm * tstep : cA; const char* nB = has_next ? (const char*)g.Bt + (size_t)nxt.pn * tstep : cB;
        for (int t = 0; t < nt; t += 2) {
            const bool last = (t == nt - 2);
            const char* a1 = cA + (size_t)(t + 1) * kstep;
            const char* a2 = last ? nA : cA + (size_t)(t + 2) * kstep; const char* b2 = last ? nB : cB + (size_t)(t + 2) * kstep;
            const char* a3 = a2 + kstep; const char* b3 = b2 + kstep;
            if (last && has_next) S.a_ready(nxt);
            if constexpr (SP2) {
            PG8_LDB(B0, 0, 0); PG8_LDB(B1, 0, 1); PG8_SCHED; PG8_LDA(At, 0, 0); PG8_STAGE(PG8_SA(1, 1), a1 + hstep, voffA);
            PG8_WAIT_V(8); PG8_WAIT_L(0); PG8_BAR; PG8_MMA(0, 0, At, B0); PG8_MMA(0, 1, At, B1); PG8_BAR; PG8_SCHED;
            PG8_LDA(At, 0, 1); PG8_STAGE(PG8_SB(0, 0), b2, voffB); PG8_STAGE(PG8_SB(0, 1), b2 + hstep, voffB); PG8_STAGE(PG8_SA(0, 0), a2, voffA);
            PG8_WAIT_V(8); PG8_WAIT_L(0); PG8_BAR; PG8_MMA(1, 0, At, B0); PG8_MMA(1, 1, At, B1); PG8_BAR; PG8_SCHED;
            PG8_LDB(B0, 1, 0); PG8_LDB(B1, 1, 1); PG8_SCHED; PG8_LDA(At, 1, 0); PG8_STAGE(PG8_SA(0, 1), a2 + hstep, voffA);
            PG8_WAIT_V(8); PG8_WAIT_L(0); PG8_BAR; PG8_MMA(0, 0, At, B0); PG8_MMA(0, 1, At, B1); PG8_BAR; PG8_SCHED;
            PG8_LDA(At, 1, 1); PG8_STAGE(PG8_SB(1, 0), b3, voffB); PG8_STAGE(PG8_SB(1, 1), b3 + hstep, voffB); PG8_STAGE(PG8_SA(1, 0), a3, voffA);
            PG8_WAIT_V(8); PG8_WAIT_L(0); PG8_BAR; PG8_MMA(1, 0, At, B0); PG8_MMA(1, 1, At, B1); PG8_BAR; PG8_SCHED;
            } else {
            PG8_LDB(B0, 0, 0); PG8_SCHED; PG8_LDA(At, 0, 0); PG8_STAGE(PG8_SA(1, 1), a1 + hstep, voffA);
            PG8_WAIT_L(8); PG8_BAR; PG8_WAIT_L(0); PG8_MMA(0, 0, At, B0); PG8_BAR; PG8_SCHED;
            PG8_LDB(B1, 0, 1); PG8_STAGE(PG8_SB(0, 0), b2, voffB);
            PG8_BAR; PG8_WAIT_L(0); PG8_MMA(0, 1, At, B1); PG8_BAR;
            PG8_LDA(At, 0, 1); PG8_STAGE(PG8_SA(0, 0), a2, voffA);
            PG8_BAR; PG8_WAIT_L(0); PG8_MMA(1, 0, At, B0); PG8_BAR; PG8_SCHED;
            PG8_STAGE(PG8_SB(0, 1), b2 + hstep, voffB);
            PG8_WAIT_V(6); PG8_BAR; PG8_MMA(1, 1, At, B1); PG8_BAR;
            PG8_LDB(B0, 1, 0); PG8_SCHED; PG8_LDA(At, 1, 0); PG8_STAGE(PG8_SA(0, 1), a2 + hstep, voffA);
            PG8_WAIT_L(8); PG8_BAR; PG8_WAIT_L(0); PG8_MMA(0, 0, At, B0); PG8_BAR; PG8_SCHED;
            PG8_LDB(B1, 1, 1); PG8_STAGE(PG8_SB(1, 0), b3, voffB);
            PG8_BAR; PG8_WAIT_L(0); PG8_MMA(0, 1, At, B1); PG8_BAR;
            PG8_LDA(At, 1, 1); PG8_STAGE(PG8_SA(1, 0), a3, voffA);
            PG8_BAR; PG8_WAIT_L(0); PG8_MMA(1, 0, At, B0); PG8_BAR; PG8_SCHED;
            PG8_STAGE(PG8_SB(1, 1), b3 + hstep, voffB);
            PG8_WAIT_V(6); PG8_BAR; PG8_MMA(1, 1, At, B1); PG8_BAR;
            }
        }
        if constexpr (ALIGN_EPI) { if (wr == 0) PG8_BAR; }
        if constexpr (!Epi::AFTER_DRAIN) { E(acc, cur, wr, wc, fr, fq); S.done(cur); }
        if (!has_next) break;
#pragma unroll
        for (int a = 0; a < 2; ++a)
#pragma unroll
            for (int b = 0; b < 2; ++b)
#pragma unroll
                for (int m = 0; m < 4; ++m)
#pragma unroll
                    for (int n = 0; n < 2; ++n) acc[a][b][m][n] = (f32x4){0.f, 0.f, 0.f, 0.f};
        cur = nxt; cA = nA; cB = nB; ++ui;
        if constexpr (ALIGN_EPI) { if (wr == 1) PG8_BAR; }
    }
    PG8_WAIT_V(0);
    if constexpr (!ALIGN_EPI) { if (wr == 0) PG8_BAR; }
    PG8_BAR;
    if constexpr (Epi::AFTER_DRAIN) { E.fused(acc, cur, wr, wc, fr, fq, lds, wid, lane); S.done(cur); }
#undef PG8_SA
#undef PG8_SB
#undef PG8_STAGE
#undef PG8_LDA
#undef PG8_LDB
#undef PG8_MMA
#undef PG8_WAIT_V
#undef PG8_WAIT_L
#undef PG8_BAR
#undef PG8_SCHED
}
}

__device__ __forceinline__ float gamma_log2(int h) { return log2f(1.f - exp2f(-5.f - (float)h)); }

__device__ __forceinline__ void phase_prologue(LAS unsigned char* lds, const float* const* in, unsigned char* ws) {
    const int tid = threadIdx.x, lane = tid & 63, wave = tid >> 6;
    const int gw = blockIdx.x * NWAVES + wave, NGW = gridDim.x * NWAVES;
    LAS float* scr = (LAS float*)(lds + wave * 16384);
    constexpr int I_ABIN = (D / 64) * (AB_IN / 32), I_SQ = (D / 64) * (D / 32), I_CIN = (D / 64) * (C_IN / 32), I_WQ = (D / 64) * (2048 / 32);
    constexpr int NITEMS = I_ABIN + I_SQ + I_CIN + I_SQ + 2 * I_WQ;
    for (int it = gw; it < NITEMS; it += NGW) {
        int r = it;
        if (r < I_ABIN) { p0_transpose_item(in[1], D, AB_IN, (bf16*)(ws + WS_WABIN), scr, r, lane); continue; } r -= I_ABIN;
        if (r < I_SQ) { p0_transpose_item(in[5], D, D, (bf16*)(ws + WS_WABOUT), scr, r, lane); continue; } r -= I_SQ;
        if (r < I_CIN) { p0_transpose_item(in[6], D, C_IN, (bf16*)(ws + WS_WCIN), scr, r, lane); continue; } r -= I_CIN;
        if (r < I_SQ) { p0_transpose_item(in[9], D, D, (bf16*)(ws + WS_WCOUT), scr, r, lane); continue; } r -= I_SQ;
        if (r < I_WQ) { p0_transpose_item(in[10], D, 2048, (bf16*)(ws + WS_WQ), scr, r, lane); continue; } r -= I_WQ;
        p0_transpose_item(in[10] + (size_t)D * 2048, D, 2048, (bf16*)(ws + WS_WQ) + (size_t)2048 * D, scr, r, lane);
    }
    for (int it = gw; it < 32; it += NGW) p0_transpose_item(in[2] + (size_t)(it >> 3) * 16384, 128, 128, (bf16*)(ws + WS_POOLWT) + (size_t)(it >> 3) * 16384, scr, it & 7, lane);
    const size_t gt = (size_t)blockIdx.x * NTHR + tid, NT = (size_t)gridDim.x * NTHR;
    { const float* x = in[0]; bf16* xb = (bf16*)(ws + WS_XB);
      for (size_t i = gt; i < (size_t)T * D / 8; i += NT) { const f32x4 a = *(const GAS f32x4*)(x + i * 8), b = *(const GAS f32x4*)(x + i * 8 + 4);
          v4u o; o.x = pk2(a.x, a.y); o.y = pk2(a.z, a.w); o.z = pk2(b.x, b.y); o.w = pk2(b.z, b.w); *(GAS v4u*)(xb + i * 8) = o; } }
    { const float* k = in[11]; bf16* kb = (bf16*)(ws + WS_KEYS);
      for (size_t i = gt; i < (size_t)2 * 8 * 2 * 128 * 128 / 8; i += NT) { const f32x4 a = *(const GAS f32x4*)(k + i * 8), b = *(const GAS f32x4*)(k + i * 8 + 4);
          v4u o; o.x = pk2(a.x, a.y); o.y = pk2(a.z, a.w); o.z = pk2(b.x, b.y); o.w = pk2(b.z, b.w); *(GAS v4u*)(kb + i * 8) = o; } }
    { float* ct = (float*)(ws + WS_ROPE); float* st = ct + 4096 * 32;
      for (size_t i = gt; i < (size_t)4096 * 32; i += NT) { const int pos = (int)(i >> 5), f = (int)(i & 31);
          const double inv = exp(-log(10000.0) * ((double)f / 31.0)); const double ang = (double)pos * inv;
          ct[i] = (float)cos(ang); st[i] = (float)sin(ang); } }
    { const float* l = in[7]; float* lb = (float*)(ws + WS_LB);
      for (size_t i = gt; i < 1024; i += NT) { const float a = l[i], b = l[1024 + i]; const float m = fmaxf(a, b); const float ea = expf(a - m), eb = expf(b - m); lb[i] = eb / (ea + eb); } }
}

__device__ __forceinline__ void phase_ret_local(LAS unsigned char* lds, unsigned char* ws) {
    const int tid = threadIdx.x;
    const bf16* H0 = (const bf16*)(ws + WS_H0); float* LST = (float*)(ws + WS_LST);
    const float* ct = (const float*)(ws + WS_ROPE); const float* st = ct + 4096 * 32;
    LAS float* kd = (LAS float*)lds;
    LAS float* vv = (LAS float*)(lds + 32768);
    for (int item = blockIdx.x; item < 1024; item += gridDim.x) {
        const int n = item & 31, h = (item >> 5) & 3, b = item >> 7;
        const size_t t0 = (size_t)b * SEQ + n * 128; const float lg = gamma_log2(h);
        for (int idx = tid; idx < 4096; idx += NTHR) { const int s = idx >> 5, i = idx & 31, pos = n * 128 + s;
            const bf16* row = H0 + (t0 + s) * AB_IN + 768 + h * 64;
            const float x1 = bf2f(row[i]), x2 = bf2f(row[i + 32]); const float c = ct[pos * 32 + i], sn = st[pos * 32 + i];
            const float dec = exp2f((float)(127 - s) * lg) * 0.125f;
            kd[s * 64 + i] = (x1 * c - x2 * sn) * dec; kd[s * 64 + i + 32] = (x2 * c + x1 * sn) * dec; }
        for (int idx = tid; idx < 16384; idx += NTHR) { const int s = idx >> 7, e = idx & 127; vv[idx] = bf2f(H0[(t0 + s) * AB_IN + 1024 + h * 128 + e]); }
        __syncthreads();
        const int e = tid & 127, dg = tid >> 7;
        float acc[16];
#pragma unroll
        for (int j = 0; j < 16; ++j) acc[j] = 0.f;
        for (int s = 0; s < 128; ++s) { const float v = vv[s * 128 + e];
#pragma unroll
            for (int j = 0; j < 16; ++j) acc[j] += kd[s * 64 + dg * 16 + j] * v; }
#pragma unroll
        for (int j = 0; j < 16; ++j) LST[(size_t)item * 8192 + (dg * 16 + j) * 128 + e] = acc[j];
        __syncthreads();
    }
}
__device__ __forceinline__ void phase_ret_prefix(unsigned char* ws) {
    float* LST = (float*)(ws + WS_LST);
    const size_t gt = (size_t)blockIdx.x * NTHR + threadIdx.x, NT = (size_t)gridDim.x * NTHR;
    for (size_t idx = gt; idx < (size_t)32 * 8192; idx += NT) { const int bh = (int)(idx >> 13), el = (int)(idx & 8191), h = bh & 3;
        const float g128 = exp2f(128.f * gamma_log2(h)); float S = 0.f;
        for (int n = 0; n < 32; ++n) { float* p = LST + ((size_t)(bh * 32 + n) * 8192 + el); const float tmp = *p; *p = S; S = S * g128 + tmp; } }
}
__device__ __forceinline__ void phase_ret_out_pool(LAS unsigned char* lds, const float* const* in, unsigned char* ws) {
    const int tid = threadIdx.x;
    const bf16* H0 = (const bf16*)(ws + WS_H0); const float* LST = (const float*)(ws + WS_LST); bf16* Y = (bf16*)(ws + WS_Y);
    const float* ct = (const float*)(ws + WS_ROPE); const float* st = ct + 4096 * 32;
    const float* pool_w = in[2]; const float* pool_scale = in[3]; const float* ret_g = in[4];
    LAS float* qs = (LAS float*)lds;
    LAS float* ks = qs + 128 * 65;
    LAS float* R2 = (LAS float*)(lds + 66560);
    LAS float* PA = (LAS float*)lds;
    LAS float* PB = (LAS float*)(lds + 66048);
    for (int item = blockIdx.x; item < 256; item += gridDim.x) {
        const int n = item & 31, b = item >> 5; const size_t t0 = (size_t)b * SEQ + n * 128;
        const int c = tid >> 2, eg = tid & 3;
        for (int h = 0; h < 4; ++h) {
            const float lg = gamma_log2(h);
            for (int idx = tid; idx < 4096; idx += NTHR) { const int s = idx >> 5, i = idx & 31, pos = n * 128 + s;
                const bf16* rq = H0 + (t0 + s) * AB_IN + 512 + h * 64; const bf16* rk = H0 + (t0 + s) * AB_IN + 768 + h * 64;
                const float cs = ct[pos * 32 + i], sn = st[pos * 32 + i];
                const float q1 = bf2f(rq[i]), q2 = bf2f(rq[i + 32]), k1 = bf2f(rk[i]), k2 = bf2f(rk[i + 32]);
                qs[s * 65 + i] = q1 * cs - q2 * sn; qs[s * 65 + i + 32] = q2 * cs + q1 * sn;
                ks[s * 65 + i] = (k1 * cs - k2 * sn) * 0.125f; ks[s * 65 + i + 32] = (k2 * cs + k1 * sn) * 0.125f; }
            { const float* Sg = LST + (size_t)((b * 4 + h) * 32 + n) * 8192;
              for (int idx = tid; idx < 8192; idx += NTHR) R2[idx] = Sg[idx]; }
            __syncthreads();
            float o[32];
#pragma unroll
            for (int j = 0; j < 32; ++j) o[j] = 0.f;
            for (int d = 0; d < 64; ++d) { const float qv = qs[c * 65 + d];
#pragma unroll
                for (int j = 0; j < 32; ++j) o[j] += qv * R2[d * 128 + eg * 32 + j]; }
            { const float qd = exp2f((float)(c + 1) * lg);
#pragma unroll
              for (int j = 0; j < 32; ++j) o[j] *= qd; }
            __syncthreads();
            for (int idx = tid; idx < 16384; idx += NTHR) { const int s = idx >> 7, e = idx & 127; R2[idx] = bf2f(H0[(t0 + s) * AB_IN + 1024 + h * 128 + e]); }
            __syncthreads();
            for (int s = 0; s <= c; ++s) {
                float dot = 0.f;
#pragma unroll 16
                for (int d = 0; d < 64; ++d) dot += qs[c * 65 + d] * ks[s * 65 + d];
                const float w = dot * exp2f((float)(c - s) * lg);
#pragma unroll
                for (int j = 0; j < 32; ++j) o[j] += w * R2[s * 128 + eg * 32 + j];
            }
            float sum = 0.f;
#pragma unroll
            for (int j = 0; j < 32; ++j) sum += o[j];
            sum += __shfl_xor(sum, 1); sum += __shfl_xor(sum, 2);
            const float mean = sum * (1.f / 128.f); float sq = 0.f;
#pragma unroll
            for (int j = 0; j < 32; ++j) { const float dl = o[j] - mean; sq += dl * dl; }
            sq += __shfl_xor(sq, 1); sq += __shfl_xor(sq, 2);
            const float rstd = 1.f / sqrtf(sq * (1.f / 128.f) + LN_EPS);
            { const bf16* rg = H0 + (t0 + c) * AB_IN + 1536 + h * 128 + eg * 32; bf16* yo = Y + (t0 + c) * D + 512 + h * 128 + eg * 32;
#pragma unroll
              for (int j = 0; j < 32; ++j) { const float g = bf2f(rg[j]); const float sg = g / (1.f + expf(-g));
                  yo[j] = (bf16)f2bf((o[j] - mean) * rstd * ret_g[h * 128 + eg * 32 + j] * sg); } }
            __syncthreads();
        }
        for (int gi = 0; gi < 4; ++gi) {
            const int w = 2 << gi;
            for (int idx = tid; idx < 16384; idx += NTHR) { const int s = idx >> 7, cc = idx & 127, pos = n * 128 + s; const int cnt = (pos + 1 < w) ? pos + 1 : w;
                float sum = 0.f; for (int j = 0; j < cnt; ++j) sum += bf2f(H0[(t0 + s - j) * AB_IN + gi * 128 + cc]);
                PA[s * 129 + cc] = sum / (float)cnt - bf2f(H0[(t0 + s) * AB_IN + gi * 128 + cc]); }
            for (int idx = tid; idx < 16384; idx += NTHR) PB[idx] = pool_w[gi * 16384 + idx];
            __syncthreads();
            float o[32];
#pragma unroll
            for (int j = 0; j < 32; ++j) o[j] = 0.f;
            for (int cc = 0; cc < 128; ++cc) { const float pv = PA[c * 129 + cc];
#pragma unroll
                for (int j = 0; j < 32; ++j) o[j] += pv * PB[cc * 128 + eg * 32 + j]; }
            { bf16* yo = Y + (t0 + c) * D + gi * 128 + eg * 32;
#pragma unroll
              for (int j = 0; j < 32; ++j) yo[j] = (bf16)f2bf(o[j] * pool_scale[gi * 128 + eg * 32 + j]); }
            __syncthreads();
        }
    }
}

__device__ __forceinline__ void unpack8(const v4u w, float (&x)[8]) { x[0] = bflo(w.x); x[1] = bfhi(w.x); x[2] = bflo(w.y); x[3] = bfhi(w.y); x[4] = bflo(w.z); x[5] = bfhi(w.z); x[6] = bflo(w.w); x[7] = bfhi(w.w); }
__device__ __forceinline__ v4u pack8(const float (&x)[8]) { v4u w; w.x = pk2(x[0], x[1]); w.y = pk2(x[2], x[3]); w.z = pk2(x[4], x[5]); w.w = pk2(x[6], x[7]); return w; }
__device__ __forceinline__ void phase_ret_out_pool_fast(LAS unsigned char* lds, const float* const* in, unsigned char* ws) {
    const int tid = threadIdx.x, lane = tid & 63, wave = __builtin_amdgcn_readfirstlane(tid >> 6);
    const int c = lane & 31, hh = lane >> 5, cbk = wave & 3, eh = wave >> 2;
    const bf16* H0 = (const bf16*)(ws + WS_H0); const float* LST = (const float*)(ws + WS_LST); bf16* Y = (bf16*)(ws + WS_Y);
    const float* ct = (const float*)(ws + WS_ROPE); const float* st = ct + 4096 * 32;
    const float* pool_scale = in[3]; const float* ret_g = in[4]; const bf16* PWT = (const bf16*)(ws + WS_POOLWT);
    constexpr int O_QP = 0, O_KP = 18432, O_VT = 36864, O_ST = 71680, O_PI = 90112, O_RED = 124928, O_PT = 0, O_WT = 34816;
    for (int item = blockIdx.x; item < 256; item += gridDim.x) {
        const int n = item & 31, b = item >> 5; const size_t t0 = (size_t)b * SEQ + n * 128;
        for (int h = 0; h < 4; ++h) {
            const float lg = gamma_log2(h);
            __syncthreads();
            { const int s = tid >> 2, grp = tid & 3, pos = n * 128 + s;
              const bf16* rq = H0 + (t0 + s) * AB_IN + 512 + h * 64 + 8 * grp; const bf16* rk = H0 + (t0 + s) * AB_IN + 768 + h * 64 + 8 * grp;
              float q1[8], q2[8], k1[8], k2[8], cs[8], sn[8];
              unpack8(*(const GAS v4u*)rq, q1); unpack8(*(const GAS v4u*)(rq + 32), q2); unpack8(*(const GAS v4u*)rk, k1); unpack8(*(const GAS v4u*)(rk + 32), k2);
              { const f32x4 a = *(const GAS f32x4*)(ct + pos * 32 + 8 * grp), bq = *(const GAS f32x4*)(ct + pos * 32 + 8 * grp + 4);
                cs[0] = a.x; cs[1] = a.y; cs[2] = a.z; cs[3] = a.w; cs[4] = bq.x; cs[5] = bq.y; cs[6] = bq.z; cs[7] = bq.w; }
              { const f32x4 a = *(const GAS f32x4*)(st + pos * 32 + 8 * grp), bq = *(const GAS f32x4*)(st + pos * 32 + 8 * grp + 4);
                sn[0] = a.x; sn[1] = a.y; sn[2] = a.z; sn[3] = a.w; sn[4] = bq.x; sn[5] = bq.y; sn[6] = bq.z; sn[7] = bq.w; }
              const float gq = exp2f((float)(s + 1) * lg), gk = 0.125f * exp2f(-(float)(s + 1) * lg);
              float qa[8], qb[8], ka[8], kb[8];
#pragma unroll
              for (int j = 0; j < 8; ++j) { qa[j] = (q1[j] * cs[j] - q2[j] * sn[j]) * gq; qb[j] = (q2[j] * cs[j] + q1[j] * sn[j]) * gq;
                                            ka[j] = (k1[j] * cs[j] - k2[j] * sn[j]) * gk; kb[j] = (k2[j] * cs[j] + k1[j] * sn[j]) * gk; }
              *(LAS v4u*)(lds + O_QP + s * 144 + 16 * grp) = pack8(qa); *(LAS v4u*)(lds + O_QP + s * 144 + 64 + 16 * grp) = pack8(qb);
              *(LAS v4u*)(lds + O_KP + s * 144 + 16 * grp) = pack8(ka); *(LAS v4u*)(lds + O_KP + s * 144 + 64 + 16 * grp) = pack8(kb); }
#pragma unroll
            for (int i = 0; i < 4; ++i) { const int task = tid + 512 * i, e8 = task >> 7, s = task & 127;
                const v4u w = *(const GAS v4u*)(H0 + (t0 + s) * AB_IN + 1024 + h * 128 + 8 * e8);
                LAS bf16* d = (LAS bf16*)(lds + O_VT + (8 * e8) * 272 + 2 * s);
                d[0 * 136] = (bf16)(w.x & 0xffffu); d[1 * 136] = (bf16)(w.x >> 16); d[2 * 136] = (bf16)(w.y & 0xffffu); d[3 * 136] = (bf16)(w.y >> 16);
                d[4 * 136] = (bf16)(w.z & 0xffffu); d[5 * 136] = (bf16)(w.z >> 16); d[6 * 136] = (bf16)(w.w & 0xffffu); d[7 * 136] = (bf16)(w.w >> 16); }
            { const float* Sg = LST + (size_t)((b * 4 + h) * 32 + n) * 8192;
#pragma unroll
              for (int i = 0; i < 4; ++i) { const int task = tid + 512 * i, e4 = task >> 6, d = task & 63;
                  const f32x4 sv = *(const GAS f32x4*)(Sg + d * 128 + 4 * e4);
                  LAS bf16* o = (LAS bf16*)(lds + O_ST + (4 * e4) * 144 + 2 * d);
                  o[0 * 72] = (bf16)f2bf(sv.x); o[1 * 72] = (bf16)f2bf(sv.y); o[2 * 72] = (bf16)f2bf(sv.z); o[3 * 72] = (bf16)f2bf(sv.w); } }
            __syncthreads();
            bf16x8 qf[4];
#pragma unroll
            for (int ks = 0; ks < 4; ++ks) qf[ks] = *(const LAS bf16x8*)(lds + O_QP + (32 * cbk + c) * 144 + (16 * ks + 8 * hh) * 2);
            for (int sb = 0; sb <= cbk; ++sb) {
                f32x16 sc;
#pragma unroll
                for (int r = 0; r < 16; ++r) sc[r] = 0.f;
#pragma unroll
                for (int ks = 0; ks < 4; ++ks) { const bf16x8 kf = *(const LAS bf16x8*)(lds + O_KP + (32 * sb + c) * 144 + (16 * ks + 8 * hh) * 2);
                    sc = __builtin_amdgcn_mfma_f32_32x32x16_bf16(kf, qf[ks], sc, 0, 0, 0); }
#pragma unroll
                for (int g4 = 0; g4 < 4; ++g4) { float m[4];
#pragma unroll
                    for (int q = 0; q < 4; ++q) { const float sv = sc[4 * g4 + q]; m[q] = (sb < cbk || 8 * g4 + 4 * hh + q <= c) ? sv : 0.f; }
                    *(LAS v2u*)(lds + O_PI + cbk * 8704 + c * 272 + (32 * sb + 8 * g4 + 4 * hh) * 2) = (v2u){pk2(m[0], m[1]), pk2(m[2], m[3])}; }
            }
            f32x16 acc[2];
#pragma unroll
            for (int j = 0; j < 2; ++j) {
#pragma unroll
                for (int r = 0; r < 16; ++r) acc[j][r] = 0.f;
                const int eb = 2 * eh + j;
                for (int sb = 0; sb <= cbk; ++sb) {
#pragma unroll
                    for (int ks = 0; ks < 2; ++ks) { const bf16x8 af = *(const LAS bf16x8*)(lds + O_VT + (32 * eb + c) * 272 + (32 * sb + 16 * ks + 8 * hh) * 2);
                        const bf16x8 pf = *(const LAS bf16x8*)(lds + O_PI + cbk * 8704 + c * 272 + (32 * sb + 16 * ks + 8 * hh) * 2);
                        acc[j] = __builtin_amdgcn_mfma_f32_32x32x16_bf16(af, pf, acc[j], 0, 0, 0); }
                }
#pragma unroll
                for (int ks = 0; ks < 4; ++ks) { const bf16x8 sf = *(const LAS bf16x8*)(lds + O_ST + (32 * eb + c) * 144 + (16 * ks + 8 * hh) * 2);
                    acc[j] = __builtin_amdgcn_mfma_f32_32x32x16_bf16(sf, qf[ks], acc[j], 0, 0, 0); }
            }
            float sum = 0.f, sq = 0.f;
#pragma unroll
            for (int j = 0; j < 2; ++j)
#pragma unroll
                for (int r = 0; r < 16; ++r) { const float ov = acc[j][r]; sum += ov; sq += ov * ov; }
            sum += __shfl_xor(sum, 32); sq += __shfl_xor(sq, 32);
            LAS float* red = (LAS float*)(lds + O_RED);
            if (hh == 0) { red[(eh * 128 + 32 * cbk + c) * 2] = sum; red[(eh * 128 + 32 * cbk + c) * 2 + 1] = sq; }
            __syncthreads();
            sum += red[((eh ^ 1) * 128 + 32 * cbk + c) * 2]; sq += red[((eh ^ 1) * 128 + 32 * cbk + c) * 2 + 1];
            const float mean = sum * (1.f / 128.f); const float var = fmaxf(sq * (1.f / 128.f) - mean * mean, 0.f);
            const float rstd = 1.f / sqrtf(var + LN_EPS);
            { const size_t row = t0 + 32 * cbk + c;
#pragma unroll
              for (int j = 0; j < 2; ++j)
#pragma unroll
                  for (int g4 = 0; g4 < 4; ++g4) { const int e = 32 * (2 * eh + j) + 8 * g4 + 4 * hh;
                      const v2u gw2 = *(const GAS v2u*)(H0 + row * AB_IN + 1536 + h * 128 + e); const f32x4 gm = *(const GAS f32x4*)(ret_g + h * 128 + e);
                      const float g0 = bflo(gw2.x), g1 = bfhi(gw2.x), g2 = bflo(gw2.y), g3 = bfhi(gw2.y);
                      const float o0 = acc[j][4 * g4 + 0], o1 = acc[j][4 * g4 + 1], o2 = acc[j][4 * g4 + 2], o3 = acc[j][4 * g4 + 3];
                      const float y0 = (o0 - mean) * rstd * gm.x * (g0 / (1.f + __expf(-g0))), y1 = (o1 - mean) * rstd * gm.y * (g1 / (1.f + __expf(-g1)));
                      const float y2 = (o2 - mean) * rstd * gm.z * (g2 / (1.f + __expf(-g2))), y3 = (o3 - mean) * rstd * gm.w * (g3 / (1.f + __expf(-g3)));
                      *(GAS v2u*)(Y + row * D + 512 + h * 128 + e) = (v2u){pk2(y0, y1), pk2(y2, y3)}; } }
        }
        for (int gi = 0; gi < 4; ++gi) {
            const int w = 2 << gi;
            __syncthreads();
#pragma unroll
            for (int i = 0; i < 4; ++i) { const int task = tid + 512 * i, t = task >> 4, c8 = task & 15, pos = n * 128 + t; const int cnt = (pos + 1 < w) ? pos + 1 : w;
                const bf16* ur = H0 + (t0 + t) * AB_IN + gi * 128 + 8 * c8;
                float u0[8], sm[8]; unpack8(*(const GAS v4u*)ur, u0);
#pragma unroll
                for (int q = 0; q < 8; ++q) sm[q] = u0[q];
                for (int j = 1; j < cnt; ++j) { float uj[8]; unpack8(*(const GAS v4u*)(ur - (size_t)j * AB_IN), uj);
#pragma unroll
                    for (int q = 0; q < 8; ++q) sm[q] += uj[q]; }
                const float ic = 1.f / (float)cnt; float pv[8];
#pragma unroll
                for (int q = 0; q < 8; ++q) pv[q] = sm[q] * ic - u0[q];
                *(LAS v4u*)(lds + O_PT + t * 272 + 16 * c8) = pack8(pv); }
#pragma unroll
            for (int i = 0; i < 4; ++i) { const int piece = tid + 512 * i, d = piece >> 4, c16 = piece & 15;
                *(LAS v4u*)(lds + O_WT + d * 272 + 16 * c16) = *(const GAS v4u*)(PWT + (size_t)(gi * 128 + d) * 128 + 8 * c16); }
            __syncthreads();
            bf16x8 pfr[8];
#pragma unroll
            for (int ks = 0; ks < 8; ++ks) pfr[ks] = *(const LAS bf16x8*)(lds + O_PT + (32 * cbk + c) * 272 + (16 * ks + 8 * hh) * 2);
#pragma unroll
            for (int j = 0; j < 2; ++j) { const int db = 2 * eh + j;
                f32x16 a2;
#pragma unroll
                for (int r = 0; r < 16; ++r) a2[r] = 0.f;
#pragma unroll
                for (int ks = 0; ks < 8; ++ks) { const bf16x8 wf = *(const LAS bf16x8*)(lds + O_WT + (32 * db + c) * 272 + (16 * ks + 8 * hh) * 2);
                    a2 = __builtin_amdgcn_mfma_f32_32x32x16_bf16(wf, pfr[ks], a2, 0, 0, 0); }
#pragma unroll
                for (int g4 = 0; g4 < 4; ++g4) { const int d0 = 32 * db + 8 * g4 + 4 * hh; const f32x4 ps = *(const GAS f32x4*)(pool_scale + gi * 128 + d0);
                    const float y0 = a2[4 * g4 + 0] * ps.x, y1 = a2[4 * g4 + 1] * ps.y, y2 = a2[4 * g4 + 2] * ps.z, y3 = a2[4 * g4 + 3] * ps.w;
                    *(GAS v2u*)(Y + (t0 + 32 * cbk + c) * D + gi * 128 + d0) = (v2u){pk2(y0, y1), pk2(y2, y3)}; }
            }
        }
    }
    __syncthreads();
}
__device__ __forceinline__ void phase_ln(const float* Z, bf16* O, const float* g, const float* bb) {
    const int tid = threadIdx.x, lane = tid & 63, wave = tid >> 6;
    const int gw = blockIdx.x * NWAVES + wave, NGW = gridDim.x * NWAVES;
    for (int m = gw; m < T; m += NGW) {
        const GAS f32x4* zr = (const GAS f32x4*)(Z + (size_t)m * D) + lane;
        f32x4 v[4]; float s = 0.f;
#pragma unroll
        for (int j = 0; j < 4; ++j) { v[j] = zr[64 * j]; s += (v[j].x + v[j].y) + (v[j].z + v[j].w); }
        const float mean = wave_sum(s) * (1.f / D); float s2 = 0.f;
#pragma unroll
        for (int j = 0; j < 4; ++j) { v[j] = v[j] - mean; s2 += (v[j].x * v[j].x + v[j].y * v[j].y) + (v[j].z * v[j].z + v[j].w * v[j].w); }
        const float rstd = 1.f / sqrtf(wave_sum(s2) * (1.f / D) + LN_EPS);
        GAS v2u* o8 = (GAS v2u*)(O + (size_t)m * D) + lane;
#pragma unroll
        for (int j = 0; j < 4; ++j) { const f32x4 gg = *((const GAS f32x4*)g + lane + 64 * j), b4 = *((const GAS f32x4*)bb + lane + 64 * j);
            v2u o; o.x = pk2(v[j].x * rstd * gg.x + b4.x, v[j].y * rstd * gg.y + b4.y); o.y = pk2(v[j].z * rstd * gg.z + b4.z, v[j].w * rstd * gg.w + b4.w); o8[64 * j] = o; }
    }
}
__device__ __forceinline__ void wave_argmax(float& bv, int& bi) {
#pragma unroll
    for (int off = 32; off >= 1; off >>= 1) { const float ov = __shfl_xor(bv, off); const int oi = __shfl_xor(bi, off);
        if (ov > bv || (ov == bv && oi < bi)) { bv = ov; bi = oi; } }
}
__device__ __forceinline__ void phase_topk(LAS unsigned char* lds, const bf16* Q, const float* keys  , int* EID, float* GATE) {
    const int tid = threadIdx.x, lane = tid & 63, wave = tid >> 6;
    LAS float* kl = (LAS float*)lds;
    LAS float* qt = (LAS float*)(lds + 66048);
    LAS float* sc = (LAS float*)(lds + 82560);
    for (int item = blockIdx.x; item < (T / 32) * 8; item += gridDim.x) {
        const int h = item & 7, tile = item >> 3; const size_t tok0 = (size_t)tile * 32;
        for (int p = 0; p < 2; ++p) {
            const float* kg = keys + (size_t)((h * 2 + p) * 128) * 128;
            for (int idx = tid; idx < 16384; idx += NTHR) { const int k = idx >> 7, d = idx & 127; kl[k * 129 + d] = kg[idx]; }
            for (int idx = tid; idx < 4096; idx += NTHR) { const int t = idx >> 7, d = idx & 127; qt[t * 129 + d] = bf2f(Q[(tok0 + t) * 2048 + h * 256 + p * 128 + d]); }
            __syncthreads();
            { const int t = tid >> 4, kg16 = tid & 15;
              for (int jj = 0; jj < 8; ++jj) { const int k = kg16 + 16 * jj; float dot = 0.f;
#pragma unroll 16
                  for (int d = 0; d < 128; ++d) dot += qt[t * 129 + d] * kl[k * 129 + d];
                  sc[(t * 2 + p) * 128 + k] = dot; } }
            __syncthreads();
        }
        for (int tt = 0; tt < 4; ++tt) {
            const int t = wave * 4 + tt;
            float tv[2]; int ti[2];
#pragma unroll
            for (int p = 0; p < 2; ++p) {
                float v0 = sc[(t * 2 + p) * 128 + lane], v1 = sc[(t * 2 + p) * 128 + lane + 64];
                float mv = 0.f; int mi = 0;
                for (int j = 0; j < 16; ++j) {
                    float bv; int bi; if (v0 >= v1) { bv = v0; bi = lane; } else { bv = v1; bi = lane + 64; }
                    wave_argmax(bv, bi);
                    if (lane == j) { mv = bv; mi = bi; }
                    if (bi == lane) v0 = -INFINITY; if (bi == lane + 64) v1 = -INFINITY;
                }
                tv[p] = mv; ti[p] = mi;
            }
            float cv[4];
#pragma unroll
            for (int m = 0; m < 4; ++m) { const int cidx = lane + 64 * m; cv[m] = __shfl(tv[0], cidx >> 4) + __shfl(tv[1], cidx & 15); }
            float bestv = 0.f; int bestc = 0;
            for (int j = 0; j < 16; ++j) {
                float bv = cv[0]; int bi = lane;
#pragma unroll
                for (int m = 1; m < 4; ++m) if (cv[m] > bv) { bv = cv[m]; bi = lane + 64 * m; }
                wave_argmax(bv, bi);
                if (lane == j) { bestv = bv; bestc = bi; }
#pragma unroll
                for (int m = 0; m < 4; ++m) if (bi == lane + 64 * m) cv[m] = -INFINITY;
            }
            const float mx = __shfl(bestv, 0);
            const float ex = (lane < 16) ? expf(bestv - mx) : 0.f;
            const float den = wave_sum(ex);
            const int ia = __shfl(ti[0], bestc >> 4), ib = __shfl(ti[1], bestc & 15);
            if (lane < 16) { const size_t o = (tok0 + t) * 128 + h * 16 + lane; EID[o] = ia * 128 + ib; GATE[o] = ex / den; }
        }
        __syncthreads();
    }
}

#define CEF_D(a, b) { const float hi_ = fmaxf((a), (b)), lo_ = fminf((a), (b)); (a) = hi_; (b) = lo_; }
#define CEF_A(a, b) { const float hi_ = fmaxf((a), (b)), lo_ = fminf((a), (b)); (a) = lo_; (b) = hi_; }
#define CEP_D(ka, pa, kb, pb) { const bool sw_ = (kb) > (ka); const float k0_ = sw_ ? (kb) : (ka), k1_ = sw_ ? (ka) : (kb); const int p0_ = sw_ ? (pb) : (pa), p1_ = sw_ ? (pa) : (pb); (ka) = k0_; (kb) = k1_; (pa) = p0_; (pb) = p1_; }
template <int OFF, int NV> __device__ __forceinline__ void bsort16_desc(float (&v)[NV]) {
#pragma unroll
    for (int k = 2; k <= 16; k <<= 1) {
#pragma unroll
        for (int j = k >> 1; j > 0; j >>= 1) {
#pragma unroll
            for (int i = 0; i < 16; ++i) { const int l = i ^ j;
                if (l > i) { if ((i & k) == 0) CEF_D(v[OFF + i], v[OFF + l]) else CEF_A(v[OFF + i], v[OFF + l]) } }
        }
    }
}
template <int OA, int NV> __device__ __forceinline__ void bmerge16_desc(float (&v)[NV]) {
#pragma unroll
    for (int j = 8; j > 0; j >>= 1) {
#pragma unroll
        for (int i = 0; i < 16; ++i) { const int l = i ^ j; if (l > i) CEF_D(v[OA + i], v[OA + l]) }
    }
}
template <int OA, int OB, int NV> __device__ __forceinline__ void merge_top16(float (&v)[NV]) {
#pragma unroll
    for (int i = 0; i < 16; ++i) v[OA + i] = fmaxf(v[OA + i], v[OB + 15 - i]);
    bmerge16_desc<OA, NV>(v);
}
template <int OFF, int NV> __device__ __forceinline__ void bsort16p_desc(float (&v)[NV], int (&q)[NV]) {
#pragma unroll
    for (int k = 2; k <= 16; k <<= 1) {
#pragma unroll
        for (int j = k >> 1; j > 0; j >>= 1) {
#pragma unroll
            for (int i = 0; i < 16; ++i) { const int l = i ^ j;
                if (l > i) { if ((i & k) == 0) CEP_D(v[OFF + i], q[OFF + i], v[OFF + l], q[OFF + l]) else CEP_D(v[OFF + l], q[OFF + l], v[OFF + i], q[OFF + i]) } }
        }
    }
}
template <int OA, int NV> __device__ __forceinline__ void bmerge16p_desc(float (&v)[NV], int (&q)[NV]) {
#pragma unroll
    for (int j = 8; j > 0; j >>= 1) {
#pragma unroll
        for (int i = 0; i < 16; ++i) { const int l = i ^ j; if (l > i) CEP_D(v[OA + i], q[OA + i], v[OA + l], q[OA + l]) }
    }
}
__host__ __device__ constexpr int pair_i(int s) { return s < 16 ? 0 : s < 24 ? 1 : s < 29 ? 2 : s < 33 ? 3 : s < 36 ? 4 : s < 38 ? 5 : s < 40 ? 6 : s < 42 ? 7 : (s - 42 + 8); }
__host__ __device__ constexpr int pair_j(int s) { return s < 16 ? s : s < 24 ? s - 16 : s < 29 ? s - 24 : s < 33 ? s - 29 : s < 36 ? s - 33 : s < 38 ? s - 36 : s < 40 ? s - 38 : s < 42 ? s - 40 : 0; }
__device__ __forceinline__ void phase_topk_fast(LAS unsigned char* lds, const bf16* Q, const bf16* keysb  , int* EID, float* GATE) {
    const int tid = threadIdx.x, lane = tid & 63, wave = __builtin_amdgcn_readfirstlane(tid >> 6);
    const int c = lane & 31, hh = lane >> 5;
    for (int hi = blockIdx.x; hi < 256; hi += gridDim.x) {
        const int h = hi & 7, rank = hi >> 3;
        __syncthreads();
        for (int idx = tid; idx < 2 * 128 * 16; idx += NTHR) { const int rowi = idx >> 4, ch = idx & 15;
            const v4u kv = *(const GAS v4u*)(keysb + (size_t)h * 32768 + rowi * 128 + ch * 8);
            *(LAS v4u*)(lds + rowi * 272 + ch * 16) = kv; }
        __syncthreads();
        for (int it = 0; it < 4; ++it) {
            const int tile = rank * 8 + wave + 256 * it;
            const size_t tok0 = (size_t)tile * 32;
            float ta[16], tb[16];
#pragma unroll
            for (int p = 0; p < 2; ++p) {
                bf16x8 bq[8];
                const bf16* qrow = Q + (tok0 + c) * 2048 + h * 256 + p * 128 + 8 * hh;
#pragma unroll
                for (int ks = 0; ks < 8; ++ks) bq[ks] = *(const GAS bf16x8*)(qrow + 16 * ks);
                f32x16 acc[4];
#pragma unroll
                for (int blk = 0; blk < 4; ++blk) {
#pragma unroll
                    for (int r = 0; r < 16; ++r) acc[blk][r] = 0.f;
#pragma unroll
                    for (int ks = 0; ks < 8; ++ks) { const bf16x8 a = *(const LAS bf16x8*)(lds + (p * 128 + 32 * blk + c) * 272 + (16 * ks + 8 * hh) * 2);
                        acc[blk] = __builtin_amdgcn_mfma_f32_32x32x16_bf16(a, bq[ks], acc[blk], 0, 0, 0); }
                }
                float v[64];
#pragma unroll
                for (int blk = 0; blk < 4; ++blk)
#pragma unroll
                    for (int r = 0; r < 16; ++r)
                    { const float sv = acc[blk][r]; v[blk * 16 + r] = __uint_as_float((__float_as_uint(sv) & ~127u) | (unsigned)(32 * blk + (r & 3) + 8 * (r >> 2)) | (unsigned)(hh << 2)); }
                __builtin_amdgcn_sched_barrier(0);
                bsort16_desc<0, 64>(v); bsort16_desc<16, 64>(v); bsort16_desc<32, 64>(v); bsort16_desc<48, 64>(v);
                merge_top16<0, 16, 64>(v); merge_top16<32, 48, 64>(v); merge_top16<0, 32, 64>(v);
                float o[16];
#pragma unroll
                for (int i = 0; i < 16; ++i) o[i] = __shfl_xor(v[i], 32);
#pragma unroll
                for (int i = 0; i < 16; ++i) v[i] = fmaxf(v[i], o[15 - i]);
                bmerge16_desc<0, 64>(v);
#pragma unroll
                for (int i = 0; i < 16; ++i) { if (p == 0) ta[i] = v[i]; else tb[i] = v[i]; }
                __builtin_amdgcn_sched_barrier(0);
            }
            float av[16], bv[16]; int ai[16], bi[16];
#pragma unroll
            for (int i = 0; i < 16; ++i) { const unsigned ua = __builtin_bit_cast(unsigned, ta[i]), ub = __builtin_bit_cast(unsigned, tb[i]);
                av[i] = __builtin_bit_cast(float, ua & ~127u); ai[i] = (int)(ua & 127u); bv[i] = __builtin_bit_cast(float, ub & ~127u); bi[i] = (int)(ub & 127u); }
            float ck[32]; int cp[32];
#pragma unroll
            for (int s2 = 0; s2 < 32; ++s2) {
                const float k0 = av[pair_i(s2)] + bv[pair_j(s2)]; const int p0 = (ai[pair_i(s2)] << 7) | bi[pair_j(s2)];
                float k1 = -INFINITY; int p1 = 0;
                if (s2 + 32 < 50) { k1 = av[pair_i(s2 + 32 < 50 ? s2 + 32 : 0)] + bv[pair_j(s2 + 32 < 50 ? s2 + 32 : 0)]; p1 = (ai[pair_i(s2 + 32 < 50 ? s2 + 32 : 0)] << 7) | bi[pair_j(s2 + 32 < 50 ? s2 + 32 : 0)]; }
                ck[s2] = hh ? k1 : k0; cp[s2] = hh ? p1 : p0;
            }
            __builtin_amdgcn_sched_barrier(0);
            bsort16p_desc<0, 32>(ck, cp); bsort16p_desc<16, 32>(ck, cp);
#pragma unroll
            for (int i = 0; i < 16; ++i) { if (ck[16 + 15 - i] > ck[i]) { ck[i] = ck[16 + 15 - i]; cp[i] = cp[16 + 15 - i]; } }
            bmerge16p_desc<0, 32>(ck, cp);
            { float ok[16]; int op[16];
#pragma unroll
              for (int i = 0; i < 16; ++i) { ok[i] = __shfl_xor(ck[i], 32); op[i] = __shfl_xor(cp[i], 32); }
#pragma unroll
              for (int i = 0; i < 16; ++i) { if (ok[15 - i] > ck[i]) { ck[i] = ok[15 - i]; cp[i] = op[15 - i]; } } }
            bmerge16p_desc<0, 32>(ck, cp);
            float ex[16]; float sum = 0.f;
#pragma unroll
            for (int i = 0; i < 16; ++i) { ex[i] = __expf(ck[i] - ck[0]); sum += ex[i]; }
            const float inv = 1.f / sum;
            if (hh == 0) {
                int* eo = EID + (tok0 + c) * 128 + h * 16; float* go = GATE + (tok0 + c) * 128 + h * 16;
#pragma unroll
                for (int i = 0; i < 4; ++i) { *(GAS v4u*)(eo + 4 * i) = (v4u){(unsigned)cp[4 * i], (unsigned)cp[4 * i + 1], (unsigned)cp[4 * i + 2], (unsigned)cp[4 * i + 3]};
                    *(GAS f32x4*)(go + 4 * i) = (f32x4){ex[4 * i] * inv, ex[4 * i + 1] * inv, ex[4 * i + 2] * inv, ex[4 * i + 3] * inv}; }
            }
        }
    }
    __syncthreads();
}
template <bool FINAL>
__device__ __forceinline__ void phase_gather(const bf16* X, const int* EID, const float* GATE, const float* U, const float* V, const float* g, const float* bb, bf16* Ob, float* Of) {
    const int tid = threadIdx.x, lane = tid & 63, wave = tid >> 6;
    const int gw = blockIdx.x * NWAVES + wave, NGW = gridDim.x * NWAVES;
    for (int t = gw; t < T; t += NGW) {
        f32x4 x[4], acc[4];
#pragma unroll
        for (int j = 0; j < 4; ++j) { const v2u w = *((const GAS v2u*)(X + (size_t)t * D) + lane + 64 * j);
            x[j] = (f32x4){bflo(w.x), bfhi(w.x), bflo(w.y), bfhi(w.y)}; acc[j] = (f32x4){0.f, 0.f, 0.f, 0.f}; }
        const int e0 = EID[(size_t)t * 128 + lane], e1 = EID[(size_t)t * 128 + 64 + lane];
        const float g0 = GATE[(size_t)t * 128 + lane], g1 = GATE[(size_t)t * 128 + 64 + lane];
#pragma unroll 2
        for (int k = 0; k < 128; ++k) {
            const int e = (k < 64) ? __shfl(e0, k) : __shfl(e1, k - 64);
            const float gt = (k < 64) ? __shfl(g0, k) : __shfl(g1, k - 64);
            const GAS f32x4* ur = (const GAS f32x4*)(U + (size_t)e * D) + lane;
            float dot = 0.f;
#pragma unroll
            for (int j = 0; j < 4; ++j) { const f32x4 u = ur[64 * j]; dot += (x[j].x * u.x + x[j].y * u.y) + (x[j].z * u.z + x[j].w * u.w); }
            dot = wave_sum(dot);
            const float a = 0.5f * dot * (1.f + erff(dot * 0.70710678118654752f));
            const float cf = gt * a;
            const GAS f32x4* vr = (const GAS f32x4*)(V + (size_t)e * D) + lane;
#pragma unroll
            for (int j = 0; j < 4; ++j) { const f32x4 v = vr[64 * j]; acc[j] += cf * v; }
        }
        float s = 0.f;
#pragma unroll
        for (int j = 0; j < 4; ++j) { acc[j] = ALPHA * x[j] + acc[j]; s += (acc[j].x + acc[j].y) + (acc[j].z + acc[j].w); }
        const float mean = wave_sum(s) * (1.f / D); float s2 = 0.f;
#pragma unroll
        for (int j = 0; j < 4; ++j) { acc[j] = acc[j] - mean; s2 += (acc[j].x * acc[j].x + acc[j].y * acc[j].y) + (acc[j].z * acc[j].z + acc[j].w * acc[j].w); }
        const float rstd = 1.f / sqrtf(wave_sum(s2) * (1.f / D) + LN_EPS);
#pragma unroll
        for (int j = 0; j < 4; ++j) { const f32x4 gg = *((const GAS f32x4*)g + lane + 64 * j), b4 = *((const GAS f32x4*)bb + lane + 64 * j);
            const f32x4 o = acc[j] * rstd * gg + b4;
            if (FINAL) *((GAS f32x4*)(Of + (size_t)t * D) + lane + 64 * j) = o;
            else { v2u w; w.x = pk2(o.x, o.y); w.y = pk2(o.z, o.w); *((GAS v2u*)(Ob + (size_t)t * D) + lane + 64 * j) = w; } }
    }
}

typedef float f32x2 __attribute__((ext_vector_type(2)));
__device__ __forceinline__ void phase_convert_tables(const float* U, const float* V, unsigned char* ws) {
    const int tid = threadIdx.x, lane = tid & 63, wave = tid >> 6;
    const int gw = blockIdx.x * NWAVES + wave, NGW = gridDim.x * NWAVES;
    for (int row = gw; row < 4 * NEXP; row += NGW) {
        const bool isv = row >= 2 * NEXP; const int r = row & (2 * NEXP - 1);
        const GAS f32x4* src = (const GAS f32x4*)((isv ? V : U) + (size_t)r * D) + 4 * lane; const int sstep = 1;
        f32x4 v[4]; float m = 0.f;
#pragma unroll
        for (int j = 0; j < 4; ++j) { v[j] = src[sstep * j]; m = fmaxf(fmaxf(m, fmaxf(fabsf(v[j].x), fabsf(v[j].y))), fmaxf(fabsf(v[j].z), fabsf(v[j].w))); }
#pragma unroll
        for (int o = 1; o < 64; o <<= 1) m = fmaxf(m, __shfl_xor(m, o));
        m = fmaxf(m, 1e-30f);
        const float sc = 7.f / m;
        unsigned w0 = 0u, w1 = 0u;
#define Q4(x) fminf(fmaxf((x) * sc, -6.f), 6.f)
        w0 = __builtin_amdgcn_cvt_scalef32_pk_fp4_f32(w0, Q4(v[0].x), Q4(v[0].y), 1.0f, 0); w0 = __builtin_amdgcn_cvt_scalef32_pk_fp4_f32(w0, Q4(v[0].z), Q4(v[0].w), 1.0f, 1);
        w0 = __builtin_amdgcn_cvt_scalef32_pk_fp4_f32(w0, Q4(v[1].x), Q4(v[1].y), 1.0f, 2); w0 = __builtin_amdgcn_cvt_scalef32_pk_fp4_f32(w0, Q4(v[1].z), Q4(v[1].w), 1.0f, 3);
        w1 = __builtin_amdgcn_cvt_scalef32_pk_fp4_f32(w1, Q4(v[2].x), Q4(v[2].y), 1.0f, 0); w1 = __builtin_amdgcn_cvt_scalef32_pk_fp4_f32(w1, Q4(v[2].z), Q4(v[2].w), 1.0f, 1);
        w1 = __builtin_amdgcn_cvt_scalef32_pk_fp4_f32(w1, Q4(v[3].x), Q4(v[3].y), 1.0f, 2); w1 = __builtin_amdgcn_cvt_scalef32_pk_fp4_f32(w1, Q4(v[3].z), Q4(v[3].w), 1.0f, 3);
#undef Q4
        *((GAS v2u*)(ws + (isv ? WS_V8 : WS_U8) + (size_t)r * 512) + lane) = (v2u){w0, w1};
        if (lane == 0) ((float*)(ws + (isv ? WS_DQV : WS_DQU)))[r] = m * (1.f / 7.f);
    }
}
__host__ __device__ constexpr int rev4(int i) { return ((i & 1) << 3) | ((i & 2) << 1) | ((i & 4) >> 1) | ((i & 8) >> 3); }
#define FMA2(a, b, c) __builtin_elementwise_fma((a), (b), (c))
#define CVT8(w, hi) __builtin_amdgcn_cvt_pk_f32_fp8((int)(w), (hi))
template <bool FINAL, int MODE  >
__device__ __forceinline__ void phase_gather8(const bf16* X, const int* EID, float* GATE, const unsigned char* U8, const unsigned char* V8, const float* DQU, const float* DQV,
                                              const float* g, const float* bb, bf16* Ob, float* Of) {
    const int tid = threadIdx.x, lane = tid & 63, wave = tid >> 6;
    const int gw = blockIdx.x * NWAVES + wave, NGW = gridDim.x * NWAVES;
    const bool b0 = (lane & 1) != 0, b1 = (lane & 2) != 0, b2 = (lane & 4) != 0, b3 = (lane & 8) != 0; const int myrow = lane >> 4;
    for (int t = gw; t < T; t += NGW) {
        f32x2 x[8];
#pragma unroll
        for (int j = 0; j < 4; ++j) { const v2u w = *((const GAS v2u*)(X + (size_t)t * D) + lane + 64 * j);
            x[2 * j] = (f32x2){bflo(w.x), bfhi(w.x)}; x[2 * j + 1] = (f32x2){bflo(w.y), bfhi(w.y)}; }
        const int e0 = EID[(size_t)t * 128 + lane], e1 = EID[(size_t)t * 128 + 64 + lane];
        const float gt0 = GATE[(size_t)t * 128 + lane], gt1 = GATE[(size_t)t * 128 + 64 + lane];
        const float dqu0 = DQU[e0], dqu1 = DQU[e1], dqv0 = DQV[e0], dqv1 = DQV[e1];
        float act0 = 0.f, act1 = 0.f;
        if (MODE != 2) {
#pragma unroll
        for (int r = 0; r < 2; ++r) {
            const int er = r ? e1 : e0;
            for (int row = 0; row < 4; ++row) {
                v4u w[16];
#pragma unroll
                for (int i = 0; i < 16; ++i) { const int e = __builtin_amdgcn_readlane(er, row * 16 + rev4(i)); w[i] = *((const GAS v4u*)(U8 + (size_t)e * 1024) + lane); }
                float p[16];
#pragma unroll
                for (int i = 0; i < 16; ++i) { f32x2 a = (f32x2){0.f, 0.f};
                    a = FMA2(x[0], CVT8(w[i].x, false), a); a = FMA2(x[1], CVT8(w[i].x, true), a);
                    a = FMA2(x[2], CVT8(w[i].y, false), a); a = FMA2(x[3], CVT8(w[i].y, true), a);
                    a = FMA2(x[4], CVT8(w[i].z, false), a); a = FMA2(x[5], CVT8(w[i].z, true), a);
                    a = FMA2(x[6], CVT8(w[i].w, false), a); a = FMA2(x[7], CVT8(w[i].w, true), a);
                    p[i] = a.x + a.y; }
                float r8[8], r4[4], r2[2];
#pragma unroll
                for (int i = 0; i < 8; ++i) { const float keep = b0 ? p[8 + i] : p[i], send = b0 ? p[i] : p[8 + i]; r8[i] = keep + __shfl_xor(send, 1); }
#pragma unroll
                for (int i = 0; i < 4; ++i) { const float keep = b1 ? r8[4 + i] : r8[i], send = b1 ? r8[i] : r8[4 + i]; r4[i] = keep + __shfl_xor(send, 2); }
#pragma unroll
                for (int i = 0; i < 2; ++i) { const float keep = b2 ? r4[2 + i] : r4[i], send = b2 ? r4[i] : r4[2 + i]; r2[i] = keep + __shfl_xor(send, 4); }
                float r1 = (b3 ? r2[1] : r2[0]) + __shfl_xor(b3 ? r2[0] : r2[1], 8);
                r1 += __shfl_xor(r1, 16); r1 += __shfl_xor(r1, 32);
                if (myrow == row) { if (r == 0) act0 = r1; else act1 = r1; }
            }
        }
        }
        float c0, c1;
        if (MODE != 2) { const float a0 = act0 * dqu0, a1 = act1 * dqu1;
          c0 = gt0 * (0.5f * a0 * (1.f + erff(a0 * 0.70710678118654752f))) * dqv0;
          c1 = gt1 * (0.5f * a1 * (1.f + erff(a1 * 0.70710678118654752f))) * dqv1; }
        else { c0 = gt0; c1 = gt1; }
        if (MODE == 1) { GATE[(size_t)t * 128 + lane] = c0; GATE[(size_t)t * 128 + 64 + lane] = c1; continue; }
        f32x2 acc[8];
#pragma unroll
        for (int j = 0; j < 8; ++j) acc[j] = (f32x2){0.f, 0.f};
#pragma unroll
        for (int r = 0; r < 2; ++r) {
            const int er = r ? e1 : e0; const int cr = __builtin_bit_cast(int, r ? c1 : c0);
            for (int row = 0; row < 4; ++row) {
                v4u w[16];
#pragma unroll
                for (int i = 0; i < 16; ++i) { const int e = __builtin_amdgcn_readlane(er, row * 16 + i); w[i] = *((const GAS v4u*)(V8 + (size_t)e * 1024) + lane); }
#pragma unroll
                for (int i = 0; i < 16; ++i) { const float cf = __builtin_bit_cast(float, __builtin_amdgcn_readlane(cr, row * 16 + i)); const f32x2 c2 = (f32x2){cf, cf};
                    acc[0] = FMA2(c2, CVT8(w[i].x, false), acc[0]); acc[1] = FMA2(c2, CVT8(w[i].x, true), acc[1]);
                    acc[2] = FMA2(c2, CVT8(w[i].y, false), acc[2]); acc[3] = FMA2(c2, CVT8(w[i].y, true), acc[3]);
                    acc[4] = FMA2(c2, CVT8(w[i].z, false), acc[4]); acc[5] = FMA2(c2, CVT8(w[i].z, true), acc[5]);
                    acc[6] = FMA2(c2, CVT8(w[i].w, false), acc[6]); acc[7] = FMA2(c2, CVT8(w[i].w, true), acc[7]); }
            }
        }
        float s = 0.f;
#pragma unroll
        for (int j = 0; j < 8; ++j) { acc[j] = x[j] * ALPHA + acc[j]; s += acc[j].x + acc[j].y; }
        const float mean = wave_sum(s) * (1.f / D); float s2 = 0.f;
#pragma unroll
        for (int j = 0; j < 8; ++j) { acc[j] = acc[j] - mean; s2 += acc[j].x * acc[j].x + acc[j].y * acc[j].y; }
        const float rstd = 1.f / sqrtf(wave_sum(s2) * (1.f / D) + LN_EPS);
#pragma unroll
        for (int j = 0; j < 4; ++j) { const f32x4 gg = *((const GAS f32x4*)g + lane + 64 * j), b4 = *((const GAS f32x4*)bb + lane + 64 * j);
            const f32x4 o = (f32x4){acc[2 * j].x, acc[2 * j].y, acc[2 * j + 1].x, acc[2 * j + 1].y} * rstd * gg + b4;
            if (FINAL) *((GAS f32x4*)(Of + (size_t)t * D) + lane + 64 * j) = o;
            else { v2u w; w.x = pk2(o.x, o.y); w.y = pk2(o.z, o.w); *((GAS v2u*)(Ob + (size_t)t * D) + lane + 64 * j) = w; } }
    }
}
__device__ __forceinline__ void phase_hgrn(LAS unsigned char* lds, unsigned char* ws) {
    const int tid = threadIdx.x;
    const bf16* CQ = (const bf16*)(ws + WS_CQ); const bf16* CK = (const bf16*)(ws + WS_CK); const bf16* CV = (const bf16*)(ws + WS_CV); bf16* O = (bf16*)(ws + WS_O);
    LAS float* fL = (LAS float*)lds;
    LAS float* kL = fL + 4096; LAS float* qL = kL + 4096;
    LAS float* vL = qL + 4096;
    LAS float* part = vL + 1024;
    for (int item = blockIdx.x; item < 256; item += gridDim.x) {
        const int es = item & 3, h = (item >> 2) & 7, b = item >> 5;
        const int e = tid & 31, dg = tid >> 5;
        float S[8];
#pragma unroll
        for (int j = 0; j < 8; ++j) S[j] = 0.f;
        for (int blk = 0; blk < SEQ / 32; ++blk) {
            const size_t t0 = (size_t)b * SEQ + blk * 32;
            for (int idx = tid; idx < 4096; idx += NTHR) { const int s = idx >> 7, d = idx & 127; const size_t o = (t0 + s) * D + h * 128 + d;
                const float kk = bf2f(CK[o]); kL[idx] = kk; fL[idx] = 1.f - kk; qL[idx] = bf2f(CQ[o]); }
            for (int idx = tid; idx < 1024; idx += NTHR) { const int s = idx >> 5, ee = idx & 31; vL[idx] = bf2f(CV[(t0 + s) * D + h * 128 + es * 32 + ee]); }
            __syncthreads();
            for (int s = 0; s < 32; ++s) { const float v = vL[s * 32 + e]; float po = 0.f;
#pragma unroll
                for (int j = 0; j < 8; ++j) { const int d = dg * 8 + j; S[j] = fL[s * 128 + d] * S[j] + kL[s * 128 + d] * v; po += qL[s * 128 + d] * S[j]; }
                part[(s * 16 + dg) * 32 + e] = po; }
            __syncthreads();
            for (int idx = tid; idx < 1024; idx += NTHR) { const int s = idx >> 5, ee = idx & 31; float o = 0.f;
#pragma unroll
                for (int g = 0; g < 16; ++g) o += part[(s * 16 + g) * 32 + ee];
                O[(t0 + s) * D + h * 128 + es * 32 + ee] = (bf16)f2bf(o); }
            __syncthreads();
        }
    }
}


#define GROW(wb, i_, tab, ereg, lsel) (wb)[i_] = *((const GAS v2u*)((tab) + (size_t)__builtin_amdgcn_readlane((ereg), (lsel)) * 512) + lane)
#define CVT4(wd, bs) __builtin_amdgcn_cvt_scalef32_pk_f32_fp4((wd), 1.0f, (bs))
#define CVT4H(wd, bs) __builtin_amdgcn_cvt_scalef32_pk_f16_fp4((wd), 1.0f, (bs))
typedef _Float16 h16x2 __attribute__((ext_vector_type(2)));
__device__ __forceinline__ void phase_gather_u(const bf16* X, const int* EID, float* GATE, const unsigned char* U8, const float* DQU, const float* DQV) {
    const int tid = threadIdx.x, lane = tid & 63, wave = tid >> 6;
    const int gw = blockIdx.x * NWAVES + wave, NGW = gridDim.x * NWAVES;
    const bool b0 = (lane & 1) != 0, b1 = (lane & 2) != 0, b2 = (lane & 4) != 0, b3 = (lane & 8) != 0; const int myrow = lane >> 4;
    int t = gw;
    if (t < T) {
    v2u xr[4]; int e0, e1; float gt0, gt1;
#pragma unroll
    for (int j = 0; j < 4; ++j) xr[j] = *((const GAS v2u*)(X + (size_t)t * D) + lane + 64 * j);
    e0 = EID[(size_t)t * 128 + lane]; e1 = EID[(size_t)t * 128 + 64 + lane]; gt0 = GATE[(size_t)t * 128 + lane]; gt1 = GATE[(size_t)t * 128 + 64 + lane];
    v2u wA[16], wB[16];
#pragma unroll
    for (int i = 0; i < 16; ++i) GROW(wA, i, U8, e0, rev4(i));
#pragma unroll
    for (int i = 0; i < 16; ++i) GROW(wB, i, U8, e0, 16 + rev4(i));
    for (;;) {
        const int tn = t + NGW; const bool has_next = tn < T;
        v2u nxr[4]; int ne0 = e0, ne1 = e1; float ngt0 = 0.f, ngt1 = 0.f;
        if (has_next) {
#pragma unroll
            for (int j = 0; j < 4; ++j) nxr[j] = *((const GAS v2u*)(X + (size_t)tn * D) + lane + 64 * j);
            ne0 = EID[(size_t)tn * 128 + lane]; ne1 = EID[(size_t)tn * 128 + 64 + lane]; ngt0 = GATE[(size_t)tn * 128 + lane]; ngt1 = GATE[(size_t)tn * 128 + 64 + lane];
        }
        const float dqu0 = DQU[e0], dqu1 = DQU[e1], dqv0 = DQV[e0], dqv1 = DQV[e1];
        h16x2 x[8];
#pragma unroll
        for (int j = 0; j < 4; ++j) { x[2 * j] = (h16x2){(_Float16)bflo(xr[j].x), (_Float16)bfhi(xr[j].x)}; x[2 * j + 1] = (h16x2){(_Float16)bflo(xr[j].y), (_Float16)bfhi(xr[j].y)}; }
        float act0 = 0.f, act1 = 0.f;
#define UBATCH(w, R, ROW, NEREG, NBASE) { float p[16]; \
            _Pragma("unroll") for (int i = 0; i < 16; ++i) { float a0_ = 0.f, a1_ = 0.f; \
                a0_ = __builtin_amdgcn_fdot2(x[0], CVT4H(w[i].x, 0), a0_, false); a1_ = __builtin_amdgcn_fdot2(x[1], CVT4H(w[i].x, 1), a1_, false); \
                a0_ = __builtin_amdgcn_fdot2(x[2], CVT4H(w[i].x, 2), a0_, false); a1_ = __builtin_amdgcn_fdot2(x[3], CVT4H(w[i].x, 3), a1_, false); \
                a0_ = __builtin_amdgcn_fdot2(x[4], CVT4H(w[i].y, 0), a0_, false); a1_ = __builtin_amdgcn_fdot2(x[5], CVT4H(w[i].y, 1), a1_, false); \
                a0_ = __builtin_amdgcn_fdot2(x[6], CVT4H(w[i].y, 2), a0_, false); a1_ = __builtin_amdgcn_fdot2(x[7], CVT4H(w[i].y, 3), a1_, false); \
                p[i] = a0_ + a1_; GROW(w, i, U8, NEREG, (NBASE) + rev4(i)); if ((i & 3) == 3) __builtin_amdgcn_sched_barrier(0); } \
            float r8[8], r4[4], r2[2]; \
            _Pragma("unroll") for (int i = 0; i < 8; ++i) { const float keep = b0 ? p[8 + i] : p[i], send = b0 ? p[i] : p[8 + i]; r8[i] = keep + __shfl_xor(send, 1); } \
            _Pragma("unroll") for (int i = 0; i < 4; ++i) { const float keep = b1 ? r8[4 + i] : r8[i], send = b1 ? r8[i] : r8[4 + i]; r4[i] = keep + __shfl_xor(send, 2); } \
            _Pragma("unroll") for (int i = 0; i < 2; ++i) { const float keep = b2 ? r4[2 + i] : r4[i], send = b2 ? r4[i] : r4[2 + i]; r2[i] = keep + __shfl_xor(send, 4); } \
            float r1 = (b3 ? r2[1] : r2[0]) + __shfl_xor(b3 ? r2[0] : r2[1], 8); \
            r1 += __shfl_xor(r1, 16); r1 += __shfl_xor(r1, 32); \
            if (myrow == (ROW)) { if ((R) == 0) act0 = r1; else act1 = r1; } }
        UBATCH(wA, 0, 0, e0, 32) UBATCH(wB, 0, 1, e0, 48) UBATCH(wA, 0, 2, e1, 0) UBATCH(wB, 0, 3, e1, 16)
        UBATCH(wA, 1, 0, e1, 32) UBATCH(wB, 1, 1, e1, 48) UBATCH(wA, 1, 2, ne0, 0) UBATCH(wB, 1, 3, ne0, 16)
#undef UBATCH
        { const float a0 = act0 * dqu0, a1 = act1 * dqu1;
          GATE[(size_t)t * 128 + lane] = gt0 * (0.5f * a0 * (1.f + erff(a0 * 0.70710678118654752f))) * dqv0;
          GATE[(size_t)t * 128 + 64 + lane] = gt1 * (0.5f * a1 * (1.f + erff(a1 * 0.70710678118654752f))) * dqv1; }
        if (!has_next) break;
        t = tn; e0 = ne0; e1 = ne1; gt0 = ngt0; gt1 = ngt1;
#pragma unroll
        for (int j = 0; j < 4; ++j) xr[j] = nxr[j];
    }
    }
}
template <bool FINAL, int EMASK = 0x7fffffff>
__device__ __forceinline__ void phase_gather_v(const bf16* X, const int* EID, const float* COEF, const unsigned char* V8, const float* g, const float* bb, bf16* Ob, float* Of) {
    const int tid = threadIdx.x, lane = tid & 63, wave = tid >> 6;
    const int gw = blockIdx.x * NWAVES + wave, NGW = gridDim.x * NWAVES;
    int t = gw;
    if (t < T) {
    v2u xr[4]; int e0, e1; float c0, c1;
#pragma unroll
    for (int j = 0; j < 4; ++j) xr[j] = *((const GAS v2u*)(X + (size_t)t * D) + lane + 64 * j);
    e0 = EID[(size_t)t * 128 + lane] & EMASK; e1 = EID[(size_t)t * 128 + 64 + lane] & EMASK; c0 = COEF[(size_t)t * 128 + lane]; c1 = COEF[(size_t)t * 128 + 64 + lane];
    v2u wA[16], wB[16];
#pragma unroll
    for (int i = 0; i < 16; ++i) GROW(wA, i, V8, e0, i);
#pragma unroll
    for (int i = 0; i < 16; ++i) GROW(wB, i, V8, e0, 16 + i);
    for (;;) {
        const int tn = t + NGW; const bool has_next = tn < T;
        v2u nxr[4]; int ne0 = e0, ne1 = e1; float nc0 = 0.f, nc1 = 0.f;
        if (has_next) {
#pragma unroll
            for (int j = 0; j < 4; ++j) nxr[j] = *((const GAS v2u*)(X + (size_t)tn * D) + lane + 64 * j);
            ne0 = EID[(size_t)tn * 128 + lane] & EMASK; ne1 = EID[(size_t)tn * 128 + 64 + lane] & EMASK; nc0 = COEF[(size_t)tn * 128 + lane]; nc1 = COEF[(size_t)tn * 128 + 64 + lane];
        }
        f32x2 acc[8];
#pragma unroll
        for (int j = 0; j < 8; ++j) acc[j] = (f32x2){0.f, 0.f};
#define VBATCH(w, CREG, BASE, NEREG, NBASE) { const int cr_ = __builtin_bit_cast(int, (CREG)); \
            _Pragma("unroll") for (int i = 0; i < 16; ++i) { const float cf = __builtin_bit_cast(float, __builtin_amdgcn_readlane(cr_, (BASE) + i)); const f32x2 c2 = (f32x2){cf, cf}; \
                acc[0] = FMA2(c2, CVT4(w[i].x, 0), acc[0]); acc[1] = FMA2(c2, CVT4(w[i].x, 1), acc[1]); \
                acc[2] = FMA2(c2, CVT4(w[i].x, 2), acc[2]); acc[3] = FMA2(c2, CVT4(w[i].x, 3), acc[3]); \
                acc[4] = FMA2(c2, CVT4(w[i].y, 0), acc[4]); acc[5] = FMA2(c2, CVT4(w[i].y, 1), acc[5]); \
                acc[6] = FMA2(c2, CVT4(w[i].y, 2), acc[6]); acc[7] = FMA2(c2, CVT4(w[i].y, 3), acc[7]); \
                GROW(w, i, V8, NEREG, (NBASE) + i); if ((i & 3) == 3) __builtin_amdgcn_sched_barrier(0); } }
        VBATCH(wA, c0, 0, e0, 32) VBATCH(wB, c0, 16, e0, 48) VBATCH(wA, c0, 32, e1, 0) VBATCH(wB, c0, 48, e1, 16)
        VBATCH(wA, c1, 0, e1, 32) VBATCH(wB, c1, 16, e1, 48) VBATCH(wA, c1, 32, ne0, 0) VBATCH(wB, c1, 48, ne0, 16)
#undef VBATCH
        float sm = 0.f;
#pragma unroll
        for (int j = 0; j < 4; ++j) { acc[2 * j] = (f32x2){bflo(xr[j].x), bfhi(xr[j].x)} * ALPHA + acc[2 * j]; acc[2 * j + 1] = (f32x2){bflo(xr[j].y), bfhi(xr[j].y)} * ALPHA + acc[2 * j + 1];
            sm += (acc[2 * j].x + acc[2 * j].y) + (acc[2 * j + 1].x + acc[2 * j + 1].y); }
        const float mean = wave_sum(sm) * (1.f / D); float s2 = 0.f;
#pragma unroll
        for (int j = 0; j < 8; ++j) { acc[j] = acc[j] - mean; s2 += acc[j].x * acc[j].x + acc[j].y * acc[j].y; }
        const float rstd = 1.f / sqrtf(wave_sum(s2) * (1.f / D) + LN_EPS);
#pragma unroll
        for (int j = 0; j < 4; ++j) { const f32x4 gg = *((const GAS f32x4*)g + lane + 64 * j), b4 = *((const GAS f32x4*)bb + lane + 64 * j);
            const f32x4 o = (f32x4){acc[2 * j].x, acc[2 * j].y, acc[2 * j + 1].x, acc[2 * j + 1].y} * rstd * gg + b4;
            if (FINAL) *((GAS f32x4*)(Of + (size_t)t * D) + lane + 64 * j) = o;
            else { v2u wo; wo.x = pk2(o.x, o.y); wo.y = pk2(o.z, o.w); *((GAS v2u*)(Ob + (size_t)t * D) + lane + 64 * j) = wo; } }
        if (!has_next) break;
        t = tn; e0 = ne0; e1 = ne1; c0 = nc0; c1 = nc1;
#pragma unroll
        for (int j = 0; j < 4; ++j) xr[j] = nxr[j];
    }
    }
}


template <bool FINAL>
__device__ __forceinline__ void phase_gather_v_mfma(const bf16* X, const int* EID, const float* COEF, const unsigned char* V4, const float* g, const float* bb, bf16* Ob, float* Of) {
    const int tid = threadIdx.x, lane = tid & 63, wave = tid >> 6;
    const int gw = blockIdx.x * NWAVES + wave, NGW = gridDim.x * NWAVES;
    const int n = lane & 31, hh = lane >> 5;
    unsigned mask[4];
#pragma unroll
    for (int d = 0; d < 4; ++d) mask[d] = (hh == (n >> 4) && d == ((n & 15) >> 2)) ? (0xFFu << (8 * (n & 3))) : 0u;
    float gl[16], bl[16];
#pragma unroll
    for (int r = 0; r < 16; ++r) { const int col = 32 * ((r & 3) + 8 * (r >> 2) + 4 * hh) + n; gl[r] = g[col]; bl[r] = bb[col]; }
    const unsigned laneoff = 16u * (unsigned)n;
    int t = gw;
    if (t < T) {
    int e0 = EID[(size_t)t * 128 + lane], e1 = EID[(size_t)t * 128 + 64 + lane];
    float c0 = COEF[(size_t)t * 128 + lane], c1 = COEF[(size_t)t * 128 + 64 + lane];
    v4u ring[16];
#define VLOADA(slot, ereg, lsel) { const int ea_ = __builtin_amdgcn_readlane((ereg), (lsel)), eb_ = __builtin_amdgcn_readlane((ereg), (lsel) + 1); const int el_ = hh ? eb_ : ea_; ring[slot] = *(const GAS v4u*)(V4 + (((unsigned)el_ << 9) + laneoff)); }
#pragma unroll
    for (int j = 0; j < 16; ++j) VLOADA(j, e0, 2 * j)
    for (;;) {
        const int tn = t + NGW; const bool has_next = tn < T;
        int ne0 = e0, ne1 = e1; float nc0 = 0.f, nc1 = 0.f;
        if (has_next) { ne0 = EID[(size_t)tn * 128 + lane]; ne1 = EID[(size_t)tn * 128 + 64 + lane]; nc0 = COEF[(size_t)tn * 128 + lane]; nc1 = COEF[(size_t)tn * 128 + 64 + lane]; }
        unsigned short xs[16];
#pragma unroll
        for (int r = 0; r < 16; ++r) xs[r] = X[(size_t)t * D + 32 * ((r & 3) + 8 * (r >> 2) + 4 * hh) + n];
        float cm = fmaxf(fabsf(c0), fabsf(c1));
#pragma unroll
        for (int o = 1; o < 64; o <<= 1) cm = fmaxf(cm, __shfl_xor(cm, o));
        unsigned ex = (__float_as_uint(cm) >> 23) & 0xffu; ex = ex < 8u ? 8u : ex;
        const float S = __uint_as_float((261u - ex) << 23), invS = __uint_as_float((ex - 7u) << 23);
        const unsigned wq = (unsigned)__builtin_amdgcn_cvt_pk_fp8_f32(c0 * S, c1 * S, 0, false);
        const int rep0 = (int)((wq & 0xffu) * 0x01010101u), rep1 = (int)(((wq >> 8) & 0xffu) * 0x01010101u);
        f32x16 acc;
#pragma unroll
        for (int r = 0; r < 16; ++r) acc[r] = 0.f;
#pragma unroll
        for (int J = 0; J < 64; ++J) {
            const int ra = __builtin_amdgcn_readlane((J >> 5) ? rep1 : rep0, (2 * J) & 63), rb = __builtin_amdgcn_readlane((J >> 5) ? rep1 : rep0, ((2 * J) & 63) + 1);
            v8i A, B;
            A[0] = (int)ring[J & 15].x; A[1] = (int)ring[J & 15].y; A[2] = (int)ring[J & 15].z; A[3] = (int)ring[J & 15].w; A[4] = 0; A[5] = 0; A[6] = 0; A[7] = 0;
#pragma unroll
            for (int d = 0; d < 4; ++d) { B[d] = ra & (int)mask[d]; B[4 + d] = rb & (int)mask[d]; }
            acc = __builtin_amdgcn_mfma_scale_f32_32x32x64_f8f6f4(A, B, acc, 4, 0, 0, 0x7f7f7f7f, 0, 0x7f7f7f7f);
            if (J + 16 < 64) { VLOADA(J & 15, ((J + 16) >> 5) ? e1 : e0, (2 * (J + 16)) & 63) }
            else { VLOADA(J & 15, ne0, 2 * (J + 16 - 64)) }
            if ((J & 3) == 3) __builtin_amdgcn_sched_barrier(0);
        }
        float z[16]; float sm = 0.f;
#pragma unroll
        for (int r = 0; r < 16; ++r) { const float av = acc[r]; z[r] = ALPHA * bf2f(xs[r]) + av * invS; sm += z[r]; }
        const float mean = wave_sum(sm) * (1.f / D); float s2 = 0.f;
#pragma unroll
        for (int r = 0; r < 16; ++r) { z[r] -= mean; s2 += z[r] * z[r]; }
        const float rstd = 1.f / sqrtf(wave_sum(s2) * (1.f / D) + LN_EPS);
#pragma unroll
        for (int r = 0; r < 16; ++r) { const int col = 32 * ((r & 3) + 8 * (r >> 2) + 4 * hh) + n; const float o = z[r] * rstd * gl[r] + bl[r];
            if (FINAL) Of[(size_t)t * D + col] = o; else Ob[(size_t)t * D + col] = (bf16)f2bf(o); }
        if (!has_next) break;
        t = tn; e0 = ne0; e1 = ne1; c0 = nc0; c1 = nc1;
    }
#undef VLOADA
    }
}

__device__ __forceinline__ void phase_gather_u_mfma(LAS unsigned char* lds, const bf16* X, const int* EID, float* GATE, const unsigned char* U4, const float* DQU, const float* DQV) {
    const int tid = threadIdx.x, lane = tid & 63, wave = __builtin_amdgcn_readfirstlane(tid >> 6);
    const int gw = blockIdx.x * NWAVES + wave, NGW = gridDim.x * NWAVES;
    const int n = lane & 31, hh = lane >> 5;
    LAS unsigned char* rows = lds + wave * 18048;
    LAS unsigned char* x8 = rows + 16896;
    const unsigned laneoff = 16u * (unsigned)n;
    int t = gw;
    if (t < T) {
    int e0 = EID[(size_t)t * 128 + lane], e1 = EID[(size_t)t * 128 + 64 + lane];
    v4u ring[16];
#define ULOADA(slot, ereg, lb, j_) { const int ea_ = __builtin_amdgcn_readlane((ereg), (lb) + 2 * (j_)), eb_ = __builtin_amdgcn_readlane((ereg), (lb) + 2 * (j_) + 1); const int el_ = hh ? eb_ : ea_; \
        ring[slot] = *(const GAS v4u*)(U4 + (((unsigned)el_ << 9) + laneoff)); }
#pragma unroll
    for (int j = 0; j < 16; ++j) ULOADA(j, e0, 0, j)
    for (;;) {
        const int tn = t + NGW; const bool has_next = tn < T;
        int ne0 = e0, ne1 = e1;
        if (has_next) { ne0 = EID[(size_t)tn * 128 + lane]; ne1 = EID[(size_t)tn * 128 + 64 + lane]; }
        const float gt0 = GATE[(size_t)t * 128 + lane], gt1 = GATE[(size_t)t * 128 + 64 + lane];
        const float dqu0 = DQU[e0], dqu1 = DQU[e1], dqv0 = DQV[e0], dqv1 = DQV[e1];
        { const v4u xa = *((const GAS v4u*)(X + (size_t)t * D) + 2 * lane), xb = *((const GAS v4u*)(X + (size_t)t * D) + 2 * lane + 1);
          int w0 = 0, w1 = 0, w2 = 0, w3 = 0;
          w0 = __builtin_amdgcn_cvt_pk_fp8_f32(bflo(xa.x), bfhi(xa.x), w0, false); w0 = __builtin_amdgcn_cvt_pk_fp8_f32(bflo(xa.y), bfhi(xa.y), w0, true);
          w1 = __builtin_amdgcn_cvt_pk_fp8_f32(bflo(xa.z), bfhi(xa.z), w1, false); w1 = __builtin_amdgcn_cvt_pk_fp8_f32(bflo(xa.w), bfhi(xa.w), w1, true);
          w2 = __builtin_amdgcn_cvt_pk_fp8_f32(bflo(xb.x), bfhi(xb.x), w2, false); w2 = __builtin_amdgcn_cvt_pk_fp8_f32(bflo(xb.y), bfhi(xb.y), w2, true);
          w3 = __builtin_amdgcn_cvt_pk_fp8_f32(bflo(xb.z), bfhi(xb.z), w3, false); w3 = __builtin_amdgcn_cvt_pk_fp8_f32(bflo(xb.w), bfhi(xb.w), w3, true);
          *(LAS v4u*)(x8 + 16 * lane) = (v4u){(unsigned)w0, (unsigned)w1, (unsigned)w2, (unsigned)w3}; }
        float act0 = 0.f, act1 = 0.f;
        for (int q = 0; q < 4; ++q) {
#pragma unroll
            for (int j = 0; j < 16; ++j) *(LAS v4u*)(rows + hh * 528 + 16 * n + j * 1056) = ring[j];
            __builtin_amdgcn_sched_barrier(0);
            { const int qn = q + 1;
              const int er = (qn >= 4) ? ne0 : ((qn >> 1) ? e1 : e0); const int lb = (qn >= 4) ? 0 : 32 * (qn & 1);
#pragma unroll
              for (int j = 0; j < 16; ++j) ULOADA(j, er, lb, j) }
            __builtin_amdgcn_sched_barrier(0);
            f32x16 acc;
#pragma unroll
            for (int r = 0; r < 16; ++r) acc[r] = 0.f;
            unsigned xo = 16u * (unsigned)hh; asm volatile("" : "+v"(xo));
#pragma unroll 2
            for (int ks = 0; ks < 16; ++ks) {
                const v4u a4 = *(const LAS v4u*)(rows + n * 528 + 16 * hh + 32 * ks);
                const v4u b0 = *(const LAS v4u*)(x8 + xo + 64 * ks), b1 = *(const LAS v4u*)(x8 + xo + 64 * ks + 32);
                v8i A, B;
                A[0] = (int)a4.x; A[1] = (int)a4.y; A[2] = (int)a4.z; A[3] = (int)a4.w; A[4] = 0; A[5] = 0; A[6] = 0; A[7] = 0;
                B[0] = (int)b0.x; B[1] = (int)b0.y; B[2] = (int)b0.z; B[3] = (int)b0.w; B[4] = (int)b1.x; B[5] = (int)b1.y; B[6] = (int)b1.z; B[7] = (int)b1.w;
                acc = __builtin_amdgcn_mfma_scale_f32_32x32x64_f8f6f4(A, B, acc, 4, 0, 0, 0x7f7f7f7f, 0, 0x7f7f7f7f);
            }
            if (n == 0) {
#pragma unroll
                for (int r = 0; r < 16; ++r) { const float av = acc[r]; *(LAS float*)(x8 + 1024 + 4 * ((r & 3) + 8 * (r >> 2) + 4 * hh)) = av; }
            }
            const float act = *(const LAS float*)(x8 + 1024 + 4 * n);
            if (hh == (q & 1)) { if (q >> 1) act1 = act; else act0 = act; }
        }
        { const float a0 = act0 * dqu0, a1 = act1 * dqu1;
          GATE[(size_t)t * 128 + lane] = gt0 * (0.5f * a0 * (1.f + erff(a0 * 0.70710678118654752f))) * dqv0;
          GATE[(size_t)t * 128 + 64 + lane] = gt1 * (0.5f * a1 * (1.f + erff(a1 * 0.70710678118654752f))) * dqv1; }
        if (!has_next) break;
        t = tn; e0 = ne0; e1 = ne1;
    }
#undef ULOADA
    }
}
__device__ __forceinline__ void phase_hgrn_prep(unsigned char* ws, float* scratch  ) {
    const int tid = threadIdx.x, lane = tid & 63, wave = tid >> 6;
    const int gw = blockIdx.x * NWAVES + wave, NGW = gridDim.x * NWAVES;
    bf16* CQ = (bf16*)(ws + WS_CQ); bf16* CK = (bf16*)(ws + WS_CK); const bf16* CV = (const bf16*)(ws + WS_CV);
    bf16* KOT = (bf16*)scratch; bf16* VT = (bf16*)scratch + (size_t)T * D; float* DEC = (float*)(ws + WS_DEC);
    for (int item = gw; item < 1024 * 8; item += NGW) {
        const int g = item >> 3, h = item & 7; const size_t t0 = (size_t)g * 32;
        float k0[32], k1[32], b0[32], b1[32]; float c0 = 0.f, c1 = 0.f;
#pragma unroll
        for (int s2 = 0; s2 < 32; ++s2) { const size_t o = (t0 + s2) * D + h * 128 + 2 * lane;
            const unsigned kw = *(const GAS unsigned*)(CK + o), qw = *(const GAS unsigned*)(CQ + o);
            const float ka = bflo(kw), kb = bfhi(kw);
            c0 += __logf(1.f - ka); c1 += __logf(1.f - kb);
            k0[s2] = ka; k1[s2] = kb; b0[s2] = c0; b1[s2] = c1;
            *(GAS unsigned*)(CQ + o) = pk2(bflo(qw) * __expf(c0), bfhi(qw) * __expf(c1));
            *(GAS unsigned*)(CK + o) = pk2(ka * __expf(-c0), kb * __expf(-c1)); }
        { GAS v4u* r0 = (GAS v4u*)(KOT + ((size_t)g * 1024 + h * 128 + 2 * lane) * 32);
#pragma unroll
          for (int j = 0; j < 4; ++j) { v4u w;
              w.x = pk2(k0[8 * j + 0] * __expf(c0 - b0[8 * j + 0]), k0[8 * j + 1] * __expf(c0 - b0[8 * j + 1])); w.y = pk2(k0[8 * j + 2] * __expf(c0 - b0[8 * j + 2]), k0[8 * j + 3] * __expf(c0 - b0[8 * j + 3]));
              w.z = pk2(k0[8 * j + 4] * __expf(c0 - b0[8 * j + 4]), k0[8 * j + 5] * __expf(c0 - b0[8 * j + 5])); w.w = pk2(k0[8 * j + 6] * __expf(c0 - b0[8 * j + 6]), k0[8 * j + 7] * __expf(c0 - b0[8 * j + 7]));
              r0[j] = w; }
#pragma unroll
          for (int j = 0; j < 4; ++j) { v4u w;
              w.x = pk2(k1[8 * j + 0] * __expf(c1 - b1[8 * j + 0]), k1[8 * j + 1] * __expf(c1 - b1[8 * j + 1])); w.y = pk2(k1[8 * j + 2] * __expf(c1 - b1[8 * j + 2]), k1[8 * j + 3] * __expf(c1 - b1[8 * j + 3]));
              w.z = pk2(k1[8 * j + 4] * __expf(c1 - b1[8 * j + 4]), k1[8 * j + 5] * __expf(c1 - b1[8 * j + 5])); w.w = pk2(k1[8 * j + 6] * __expf(c1 - b1[8 * j + 6]), k1[8 * j + 7] * __expf(c1 - b1[8 * j + 7]));
              r0[4 + j] = w; } }
        *(GAS v2u*)(DEC + (size_t)g * 1024 + h * 128 + 2 * lane) = (v2u){__float_as_uint(__expf(c0)), __float_as_uint(__expf(c1))};
        { unsigned va[16], vb[16];
#pragma unroll
          for (int j = 0; j < 16; ++j) { const unsigned w0 = *(const GAS unsigned*)(CV + (t0 + 2 * j) * D + h * 128 + 2 * lane), w1 = *(const GAS unsigned*)(CV + (t0 + 2 * j + 1) * D + h * 128 + 2 * lane);
              va[j] = (w0 & 0xffffu) | (w1 << 16); vb[j] = (w0 >> 16) | (w1 & 0xffff0000u); }
          GAS v4u* r0 = (GAS v4u*)(VT + ((size_t)g * 1024 + h * 128 + 2 * lane) * 32);
#pragma unroll
          for (int j = 0; j < 4; ++j) { r0[j] = (v4u){va[4 * j], va[4 * j + 1], va[4 * j + 2], va[4 * j + 3]}; r0[4 + j] = (v4u){vb[4 * j], vb[4 * j + 1], vb[4 * j + 2], vb[4 * j + 3]}; } }
    }
}
__device__ __forceinline__ void phase_hgrn_scan(LAS unsigned char* lds, unsigned char* ws, const float* scratch) {
    const int tid = threadIdx.x, lane = tid & 63, wave = __builtin_amdgcn_readfirstlane(tid >> 6);
    const int c = lane & 31, hh = lane >> 5;
    const bf16* QI = (const bf16*)(ws + WS_CQ); const bf16* KI = (const bf16*)(ws + WS_CK);
    const bf16* KOT = (const bf16*)scratch; const bf16* VT = (const bf16*)scratch + (size_t)T * D; const float* DEC = (const float*)(ws + WS_DEC);
    bf16* O = (bf16*)(ws + WS_O);
    constexpr int BUF = 30720, O_KI = 0, O_QI = 8704, O_KOT = 17408, O_VT = 27648, O_DEC = 30208, O_ST = 3 * BUF, O_P = O_ST + 8704, NPIECE = 1696;
    for (int item = blockIdx.x; item < 256; item += gridDim.x) {
        const int es = item & 3, h = (item >> 2) & 7, b = item >> 5;
        __syncthreads();
        for (int i = tid; i < 8704 / 16; i += NTHR) *(LAS v4u*)(lds + O_ST + i * 16) = (v4u){0u, 0u, 0u, 0u};
        f32x16 S[4];
#pragma unroll
        for (int blk = 0; blk < 4; ++blk)
#pragma unroll
            for (int r = 0; r < 16; ++r) S[blk][r] = 0.f;
        v4u rg[5];
        const int lt = tid - 128;
        auto piece_src = [&](int n, int q) -> const GAS v4u* {
            const size_t gch = (size_t)b * 128 + n, t0 = gch * 32;
            if (q < 512) return (const GAS v4u*)(KI + (t0 + (q >> 4)) * D + h * 128 + 8 * (q & 15));
            if (q < 1024) { const int u = q - 512; return (const GAS v4u*)(QI + (t0 + (u >> 4)) * D + h * 128 + 8 * (u & 15)); }
            if (q < 1536) { const int u = q - 1024; return (const GAS v4u*)(KOT + (gch * 1024 + h * 128 + (u >> 2)) * 32 + 8 * (u & 3)); }
            if (q < 1664) { const int u = q - 1536; return (const GAS v4u*)(VT + (gch * 1024 + h * 128 + es * 32 + (u >> 2)) * 32 + 8 * (u & 3)); }
            return (const GAS v4u*)(DEC + gch * 1024 + h * 128 + 4 * (q - 1664));
        };
        auto piece_dst = [&](int q) -> int {
            if (q < 512) return O_KI + (q >> 4) * 272 + (q & 15) * 16;
            if (q < 1024) { const int u = q - 512; return O_QI + (u >> 4) * 272 + (u & 15) * 16; }
            if (q < 1536) { const int u = q - 1024; return O_KOT + (u >> 2) * 80 + (u & 3) * 16; }
            if (q < 1664) { const int u = q - 1536; return O_VT + (u >> 2) * 80 + (u & 3) * 16; }
            return O_DEC + (q - 1664) * 16;
        };
        auto load_chunk = [&](int n) {
            if (lt >= 0) {
#pragma unroll
                for (int i = 0; i < 5; ++i) { const int q = lt + 384 * i; if (q < NPIECE) rg[i] = *piece_src(n, q); }
            }
        };
        auto store_chunk = [&](int bufi) {
            if (lt >= 0) {
#pragma unroll
                for (int i = 0; i < 5; ++i) { const int q = lt + 384 * i; if (q < NPIECE) *(LAS v4u*)(lds + bufi * BUF + piece_dst(q)) = rg[i]; }
            }
        };
        auto scores = [&](int n) {
            LAS unsigned char* bp = lds + (n % 3) * BUF; LAS unsigned char* pi = lds + O_P + (n & 1) * 2560;
            f32x16 sc;
#pragma unroll
            for (int r = 0; r < 16; ++r) sc[r] = 0.f;
#pragma unroll
            for (int ks = 0; ks < 8; ++ks) { const bf16x8 kf = *(const LAS bf16x8*)(bp + O_KI + c * 272 + (16 * ks + 8 * hh) * 2);
                const bf16x8 qf = *(const LAS bf16x8*)(bp + O_QI + c * 272 + (16 * ks + 8 * hh) * 2);
                sc = __builtin_amdgcn_mfma_f32_32x32x16_bf16(kf, qf, sc, 0, 0, 0); }
#pragma unroll
            for (int g4 = 0; g4 < 4; ++g4) { float m[4];
#pragma unroll
                for (int q = 0; q < 4; ++q) { const float sv = sc[4 * g4 + q]; m[q] = (8 * g4 + 4 * hh + q <= c) ? sv : 0.f; }
                *(LAS v2u*)(pi + c * 80 + (8 * g4 + 4 * hh) * 2) = (v2u){pk2(m[0], m[1]), pk2(m[2], m[3])}; }
        };
        load_chunk(0); store_chunk(0); load_chunk(1); store_chunk(1); load_chunk(2);
        __syncthreads();
        if (wave == 1) scores(0);
        __syncthreads();
        for (int n = 0; n < 128; ++n) {
            if (n + 2 < 128) store_chunk((n + 2) % 3);
            if (n + 3 < 128) load_chunk(n + 3);
            if (wave == 1 && n + 1 < 128) scores(n + 1);
            if (wave == 0) {
                LAS unsigned char* bp = lds + (n % 3) * BUF; LAS unsigned char* pi = lds + O_P + (n & 1) * 2560;
                const size_t t0 = ((size_t)b * 128 + n) * 32;
                bf16x8 vf[2];
                f32x16 o;
#pragma unroll
                for (int r = 0; r < 16; ++r) o[r] = 0.f;
#pragma unroll
                for (int ks = 0; ks < 2; ++ks) { const bf16x8 pf = *(const LAS bf16x8*)(pi + c * 80 + (16 * ks + 8 * hh) * 2);
                    vf[ks] = *(const LAS bf16x8*)(bp + O_VT + c * 80 + (16 * ks + 8 * hh) * 2);
                    o = __builtin_amdgcn_mfma_f32_32x32x16_bf16(pf, vf[ks], o, 0, 0, 0); }
#pragma unroll
                for (int ks = 0; ks < 8; ++ks) { const bf16x8 qf = *(const LAS bf16x8*)(bp + O_QI + c * 272 + (16 * ks + 8 * hh) * 2);
                    const bf16x8 sf = *(const LAS bf16x8*)(lds + O_ST + c * 272 + (16 * ks + 8 * hh) * 2);
                    o = __builtin_amdgcn_mfma_f32_32x32x16_bf16(qf, sf, o, 0, 0, 0); }
#pragma unroll
                for (int r = 0; r < 16; ++r) { const float ov = o[r]; O[(t0 + (r & 3) + 8 * (r >> 2) + 4 * hh) * D + h * 128 + es * 32 + c] = (bf16)f2bf(ov); }
#pragma unroll
                for (int blk = 0; blk < 4; ++blk) {
#pragma unroll
                    for (int g4 = 0; g4 < 4; ++g4) { const f32x4 dv = *(const LAS f32x4*)(bp + O_DEC + (32 * blk + 8 * g4 + 4 * hh) * 4);
                        S[blk][4 * g4 + 0] *= dv.x; S[blk][4 * g4 + 1] *= dv.y; S[blk][4 * g4 + 2] *= dv.z; S[blk][4 * g4 + 3] *= dv.w; }
#pragma unroll
                    for (int ks = 0; ks < 2; ++ks) { const bf16x8 af = *(const LAS bf16x8*)(bp + O_KOT + (32 * blk + c) * 80 + (16 * ks + 8 * hh) * 2);
                        S[blk] = __builtin_amdgcn_mfma_f32_32x32x16_bf16(af, vf[ks], S[blk], 0, 0, 0); }
#pragma unroll
                    for (int g4 = 0; g4 < 4; ++g4) { const float s0 = S[blk][4 * g4 + 0], s1 = S[blk][4 * g4 + 1], s2 = S[blk][4 * g4 + 2], s3 = S[blk][4 * g4 + 3];
                        *(LAS v2u*)(lds + O_ST + c * 272 + (32 * blk + 8 * g4 + 4 * hh) * 2) = (v2u){pk2(s0, s1), pk2(s2, s3)}; }
                }
            }
            __syncthreads();
        }
    }
}
__device__ __forceinline__ void phase_hgrn_norm(const float* norm_g, unsigned char* ws) {
    const int tid = threadIdx.x, lane = tid & 63, wave = tid >> 6;
    const int gw = blockIdx.x * NWAVES + wave, NGW = gridDim.x * NWAVES;
    const bf16* O = (const bf16*)(ws + WS_O); const bf16* CG = (const bf16*)(ws + WS_CG); bf16* Y2 = (bf16*)(ws + WS_Y2);
    for (int t = gw; t < T; t += NGW) {
        const v4u a0 = *((const GAS v4u*)(O + (size_t)t * D) + lane * 2), a1 = *((const GAS v4u*)(O + (size_t)t * D) + lane * 2 + 1);
        const v4u g0 = *((const GAS v4u*)(CG + (size_t)t * D) + lane * 2), g1 = *((const GAS v4u*)(CG + (size_t)t * D) + lane * 2 + 1);
        float o[16], gv[16];
        o[0] = bflo(a0.x); o[1] = bfhi(a0.x); o[2] = bflo(a0.y); o[3] = bfhi(a0.y); o[4] = bflo(a0.z); o[5] = bfhi(a0.z); o[6] = bflo(a0.w); o[7] = bfhi(a0.w);
        o[8] = bflo(a1.x); o[9] = bfhi(a1.x); o[10] = bflo(a1.y); o[11] = bfhi(a1.y); o[12] = bflo(a1.z); o[13] = bfhi(a1.z); o[14] = bflo(a1.w); o[15] = bfhi(a1.w);
        gv[0] = bflo(g0.x); gv[1] = bfhi(g0.x); gv[2] = bflo(g0.y); gv[3] = bfhi(g0.y); gv[4] = bflo(g0.z); gv[5] = bfhi(g0.z); gv[6] = bflo(g0.w); gv[7] = bfhi(g0.w);
        gv[8] = bflo(g1.x); gv[9] = bfhi(g1.x); gv[10] = bflo(g1.y); gv[11] = bfhi(g1.y); gv[12] = bflo(g1.z); gv[13] = bfhi(g1.z); gv[14] = bflo(g1.w); gv[15] = bfhi(g1.w);
        float sq = 0.f;
#pragma unroll
        for (int j = 0; j < 16; ++j) sq += o[j] * o[j];
        sq += __shfl_xor(sq, 1); sq += __shfl_xor(sq, 2); sq += __shfl_xor(sq, 4);
        const float r = 1.f / sqrtf(sq * (1.f / 128.f) + LN_EPS);
        float y[16];
#pragma unroll
        for (int j = 0; j < 16; ++j) { const float sg = gv[j] / (1.f + expf(-gv[j])); y[j] = o[j] * r * norm_g[lane * 16 + j] * sg; }
        v4u w0, w1; w0.x = pk2(y[0], y[1]); w0.y = pk2(y[2], y[3]); w0.z = pk2(y[4], y[5]); w0.w = pk2(y[6], y[7]);
        w1.x = pk2(y[8], y[9]); w1.y = pk2(y[10], y[11]); w1.z = pk2(y[12], y[13]); w1.w = pk2(y[14], y[15]);
        *((GAS v4u*)(Y2 + (size_t)t * D) + lane * 2) = w0; *((GAS v4u*)(Y2 + (size_t)t * D) + lane * 2 + 1) = w1;
    }
}

struct Args { const float* in[16]; float* out; unsigned char* ws; int ph_lo, ph_hi, li, pad; };
__global__ void __launch_bounds__(NTHR, 2) mk_fwd(Args args) {
    extern __shared__ __attribute__((aligned(16))) unsigned char lds_raw[];
    LAS unsigned char* lds = (LAS unsigned char*)lds_raw;
    volatile LAS unsigned* MISC = (volatile LAS unsigned*)(lds + MISC_OFF);
    const int tid = threadIdx.x;
    unsigned char* ws = args.ws;
    gu32* ctl = (gu32*)(ws + WS_CTL);
    if (tid < 32) ((LAS unsigned*)(lds + MISC_OFF))[tid] = 0u;
    __syncthreads();
    XcdBarrier bar; bar.bar = (unsigned*)ctl + CW_BAR; bar.x = 0; bar.st = nullptr;
    if (N_LAUNCHES == 1) bar = xcd_barrier_post((unsigned*)ctl + CW_BAR, MISC + 8);
    const int lo = args.ph_lo, hi = args.ph_hi;
#define IN(k) (lo <= (k) && (k) < hi)
#define SEAM(k) do { if (IN(k) && IN((k) + 1)) xcd_barrier(bar); } while (0)
    const float* const* in = args.in;
    bf16* XB = (bf16*)(ws + WS_XB); bf16* H0 = (bf16*)(ws + WS_H0); bf16* Y = (bf16*)(ws + WS_Y); bf16* H1 = (bf16*)(ws + WS_H1);
    int* EID = (int*)(ws + WS_EID); float* GATE = (float*)(ws + WS_GATE);
    float* Z = args.out;

    int ph_ = 0;
#define PH_BEGIN if (lo <= ph_ && ph_ < hi) for (int rep_ = 0; rep_ < 1 + (int)((DUP_MASK >> ph_) & 1u); ++rep_) {
#define PH_END } if (lo <= ph_ && ph_ + 1 < hi) xcd_barrier(bar); ++ph_;
      PH_BEGIN phase_prologue(lds, in, ws); phase_convert_tables(in[12], in[13], ws); PH_END
      PH_BEGIN pg8::Gemm g{XB, (const bf16*)(ws + WS_WABIN), T, AB_IN, D}; pg8::StaticOrder S; S.init(T, AB_IN, (int)gridDim.x, (int)blockIdx.x); pg8::EpiBf16<0> E{H0, AB_IN, nullptr, 0, 0, 1.f};
                     pg8::gemm_phase<pg8::EpiBf16<0>, pg8::StaticOrder, true, true>(lds, g, S, E); PH_END
      PH_BEGIN phase_ret_local(lds, ws); PH_END
      PH_BEGIN phase_ret_prefix(ws); PH_END
      PH_BEGIN phase_ret_out_pool_fast(lds, in, ws); PH_END
      PH_BEGIN pg8::Gemm g{Y, (const bf16*)(ws + WS_WABOUT), T, D, D}; pg8::StaticOrder S; S.init(T, D, (int)gridDim.x, (int)blockIdx.x); pg8::EpiResidF32 E{XB, Z};
                     pg8::gemm_phase<pg8::EpiResidF32, pg8::StaticOrder, true, true>(lds, g, S, E); PH_END
      PH_BEGIN phase_ln(Z, H1, in[14], in[15]); PH_END
      PH_BEGIN pg8::Gemm g{H1, (const bf16*)(ws + WS_WQ), T, 2048, D}; pg8::StaticOrder S; S.init(T, 2048, (int)gridDim.x, (int)blockIdx.x); pg8::EpiBf16<0> E{H0  , 2048, nullptr, 0, 0, 1.f};
                     pg8::gemm_phase<pg8::EpiBf16<0>, pg8::StaticOrder, true, true>(lds, g, S, E); PH_END
      PH_BEGIN phase_topk_fast(lds, H0, (const bf16*)(ws + WS_KEYS), EID, GATE); PH_END
      PH_BEGIN phase_gather_u_mfma(lds, H1, EID, GATE, ws + WS_U8, (const float*)(ws + WS_DQU), (const float*)(ws + WS_DQV)); PH_END
      PH_BEGIN phase_gather_v_mfma<false>(H1, EID, GATE, ws + WS_V8, in[14] + D, in[15] + D, XB  , nullptr); PH_END
#ifdef PROBE_L2
    PH_BEGIN phase_gather_v<false, PROBE_L2>(H1, EID, GATE, ws + WS_V8, in[14] + D, in[15] + D, Y  , nullptr); PH_END
#endif
      PH_BEGIN pg8::Gemm g{XB, (const bf16*)(ws + WS_WCIN), T, C_IN, D}; pg8::StaticOrder S; S.init(T, C_IN, (int)gridDim.x, (int)blockIdx.x);
                      pg8::EpiCInF E2{(bf16*)(ws + WS_CQ), (bf16*)(ws + WS_CK), (bf16*)(ws + WS_CV), (bf16*)(ws + WS_CG), (const float*)(ws + WS_LB)};
                      pg8::gemm_phase<pg8::EpiCInF, pg8::StaticOrder, true, true>(lds, g, S, E2); PH_END
      PH_BEGIN phase_hgrn_prep(ws, args.out); PH_END
      PH_BEGIN phase_hgrn_scan(lds, ws, args.out); PH_END
      PH_BEGIN phase_hgrn_norm(in[8], ws); PH_END
      PH_BEGIN pg8::Gemm g{(const bf16*)(ws + WS_Y2), (const bf16*)(ws + WS_WCOUT), T, D, D}; pg8::StaticOrder S; S.init(T, D, (int)gridDim.x, (int)blockIdx.x); pg8::EpiResidF32 E{XB, Z};
                      pg8::gemm_phase<pg8::EpiResidF32, pg8::StaticOrder, true, true>(lds, g, S, E); PH_END
      PH_BEGIN phase_ln(Z, H1  , in[14] + 2 * D, in[15] + 2 * D); PH_END
      PH_BEGIN pg8::Gemm g{H1, (const bf16*)(ws + WS_WQ) + (size_t)2048 * D, T, 2048, D}; pg8::StaticOrder S; S.init(T, 2048, (int)gridDim.x, (int)blockIdx.x); pg8::EpiBf16<0> E{(bf16*)(ws + WS_Q1), 2048, nullptr, 0, 0, 1.f};
                      pg8::gemm_phase<pg8::EpiBf16<0>, pg8::StaticOrder, true, true>(lds, g, S, E); PH_END
      PH_BEGIN phase_topk_fast(lds, (const bf16*)(ws + WS_Q1), (const bf16*)(ws + WS_KEYS) + (size_t)8 * 2 * 128 * 128, EID, GATE); PH_END
      PH_BEGIN phase_gather_u_mfma(lds, H1, EID, GATE, ws + WS_U8 + (size_t)NEXP * 512, (const float*)(ws + WS_DQU) + NEXP, (const float*)(ws + WS_DQV) + NEXP); PH_END
      PH_BEGIN phase_gather_v_mfma<true>(H1, EID, GATE, ws + WS_V8 + (size_t)NEXP * 512, in[14] + 3 * D, in[15] + 3 * D, nullptr, args.out); PH_END
#undef PH_BEGIN
#undef PH_END
#undef IN
#undef SEAM
}

extern "C" void kernel_launch(void* const* d_in, const int* in_sizes, int n_in, void* d_out, int out_size, void* d_ws, size_t ws_size, hipStream_t stream) {
    static int grid = 0;
    if (grid == 0) {
        if (n_in != 16 || in_sizes[0] != T * D || out_size != T * D || ws_size < WS_END) { fprintf(stderr, "kernel_launch: unexpected problem (n_in %d, in0 %d, out %d, ws %zu); nothing launched\n", n_in, n_in > 0 ? in_sizes[0] : -1, out_size, ws_size); grid = -1; return; }
        int dev = 0, cus = 0;
        if (hipGetDevice(&dev) != hipSuccess || hipDeviceGetAttribute(&cus, hipDeviceAttributeMultiprocessorCount, dev) != hipSuccess) { grid = -1; return; }
        if (hipFuncSetAttribute((const void*)mk_fwd, hipFuncAttributeMaxDynamicSharedMemorySize, LDS_BYTES) != hipSuccess) { fprintf(stderr, "kernel_launch: hipFuncSetAttribute failed\n"); grid = -1; return; }
        (void)hipGetLastError();
        grid = cus;
    }
    if (grid < 0) return;
    if (hipMemsetAsync((char*)d_ws + WS_CTL, 0, CTL_ZERO_BYTES, stream) != hipSuccess) return;
    Args a{};
    for (int i = 0; i < 16; ++i) a.in[i] = (const float*)d_in[i];
    a.out = (float*)d_out; a.ws = (unsigned char*)d_ws;
    for (int li = 0; li < N_LAUNCHES; ++li) {
        a.ph_lo = (N_LAUNCHES == 1) ? 0 : li; a.ph_hi = (N_LAUNCHES == 1) ? NPHASE : li + 1; a.li = li;
        hipLaunchKernelGGL(mk_fwd, dim3(grid), dim3(NTHR), LDS_BYTES, stream, a);
        if (hipPeekAtLastError() != hipSuccess) { fprintf(stderr, "kernel_launch: launch %d failed\n", li); break; }
    }
}
```

```cpp
#include <hip/hip_runtime.h>
#include <cstdio>
#include <cstdint>

#ifndef MK_N_LAUNCHES
#define MK_N_LAUNCHES 1
#endif
#ifdef PROBE_L2
constexpr int NPHASE = 22;
#else
constexpr int NPHASE = 21;
#endif
#ifndef DUP_MASK
#define DUP_MASK 0u
#endif
constexpr int N_LAUNCHES = MK_N_LAUNCHES;

constexpr int BATCH = 8, SEQ = 4096, D = 1024, T = BATCH * SEQ;
constexpr int AB_IN = 2048, C_IN = 4096, NEXP = 16384;
constexpr float LN_EPS = 1e-5f;
constexpr float ALPHA = 1.41421356237309515f;
constexpr int NWAVES = 8, NTHR = 512;

constexpr size_t MiB = 1u << 20;
constexpr size_t WS_CTL = 0, CTL_ZERO_BYTES = 1 * MiB;
constexpr size_t WS_LB = 1 * MiB;
constexpr size_t WS_ROPE = 2 * MiB;
constexpr size_t WS_WABIN = 4 * MiB;
constexpr size_t WS_WABOUT = 8 * MiB;
constexpr size_t WS_WCIN = 10 * MiB;
constexpr size_t WS_WCOUT = 18 * MiB;
constexpr size_t WS_WQ = 20 * MiB;
constexpr size_t WS_KEYS = 28 * MiB;
constexpr size_t WS_DQU = 29 * MiB;
constexpr size_t WS_DQV = 29 * MiB + 131072;
constexpr size_t WS_U8 = 32 * MiB;
constexpr size_t WS_V8 = 64 * MiB;
constexpr size_t WS_POOLWT = 30 * MiB;
constexpr size_t WS_XB = 96 * MiB;
constexpr size_t WS_H0 = 160 * MiB;
constexpr size_t WS_LST = 288 * MiB;
constexpr size_t WS_Y = 320 * MiB;
constexpr size_t WS_H1 = 384 * MiB;
constexpr size_t WS_EID = 448 * MiB;
constexpr size_t WS_GATE = 464 * MiB;
constexpr size_t WS_CQ = 160 * MiB, WS_CK = 224 * MiB, WS_CV = 288 * MiB, WS_CG = 352 * MiB;
constexpr size_t WS_O = 416 * MiB;
constexpr size_t WS_Y2 = 160 * MiB;
constexpr size_t WS_Q1 = 224 * MiB;
constexpr size_t WS_DEC = 480 * MiB;
constexpr size_t WS_END = 484 * MiB;

constexpr int CW_BAR = 4096;
constexpr int LDS_BYTES = 147456;
constexpr int MISC_OFF = LDS_BYTES - 128;

#define GAS __attribute__((address_space(1)))
#define LAS __attribute__((address_space(3)))
typedef unsigned short bf16;
typedef unsigned v4u __attribute__((ext_vector_type(4)));
typedef unsigned v2u __attribute__((ext_vector_type(2)));
typedef float f32x4 __attribute__((ext_vector_type(4)));
typedef GAS unsigned gu32;
typedef short bf16x8 __attribute__((ext_vector_type(8)));
typedef int v8i __attribute__((ext_vector_type(8)));
typedef float f32x16 __attribute__((ext_vector_type(16)));
#define RLX_AGENT __ATOMIC_RELAXED, __HIP_MEMORY_SCOPE_AGENT
#define LDS_WAIT() asm volatile("s_waitcnt lgkmcnt(0)" ::: "memory")
typedef __bf16 hwbf16x2 __attribute__((ext_vector_type(2)));
typedef float hwf32x2 __attribute__((ext_vector_type(2)));
__device__ __forceinline__ unsigned pk2(float lo, float hi) { const hwf32x2 v = {lo, hi}; const hwbf16x2 b = __builtin_convertvector(v, hwbf16x2); return __builtin_bit_cast(unsigned, b); }
__device__ __forceinline__ unsigned f2bf(float f) { return pk2(f, 0.f) & 0xffffu; }
__device__ __forceinline__ float bf2f(unsigned b) { return __builtin_bit_cast(float, b << 16); }
__device__ __forceinline__ float bflo(unsigned w) { return __builtin_bit_cast(float, w << 16); }
__device__ __forceinline__ float bfhi(unsigned w) { return __builtin_bit_cast(float, w & 0xffff0000u); }
__device__ __forceinline__ float wave_sum(float v) {
#pragma unroll
    for (int o = 1; o < 64; o <<= 1) v += __shfl_xor(v, o);
    return v;
}

#define XB_TMO      128
#define XB_XCNT(j)  (256  + 64 * (j))
#define XB_XSUB(j)  (1280 + 64 * (j))
#define XB_XGEN(j)  (2304 + 64 * (j))
#define XB_TOP      3328
#define XB_TOPGEN   3392
#define XCD_BAR_WORDS 3456
#define XB_SPIN_CAP (1u << 21)
__device__ __forceinline__ unsigned xb_ld(unsigned* p)              { return __hip_atomic_load(p, __ATOMIC_RELAXED, __HIP_MEMORY_SCOPE_AGENT); }
__device__ __forceinline__ unsigned xb_add(unsigned* p, unsigned v) { return __hip_atomic_fetch_add(p, v, __ATOMIC_RELAXED, __HIP_MEMORY_SCOPE_AGENT); }
__device__ __forceinline__ unsigned xb_xcc_id() { return (unsigned)__builtin_amdgcn_s_getreg((3 << 11) | 20) & 0xFu; }
#define XB_SPIN(cond, bar) do { unsigned _sp = 0; while (cond) { __builtin_amdgcn_s_sleep(1); \
    if ((++_sp & 255u) == 0u) { if (xb_ld(&(bar)[XB_TMO])) break; if (_sp > XB_SPIN_CAP) { atomicAdd(&(bar)[XB_TMO], 1u); break; } } } } while (0)
struct XcdBarrier { unsigned* bar; unsigned x; volatile LAS unsigned* st; };
__device__ __forceinline__ XcdBarrier xcd_barrier_post(unsigned* bar, volatile LAS unsigned* st) {
    XcdBarrier b; b.bar = bar; b.x = xb_xcc_id(); b.st = st;
    if (threadIdx.x == 0) (void)xb_add(&bar[XB_XCNT(b.x)], 1u);
    return b;
}
__device__ __forceinline__ void xcd_barrier_complete(unsigned* bar, unsigned x, unsigned& nloc, unsigned& nx) {
    const unsigned G = gridDim.x * gridDim.y * gridDim.z;
    unsigned sum, cnt, mine, sp = 0u;
    for (;;) {
        sum = 0u; cnt = 0u; mine = 0u;
#pragma unroll
        for (unsigned j = 0; j < 16; ++j) { const unsigned c = xb_ld(&bar[XB_XCNT(j)]); sum += c; cnt += (c > 0u) ? 1u : 0u; mine = (j == x) ? c : mine; }
        if (sum == G) break;
        __builtin_amdgcn_s_sleep(1);
        if ((++sp & 255u) == 0u) { if (xb_ld(&bar[XB_TMO])) break; if (sp > XB_SPIN_CAP) { atomicAdd(&bar[XB_TMO], 1u); break; } }
    }
    nloc = mine > 0u ? mine : 1u; nx = cnt > 0u ? cnt : 1u;
}
__device__ __forceinline__ void xcd_barrier(const XcdBarrier& b) {
    asm volatile("s_waitcnt vmcnt(0)" ::: "memory");
    __syncthreads();
    if (threadIdx.x == 0) {
        unsigned* bar = b.bar;
        __builtin_amdgcn_s_waitcnt(0);
        unsigned nloc = b.st[0], nx = b.st[1];
        if (nloc == 0u) { xcd_barrier_complete(bar, b.x, nloc, nx); b.st[0] = nloc; b.st[1] = nx; }
        const unsigned old = xb_add(&bar[XB_XSUB(b.x)], 1u);
        const unsigned gen = old / nloc;
        if (old + 1u == (gen + 1u) * nloc) {
            __builtin_amdgcn_fence(__ATOMIC_RELEASE, "agent");
            asm volatile("s_waitcnt vmcnt(0)" ::: "memory");
            const unsigned og = xb_add(&bar[XB_TOP], 1u);
            const unsigned tg = og / nx;
            if (og + 1u == (tg + 1u) * nx) xb_add(&bar[XB_TOPGEN], 1u);
            else XB_SPIN(xb_ld(&bar[XB_TOPGEN]) == tg, bar);
            __builtin_amdgcn_fence(__ATOMIC_ACQUIRE, "agent");
            xb_add(&bar[XB_XGEN(b.x)], 1u);
            asm volatile("s_waitcnt vmcnt(0)" ::: "memory");
        } else {
            XB_SPIN(xb_ld(&bar[XB_XGEN(b.x)]) == gen, bar);
            __builtin_amdgcn_fence(__ATOMIC_ACQUIRE, "agent");
            asm volatile("s_waitcnt vmcnt(0)" ::: "memory");
        }
    }
    __syncthreads();
}

__device__ __forceinline__ void p0_transpose_item(const float* W, int K, int N, bf16* WT, LAS float* scr, int item, int lane) {
    const int nblk = N / 32, kb = item / nblk, nb = item % nblk, k0 = 64 * kb, n0 = 32 * nb;
#pragma unroll 8
    for (int i = 0; i < 32; ++i) { const int kk = 2 * i + (lane >> 5); scr[kk * 33 + (lane & 31)] = W[(size_t)(k0 + kk) * N + n0 + (lane & 31)]; }
    LDS_WAIT(); asm volatile("" ::: "memory");
    const int c = lane & 7;
#pragma unroll
    for (int j = 0; j < 4; ++j) { const int n = (lane >> 3) + 8 * j; const LAS float* s = scr + (8 * c) * 33 + n;
        v4u o; o.x = pk2(s[0 * 33], s[1 * 33]); o.y = pk2(s[2 * 33], s[3 * 33]); o.z = pk2(s[4 * 33], s[5 * 33]); o.w = pk2(s[6 * 33], s[7 * 33]);
        *(GAS v4u*)(WT + (size_t)(n0 + n) * K + k0 + 8 * c) = o; }
    LDS_WAIT(); asm volatile("" ::: "memory");
}

template <class Epi>
__device__ __forceinline__ void gemm_naive(LAS unsigned char* lds, const bf16* A, const bf16* Bt, int M, int N, int K, const Epi& E) {
    LAS float* As = (LAS float*)lds;
    LAS float* Bs = As + 128 * 33;
    const int tid = threadIdx.x, tx = tid & 15, ty = tid >> 4;
    const int ntn = N / 128, ntiles = (M / 128) * ntn;
    for (int tile = blockIdx.x; tile < ntiles; tile += gridDim.x) {
        const int tm = tile / ntn, tn = tile % ntn;
        float acc[4][8];
#pragma unroll
        for (int i = 0; i < 4; ++i)
#pragma unroll
            for (int j = 0; j < 8; ++j) acc[i][j] = 0.f;
        for (int k0 = 0; k0 < K; k0 += 32) {
            { const int r = tid >> 2, kc = (tid & 3) * 8;
              const v4u va = *(const GAS v4u*)(A + (size_t)(tm * 128 + r) * K + k0 + kc);
              const v4u vb = *(const GAS v4u*)(Bt + (size_t)(tn * 128 + r) * K + k0 + kc);
              LAS float* pa = As + r * 33 + kc; LAS float* pb = Bs + r * 33 + kc;
              pa[0] = bflo(va.x); pa[1] = bfhi(va.x); pa[2] = bflo(va.y); pa[3] = bfhi(va.y); pa[4] = bflo(va.z); pa[5] = bfhi(va.z); pa[6] = bflo(va.w); pa[7] = bfhi(va.w);
              pb[0] = bflo(vb.x); pb[1] = bfhi(vb.x); pb[2] = bflo(vb.y); pb[3] = bfhi(vb.y); pb[4] = bflo(vb.z); pb[5] = bfhi(vb.z); pb[6] = bflo(vb.w); pb[7] = bfhi(vb.w); }
            __syncthreads();
#pragma unroll 8
            for (int kk = 0; kk < 32; ++kk) {
                float a[4], b[8];
#pragma unroll
                for (int i = 0; i < 4; ++i) a[i] = As[(ty * 4 + i) * 33 + kk];
#pragma unroll
                for (int j = 0; j < 8; ++j) b[j] = Bs[(tx + 16 * j) * 33 + kk];
#pragma unroll
                for (int i = 0; i < 4; ++i)
#pragma unroll
                    for (int j = 0; j < 8; ++j) acc[i][j] += a[i] * b[j];
            }
            __syncthreads();
        }
#pragma unroll
        for (int i = 0; i < 4; ++i)
#pragma unroll
            for (int j = 0; j < 8; ++j) E(tm * 128 + ty * 4 + i, tn * 128 + tx + 16 * j, acc[i][j]);
    }
}
struct EpiStore { bf16* O; int ldc;
    __device__ __forceinline__ void operator()(int r, int c, float v) const { O[(size_t)r * ldc + c] = (bf16)f2bf(v); } };
struct EpiResid { const bf16* X; float* Z;
    __device__ __forceinline__ void operator()(int r, int c, float v) const { Z[(size_t)r * D + c] = ALPHA * bf2f(X[(size_t)r * D + c]) + v; } };
struct EpiCIn { bf16 *CQ, *CK, *CV, *CG; const float* lb;
    __device__ __forceinline__ void operator()(int r, int c, float v) const {
        const int seg = c >> 10, cc = c & 1023; const size_t o = (size_t)r * D + cc;
        if (seg == 0) CQ[o] = (bf16)f2bf(v);
        else if (seg == 1) { const float k = (1.f - lb[cc]) / (1.f + expf(v)); CK[o] = (bf16)f2bf(k); }
        else if (seg == 2) CV[o] = (bf16)f2bf(v);
        else CG[o] = (bf16)f2bf(v);
    } };

namespace pg8 {
#define PG8_LAS __attribute__((address_space(3)))
typedef unsigned short bf16_t;
typedef short bf16x8 __attribute__((ext_vector_type(8)));
typedef float f32x4 __attribute__((ext_vector_type(4)));
typedef unsigned u32x4 __attribute__((ext_vector_type(4)));
constexpr int BM = 256, BK = 64, HALF = 128, HTB = HALF * BK * 2  , STAGE_BYTES = 8 * HTB, NXCD = 8, WGM = 8;

__host__ __device__ __forceinline__ int lds_byte(int r, int c) { const int st = (r >> 4) * 2 + (c >> 5), rr = r & 15, cc = c & 31, ob = rr * 64 + cc * 2; return st * 1024 + (ob ^ (((ob >> 9) & 1) << 5)); }
__host__ __device__ __forceinline__ void stage_rc(int b, int& R, int& C) { const int st = b / 1024, sb = b % 1024, swz = sb ^ (((sb >> 9) & 1) << 5); R = (st >> 1) * 16 + swz / 64; C = (st & 1) * 32 + (swz % 64) / 2; }
__host__ __device__ __forceinline__ int perm32(int rho) { const int n = rho >> 4, i = rho & 15; return 8 * (i >> 2) + 4 * n + (i & 3); }

struct Unit { int pm, pn; };
struct Gemm { const bf16_t* A; const bf16_t* Bt; int M, N, K; };

struct StaticOrder {
    int nM, nN, nwg, G, c;
    __host__ __device__ void init(int M, int N, int G_, int c_) { nM = M / BM; nN = N / BM; nwg = nM * nN; G = G_; c = c_; }
    __host__ __device__ bool next(int i, Unit& u) const {
        const long L = (long)i * G + c; if (L >= nwg) return false;
        int wgid = (int)L; { const int q = nwg / NXCD, r = nwg % NXCD, xcd = wgid % NXCD, off = wgid / NXCD; wgid = (xcd < r ? xcd * (q + 1) : r * (q + 1) + (xcd - r) * q) + off; }
        const int nig = WGM * nN, gid = wgid / nig, fm = gid * WGM, gsz = (nM - fm) < WGM ? (nM - fm) : WGM;
        u.pm = fm + ((wgid % nig) % gsz); u.pn = (wgid % nig) / gsz; return true;
    }
    __device__ __forceinline__ void a_ready(const Unit&) const {}
    __device__ __forceinline__ void done(const Unit&) const {}
};

__device__ __forceinline__ unsigned cvt_pk_bf16(float lo, float hi) { unsigned r; asm volatile("v_cvt_pk_bf16_f32 %0, %1, %2" : "=v"(r) : "v"(lo), "v"(hi)); return r; }
typedef float f32x2 __attribute__((ext_vector_type(2)));
__device__ __forceinline__ f32x2 gelu_pk(f32x2 v) {
    const f32x2 av = __builtin_elementwise_abs(v), d = av * 0.2316418882f + 1.0f;
    f32x2 t; t.x = __builtin_amdgcn_rcpf(d.x); t.y = __builtin_amdgcn_rcpf(d.y);
    f32x2 q = t * 0.5307027145f + (-0.7265760135f); q = q * t + 0.7107068705f; q = q * t + (-0.142248368f); q = q * t + 0.127414796f; q = q * t;
    const f32x2 s = (v * v) * (-0.72134752044f);
    f32x2 e; e.x = __builtin_amdgcn_exp2f(s.x); e.y = __builtin_amdgcn_exp2f(s.y);
    const f32x2 m = v * (q * e), r = v - m;
    f32x2 o; o.x = v.x < 0.f ? m.x : r.x; o.y = v.y < 0.f ? m.y : r.y; return o;
}

template <int ACT  > struct EpiBf16 {
    static constexpr bool PERM = true, AFTER_DRAIN = false; static_assert(ACT == 0 || ACT == 1, "EpiBf16: ACT is 0 (none) or 1 (gelu_pk)");
    bf16_t* O; int ldc; const float* bias; int split_cols; size_t split_stride; float scale0;
    __device__ __forceinline__ void operator()(const f32x4 (&acc)[2][2][4][2], const Unit& u, int wr, int wc, int fr, int fq) const {
        const int row0 = u.pm * BM + wr * 64 + fr; int colt = u.pn * BM; bf16_t* base = O;
        float sc = 1.f; if (split_cols) { const int t = colt / split_cols; base += (size_t)t * split_stride; colt -= t * split_cols; if (t == 0) sc = scale0; }
        const int col0 = colt + wc * 32 + 8 * fq, bcol0 = u.pn * BM + wc * 32 + 8 * fq;
        f32x4 bv[2][2];
#pragma unroll
        for (int bj = 0; bj < 2; ++bj)
#pragma unroll
            for (int n = 0; n < 2; ++n) bv[bj][n] = bias ? *(const f32x4*)(bias + bcol0 + bj * HALF + 4 * n) : (f32x4){0.f, 0.f, 0.f, 0.f};
#pragma unroll
        for (int ai = 0; ai < 2; ++ai)
#pragma unroll
            for (int m = 0; m < 4; ++m) { bf16_t* rowp = base + (size_t)(row0 + ai * HALF + m * 16) * ldc + col0;
#pragma unroll
                for (int bj = 0; bj < 2; ++bj) { f32x4 v0 = acc[ai][bj][m][0] + bv[bj][0], v1 = acc[ai][bj][m][1] + bv[bj][1];
                    if (ACT == 1) { f32x2 a = gelu_pk((f32x2){v0[0], v0[1]}), b = gelu_pk((f32x2){v0[2], v0[3]}), c = gelu_pk((f32x2){v1[0], v1[1]}), d = gelu_pk((f32x2){v1[2], v1[3]});
                        v0 = (f32x4){a.x, a.y, b.x, b.y}; v1 = (f32x4){c.x, c.y, d.x, d.y}; }
                    v0 = v0 * sc; v1 = v1 * sc; u32x4 w; w.x = cvt_pk_bf16(v0[0], v0[1]); w.y = cvt_pk_bf16(v0[2], v0[3]); w.z = cvt_pk_bf16(v1[0], v1[1]); w.w = cvt_pk_bf16(v1[2], v1[3]);
                    *(u32x4*)(rowp + bj * HALF) = w; } }
    }
};

struct EpiResidF32 {
    static constexpr bool PERM = false, AFTER_DRAIN = false;
    const bf16_t* X; bf16_t* Z;
    __device__ __forceinline__ void operator()(const f32x4 (&acc)[2][2][4][2], const Unit& u, int wr, int wc, int fr, int fq) const {
        typedef unsigned u32x2 __attribute__((ext_vector_type(2)));
        const int row0 = u.pm * BM + wr * 64 + fr, col0 = u.pn * BM + wc * 32 + 4 * fq;
#pragma unroll
        for (int ai = 0; ai < 2; ++ai)
#pragma unroll
            for (int m = 0; m < 4; ++m) { const size_t ro = (size_t)(row0 + ai * HALF + m * 16) * 1024;
#pragma unroll
                for (int bj = 0; bj < 2; ++bj)
#pragma unroll
                    for (int n = 0; n < 2; ++n) { const int c = col0 + bj * HALF + n * 16; const u32x2 xw = *(const u32x2*)(X + ro + c);
                        f32x4 xv; xv[0] = __builtin_bit_cast(float, xw.x << 16); xv[1] = __builtin_bit_cast(float, xw.x & 0xffff0000u); xv[2] = __builtin_bit_cast(float, xw.y << 16); xv[3] = __builtin_bit_cast(float, xw.y & 0xffff0000u);
                        const f32x4 zv = xv * 1.41421356237309515f + acc[ai][bj][m][n]; u32x2 zw; zw.x = cvt_pk_bf16(zv[0], zv[1]); zw.y = cvt_pk_bf16(zv[2], zv[3]); *(u32x2*)(Z + ro + c) = zw; } }
    }
};
struct EpiCInF {
    static constexpr bool PERM = true, AFTER_DRAIN = false;
    bf16_t *CQ, *CK, *CV, *CG; const float* lb;
    __device__ __forceinline__ void operator()(const f32x4 (&acc)[2][2][4][2], const Unit& u, int wr, int wc, int fr, int fq) const {
        const int seg = u.pn >> 2, colt = (u.pn & 3) * BM;
        bf16_t* base = seg == 0 ? CQ : (seg == 1 ? CK : (seg == 2 ? CV : CG));
        const int row0 = u.pm * BM + wr * 64 + fr, col0 = colt + wc * 32 + 8 * fq;
        f32x4 om[2][2];
#pragma unroll
        for (int bj = 0; bj < 2; ++bj)
#pragma unroll
            for (int n = 0; n < 2; ++n) { const f32x4 l = *(const f32x4*)(lb + col0 + bj * HALF + 4 * n); om[bj][n] = 1.0f - l; }
#pragma unroll
        for (int ai = 0; ai < 2; ++ai)
#pragma unroll
            for (int m = 0; m < 4; ++m) { bf16_t* rowp = base + (size_t)(row0 + ai * HALF + m * 16) * 1024 + col0;
#pragma unroll
                for (int bj = 0; bj < 2; ++bj) { f32x4 v0 = acc[ai][bj][m][0], v1 = acc[ai][bj][m][1];
                    if (seg == 1) {
#pragma unroll
                        for (int q = 0; q < 4; ++q) { v0[q] = om[bj][0][q] / (1.0f + __expf(v0[q])); v1[q] = om[bj][1][q] / (1.0f + __expf(v1[q])); } }
                    u32x4 w; w.x = cvt_pk_bf16(v0[0], v0[1]); w.y = cvt_pk_bf16(v0[2], v0[3]); w.z = cvt_pk_bf16(v1[0], v1[1]); w.w = cvt_pk_bf16(v1[2], v1[3]);
                    *(u32x4*)(rowp + bj * HALF) = w; } }
    }
};
template <class Epi, class Sched, bool ALIGN_EPI = false, bool SP2 = false>
__device__ __forceinline__ void gemm_phase(PG8_LAS unsigned char* lds, const Gemm g, const Sched& S, const Epi& E) {
    const int tid = threadIdx.x, wid = __builtin_amdgcn_readfirstlane(tid >> 6), lane = tid & 63, wr = wid >> 2, wc = wid & 3, fr = lane & 15, fq = lane >> 4;
    const int K = g.K, nt = K / BK;
    unsigned voffA[2], voffB[2];
#pragma unroll
    for (int i = 0; i < 2; ++i) { int R, C; stage_rc(tid * 16 + i * 8192, R, C); const int Rb = Epi::PERM ? ((R & ~31) + perm32(R & 31)) : R;
        voffA[i] = (unsigned)(R * K + C) * 2u; voffB[i] = (unsigned)(Rb * K + C) * 2u; }
    const size_t kstep = (size_t)(BK * 2);
    const size_t hstep = (size_t)HALF * K * 2;
    const size_t tstep = 2 * hstep;
    const unsigned ldsw = (unsigned)wid * 1024u;
    const int aoff = lds_byte(wr * 64 + fr, fq * 8), boff = lds_byte(wc * 32 + fr, fq * 8);
#define PG8_SA(b, h) (((b) * 2 + (h)) * HTB)
#define PG8_SB(b, h) ((4 + (b) * 2 + (h)) * HTB)
#define PG8_STAGE(bufoff, gbase, voff) do { _Pragma("unroll") for (int _i = 0; _i < 2; ++_i) \
        __builtin_amdgcn_global_load_lds((const unsigned*)((const char*)(gbase) + (voff)[_i]), (PG8_LAS unsigned*)(lds + (bufoff) + ldsw + _i * 8192), 16, 0, 0); } while (0)
#define PG8_LDA(dst, b, h) do { _Pragma("unroll") for (int m = 0; m < 4; ++m) _Pragma("unroll") for (int k = 0; k < 2; ++k) dst[m][k] = *(const PG8_LAS bf16x8*)(lds + PG8_SA(b, h) + aoff + m * 2048 + k * 1024); } while (0)
#define PG8_LDB(dst, b, h) do { _Pragma("unroll") for (int n = 0; n < 2; ++n) _Pragma("unroll") for (int k = 0; k < 2; ++k) dst[n][k] = *(const PG8_LAS bf16x8*)(lds + PG8_SB(b, h) + boff + n * 2048 + k * 1024); } while (0)
#define PG8_MMA(ai, bj, At, Bt) do { __builtin_amdgcn_s_setprio(1); _Pragma("unroll") for (int m = 0; m < 4; ++m) _Pragma("unroll") for (int n = 0; n < 2; ++n) _Pragma("unroll") for (int k = 0; k < 2; ++k) \
        acc[ai][bj][m][n] = __builtin_amdgcn_mfma_f32_16x16x32_bf16(Bt[n][k], At[m][k], acc[ai][bj][m][n], 0, 0, 0); __builtin_amdgcn_s_setprio(0); } while (0)
#define PG8_WAIT_V(n) asm volatile("s_waitcnt vmcnt(" #n ")" ::: "memory")
#define PG8_WAIT_L(n) asm volatile("s_waitcnt lgkmcnt(" #n ")" ::: "memory")
#define PG8_BAR __builtin_amdgcn_s_barrier()
#define PG8_SCHED __builtin_amdgcn_sched_barrier(0)
    Unit cur, nxt; int ui = 0;
    if (!S.next(0, cur)) return;
    f32x4 acc[2][2][4][2];
#pragma unroll
    for (int a = 0; a < 2; ++a)
#pragma unroll
        for (int b = 0; b < 2; ++b)
#pragma unroll
            for (int m = 0; m < 4; ++m)
#pragma unroll
                for (int n = 0; n < 2; ++n) acc[a][b][m][n] = (f32x4){0.f, 0.f, 0.f, 0.f};
    bf16x8 At[4][2], B0[2][2], B1[2][2];
    const char* cA = (const char*)g.A + (size_t)cur.pm * tstep; const char* cB = (const char*)g.Bt + (size_t)cur.pn * tstep;
    S.a_ready(cur);
    if constexpr (SP2) {
        PG8_STAGE(PG8_SB(0, 0), cB, voffB); PG8_STAGE(PG8_SB(0, 1), cB + hstep, voffB); PG8_STAGE(PG8_SA(0, 0), cA, voffA); PG8_STAGE(PG8_SA(0, 1), cA + hstep, voffA);
        if (wr == 1) PG8_BAR;
        PG8_WAIT_V(2); PG8_BAR;
        PG8_STAGE(PG8_SB(1, 0), cB + kstep, voffB); PG8_STAGE(PG8_SA(1, 0), cA + kstep, voffA); PG8_STAGE(PG8_SB(1, 1), cB + hstep + kstep, voffB);
        PG8_WAIT_V(6); PG8_BAR;
    } else {
        PG8_STAGE(PG8_SB(0, 0), cB, voffB); PG8_STAGE(PG8_SA(0, 0), cA, voffA); PG8_STAGE(PG8_SB(0, 1), cB + hstep, voffB); PG8_STAGE(PG8_SA(0, 1), cA + hstep, voffA);
        if (wr == 1) PG8_BAR;
        PG8_WAIT_V(4); PG8_BAR;
        PG8_STAGE(PG8_SB(1, 0), cB + kstep, voffB); PG8_STAGE(PG8_SA(1, 0), cA + kstep, voffA); PG8_STAGE(PG8_SB(1, 1), cB + hstep + kstep, voffB);
        PG8_WAIT_V(6); PG8_BAR;
    }
    for (;;) {
        const bool has_next = S.next(ui + 1, nxt);
        const char* nA = has_next ? (const char*)g.A + (size_t)nxt.pm * tstep : cA; const char* nB = has_next ? (const char*)g.Bt + (size_t)nxt.pn * tstep : cB;
        for (int t = 0; t < nt; t += 2) {
            const bool last = (t == nt - 2);
            const char* a1 = cA + (size_t)(t + 1) * kstep;
            const char* a2 = last ? nA : cA + (size_t)(t + 2) * kstep; const char* b2 = last ? nB : cB + (size_t)(t + 2) * kstep;
            const char* a3 = a2 + kstep; const char* b3 = b2 + kstep;
            if (last && has_next) S.a_ready(nxt);
            if constexpr (SP2) {
            PG8_LDB(B0, 0, 0); PG8_LDB(B1, 0, 1); PG8_SCHED; PG8_LDA(At, 0, 0); PG8_STAGE(PG8_SA(1, 1), a1 + hstep, voffA);
            PG8_WAIT_V(8); PG8_WAIT_L(0); PG8_BAR; PG8_MMA(0, 0, At, B0); PG8_MMA(0, 1, At, B1); PG8_BAR; PG8_SCHED;
            PG8_LDA(At, 0, 1); PG8_STAGE(PG8_SB(0, 0), b2, voffB); PG8_STAGE(PG8_SB(0, 1), b2 + hstep, voffB); PG8_STAGE(PG8_SA(0, 0), a2, voffA);
            PG8_WAIT_V(8); PG8_WAIT_L(0); PG8_BAR; PG8_MMA(1, 0, At, B0); PG8_MMA(1, 1, At, B1); PG8_BAR; PG8_SCHED;
            PG8_LDB(B0, 1, 0); PG8_LDB(B1, 1, 1); PG8_SCHED; PG8_LDA(At, 1, 0); PG8_STAGE(PG8_SA(0, 1), a2 + hstep, voffA);
            PG8_WAIT_V(8); PG8_WAIT_L(0); PG8_BAR; PG8_MMA(0, 0, At, B0); PG8_MMA(0, 1, At, B1); PG8_BAR; PG8_SCHED;
            PG8_LDA(At, 1, 1); PG8_STAGE(PG8_SB(1, 0), b3, voffB); PG8_STAGE(PG8_SB(1, 1), b3 + hstep, voffB); PG8_STAGE(PG8_SA(1, 0), a3, voffA);
            PG8_WAIT_V(8); PG8_WAIT_L(0); PG8_BAR; PG8_MMA(1, 0, At, B0); PG8_MMA(1, 1, At, B1); PG8_BAR; PG8_SCHED;
            } else {
            PG8_LDB(B0, 0, 0); PG8_SCHED; PG8_LDA(At, 0, 0); PG8_STAGE(PG8_SA(1, 1), a1 + hstep, voffA);
            PG8_WAIT_L(8); PG8_BAR; PG8_WAIT_L(0); PG8_MMA(0, 0, At, B0); PG8_BAR; PG8_SCHED;
            PG8_LDB(B1, 0, 1); PG8_STAGE(PG8_SB(0, 0), b2, voffB);
            PG8_BAR; PG8_WAIT_L(0); PG8_MMA(0, 1, At, B1); PG8_BAR;
            PG8_LDA(At, 0, 1); PG8_STAGE(PG8_SA(0, 0), a2, voffA);
            PG8_BAR; PG8_WAIT_L(0); PG8_MMA(1, 0, At, B0); PG8_BAR; PG8_SCHED;
            PG8_STAGE(PG8_SB(0, 1), b2 + hstep, voffB);
            PG8_WAIT_V(6); PG8_BAR; PG8_MMA(1, 1, At, B1); PG8_BAR;
            PG8_LDB(B0, 1, 0); PG8_SCHED; PG8_LDA(At, 1, 0); PG8_STAGE(PG8_SA(0, 1), a2 + hstep, voffA);
            PG8_WAIT_L(8); PG8_BAR; PG8_WAIT_L(0); PG8_MMA(0, 0, At, B0); PG8_BAR; PG8_SCHED;
            PG8_LDB(B1, 1, 1); PG8_STAGE(PG8_SB(1, 0), b3, voffB);
            PG8_BAR; PG8_WAIT_L(0); PG8_MMA(0, 1, At, B1); PG8_BAR;
            PG8_LDA(At, 1, 1); PG8_STAGE(PG8_SA(1, 0), a3, voffA);
            PG8_BAR; PG8_WAIT_L(0); PG8_MMA(1, 0, At, B0); PG8_BAR; PG8_SCHED;
            PG8_STAGE(PG8_SB(1, 1), b3 + hstep, voffB);
            PG8_WAIT_V(6); PG8_BAR; PG8_MMA(1, 1, At, B1); PG8_BAR;
            }
        }
        if constexpr (ALIGN_EPI) { if (wr == 0) PG8_BAR; }
        if constexpr (!Epi::AFTER_DRAIN) { E(acc, cur, wr, wc, fr, fq); S.done(cur); }
        if (!has_next) break;
#pragma unroll
        for (int a = 0; a < 2; ++a)
#pragma unroll
            for (int b = 0; b < 2; ++b)
#pragma unroll
                for (int m = 0; m < 4; ++m)
#pragma unroll
                    for (int n = 0; n < 2; ++n) acc[a][b][m][n] = (f32x4){0.f, 0.f, 0.f, 0.f};
        cur = nxt; cA = nA; cB = nB; ++ui;
        if constexpr (ALIGN_EPI) { if (wr == 1) PG8_BAR; }
    }
    PG8_WAIT_V(0);
    if constexpr (!ALIGN_EPI) { if (wr == 0) PG8_BAR; }
    PG8_BAR;
    if constexpr (Epi::AFTER_DRAIN) { E.fused(acc, cur, wr, wc, fr, fq, lds, wid, lane); S.done(cur); }
#undef PG8_SA
#undef PG8_SB
#undef PG8_STAGE
#undef PG8_LDA
#undef PG8_LDB
#undef PG8_MMA
#undef PG8_WAIT_V
#undef PG8_WAIT_L
#undef PG8_BAR
#undef PG8_SCHED
}
}

__device__ __forceinline__ float gamma_log2(int h) { return log2f(1.f - exp2f(-5.f - (float)h)); }

__device__ __forceinline__ void phase_prologue(LAS unsigned char* lds, const float* const* in, unsigned char* ws) {
    const int tid = threadIdx.x, lane = tid & 63, wave = tid >> 6;
    const int gw = blockIdx.x * NWAVES + wave, NGW = gridDim.x * NWAVES;
    LAS float* scr = (LAS float*)(lds + wave * 16384);
    constexpr int I_ABIN = (D / 64) * (AB_IN / 32), I_SQ = (D / 64) * (D / 32), I_CIN = (D / 64) * (C_IN / 32), I_WQ = (D / 64) * (2048 / 32);
    constexpr int NITEMS = I_ABIN + I_SQ + I_CIN + I_SQ + 2 * I_WQ;
    for (int it = gw; it < NITEMS; it += NGW) {
        int r = it;
        if (r < I_ABIN) { p0_transpose_item(in[1], D, AB_IN, (bf16*)(ws + WS_WABIN), scr, r, lane); continue; } r -= I_ABIN;
        if (r < I_SQ) { p0_transpose_item(in[5], D, D, (bf16*)(ws + WS_WABOUT), scr, r, lane); continue; } r -= I_SQ;
        if (r < I_CIN) { p0_transpose_item(in[6], D, C_IN, (bf16*)(ws + WS_WCIN), scr, r, lane); continue; } r -= I_CIN;
        if (r < I_SQ) { p0_transpose_item(in[9], D, D, (bf16*)(ws + WS_WCOUT), scr, r, lane); continue; } r -= I_SQ;
        if (r < I_WQ) { p0_transpose_item(in[10], D, 2048, (bf16*)(ws + WS_WQ), scr, r, lane); continue; } r -= I_WQ;
        p0_transpose_item(in[10] + (size_t)D * 2048, D, 2048, (bf16*)(ws + WS_WQ) + (size_t)2048 * D, scr, r, lane);
    }
    for (int it = gw; it < 32; it += NGW) p0_transpose_item(in[2] + (size_t)(it >> 3) * 16384, 128, 128, (bf16*)(ws + WS_POOLWT) + (size_t)(it >> 3) * 16384, scr, it & 7, lane);
    const size_t gt = (size_t)blockIdx.x * NTHR + tid, NT = (size_t)gridDim.x * NTHR;
    { const float* x = in[0]; bf16* xb = (bf16*)(ws + WS_XB);
      for (size_t i = gt; i < (size_t)T * D / 8; i += NT) { const f32x4 a = *(const GAS f32x4*)(x + i * 8), b = *(const GAS f32x4*)(x + i * 8 + 4);
          v4u o; o.x = pk2(a.x, a.y); o.y = pk2(a.z, a.w); o.z = pk2(b.x, b.y); o.w = pk2(b.z, b.w); *(GAS v4u*)(xb + i * 8) = o; } }
    { const float* k = in[11]; bf16* kb = (bf16*)(ws + WS_KEYS);
      for (size_t i = gt; i < (size_t)2 * 8 * 2 * 128 * 128 / 8; i += NT) { const f32x4 a = *(const GAS f32x4*)(k + i * 8), b = *(const GAS f32x4*)(k + i * 8 + 4);
          v4u o; o.x = pk2(a.x, a.y); o.y = pk2(a.z, a.w); o.z = pk2(b.x, b.y); o.w = pk2(b.z, b.w); *(GAS v4u*)(kb + i * 8) = o; } }
    { float* ct = (float*)(ws + WS_ROPE); float* st = ct + 4096 * 32;
      for (size_t i = gt; i < (size_t)4096 * 32; i += NT) { const int pos = (int)(i >> 5), f = (int)(i & 31);
          const double inv = exp(-log(10000.0) * ((double)f / 31.0)); const double ang = (double)pos * inv;
          ct[i] = (float)cos(ang); st[i] = (float)sin(ang); } }
    { const float* l = in[7]; float* lb = (float*)(ws + WS_LB);
      for (size_t i = gt; i < 1024; i += NT) { const float a = l[i], b = l[1024 + i]; const float m = fmaxf(a, b); const float ea = expf(a - m), eb = expf(b - m); lb[i] = eb / (ea + eb); } }
}

__device__ __forceinline__ void phase_ret_local(LAS unsigned char* lds, unsigned char* ws) {
    const int tid = threadIdx.x;
    const bf16* H0 = (const bf16*)(ws + WS_H0); float* LST = (float*)(ws + WS_LST);
    const float* ct = (const float*)(ws + WS_ROPE); const float* st = ct + 4096 * 32;
    LAS float* kd = (LAS float*)lds;
    LAS float* vv = (LAS float*)(lds + 32768);
    for (int item = blockIdx.x; item < 1024; item += gridDim.x) {
        const int n = item & 31, h = (item >> 5) & 3, b = item >> 7;
        const size_t t0 = (size_t)b * SEQ + n * 128; const float lg = gamma_log2(h);
        for (int idx = tid; idx < 4096; idx += NTHR) { const int s = idx >> 5, i = idx & 31, pos = n * 128 + s;
            const bf16* row = H0 + (t0 + s) * AB_IN + 768 + h * 64;
            const float x1 = bf2f(row[i]), x2 = bf2f(row[i + 32]); const float c = ct[pos * 32 + i], sn = st[pos * 32 + i];
            const float dec = exp2f((float)(127 - s) * lg) * 0.125f;
            kd[s * 64 + i] = (x1 * c - x2 * sn) * dec; kd[s * 64 + i + 32] = (x2 * c + x1 * sn) * dec; }
        for (int idx = tid; idx < 16384; idx += NTHR) { const int s = idx >> 7, e = idx & 127; vv[idx] = bf2f(H0[(t0 + s) * AB_IN + 1024 + h * 128 + e]); }
        __syncthreads();
        const int e = tid & 127, dg = tid >> 7;
        float acc[16];
#pragma unroll
        for (int j = 0; j < 16; ++j) acc[j] = 0.f;
        for (int s = 0; s < 128; ++s) { const float v = vv[s * 128 + e];
#pragma unroll
            for (int j = 0; j < 16; ++j) acc[j] += kd[s * 64 + dg * 16 + j] * v; }
#pragma unroll
        for (int j = 0; j < 16; ++j) LST[(size_t)item * 8192 + (dg * 16 + j) * 128 + e] = acc[j];
        __syncthreads();
    }
}
__device__ __forceinline__ void phase_ret_prefix(unsigned char* ws) {
    float* LST = (float*)(ws + WS_LST);
    const size_t gt = (size_t)blockIdx.x * NTHR + threadIdx.x, NT = (size_t)gridDim.x * NTHR;
    for (size_t idx = gt; idx < (size_t)32 * 8192; idx += NT) { const int bh = (int)(idx >> 13), el = (int)(idx & 8191), h = bh & 3;
        const float g128 = exp2f(128.f * gamma_log2(h)); float S = 0.f;
        for (int n = 0; n < 32; ++n) { float* p = LST + ((size_t)(bh * 32 + n) * 8192 + el); const float tmp = *p; *p = S; S = S * g128 + tmp; } }
}
__device__ __forceinline__ void phase_ret_out_pool(LAS unsigned char* lds, const float* const* in, unsigned char* ws) {
    const int tid = threadIdx.x;
    const bf16* H0 = (const bf16*)(ws + WS_H0); const float* LST = (const float*)(ws + WS_LST); bf16* Y = (bf16*)(ws + WS_Y);
    const float* ct = (const float*)(ws + WS_ROPE); const float* st = ct + 4096 * 32;
    const float* pool_w = in[2]; const float* pool_scale = in[3]; const float* ret_g = in[4];
    LAS float* qs = (LAS float*)lds;
    LAS float* ks = qs + 128 * 65;
    LAS float* R2 = (LAS float*)(lds + 66560);
    LAS float* PA = (LAS float*)lds;
    LAS float* PB = (LAS float*)(lds + 66048);
    for (int item = blockIdx.x; item < 256; item += gridDim.x) {
        const int n = item & 31, b = item >> 5; const size_t t0 = (size_t)b * SEQ + n * 128;
        const int c = tid >> 2, eg = tid & 3;
        for (int h = 0; h < 4; ++h) {
            const float lg = gamma_log2(h);
            for (int idx = tid; idx < 4096; idx += NTHR) { const int s = idx >> 5, i = idx & 31, pos = n * 128 + s;
                const bf16* rq = H0 + (t0 + s) * AB_IN + 512 + h * 64; const bf16* rk = H0 + (t0 + s) * AB_IN + 768 + h * 64;
                const float cs = ct[pos * 32 + i], sn = st[pos * 32 + i];
                const float q1 = bf2f(rq[i]), q2 = bf2f(rq[i + 32]), k1 = bf2f(rk[i]), k2 = bf2f(rk[i + 32]);
                qs[s * 65 + i] = q1 * cs - q2 * sn; qs[s * 65 + i + 32] = q2 * cs + q1 * sn;
                ks[s * 65 + i] = (k1 * cs - k2 * sn) * 0.125f; ks[s * 65 + i + 32] = (k2 * cs + k1 * sn) * 0.125f; }
            { const float* Sg = LST + (size_t)((b * 4 + h) * 32 + n) * 8192;
              for (int idx = tid; idx < 8192; idx += NTHR) R2[idx] = Sg[idx]; }
            __syncthreads();
            float o[32];
#pragma unroll
            for (int j = 0; j < 32; ++j) o[j] = 0.f;
            for (int d = 0; d < 64; ++d) { const float qv = qs[c * 65 + d];
#pragma unroll
                for (int j = 0; j < 32; ++j) o[j] += qv * R2[d * 128 + eg * 32 + j]; }
            { const float qd = exp2f((float)(c + 1) * lg);
#pragma unroll
              for (int j = 0; j < 32; ++j) o[j] *= qd; }
            __syncthreads();
            for (int idx = tid; idx < 16384; idx += NTHR) { const int s = idx >> 7, e = idx & 127; R2[idx] = bf2f(H0[(t0 + s) * AB_IN + 1024 + h * 128 + e]); }
            __syncthreads();
            for (int s = 0; s <= c; ++s) {
                float dot = 0.f;
#pragma unroll 16
                for (int d = 0; d < 64; ++d) dot += qs[c * 65 + d] * ks[s * 65 + d];
                const float w = dot * exp2f((float)(c - s) * lg);
#pragma unroll
                for (int j = 0; j < 32; ++j) o[j] += w * R2[s * 128 + eg * 32 + j];
            }
            float sum = 0.f;
#pragma unroll
            for (int j = 0; j < 32; ++j) sum += o[j];
            sum += __shfl_xor(sum, 1); sum += __shfl_xor(sum, 2);
            const float mean = sum * (1.f / 128.f); float sq = 0.f;
#pragma unroll
            for (int j = 0; j < 32; ++j) { const float dl = o[j] - mean; sq += dl * dl; }
            sq += __shfl_xor(sq, 1); sq += __shfl_xor(sq, 2);
            const float rstd = 1.f / sqrtf(sq * (1.f / 128.f) + LN_EPS);
            { const bf16* rg = H0 + (t0 + c) * AB_IN + 1536 + h * 128 + eg * 32; bf16* yo = Y + (t0 + c) * D + 512 + h * 128 + eg * 32;
#pragma unroll
              for (int j = 0; j < 32; ++j) { const float g = bf2f(rg[j]); const float sg = g / (1.f + expf(-g));
                  yo[j] = (bf16)f2bf((o[j] - mean) * rstd * ret_g[h * 128 + eg * 32 + j] * sg); } }
            __syncthreads();
        }
        for (int gi = 0; gi < 4; ++gi) {
            const int w = 2 << gi;
            for (int idx = tid; idx < 16384; idx += NTHR) { const int s = idx >> 7, cc = idx & 127, pos = n * 128 + s; const int cnt = (pos + 1 < w) ? pos + 1 : w;
                float sum = 0.f; for (int j = 0; j < cnt; ++j) sum += bf2f(H0[(t0 + s - j) * AB_IN + gi * 128 + cc]);
                PA[s * 129 + cc] = sum / (float)cnt - bf2f(H0[(t0 + s) * AB_IN + gi * 128 + cc]); }
            for (int idx = tid; idx < 16384; idx += NTHR) PB[idx] = pool_w[gi * 16384 + idx];
            __syncthreads();
            float o[32];
#pragma unroll
            for (int j = 0; j < 32; ++j) o[j] = 0.f;
            for (int cc = 0; cc < 128; ++cc) { const float pv = PA[c * 129 + cc];
#pragma unroll
                for (int j = 0; j < 32; ++j) o[j] += pv * PB[cc * 128 + eg * 32 + j]; }
            { bf16* yo = Y + (t0 + c) * D + gi * 128 + eg * 32;
#pragma unroll
              for (int j = 0; j < 32; ++j) yo[j] = (bf16)f2bf(o[j] * pool_scale[gi * 128 + eg * 32 + j]); }
            __syncthreads();
        }
    }
}

__device__ __forceinline__ void unpack8(const v4u w, float (&x)[8]) { x[0] = bflo(w.x); x[1] = bfhi(w.x); x[2] = bflo(w.y); x[3] = bfhi(w.y); x[4] = bflo(w.z); x[5] = bfhi(w.z); x[6] = bflo(w.w); x[7] = bfhi(w.w); }
__device__ __forceinline__ v4u pack8(const float (&x)[8]) { v4u w; w.x = pk2(x[0], x[1]); w.y = pk2(x[2], x[3]); w.z = pk2(x[4], x[5]); w.w = pk2(x[6], x[7]); return w; }
__device__ __forceinline__ void phase_ret_out_pool_fast(LAS unsigned char* lds, const float* const* in, unsigned char* ws) {
    const int tid = threadIdx.x, lane = tid & 63, wave = __builtin_amdgcn_readfirstlane(tid >> 6);
    const int c = lane & 31, hh = lane >> 5, cbk = wave & 3, eh = wave >> 2;
    const bf16* H0 = (const bf16*)(ws + WS_H0); const float* LST = (const float*)(ws + WS_LST); bf16* Y = (bf16*)(ws + WS_Y);
    const float* ct = (const float*)(ws + WS_ROPE); const float* st = ct + 4096 * 32;
    const float* pool_scale = in[3]; const float* ret_g = in[4]; const bf16* PWT = (const bf16*)(ws + WS_POOLWT);
    constexpr int O_QP = 0, O_KP = 18432, O_VT = 36864, O_ST = 71680, O_PI = 90112, O_RED = 124928, O_PT = 0, O_WT = 34816;
    for (int item = blockIdx.x; item < 256; item += gridDim.x) {
        const int n = item & 31, b = item >> 5; const size_t t0 = (size_t)b * SEQ + n * 128;
        for (int h = 0; h < 4; ++h) {
            const float lg = gamma_log2(h);
            __syncthreads();
            { const int s = tid >> 2, grp = tid & 3, pos = n * 128 + s;
              const bf16* rq = H0 + (t0 + s) * AB_IN + 512 + h * 64 + 8 * grp; const bf16* rk = H0 + (t0 + s) * AB_IN + 768 + h * 64 + 8 * grp;
              float q1[8], q2[8], k1[8], k2[8], cs[8], sn[8];
              unpack8(*(const GAS v4u*)rq, q1); unpack8(*(const GAS v4u*)(rq + 32), q2); unpack8(*(const GAS v4u*)rk, k1); unpack8(*(const GAS v4u*)(rk + 32), k2);
              { const f32x4 a = *(const GAS f32x4*)(ct + pos * 32 + 8 * grp), bq = *(const GAS f32x4*)(ct + pos * 32 + 8 * grp + 4);
                cs[0] = a.x; cs[1] = a.y; cs[2] = a.z; cs[3] = a.w; cs[4] = bq.x; cs[5] = bq.y; cs[6] = bq.z; cs[7] = bq.w; }
              { const f32x4 a = *(const GAS f32x4*)(st + pos * 32 + 8 * grp), bq = *(const GAS f32x4*)(st + pos * 32 + 8 * grp + 4);
                sn[0] = a.x; sn[1] = a.y; sn[2] = a.z; sn[3] = a.w; sn[4] = bq.x; sn[5] = bq.y; sn[6] = bq.z; sn[7] = bq.w; }
              const float gq = exp2f((float)(s + 1) * lg), gk = 0.125f * exp2f(-(float)(s + 1) * lg);
              float qa[8], qb[8], ka[8], kb[8];
#pragma unroll
              for (int j = 0; j < 8; ++j) { qa[j] = (q1[j] * cs[j] - q2[j] * sn[j]) * gq; qb[j] = (q2[j] * cs[j] + q1[j] * sn[j]) * gq;
                                            ka[j] = (k1[j] * cs[j] - k2[j] * sn[j]) * gk; kb[j] = (k2[j] * cs[j] + k1[j] * sn[j]) * gk; }
              *(LAS v4u*)(lds + O_QP + s * 144 + 16 * grp) = pack8(qa); *(LAS v4u*)(lds + O_QP + s * 144 + 64 + 16 * grp) = pack8(qb);
              *(LAS v4u*)(lds + O_KP + s * 144 + 16 * grp) = pack8(ka); *(LAS v4u*)(lds + O_KP + s * 144 + 64 + 16 * grp) = pack8(kb); }
#pragma unroll
            for (int i = 0; i < 4; ++i) { const int task = tid + 512 * i, e8 = task >> 7, s = task & 127;
                const v4u w = *(const GAS v4u*)(H0 + (t0 + s) * AB_IN + 1024 + h * 128 + 8 * e8);
                LAS bf16* d = (LAS bf16*)(lds + O_VT + (8 * e8) * 272 + 2 * s);
                d[0 * 136] = (bf16)(w.x & 0xffffu); d[1 * 136] = (bf16)(w.x >> 16); d[2 * 136] = (bf16)(w.y & 0xffffu); d[3 * 136] = (bf16)(w.y >> 16);
                d[4 * 136] = (bf16)(w.z & 0xffffu); d[5 * 136] = (bf16)(w.z >> 16); d[6 * 136] = (bf16)(w.w & 0xffffu); d[7 * 136] = (bf16)(w.w >> 16); }
            { const float* Sg = LST + (size_t)((b * 4 + h) * 32 + n) * 8192;
#pragma unroll
              for (int i = 0; i < 4; ++i) { const int task = tid + 512 * i, e4 = task >> 6, d = task & 63;
                  const f32x4 sv = *(const GAS f32x4*)(Sg + d * 128 + 4 * e4);
                  LAS bf16* o = (LAS bf16*)(lds + O_ST + (4 * e4) * 144 + 2 * d);
                  o[0 * 72] = (bf16)f2bf(sv.x); o[1 * 72] = (bf16)f2bf(sv.y); o[2 * 72] = (bf16)f2bf(sv.z); o[3 * 72] = (bf16)f2bf(sv.w); } }
            __syncthreads();
            bf16x8 qf[4];
#pragma unroll
            for (int ks = 0; ks < 4; ++ks) qf[ks] = *(const LAS bf16x8*)(lds + O_QP + (32 * cbk + c) * 144 + (16 * ks + 8 * hh) * 2);
            for (int sb = 0; sb <= cbk; ++sb) {
                f32x16 sc;
#pragma unroll
                for (int r = 0; r < 16; ++r) sc[r] = 0.f;
#pragma unroll
                for (int ks = 0; ks < 4; ++ks) { const bf16x8 kf = *(const LAS bf16x8*)(lds + O_KP + (32 * sb + c) * 144 + (16 * ks + 8 * hh) * 2);
                    sc = __builtin_amdgcn_mfma_f32_32x32x16_bf16(kf, qf[ks], sc, 0, 0, 0); }
#pragma unroll
                for (int g4 = 0; g4 < 4; ++g4) { float m[4];
#pragma unroll
                    for (int q = 0; q < 4; ++q) { const float sv = sc[4 * g4 + q]; m[q] = (sb < cbk || 8 * g4 + 4 * hh + q <= c) ? sv : 0.f; }
                    *(LAS v2u*)(lds + O_PI + cbk * 8704 + c * 272 + (32 * sb + 8 * g4 + 4 * hh) * 2) = (v2u){pk2(m[0], m[1]), pk2(m[2], m[3])}; }
            }
            f32x16 acc[2];
#pragma unroll
            for (int j = 0; j < 2; ++j) {
#pragma unroll
                for (int r = 0; r < 16; ++r) acc[j][r] = 0.f;
                const int eb = 2 * eh + j;
                for (int sb = 0; sb <= cbk; ++sb) {
#pragma unroll
                    for (int ks = 0; ks < 2; ++ks) { const bf16x8 af = *(const LAS bf16x8*)(lds + O_VT + (32 * eb + c) * 272 + (32 * sb + 16 * ks + 8 * hh) * 2);
                        const bf16x8 pf = *(const LAS bf16x8*)(lds + O_PI + cbk * 8704 + c * 272 + (32 * sb + 16 * ks + 8 * hh) * 2);
                        acc[j] = __builtin_amdgcn_mfma_f32_32x32x16_bf16(af, pf, acc[j], 0, 0, 0); }
                }
#pragma unroll
                for (int ks = 0; ks < 4; ++ks) { const bf16x8 sf = *(const LAS bf16x8*)(lds + O_ST + (32 * eb + c) * 144 + (16 * ks + 8 * hh) * 2);
                    acc[j] = __builtin_amdgcn_mfma_f32_32x32x16_bf16(sf, qf[ks], acc[j], 0, 0, 0); }
            }
            float sum = 0.f, sq = 0.f;
#pragma unroll
            for (int j = 0; j < 2; ++j)
#pragma unroll
                for (int r = 0; r < 16; ++r) { const float ov = acc[j][r]; sum += ov; sq += ov * ov; }
            sum += __shfl_xor(sum, 32); sq += __shfl_xor(sq, 32);
            LAS float* red = (LAS float*)(lds + O_RED);
            if (hh == 0) { red[(eh * 128 + 32 * cbk + c) * 2] = sum; red[(eh * 128 + 32 * cbk + c) * 2 + 1] = sq; }
            __syncthreads();
            sum += red[((eh ^ 1) * 128 + 32 * cbk + c) * 2]; sq += red[((eh ^ 1) * 128 + 32 * cbk + c) * 2 + 1];
            const float mean = sum * (1.f / 128.f); const float var = fmaxf(sq * (1.f / 128.f) - mean * mean, 0.f);
            const float rstd = 1.f / sqrtf(var + LN_EPS);
            { const size_t row = t0 + 32 * cbk + c;
#pragma unroll
              for (int j = 0; j < 2; ++j)
#pragma unroll
                  for (int g4 = 0; g4 < 4; ++g4) { const int e = 32 * (2 * eh + j) + 8 * g4 + 4 * hh;
                      const v2u gw2 = *(const GAS v2u*)(H0 + row * AB_IN + 1536 + h * 128 + e); const f32x4 gm = *(const GAS f32x4*)(ret_g + h * 128 + e);
                      const float g0 = bflo(gw2.x), g1 = bfhi(gw2.x), g2 = bflo(gw2.y), g3 = bfhi(gw2.y);
                      const float o0 = acc[j][4 * g4 + 0], o1 = acc[j][4 * g4 + 1], o2 = acc[j][4 * g4 + 2], o3 = acc[j][4 * g4 + 3];
                      const float y0 = (o0 - mean) * rstd * gm.x * (g0 / (1.f + __expf(-g0))), y1 = (o1 - mean) * rstd * gm.y * (g1 / (1.f + __expf(-g1)));
                      const float y2 = (o2 - mean) * rstd * gm.z * (g2 / (1.f + __expf(-g2))), y3 = (o3 - mean) * rstd * gm.w * (g3 / (1.f + __expf(-g3)));
                      *(GAS v2u*)(Y + row * D + 512 + h * 128 + e) = (v2u){pk2(y0, y1), pk2(y2, y3)}; } }
        }
        for (int gi = 0; gi < 4; ++gi) {
            const int w = 2 << gi;
            __syncthreads();
#pragma unroll
            for (int i = 0; i < 4; ++i) { const int task = tid + 512 * i, t = task >> 4, c8 = task & 15, pos = n * 128 + t; const int cnt = (pos + 1 < w) ? pos + 1 : w;
                const bf16* ur = H0 + (t0 + t) * AB_IN + gi * 128 + 8 * c8;
                float u0[8], sm[8]; unpack8(*(const GAS v4u*)ur, u0);
#pragma unroll
                for (int q = 0; q < 8; ++q) sm[q] = u0[q];
                for (int j = 1; j < cnt; ++j) { float uj[8]; unpack8(*(const GAS v4u*)(ur - (size_t)j * AB_IN), uj);
#pragma unroll
                    for (int q = 0; q < 8; ++q) sm[q] += uj[q]; }
                const float ic = 1.f / (float)cnt; float pv[8];
#pragma unroll
                for (int q = 0; q < 8; ++q) pv[q] = sm[q] * ic - u0[q];
                *(LAS v4u*)(lds + O_PT + t * 272 + 16 * c8) = pack8(pv); }
#pragma unroll
            for (int i = 0; i < 4; ++i) { const int piece = tid + 512 * i, d = piece >> 4, c16 = piece & 15;
                *(LAS v4u*)(lds + O_WT + d * 272 + 16 * c16) = *(const GAS v4u*)(PWT + (size_t)(gi * 128 + d) * 128 + 8 * c16); }
            __syncthreads();
            bf16x8 pfr[8];
#pragma unroll
            for (int ks = 0; ks < 8; ++ks) pfr[ks] = *(const LAS bf16x8*)(lds + O_PT + (32 * cbk + c) * 272 + (16 * ks + 8 * hh) * 2);
#pragma unroll
            for (int j = 0; j < 2; ++j) { const int db = 2 * eh + j;
                f32x16 a2;
#pragma unroll
                for (int r = 0; r < 16; ++r) a2[r] = 0.f;
#pragma unroll
                for (int ks = 0; ks < 8; ++ks) { const bf16x8 wf = *(const LAS bf16x8*)(lds + O_WT + (32 * db + c) * 272 + (16 * ks + 8 * hh) * 2);
                    a2 = __builtin_amdgcn_mfma_f32_32x32x16_bf16(wf, pfr[ks], a2, 0, 0, 0); }
#pragma unroll
                for (int g4 = 0; g4 < 4; ++g4) { const int d0 = 32 * db + 8 * g4 + 4 * hh; const f32x4 ps = *(const GAS f32x4*)(pool_scale + gi * 128 + d0);
                    const float y0 = a2[4 * g4 + 0] * ps.x, y1 = a2[4 * g4 + 1] * ps.y, y2 = a2[4 * g4 + 2] * ps.z, y3 = a2[4 * g4 + 3] * ps.w;
                    *(GAS v2u*)(Y + (t0 + 32 * cbk + c) * D + gi * 128 + d0) = (v2u){pk2(y0, y1), pk2(y2, y3)}; }
            }
        }
    }
    __syncthreads();
}
__device__ __forceinline__ void phase_ln(const bf16* Z, bf16* O, const float* g, const float* bb) {
    const int tid = threadIdx.x, lane = tid & 63, wave = tid >> 6;
    const int gw = blockIdx.x * NWAVES + wave, NGW = gridDim.x * NWAVES;
    for (int m = gw; m < T; m += NGW) {
        const GAS v2u* zr = (const GAS v2u*)(Z + (size_t)m * D) + lane;
        f32x4 v[4]; float s = 0.f;
#pragma unroll
        for (int j = 0; j < 4; ++j) { const v2u zw = zr[64 * j]; v[j] = (f32x4){bflo(zw.x), bfhi(zw.x), bflo(zw.y), bfhi(zw.y)}; s += (v[j].x + v[j].y) + (v[j].z + v[j].w); }
        const float mean = wave_sum(s) * (1.f / D); float s2 = 0.f;
#pragma unroll
        for (int j = 0; j < 4; ++j) { v[j] = v[j] - mean; s2 += (v[j].x * v[j].x + v[j].y * v[j].y) + (v[j].z * v[j].z + v[j].w * v[j].w); }
        const float rstd = 1.f / sqrtf(wave_sum(s2) * (1.f / D) + LN_EPS);
        GAS v2u* o8 = (GAS v2u*)(O + (size_t)m * D) + lane;
#pragma unroll
        for (int j = 0; j < 4; ++j) { const f32x4 gg = *((const GAS f32x4*)g + lane + 64 * j), b4 = *((const GAS f32x4*)bb + lane + 64 * j);
            v2u o; o.x = pk2(v[j].x * rstd * gg.x + b4.x, v[j].y * rstd * gg.y + b4.y); o.y = pk2(v[j].z * rstd * gg.z + b4.z, v[j].w * rstd * gg.w + b4.w); o8[64 * j] = o; }
    }
}
__device__ __forceinline__ void wave_argmax(float& bv, int& bi) {
#pragma unroll
    for (int off = 32; off >= 1; off >>= 1) { const float ov = __shfl_xor(bv, off); const int oi = __shfl_xor(bi, off);
        if (ov > bv || (ov == bv && oi < bi)) { bv = ov; bi = oi; } }
}
__device__ __forceinline__ void phase_topk(LAS unsigned char* lds, const bf16* Q, const float* keys  , int* EID, float* GATE) {
    const int tid = threadIdx.x, lane = tid & 63, wave = tid >> 6;
    LAS float* kl = (LAS float*)lds;
    LAS float* qt = (LAS float*)(lds + 66048);
    LAS float* sc = (LAS float*)(lds + 82560);
    for (int item = blockIdx.x; item < (T / 32) * 8; item += gridDim.x) {
        const int h = item & 7, tile = item >> 3; const size_t tok0 = (size_t)tile * 32;
        for (int p = 0; p < 2; ++p) {
            const float* kg = keys + (size_t)((h * 2 + p) * 128) * 128;
            for (int idx = tid; idx < 16384; idx += NTHR) { const int k = idx >> 7, d = idx & 127; kl[k * 129 + d] = kg[idx]; }
            for (int idx = tid; idx < 4096; idx += NTHR) { const int t = idx >> 7, d = idx & 127; qt[t * 129 + d] = bf2f(Q[(tok0 + t) * 2048 + h * 256 + p * 128 + d]); }
            __syncthreads();
            { const int t = tid >> 4, kg16 = tid & 15;
              for (int jj = 0; jj < 8; ++jj) { const int k = kg16 + 16 * jj; float dot = 0.f;
#pragma unroll 16
                  for (int d = 0; d < 128; ++d) dot += qt[t * 129 + d] * kl[k * 129 + d];
                  sc[(t * 2 + p) * 128 + k] = dot; } }
            __syncthreads();
        }
        for (int tt = 0; tt < 4; ++tt) {
            const int t = wave * 4 + tt;
            float tv[2]; int ti[2];
#pragma unroll
            for (int p = 0; p < 2; ++p) {
                float v0 = sc[(t * 2 + p) * 128 + lane], v1 = sc[(t * 2 + p) * 128 + lane + 64];
                float mv = 0.f; int mi = 0;
                for (int j = 0; j < 16; ++j) {
                    float bv; int bi; if (v0 >= v1) { bv = v0; bi = lane; } else { bv = v1; bi = lane + 64; }
                    wave_argmax(bv, bi);
                    if (lane == j) { mv = bv; mi = bi; }
                    if (bi == lane) v0 = -INFINITY; if (bi == lane + 64) v1 = -INFINITY;
                }
                tv[p] = mv; ti[p] = mi;
            }
            float cv[4];
#pragma unroll
            for (int m = 0; m < 4; ++m) { const int cidx = lane + 64 * m; cv[m] = __shfl(tv[0], cidx >> 4) + __shfl(tv[1], cidx & 15); }
            float bestv = 0.f; int bestc = 0;
            for (int j = 0; j < 16; ++j) {
                float bv = cv[0]; int bi = lane;
#pragma unroll
                for (int m = 1; m < 4; ++m) if (cv[m] > bv) { bv = cv[m]; bi = lane + 64 * m; }
                wave_argmax(bv, bi);
                if (lane == j) { bestv = bv; bestc = bi; }
#pragma unroll
                for (int m = 0; m < 4; ++m) if (bi == lane + 64 * m) cv[m] = -INFINITY;
            }
            const float mx = __shfl(bestv, 0);
            const float ex = (lane < 16) ? expf(bestv - mx) : 0.f;
            const float den = wave_sum(ex);
            const int ia = __shfl(ti[0], bestc >> 4), ib = __shfl(ti[1], bestc & 15);
            if (lane < 16) { const size_t o = (tok0 + t) * 128 + h * 16 + lane; EID[o] = ia * 128 + ib; GATE[o] = ex / den; }
        }
        __syncthreads();
    }
}

#define CEF_D(a, b) { const float hi_ = fmaxf((a), (b)), lo_ = fminf((a), (b)); (a) = hi_; (b) = lo_; }
#define CEF_A(a, b) { const float hi_ = fmaxf((a), (b)), lo_ = fminf((a), (b)); (a) = lo_; (b) = hi_; }
#define CEP_D(ka, pa, kb, pb) { const bool sw_ = (kb) > (ka); const float k0_ = sw_ ? (kb) : (ka), k1_ = sw_ ? (ka) : (kb); const int p0_ = sw_ ? (pb) : (pa), p1_ = sw_ ? (pa) : (pb); (ka) = k0_; (kb) = k1_; (pa) = p0_; (pb) = p1_; }
template <int OFF, int NV> __device__ __forceinline__ void bsort16_desc(float (&v)[NV]) {
#pragma unroll
    for (int k = 2; k <= 16; k <<= 1) {
#pragma unroll
        for (int j = k >> 1; j > 0; j >>= 1) {
#pragma unroll
            for (int i = 0; i < 16; ++i) { const int l = i ^ j;
                if (l > i) { if ((i & k) == 0) CEF_D(v[OFF + i], v[OFF + l]) else CEF_A(v[OFF + i], v[OFF + l]) } }
        }
    }
}
template <int OA, int NV> __device__ __forceinline__ void bmerge16_desc(float (&v)[NV]) {
#pragma unroll
    for (int j = 8; j > 0; j >>= 1) {
#pragma unroll
        for (int i = 0; i < 16; ++i) { const int l = i ^ j; if (l > i) CEF_D(v[OA + i], v[OA + l]) }
    }
}
template <int OA, int OB, int NV> __device__ __forceinline__ void merge_top16(float (&v)[NV]) {
#pragma unroll
    for (int i = 0; i < 16; ++i) v[OA + i] = fmaxf(v[OA + i], v[OB + 15 - i]);
    bmerge16_desc<OA, NV>(v);
}
template <int OFF, int NV> __device__ __forceinline__ void bsort16p_desc(float (&v)[NV], int (&q)[NV]) {
#pragma unroll
    for (int k = 2; k <= 16; k <<= 1) {
#pragma unroll
        for (int j = k >> 1; j > 0; j >>= 1) {
#pragma unroll
            for (int i = 0; i < 16; ++i) { const int l = i ^ j;
                if (l > i) { if ((i & k) == 0) CEP_D(v[OFF + i], q[OFF + i], v[OFF + l], q[OFF + l]) else CEP_D(v[OFF + l], q[OFF + l], v[OFF + i], q[OFF + i]) } }
        }
    }
}
template <int OA, int NV> __device__ __forceinline__ void bmerge16p_desc(float (&v)[NV], int (&q)[NV]) {
#pragma unroll
    for (int j = 8; j > 0; j >>= 1) {
#pragma unroll
        for (int i = 0; i < 16; ++i) { const int l = i ^ j; if (l > i) CEP_D(v[OA + i], q[OA + i], v[OA + l], q[OA + l]) }
    }
}
__host__ __device__ constexpr int pair_i(int s) { return s < 16 ? 0 : s < 24 ? 1 : s < 29 ? 2 : s < 33 ? 3 : s < 36 ? 4 : s < 38 ? 5 : s < 40 ? 6 : s < 42 ? 7 : (s - 42 + 8); }
__host__ __device__ constexpr int pair_j(int s) { return s < 16 ? s : s < 24 ? s - 16 : s < 29 ? s - 24 : s < 33 ? s - 29 : s < 36 ? s - 33 : s < 38 ? s - 36 : s < 40 ? s - 38 : s < 42 ? s - 40 : 0; }
__device__ __forceinline__ void phase_topk_fast(LAS unsigned char* lds, const bf16* Q, const bf16* keysb  , int* EID, float* GATE) {
    const int tid = threadIdx.x, lane = tid & 63, wave = __builtin_amdgcn_readfirstlane(tid >> 6);
    const int c = lane & 31, hh = lane >> 5;
    for (int hi = blockIdx.x; hi < 256; hi += gridDim.x) {
        const int h = hi & 7, rank = hi >> 3;
        __syncthreads();
        for (int idx = tid; idx < 2 * 128 * 16; idx += NTHR) { const int rowi = idx >> 4, ch = idx & 15;
            const v4u kv = *(const GAS v4u*)(keysb + (size_t)h * 32768 + rowi * 128 + ch * 8);
            *(LAS v4u*)(lds + rowi * 272 + ch * 16) = kv; }
        __syncthreads();
        for (int it = 0; it < 4; ++it) {
            const int tile = rank * 8 + wave + 256 * it;
            const size_t tok0 = (size_t)tile * 32;
            float ta[16], tb[16];
#pragma unroll
            for (int p = 0; p < 2; ++p) {
                bf16x8 bq[8];
                const bf16* qrow = Q + (tok0 + c) * 2048 + h * 256 + p * 128 + 8 * hh;
#pragma unroll
                for (int ks = 0; ks < 8; ++ks) bq[ks] = *(const GAS bf16x8*)(qrow + 16 * ks);
                f32x16 acc[4];
#pragma unroll
                for (int blk = 0; blk < 4; ++blk) {
#pragma unroll
                    for (int r = 0; r < 16; ++r) acc[blk][r] = 0.f;
#pragma unroll
                    for (int ks = 0; ks < 8; ++ks) { const bf16x8 a = *(const LAS bf16x8*)(lds + (p * 128 + 32 * blk + c) * 272 + (16 * ks + 8 * hh) * 2);
                        acc[blk] = __builtin_amdgcn_mfma_f32_32x32x16_bf16(a, bq[ks], acc[blk], 0, 0, 0); }
                }
                float v[64];
#pragma unroll
                for (int blk = 0; blk < 4; ++blk)
#pragma unroll
                    for (int r = 0; r < 16; ++r)
                    { const float sv = acc[blk][r]; v[blk * 16 + r] = __uint_as_float((__float_as_uint(sv) & ~127u) | (unsigned)(32 * blk + (r & 3) + 8 * (r >> 2)) | (unsigned)(hh << 2)); }
                __builtin_amdgcn_sched_barrier(0);
                bsort16_desc<0, 64>(v); bsort16_desc<16, 64>(v); bsort16_desc<32, 64>(v); bsort16_desc<48, 64>(v);
                merge_top16<0, 16, 64>(v); merge_top16<32, 48, 64>(v); merge_top16<0, 32, 64>(v);
                float o[16];
#pragma unroll
                for (int i = 0; i < 16; ++i) o[i] = __shfl_xor(v[i], 32);
#pragma unroll
                for (int i = 0; i < 16; ++i) v[i] = fmaxf(v[i], o[15 - i]);
                bmerge16_desc<0, 64>(v);
#pragma unroll
                for (int i = 0; i < 16; ++i) { if (p == 0) ta[i] = v[i]; else tb[i] = v[i]; }
                __builtin_amdgcn_sched_barrier(0);
            }
            float av[16], bv[16]; int ai[16], bi[16];
#pragma unroll
            for (int i = 0; i < 16; ++i) { const unsigned ua = __builtin_bit_cast(unsigned, ta[i]), ub = __builtin_bit_cast(unsigned, tb[i]);
                av[i] = __builtin_bit_cast(float, ua & ~127u); ai[i] = (int)(ua & 127u); bv[i] = __builtin_bit_cast(float, ub & ~127u); bi[i] = (int)(ub & 127u); }
            float ck[32]; int cp[32];
#pragma unroll
            for (int s2 = 0; s2 < 32; ++s2) {
                const float k0 = av[pair_i(s2)] + bv[pair_j(s2)]; const int p0 = (ai[pair_i(s2)] << 7) | bi[pair_j(s2)];
                float k1 = -INFINITY; int p1 = 0;
                if (s2 + 32 < 50) { k1 = av[pair_i(s2 + 32 < 50 ? s2 + 32 : 0)] + bv[pair_j(s2 + 32 < 50 ? s2 + 32 : 0)]; p1 = (ai[pair_i(s2 + 32 < 50 ? s2 + 32 : 0)] << 7) | bi[pair_j(s2 + 32 < 50 ? s2 + 32 : 0)]; }
                ck[s2] = hh ? k1 : k0; cp[s2] = hh ? p1 : p0;
            }
            __builtin_amdgcn_sched_barrier(0);
            bsort16p_desc<0, 32>(ck, cp); bsort16p_desc<16, 32>(ck, cp);
#pragma unroll
            for (int i = 0; i < 16; ++i) { if (ck[16 + 15 - i] > ck[i]) { ck[i] = ck[16 + 15 - i]; cp[i] = cp[16 + 15 - i]; } }
            bmerge16p_desc<0, 32>(ck, cp);
            { float ok[16]; int op[16];
#pragma unroll
              for (int i = 0; i < 16; ++i) { ok[i] = __shfl_xor(ck[i], 32); op[i] = __shfl_xor(cp[i], 32); }
#pragma unroll
              for (int i = 0; i < 16; ++i) { if (ok[15 - i] > ck[i]) { ck[i] = ok[15 - i]; cp[i] = op[15 - i]; } } }
            bmerge16p_desc<0, 32>(ck, cp);
            float ex[16]; float sum = 0.f;
#pragma unroll
            for (int i = 0; i < 16; ++i) { ex[i] = __expf(ck[i] - ck[0]); sum += ex[i]; }
            const float inv = 1.f / sum;
            if (hh == 0) {
                int* eo = EID + (tok0 + c) * 128 + h * 16; float* go = GATE + (tok0 + c) * 128 + h * 16;
#pragma unroll
                for (int i = 0; i < 4; ++i) { *(GAS v4u*)(eo + 4 * i) = (v4u){(unsigned)cp[4 * i], (unsigned)cp[4 * i + 1], (unsigned)cp[4 * i + 2], (unsigned)cp[4 * i + 3]};
                    *(GAS f32x4*)(go + 4 * i) = (f32x4){ex[4 * i] * inv, ex[4 * i + 1] * inv, ex[4 * i + 2] * inv, ex[4 * i + 3] * inv}; }
            }
        }
    }
    __syncthreads();
}
template <bool FINAL>
__device__ __forceinline__ void phase_gather(const bf16* X, const int* EID, const float* GATE, const float* U, const float* V, const float* g, const float* bb, bf16* Ob, float* Of) {
    const int tid = threadIdx.x, lane = tid & 63, wave = tid >> 6;
    const int gw = blockIdx.x * NWAVES + wave, NGW = gridDim.x * NWAVES;
    for (int t = gw; t < T; t += NGW) {
        f32x4 x[4], acc[4];
#pragma unroll
        for (int j = 0; j < 4; ++j) { const v2u w = *((const GAS v2u*)(X + (size_t)t * D) + lane + 64 * j);
            x[j] = (f32x4){bflo(w.x), bfhi(w.x), bflo(w.y), bfhi(w.y)}; acc[j] = (f32x4){0.f, 0.f, 0.f, 0.f}; }
        const int e0 = EID[(size_t)t * 128 + lane], e1 = EID[(size_t)t * 128 + 64 + lane];
        const float g0 = GATE[(size_t)t * 128 + lane], g1 = GATE[(size_t)t * 128 + 64 + lane];
#pragma unroll 2
        for (int k = 0; k < 128; ++k) {
            const int e = (k < 64) ? __shfl(e0, k) : __shfl(e1, k - 64);
            const float gt = (k < 64) ? __shfl(g0, k) : __shfl(g1, k - 64);
            const GAS f32x4* ur = (const GAS f32x4*)(U + (size_t)e * D) + lane;
            float dot = 0.f;
#pragma unroll
            for (int j = 0; j < 4; ++j) { const f32x4 u = ur[64 * j]; dot += (x[j].x * u.x + x[j].y * u.y) + (x[j].z * u.z + x[j].w * u.w); }
            dot = wave_sum(dot);
            const float a = 0.5f * dot * (1.f + erff(dot * 0.70710678118654752f));
            const float cf = gt * a;
            const GAS f32x4* vr = (const GAS f32x4*)(V + (size_t)e * D) + lane;
#pragma unroll
            for (int j = 0; j < 4; ++j) { const f32x4 v = vr[64 * j]; acc[j] += cf * v; }
        }
        float s = 0.f;
#pragma unroll
        for (int j = 0; j < 4; ++j) { acc[j] = ALPHA * x[j] + acc[j]; s += (acc[j].x + acc[j].y) + (acc[j].z + acc[j].w); }
        const float mean = wave_sum(s) * (1.f / D); float s2 = 0.f;
#pragma unroll
        for (int j = 0; j < 4; ++j) { acc[j] = acc[j] - mean; s2 += (acc[j].x * acc[j].x + acc[j].y * acc[j].y) + (acc[j].z * acc[j].z + acc[j].w * acc[j].w); }
        const float rstd = 1.f / sqrtf(wave_sum(s2) * (1.f / D) + LN_EPS);
#pragma unroll
        for (int j = 0; j < 4; ++j) { const f32x4 gg = *((const GAS f32x4*)g + lane + 64 * j), b4 = *((const GAS f32x4*)bb + lane + 64 * j);
            const f32x4 o = acc[j] * rstd * gg + b4;
            if (FINAL) *((GAS f32x4*)(Of + (size_t)t * D) + lane + 64 * j) = o;
            else { v2u w; w.x = pk2(o.x, o.y); w.y = pk2(o.z, o.w); *((GAS v2u*)(Ob + (size_t)t * D) + lane + 64 * j) = w; } }
    }
}

typedef float f32x2 __attribute__((ext_vector_type(2)));
__device__ __forceinline__ void phase_convert_tables(const float* U, const float* V, unsigned char* ws) {
    const int tid = threadIdx.x, lane = tid & 63, wave = tid >> 6;
    const int gw = blockIdx.x * NWAVES + wave, NGW = gridDim.x * NWAVES;
    for (int row = gw; row < 4 * NEXP; row += NGW) {
        const bool isv = row >= 2 * NEXP; const int r = row & (2 * NEXP - 1);
        const GAS f32x4* src = (const GAS f32x4*)((isv ? V : U) + (size_t)r * D) + 4 * lane; const int sstep = 1;
        f32x4 v[4]; float m = 0.f;
#pragma unroll
        for (int j = 0; j < 4; ++j) { v[j] = src[sstep * j]; m = fmaxf(fmaxf(m, fmaxf(fabsf(v[j].x), fabsf(v[j].y))), fmaxf(fabsf(v[j].z), fabsf(v[j].w))); }
#pragma unroll
        for (int o = 1; o < 64; o <<= 1) m = fmaxf(m, __shfl_xor(m, o));
        m = fmaxf(m, 1e-30f);
        const float sc = 7.f / m;
        unsigned w0 = 0u, w1 = 0u;
#define Q4(x) fminf(fmaxf((x) * sc, -6.f), 6.f)
        w0 = __builtin_amdgcn_cvt_scalef32_pk_fp4_f32(w0, Q4(v[0].x), Q4(v[0].y), 1.0f, 0); w0 = __builtin_amdgcn_cvt_scalef32_pk_fp4_f32(w0, Q4(v[0].z), Q4(v[0].w), 1.0f, 1);
        w0 = __builtin_amdgcn_cvt_scalef32_pk_fp4_f32(w0, Q4(v[1].x), Q4(v[1].y), 1.0f, 2); w0 = __builtin_amdgcn_cvt_scalef32_pk_fp4_f32(w0, Q4(v[1].z), Q4(v[1].w), 1.0f, 3);
        w1 = __builtin_amdgcn_cvt_scalef32_pk_fp4_f32(w1, Q4(v[2].x), Q4(v[2].y), 1.0f, 0); w1 = __builtin_amdgcn_cvt_scalef32_pk_fp4_f32(w1, Q4(v[2].z), Q4(v[2].w), 1.0f, 1);
        w1 = __builtin_amdgcn_cvt_scalef32_pk_fp4_f32(w1, Q4(v[3].x), Q4(v[3].y), 1.0f, 2); w1 = __builtin_amdgcn_cvt_scalef32_pk_fp4_f32(w1, Q4(v[3].z), Q4(v[3].w), 1.0f, 3);
#undef Q4
        *((GAS v2u*)(ws + (isv ? WS_V8 : WS_U8) + (size_t)r * 512) + lane) = (v2u){w0, w1};
        if (lane == 0) ((float*)(ws + (isv ? WS_DQV : WS_DQU)))[r] = m * (1.f / 7.f);
    }
}
__host__ __device__ constexpr int rev4(int i) { return ((i & 1) << 3) | ((i & 2) << 1) | ((i & 4) >> 1) | ((i & 8) >> 3); }
#define FMA2(a, b, c) __builtin_elementwise_fma((a), (b), (c))
#define CVT8(w, hi) __builtin_amdgcn_cvt_pk_f32_fp8((int)(w), (hi))
template <bool FINAL, int MODE  >
__device__ __forceinline__ void phase_gather8(const bf16* X, const int* EID, float* GATE, const unsigned char* U8, const unsigned char* V8, const float* DQU, const float* DQV,
                                              const float* g, const float* bb, bf16* Ob, float* Of) {
    const int tid = threadIdx.x, lane = tid & 63, wave = tid >> 6;
    const int gw = blockIdx.x * NWAVES + wave, NGW = gridDim.x * NWAVES;
    const bool b0 = (lane & 1) != 0, b1 = (lane & 2) != 0, b2 = (lane & 4) != 0, b3 = (lane & 8) != 0; const int myrow = lane >> 4;
    for (int t = gw; t < T; t += NGW) {
        f32x2 x[8];
#pragma unroll
        for (int j = 0; j < 4; ++j) { const v2u w = *((const GAS v2u*)(X + (size_t)t * D) + lane + 64 * j);
            x[2 * j] = (f32x2){bflo(w.x), bfhi(w.x)}; x[2 * j + 1] = (f32x2){bflo(w.y), bfhi(w.y)}; }
        const int e0 = EID[(size_t)t * 128 + lane], e1 = EID[(size_t)t * 128 + 64 + lane];
        const float gt0 = GATE[(size_t)t * 128 + lane], gt1 = GATE[(size_t)t * 128 + 64 + lane];
        const float dqu0 = DQU[e0], dqu1 = DQU[e1], dqv0 = DQV[e0], dqv1 = DQV[e1];
        float act0 = 0.f, act1 = 0.f;
        if (MODE != 2) {
#pragma unroll
        for (int r = 0; r < 2; ++r) {
            const int er = r ? e1 : e0;
            for (int row = 0; row < 4; ++row) {
                v4u w[16];
#pragma unroll
                for (int i = 0; i < 16; ++i) { const int e = __builtin_amdgcn_readlane(er, row * 16 + rev4(i)); w[i] = *((const GAS v4u*)(U8 + (size_t)e * 1024) + lane); }
                float p[16];
#pragma unroll
                for (int i = 0; i < 16; ++i) { f32x2 a = (f32x2){0.f, 0.f};
                    a = FMA2(x[0], CVT8(w[i].x, false), a); a = FMA2(x[1], CVT8(w[i].x, true), a);
                    a = FMA2(x[2], CVT8(w[i].y, false), a); a = FMA2(x[3], CVT8(w[i].y, true), a);
                    a = FMA2(x[4], CVT8(w[i].z, false), a); a = FMA2(x[5], CVT8(w[i].z, true), a);
                    a = FMA2(x[6], CVT8(w[i].w, false), a); a = FMA2(x[7], CVT8(w[i].w, true), a);
                    p[i] = a.x + a.y; }
                float r8[8], r4[4], r2[2];
#pragma unroll
                for (int i = 0; i < 8; ++i) { const float keep = b0 ? p[8 + i] : p[i], send = b0 ? p[i] : p[8 + i]; r8[i] = keep + __shfl_xor(send, 1); }
#pragma unroll
                for (int i = 0; i < 4; ++i) { const float keep = b1 ? r8[4 + i] : r8[i], send = b1 ? r8[i] : r8[4 + i]; r4[i] = keep + __shfl_xor(send, 2); }
#pragma unroll
                for (int i = 0; i < 2; ++i) { const float keep = b2 ? r4[2 + i] : r4[i], send = b2 ? r4[i] : r4[2 + i]; r2[i] = keep + __shfl_xor(send, 4); }
                float r1 = (b3 ? r2[1] : r2[0]) + __shfl_xor(b3 ? r2[0] : r2[1], 8);
                r1 += __shfl_xor(r1, 16); r1 += __shfl_xor(r1, 32);
                if (myrow == row) { if (r == 0) act0 = r1; else act1 = r1; }
            }
        }
        }
        float c0, c1;
        if (MODE != 2) { const float a0 = act0 * dqu0, a1 = act1 * dqu1;
          c0 = gt0 * (0.5f * a0 * (1.f + erff(a0 * 0.70710678118654752f))) * dqv0;
          c1 = gt1 * (0.5f * a1 * (1.f + erff(a1 * 0.70710678118654752f))) * dqv1; }
        else { c0 = gt0; c1 = gt1; }
        if (MODE == 1) { GATE[(size_t)t * 128 + lane] = c0; GATE[(size_t)t * 128 + 64 + lane] = c1; continue; }
        f32x2 acc[8];
#pragma unroll
        for (int j = 0; j < 8; ++j) acc[j] = (f32x2){0.f, 0.f};
#pragma unroll
        for (int r = 0; r < 2; ++r) {
            const int er = r ? e1 : e0; const int cr = __builtin_bit_cast(int, r ? c1 : c0);
            for (int row = 0; row < 4; ++row) {
                v4u w[16];
#pragma unroll
                for (int i = 0; i < 16; ++i) { const int e = __builtin_amdgcn_readlane(er, row * 16 + i); w[i] = *((const GAS v4u*)(V8 + (size_t)e * 1024) + lane); }
#pragma unroll
                for (int i = 0; i < 16; ++i) { const float cf = __builtin_bit_cast(float, __builtin_amdgcn_readlane(cr, row * 16 + i)); const f32x2 c2 = (f32x2){cf, cf};
                    acc[0] = FMA2(c2, CVT8(w[i].x, false), acc[0]); acc[1] = FMA2(c2, CVT8(w[i].x, true), acc[1]);
                    acc[2] = FMA2(c2, CVT8(w[i].y, false), acc[2]); acc[3] = FMA2(c2, CVT8(w[i].y, true), acc[3]);
                    acc[4] = FMA2(c2, CVT8(w[i].z, false), acc[4]); acc[5] = FMA2(c2, CVT8(w[i].z, true), acc[5]);
                    acc[6] = FMA2(c2, CVT8(w[i].w, false), acc[6]); acc[7] = FMA2(c2, CVT8(w[i].w, true), acc[7]); }
            }
        }
        float s = 0.f;
#pragma unroll
        for (int j = 0; j < 8; ++j) { acc[j] = x[j] * ALPHA + acc[j]; s += acc[j].x + acc[j].y; }
        const float mean = wave_sum(s) * (1.f / D); float s2 = 0.f;
#pragma unroll
        for (int j = 0; j < 8; ++j) { acc[j] = acc[j] - mean; s2 += acc[j].x * acc[j].x + acc[j].y * acc[j].y; }
        const float rstd = 1.f / sqrtf(wave_sum(s2) * (1.f / D) + LN_EPS);
#pragma unroll
        for (int j = 0; j < 4; ++j) { const f32x4 gg = *((const GAS f32x4*)g + lane + 64 * j), b4 = *((const GAS f32x4*)bb + lane + 64 * j);
            const f32x4 o = (f32x4){acc[2 * j].x, acc[2 * j].y, acc[2 * j + 1].x, acc[2 * j + 1].y} * rstd * gg + b4;
            if (FINAL) *((GAS f32x4*)(Of + (size_t)t * D) + lane + 64 * j) = o;
            else { v2u w; w.x = pk2(o.x, o.y); w.y = pk2(o.z, o.w); *((GAS v2u*)(Ob + (size_t)t * D) + lane + 64 * j) = w; } }
    }
}
__device__ __forceinline__ void phase_hgrn(LAS unsigned char* lds, unsigned char* ws) {
    const int tid = threadIdx.x;
    const bf16* CQ = (const bf16*)(ws + WS_CQ); const bf16* CK = (const bf16*)(ws + WS_CK); const bf16* CV = (const bf16*)(ws + WS_CV); bf16* O = (bf16*)(ws + WS_O);
    LAS float* fL = (LAS float*)lds;
    LAS float* kL = fL + 4096; LAS float* qL = kL + 4096;
    LAS float* vL = qL + 4096;
    LAS float* part = vL + 1024;
    for (int item = blockIdx.x; item < 256; item += gridDim.x) {
        const int es = item & 3, h = (item >> 2) & 7, b = item >> 5;
        const int e = tid & 31, dg = tid >> 5;
        float S[8];
#pragma unroll
        for (int j = 0; j < 8; ++j) S[j] = 0.f;
        for (int blk = 0; blk < SEQ / 32; ++blk) {
            const size_t t0 = (size_t)b * SEQ + blk * 32;
            for (int idx = tid; idx < 4096; idx += NTHR) { const int s = idx >> 7, d = idx & 127; const size_t o = (t0 + s) * D + h * 128 + d;
                const float kk = bf2f(CK[o]); kL[idx] = kk; fL[idx] = 1.f - kk; qL[idx] = bf2f(CQ[o]); }
            for (int idx = tid; idx < 1024; idx += NTHR) { const int s = idx >> 5, ee = idx & 31; vL[idx] = bf2f(CV[(t0 + s) * D + h * 128 + es * 32 + ee]); }
            __syncthreads();
            for (int s = 0; s < 32; ++s) { const float v = vL[s * 32 + e]; float po = 0.f;
#pragma unroll
                for (int j = 0; j < 8; ++j) { const int d = dg * 8 + j; S[j] = fL[s * 128 + d] * S[j] + kL[s * 128 + d] * v; po += qL[s * 128 + d] * S[j]; }
                part[(s * 16 + dg) * 32 + e] = po; }
            __syncthreads();
            for (int idx = tid; idx < 1024; idx += NTHR) { const int s = idx >> 5, ee = idx & 31; float o = 0.f;
#pragma unroll
                for (int g = 0; g < 16; ++g) o += part[(s * 16 + g) * 32 + ee];
                O[(t0 + s) * D + h * 128 + es * 32 + ee] = (bf16)f2bf(o); }
            __syncthreads();
        }
    }
}


#define GROW(wb, i_, tab, ereg, lsel) (wb)[i_] = *((const GAS v2u*)((tab) + (size_t)__builtin_amdgcn_readlane((ereg), (lsel)) * 512) + lane)
#define CVT4(wd, bs) __builtin_amdgcn_cvt_scalef32_pk_f32_fp4((wd), 1.0f, (bs))
#define CVT4H(wd, bs) __builtin_amdgcn_cvt_scalef32_pk_f16_fp4((wd), 1.0f, (bs))
typedef _Float16 h16x2 __attribute__((ext_vector_type(2)));
__device__ __forceinline__ void phase_gather_u(const bf16* X, const int* EID, float* GATE, const unsigned char* U8, const float* DQU, const float* DQV) {
    const int tid = threadIdx.x, lane = tid & 63, wave = tid >> 6;
    const int gw = blockIdx.x * NWAVES + wave, NGW = gridDim.x * NWAVES;
    const bool b0 = (lane & 1) != 0, b1 = (lane & 2) != 0, b2 = (lane & 4) != 0, b3 = (lane & 8) != 0; const int myrow = lane >> 4;
    int t = gw;
    if (t < T) {
    v2u xr[4]; int e0, e1; float gt0, gt1;
#pragma unroll
    for (int j = 0; j < 4; ++j) xr[j] = *((const GAS v2u*)(X + (size_t)t * D) + lane + 64 * j);
    e0 = EID[(size_t)t * 128 + lane]; e1 = EID[(size_t)t * 128 + 64 + lane]; gt0 = GATE[(size_t)t * 128 + lane]; gt1 = GATE[(size_t)t * 128 + 64 + lane];
    v2u wA[16], wB[16];
#pragma unroll
    for (int i = 0; i < 16; ++i) GROW(wA, i, U8, e0, rev4(i));
#pragma unroll
    for (int i = 0; i < 16; ++i) GROW(wB, i, U8, e0, 16 + rev4(i));
    for (;;) {
        const int tn = t + NGW; const bool has_next = tn < T;
        v2u nxr[4]; int ne0 = e0, ne1 = e1; float ngt0 = 0.f, ngt1 = 0.f;
        if (has_next) {
#pragma unroll
            for (int j = 0; j < 4; ++j) nxr[j] = *((const GAS v2u*)(X + (size_t)tn * D) + lane + 64 * j);
            ne0 = EID[(size_t)tn * 128 + lane]; ne1 = EID[(size_t)tn * 128 + 64 + lane]; ngt0 = GATE[(size_t)tn * 128 + lane]; ngt1 = GATE[(size_t)tn * 128 + 64 + lane];
        }
        const float dqu0 = DQU[e0], dqu1 = DQU[e1], dqv0 = DQV[e0], dqv1 = DQV[e1];
        h16x2 x[8];
#pragma unroll
        for (int j = 0; j < 4; ++j) { x[2 * j] = (h16x2){(_Float16)bflo(xr[j].x), (_Float16)bfhi(xr[j].x)}; x[2 * j + 1] = (h16x2){(_Float16)bflo(xr[j].y), (_Float16)bfhi(xr[j].y)}; }
        float act0 = 0.f, act1 = 0.f;
#define UBATCH(w, R, ROW, NEREG, NBASE) { float p[16]; \
            _Pragma("unroll") for (int i = 0; i < 16; ++i) { float a0_ = 0.f, a1_ = 0.f; \
                a0_ = __builtin_amdgcn_fdot2(x[0], CVT4H(w[i].x, 0), a0_, false); a1_ = __builtin_amdgcn_fdot2(x[1], CVT4H(w[i].x, 1), a1_, false); \
                a0_ = __builtin_amdgcn_fdot2(x[2], CVT4H(w[i].x, 2), a0_, false); a1_ = __builtin_amdgcn_fdot2(x[3], CVT4H(w[i].x, 3), a1_, false); \
                a0_ = __builtin_amdgcn_fdot2(x[4], CVT4H(w[i].y, 0), a0_, false); a1_ = __builtin_amdgcn_fdot2(x[5], CVT4H(w[i].y, 1), a1_, false); \
                a0_ = __builtin_amdgcn_fdot2(x[6], CVT4H(w[i].y, 2), a0_, false); a1_ = __builtin_amdgcn_fdot2(x[7], CVT4H(w[i].y, 3), a1_, false); \
                p[i] = a0_ + a1_; GROW(w, i, U8, NEREG, (NBASE) + rev4(i)); if ((i & 3) == 3) __builtin_amdgcn_sched_barrier(0); } \
            float r8[8], r4[4], r2[2]; \
            _Pragma("unroll") for (int i = 0; i < 8; ++i) { const float keep = b0 ? p[8 + i] : p[i], send = b0 ? p[i] : p[8 + i]; r8[i] = keep + __shfl_xor(send, 1); } \
            _Pragma("unroll") for (int i = 0; i < 4; ++i) { const float keep = b1 ? r8[4 + i] : r8[i], send = b1 ? r8[i] : r8[4 + i]; r4[i] = keep + __shfl_xor(send, 2); } \
            _Pragma("unroll") for (int i = 0; i < 2; ++i) { const float keep = b2 ? r4[2 + i] : r4[i], send = b2 ? r4[i] : r4[2 + i]; r2[i] = keep + __shfl_xor(send, 4); } \
            float r1 = (b3 ? r2[1] : r2[0]) + __shfl_xor(b3 ? r2[0] : r2[1], 8); \
            r1 += __shfl_xor(r1, 16); r1 += __shfl_xor(r1, 32); \
            if (myrow == (ROW)) { if ((R) == 0) act0 = r1; else act1 = r1; } }
        UBATCH(wA, 0, 0, e0, 32) UBATCH(wB, 0, 1, e0, 48) UBATCH(wA, 0, 2, e1, 0) UBATCH(wB, 0, 3, e1, 16)
        UBATCH(wA, 1, 0, e1, 32) UBATCH(wB, 1, 1, e1, 48) UBATCH(wA, 1, 2, ne0, 0) UBATCH(wB, 1, 3, ne0, 16)
#undef UBATCH
        { const float a0 = act0 * dqu0, a1 = act1 * dqu1;
          GATE[(size_t)t * 128 + lane] = gt0 * (0.5f * a0 * (1.f + erff(a0 * 0.70710678118654752f))) * dqv0;
          GATE[(size_t)t * 128 + 64 + lane] = gt1 * (0.5f * a1 * (1.f + erff(a1 * 0.70710678118654752f))) * dqv1; }
        if (!has_next) break;
        t = tn; e0 = ne0; e1 = ne1; gt0 = ngt0; gt1 = ngt1;
#pragma unroll
        for (int j = 0; j < 4; ++j) xr[j] = nxr[j];
    }
    }
}
template <bool FINAL, int EMASK = 0x7fffffff>
__device__ __forceinline__ void phase_gather_v(const bf16* X, const int* EID, const float* COEF, const unsigned char* V8, const float* g, const float* bb, bf16* Ob, float* Of) {
    const int tid = threadIdx.x, lane = tid & 63, wave = tid >> 6;
    const int gw = blockIdx.x * NWAVES + wave, NGW = gridDim.x * NWAVES;
    int t = gw;
    if (t < T) {
    v2u xr[4]; int e0, e1; float c0, c1;
#pragma unroll
    for (int j = 0; j < 4; ++j) xr[j] = *((const GAS v2u*)(X + (size_t)t * D) + lane + 64 * j);
    e0 = EID[(size_t)t * 128 + lane] & EMASK; e1 = EID[(size_t)t * 128 + 64 + lane] & EMASK; c0 = COEF[(size_t)t * 128 + lane]; c1 = COEF[(size_t)t * 128 + 64 + lane];
    v2u wA[16], wB[16];
#pragma unroll
    for (int i = 0; i < 16; ++i) GROW(wA, i, V8, e0, i);
#pragma unroll
    for (int i = 0; i < 16; ++i) GROW(wB, i, V8, e0, 16 + i);
    for (;;) {
        const int tn = t + NGW; const bool has_next = tn < T;
        v2u nxr[4]; int ne0 = e0, ne1 = e1; float nc0 = 0.f, nc1 = 0.f;
        if (has_next) {
#pragma unroll
            for (int j = 0; j < 4; ++j) nxr[j] = *((const GAS v2u*)(X + (size_t)tn * D) + lane + 64 * j);
            ne0 = EID[(size_t)tn * 128 + lane] & EMASK; ne1 = EID[(size_t)tn * 128 + 64 + lane] & EMASK; nc0 = COEF[(size_t)tn * 128 + lane]; nc1 = COEF[(size_t)tn * 128 + 64 + lane];
        }
        f32x2 acc[8];
#pragma unroll
        for (int j = 0; j < 8; ++j) acc[j] = (f32x2){0.f, 0.f};
#define VBATCH(w, CREG, BASE, NEREG, NBASE) { const int cr_ = __builtin_bit_cast(int, (CREG)); \
            _Pragma("unroll") for (int i = 0; i < 16; ++i) { const float cf = __builtin_bit_cast(float, __builtin_amdgcn_readlane(cr_, (BASE) + i)); const f32x2 c2 = (f32x2){cf, cf}; \
                acc[0] = FMA2(c2, CVT4(w[i].x, 0), acc[0]); acc[1] = FMA2(c2, CVT4(w[i].x, 1), acc[1]); \
                acc[2] = FMA2(c2, CVT4(w[i].x, 2), acc[2]); acc[3] = FMA2(c2, CVT4(w[i].x, 3), acc[3]); \
                acc[4] = FMA2(c2, CVT4(w[i].y, 0), acc[4]); acc[5] = FMA2(c2, CVT4(w[i].y, 1), acc[5]); \
                acc[6] = FMA2(c2, CVT4(w[i].y, 2), acc[6]); acc[7] = FMA2(c2, CVT4(w[i].y, 3), acc[7]); \
                GROW(w, i, V8, NEREG, (NBASE) + i); if ((i & 3) == 3) __builtin_amdgcn_sched_barrier(0); } }
        VBATCH(wA, c0, 0, e0, 32) VBATCH(wB, c0, 16, e0, 48) VBATCH(wA, c0, 32, e1, 0) VBATCH(wB, c0, 48, e1, 16)
        VBATCH(wA, c1, 0, e1, 32) VBATCH(wB, c1, 16, e1, 48) VBATCH(wA, c1, 32, ne0, 0) VBATCH(wB, c1, 48, ne0, 16)
#undef VBATCH
        float sm = 0.f;
#pragma unroll
        for (int j = 0; j < 4; ++j) { acc[2 * j] = (f32x2){bflo(xr[j].x), bfhi(xr[j].x)} * ALPHA + acc[2 * j]; acc[2 * j + 1] = (f32x2){bflo(xr[j].y), bfhi(xr[j].y)} * ALPHA + acc[2 * j + 1];
            sm += (acc[2 * j].x + acc[2 * j].y) + (acc[2 * j + 1].x + acc[2 * j + 1].y); }
        const float mean = wave_sum(sm) * (1.f / D); float s2 = 0.f;
#pragma unroll
        for (int j = 0; j < 8; ++j) { acc[j] = acc[j] - mean; s2 += acc[j].x * acc[j].x + acc[j].y * acc[j].y; }
        const float rstd = 1.f / sqrtf(wave_sum(s2) * (1.f / D) + LN_EPS);
#pragma unroll
        for (int j = 0; j < 4; ++j) { const f32x4 gg = *((const GAS f32x4*)g + lane + 64 * j), b4 = *((const GAS f32x4*)bb + lane + 64 * j);
            const f32x4 o = (f32x4){acc[2 * j].x, acc[2 * j].y, acc[2 * j + 1].x, acc[2 * j + 1].y} * rstd * gg + b4;
            if (FINAL) *((GAS f32x4*)(Of + (size_t)t * D) + lane + 64 * j) = o;
            else { v2u wo; wo.x = pk2(o.x, o.y); wo.y = pk2(o.z, o.w); *((GAS v2u*)(Ob + (size_t)t * D) + lane + 64 * j) = wo; } }
        if (!has_next) break;
        t = tn; e0 = ne0; e1 = ne1; c0 = nc0; c1 = nc1;
#pragma unroll
        for (int j = 0; j < 4; ++j) xr[j] = nxr[j];
    }
    }
}


template <bool FINAL>
__device__ __forceinline__ void phase_gather_v_mfma(const bf16* X, const int* EID, const float* COEF, const unsigned char* V4, const float* g, const float* bb, bf16* Ob, float* Of) {
    const int tid = threadIdx.x, lane = tid & 63, wave = tid >> 6;
    const int gw = blockIdx.x * NWAVES + wave, NGW = gridDim.x * NWAVES;
    const int n = lane & 31, hh = lane >> 5;
    unsigned mask[4];
#pragma unroll
    for (int d = 0; d < 4; ++d) mask[d] = (hh == (n >> 4) && d == ((n & 15) >> 2)) ? (0xFFu << (8 * (n & 3))) : 0u;
    float gl[16], bl[16];
#pragma unroll
    for (int r = 0; r < 16; ++r) { const int col = 32 * ((r & 3) + 8 * (r >> 2) + 4 * hh) + n; gl[r] = g[col]; bl[r] = bb[col]; }
    const unsigned laneoff = 16u * (unsigned)n;
    int t = gw;
    if (t < T) {
    int e0 = EID[(size_t)t * 128 + lane], e1 = EID[(size_t)t * 128 + 64 + lane];
    float c0 = COEF[(size_t)t * 128 + lane], c1 = COEF[(size_t)t * 128 + 64 + lane];
    v4u ring[16];
#define VLOADA(slot, ereg, lsel) { const int ea_ = __builtin_amdgcn_readlane((ereg), (lsel)), eb_ = __builtin_amdgcn_readlane((ereg), (lsel) + 1); const int el_ = hh ? eb_ : ea_; ring[slot] = *(const GAS v4u*)(V4 + (((unsigned)el_ << 9) + laneoff)); }
#pragma unroll
    for (int j = 0; j < 16; ++j) VLOADA(j, e0, 2 * j)
    for (;;) {
        const int tn = t + NGW; const bool has_next = tn < T;
        int ne0 = e0, ne1 = e1; float nc0 = 0.f, nc1 = 0.f;
        if (has_next) { ne0 = EID[(size_t)tn * 128 + lane]; ne1 = EID[(size_t)tn * 128 + 64 + lane]; nc0 = COEF[(size_t)tn * 128 + lane]; nc1 = COEF[(size_t)tn * 128 + 64 + lane]; }
        unsigned short xs[16];
#pragma unroll
        for (int r = 0; r < 16; ++r) xs[r] = X[(size_t)t * D + 32 * ((r & 3) + 8 * (r >> 2) + 4 * hh) + n];
        float cm = fmaxf(fabsf(c0), fabsf(c1));
#pragma unroll
        for (int o = 1; o < 64; o <<= 1) cm = fmaxf(cm, __shfl_xor(cm, o));
        unsigned ex = (__float_as_uint(cm) >> 23) & 0xffu; ex = ex < 8u ? 8u : ex;
        const float S = __uint_as_float((261u - ex) << 23), invS = __uint_as_float((ex - 7u) << 23);
        const unsigned wq = (unsigned)__builtin_amdgcn_cvt_pk_fp8_f32(c0 * S, c1 * S, 0, false);
        const int rep0 = (int)((wq & 0xffu) * 0x01010101u), rep1 = (int)(((wq >> 8) & 0xffu) * 0x01010101u);
        f32x16 acc;
#pragma unroll
        for (int r = 0; r < 16; ++r) acc[r] = 0.f;
#pragma unroll
        for (int J = 0; J < 64; ++J) {
            const int ra = __builtin_amdgcn_readlane((J >> 5) ? rep1 : rep0, (2 * J) & 63), rb = __builtin_amdgcn_readlane((J >> 5) ? rep1 : rep0, ((2 * J) & 63) + 1);
            v8i A, B;
            A[0] = (int)ring[J & 15].x; A[1] = (int)ring[J & 15].y; A[2] = (int)ring[J & 15].z; A[3] = (int)ring[J & 15].w; A[4] = 0; A[5] = 0; A[6] = 0; A[7] = 0;
#pragma unroll
            for (int d = 0; d < 4; ++d) { B[d] = ra & (int)mask[d]; B[4 + d] = rb & (int)mask[d]; }
            acc = __builtin_amdgcn_mfma_scale_f32_32x32x64_f8f6f4(A, B, acc, 4, 0, 0, 0x7f7f7f7f, 0, 0x7f7f7f7f);
            if (J + 16 < 64) { VLOADA(J & 15, ((J + 16) >> 5) ? e1 : e0, (2 * (J + 16)) & 63) }
            else { VLOADA(J & 15, ne0, 2 * (J + 16 - 64)) }
            if ((J & 3) == 3) __builtin_amdgcn_sched_barrier(0);
        }
        float z[16]; float sm = 0.f;
#pragma unroll
        for (int r = 0; r < 16; ++r) { const float av = acc[r]; z[r] = ALPHA * bf2f(xs[r]) + av * invS; sm += z[r]; }
        const float mean = wave_sum(sm) * (1.f / D); float s2 = 0.f;
#pragma unroll
        for (int r = 0; r < 16; ++r) { z[r] -= mean; s2 += z[r] * z[r]; }
        const float rstd = 1.f / sqrtf(wave_sum(s2) * (1.f / D) + LN_EPS);
#pragma unroll
        for (int r = 0; r < 16; ++r) { const int col = 32 * ((r & 3) + 8 * (r >> 2) + 4 * hh) + n; const float o = z[r] * rstd * gl[r] + bl[r];
            if (FINAL) Of[(size_t)t * D + col] = o; else Ob[(size_t)t * D + col] = (bf16)f2bf(o); }
        if (!has_next) break;
        t = tn; e0 = ne0; e1 = ne1; c0 = nc0; c1 = nc1;
    }
#undef VLOADA
    }
}

__device__ __forceinline__ void phase_gather_u_mfma(LAS unsigned char* lds, const bf16* X, const int* EID, float* GATE, const unsigned char* U4, const float* DQU, const float* DQV) {
    const int tid = threadIdx.x, lane = tid & 63, wave = __builtin_amdgcn_readfirstlane(tid >> 6);
    const int gw = blockIdx.x * NWAVES + wave, NGW = gridDim.x * NWAVES;
    const int n = lane & 31, hh = lane >> 5;
    LAS unsigned char* rows = lds + wave * 18048;
    LAS unsigned char* x8 = rows + 16896;
    const unsigned laneoff = 16u * (unsigned)n;
    int t = gw;
    if (t < T) {
    int e0 = EID[(size_t)t * 128 + lane], e1 = EID[(size_t)t * 128 + 64 + lane];
    v4u ring[16];
#define ULOADA(slot, ereg, lb, j_) { const int ea_ = __builtin_amdgcn_readlane((ereg), (lb) + 2 * (j_)), eb_ = __builtin_amdgcn_readlane((ereg), (lb) + 2 * (j_) + 1); const int el_ = hh ? eb_ : ea_; \
        ring[slot] = *(const GAS v4u*)(U4 + (((unsigned)el_ << 9) + laneoff)); }
#pragma unroll
    for (int j = 0; j < 16; ++j) ULOADA(j, e0, 0, j)
    for (;;) {
        const int tn = t + NGW; const bool has_next = tn < T;
        int ne0 = e0, ne1 = e1;
        if (has_next) { ne0 = EID[(size_t)tn * 128 + lane]; ne1 = EID[(size_t)tn * 128 + 64 + lane]; }
        const float gt0 = GATE[(size_t)t * 128 + lane], gt1 = GATE[(size_t)t * 128 + 64 + lane];
        const float dqu0 = DQU[e0], dqu1 = DQU[e1], dqv0 = DQV[e0], dqv1 = DQV[e1];
        { const v4u xa = *((const GAS v4u*)(X + (size_t)t * D) + 2 * lane), xb = *((const GAS v4u*)(X + (size_t)t * D) + 2 * lane + 1);
          int w0 = 0, w1 = 0, w2 = 0, w3 = 0;
          w0 = __builtin_amdgcn_cvt_pk_fp8_f32(bflo(xa.x), bfhi(xa.x), w0, false); w0 = __builtin_amdgcn_cvt_pk_fp8_f32(bflo(xa.y), bfhi(xa.y), w0, true);
          w1 = __builtin_amdgcn_cvt_pk_fp8_f32(bflo(xa.z), bfhi(xa.z), w1, false); w1 = __builtin_amdgcn_cvt_pk_fp8_f32(bflo(xa.w), bfhi(xa.w), w1, true);
          w2 = __builtin_amdgcn_cvt_pk_fp8_f32(bflo(xb.x), bfhi(xb.x), w2, false); w2 = __builtin_amdgcn_cvt_pk_fp8_f32(bflo(xb.y), bfhi(xb.y), w2, true);
          w3 = __builtin_amdgcn_cvt_pk_fp8_f32(bflo(xb.z), bfhi(xb.z), w3, false); w3 = __builtin_amdgcn_cvt_pk_fp8_f32(bflo(xb.w), bfhi(xb.w), w3, true);
          *(LAS v4u*)(x8 + 16 * lane) = (v4u){(unsigned)w0, (unsigned)w1, (unsigned)w2, (unsigned)w3}; }
        float act0 = 0.f, act1 = 0.f;
        for (int q = 0; q < 4; ++q) {
#pragma unroll
            for (int j = 0; j < 16; ++j) *(LAS v4u*)(rows + hh * 528 + 16 * n + j * 1056) = ring[j];
            __builtin_amdgcn_sched_barrier(0);
            { const int qn = q + 1;
              const int er = (qn >= 4) ? ne0 : ((qn >> 1) ? e1 : e0); const int lb = (qn >= 4) ? 0 : 32 * (qn & 1);
#pragma unroll
              for (int j = 0; j < 16; ++j) ULOADA(j, er, lb, j) }
            __builtin_amdgcn_sched_barrier(0);
            f32x16 acc;
#pragma unroll
            for (int r = 0; r < 16; ++r) acc[r] = 0.f;
            unsigned xo = 16u * (unsigned)hh; asm volatile("" : "+v"(xo));
#pragma unroll 2
            for (int ks = 0; ks < 16; ++ks) {
                const v4u a4 = *(const LAS v4u*)(rows + n * 528 + 16 * hh + 32 * ks);
                const v4u b0 = *(const LAS v4u*)(x8 + xo + 64 * ks), b1 = *(const LAS v4u*)(x8 + xo + 64 * ks + 32);
                v8i A, B;
                A[0] = (int)a4.x; A[1] = (int)a4.y; A[2] = (int)a4.z; A[3] = (int)a4.w; A[4] = 0; A[5] = 0; A[6] = 0; A[7] = 0;
                B[0] = (int)b0.x; B[1] = (int)b0.y; B[2] = (int)b0.z; B[3] = (int)b0.w; B[4] = (int)b1.x; B[5] = (int)b1.y; B[6] = (int)b1.z; B[7] = (int)b1.w;
                acc = __builtin_amdgcn_mfma_scale_f32_32x32x64_f8f6f4(A, B, acc, 4, 0, 0, 0x7f7f7f7f, 0, 0x7f7f7f7f);
            }
            if (n == 0) {
#pragma unroll
                for (int r = 0; r < 16; ++r) { const float av = acc[r]; *(LAS float*)(x8 + 1024 + 4 * ((r & 3) + 8 * (r >> 2) + 4 * hh)) = av; }
            }
            const float act = *(const LAS float*)(x8 + 1024 + 4 * n);
            if (hh == (q & 1)) { if (q >> 1) act1 = act; else act0 = act; }
        }
        { const float a0 = act0 * dqu0, a1 = act1 * dqu1;
          GATE[(size_t)t * 128 + lane] = gt0 * (0.5f * a0 * (1.f + erff(a0 * 0.70710678118654752f))) * dqv0;
          GATE[(size_t)t * 128 + 64 + lane] = gt1 * (0.5f * a1 * (1.f + erff(a1 * 0.70710678118654752f))) * dqv1; }
        if (!has_next) break;
        t = tn; e0 = ne0; e1 = ne1;
    }
#undef ULOADA
    }
}
__device__ __forceinline__ void phase_hgrn_prep(unsigned char* ws, float* scratch  ) {
    const int tid = threadIdx.x, lane = tid & 63, wave = tid >> 6;
    const int gw = blockIdx.x * NWAVES + wave, NGW = gridDim.x * NWAVES;
    bf16* CQ = (bf16*)(ws + WS_CQ); bf16* CK = (bf16*)(ws + WS_CK); const bf16* CV = (const bf16*)(ws + WS_CV);
    bf16* KOT = (bf16*)scratch; bf16* VT = (bf16*)scratch + (size_t)T * D; float* DEC = (float*)(ws + WS_DEC);
    for (int item = gw; item < 1024 * 8; item += NGW) {
        const int g = item >> 3, h = item & 7; const size_t t0 = (size_t)g * 32;
        float k0[32], k1[32], b0[32], b1[32]; float c0 = 0.f, c1 = 0.f;
#pragma unroll
        for (int s2 = 0; s2 < 32; ++s2) { const size_t o = (t0 + s2) * D + h * 128 + 2 * lane;
            const unsigned kw = *(const GAS unsigned*)(CK + o), qw = *(const GAS unsigned*)(CQ + o);
            const float ka = bflo(kw), kb = bfhi(kw);
            c0 += __logf(1.f - ka); c1 += __logf(1.f - kb);
            k0[s2] = ka; k1[s2] = kb; b0[s2] = c0; b1[s2] = c1;
            *(GAS unsigned*)(CQ + o) = pk2(bflo(qw) * __expf(c0), bfhi(qw) * __expf(c1));
            *(GAS unsigned*)(CK + o) = pk2(ka * __expf(-c0), kb * __expf(-c1)); }
        { GAS v4u* r0 = (GAS v4u*)(KOT + ((size_t)g * 1024 + h * 128 + 2 * lane) * 32);
#pragma unroll
          for (int j = 0; j < 4; ++j) { v4u w;
              w.x = pk2(k0[8 * j + 0] * __expf(c0 - b0[8 * j + 0]), k0[8 * j + 1] * __expf(c0 - b0[8 * j + 1])); w.y = pk2(k0[8 * j + 2] * __expf(c0 - b0[8 * j + 2]), k0[8 * j + 3] * __expf(c0 - b0[8 * j + 3]));
              w.z = pk2(k0[8 * j + 4] * __expf(c0 - b0[8 * j + 4]), k0[8 * j + 5] * __expf(c0 - b0[8 * j + 5])); w.w = pk2(k0[8 * j + 6] * __expf(c0 - b0[8 * j + 6]), k0[8 * j + 7] * __expf(c0 - b0[8 * j + 7]));
              r0[j] = w; }
#pragma unroll
          for (int j = 0; j < 4; ++j) { v4u w;
              w.x = pk2(k1[8 * j + 0] * __expf(c1 - b1[8 * j + 0]), k1[8 * j + 1] * __expf(c1 - b1[8 * j + 1])); w.y = pk2(k1[8 * j + 2] * __expf(c1 - b1[8 * j + 2]), k1[8 * j + 3] * __expf(c1 - b1[8 * j + 3]));
              w.z = pk2(k1[8 * j + 4] * __expf(c1 - b1[8 * j + 4]), k1[8 * j + 5] * __expf(c1 - b1[8 * j + 5])); w.w = pk2(k1[8 * j + 6] * __expf(c1 - b1[8 * j + 6]), k1[8 * j + 7] * __expf(c1 - b1[8 * j + 7]));
              r0[4 + j] = w; } }
        *(GAS v2u*)(DEC + (size_t)g * 1024 + h * 128 + 2 * lane) = (v2u){__float_as_uint(__expf(c0)), __float_as_uint(__expf(c1))};
        { unsigned va[16], vb[16];
#pragma unroll
          for (int j = 0; j < 16; ++j) { const unsigned w0 = *(const GAS unsigned*)(CV + (t0 + 2 * j) * D + h * 128 + 2 * lane), w1 = *(const GAS unsigned*)(CV + (t0 + 2 * j + 1) * D + h * 128 + 2 * lane);
              va[j] = (w0 & 0xffffu) | (w1 << 16); vb[j] = (w0 >> 16) | (w1 & 0xffff0000u); }
          GAS v4u* r0 = (GAS v4u*)(VT + ((size_t)g * 1024 + h * 128 + 2 * lane) * 32);
#pragma unroll
          for (int j = 0; j < 4; ++j) { r0[j] = (v4u){va[4 * j], va[4 * j + 1], va[4 * j + 2], va[4 * j + 3]}; r0[4 + j] = (v4u){vb[4 * j], vb[4 * j + 1], vb[4 * j + 2], vb[4 * j + 3]}; } }
    }
}
__device__ __forceinline__ void phase_hgrn_scan(LAS unsigned char* lds, unsigned char* ws, const float* scratch) {
    const int tid = threadIdx.x, lane = tid & 63, wave = __builtin_amdgcn_readfirstlane(tid >> 6);
    const int c = lane & 31, hh = lane >> 5;
    const bf16* QI = (const bf16*)(ws + WS_CQ); const bf16* KI = (const bf16*)(ws + WS_CK);
    const bf16* KOT = (const bf16*)scratch; const bf16* VT = (const bf16*)scratch + (size_t)T * D; const float* DEC = (const float*)(ws + WS_DEC);
    bf16* O = (bf16*)(ws + WS_O);
    constexpr int BUF = 30720, O_KI = 0, O_QI = 8704, O_KOT = 17408, O_VT = 27648, O_DEC = 30208, O_ST = 3 * BUF, O_P = O_ST + 8704, NPIECE = 1696;
    for (int item = blockIdx.x; item < 256; item += gridDim.x) {
        const int es = item & 3, h = (item >> 2) & 7, b = item >> 5;
        __syncthreads();
        for (int i = tid; i < 8704 / 16; i += NTHR) *(LAS v4u*)(lds + O_ST + i * 16) = (v4u){0u, 0u, 0u, 0u};
        f32x16 S[4];
#pragma unroll
        for (int blk = 0; blk < 4; ++blk)
#pragma unroll
            for (int r = 0; r < 16; ++r) S[blk][r] = 0.f;
        v4u rg[5];
        const int lt = tid - 128;
        auto piece_src = [&](int n, int q) -> const GAS v4u* {
            const size_t gch = (size_t)b * 128 + n, t0 = gch * 32;
            if (q < 512) return (const GAS v4u*)(KI + (t0 + (q >> 4)) * D + h * 128 + 8 * (q & 15));
            if (q < 1024) { const int u = q - 512; return (const GAS v4u*)(QI + (t0 + (u >> 4)) * D + h * 128 + 8 * (u & 15)); }
            if (q < 1536) { const int u = q - 1024; return (const GAS v4u*)(KOT + (gch * 1024 + h * 128 + (u >> 2)) * 32 + 8 * (u & 3)); }
            if (q < 1664) { const int u = q - 1536; return (const GAS v4u*)(VT + (gch * 1024 + h * 128 + es * 32 + (u >> 2)) * 32 + 8 * (u & 3)); }
            return (const GAS v4u*)(DEC + gch * 1024 + h * 128 + 4 * (q - 1664));
        };
        auto piece_dst = [&](int q) -> int {
            if (q < 512) return O_KI + (q >> 4) * 272 + (q & 15) * 16;
            if (q < 1024) { const int u = q - 512; return O_QI + (u >> 4) * 272 + (u & 15) * 16; }
            if (q < 1536) { const int u = q - 1024; return O_KOT + (u >> 2) * 80 + (u & 3) * 16; }
            if (q < 1664) { const int u = q - 1536; return O_VT + (u >> 2) * 80 + (u & 3) * 16; }
            return O_DEC + (q - 1664) * 16;
        };
        auto load_chunk = [&](int n) {
            if (lt >= 0) {
#pragma unroll
                for (int i = 0; i < 5; ++i) { const int q = lt + 384 * i; if (q < NPIECE) rg[i] = *piece_src(n, q); }
            }
        };
        auto store_chunk = [&](int bufi) {
            if (lt >= 0) {
#pragma unroll
                for (int i = 0; i < 5; ++i) { const int q = lt + 384 * i; if (q < NPIECE) *(LAS v4u*)(lds + bufi * BUF + piece_dst(q)) = rg[i]; }
            }
        };
        auto scores = [&](int n) {
            LAS unsigned char* bp = lds + (n % 3) * BUF; LAS unsigned char* pi = lds + O_P + (n & 1) * 2560;
            f32x16 sc;
#pragma unroll
            for (int r = 0; r < 16; ++r) sc[r] = 0.f;
#pragma unroll
            for (int ks = 0; ks < 8; ++ks) { const bf16x8 kf = *(const LAS bf16x8*)(bp + O_KI + c * 272 + (16 * ks + 8 * hh) * 2);
                const bf16x8 qf = *(const LAS bf16x8*)(bp + O_QI + c * 272 + (16 * ks + 8 * hh) * 2);
                sc = __builtin_amdgcn_mfma_f32_32x32x16_bf16(kf, qf, sc, 0, 0, 0); }
#pragma unroll
            for (int g4 = 0; g4 < 4; ++g4) { float m[4];
#pragma unroll
                for (int q = 0; q < 4; ++q) { const float sv = sc[4 * g4 + q]; m[q] = (8 * g4 + 4 * hh + q <= c) ? sv : 0.f; }
                *(LAS v2u*)(pi + c * 80 + (8 * g4 + 4 * hh) * 2) = (v2u){pk2(m[0], m[1]), pk2(m[2], m[3])}; }
        };
        load_chunk(0); store_chunk(0); load_chunk(1); store_chunk(1); load_chunk(2);
        __syncthreads();
        if (wave == 1) scores(0);
        __syncthreads();
        for (int n = 0; n < 128; ++n) {
            if (n + 2 < 128) store_chunk((n + 2) % 3);
            if (n + 3 < 128) load_chunk(n + 3);
            if (wave == 1 && n + 1 < 128) scores(n + 1);
            if (wave == 0) {
                LAS unsigned char* bp = lds + (n % 3) * BUF; LAS unsigned char* pi = lds + O_P + (n & 1) * 2560;
                const size_t t0 = ((size_t)b * 128 + n) * 32;
                bf16x8 vf[2];
                f32x16 o;
#pragma unroll
                for (int r = 0; r < 16; ++r) o[r] = 0.f;
#pragma unroll
                for (int ks = 0; ks < 2; ++ks) { const bf16x8 pf = *(const LAS bf16x8*)(pi + c * 80 + (16 * ks + 8 * hh) * 2);
                    vf[ks] = *(const LAS bf16x8*)(bp + O_VT + c * 80 + (16 * ks + 8 * hh) * 2);
                    o = __builtin_amdgcn_mfma_f32_32x32x16_bf16(pf, vf[ks], o, 0, 0, 0); }
#pragma unroll
                for (int ks = 0; ks < 8; ++ks) { const bf16x8 qf = *(const LAS bf16x8*)(bp + O_QI + c * 272 + (16 * ks + 8 * hh) * 2);
                    const bf16x8 sf = *(const LAS bf16x8*)(lds + O_ST + c * 272 + (16 * ks + 8 * hh) * 2);
                    o = __builtin_amdgcn_mfma_f32_32x32x16_bf16(qf, sf, o, 0, 0, 0); }
#pragma unroll
                for (int r = 0; r < 16; ++r) { const float ov = o[r]; O[(t0 + (r & 3) + 8 * (r >> 2) + 4 * hh) * D + h * 128 + es * 32 + c] = (bf16)f2bf(ov); }
#pragma unroll
                for (int blk = 0; blk < 4; ++blk) {
#pragma unroll
                    for (int g4 = 0; g4 < 4; ++g4) { const f32x4 dv = *(const LAS f32x4*)(bp + O_DEC + (32 * blk + 8 * g4 + 4 * hh) * 4);
                        S[blk][4 * g4 + 0] *= dv.x; S[blk][4 * g4 + 1] *= dv.y; S[blk][4 * g4 + 2] *= dv.z; S[blk][4 * g4 + 3] *= dv.w; }
#pragma unroll
                    for (int ks = 0; ks < 2; ++ks) { const bf16x8 af = *(const LAS bf16x8*)(bp + O_KOT + (32 * blk + c) * 80 + (16 * ks + 8 * hh) * 2);
                        S[blk] = __builtin_amdgcn_mfma_f32_32x32x16_bf16(af, vf[ks], S[blk], 0, 0, 0); }
#pragma unroll
                    for (int g4 = 0; g4 < 4; ++g4) { const float s0 = S[blk][4 * g4 + 0], s1 = S[blk][4 * g4 + 1], s2 = S[blk][4 * g4 + 2], s3 = S[blk][4 * g4 + 3];
                        *(LAS v2u*)(lds + O_ST + c * 272 + (32 * blk + 8 * g4 + 4 * hh) * 2) = (v2u){pk2(s0, s1), pk2(s2, s3)}; }
                }
            }
            __syncthreads();
        }
    }
}
__device__ __forceinline__ void phase_hgrn_norm(const float* norm_g, unsigned char* ws) {
    const int tid = threadIdx.x, lane = tid & 63, wave = tid >> 6;
    const int gw = blockIdx.x * NWAVES + wave, NGW = gridDim.x * NWAVES;
    const bf16* O = (const bf16*)(ws + WS_O); const bf16* CG = (const bf16*)(ws + WS_CG); bf16* Y2 = (bf16*)(ws + WS_Y2);
    for (int t = gw; t < T; t += NGW) {
        const v4u a0 = *((const GAS v4u*)(O + (size_t)t * D) + lane * 2), a1 = *((const GAS v4u*)(O + (size_t)t * D) + lane * 2 + 1);
        const v4u g0 = *((const GAS v4u*)(CG + (size_t)t * D) + lane * 2), g1 = *((const GAS v4u*)(CG + (size_t)t * D) + lane * 2 + 1);
        float o[16], gv[16];
        o[0] = bflo(a0.x); o[1] = bfhi(a0.x); o[2] = bflo(a0.y); o[3] = bfhi(a0.y); o[4] = bflo(a0.z); o[5] = bfhi(a0.z); o[6] = bflo(a0.w); o[7] = bfhi(a0.w);
        o[8] = bflo(a1.x); o[9] = bfhi(a1.x); o[10] = bflo(a1.y); o[11] = bfhi(a1.y); o[12] = bflo(a1.z); o[13] = bfhi(a1.z); o[14] = bflo(a1.w); o[15] = bfhi(a1.w);
        gv[0] = bflo(g0.x); gv[1] = bfhi(g0.x); gv[2] = bflo(g0.y); gv[3] = bfhi(g0.y); gv[4] = bflo(g0.z); gv[5] = bfhi(g0.z); gv[6] = bflo(g0.w); gv[7] = bfhi(g0.w);
        gv[8] = bflo(g1.x); gv[9] = bfhi(g1.x); gv[10] = bflo(g1.y); gv[11] = bfhi(g1.y); gv[12] = bflo(g1.z); gv[13] = bfhi(g1.z); gv[14] = bflo(g1.w); gv[15] = bfhi(g1.w);
        float sq = 0.f;
#pragma unroll
        for (int j = 0; j < 16; ++j) sq += o[j] * o[j];
        sq += __shfl_xor(sq, 1); sq += __shfl_xor(sq, 2); sq += __shfl_xor(sq, 4);
        const float r = 1.f / sqrtf(sq * (1.f / 128.f) + LN_EPS);
        float y[16];
#pragma unroll
        for (int j = 0; j < 16; ++j) { const float sg = gv[j] / (1.f + expf(-gv[j])); y[j] = o[j] * r * norm_g[lane * 16 + j] * sg; }
        v4u w0, w1; w0.x = pk2(y[0], y[1]); w0.y = pk2(y[2], y[3]); w0.z = pk2(y[4], y[5]); w0.w = pk2(y[6], y[7]);
        w1.x = pk2(y[8], y[9]); w1.y = pk2(y[10], y[11]); w1.z = pk2(y[12], y[13]); w1.w = pk2(y[14], y[15]);
        *((GAS v4u*)(Y2 + (size_t)t * D) + lane * 2) = w0; *((GAS v4u*)(Y2 + (size_t)t * D) + lane * 2 + 1) = w1;
    }
}

struct Args { const float* in[16]; float* out; unsigned char* ws; int ph_lo, ph_hi, li, pad; };
__global__ void __launch_bounds__(NTHR, 2) mk_fwd(Args args) {
    extern __shared__ __attribute__((aligned(16))) unsigned char lds_raw[];
    LAS unsigned char* lds = (LAS unsigned char*)lds_raw;
    volatile LAS unsigned* MISC = (volatile LAS unsigned*)(lds + MISC_OFF);
    const int tid = threadIdx.x;
    unsigned char* ws = args.ws;
    gu32* ctl = (gu32*)(ws + WS_CTL);
    if (tid < 32) ((LAS unsigned*)(lds + MISC_OFF))[tid] = 0u;
    __syncthreads();
    XcdBarrier bar; bar.bar = (unsigned*)ctl + CW_BAR; bar.x = 0; bar.st = nullptr;
    if (N_LAUNCHES == 1) bar = xcd_barrier_post((unsigned*)ctl + CW_BAR, MISC + 8);
    const int lo = args.ph_lo, hi = args.ph_hi;
#define IN(k) (lo <= (k) && (k) < hi)
#define SEAM(k) do { if (IN(k) && IN((k) + 1)) xcd_barrier(bar); } while (0)
    const float* const* in = args.in;
    bf16* XB = (bf16*)(ws + WS_XB); bf16* H0 = (bf16*)(ws + WS_H0); bf16* Y = (bf16*)(ws + WS_Y); bf16* H1 = (bf16*)(ws + WS_H1);
    int* EID = (int*)(ws + WS_EID); float* GATE = (float*)(ws + WS_GATE);
    bf16* Z = (bf16*)args.out;

    int ph_ = 0;
#define PH_BEGIN if (lo <= ph_ && ph_ < hi) for (int rep_ = 0; rep_ < 1 + (int)((DUP_MASK >> ph_) & 1u); ++rep_) {
#define PH_END } if (lo <= ph_ && ph_ + 1 < hi) xcd_barrier(bar); ++ph_;
      PH_BEGIN phase_prologue(lds, in, ws); phase_convert_tables(in[12], in[13], ws); PH_END
      PH_BEGIN pg8::Gemm g{XB, (const bf16*)(ws + WS_WABIN), T, AB_IN, D}; pg8::StaticOrder S; S.init(T, AB_IN, (int)gridDim.x, (int)blockIdx.x); pg8::EpiBf16<0> E{H0, AB_IN, nullptr, 0, 0, 1.f};
                     pg8::gemm_phase<pg8::EpiBf16<0>, pg8::StaticOrder, true, true>(lds, g, S, E); PH_END
      PH_BEGIN phase_ret_local(lds, ws); PH_END
      PH_BEGIN phase_ret_prefix(ws); PH_END
      PH_BEGIN phase_ret_out_pool_fast(lds, in, ws); PH_END
      PH_BEGIN pg8::Gemm g{Y, (const bf16*)(ws + WS_WABOUT), T, D, D}; pg8::StaticOrder S; S.init(T, D, (int)gridDim.x, (int)blockIdx.x); pg8::EpiResidF32 E{XB, Z};
                     pg8::gemm_phase<pg8::EpiResidF32, pg8::StaticOrder, true, true>(lds, g, S, E); PH_END
      PH_BEGIN phase_ln(Z, H1, in[14], in[15]); PH_END
      PH_BEGIN pg8::Gemm g{H1, (const bf16*)(ws + WS_WQ), T, 2048, D}; pg8::StaticOrder S; S.init(T, 2048, (int)gridDim.x, (int)blockIdx.x); pg8::EpiBf16<0> E{H0  , 2048, nullptr, 0, 0, 1.f};
                     pg8::gemm_phase<pg8::EpiBf16<0>, pg8::StaticOrder, true, true>(lds, g, S, E); PH_END
      PH_BEGIN phase_topk_fast(lds, H0, (const bf16*)(ws + WS_KEYS), EID, GATE); PH_END
      PH_BEGIN phase_gather_u_mfma(lds, H1, EID, GATE, ws + WS_U8, (const float*)(ws + WS_DQU), (const float*)(ws + WS_DQV)); PH_END
      PH_BEGIN phase_gather_v_mfma<false>(H1, EID, GATE, ws + WS_V8, in[14] + D, in[15] + D, XB  , nullptr); PH_END
#ifdef PROBE_L2
    PH_BEGIN phase_gather_v<false, PROBE_L2>(H1, EID, GATE, ws + WS_V8, in[14] + D, in[15] + D, Y  , nullptr); PH_END
#endif
      PH_BEGIN pg8::Gemm g{XB, (const bf16*)(ws + WS_WCIN), T, C_IN, D}; pg8::StaticOrder S; S.init(T, C_IN, (int)gridDim.x, (int)blockIdx.x);
                      pg8::EpiCInF E2{(bf16*)(ws + WS_CQ), (bf16*)(ws + WS_CK), (bf16*)(ws + WS_CV), (bf16*)(ws + WS_CG), (const float*)(ws + WS_LB)};
                      pg8::gemm_phase<pg8::EpiCInF, pg8::StaticOrder, true, true>(lds, g, S, E2); PH_END
      PH_BEGIN phase_hgrn_prep(ws, args.out); PH_END
      PH_BEGIN phase_hgrn_scan(lds, ws, args.out); PH_END
      PH_BEGIN phase_hgrn_norm(in[8], ws); PH_END
      PH_BEGIN pg8::Gemm g{(const bf16*)(ws + WS_Y2), (const bf16*)(ws + WS_WCOUT), T, D, D}; pg8::StaticOrder S; S.init(T, D, (int)gridDim.x, (int)blockIdx.x); pg8::EpiResidF32 E{XB, Z};
                      pg8::gemm_phase<pg8::EpiResidF32, pg8::StaticOrder, true, true>(lds, g, S, E); PH_END
      PH_BEGIN phase_ln(Z, H1  , in[14] + 2 * D, in[15] + 2 * D); PH_END
      PH_BEGIN pg8::Gemm g{H1, (const bf16*)(ws + WS_WQ) + (size_t)2048 * D, T, 2048, D}; pg8::StaticOrder S; S.init(T, 2048, (int)gridDim.x, (int)blockIdx.x); pg8::EpiBf16<0> E{(bf16*)(ws + WS_Q1), 2048, nullptr, 0, 0, 1.f};
                      pg8::gemm_phase<pg8::EpiBf16<0>, pg8::StaticOrder, true, true>(lds, g, S, E); PH_END
      PH_BEGIN phase_topk_fast(lds, (const bf16*)(ws + WS_Q1), (const bf16*)(ws + WS_KEYS) + (size_t)8 * 2 * 128 * 128, EID, GATE); PH_END
      PH_BEGIN phase_gather_u_mfma(lds, H1, EID, GATE, ws + WS_U8 + (size_t)NEXP * 512, (const float*)(ws + WS_DQU) + NEXP, (const float*)(ws + WS_DQV) + NEXP); PH_END
      PH_BEGIN phase_gather_v_mfma<true>(H1, EID, GATE, ws + WS_V8 + (size_t)NEXP * 512, in[14] + 3 * D, in[15] + 3 * D, nullptr, args.out); PH_END
#undef PH_BEGIN
#undef PH_END
#undef IN
#undef SEAM
}

extern "C" void kernel_launch(void* const* d_in, const int* in_sizes, int n_in, void* d_out, int out_size, void* d_ws, size_t ws_size, hipStream_t stream) {
    static int grid = 0;
    if (grid == 0) {
        if (n_in != 16 || in_sizes[0] != T * D || out_size != T * D || ws_size < WS_END) { fprintf(stderr, "kernel_launch: unexpected problem (n_in %d, in0 %d, out %d, ws %zu); nothing launched\n", n_in, n_in > 0 ? in_sizes[0] : -1, out_size, ws_size); grid = -1; return; }
        int dev = 0, cus = 0;
        if (hipGetDevice(&dev) != hipSuccess || hipDeviceGetAttribute(&cus, hipDeviceAttributeMultiprocessorCount, dev) != hipSuccess) { grid = -1; return; }
        if (hipFuncSetAttribute((const void*)mk_fwd, hipFuncAttributeMaxDynamicSharedMemorySize, LDS_BYTES) != hipSuccess) { fprintf(stderr, "kernel_launch: hipFuncSetAttribute failed\n"); grid = -1; return; }
        (void)hipGetLastError();
        grid = cus;
    }
    if (grid < 0) return;
    if (hipMemsetAsync((char*)d_ws + WS_CTL, 0, CTL_ZERO_BYTES, stream) != hipSuccess) return;
    Args a{};
    for (int i = 0; i < 16; ++i) a.in[i] = (const float*)d_in[i];
    a.out = (float*)d_out; a.ws = (unsigned char*)d_ws;
    for (int li = 0; li < N_LAUNCHES; ++li) {
        a.ph_lo = (N_LAUNCHES == 1) ? 0 : li; a.ph_hi = (N_LAUNCHES == 1) ? NPHASE : li + 1; a.li = li;
        hipLaunchKernelGGL(mk_fwd, dim3(grid), dim3(NTHR), LDS_BYTES, stream, a);
        if (hipPeekAtLastError() != hipSuccess) { fprintf(stderr, "kernel_launch: launch %d failed\n", li); break; }
    }
}
```

```cpp
#include <hip/hip_runtime.h>
#include <cstdio>
#include <cstdint>

#ifndef MK_N_LAUNCHES
#define MK_N_LAUNCHES 1
#endif
#ifdef PROBE_L2
constexpr int NPHASE = 22;
#else
constexpr int NPHASE = 21;
#endif
#ifndef DUP_MASK
#define DUP_MASK 0u
#endif
constexpr int N_LAUNCHES = MK_N_LAUNCHES;

constexpr int BATCH = 8, SEQ = 4096, D = 1024, T = BATCH * SEQ;
constexpr int AB_IN = 2048, C_IN = 4096, NEXP = 16384;
constexpr float LN_EPS = 1e-5f;
constexpr float ALPHA = 1.41421356237309515f;
constexpr int NWAVES = 8, NTHR = 512;

constexpr size_t MiB = 1u << 20;
constexpr size_t WS_CTL = 0, CTL_ZERO_BYTES = 1 * MiB;
constexpr size_t WS_LB = 1 * MiB;
constexpr size_t WS_ROPE = 2 * MiB;
constexpr size_t WS_WABIN = 4 * MiB;
constexpr size_t WS_WABOUT = 8 * MiB;
constexpr size_t WS_WCIN = 10 * MiB;
constexpr size_t WS_WCOUT = 18 * MiB;
constexpr size_t WS_WQ = 20 * MiB;
constexpr size_t WS_KEYS = 28 * MiB;
constexpr size_t WS_DQU = 29 * MiB;
constexpr size_t WS_DQV = 29 * MiB + 131072;
constexpr size_t WS_U8 = 32 * MiB;
constexpr size_t WS_V8 = 64 * MiB;
constexpr size_t WS_POOLWT = 30 * MiB;
constexpr size_t WS_XB = 96 * MiB;
constexpr size_t WS_H0 = 160 * MiB;
constexpr size_t WS_LST = 288 * MiB;
constexpr size_t WS_Y = 320 * MiB;
constexpr size_t WS_H1 = 384 * MiB;
constexpr size_t WS_EID = 448 * MiB;
constexpr size_t WS_GATE = 464 * MiB;
constexpr size_t WS_CQ = 160 * MiB, WS_CK = 224 * MiB, WS_CV = 288 * MiB, WS_CG = 352 * MiB;
constexpr size_t WS_O = 416 * MiB;
constexpr size_t WS_Y2 = 160 * MiB;
constexpr size_t WS_Q1 = 224 * MiB;
constexpr size_t WS_DEC = 480 * MiB;
constexpr size_t WS_END = 484 * MiB;

constexpr int CW_BAR = 4096;
constexpr int LDS_BYTES = 147456;
constexpr int MISC_OFF = LDS_BYTES - 128;

#define GAS __attribute__((address_space(1)))
#define LAS __attribute__((address_space(3)))
typedef unsigned short bf16;
typedef unsigned v4u __attribute__((ext_vector_type(4)));
typedef unsigned v2u __attribute__((ext_vector_type(2)));
typedef float f32x4 __attribute__((ext_vector_type(4)));
typedef GAS unsigned gu32;
typedef short bf16x8 __attribute__((ext_vector_type(8)));
typedef int v8i __attribute__((ext_vector_type(8)));
typedef float f32x16 __attribute__((ext_vector_type(16)));
#define RLX_AGENT __ATOMIC_RELAXED, __HIP_MEMORY_SCOPE_AGENT
#define LDS_WAIT() asm volatile("s_waitcnt lgkmcnt(0)" ::: "memory")
typedef __bf16 hwbf16x2 __attribute__((ext_vector_type(2)));
typedef float hwf32x2 __attribute__((ext_vector_type(2)));
__device__ __forceinline__ unsigned pk2(float lo, float hi) { const hwf32x2 v = {lo, hi}; const hwbf16x2 b = __builtin_convertvector(v, hwbf16x2); return __builtin_bit_cast(unsigned, b); }
__device__ __forceinline__ unsigned f2bf(float f) { return pk2(f, 0.f) & 0xffffu; }
__device__ __forceinline__ float bf2f(unsigned b) { return __builtin_bit_cast(float, b << 16); }
__device__ __forceinline__ float bflo(unsigned w) { return __builtin_bit_cast(float, w << 16); }
__device__ __forceinline__ float bfhi(unsigned w) { return __builtin_bit_cast(float, w & 0xffff0000u); }
__device__ __forceinline__ float wave_sum(float v) {
#pragma unroll
    for (int o = 1; o < 64; o <<= 1) v += __shfl_xor(v, o);
    return v;
}

#define XB_TMO      128
#define XB_XCNT(j)  (256  + 64 * (j))
#define XB_XSUB(j)  (1280 + 64 * (j))
#define XB_XGEN(j)  (2304 + 64 * (j))
#define XB_TOP      3328
#define XB_TOPGEN   3392
#define XCD_BAR_WORDS 3456
#define XB_SPIN_CAP (1u << 21)
__device__ __forceinline__ unsigned xb_ld(unsigned* p)              { return __hip_atomic_load(p, __ATOMIC_RELAXED, __HIP_MEMORY_SCOPE_AGENT); }
__device__ __forceinline__ unsigned xb_add(unsigned* p, unsigned v) { return __hip_atomic_fetch_add(p, v, __ATOMIC_RELAXED, __HIP_MEMORY_SCOPE_AGENT); }
__device__ __forceinline__ unsigned xb_xcc_id() { return (unsigned)__builtin_amdgcn_s_getreg((3 << 11) | 20) & 0xFu; }
#define XB_SPIN(cond, bar) do { unsigned _sp = 0; while (cond) { __builtin_amdgcn_s_sleep(1); \
    if ((++_sp & 255u) == 0u) { if (xb_ld(&(bar)[XB_TMO])) break; if (_sp > XB_SPIN_CAP) { atomicAdd(&(bar)[XB_TMO], 1u); break; } } } } while (0)
struct XcdBarrier { unsigned* bar; unsigned x; volatile LAS unsigned* st; };
__device__ __forceinline__ XcdBarrier xcd_barrier_post(unsigned* bar, volatile LAS unsigned* st) {
    XcdBarrier b; b.bar = bar; b.x = xb_xcc_id(); b.st = st;
    if (threadIdx.x == 0) (void)xb_add(&bar[XB_XCNT(b.x)], 1u);
    return b;
}
__device__ __forceinline__ void xcd_barrier_complete(unsigned* bar, unsigned x, unsigned& nloc, unsigned& nx) {
    const unsigned G = gridDim.x * gridDim.y * gridDim.z;
    unsigned sum, cnt, mine, sp = 0u;
    for (;;) {
        sum = 0u; cnt = 0u; mine = 0u;
#pragma unroll
        for (unsigned j = 0; j < 16; ++j) { const unsigned c = xb_ld(&bar[XB_XCNT(j)]); sum += c; cnt += (c > 0u) ? 1u : 0u; mine = (j == x) ? c : mine; }
        if (sum == G) break;
        __builtin_amdgcn_s_sleep(1);
        if ((++sp & 255u) == 0u) { if (xb_ld(&bar[XB_TMO])) break; if (sp > XB_SPIN_CAP) { atomicAdd(&bar[XB_TMO], 1u); break; } }
    }
    nloc = mine > 0u ? mine : 1u; nx = cnt > 0u ? cnt : 1u;
}
__device__ __forceinline__ void xcd_barrier(const XcdBarrier& b) {
    asm volatile("s_waitcnt vmcnt(0)" ::: "memory");
    __syncthreads();
    if (threadIdx.x == 0) {
        unsigned* bar = b.bar;
        __builtin_amdgcn_s_waitcnt(0);
        unsigned nloc = b.st[0], nx = b.st[1];
        if (nloc == 0u) { xcd_barrier_complete(bar, b.x, nloc, nx); b.st[0] = nloc; b.st[1] = nx; }
        const unsigned old = xb_add(&bar[XB_XSUB(b.x)], 1u);
        const unsigned gen = old / nloc;
        if (old + 1u == (gen + 1u) * nloc) {
            __builtin_amdgcn_fence(__ATOMIC_RELEASE, "agent");
            asm volatile("s_waitcnt vmcnt(0)" ::: "memory");
            const unsigned og = xb_add(&bar[XB_TOP], 1u);
            const unsigned tg = og / nx;
            if (og + 1u == (tg + 1u) * nx) xb_add(&bar[XB_TOPGEN], 1u);
            else XB_SPIN(xb_ld(&bar[XB_TOPGEN]) == tg, bar);
            __builtin_amdgcn_fence(__ATOMIC_ACQUIRE, "agent");
            xb_add(&bar[XB_XGEN(b.x)], 1u);
            asm volatile("s_waitcnt vmcnt(0)" ::: "memory");
        } else {
            XB_SPIN(xb_ld(&bar[XB_XGEN(b.x)]) == gen, bar);
            __builtin_amdgcn_fence(__ATOMIC_ACQUIRE, "agent");
            asm volatile("s_waitcnt vmcnt(0)" ::: "memory");
        }
    }
    __syncthreads();
}

__device__ __forceinline__ void p0_transpose_item(const float* W, int K, int N, bf16* WT, LAS float* scr, int item, int lane) {
    const int nblk = N / 32, kb = item / nblk, nb = item % nblk, k0 = 64 * kb, n0 = 32 * nb;
#pragma unroll 8
    for (int i = 0; i < 32; ++i) { const int kk = 2 * i + (lane >> 5); scr[kk * 33 + (lane & 31)] = W[(size_t)(k0 + kk) * N + n0 + (lane & 31)]; }
    LDS_WAIT(); asm volatile("" ::: "memory");
    const int c = lane & 7;
#pragma unroll
    for (int j = 0; j < 4; ++j) { const int n = (lane >> 3) + 8 * j; const LAS float* s = scr + (8 * c) * 33 + n;
        v4u o; o.x = pk2(s[0 * 33], s[1 * 33]); o.y = pk2(s[2 * 33], s[3 * 33]); o.z = pk2(s[4 * 33], s[5 * 33]); o.w = pk2(s[6 * 33], s[7 * 33]);
        *(GAS v4u*)(WT + (size_t)(n0 + n) * K + k0 + 8 * c) = o; }
    LDS_WAIT(); asm volatile("" ::: "memory");
}

template <class Epi>
__device__ __forceinline__ void gemm_naive(LAS unsigned char* lds, const bf16* A, const bf16* Bt, int M, int N, int K, const Epi& E) {
    LAS float* As = (LAS float*)lds;
    LAS float* Bs = As + 128 * 33;
    const int tid = threadIdx.x, tx = tid & 15, ty = tid >> 4;
    const int ntn = N / 128, ntiles = (M / 128) * ntn;
    for (int tile = blockIdx.x; tile < ntiles; tile += gridDim.x) {
        const int tm = tile / ntn, tn = tile % ntn;
        float acc[4][8];
#pragma unroll
        for (int i = 0; i < 4; ++i)
#pragma unroll
            for (int j = 0; j < 8; ++j) acc[i][j] = 0.f;
        for (int k0 = 0; k0 < K; k0 += 32) {
            { const int r = tid >> 2, kc = (tid & 3) * 8;
              const v4u va = *(const GAS v4u*)(A + (size_t)(tm * 128 + r) * K + k0 + kc);
              const v4u vb = *(const GAS v4u*)(Bt + (size_t)(tn * 128 + r) * K + k0 + kc);
              LAS float* pa = As + r * 33 + kc; LAS float* pb = Bs + r * 33 + kc;
              pa[0] = bflo(va.x); pa[1] = bfhi(va.x); pa[2] = bflo(va.y); pa[3] = bfhi(va.y); pa[4] = bflo(va.z); pa[5] = bfhi(va.z); pa[6] = bflo(va.w); pa[7] = bfhi(va.w);
              pb[0] = bflo(vb.x); pb[1] = bfhi(vb.x); pb[2] = bflo(vb.y); pb[3] = bfhi(vb.y); pb[4] = bflo(vb.z); pb[5] = bfhi(vb.z); pb[6] = bflo(vb.w); pb[7] = bfhi(vb.w); }
            __syncthreads();
#pragma unroll 8
            for (int kk = 0; kk < 32; ++kk) {
                float a[4], b[8];
#pragma unroll
                for (int i = 0; i < 4; ++i) a[i] = As[(ty * 4 + i) * 33 + kk];
#pragma unroll
                for (int j = 0; j < 8; ++j) b[j] = Bs[(tx + 16 * j) * 33 + kk];
#pragma unroll
                for (int i = 0; i < 4; ++i)
#pragma unroll
                    for (int j = 0; j < 8; ++j) acc[i][j] += a[i] * b[j];
            }
            __syncthreads();
        }
#pragma unroll
        for (int i = 0; i < 4; ++i)
#pragma unroll
            for (int j = 0; j < 8; ++j) E(tm * 128 + ty * 4 + i, tn * 128 + tx + 16 * j, acc[i][j]);
    }
}
struct EpiStore { bf16* O; int ldc;
    __device__ __forceinline__ void operator()(int r, int c, float v) const { O[(size_t)r * ldc + c] = (bf16)f2bf(v); } };
struct EpiResid { const bf16* X; float* Z;
    __device__ __forceinline__ void operator()(int r, int c, float v) const { Z[(size_t)r * D + c] = ALPHA * bf2f(X[(size_t)r * D + c]) + v; } };
struct EpiCIn { bf16 *CQ, *CK, *CV, *CG; const float* lb;
    __device__ __forceinline__ void operator()(int r, int c, float v) const {
        const int seg = c >> 10, cc = c & 1023; const size_t o = (size_t)r * D + cc;
        if (seg == 0) CQ[o] = (bf16)f2bf(v);
        else if (seg == 1) { const float k = (1.f - lb[cc]) / (1.f + expf(v)); CK[o] = (bf16)f2bf(k); }
        else if (seg == 2) CV[o] = (bf16)f2bf(v);
        else CG[o] = (bf16)f2bf(v);
    } };

namespace pg8 {
#define PG8_LAS __attribute__((address_space(3)))
typedef unsigned short bf16_t;
typedef short bf16x8 __attribute__((ext_vector_type(8)));
typedef float f32x4 __attribute__((ext_vector_type(4)));
typedef unsigned u32x4 __attribute__((ext_vector_type(4)));
constexpr int BM = 256, BK = 64, HALF = 128, HTB = HALF * BK * 2  , STAGE_BYTES = 8 * HTB, NXCD = 8, WGM = 8;

__host__ __device__ __forceinline__ int lds_byte(int r, int c) { const int st = (r >> 4) * 2 + (c >> 5), rr = r & 15, cc = c & 31, ob = rr * 64 + cc * 2; return st * 1024 + (ob ^ (((ob >> 9) & 1) << 5)); }
__host__ __device__ __forceinline__ void stage_rc(int b, int& R, int& C) { const int st = b / 1024, sb = b % 1024, swz = sb ^ (((sb >> 9) & 1) << 5); R = (st >> 1) * 16 + swz / 64; C = (st & 1) * 32 + (swz % 64) / 2; }
__host__ __device__ __forceinline__ int perm32(int rho) { const int n = rho >> 4, i = rho & 15; return 8 * (i >> 2) + 4 * n + (i & 3); }

struct Unit { int pm, pn; };
struct Gemm { const bf16_t* A; const bf16_t* Bt; int M, N, K; };

struct StaticOrder {
    int nM, nN, nwg, G, c;
    __host__ __device__ void init(int M, int N, int G_, int c_) { nM = M / BM; nN = N / BM; nwg = nM * nN; G = G_; c = c_; }
    __host__ __device__ bool next(int i, Unit& u) const {
        const long L = (long)i * G + c; if (L >= nwg) return false;
        int wgid = (int)L; { const int q = nwg / NXCD, r = nwg % NXCD, xcd = wgid % NXCD, off = wgid / NXCD; wgid = (xcd < r ? xcd * (q + 1) : r * (q + 1) + (xcd - r) * q) + off; }
        const int nig = WGM * nN, gid = wgid / nig, fm = gid * WGM, gsz = (nM - fm) < WGM ? (nM - fm) : WGM;
        u.pm = fm + ((wgid % nig) % gsz); u.pn = (wgid % nig) / gsz; return true;
    }
    __device__ __forceinline__ void a_ready(const Unit&) const {}
    __device__ __forceinline__ void done(const Unit&) const {}
};

__device__ __forceinline__ unsigned cvt_pk_bf16(float lo, float hi) { unsigned r; asm volatile("v_cvt_pk_bf16_f32 %0, %1, %2" : "=v"(r) : "v"(lo), "v"(hi)); return r; }
typedef float f32x2 __attribute__((ext_vector_type(2)));
__device__ __forceinline__ f32x2 gelu_pk(f32x2 v) {
    const f32x2 av = __builtin_elementwise_abs(v), d = av * 0.2316418882f + 1.0f;
    f32x2 t; t.x = __builtin_amdgcn_rcpf(d.x); t.y = __builtin_amdgcn_rcpf(d.y);
    f32x2 q = t * 0.5307027145f + (-0.7265760135f); q = q * t + 0.7107068705f; q = q * t + (-0.142248368f); q = q * t + 0.127414796f; q = q * t;
    const f32x2 s = (v * v) * (-0.72134752044f);
    f32x2 e; e.x = __builtin_amdgcn_exp2f(s.x); e.y = __builtin_amdgcn_exp2f(s.y);
    const f32x2 m = v * (q * e), r = v - m;
    f32x2 o; o.x = v.x < 0.f ? m.x : r.x; o.y = v.y < 0.f ? m.y : r.y; return o;
}

template <int ACT  > struct EpiBf16 {
    static constexpr bool PERM = true, AFTER_DRAIN = false; static_assert(ACT == 0 || ACT == 1, "EpiBf16: ACT is 0 (none) or 1 (gelu_pk)");
    bf16_t* O; int ldc; const float* bias; int split_cols; size_t split_stride; float scale0;
    __device__ __forceinline__ void operator()(const f32x4 (&acc)[2][2][4][2], const Unit& u, int wr, int wc, int fr, int fq) const {
        const int row0 = u.pm * BM + wr * 64 + fr; int colt = u.pn * BM; bf16_t* base = O;
        float sc = 1.f; if (split_cols) { const int t = colt / split_cols; base += (size_t)t * split_stride; colt -= t * split_cols; if (t == 0) sc = scale0; }
        const int col0 = colt + wc * 32 + 8 * fq, bcol0 = u.pn * BM + wc * 32 + 8 * fq;
        f32x4 bv[2][2];
#pragma unroll
        for (int bj = 0; bj < 2; ++bj)
#pragma unroll
            for (int n = 0; n < 2; ++n) bv[bj][n] = bias ? *(const f32x4*)(bias + bcol0 + bj * HALF + 4 * n) : (f32x4){0.f, 0.f, 0.f, 0.f};
#pragma unroll
        for (int ai = 0; ai < 2; ++ai)
#pragma unroll
            for (int m = 0; m < 4; ++m) { bf16_t* rowp = base + (size_t)(row0 + ai * HALF + m * 16) * ldc + col0;
#pragma unroll
                for (int bj = 0; bj < 2; ++bj) { f32x4 v0 = acc[ai][bj][m][0] + bv[bj][0], v1 = acc[ai][bj][m][1] + bv[bj][1];
                    if (ACT == 1) { f32x2 a = gelu_pk((f32x2){v0[0], v0[1]}), b = gelu_pk((f32x2){v0[2], v0[3]}), c = gelu_pk((f32x2){v1[0], v1[1]}), d = gelu_pk((f32x2){v1[2], v1[3]});
                        v0 = (f32x4){a.x, a.y, b.x, b.y}; v1 = (f32x4){c.x, c.y, d.x, d.y}; }
                    v0 = v0 * sc; v1 = v1 * sc; u32x4 w; w.x = cvt_pk_bf16(v0[0], v0[1]); w.y = cvt_pk_bf16(v0[2], v0[3]); w.z = cvt_pk_bf16(v1[0], v1[1]); w.w = cvt_pk_bf16(v1[2], v1[3]);
                    *(u32x4*)(rowp + bj * HALF) = w; } }
    }
};

struct EpiResidF32 {
    static constexpr bool PERM = false, AFTER_DRAIN = false;
    const bf16_t* X; bf16_t* Z;
    __device__ __forceinline__ void operator()(const f32x4 (&acc)[2][2][4][2], const Unit& u, int wr, int wc, int fr, int fq) const {
        typedef unsigned u32x2 __attribute__((ext_vector_type(2)));
        const int row0 = u.pm * BM + wr * 64 + fr, col0 = u.pn * BM + wc * 32 + 4 * fq;
#pragma unroll
        for (int ai = 0; ai < 2; ++ai)
#pragma unroll
            for (int m = 0; m < 4; ++m) { const size_t ro = (size_t)(row0 + ai * HALF + m * 16) * 1024;
#pragma unroll
                for (int bj = 0; bj < 2; ++bj)
#pragma unroll
                    for (int n = 0; n < 2; ++n) { const int c = col0 + bj * HALF + n * 16; const u32x2 xw = *(const u32x2*)(X + ro + c);
                        f32x4 xv; xv[0] = __builtin_bit_cast(float, xw.x << 16); xv[1] = __builtin_bit_cast(float, xw.x & 0xffff0000u); xv[2] = __builtin_bit_cast(float, xw.y << 16); xv[3] = __builtin_bit_cast(float, xw.y & 0xffff0000u);
                        const f32x4 zv = xv * 1.41421356237309515f + acc[ai][bj][m][n]; u32x2 zw; zw.x = cvt_pk_bf16(zv[0], zv[1]); zw.y = cvt_pk_bf16(zv[2], zv[3]); *(u32x2*)(Z + ro + c) = zw; } }
    }
};
struct EpiCInF {
    static constexpr bool PERM = true, AFTER_DRAIN = false;
    bf16_t *CQ, *CK, *CV, *CG; const float* lb;
    __device__ __forceinline__ void operator()(const f32x4 (&acc)[2][2][4][2], const Unit& u, int wr, int wc, int fr, int fq) const {
        const int seg = u.pn >> 2, colt = (u.pn & 3) * BM;
        bf16_t* base = seg == 0 ? CQ : (seg == 1 ? CK : (seg == 2 ? CV : CG));
        const int row0 = u.pm * BM + wr * 64 + fr, col0 = colt + wc * 32 + 8 * fq;
        f32x4 om[2][2];
#pragma unroll
        for (int bj = 0; bj < 2; ++bj)
#pragma unroll
            for (int n = 0; n < 2; ++n) { const f32x4 l = *(const f32x4*)(lb + col0 + bj * HALF + 4 * n); om[bj][n] = 1.0f - l; }
#pragma unroll
        for (int ai = 0; ai < 2; ++ai)
#pragma unroll
            for (int m = 0; m < 4; ++m) { bf16_t* rowp = base + (size_t)(row0 + ai * HALF + m * 16) * 1024 + col0;
#pragma unroll
                for (int bj = 0; bj < 2; ++bj) { f32x4 v0 = acc[ai][bj][m][0], v1 = acc[ai][bj][m][1];
                    if (seg == 1) {
#pragma unroll
                        for (int q = 0; q < 4; ++q) { v0[q] = om[bj][0][q] / (1.0f + __expf(v0[q])); v1[q] = om[bj][1][q] / (1.0f + __expf(v1[q])); } }
                    u32x4 w; w.x = cvt_pk_bf16(v0[0], v0[1]); w.y = cvt_pk_bf16(v0[2], v0[3]); w.z = cvt_pk_bf16(v1[0], v1[1]); w.w = cvt_pk_bf16(v1[2], v1[3]);
                    *(u32x4*)(rowp + bj * HALF) = w; } }
    }
};
template <class Epi, class Sched, bool ALIGN_EPI = false, bool SP2 = false>
__device__ __forceinline__ void gemm_phase(PG8_LAS unsigned char* lds, const Gemm g, const Sched& S, const Epi& E) {
    const int tid = threadIdx.x, wid = __builtin_amdgcn_readfirstlane(tid >> 6), lane = tid & 63, wr = wid >> 2, wc = wid & 3, fr = lane & 15, fq = lane >> 4;
    const int K = g.K, nt = K / BK;
    unsigned voffA[2], voffB[2];
#pragma unroll
    for (int i = 0; i < 2; ++i) { int R, C; stage_rc(tid * 16 + i * 8192, R, C); const int Rb = Epi::PERM ? ((R & ~31) + perm32(R & 31)) : R;
        voffA[i] = (unsigned)(R * K + C) * 2u; voffB[i] = (unsigned)(Rb * K + C) * 2u; }
    const size_t kstep = (size_t)(BK * 2);
    const size_t hstep = (size_t)HALF * K * 2;
    const size_t tstep = 2 * hstep;
    const unsigned ldsw = (unsigned)wid * 1024u;
    const int aoff = lds_byte(wr * 64 + fr, fq * 8), boff = lds_byte(wc * 32 + fr, fq * 8);
#define PG8_SA(b, h) (((b) * 2 + (h)) * HTB)
#define PG8_SB(b, h) ((4 + (b) * 2 + (h)) * HTB)
#define PG8_STAGE(bufoff, gbase, voff) do { _Pragma("unroll") for (int _i = 0; _i < 2; ++_i) \
        __builtin_amdgcn_global_load_lds((const unsigned*)((const char*)(gbase) + (voff)[_i]), (PG8_LAS unsigned*)(lds + (bufoff) + ldsw + _i * 8192), 16, 0, 0); } while (0)
#define PG8_LDA(dst, b, h) do { _Pragma("unroll") for (int m = 0; m < 4; ++m) _Pragma("unroll") for (int k = 0; k < 2; ++k) dst[m][k] = *(const PG8_LAS bf16x8*)(lds + PG8_SA(b, h) + aoff + m * 2048 + k * 1024); } while (0)
#define PG8_LDB(dst, b, h) do { _Pragma("unroll") for (int n = 0; n < 2; ++n) _Pragma("unroll") for (int k = 0; k < 2; ++k) dst[n][k] = *(const PG8_LAS bf16x8*)(lds + PG8_SB(b, h) + boff + n * 2048 + k * 1024); } while (0)
#define PG8_MMA(ai, bj, At, Bt) do { __builtin_amdgcn_s_setprio(1); _Pragma("unroll") for (int m = 0; m < 4; ++m) _Pragma("unroll") for (int n = 0; n < 2; ++n) _Pragma("unroll") for (int k = 0; k < 2; ++k) \
        acc[ai][bj][m][n] = __builtin_amdgcn_mfma_f32_16x16x32_bf16(Bt[n][k], At[m][k], acc[ai][bj][m][n], 0, 0, 0); __builtin_amdgcn_s_setprio(0); } while (0)
#define PG8_WAIT_V(n) asm volatile("s_waitcnt vmcnt(" #n ")" ::: "memory")
#define PG8_WAIT_L(n) asm volatile("s_waitcnt lgkmcnt(" #n ")" ::: "memory")
#define PG8_BAR __builtin_amdgcn_s_barrier()
#define PG8_SCHED __builtin_amdgcn_sched_barrier(0)
    Unit cur, nxt; int ui = 0;
    if (!S.next(0, cur)) return;
    f32x4 acc[2][2][4][2];
#pragma unroll
    for (int a = 0; a < 2; ++a)
#pragma unroll
        for (int b = 0; b < 2; ++b)
#pragma unroll
            for (int m = 0; m < 4; ++m)
#pragma unroll
                for (int n = 0; n < 2; ++n) acc[a][b][m][n] = (f32x4){0.f, 0.f, 0.f, 0.f};
    bf16x8 At[4][2], B0[2][2], B1[2][2];
    const char* cA = (const char*)g.A + (size_t)cur.pm * tstep; const char* cB = (const char*)g.Bt + (size_t)cur.pn * tstep;
    S.a_ready(cur);
    if constexpr (SP2) {
        PG8_STAGE(PG8_SB(0, 0), cB, voffB); PG8_STAGE(PG8_SB(0, 1), cB + hstep, voffB); PG8_STAGE(PG8_SA(0, 0), cA, voffA); PG8_STAGE(PG8_SA(0, 1), cA + hstep, voffA);
        if (wr == 1) PG8_BAR;
        PG8_WAIT_V(2); PG8_BAR;
        PG8_STAGE(PG8_SB(1, 0), cB + kstep, voffB); PG8_STAGE(PG8_SA(1, 0), cA + kstep, voffA); PG8_STAGE(PG8_SB(1, 1), cB + hstep + kstep, voffB);
        PG8_WAIT_V(6); PG8_BAR;
    } else {
        PG8_STAGE(PG8_SB(0, 0), cB, voffB); PG8_STAGE(PG8_SA(0, 0), cA, voffA); PG8_STAGE(PG8_SB(0, 1), cB + hstep, voffB); PG8_STAGE(PG8_SA(0, 1), cA + hstep, voffA);
        if (wr == 1) PG8_BAR;
        PG8_WAIT_V(4); PG8_BAR;
        PG8_STAGE(PG8_SB(1, 0), cB + kstep, voffB); PG8_STAGE(PG8_SA(1, 0), cA + kstep, voffA); PG8_STAGE(PG8_SB(1, 1), cB + hstep + kstep, voffB);
        PG8_WAIT_V(6); PG8_BAR;
    }
    for (;;) {
        const bool has_next = S.next(ui + 1, nxt);
        const char* nA = has_next ? (const char*)g.A + (size_t)nxt.pm * tstep : cA; const char* nB = has_next ? (const char*)g.Bt + (size_t)nxt.pn * tstep : cB;
        for (int t = 0; t < nt; t += 2) {
            const bool last = (t == nt - 2);
            const char* a1 = cA + (size_t)(t + 1) * kstep;
            const char* a2 = last ? nA : cA + (size_t)(t + 2) * kstep; const char* b2 = last ? nB : cB + (size_t)(t + 2) * kstep;
            const char* a3 = a2 + kstep; const char* b3 = b2 + kstep;
            if (last && has_next) S.a_ready(nxt);
            if constexpr (SP2) {
            PG8_LDB(B0, 0, 0); PG8_LDB(B1, 0, 1); PG8_SCHED; PG8_LDA(At, 0, 0); PG8_STAGE(PG8_SA(1, 1), a1 + hstep, voffA);
            PG8_WAIT_V(8); PG8_WAIT_L(0); PG8_BAR; PG8_MMA(0, 0, At, B0); PG8_MMA(0, 1, At, B1); PG8_BAR; PG8_SCHED;
            PG8_LDA(At, 0, 1); PG8_STAGE(PG8_SB(0, 0), b2, voffB); PG8_STAGE(PG8_SB(0, 1), b2 + hstep, voffB); PG8_STAGE(PG8_SA(0, 0), a2, voffA);
            PG8_WAIT_V(8); PG8_WAIT_L(0); PG8_BAR; PG8_MMA(1, 0, At, B0); PG8_MMA(1, 1, At, B1); PG8_BAR; PG8_SCHED;
            PG8_LDB(B0, 1, 0); PG8_LDB(B1, 1, 1); PG8_SCHED; PG8_LDA(At, 1, 0); PG8_STAGE(PG8_SA(0, 1), a2 + hstep, voffA);
            PG8_WAIT_V(8); PG8_WAIT_L(0); PG8_BAR; PG8_MMA(0, 0, At, B0); PG8_MMA(0, 1, At, B1); PG8_BAR; PG8_SCHED;
            PG8_LDA(At, 1, 1); PG8_STAGE(PG8_SB(1, 0), b3, voffB); PG8_STAGE(PG8_SB(1, 1), b3 + hstep, voffB); PG8_STAGE(PG8_SA(1, 0), a3, voffA);
            PG8_WAIT_V(8); PG8_WAIT_L(0); PG8_BAR; PG8_MMA(1, 0, At, B0); PG8_MMA(1, 1, At, B1); PG8_BAR; PG8_SCHED;
            } else {
            PG8_LDB(B0, 0, 0); PG8_SCHED; PG8_LDA(At, 0, 0); PG8_STAGE(PG8_SA(1, 1), a1 + hstep, voffA);
            PG8_WAIT_L(8); PG8_BAR; PG8_WAIT_L(0); PG8_MMA(0, 0, At, B0); PG8_BAR; PG8_SCHED;
            PG8_LDB(B1, 0, 1); PG8_STAGE(PG8_SB(0, 0), b2, voffB);
            PG8_BAR; PG8_WAIT_L(0); PG8_MMA(0, 1, At, B1); PG8_BAR;
            PG8_LDA(At, 0, 1); PG8_STAGE(PG8_SA(0, 0), a2, voffA);
            PG8_BAR; PG8_WAIT_L(0); PG8_MMA(1, 0, At, B0); PG8_BAR; PG8_SCHED;
            PG8_STAGE(PG8_SB(0, 1), b2 + hstep, voffB);
            PG8_WAIT_V(6); PG8_BAR; PG8_MMA(1, 1, At, B1); PG8_BAR;
            PG8_LDB(B0, 1, 0); PG8_SCHED; PG8_LDA(At, 1, 0); PG8_STAGE(PG8_SA(0, 1), a2 + hstep, voffA);
            PG8_WAIT_L(8); PG8_BAR; PG8_WAIT_L(0); PG8_MMA(0, 0, At, B0); PG8_BAR; PG8_SCHED;
            PG8_LDB(B1, 1, 1); PG8_STAGE(PG8_SB(1, 0), b3, voffB);
            PG8_BAR; PG8_WAIT_L(0); PG8_MMA(0, 1, At, B1); PG8_BAR;
            PG8_LDA(At, 1, 1); PG8_STAGE(PG8_SA(1, 0), a3, voffA);
            PG8_BAR; PG8_WAIT_L(0); PG8_MMA(1, 0, At, B0); PG8_BAR; PG8_SCHED;
            PG8_STAGE(PG8_SB(1, 1), b3 + hstep, voffB);
            PG8_WAIT_V(6); PG8_BAR; PG8_MMA(1, 1, At, B1); PG8_BAR;
            }
        }
        if constexpr (ALIGN_EPI) { if (wr == 0) PG8_BAR; }
        if constexpr (!Epi::AFTER_DRAIN) { E(acc, cur, wr, wc, fr, fq); S.done(cur); }
        if (!has_next) break;
#pragma unroll
        for (int a = 0; a < 2; ++a)
#pragma unroll
            for (int b = 0; b < 2; ++b)
#pragma unroll
                for (int m = 0; m < 4; ++m)
#pragma unroll
                    for (int n = 0; n < 2; ++n) acc[a][b][m][n] = (f32x4){0.f, 0.f, 0.f, 0.f};
        cur = nxt; cA = nA; cB = nB; ++ui;
        if constexpr (ALIGN_EPI) { if (wr == 1) PG8_BAR; }
    }
    PG8_WAIT_V(0);
    if constexpr (!ALIGN_EPI) { if (wr == 0) PG8_BAR; }
    PG8_BAR;
    if constexpr (Epi::AFTER_DRAIN) { E.fused(acc, cur, wr, wc, fr, fq, lds, wid, lane); S.done(cur); }
#undef PG8_SA
#undef PG8_SB
#undef PG8_STAGE
#undef PG8_LDA
#undef PG8_LDB
#undef PG8_MMA
#undef PG8_WAIT_V
#undef PG8_WAIT_L
#undef PG8_BAR
#undef PG8_SCHED
}
}

__device__ __forceinline__ float gamma_log2(int h) { return log2f(1.f - exp2f(-5.f - (float)h)); }

__device__ __forceinline__ void phase_prologue(LAS unsigned char* lds, const float* const* in, unsigned char* ws) {
    const int tid = threadIdx.x, lane = tid & 63, wave = tid >> 6;
    const int gw = blockIdx.x * NWAVES + wave, NGW = gridDim.x * NWAVES;
    LAS float* scr = (LAS float*)(lds + wave * 16384);
    constexpr int I_ABIN = (D / 64) * (AB_IN / 32), I_SQ = (D / 64) * (D / 32), I_CIN = (D / 64) * (C_IN / 32), I_WQ = (D / 64) * (2048 / 32);
    constexpr int NITEMS = I_ABIN + I_SQ + I_CIN + I_SQ + 2 * I_WQ;
    for (int it = gw; it < NITEMS; it += NGW) {
        int r = it;
        if (r < I_ABIN) { p0_transpose_item(in[1], D, AB_IN, (bf16*)(ws + WS_WABIN), scr, r, lane); continue; } r -= I_ABIN;
        if (r < I_SQ) { p0_transpose_item(in[5], D, D, (bf16*)(ws + WS_WABOUT), scr, r, lane); continue; } r -= I_SQ;
        if (r < I_CIN) { p0_transpose_item(in[6], D, C_IN, (bf16*)(ws + WS_WCIN), scr, r, lane); continue; } r -= I_CIN;
        if (r < I_SQ) { p0_transpose_item(in[9], D, D, (bf16*)(ws + WS_WCOUT), scr, r, lane); continue; } r -= I_SQ;
        if (r < I_WQ) { p0_transpose_item(in[10], D, 2048, (bf16*)(ws + WS_WQ), scr, r, lane); continue; } r -= I_WQ;
        p0_transpose_item(in[10] + (size_t)D * 2048, D, 2048, (bf16*)(ws + WS_WQ) + (size_t)2048 * D, scr, r, lane);
    }
    for (int it = gw; it < 32; it += NGW) p0_transpose_item(in[2] + (size_t)(it >> 3) * 16384, 128, 128, (bf16*)(ws + WS_POOLWT) + (size_t)(it >> 3) * 16384, scr, it & 7, lane);
    const size_t gt = (size_t)blockIdx.x * NTHR + tid, NT = (size_t)gridDim.x * NTHR;
    { const float* x = in[0]; bf16* xb = (bf16*)(ws + WS_XB);
      for (size_t i = gt; i < (size_t)T * D / 8; i += NT) { const f32x4 a = *(const GAS f32x4*)(x + i * 8), b = *(const GAS f32x4*)(x + i * 8 + 4);
          v4u o; o.x = pk2(a.x, a.y); o.y = pk2(a.z, a.w); o.z = pk2(b.x, b.y); o.w = pk2(b.z, b.w); *(GAS v4u*)(xb + i * 8) = o; } }
    { const float* k = in[11]; bf16* kb = (bf16*)(ws + WS_KEYS);
      for (size_t i = gt; i < (size_t)2 * 8 * 2 * 128 * 128 / 8; i += NT) { const f32x4 a = *(const GAS f32x4*)(k + i * 8), b = *(const GAS f32x4*)(k + i * 8 + 4);
          v4u o; o.x = pk2(a.x, a.y); o.y = pk2(a.z, a.w); o.z = pk2(b.x, b.y); o.w = pk2(b.z, b.w); *(GAS v4u*)(kb + i * 8) = o; } }
    { float* ct = (float*)(ws + WS_ROPE); float* st = ct + 4096 * 32;
      for (size_t i = gt; i < (size_t)4096 * 32; i += NT) { const int pos = (int)(i >> 5), f = (int)(i & 31);
          const double inv = exp(-log(10000.0) * ((double)f / 31.0)); const double ang = (double)pos * inv;
          ct[i] = (float)cos(ang); st[i] = (float)sin(ang); } }
    { const float* l = in[7]; float* lb = (float*)(ws + WS_LB);
      for (size_t i = gt; i < 1024; i += NT) { const float a = l[i], b = l[1024 + i]; const float m = fmaxf(a, b); const float ea = expf(a - m), eb = expf(b - m); lb[i] = eb / (ea + eb); } }
}

__device__ __forceinline__ void phase_ret_local(LAS unsigned char* lds, unsigned char* ws) {
    const int tid = threadIdx.x;
    const bf16* H0 = (const bf16*)(ws + WS_H0); float* LST = (float*)(ws + WS_LST);
    const float* ct = (const float*)(ws + WS_ROPE); const float* st = ct + 4096 * 32;
    LAS float* kd = (LAS float*)lds;
    LAS float* vv = (LAS float*)(lds + 32768);
    for (int item = blockIdx.x; item < 1024; item += gridDim.x) {
        const int n = item & 31, h = (item >> 5) & 3, b = item >> 7;
        const size_t t0 = (size_t)b * SEQ + n * 128; const float lg = gamma_log2(h);
        for (int idx = tid; idx < 4096; idx += NTHR) { const int s = idx >> 5, i = idx & 31, pos = n * 128 + s;
            const bf16* row = H0 + (t0 + s) * AB_IN + 768 + h * 64;
            const float x1 = bf2f(row[i]), x2 = bf2f(row[i + 32]); const float c = ct[pos * 32 + i], sn = st[pos * 32 + i];
            const float dec = exp2f((float)(127 - s) * lg) * 0.125f;
            kd[s * 64 + i] = (x1 * c - x2 * sn) * dec; kd[s * 64 + i + 32] = (x2 * c + x1 * sn) * dec; }
        for (int idx = tid; idx < 16384; idx += NTHR) { const int s = idx >> 7, e = idx & 127; vv[idx] = bf2f(H0[(t0 + s) * AB_IN + 1024 + h * 128 + e]); }
        __syncthreads();
        const int e = tid & 127, dg = tid >> 7;
        float acc[16];
#pragma unroll
        for (int j = 0; j < 16; ++j) acc[j] = 0.f;
        for (int s = 0; s < 128; ++s) { const float v = vv[s * 128 + e];
#pragma unroll
            for (int j = 0; j < 16; ++j) acc[j] += kd[s * 64 + dg * 16 + j] * v; }
#pragma unroll
        for (int j = 0; j < 16; ++j) LST[(size_t)item * 8192 + (dg * 16 + j) * 128 + e] = acc[j];
        __syncthreads();
    }
}
__device__ __forceinline__ void phase_ret_prefix(unsigned char* ws) {
    float* LST = (float*)(ws + WS_LST);
    const size_t gt = (size_t)blockIdx.x * NTHR + threadIdx.x, NT = (size_t)gridDim.x * NTHR;
    for (size_t idx = gt; idx < (size_t)32 * 8192; idx += NT) { const int bh = (int)(idx >> 13), el = (int)(idx & 8191), h = bh & 3;
        const float g128 = exp2f(128.f * gamma_log2(h)); float S = 0.f;
        for (int n = 0; n < 32; ++n) { float* p = LST + ((size_t)(bh * 32 + n) * 8192 + el); const float tmp = *p; *p = S; S = S * g128 + tmp; } }
}
__device__ __forceinline__ void phase_ret_out_pool(LAS unsigned char* lds, const float* const* in, unsigned char* ws) {
    const int tid = threadIdx.x;
    const bf16* H0 = (const bf16*)(ws + WS_H0); const float* LST = (const float*)(ws + WS_LST); bf16* Y = (bf16*)(ws + WS_Y);
    const float* ct = (const float*)(ws + WS_ROPE); const float* st = ct + 4096 * 32;
    const float* pool_w = in[2]; const float* pool_scale = in[3]; const float* ret_g = in[4];
    LAS float* qs = (LAS float*)lds;
    LAS float* ks = qs + 128 * 65;
    LAS float* R2 = (LAS float*)(lds + 66560);
    LAS float* PA = (LAS float*)lds;
    LAS float* PB = (LAS float*)(lds + 66048);
    for (int item = blockIdx.x; item < 256; item += gridDim.x) {
        const int n = item & 31, b = item >> 5; const size_t t0 = (size_t)b * SEQ + n * 128;
        const int c = tid >> 2, eg = tid & 3;
        for (int h = 0; h < 4; ++h) {
            const float lg = gamma_log2(h);
            for (int idx = tid; idx < 4096; idx += NTHR) { const int s = idx >> 5, i = idx & 31, pos = n * 128 + s;
                const bf16* rq = H0 + (t0 + s) * AB_IN + 512 + h * 64; const bf16* rk = H0 + (t0 + s) * AB_IN + 768 + h * 64;
                const float cs = ct[pos * 32 + i], sn = st[pos * 32 + i];
                const float q1 = bf2f(rq[i]), q2 = bf2f(rq[i + 32]), k1 = bf2f(rk[i]), k2 = bf2f(rk[i + 32]);
                qs[s * 65 + i] = q1 * cs - q2 * sn; qs[s * 65 + i + 32] = q2 * cs + q1 * sn;
                ks[s * 65 + i] = (k1 * cs - k2 * sn) * 0.125f; ks[s * 65 + i + 32] = (k2 * cs + k1 * sn) * 0.125f; }
            { const float* Sg = LST + (size_t)((b * 4 + h) * 32 + n) * 8192;
              for (int idx = tid; idx < 8192; idx += NTHR) R2[idx] = Sg[idx]; }
            __syncthreads();
            float o[32];
#pragma unroll
            for (int j = 0; j < 32; ++j) o[j] = 0.f;
            for (int d = 0; d < 64; ++d) { const float qv = qs[c * 65 + d];
#pragma unroll
                for (int j = 0; j < 32; ++j) o[j] += qv * R2[d * 128 + eg * 32 + j]; }
            { const float qd = exp2f((float)(c + 1) * lg);
#pragma unroll
              for (int j = 0; j < 32; ++j) o[j] *= qd; }
            __syncthreads();
            for (int idx = tid; idx < 16384; idx += NTHR) { const int s = idx >> 7, e = idx & 127; R2[idx] = bf2f(H0[(t0 + s) * AB_IN + 1024 + h * 128 + e]); }
            __syncthreads();
            for (int s = 0; s <= c; ++s) {
                float dot = 0.f;
#pragma unroll 16
                for (int d = 0; d < 64; ++d) dot += qs[c * 65 + d] * ks[s * 65 + d];
                const float w = dot * exp2f((float)(c - s) * lg);
#pragma unroll
                for (int j = 0; j < 32; ++j) o[j] += w * R2[s * 128 + eg * 32 + j];
            }
            float sum = 0.f;
#pragma unroll
            for (int j = 0; j < 32; ++j) sum += o[j];
            sum += __shfl_xor(sum, 1); sum += __shfl_xor(sum, 2);
            const float mean = sum * (1.f / 128.f); float sq = 0.f;
#pragma unroll
            for (int j = 0; j < 32; ++j) { const float dl = o[j] - mean; sq += dl * dl; }
            sq += __shfl_xor(sq, 1); sq += __shfl_xor(sq, 2);
            const float rstd = 1.f / sqrtf(sq * (1.f / 128.f) + LN_EPS);
            { const bf16* rg = H0 + (t0 + c) * AB_IN + 1536 + h * 128 + eg * 32; bf16* yo = Y + (t0 + c) * D + 512 + h * 128 + eg * 32;
#pragma unroll
              for (int j = 0; j < 32; ++j) { const float g = bf2f(rg[j]); const float sg = g / (1.f + expf(-g));
                  yo[j] = (bf16)f2bf((o[j] - mean) * rstd * ret_g[h * 128 + eg * 32 + j] * sg); } }
            __syncthreads();
        }
        for (int gi = 0; gi < 4; ++gi) {
            const int w = 2 << gi;
            for (int idx = tid; idx < 16384; idx += NTHR) { const int s = idx >> 7, cc = idx & 127, pos = n * 128 + s; const int cnt = (pos + 1 < w) ? pos + 1 : w;
                float sum = 0.f; for (int j = 0; j < cnt; ++j) sum += bf2f(H0[(t0 + s - j) * AB_IN + gi * 128 + cc]);
                PA[s * 129 + cc] = sum / (float)cnt - bf2f(H0[(t0 + s) * AB_IN + gi * 128 + cc]); }
            for (int idx = tid; idx < 16384; idx += NTHR) PB[idx] = pool_w[gi * 16384 + idx];
            __syncthreads();
            float o[32];
#pragma unroll
            for (int j = 0; j < 32; ++j) o[j] = 0.f;
            for (int cc = 0; cc < 128; ++cc) { const float pv = PA[c * 129 + cc];
#pragma unroll
                for (int j = 0; j < 32; ++j) o[j] += pv * PB[cc * 128 + eg * 32 + j]; }
            { bf16* yo = Y + (t0 + c) * D + gi * 128 + eg * 32;
#pragma unroll
              for (int j = 0; j < 32; ++j) yo[j] = (bf16)f2bf(o[j] * pool_scale[gi * 128 + eg * 32 + j]); }
            __syncthreads();
        }
    }
}

__device__ __forceinline__ void unpack8(const v4u w, float (&x)[8]) { x[0] = bflo(w.x); x[1] = bfhi(w.x); x[2] = bflo(w.y); x[3] = bfhi(w.y); x[4] = bflo(w.z); x[5] = bfhi(w.z); x[6] = bflo(w.w); x[7] = bfhi(w.w); }
__device__ __forceinline__ v4u pack8(const float (&x)[8]) { v4u w; w.x = pk2(x[0], x[1]); w.y = pk2(x[2], x[3]); w.z = pk2(x[4], x[5]); w.w = pk2(x[6], x[7]); return w; }
__device__ __forceinline__ void phase_ret_out_pool_fast(LAS unsigned char* lds, const float* const* in, unsigned char* ws) {
    const int tid = threadIdx.x, lane = tid & 63, wave = __builtin_amdgcn_readfirstlane(tid >> 6);
    const int c = lane & 31, hh = lane >> 5, cbk = wave & 3, eh = wave >> 2;
    const bf16* H0 = (const bf16*)(ws + WS_H0); const float* LST = (const float*)(ws + WS_LST); bf16* Y = (bf16*)(ws + WS_Y);
    const float* ct = (const float*)(ws + WS_ROPE); const float* st = ct + 4096 * 32;
    const float* pool_scale = in[3]; const float* ret_g = in[4]; const bf16* PWT = (const bf16*)(ws + WS_POOLWT);
    constexpr int O_QP = 0, O_KP = 18432, O_VT = 36864, O_ST = 71680, O_PI = 90112, O_RED = 124928, O_PT = 0, O_WT = 34816;
    for (int item = blockIdx.x; item < 256; item += gridDim.x) {
        const int n = item & 31, b = item >> 5; const size_t t0 = (size_t)b * SEQ + n * 128;
        for (int h = 0; h < 4; ++h) {
            const float lg = gamma_log2(h);
            __syncthreads();
            { const int s = tid >> 2, grp = tid & 3, pos = n * 128 + s;
              const bf16* rq = H0 + (t0 + s) * AB_IN + 512 + h * 64 + 8 * grp; const bf16* rk = H0 + (t0 + s) * AB_IN + 768 + h * 64 + 8 * grp;
              float q1[8], q2[8], k1[8], k2[8], cs[8], sn[8];
              unpack8(*(const GAS v4u*)rq, q1); unpack8(*(const GAS v4u*)(rq + 32), q2); unpack8(*(const GAS v4u*)rk, k1); unpack8(*(const GAS v4u*)(rk + 32), k2);
              { const f32x4 a = *(const GAS f32x4*)(ct + pos * 32 + 8 * grp), bq = *(const GAS f32x4*)(ct + pos * 32 + 8 * grp + 4);
                cs[0] = a.x; cs[1] = a.y; cs[2] = a.z; cs[3] = a.w; cs[4] = bq.x; cs[5] = bq.y; cs[6] = bq.z; cs[7] = bq.w; }
              { const f32x4 a = *(const GAS f32x4*)(st + pos * 32 + 8 * grp), bq = *(const GAS f32x4*)(st + pos * 32 + 8 * grp + 4);
                sn[0] = a.x; sn[1] = a.y; sn[2] = a.z; sn[3] = a.w; sn[4] = bq.x; sn[5] = bq.y; sn[6] = bq.z; sn[7] = bq.w; }
              const float gq = exp2f((float)(s + 1) * lg), gk = 0.125f * exp2f(-(float)(s + 1) * lg);
              float qa[8], qb[8], ka[8], kb[8];
#pragma unroll
              for (int j = 0; j < 8; ++j) { qa[j] = (q1[j] * cs[j] - q2[j] * sn[j]) * gq; qb[j] = (q2[j] * cs[j] + q1[j] * sn[j]) * gq;
                                            ka[j] = (k1[j] * cs[j] - k2[j] * sn[j]) * gk; kb[j] = (k2[j] * cs[j] + k1[j] * sn[j]) * gk; }
              *(LAS v4u*)(lds + O_QP + s * 144 + 16 * grp) = pack8(qa); *(LAS v4u*)(lds + O_QP + s * 144 + 64 + 16 * grp) = pack8(qb);
              *(LAS v4u*)(lds + O_KP + s * 144 + 16 * grp) = pack8(ka); *(LAS v4u*)(lds + O_KP + s * 144 + 64 + 16 * grp) = pack8(kb); }
#pragma unroll
            for (int i = 0; i < 4; ++i) { const int task = tid + 512 * i, e8 = task >> 7, s = task & 127;
                const v4u w = *(const GAS v4u*)(H0 + (t0 + s) * AB_IN + 1024 + h * 128 + 8 * e8);
                LAS bf16* d = (LAS bf16*)(lds + O_VT + (8 * e8) * 272 + 2 * s);
                d[0 * 136] = (bf16)(w.x & 0xffffu); d[1 * 136] = (bf16)(w.x >> 16); d[2 * 136] = (bf16)(w.y & 0xffffu); d[3 * 136] = (bf16)(w.y >> 16);
                d[4 * 136] = (bf16)(w.z & 0xffffu); d[5 * 136] = (bf16)(w.z >> 16); d[6 * 136] = (bf16)(w.w & 0xffffu); d[7 * 136] = (bf16)(w.w >> 16); }
            { const float* Sg = LST + (size_t)((b * 4 + h) * 32 + n) * 8192;
#pragma unroll
              for (int i = 0; i < 4; ++i) { const int task = tid + 512 * i, e4 = task >> 6, d = task & 63;
                  const f32x4 sv = *(const GAS f32x4*)(Sg + d * 128 + 4 * e4);
                  LAS bf16* o = (LAS bf16*)(lds + O_ST + (4 * e4) * 144 + 2 * d);
                  o[0 * 72] = (bf16)f2bf(sv.x); o[1 * 72] = (bf16)f2bf(sv.y); o[2 * 72] = (bf16)f2bf(sv.z); o[3 * 72] = (bf16)f2bf(sv.w); } }
            __syncthreads();
            bf16x8 qf[4];
#pragma unroll
            for (int ks = 0; ks < 4; ++ks) qf[ks] = *(const LAS bf16x8*)(lds + O_QP + (32 * cbk + c) * 144 + (16 * ks + 8 * hh) * 2);
            for (int sb = 0; sb <= cbk; ++sb) {
                f32x16 sc;
#pragma unroll
                for (int r = 0; r < 16; ++r) sc[r] = 0.f;
#pragma unroll
                for (int ks = 0; ks < 4; ++ks) { const bf16x8 kf = *(const LAS bf16x8*)(lds + O_KP + (32 * sb + c) * 144 + (16 * ks + 8 * hh) * 2);
                    sc = __builtin_amdgcn_mfma_f32_32x32x16_bf16(kf, qf[ks], sc, 0, 0, 0); }
#pragma unroll
                for (int g4 = 0; g4 < 4; ++g4) { float m[4];
#pragma unroll
                    for (int q = 0; q < 4; ++q) { const float sv = sc[4 * g4 + q]; m[q] = (sb < cbk || 8 * g4 + 4 * hh + q <= c) ? sv : 0.f; }
                    *(LAS v2u*)(lds + O_PI + cbk * 8704 + c * 272 + (32 * sb + 8 * g4 + 4 * hh) * 2) = (v2u){pk2(m[0], m[1]), pk2(m[2], m[3])}; }
            }
            f32x16 acc[2];
#pragma unroll
            for (int j = 0; j < 2; ++j) {
#pragma unroll
                for (int r = 0; r < 16; ++r) acc[j][r] = 0.f;
                const int eb = 2 * eh + j;
                for (int sb = 0; sb <= cbk; ++sb) {
#pragma unroll
                    for (int ks = 0; ks < 2; ++ks) { const bf16x8 af = *(const LAS bf16x8*)(lds + O_VT + (32 * eb + c) * 272 + (32 * sb + 16 * ks + 8 * hh) * 2);
                        const bf16x8 pf = *(const LAS bf16x8*)(lds + O_PI + cbk * 8704 + c * 272 + (32 * sb + 16 * ks + 8 * hh) * 2);
                        acc[j] = __builtin_amdgcn_mfma_f32_32x32x16_bf16(af, pf, acc[j], 0, 0, 0); }
                }
#pragma unroll
                for (int ks = 0; ks < 4; ++ks) { const bf16x8 sf = *(const LAS bf16x8*)(lds + O_ST + (32 * eb + c) * 144 + (16 * ks + 8 * hh) * 2);
                    acc[j] = __builtin_amdgcn_mfma_f32_32x32x16_bf16(sf, qf[ks], acc[j], 0, 0, 0); }
            }
            float sum = 0.f, sq = 0.f;
#pragma unroll
            for (int j = 0; j < 2; ++j)
#pragma unroll
                for (int r = 0; r < 16; ++r) { const float ov = acc[j][r]; sum += ov; sq += ov * ov; }
            sum += __shfl_xor(sum, 32); sq += __shfl_xor(sq, 32);
            LAS float* red = (LAS float*)(lds + O_RED);
            if (hh == 0) { red[(eh * 128 + 32 * cbk + c) * 2] = sum; red[(eh * 128 + 32 * cbk + c) * 2 + 1] = sq; }
            __syncthreads();
            sum += red[((eh ^ 1) * 128 + 32 * cbk + c) * 2]; sq += red[((eh ^ 1) * 128 + 32 * cbk + c) * 2 + 1];
            const float mean = sum * (1.f / 128.f); const float var = fmaxf(sq * (1.f / 128.f) - mean * mean, 0.f);
            const float rstd = 1.f / sqrtf(var + LN_EPS);
            { const size_t row = t0 + 32 * cbk + c;
#pragma unroll
              for (int j = 0; j < 2; ++j)
#pragma unroll
                  for (int g4 = 0; g4 < 4; ++g4) { const int e = 32 * (2 * eh + j) + 8 * g4 + 4 * hh;
                      const v2u gw2 = *(const GAS v2u*)(H0 + row * AB_IN + 1536 + h * 128 + e); const f32x4 gm = *(const GAS f32x4*)(ret_g + h * 128 + e);
                      const float g0 = bflo(gw2.x), g1 = bfhi(gw2.x), g2 = bflo(gw2.y), g3 = bfhi(gw2.y);
                      const float o0 = acc[j][4 * g4 + 0], o1 = acc[j][4 * g4 + 1], o2 = acc[j][4 * g4 + 2], o3 = acc[j][4 * g4 + 3];
                      const float y0 = (o0 - mean) * rstd * gm.x * (g0 / (1.f + __expf(-g0))), y1 = (o1 - mean) * rstd * gm.y * (g1 / (1.f + __expf(-g1)));
                      const float y2 = (o2 - mean) * rstd * gm.z * (g2 / (1.f + __expf(-g2))), y3 = (o3 - mean) * rstd * gm.w * (g3 / (1.f + __expf(-g3)));
                      *(GAS v2u*)(Y + row * D + 512 + h * 128 + e) = (v2u){pk2(y0, y1), pk2(y2, y3)}; } }
        }
        for (int gi = 0; gi < 4; ++gi) {
            const int w = 2 << gi;
            __syncthreads();
#pragma unroll
            for (int i = 0; i < 4; ++i) { const int task = tid + 512 * i, t = task >> 4, c8 = task & 15, pos = n * 128 + t; const int cnt = (pos + 1 < w) ? pos + 1 : w;
                const bf16* ur = H0 + (t0 + t) * AB_IN + gi * 128 + 8 * c8;
                float u0[8], sm[8]; unpack8(*(const GAS v4u*)ur, u0);
#pragma unroll
                for (int q = 0; q < 8; ++q) sm[q] = u0[q];
                for (int j = 1; j < cnt; ++j) { float uj[8]; unpack8(*(const GAS v4u*)(ur - (size_t)j * AB_IN), uj);
#pragma unroll
                    for (int q = 0; q < 8; ++q) sm[q] += uj[q]; }
                const float ic = 1.f / (float)cnt; float pv[8];
#pragma unroll
                for (int q = 0; q < 8; ++q) pv[q] = sm[q] * ic - u0[q];
                *(LAS v4u*)(lds + O_PT + t * 272 + 16 * c8) = pack8(pv); }
#pragma unroll
            for (int i = 0; i < 4; ++i) { const int piece = tid + 512 * i, d = piece >> 4, c16 = piece & 15;
                *(LAS v4u*)(lds + O_WT + d * 272 + 16 * c16) = *(const GAS v4u*)(PWT + (size_t)(gi * 128 + d) * 128 + 8 * c16); }
            __syncthreads();
            bf16x8 pfr[8];
#pragma unroll
            for (int ks = 0; ks < 8; ++ks) pfr[ks] = *(const LAS bf16x8*)(lds + O_PT + (32 * cbk + c) * 272 + (16 * ks + 8 * hh) * 2);
#pragma unroll
            for (int j = 0; j < 2; ++j) { const int db = 2 * eh + j;
                f32x16 a2;
#pragma unroll
                for (int r = 0; r < 16; ++r) a2[r] = 0.f;
#pragma unroll
                for (int ks = 0; ks < 8; ++ks) { const bf16x8 wf = *(const LAS bf16x8*)(lds + O_WT + (32 * db + c) * 272 + (16 * ks + 8 * hh) * 2);
                    a2 = __builtin_amdgcn_mfma_f32_32x32x16_bf16(wf, pfr[ks], a2, 0, 0, 0); }
#pragma unroll
                for (int g4 = 0; g4 < 4; ++g4) { const int d0 = 32 * db + 8 * g4 + 4 * hh; const f32x4 ps = *(const GAS f32x4*)(pool_scale + gi * 128 + d0);
                    const float y0 = a2[4 * g4 + 0] * ps.x, y1 = a2[4 * g4 + 1] * ps.y, y2 = a2[4 * g4 + 2] * ps.z, y3 = a2[4 * g4 + 3] * ps.w;
                    *(GAS v2u*)(Y + (t0 + 32 * cbk + c) * D + gi * 128 + d0) = (v2u){pk2(y0, y1), pk2(y2, y3)}; }
            }
        }
    }
    __syncthreads();
}
__device__ __forceinline__ void phase_ln(const bf16* Z, bf16* O, const float* g, const float* bb) {
    const int tid = threadIdx.x, lane = tid & 63, wave = tid >> 6;
    const int gw = blockIdx.x * NWAVES + wave, NGW = gridDim.x * NWAVES;
    for (int m = gw; m < T; m += NGW) {
        const GAS v2u* zr = (const GAS v2u*)(Z + (size_t)m * D) + lane;
        f32x4 v[4]; float s = 0.f;
#pragma unroll
        for (int j = 0; j < 4; ++j) { const v2u zw = zr[64 * j]; v[j] = (f32x4){bflo(zw.x), bfhi(zw.x), bflo(zw.y), bfhi(zw.y)}; s += (v[j].x + v[j].y) + (v[j].z + v[j].w); }
        const float mean = wave_sum(s) * (1.f / D); float s2 = 0.f;
#pragma unroll
        for (int j = 0; j < 4; ++j) { v[j] = v[j] - mean; s2 += (v[j].x * v[j].x + v[j].y * v[j].y) + (v[j].z * v[j].z + v[j].w * v[j].w); }
        const float rstd = 1.f / sqrtf(wave_sum(s2) * (1.f / D) + LN_EPS);
        GAS v2u* o8 = (GAS v2u*)(O + (size_t)m * D) + lane;
#pragma unroll
        for (int j = 0; j < 4; ++j) { const f32x4 gg = *((const GAS f32x4*)g + lane + 64 * j), b4 = *((const GAS f32x4*)bb + lane + 64 * j);
            v2u o; o.x = pk2(v[j].x * rstd * gg.x + b4.x, v[j].y * rstd * gg.y + b4.y); o.y = pk2(v[j].z * rstd * gg.z + b4.z, v[j].w * rstd * gg.w + b4.w); o8[64 * j] = o; }
    }
}
__device__ __forceinline__ void wave_argmax(float& bv, int& bi) {
#pragma unroll
    for (int off = 32; off >= 1; off >>= 1) { const float ov = __shfl_xor(bv, off); const int oi = __shfl_xor(bi, off);
        if (ov > bv || (ov == bv && oi < bi)) { bv = ov; bi = oi; } }
}
__device__ __forceinline__ void phase_topk(LAS unsigned char* lds, const bf16* Q, const float* keys  , int* EID, float* GATE) {
    const int tid = threadIdx.x, lane = tid & 63, wave = tid >> 6;
    LAS float* kl = (LAS float*)lds;
    LAS float* qt = (LAS float*)(lds + 66048);
    LAS float* sc = (LAS float*)(lds + 82560);
    for (int item = blockIdx.x; item < (T / 32) * 8; item += gridDim.x) {
        const int h = item & 7, tile = item >> 3; const size_t tok0 = (size_t)tile * 32;
        for (int p = 0; p < 2; ++p) {
            const float* kg = keys + (size_t)((h * 2 + p) * 128) * 128;
            for (int idx = tid; idx < 16384; idx += NTHR) { const int k = idx >> 7, d = idx & 127; kl[k * 129 + d] = kg[idx]; }
            for (int idx = tid; idx < 4096; idx += NTHR) { const int t = idx >> 7, d = idx & 127; qt[t * 129 + d] = bf2f(Q[(tok0 + t) * 2048 + h * 256 + p * 128 + d]); }
            __syncthreads();
            { const int t = tid >> 4, kg16 = tid & 15;
              for (int jj = 0; jj < 8; ++jj) { const int k = kg16 + 16 * jj; float dot = 0.f;
#pragma unroll 16
                  for (int d = 0; d < 128; ++d) dot += qt[t * 129 + d] * kl[k * 129 + d];
                  sc[(t * 2 + p) * 128 + k] = dot; } }
            __syncthreads();
        }
        for (int tt = 0; tt < 4; ++tt) {
            const int t = wave * 4 + tt;
            float tv[2]; int ti[2];
#pragma unroll
            for (int p = 0; p < 2; ++p) {
                float v0 = sc[(t * 2 + p) * 128 + lane], v1 = sc[(t * 2 + p) * 128 + lane + 64];
                float mv = 0.f; int mi = 0;
                for (int j = 0; j < 16; ++j) {
                    float bv; int bi; if (v0 >= v1) { bv = v0; bi = lane; } else { bv = v1; bi = lane + 64; }
                    wave_argmax(bv, bi);
                    if (lane == j) { mv = bv; mi = bi; }
                    if (bi == lane) v0 = -INFINITY; if (bi == lane + 64) v1 = -INFINITY;
                }
                tv[p] = mv; ti[p] = mi;
            }
            float cv[4];
#pragma unroll
            for (int m = 0; m < 4; ++m) { const int cidx = lane + 64 * m; cv[m] = __shfl(tv[0], cidx >> 4) + __shfl(tv[1], cidx & 15); }
            float bestv = 0.f; int bestc = 0;
            for (int j = 0; j < 16; ++j) {
                float bv = cv[0]; int bi = lane;
#pragma unroll
                for (int m = 1; m < 4; ++m) if (cv[m] > bv) { bv = cv[m]; bi = lane + 64 * m; }
                wave_argmax(bv, bi);
                if (lane == j) { bestv = bv; bestc = bi; }
#pragma unroll
                for (int m = 0; m < 4; ++m) if (bi == lane + 64 * m) cv[m] = -INFINITY;
            }
            const float mx = __shfl(bestv, 0);
            const float ex = (lane < 16) ? expf(bestv - mx) : 0.f;
            const float den = wave_sum(ex);
            const int ia = __shfl(ti[0], bestc >> 4), ib = __shfl(ti[1], bestc & 15);
            if (lane < 16) { const size_t o = (tok0 + t) * 128 + h * 16 + lane; EID[o] = ia * 128 + ib; GATE[o] = ex / den; }
        }
        __syncthreads();
    }
}

#define CEF_D(a, b) { const float hi_ = fmaxf((a), (b)), lo_ = fminf((a), (b)); (a) = hi_; (b) = lo_; }
#define CEF_A(a, b) { const float hi_ = fmaxf((a), (b)), lo_ = fminf((a), (b)); (a) = lo_; (b) = hi_; }
#define CEP_D(ka, pa, kb, pb) { const bool sw_ = (kb) > (ka); const float k0_ = sw_ ? (kb) : (ka), k1_ = sw_ ? (ka) : (kb); const int p0_ = sw_ ? (pb) : (pa), p1_ = sw_ ? (pa) : (pb); (ka) = k0_; (kb) = k1_; (pa) = p0_; (pb) = p1_; }
template <int OFF, int NV> __device__ __forceinline__ void bsort16_desc(float (&v)[NV]) {
#pragma unroll
    for (int k = 2; k <= 16; k <<= 1) {
#pragma unroll
        for (int j = k >> 1; j > 0; j >>= 1) {
#pragma unroll
            for (int i = 0; i < 16; ++i) { const int l = i ^ j;
                if (l > i) { if ((i & k) == 0) CEF_D(v[OFF + i], v[OFF + l]) else CEF_A(v[OFF + i], v[OFF + l]) } }
        }
    }
}
template <int OA, int NV> __device__ __forceinline__ void bmerge16_desc(float (&v)[NV]) {
#pragma unroll
    for (int j = 8; j > 0; j >>= 1) {
#pragma unroll
        for (int i = 0; i < 16; ++i) { const int l = i ^ j; if (l > i) CEF_D(v[OA + i], v[OA + l]) }
    }
}
template <int OA, int OB, int NV> __device__ __forceinline__ void merge_top16(float (&v)[NV]) {
#pragma unroll
    for (int i = 0; i < 16; ++i) v[OA + i] = fmaxf(v[OA + i], v[OB + 15 - i]);
    bmerge16_desc<OA, NV>(v);
}
template <int OFF, int NV> __device__ __forceinline__ void bsort16p_desc(float (&v)[NV], int (&q)[NV]) {
#pragma unroll
    for (int k = 2; k <= 16; k <<= 1) {
#pragma unroll
        for (int j = k >> 1; j > 0; j >>= 1) {
#pragma unroll
            for (int i = 0; i < 16; ++i) { const int l = i ^ j;
                if (l > i) { if ((i & k) == 0) CEP_D(v[OFF + i], q[OFF + i], v[OFF + l], q[OFF + l]) else CEP_D(v[OFF + l], q[OFF + l], v[OFF + i], q[OFF + i]) } }
        }
    }
}
template <int OA, int NV> __device__ __forceinline__ void bmerge16p_desc(float (&v)[NV], int (&q)[NV]) {
#pragma unroll
    for (int j = 8; j > 0; j >>= 1) {
#pragma unroll
        for (int i = 0; i < 16; ++i) { const int l = i ^ j; if (l > i) CEP_D(v[OA + i], q[OA + i], v[OA + l], q[OA + l]) }
    }
}
__host__ __device__ constexpr int pair_i(int s) { return s < 16 ? 0 : s < 24 ? 1 : s < 29 ? 2 : s < 33 ? 3 : s < 36 ? 4 : s < 38 ? 5 : s < 40 ? 6 : s < 42 ? 7 : (s - 42 + 8); }
__host__ __device__ constexpr int pair_j(int s) { return s < 16 ? s : s < 24 ? s - 16 : s < 29 ? s - 24 : s < 33 ? s - 29 : s < 36 ? s - 33 : s < 38 ? s - 36 : s < 40 ? s - 38 : s < 42 ? s - 40 : 0; }
__device__ __forceinline__ void phase_topk_fast(LAS unsigned char* lds, const bf16* Q, const bf16* keysb  , int* EID, float* GATE) {
    const int tid = threadIdx.x, lane = tid & 63, wave = __builtin_amdgcn_readfirstlane(tid >> 6);
    const int c = lane & 31, hh = lane >> 5;
    for (int hi = blockIdx.x; hi < 256; hi += gridDim.x) {
        const int h = hi & 7, rank = hi >> 3;
        __syncthreads();
        for (int idx = tid; idx < 2 * 128 * 16; idx += NTHR) { const int rowi = idx >> 4, ch = idx & 15;
            const v4u kv = *(const GAS v4u*)(keysb + (size_t)h * 32768 + rowi * 128 + ch * 8);
            *(LAS v4u*)(lds + rowi * 272 + ch * 16) = kv; }
        __syncthreads();
        for (int it = 0; it < 4; ++it) {
            const int tile = rank * 8 + wave + 256 * it;
            const size_t tok0 = (size_t)tile * 32;
            float ta[16], tb[16];
#pragma unroll
            for (int p = 0; p < 2; ++p) {
                bf16x8 bq[8];
                const bf16* qrow = Q + (tok0 + c) * 2048 + h * 256 + p * 128 + 8 * hh;
#pragma unroll
                for (int ks = 0; ks < 8; ++ks) bq[ks] = *(const GAS bf16x8*)(qrow + 16 * ks);
                f32x16 acc[4];
#pragma unroll
                for (int blk = 0; blk < 4; ++blk) {
#pragma unroll
                    for (int r = 0; r < 16; ++r) acc[blk][r] = 0.f;
#pragma unroll
                    for (int ks = 0; ks < 8; ++ks) { const bf16x8 a = *(const LAS bf16x8*)(lds + (p * 128 + 32 * blk + c) * 272 + (16 * ks + 8 * hh) * 2);
                        acc[blk] = __builtin_amdgcn_mfma_f32_32x32x16_bf16(a, bq[ks], acc[blk], 0, 0, 0); }
                }
                float v[64];
#pragma unroll
                for (int blk = 0; blk < 4; ++blk)
#pragma unroll
                    for (int r = 0; r < 16; ++r)
                    { const float sv = acc[blk][r]; v[blk * 16 + r] = __uint_as_float((__float_as_uint(sv) & ~127u) | (unsigned)(32 * blk + (r & 3) + 8 * (r >> 2)) | (unsigned)(hh << 2)); }
                __builtin_amdgcn_sched_barrier(0);
                bsort16_desc<0, 64>(v); bsort16_desc<16, 64>(v); bsort16_desc<32, 64>(v); bsort16_desc<48, 64>(v);
                merge_top16<0, 16, 64>(v); merge_top16<32, 48, 64>(v); merge_top16<0, 32, 64>(v);
                float o[16];
#pragma unroll
                for (int i = 0; i < 16; ++i) o[i] = __shfl_xor(v[i], 32);
#pragma unroll
                for (int i = 0; i < 16; ++i) v[i] = fmaxf(v[i], o[15 - i]);
                bmerge16_desc<0, 64>(v);
#pragma unroll
                for (int i = 0; i < 16; ++i) { if (p == 0) ta[i] = v[i]; else tb[i] = v[i]; }
                __builtin_amdgcn_sched_barrier(0);
            }
            float av[16], bv[16]; int ai[16], bi[16];
#pragma unroll
            for (int i = 0; i < 16; ++i) { const unsigned ua = __builtin_bit_cast(unsigned, ta[i]), ub = __builtin_bit_cast(unsigned, tb[i]);
                av[i] = __builtin_bit_cast(float, ua & ~127u); ai[i] = (int)(ua & 127u); bv[i] = __builtin_bit_cast(float, ub & ~127u); bi[i] = (int)(ub & 127u); }
            float ck[32]; int cp[32];
#pragma unroll
            for (int s2 = 0; s2 < 32; ++s2) {
                const float k0 = av[pair_i(s2)] + bv[pair_j(s2)]; const int p0 = (ai[pair_i(s2)] << 7) | bi[pair_j(s2)];
                float k1 = -INFINITY; int p1 = 0;
                if (s2 + 32 < 50) { k1 = av[pair_i(s2 + 32 < 50 ? s2 + 32 : 0)] + bv[pair_j(s2 + 32 < 50 ? s2 + 32 : 0)]; p1 = (ai[pair_i(s2 + 32 < 50 ? s2 + 32 : 0)] << 7) | bi[pair_j(s2 + 32 < 50 ? s2 + 32 : 0)]; }
                ck[s2] = hh ? k1 : k0; cp[s2] = hh ? p1 : p0;
            }
            __builtin_amdgcn_sched_barrier(0);
            bsort16p_desc<0, 32>(ck, cp); bsort16p_desc<16, 32>(ck, cp);
#pragma unroll
            for (int i = 0; i < 16; ++i) { if (ck[16 + 15 - i] > ck[i]) { ck[i] = ck[16 + 15 - i]; cp[i] = cp[16 + 15 - i]; } }
            bmerge16p_desc<0, 32>(ck, cp);
            { float ok[16]; int op[16];
#pragma unroll
              for (int i = 0; i < 16; ++i) { ok[i] = __shfl_xor(ck[i], 32); op[i] = __shfl_xor(cp[i], 32); }
#pragma unroll
              for (int i = 0; i < 16; ++i) { if (ok[15 - i] > ck[i]) { ck[i] = ok[15 - i]; cp[i] = op[15 - i]; } } }
            bmerge16p_desc<0, 32>(ck, cp);
            float ex[16]; float sum = 0.f;
#pragma unroll
            for (int i = 0; i < 16; ++i) { ex[i] = __expf(ck[i] - ck[0]); sum += ex[i]; }
            const float inv = 1.f / sum;
            if (hh == 0) {
                int* eo = EID + (tok0 + c) * 128 + h * 16; float* go = GATE + (tok0 + c) * 128 + h * 16;
#pragma unroll
                for (int i = 0; i < 4; ++i) { *(GAS v4u*)(eo + 4 * i) = (v4u){(unsigned)cp[4 * i], (unsigned)cp[4 * i + 1], (unsigned)cp[4 * i + 2], (unsigned)cp[4 * i + 3]};
                    *(GAS f32x4*)(go + 4 * i) = (f32x4){ex[4 * i] * inv, ex[4 * i + 1] * inv, ex[4 * i + 2] * inv, ex[4 * i + 3] * inv}; }
            }
        }
    }
    __syncthreads();
}
template <bool FINAL>
__device__ __forceinline__ void phase_gather(const bf16* X, const int* EID, const float* GATE, const float* U, const float* V, const float* g, const float* bb, bf16* Ob, float* Of) {
    const int tid = threadIdx.x, lane = tid & 63, wave = tid >> 6;
    const int gw = blockIdx.x * NWAVES + wave, NGW = gridDim.x * NWAVES;
    for (int t = gw; t < T; t += NGW) {
        f32x4 x[4], acc[4];
#pragma unroll
        for (int j = 0; j < 4; ++j) { const v2u w = *((const GAS v2u*)(X + (size_t)t * D) + lane + 64 * j);
            x[j] = (f32x4){bflo(w.x), bfhi(w.x), bflo(w.y), bfhi(w.y)}; acc[j] = (f32x4){0.f, 0.f, 0.f, 0.f}; }
        const int e0 = EID[(size_t)t * 128 + lane], e1 = EID[(size_t)t * 128 + 64 + lane];
        const float g0 = GATE[(size_t)t * 128 + lane], g1 = GATE[(size_t)t * 128 + 64 + lane];
#pragma unroll 2
        for (int k = 0; k < 128; ++k) {
            const int e = (k < 64) ? __shfl(e0, k) : __shfl(e1, k - 64);
            const float gt = (k < 64) ? __shfl(g0, k) : __shfl(g1, k - 64);
            const GAS f32x4* ur = (const GAS f32x4*)(U + (size_t)e * D) + lane;
            float dot = 0.f;
#pragma unroll
            for (int j = 0; j < 4; ++j) { const f32x4 u = ur[64 * j]; dot += (x[j].x * u.x + x[j].y * u.y) + (x[j].z * u.z + x[j].w * u.w); }
            dot = wave_sum(dot);
            const float a = 0.5f * dot * (1.f + erff(dot * 0.70710678118654752f));
            const float cf = gt * a;
            const GAS f32x4* vr = (const GAS f32x4*)(V + (size_t)e * D) + lane;
#pragma unroll
            for (int j = 0; j < 4; ++j) { const f32x4 v = vr[64 * j]; acc[j] += cf * v; }
        }
        float s = 0.f;
#pragma unroll
        for (int j = 0; j < 4; ++j) { acc[j] = ALPHA * x[j] + acc[j]; s += (acc[j].x + acc[j].y) + (acc[j].z + acc[j].w); }
        const float mean = wave_sum(s) * (1.f / D); float s2 = 0.f;
#pragma unroll
        for (int j = 0; j < 4; ++j) { acc[j] = acc[j] - mean; s2 += (acc[j].x * acc[j].x + acc[j].y * acc[j].y) + (acc[j].z * acc[j].z + acc[j].w * acc[j].w); }
        const float rstd = 1.f / sqrtf(wave_sum(s2) * (1.f / D) + LN_EPS);
#pragma unroll
        for (int j = 0; j < 4; ++j) { const f32x4 gg = *((const GAS f32x4*)g + lane + 64 * j), b4 = *((const GAS f32x4*)bb + lane + 64 * j);
            const f32x4 o = acc[j] * rstd * gg + b4;
            if (FINAL) *((GAS f32x4*)(Of + (size_t)t * D) + lane + 64 * j) = o;
            else { v2u w; w.x = pk2(o.x, o.y); w.y = pk2(o.z, o.w); *((GAS v2u*)(Ob + (size_t)t * D) + lane + 64 * j) = w; } }
    }
}

typedef float f32x2 __attribute__((ext_vector_type(2)));
__device__ __forceinline__ void phase_convert_tables(const float* U, const float* V, unsigned char* ws) {
    const int tid = threadIdx.x, lane = tid & 63, wave = tid >> 6;
    const int gw = blockIdx.x * NWAVES + wave, NGW = gridDim.x * NWAVES;
    for (int row = gw; row < 4 * NEXP; row += NGW) {
        const bool isv = row >= 2 * NEXP; const int r = row & (2 * NEXP - 1);
        const GAS f32x4* src = (const GAS f32x4*)((isv ? V : U) + (size_t)r * D) + 4 * lane; const int sstep = 1;
        f32x4 v[4]; float m = 0.f;
#pragma unroll
        for (int j = 0; j < 4; ++j) { v[j] = src[sstep * j]; m = fmaxf(fmaxf(m, fmaxf(fabsf(v[j].x), fabsf(v[j].y))), fmaxf(fabsf(v[j].z), fabsf(v[j].w))); }
#pragma unroll
        for (int o = 1; o < 64; o <<= 1) m = fmaxf(m, __shfl_xor(m, o));
        m = fmaxf(m, 1e-30f);
        const float sc = 7.f / m;
        unsigned w0 = 0u, w1 = 0u;
#define Q4(x) fminf(fmaxf((x) * sc, -6.f), 6.f)
        w0 = __builtin_amdgcn_cvt_scalef32_pk_fp4_f32(w0, Q4(v[0].x), Q4(v[0].y), 1.0f, 0); w0 = __builtin_amdgcn_cvt_scalef32_pk_fp4_f32(w0, Q4(v[0].z), Q4(v[0].w), 1.0f, 1);
        w0 = __builtin_amdgcn_cvt_scalef32_pk_fp4_f32(w0, Q4(v[1].x), Q4(v[1].y), 1.0f, 2); w0 = __builtin_amdgcn_cvt_scalef32_pk_fp4_f32(w0, Q4(v[1].z), Q4(v[1].w), 1.0f, 3);
        w1 = __builtin_amdgcn_cvt_scalef32_pk_fp4_f32(w1, Q4(v[2].x), Q4(v[2].y), 1.0f, 0); w1 = __builtin_amdgcn_cvt_scalef32_pk_fp4_f32(w1, Q4(v[2].z), Q4(v[2].w), 1.0f, 1);
        w1 = __builtin_amdgcn_cvt_scalef32_pk_fp4_f32(w1, Q4(v[3].x), Q4(v[3].y), 1.0f, 2); w1 = __builtin_amdgcn_cvt_scalef32_pk_fp4_f32(w1, Q4(v[3].z), Q4(v[3].w), 1.0f, 3);
#undef Q4
        *((GAS v2u*)(ws + (isv ? WS_V8 : WS_U8) + (size_t)r * 512) + lane) = (v2u){w0, w1};
        if (lane == 0) ((float*)(ws + (isv ? WS_DQV : WS_DQU)))[r] = m * (1.f / 7.f);
    }
}
__host__ __device__ constexpr int rev4(int i) { return ((i & 1) << 3) | ((i & 2) << 1) | ((i & 4) >> 1) | ((i & 8) >> 3); }
#define FMA2(a, b, c) __builtin_elementwise_fma((a), (b), (c))
#define CVT8(w, hi) __builtin_amdgcn_cvt_pk_f32_fp8((int)(w), (hi))
template <bool FINAL, int MODE  >
__device__ __forceinline__ void phase_gather8(const bf16* X, const int* EID, float* GATE, const unsigned char* U8, const unsigned char* V8, const float* DQU, const float* DQV,
                                              const float* g, const float* bb, bf16* Ob, float* Of) {
    const int tid = threadIdx.x, lane = tid & 63, wave = tid >> 6;
    const int gw = blockIdx.x * NWAVES + wave, NGW = gridDim.x * NWAVES;
    const bool b0 = (lane & 1) != 0, b1 = (lane & 2) != 0, b2 = (lane & 4) != 0, b3 = (lane & 8) != 0; const int myrow = lane >> 4;
    for (int t = gw; t < T; t += NGW) {
        f32x2 x[8];
#pragma unroll
        for (int j = 0; j < 4; ++j) { const v2u w = *((const GAS v2u*)(X + (size_t)t * D) + lane + 64 * j);
            x[2 * j] = (f32x2){bflo(w.x), bfhi(w.x)}; x[2 * j + 1] = (f32x2){bflo(w.y), bfhi(w.y)}; }
        const int e0 = EID[(size_t)t * 128 + lane], e1 = EID[(size_t)t * 128 + 64 + lane];
        const float gt0 = GATE[(size_t)t * 128 + lane], gt1 = GATE[(size_t)t * 128 + 64 + lane];
        const float dqu0 = DQU[e0], dqu1 = DQU[e1], dqv0 = DQV[e0], dqv1 = DQV[e1];
        float act0 = 0.f, act1 = 0.f;
        if (MODE != 2) {
#pragma unroll
        for (int r = 0; r < 2; ++r) {
            const int er = r ? e1 : e0;
            for (int row = 0; row < 4; ++row) {
                v4u w[16];
#pragma unroll
                for (int i = 0; i < 16; ++i) { const int e = __builtin_amdgcn_readlane(er, row * 16 + rev4(i)); w[i] = *((const GAS v4u*)(U8 + (size_t)e * 1024) + lane); }
                float p[16];
#pragma unroll
                for (int i = 0; i < 16; ++i) { f32x2 a = (f32x2){0.f, 0.f};
                    a = FMA2(x[0], CVT8(w[i].x, false), a); a = FMA2(x[1], CVT8(w[i].x, true), a);
                    a = FMA2(x[2], CVT8(w[i].y, false), a); a = FMA2(x[3], CVT8(w[i].y, true), a);
                    a = FMA2(x[4], CVT8(w[i].z, false), a); a = FMA2(x[5], CVT8(w[i].z, true), a);
                    a = FMA2(x[6], CVT8(w[i].w, false), a); a = FMA2(x[7], CVT8(w[i].w, true), a);
                    p[i] = a.x + a.y; }
                float r8[8], r4[4], r2[2];
#pragma unroll
                for (int i = 0; i < 8; ++i) { const float keep = b0 ? p[8 + i] : p[i], send = b0 ? p[i] : p[8 + i]; r8[i] = keep + __shfl_xor(send, 1); }
#pragma unroll
                for (int i = 0; i < 4; ++i) { const float keep = b1 ? r8[4 + i] : r8[i], send = b1 ? r8[i] : r8[4 + i]; r4[i] = keep + __shfl_xor(send, 2); }
#pragma unroll
                for (int i = 0; i < 2; ++i) { const float keep = b2 ? r4[2 + i] : r4[i], send = b2 ? r4[i] : r4[2 + i]; r2[i] = keep + __shfl_xor(send, 4); }
                float r1 = (b3 ? r2[1] : r2[0]) + __shfl_xor(b3 ? r2[0] : r2[1], 8);
                r1 += __shfl_xor(r1, 16); r1 += __shfl_xor(r1, 32);
                if (myrow == row) { if (r == 0) act0 = r1; else act1 = r1; }
            }
        }
        }
        float c0, c1;
        if (MODE != 2) { const float a0 = act0 * dqu0, a1 = act1 * dqu1;
          c0 = gt0 * (0.5f * a0 * (1.f + erff(a0 * 0.70710678118654752f))) * dqv0;
          c1 = gt1 * (0.5f * a1 * (1.f + erff(a1 * 0.70710678118654752f))) * dqv1; }
        else { c0 = gt0; c1 = gt1; }
        if (MODE == 1) { GATE[(size_t)t * 128 + lane] = c0; GATE[(size_t)t * 128 + 64 + lane] = c1; continue; }
        f32x2 acc[8];
#pragma unroll
        for (int j = 0; j < 8; ++j) acc[j] = (f32x2){0.f, 0.f};
#pragma unroll
        for (int r = 0; r < 2; ++r) {
            const int er = r ? e1 : e0; const int cr = __builtin_bit_cast(int, r ? c1 : c0);
            for (int row = 0; row < 4; ++row) {
                v4u w[16];
#pragma unroll
                for (int i = 0; i < 16; ++i) { const int e = __builtin_amdgcn_readlane(er, row * 16 + i); w[i] = *((const GAS v4u*)(V8 + (size_t)e * 1024) + lane); }
#pragma unroll
                for (int i = 0; i < 16; ++i) { const float cf = __builtin_bit_cast(float, __builtin_amdgcn_readlane(cr, row * 16 + i)); const f32x2 c2 = (f32x2){cf, cf};
                    acc[0] = FMA2(c2, CVT8(w[i].x, false), acc[0]); acc[1] = FMA2(c2, CVT8(w[i].x, true), acc[1]);
                    acc[2] = FMA2(c2, CVT8(w[i].y, false), acc[2]); acc[3] = FMA2(c2, CVT8(w[i].y, true), acc[3]);
                    acc[4] = FMA2(c2, CVT8(w[i].z, false), acc[4]); acc[5] = FMA2(c2, CVT8(w[i].z, true), acc[5]);
                    acc[6] = FMA2(c2, CVT8(w[i].w, false), acc[6]); acc[7] = FMA2(c2, CVT8(w[i].w, true), acc[7]); }
            }
        }
        float s = 0.f;
#pragma unroll
        for (int j = 0; j < 8; ++j) { acc[j] = x[j] * ALPHA + acc[j]; s += acc[j].x + acc[j].y; }
        const float mean = wave_sum(s) * (1.f / D); float s2 = 0.f;
#pragma unroll
        for (int j = 0; j < 8; ++j) { acc[j] = acc[j] - mean; s2 += acc[j].x * acc[j].x + acc[j].y * acc[j].y; }
        const float rstd = 1.f / sqrtf(wave_sum(s2) * (1.f / D) + LN_EPS);
#pragma unroll
        for (int j = 0; j < 4; ++j) { const f32x4 gg = *((const GAS f32x4*)g + lane + 64 * j), b4 = *((const GAS f32x4*)bb + lane + 64 * j);
            const f32x4 o = (f32x4){acc[2 * j].x, acc[2 * j].y, acc[2 * j + 1].x, acc[2 * j + 1].y} * rstd * gg + b4;
            if (FINAL) *((GAS f32x4*)(Of + (size_t)t * D) + lane + 64 * j) = o;
            else { v2u w; w.x = pk2(o.x, o.y); w.y = pk2(o.z, o.w); *((GAS v2u*)(Ob + (size_t)t * D) + lane + 64 * j) = w; } }
    }
}
__device__ __forceinline__ void phase_hgrn(LAS unsigned char* lds, unsigned char* ws) {
    const int tid = threadIdx.x;
    const bf16* CQ = (const bf16*)(ws + WS_CQ); const bf16* CK = (const bf16*)(ws + WS_CK); const bf16* CV = (const bf16*)(ws + WS_CV); bf16* O = (bf16*)(ws + WS_O);
    LAS float* fL = (LAS float*)lds;
    LAS float* kL = fL + 4096; LAS float* qL = kL + 4096;
    LAS float* vL = qL + 4096;
    LAS float* part = vL + 1024;
    for (int item = blockIdx.x; item < 256; item += gridDim.x) {
        const int es = item & 3, h = (item >> 2) & 7, b = item >> 5;
        const int e = tid & 31, dg = tid >> 5;
        float S[8];
#pragma unroll
        for (int j = 0; j < 8; ++j) S[j] = 0.f;
        for (int blk = 0; blk < SEQ / 32; ++blk) {
            const size_t t0 = (size_t)b * SEQ + blk * 32;
            for (int idx = tid; idx < 4096; idx += NTHR) { const int s = idx >> 7, d = idx & 127; const size_t o = (t0 + s) * D + h * 128 + d;
                const float kk = bf2f(CK[o]); kL[idx] = kk; fL[idx] = 1.f - kk; qL[idx] = bf2f(CQ[o]); }
            for (int idx = tid; idx < 1024; idx += NTHR) { const int s = idx >> 5, ee = idx & 31; vL[idx] = bf2f(CV[(t0 + s) * D + h * 128 + es * 32 + ee]); }
            __syncthreads();
            for (int s = 0; s < 32; ++s) { const float v = vL[s * 32 + e]; float po = 0.f;
#pragma unroll
                for (int j = 0; j < 8; ++j) { const int d = dg * 8 + j; S[j] = fL[s * 128 + d] * S[j] + kL[s * 128 + d] * v; po += qL[s * 128 + d] * S[j]; }
                part[(s * 16 + dg) * 32 + e] = po; }
            __syncthreads();
            for (int idx = tid; idx < 1024; idx += NTHR) { const int s = idx >> 5, ee = idx & 31; float o = 0.f;
#pragma unroll
                for (int g = 0; g < 16; ++g) o += part[(s * 16 + g) * 32 + ee];
                O[(t0 + s) * D + h * 128 + es * 32 + ee] = (bf16)f2bf(o); }
            __syncthreads();
        }
    }
}


#define GROW(wb, i_, tab, ereg, lsel) (wb)[i_] = *((const GAS v2u*)((tab) + (size_t)__builtin_amdgcn_readlane((ereg), (lsel)) * 512) + lane)
#define CVT4(wd, bs) __builtin_amdgcn_cvt_scalef32_pk_f32_fp4((wd), 1.0f, (bs))
#define CVT4H(wd, bs) __builtin_amdgcn_cvt_scalef32_pk_f16_fp4((wd), 1.0f, (bs))
typedef _Float16 h16x2 __attribute__((ext_vector_type(2)));
__device__ __forceinline__ void phase_gather_u(const bf16* X, const int* EID, float* GATE, const unsigned char* U8, const float* DQU, const float* DQV) {
    const int tid = threadIdx.x, lane = tid & 63, wave = tid >> 6;
    const int gw = blockIdx.x * NWAVES + wave, NGW = gridDim.x * NWAVES;
    const bool b0 = (lane & 1) != 0, b1 = (lane & 2) != 0, b2 = (lane & 4) != 0, b3 = (lane & 8) != 0; const int myrow = lane >> 4;
    int t = gw;
    if (t < T) {
    v2u xr[4]; int e0, e1; float gt0, gt1;
#pragma unroll
    for (int j = 0; j < 4; ++j) xr[j] = *((const GAS v2u*)(X + (size_t)t * D) + lane + 64 * j);
    e0 = EID[(size_t)t * 128 + lane]; e1 = EID[(size_t)t * 128 + 64 + lane]; gt0 = GATE[(size_t)t * 128 + lane]; gt1 = GATE[(size_t)t * 128 + 64 + lane];
    v2u wA[16], wB[16];
#pragma unroll
    for (int i = 0; i < 16; ++i) GROW(wA, i, U8, e0, rev4(i));
#pragma unroll
    for (int i = 0; i < 16; ++i) GROW(wB, i, U8, e0, 16 + rev4(i));
    for (;;) {
        const int tn = t + NGW; const bool has_next = tn < T;
        v2u nxr[4]; int ne0 = e0, ne1 = e1; float ngt0 = 0.f, ngt1 = 0.f;
        if (has_next) {
#pragma unroll
            for (int j = 0; j < 4; ++j) nxr[j] = *((const GAS v2u*)(X + (size_t)tn * D) + lane + 64 * j);
            ne0 = EID[(size_t)tn * 128 + lane]; ne1 = EID[(size_t)tn * 128 + 64 + lane]; ngt0 = GATE[(size_t)tn * 128 + lane]; ngt1 = GATE[(size_t)tn * 128 + 64 + lane];
        }
        const float dqu0 = DQU[e0], dqu1 = DQU[e1], dqv0 = DQV[e0], dqv1 = DQV[e1];
        h16x2 x[8];
#pragma unroll
        for (int j = 0; j < 4; ++j) { x[2 * j] = (h16x2){(_Float16)bflo(xr[j].x), (_Float16)bfhi(xr[j].x)}; x[2 * j + 1] = (h16x2){(_Float16)bflo(xr[j].y), (_Float16)bfhi(xr[j].y)}; }
        float act0 = 0.f, act1 = 0.f;
#define UBATCH(w, R, ROW, NEREG, NBASE) { float p[16]; \
            _Pragma("unroll") for (int i = 0; i < 16; ++i) { float a0_ = 0.f, a1_ = 0.f; \
                a0_ = __builtin_amdgcn_fdot2(x[0], CVT4H(w[i].x, 0), a0_, false); a1_ = __builtin_amdgcn_fdot2(x[1], CVT4H(w[i].x, 1), a1_, false); \
                a0_ = __builtin_amdgcn_fdot2(x[2], CVT4H(w[i].x, 2), a0_, false); a1_ = __builtin_amdgcn_fdot2(x[3], CVT4H(w[i].x, 3), a1_, false); \
                a0_ = __builtin_amdgcn_fdot2(x[4], CVT4H(w[i].y, 0), a0_, false); a1_ = __builtin_amdgcn_fdot2(x[5], CVT4H(w[i].y, 1), a1_, false); \
                a0_ = __builtin_amdgcn_fdot2(x[6], CVT4H(w[i].y, 2), a0_, false); a1_ = __builtin_amdgcn_fdot2(x[7], CVT4H(w[i].y, 3), a1_, false); \
                p[i] = a0_ + a1_; GROW(w, i, U8, NEREG, (NBASE) + rev4(i)); if ((i & 3) == 3) __builtin_amdgcn_sched_barrier(0); } \
            float r8[8], r4[4], r2[2]; \
            _Pragma("unroll") for (int i = 0; i < 8; ++i) { const float keep = b0 ? p[8 + i] : p[i], send = b0 ? p[i] : p[8 + i]; r8[i] = keep + __shfl_xor(send, 1); } \
            _Pragma("unroll") for (int i = 0; i < 4; ++i) { const float keep = b1 ? r8[4 + i] : r8[i], send = b1 ? r8[i] : r8[4 + i]; r4[i] = keep + __shfl_xor(send, 2); } \
            _Pragma("unroll") for (int i = 0; i < 2; ++i) { const float keep = b2 ? r4[2 + i] : r4[i], send = b2 ? r4[i] : r4[2 + i]; r2[i] = keep + __shfl_xor(send, 4); } \
            float r1 = (b3 ? r2[1] : r2[0]) + __shfl_xor(b3 ? r2[0] : r2[1], 8); \
            r1 += __shfl_xor(r1, 16); r1 += __shfl_xor(r1, 32); \
            if (myrow == (ROW)) { if ((R) == 0) act0 = r1; else act1 = r1; } }
        UBATCH(wA, 0, 0, e0, 32) UBATCH(wB, 0, 1, e0, 48) UBATCH(wA, 0, 2, e1, 0) UBATCH(wB, 0, 3, e1, 16)
        UBATCH(wA, 1, 0, e1, 32) UBATCH(wB, 1, 1, e1, 48) UBATCH(wA, 1, 2, ne0, 0) UBATCH(wB, 1, 3, ne0, 16)
#undef UBATCH
        { const float a0 = act0 * dqu0, a1 = act1 * dqu1;
          GATE[(size_t)t * 128 + lane] = gt0 * (0.5f * a0 * (1.f + erff(a0 * 0.70710678118654752f))) * dqv0;
          GATE[(size_t)t * 128 + 64 + lane] = gt1 * (0.5f * a1 * (1.f + erff(a1 * 0.70710678118654752f))) * dqv1; }
        if (!has_next) break;
        t = tn; e0 = ne0; e1 = ne1; gt0 = ngt0; gt1 = ngt1;
#pragma unroll
        for (int j = 0; j < 4; ++j) xr[j] = nxr[j];
    }
    }
}
template <bool FINAL, int EMASK = 0x7fffffff>
__device__ __forceinline__ void phase_gather_v(const bf16* X, const int* EID, const float* COEF, const unsigned char* V8, const float* g, const float* bb, bf16* Ob, float* Of) {
    const int tid = threadIdx.x, lane = tid & 63, wave = tid >> 6;
    const int gw = blockIdx.x * NWAVES + wave, NGW = gridDim.x * NWAVES;
    int t = gw;
    if (t < T) {
    v2u xr[4]; int e0, e1; float c0, c1;
#pragma unroll
    for (int j = 0; j < 4; ++j) xr[j] = *((const GAS v2u*)(X + (size_t)t * D) + lane + 64 * j);
    e0 = EID[(size_t)t * 128 + lane] & EMASK; e1 = EID[(size_t)t * 128 + 64 + lane] & EMASK; c0 = COEF[(size_t)t * 128 + lane]; c1 = COEF[(size_t)t * 128 + 64 + lane];
    v2u wA[16], wB[16];
#pragma unroll
    for (int i = 0; i < 16; ++i) GROW(wA, i, V8, e0, i);
#pragma unroll
    for (int i = 0; i < 16; ++i) GROW(wB, i, V8, e0, 16 + i);
    for (;;) {
        const int tn = t + NGW; const bool has_next = tn < T;
        v2u nxr[4]; int ne0 = e0, ne1 = e1; float nc0 = 0.f, nc1 = 0.f;
        if (has_next) {
#pragma unroll
            for (int j = 0; j < 4; ++j) nxr[j] = *((const GAS v2u*)(X + (size_t)tn * D) + lane + 64 * j);
            ne0 = EID[(size_t)tn * 128 + lane] & EMASK; ne1 = EID[(size_t)tn * 128 + 64 + lane] & EMASK; nc0 = COEF[(size_t)tn * 128 + lane]; nc1 = COEF[(size_t)tn * 128 + 64 + lane];
        }
        f32x2 acc[8];
#pragma unroll
        for (int j = 0; j < 8; ++j) acc[j] = (f32x2){0.f, 0.f};
#define VBATCH(w, CREG, BASE, NEREG, NBASE) { const int cr_ = __builtin_bit_cast(int, (CREG)); \
            _Pragma("unroll") for (int i = 0; i < 16; ++i) { const float cf = __builtin_bit_cast(float, __builtin_amdgcn_readlane(cr_, (BASE) + i)); const f32x2 c2 = (f32x2){cf, cf}; \
                acc[0] = FMA2(c2, CVT4(w[i].x, 0), acc[0]); acc[1] = FMA2(c2, CVT4(w[i].x, 1), acc[1]); \
                acc[2] = FMA2(c2, CVT4(w[i].x, 2), acc[2]); acc[3] = FMA2(c2, CVT4(w[i].x, 3), acc[3]); \
                acc[4] = FMA2(c2, CVT4(w[i].y, 0), acc[4]); acc[5] = FMA2(c2, CVT4(w[i].y, 1), acc[5]); \
                acc[6] = FMA2(c2, CVT4(w[i].y, 2), acc[6]); acc[7] = FMA2(c2, CVT4(w[i].y, 3), acc[7]); \
                GROW(w, i, V8, NEREG, (NBASE) + i); if ((i & 3) == 3) __builtin_amdgcn_sched_barrier(0); } }
        VBATCH(wA, c0, 0, e0, 32) VBATCH(wB, c0, 16, e0, 48) VBATCH(wA, c0, 32, e1, 0) VBATCH(wB, c0, 48, e1, 16)
        VBATCH(wA, c1, 0, e1, 32) VBATCH(wB, c1, 16, e1, 48) VBATCH(wA, c1, 32, ne0, 0) VBATCH(wB, c1, 48, ne0, 16)
#undef VBATCH
        float sm = 0.f;
#pragma unroll
        for (int j = 0; j < 4; ++j) { acc[2 * j] = (f32x2){bflo(xr[j].x), bfhi(xr[j].x)} * ALPHA + acc[2 * j]; acc[2 * j + 1] = (f32x2){bflo(xr[j].y), bfhi(xr[j].y)} * ALPHA + acc[2 * j + 1];
            sm += (acc[2 * j].x + acc[2 * j].y) + (acc[2 * j + 1].x + acc[2 * j + 1].y); }
        const float mean = wave_sum(sm) * (1.f / D); float s2 = 0.f;
#pragma unroll
        for (int j = 0; j < 8; ++j) { acc[j] = acc[j] - mean; s2 += acc[j].x * acc[j].x + acc[j].y * acc[j].y; }
        const float rstd = 1.f / sqrtf(wave_sum(s2) * (1.f / D) + LN_EPS);
#pragma unroll
        for (int j = 0; j < 4; ++j) { const f32x4 gg = *((const GAS f32x4*)g + lane + 64 * j), b4 = *((const GAS f32x4*)bb + lane + 64 * j);
            const f32x4 o = (f32x4){acc[2 * j].x, acc[2 * j].y, acc[2 * j + 1].x, acc[2 * j + 1].y} * rstd * gg + b4;
            if (FINAL) *((GAS f32x4*)(Of + (size_t)t * D) + lane + 64 * j) = o;
            else { v2u wo; wo.x = pk2(o.x, o.y); wo.y = pk2(o.z, o.w); *((GAS v2u*)(Ob + (size_t)t * D) + lane + 64 * j) = wo; } }
        if (!has_next) break;
        t = tn; e0 = ne0; e1 = ne1; c0 = nc0; c1 = nc1;
#pragma unroll
        for (int j = 0; j < 4; ++j) xr[j] = nxr[j];
    }
    }
}


template <bool FINAL>
__device__ __forceinline__ void phase_gather_v_mfma(const bf16* X, const int* EID, const float* COEF, const unsigned char* V4, const float* g, const float* bb, bf16* Ob, float* Of) {
    const int tid = threadIdx.x, lane = tid & 63, wave = tid >> 6;
    const int gw = blockIdx.x * NWAVES + wave, NGW = gridDim.x * NWAVES;
    const int n = lane & 31, hh = lane >> 5;
    unsigned mask[4];
#pragma unroll
    for (int d = 0; d < 4; ++d) mask[d] = (hh == (n >> 4) && d == ((n & 15) >> 2)) ? (0xFFu << (8 * (n & 3))) : 0u;
    float gl[16], bl[16];
#pragma unroll
    for (int r = 0; r < 16; ++r) { const int col = 32 * ((r & 3) + 8 * (r >> 2) + 4 * hh) + n; gl[r] = g[col]; bl[r] = bb[col]; }
    const unsigned laneoff = 16u * (unsigned)n;
    int t = gw;
    if (t < T) {
    int e0 = EID[(size_t)t * 128 + lane], e1 = EID[(size_t)t * 128 + 64 + lane];
    float c0 = COEF[(size_t)t * 128 + lane], c1 = COEF[(size_t)t * 128 + 64 + lane];
    v4u ring[16];
#define VLOADA(slot, ereg, lsel) { const int ea_ = __builtin_amdgcn_readlane((ereg), (lsel)), eb_ = __builtin_amdgcn_readlane((ereg), (lsel) + 1); const int el_ = hh ? eb_ : ea_; ring[slot] = *(const GAS v4u*)(V4 + (((unsigned)el_ << 9) + laneoff)); }
#pragma unroll
    for (int j = 0; j < 16; ++j) VLOADA(j, e0, 2 * j)
    for (;;) {
        const int tn = t + NGW; const bool has_next = tn < T;
        int ne0 = e0, ne1 = e1; float nc0 = 0.f, nc1 = 0.f;
        if (has_next) { ne0 = EID[(size_t)tn * 128 + lane]; ne1 = EID[(size_t)tn * 128 + 64 + lane]; nc0 = COEF[(size_t)tn * 128 + lane]; nc1 = COEF[(size_t)tn * 128 + 64 + lane]; }
        unsigned short xs[16];
#pragma unroll
        for (int r = 0; r < 16; ++r) xs[r] = X[(size_t)t * D + 32 * ((r & 3) + 8 * (r >> 2) + 4 * hh) + n];
        float cm = fmaxf(fabsf(c0), fabsf(c1));
#pragma unroll
        for (int o = 1; o < 64; o <<= 1) cm = fmaxf(cm, __shfl_xor(cm, o));
        unsigned ex = (__float_as_uint(cm) >> 23) & 0xffu; ex = ex < 8u ? 8u : ex;
        const float S = __uint_as_float((261u - ex) << 23), invS = __uint_as_float((ex - 7u) << 23);
        const unsigned wq = (unsigned)__builtin_amdgcn_cvt_pk_fp8_f32(c0 * S, c1 * S, 0, false);
        const int rep0 = (int)((wq & 0xffu) * 0x01010101u), rep1 = (int)(((wq >> 8) & 0xffu) * 0x01010101u);
        f32x16 acc;
#pragma unroll
        for (int r = 0; r < 16; ++r) acc[r] = 0.f;
#pragma unroll
        for (int J = 0; J < 64; ++J) {
            const int ra = __builtin_amdgcn_readlane((J >> 5) ? rep1 : rep0, (2 * J) & 63), rb = __builtin_amdgcn_readlane((J >> 5) ? rep1 : rep0, ((2 * J) & 63) + 1);
            v8i A, B;
            A[0] = (int)ring[J & 15].x; A[1] = (int)ring[J & 15].y; A[2] = (int)ring[J & 15].z; A[3] = (int)ring[J & 15].w; A[4] = 0; A[5] = 0; A[6] = 0; A[7] = 0;
#pragma unroll
            for (int d = 0; d < 4; ++d) { B[d] = ra & (int)mask[d]; B[4 + d] = rb & (int)mask[d]; }
            acc = __builtin_amdgcn_mfma_scale_f32_32x32x64_f8f6f4(A, B, acc, 4, 0, 0, 0x7f7f7f7f, 0, 0x7f7f7f7f);
            if (J + 16 < 64) { VLOADA(J & 15, ((J + 16) >> 5) ? e1 : e0, (2 * (J + 16)) & 63) }
            else { VLOADA(J & 15, ne0, 2 * (J + 16 - 64)) }
            if ((J & 3) == 3) __builtin_amdgcn_sched_barrier(0);
        }
        float z[16]; float sm = 0.f;
#pragma unroll
        for (int r = 0; r < 16; ++r) { const float av = acc[r]; z[r] = ALPHA * bf2f(xs[r]) + av * invS; sm += z[r]; }
        const float mean = wave_sum(sm) * (1.f / D); float s2 = 0.f;
#pragma unroll
        for (int r = 0; r < 16; ++r) { z[r] -= mean; s2 += z[r] * z[r]; }
        const float rstd = 1.f / sqrtf(wave_sum(s2) * (1.f / D) + LN_EPS);
#pragma unroll
        for (int r = 0; r < 16; ++r) { const int col = 32 * ((r & 3) + 8 * (r >> 2) + 4 * hh) + n; const float o = z[r] * rstd * gl[r] + bl[r];
            if (FINAL) Of[(size_t)t * D + col] = o; else Ob[(size_t)t * D + col] = (bf16)f2bf(o); }
        if (!has_next) break;
        t = tn; e0 = ne0; e1 = ne1; c0 = nc0; c1 = nc1;
    }
#undef VLOADA
    }
}

__device__ __forceinline__ void phase_gather_u_mfma(LAS unsigned char* lds, const bf16* X, const int* EID, float* GATE, const unsigned char* U4, const float* DQU, const float* DQV) {
    const int tid = threadIdx.x, lane = tid & 63, wave = __builtin_amdgcn_readfirstlane(tid >> 6);
    const int gw = blockIdx.x * NWAVES + wave, NGW = gridDim.x * NWAVES;
    const int n = lane & 31, hh = lane >> 5;
    LAS unsigned char* rows = lds + wave * 18048;
    LAS unsigned char* x8 = rows + 16896;
    const unsigned laneoff = 16u * (unsigned)n;
    int t = gw;
    if (t < T) {
    int e0 = EID[(size_t)t * 128 + lane], e1 = EID[(size_t)t * 128 + 64 + lane];
    v4u ring[16];
#define ULOADA(slot, ereg, lb, j_) { const int ea_ = __builtin_amdgcn_readlane((ereg), (lb) + 2 * (j_)), eb_ = __builtin_amdgcn_readlane((ereg), (lb) + 2 * (j_) + 1); const int el_ = hh ? eb_ : ea_; \
        ring[slot] = *(const GAS v4u*)(U4 + (((unsigned)el_ << 9) + laneoff)); }
#pragma unroll
    for (int j = 0; j < 16; ++j) ULOADA(j, e0, 0, j)
    for (;;) {
        const int tn = t + NGW; const bool has_next = tn < T;
        int ne0 = e0, ne1 = e1;
        if (has_next) { ne0 = EID[(size_t)tn * 128 + lane]; ne1 = EID[(size_t)tn * 128 + 64 + lane]; }
        const float gt0 = GATE[(size_t)t * 128 + lane], gt1 = GATE[(size_t)t * 128 + 64 + lane];
        const float dqu0 = DQU[e0], dqu1 = DQU[e1], dqv0 = DQV[e0], dqv1 = DQV[e1];
        { const v4u xa = *((const GAS v4u*)(X + (size_t)t * D) + 2 * lane), xb = *((const GAS v4u*)(X + (size_t)t * D) + 2 * lane + 1);
          int w0 = 0, w1 = 0, w2 = 0, w3 = 0;
          w0 = __builtin_amdgcn_cvt_pk_fp8_f32(bflo(xa.x), bfhi(xa.x), w0, false); w0 = __builtin_amdgcn_cvt_pk_fp8_f32(bflo(xa.y), bfhi(xa.y), w0, true);
          w1 = __builtin_amdgcn_cvt_pk_fp8_f32(bflo(xa.z), bfhi(xa.z), w1, false); w1 = __builtin_amdgcn_cvt_pk_fp8_f32(bflo(xa.w), bfhi(xa.w), w1, true);
          w2 = __builtin_amdgcn_cvt_pk_fp8_f32(bflo(xb.x), bfhi(xb.x), w2, false); w2 = __builtin_amdgcn_cvt_pk_fp8_f32(bflo(xb.y), bfhi(xb.y), w2, true);
          w3 = __builtin_amdgcn_cvt_pk_fp8_f32(bflo(xb.z), bfhi(xb.z), w3, false); w3 = __builtin_amdgcn_cvt_pk_fp8_f32(bflo(xb.w), bfhi(xb.w), w3, true);
          *(LAS v4u*)(x8 + 16 * lane) = (v4u){(unsigned)w0, (unsigned)w1, (unsigned)w2, (unsigned)w3}; }
        float act0 = 0.f, act1 = 0.f;
        for (int q = 0; q < 4; ++q) {
#pragma unroll
            for (int j = 0; j < 16; ++j) *(LAS v4u*)(rows + hh * 528 + 16 * n + j * 1056) = ring[j];
            __builtin_amdgcn_sched_barrier(0);
            { const int qn = q + 1;
              const int er = (qn >= 4) ? ne0 : ((qn >> 1) ? e1 : e0); const int lb = (qn >= 4) ? 0 : 32 * (qn & 1);
#pragma unroll
              for (int j = 0; j < 16; ++j) ULOADA(j, er, lb, j) }
            __builtin_amdgcn_sched_barrier(0);
            f32x16 acc;
#pragma unroll
            for (int r = 0; r < 16; ++r) acc[r] = 0.f;
            unsigned xo = 16u * (unsigned)hh; asm volatile("" : "+v"(xo));
#pragma unroll 2
            for (int ks = 0; ks < 16; ++ks) {
                const v4u a4 = *(const LAS v4u*)(rows + n * 528 + 16 * hh + 32 * ks);
                const v4u b0 = *(const LAS v4u*)(x8 + xo + 64 * ks), b1 = *(const LAS v4u*)(x8 + xo + 64 * ks + 32);
                v8i A, B;
                A[0] = (int)a4.x; A[1] = (int)a4.y; A[2] = (int)a4.z; A[3] = (int)a4.w; A[4] = 0; A[5] = 0; A[6] = 0; A[7] = 0;
                B[0] = (int)b0.x; B[1] = (int)b0.y; B[2] = (int)b0.z; B[3] = (int)b0.w; B[4] = (int)b1.x; B[5] = (int)b1.y; B[6] = (int)b1.z; B[7] = (int)b1.w;
                acc = __builtin_amdgcn_mfma_scale_f32_32x32x64_f8f6f4(A, B, acc, 4, 0, 0, 0x7f7f7f7f, 0, 0x7f7f7f7f);
            }
            if (n == 0) {
#pragma unroll
                for (int r = 0; r < 16; ++r) { const float av = acc[r]; *(LAS float*)(x8 + 1024 + 4 * ((r & 3) + 8 * (r >> 2) + 4 * hh)) = av; }
            }
            const float act = *(const LAS float*)(x8 + 1024 + 4 * n);
            if (hh == (q & 1)) { if (q >> 1) act1 = act; else act0 = act; }
        }
        { const float a0 = act0 * dqu0, a1 = act1 * dqu1;
          GATE[(size_t)t * 128 + lane] = gt0 * (0.5f * a0 * (1.f + erff(a0 * 0.70710678118654752f))) * dqv0;
          GATE[(size_t)t * 128 + 64 + lane] = gt1 * (0.5f * a1 * (1.f + erff(a1 * 0.70710678118654752f))) * dqv1; }
        if (!has_next) break;
        t = tn; e0 = ne0; e1 = ne1;
    }
#undef ULOADA
    }
}
__device__ __forceinline__ void phase_hgrn_prep(unsigned char* ws, float* scratch  ) {
    const int tid = threadIdx.x, lane = tid & 63, wave = tid >> 6;
    const int gw = blockIdx.x * NWAVES + wave, NGW = gridDim.x * NWAVES;
    bf16* CQ = (bf16*)(ws + WS_CQ); bf16* CK = (bf16*)(ws + WS_CK); const bf16* CV = (const bf16*)(ws + WS_CV);
    bf16* KOT = (bf16*)scratch; bf16* VT = (bf16*)scratch + (size_t)T * D; float* DEC = (float*)(ws + WS_DEC);
    for (int item = gw; item < 1024 * 8; item += NGW) {
        const int g = item >> 3, h = item & 7; const size_t t0 = (size_t)g * 32;
        float k0[32], k1[32], b0[32], b1[32]; float c0 = 0.f, c1 = 0.f;
#pragma unroll
        for (int s2 = 0; s2 < 32; ++s2) { const size_t o = (t0 + s2) * D + h * 128 + 2 * lane;
            const unsigned kw = *(const GAS unsigned*)(CK + o), qw = *(const GAS unsigned*)(CQ + o);
            const float ka = bflo(kw), kb = bfhi(kw);
            c0 += __logf(1.f - ka); c1 += __logf(1.f - kb);
            k0[s2] = ka; k1[s2] = kb; b0[s2] = c0; b1[s2] = c1;
            *(GAS unsigned*)(CQ + o) = pk2(bflo(qw) * __expf(c0), bfhi(qw) * __expf(c1));
            *(GAS unsigned*)(CK + o) = pk2(ka * __expf(-c0), kb * __expf(-c1)); }
        { GAS v4u* r0 = (GAS v4u*)(KOT + ((size_t)g * 1024 + h * 128 + 2 * lane) * 32);
#pragma unroll
          for (int j = 0; j < 4; ++j) { v4u w;
              w.x = pk2(k0[8 * j + 0] * __expf(c0 - b0[8 * j + 0]), k0[8 * j + 1] * __expf(c0 - b0[8 * j + 1])); w.y = pk2(k0[8 * j + 2] * __expf(c0 - b0[8 * j + 2]), k0[8 * j + 3] * __expf(c0 - b0[8 * j + 3]));
              w.z = pk2(k0[8 * j + 4] * __expf(c0 - b0[8 * j + 4]), k0[8 * j + 5] * __expf(c0 - b0[8 * j + 5])); w.w = pk2(k0[8 * j + 6] * __expf(c0 - b0[8 * j + 6]), k0[8 * j + 7] * __expf(c0 - b0[8 * j + 7]));
              r0[j] = w; }
#pragma unroll
          for (int j = 0; j < 4; ++j) { v4u w;
              w.x = pk2(k1[8 * j + 0] * __expf(c1 - b1[8 * j + 0]), k1[8 * j + 1] * __expf(c1 - b1[8 * j + 1])); w.y = pk2(k1[8 * j + 2] * __expf(c1 - b1[8 * j + 2]), k1[8 * j + 3] * __expf(c1 - b1[8 * j + 3]));
              w.z = pk2(k1[8 * j + 4] * __expf(c1 - b1[8 * j + 4]), k1[8 * j + 5] * __expf(c1 - b1[8 * j + 5])); w.w = pk2(k1[8 * j + 6] * __expf(c1 - b1[8 * j + 6]), k1[8 * j + 7] * __expf(c1 - b1[8 * j + 7]));
              r0[4 + j] = w; } }
        *(GAS v2u*)(DEC + (size_t)g * 1024 + h * 128 + 2 * lane) = (v2u){__float_as_uint(__expf(c0)), __float_as_uint(__expf(c1))};
        { unsigned va[16], vb[16];
#pragma unroll
          for (int j = 0; j < 16; ++j) { const unsigned w0 = *(const GAS unsigned*)(CV + (t0 + 2 * j) * D + h * 128 + 2 * lane), w1 = *(const GAS unsigned*)(CV + (t0 + 2 * j + 1) * D + h * 128 + 2 * lane);
              va[j] = (w0 & 0xffffu) | (w1 << 16); vb[j] = (w0 >> 16) | (w1 & 0xffff0000u); }
          GAS v4u* r0 = (GAS v4u*)(VT + ((size_t)g * 1024 + h * 128 + 2 * lane) * 32);
#pragma unroll
          for (int j = 0; j < 4; ++j) { r0[j] = (v4u){va[4 * j], va[4 * j + 1], va[4 * j + 2], va[4 * j + 3]}; r0[4 + j] = (v4u){vb[4 * j], vb[4 * j + 1], vb[4 * j + 2], vb[4 * j + 3]}; } }
    }
}
__device__ __forceinline__ void phase_hgrn_scan(LAS unsigned char* lds, unsigned char* ws, const float* scratch) {
    const int tid = threadIdx.x, lane = tid & 63, wave = __builtin_amdgcn_readfirstlane(tid >> 6);
    const int c = lane & 31, hh = lane >> 5;
    const bf16* QI = (const bf16*)(ws + WS_CQ); const bf16* KI = (const bf16*)(ws + WS_CK);
    const bf16* KOT = (const bf16*)scratch; const bf16* VT = (const bf16*)scratch + (size_t)T * D; const float* DEC = (const float*)(ws + WS_DEC);
    bf16* O = (bf16*)(ws + WS_O);
    constexpr int BUF = 30720, O_KI = 0, O_QI = 8704, O_KOT = 17408, O_VT = 27648, O_DEC = 30208, O_ST = 3 * BUF, O_P = O_ST + 8704, O_OB = O_P + 5120  ;
    for (int item = blockIdx.x; item < 256; item += gridDim.x) {
        const int pair = (item & 7) * 8 + (item >> 5), es = (item >> 3) & 3, h = pair & 7, b = pair >> 3;
        __syncthreads();
        for (int i = tid; i < 8704 / 16; i += NTHR) *(LAS v4u*)(lds + O_ST + i * 16) = (v4u){0u, 0u, 0u, 0u};
        f32x16 S[4];
#pragma unroll
        for (int blk = 0; blk < 4; ++blk)
#pragma unroll
            for (int r = 0; r < 16; ++r) S[blk][r] = 0.f;
        v4u rg[5];
        const int lw = wave - 2; const int lane0 = lane;
        auto load_chunk = [&](int n) {
            int lane = lane0; asm volatile("" : "+v"(lane));
            const size_t gch = (size_t)b * 128 + n, t0 = gch * 32;
            if (lw >= 0 && lw < 4) { const bf16* src = ((lw < 2) ? KI : QI) + (t0 + (lw & 1) * 16 + (lane >> 4)) * D + h * 128 + 8 * (lane & 15);
#pragma unroll
                for (int i = 0; i < 4; ++i) rg[i] = *(const GAS v4u*)(src + (size_t)(4 * i) * D);
                if (lw == 1 && lane < 32) rg[4] = *(const GAS v4u*)(DEC + gch * 1024 + h * 128 + 4 * lane);
            } else if (lw >= 4) { const bf16* src = KOT + (gch * 1024 + h * 128 + (lw - 4) * 64 + (lane >> 2)) * 32 + 8 * (lane & 3);
#pragma unroll
                for (int i = 0; i < 4; ++i) rg[i] = *(const GAS v4u*)(src + (size_t)(16 * i) * 32);
                rg[4] = *(const GAS v4u*)(VT + (gch * 1024 + h * 128 + es * 32 + (lw - 4) * 16 + (lane >> 2)) * 32 + 8 * (lane & 3));
            }
        };
        auto store_chunk = [&](int bufi) {
            int lane = lane0; asm volatile("" : "+v"(lane));
            LAS unsigned char* bp = lds + bufi * BUF;
            if (lw >= 0 && lw < 4) { LAS unsigned char* dst = bp + ((lw < 2) ? O_KI : O_QI) + ((lw & 1) * 16 + (lane >> 4)) * 272 + (lane & 15) * 16;
#pragma unroll
                for (int i = 0; i < 4; ++i) *(LAS v4u*)(dst + (4 * i) * 272) = rg[i];
                if (lw == 1 && lane < 32) *(LAS v4u*)(bp + O_DEC + 16 * lane) = rg[4];
            } else if (lw >= 4) { LAS unsigned char* dst = bp + O_KOT + ((lw - 4) * 64 + (lane >> 2)) * 80 + (lane & 3) * 16;
#pragma unroll
                for (int i = 0; i < 4; ++i) *(LAS v4u*)(dst + (16 * i) * 80) = rg[i];
                *(LAS v4u*)(bp + O_VT + ((lw - 4) * 16 + (lane >> 2)) * 80 + (lane & 3) * 16) = rg[4];
            }
        };
        auto scores = [&](int n) {
            LAS unsigned char* bp = lds + (n % 3) * BUF; LAS unsigned char* pi = lds + O_P + (n & 1) * 2560;
            f32x16 sc;
#pragma unroll
            for (int r = 0; r < 16; ++r) sc[r] = 0.f;
            bf16x8 kf[8], qf[8];
#pragma unroll
            for (int ks = 0; ks < 8; ++ks) { kf[ks] = *(const LAS bf16x8*)(bp + O_KI + c * 272 + (16 * ks + 8 * hh) * 2); qf[ks] = *(const LAS bf16x8*)(bp + O_QI + c * 272 + (16 * ks + 8 * hh) * 2); }
            __builtin_amdgcn_sched_barrier(0);
#pragma unroll
            for (int ks = 0; ks < 8; ++ks) sc = __builtin_amdgcn_mfma_f32_32x32x16_bf16(kf[ks], qf[ks], sc, 0, 0, 0);
#pragma unroll
            for (int g4 = 0; g4 < 4; ++g4) { float m[4];
#pragma unroll
                for (int q = 0; q < 4; ++q) { const float sv = sc[4 * g4 + q]; m[q] = (8 * g4 + 4 * hh + q <= c) ? sv : 0.f; }
                *(LAS v2u*)(pi + c * 80 + (8 * g4 + 4 * hh) * 2) = (v2u){pk2(m[0], m[1]), pk2(m[2], m[3])}; }
        };
        load_chunk(0); store_chunk(0); load_chunk(1); store_chunk(1); load_chunk(2);
        __syncthreads();
        if (wave == 1) scores(0);
        __syncthreads();
        for (int n = 0; n < 128; ++n) {
            if (n + 2 < 128) store_chunk((n + 2) % 3);
            if (n + 3 < 128) load_chunk(n + 3);
            if (wave == 1 && n + 1 < 128) scores(n + 1);
            if (wave == 2 && n > 0) {
                const int row = lane >> 1, half = lane & 1; const LAS f32x4* ob = (const LAS f32x4*)(lds + O_OB + ((n - 1) & 1) * 4096 + row * 128 + half * 64);
                const f32x4 v0 = ob[0], v1 = ob[1], v2 = ob[2], v3 = ob[3];
                const size_t tp = ((size_t)b * 128 + (n - 1)) * 32 + row;
                GAS v4u* op = (GAS v4u*)(O + tp * D + h * 128 + es * 32 + half * 16);
                op[0] = (v4u){pk2(v0.x, v0.y), pk2(v0.z, v0.w), pk2(v1.x, v1.y), pk2(v1.z, v1.w)};
                op[1] = (v4u){pk2(v2.x, v2.y), pk2(v2.z, v2.w), pk2(v3.x, v3.y), pk2(v3.z, v3.w)};
            }
            if (wave == 0) {
                LAS unsigned char* bp = lds + (n % 3) * BUF; LAS unsigned char* pi = lds + O_P + (n & 1) * 2560;
                const size_t t0 = ((size_t)b * 128 + n) * 32;
                bf16x8 vf[2];
                f32x16 o;
#pragma unroll
                for (int r = 0; r < 16; ++r) o[r] = 0.f;
                bf16x8 pf[2], qf[8], sf[8];
#pragma unroll
                for (int ks = 0; ks < 2; ++ks) { pf[ks] = *(const LAS bf16x8*)(pi + c * 80 + (16 * ks + 8 * hh) * 2); vf[ks] = *(const LAS bf16x8*)(bp + O_VT + c * 80 + (16 * ks + 8 * hh) * 2); }
#pragma unroll
                for (int ks = 0; ks < 8; ++ks) { qf[ks] = *(const LAS bf16x8*)(bp + O_QI + c * 272 + (16 * ks + 8 * hh) * 2); sf[ks] = *(const LAS bf16x8*)(lds + O_ST + c * 272 + (16 * ks + 8 * hh) * 2); }
                __builtin_amdgcn_sched_barrier(0);
#pragma unroll
                for (int ks = 0; ks < 2; ++ks) o = __builtin_amdgcn_mfma_f32_32x32x16_bf16(pf[ks], vf[ks], o, 0, 0, 0);
#pragma unroll
                for (int ks = 0; ks < 8; ++ks) o = __builtin_amdgcn_mfma_f32_32x32x16_bf16(qf[ks], sf[ks], o, 0, 0, 0);
                __builtin_amdgcn_sched_barrier(0);
#pragma unroll
                for (int hb = 0; hb < 2; ++hb) {
                    bf16x8 af[2][2]; f32x16 dvec[2];
#pragma unroll
                    for (int bi = 0; bi < 2; ++bi) { const int blk = 2 * hb + bi;
#pragma unroll
                        for (int ks = 0; ks < 2; ++ks) af[bi][ks] = *(const LAS bf16x8*)(bp + O_KOT + (32 * blk + c) * 80 + (16 * ks + 8 * hh) * 2);
#pragma unroll
                        for (int g4 = 0; g4 < 4; ++g4) { const f32x4 dv = *(const LAS f32x4*)(bp + O_DEC + (32 * blk + 8 * g4 + 4 * hh) * 4);
                            dvec[bi][4 * g4 + 0] = dv.x; dvec[bi][4 * g4 + 1] = dv.y; dvec[bi][4 * g4 + 2] = dv.z; dvec[bi][4 * g4 + 3] = dv.w; }
                    }
                    __builtin_amdgcn_sched_barrier(0);
#pragma unroll
                    for (int bi = 0; bi < 2; ++bi) S[2 * hb + bi] = S[2 * hb + bi] * dvec[bi];
#pragma unroll
                    for (int ks = 0; ks < 2; ++ks)
#pragma unroll
                        for (int bi = 0; bi < 2; ++bi) S[2 * hb + bi] = __builtin_amdgcn_mfma_f32_32x32x16_bf16(af[bi][ks], vf[ks], S[2 * hb + bi], 0, 0, 0);
                    __builtin_amdgcn_sched_barrier(0);
                    if (hb == 0) {
#pragma unroll
                        for (int r = 0; r < 16; ++r) { const float ov = o[r]; *(LAS float*)(lds + O_OB + (n & 1) * 4096 + ((r & 3) + 8 * (r >> 2) + 4 * hh) * 128 + 4 * c) = ov; }
                    }
                }
                __builtin_amdgcn_sched_barrier(0);
#pragma unroll
                for (int blk = 0; blk < 4; ++blk)
#pragma unroll
                    for (int g4 = 0; g4 < 4; ++g4) { const float s0 = S[blk][4 * g4 + 0], s1 = S[blk][4 * g4 + 1], s2 = S[blk][4 * g4 + 2], s3 = S[blk][4 * g4 + 3];
                        *(LAS v2u*)(lds + O_ST + c * 272 + (32 * blk + 8 * g4 + 4 * hh) * 2) = (v2u){pk2(s0, s1), pk2(s2, s3)}; }
            }
            __syncthreads();
        }
        if (wave == 2) { const int row = lane >> 1, half = lane & 1; const LAS f32x4* ob = (const LAS f32x4*)(lds + O_OB + (127 & 1) * 4096 + row * 128 + half * 64);
            const f32x4 v0 = ob[0], v1 = ob[1], v2 = ob[2], v3 = ob[3];
            const size_t tp = ((size_t)b * 128 + 127) * 32 + row;
            GAS v4u* op = (GAS v4u*)(O + tp * D + h * 128 + es * 32 + half * 16);
            op[0] = (v4u){pk2(v0.x, v0.y), pk2(v0.z, v0.w), pk2(v1.x, v1.y), pk2(v1.z, v1.w)};
            op[1] = (v4u){pk2(v2.x, v2.y), pk2(v2.z, v2.w), pk2(v3.x, v3.y), pk2(v3.z, v3.w)}; }
    }
}
__device__ __forceinline__ void phase_hgrn_norm(const float* norm_g, unsigned char* ws) {
    const int tid = threadIdx.x, lane = tid & 63, wave = tid >> 6;
    const int gw = blockIdx.x * NWAVES + wave, NGW = gridDim.x * NWAVES;
    const bf16* O = (const bf16*)(ws + WS_O); const bf16* CG = (const bf16*)(ws + WS_CG); bf16* Y2 = (bf16*)(ws + WS_Y2);
    for (int t = gw; t < T; t += NGW) {
        const v4u a0 = *((const GAS v4u*)(O + (size_t)t * D) + lane * 2), a1 = *((const GAS v4u*)(O + (size_t)t * D) + lane * 2 + 1);
        const v4u g0 = *((const GAS v4u*)(CG + (size_t)t * D) + lane * 2), g1 = *((const GAS v4u*)(CG + (size_t)t * D) + lane * 2 + 1);
        float o[16], gv[16];
        o[0] = bflo(a0.x); o[1] = bfhi(a0.x); o[2] = bflo(a0.y); o[3] = bfhi(a0.y); o[4] = bflo(a0.z); o[5] = bfhi(a0.z); o[6] = bflo(a0.w); o[7] = bfhi(a0.w);
        o[8] = bflo(a1.x); o[9] = bfhi(a1.x); o[10] = bflo(a1.y); o[11] = bfhi(a1.y); o[12] = bflo(a1.z); o[13] = bfhi(a1.z); o[14] = bflo(a1.w); o[15] = bfhi(a1.w);
        gv[0] = bflo(g0.x); gv[1] = bfhi(g0.x); gv[2] = bflo(g0.y); gv[3] = bfhi(g0.y); gv[4] = bflo(g0.z); gv[5] = bfhi(g0.z); gv[6] = bflo(g0.w); gv[7] = bfhi(g0.w);
        gv[8] = bflo(g1.x); gv[9] = bfhi(g1.x); gv[10] = bflo(g1.y); gv[11] = bfhi(g1.y); gv[12] = bflo(g1.z); gv[13] = bfhi(g1.z); gv[14] = bflo(g1.w); gv[15] = bfhi(g1.w);
        float sq = 0.f;
#pragma unroll
        for (int j = 0; j < 16; ++j) sq += o[j] * o[j];
        sq += __shfl_xor(sq, 1); sq += __shfl_xor(sq, 2); sq += __shfl_xor(sq, 4);
        const float r = 1.f / sqrtf(sq * (1.f / 128.f) + LN_EPS);
        float y[16];
#pragma unroll
        for (int j = 0; j < 16; ++j) { const float sg = gv[j] / (1.f + expf(-gv[j])); y[j] = o[j] * r * norm_g[lane * 16 + j] * sg; }
        v4u w0, w1; w0.x = pk2(y[0], y[1]); w0.y = pk2(y[2], y[3]); w0.z = pk2(y[4], y[5]); w0.w = pk2(y[6], y[7]);
        w1.x = pk2(y[8], y[9]); w1.y = pk2(y[10], y[11]); w1.z = pk2(y[12], y[13]); w1.w = pk2(y[14], y[15]);
        *((GAS v4u*)(Y2 + (size_t)t * D) + lane * 2) = w0; *((GAS v4u*)(Y2 + (size_t)t * D) + lane * 2 + 1) = w1;
    }
}

struct Args { const float* in[16]; float* out; unsigned char* ws; int ph_lo, ph_hi, li, pad; };
__global__ void __launch_bounds__(NTHR, 2) mk_fwd(Args args) {
    extern __shared__ __attribute__((aligned(16))) unsigned char lds_raw[];
    LAS unsigned char* lds = (LAS unsigned char*)lds_raw;
    volatile LAS unsigned* MISC = (volatile LAS unsigned*)(lds + MISC_OFF);
    const int tid = threadIdx.x;
    unsigned char* ws = args.ws;
    gu32* ctl = (gu32*)(ws + WS_CTL);
    if (tid < 32) ((LAS unsigned*)(lds + MISC_OFF))[tid] = 0u;
    __syncthreads();
    XcdBarrier bar; bar.bar = (unsigned*)ctl + CW_BAR; bar.x = 0; bar.st = nullptr;
    if (N_LAUNCHES == 1) bar = xcd_barrier_post((unsigned*)ctl + CW_BAR, MISC + 8);
    const int lo = args.ph_lo, hi = args.ph_hi;
#define IN(k) (lo <= (k) && (k) < hi)
#define SEAM(k) do { if (IN(k) && IN((k) + 1)) xcd_barrier(bar); } while (0)
    const float* const* in = args.in;
    bf16* XB = (bf16*)(ws + WS_XB); bf16* H0 = (bf16*)(ws + WS_H0); bf16* Y = (bf16*)(ws + WS_Y); bf16* H1 = (bf16*)(ws + WS_H1);
    int* EID = (int*)(ws + WS_EID); float* GATE = (float*)(ws + WS_GATE);
    bf16* Z = (bf16*)args.out;

    int ph_ = 0;
#define PH_BEGIN if (lo <= ph_ && ph_ < hi) for (int rep_ = 0; rep_ < 1 + (int)((DUP_MASK >> ph_) & 1u); ++rep_) {
#define PH_END } if (lo <= ph_ && ph_ + 1 < hi) xcd_barrier(bar); ++ph_;
      PH_BEGIN phase_prologue(lds, in, ws); phase_convert_tables(in[12], in[13], ws); PH_END
      PH_BEGIN pg8::Gemm g{XB, (const bf16*)(ws + WS_WABIN), T, AB_IN, D}; pg8::StaticOrder S; S.init(T, AB_IN, (int)gridDim.x, (int)blockIdx.x); pg8::EpiBf16<0> E{H0, AB_IN, nullptr, 0, 0, 1.f};
                     pg8::gemm_phase<pg8::EpiBf16<0>, pg8::StaticOrder, true, true>(lds, g, S, E); PH_END
      PH_BEGIN phase_ret_local(lds, ws); PH_END
      PH_BEGIN phase_ret_prefix(ws); PH_END
      PH_BEGIN phase_ret_out_pool_fast(lds, in, ws); PH_END
      PH_BEGIN pg8::Gemm g{Y, (const bf16*)(ws + WS_WABOUT), T, D, D}; pg8::StaticOrder S; S.init(T, D, (int)gridDim.x, (int)blockIdx.x); pg8::EpiResidF32 E{XB, Z};
                     pg8::gemm_phase<pg8::EpiResidF32, pg8::StaticOrder, true, true>(lds, g, S, E); PH_END
      PH_BEGIN phase_ln(Z, H1, in[14], in[15]); PH_END
      PH_BEGIN pg8::Gemm g{H1, (const bf16*)(ws + WS_WQ), T, 2048, D}; pg8::StaticOrder S; S.init(T, 2048, (int)gridDim.x, (int)blockIdx.x); pg8::EpiBf16<0> E{H0  , 2048, nullptr, 0, 0, 1.f};
                     pg8::gemm_phase<pg8::EpiBf16<0>, pg8::StaticOrder, true, true>(lds, g, S, E); PH_END
      PH_BEGIN phase_topk_fast(lds, H0, (const bf16*)(ws + WS_KEYS), EID, GATE); PH_END
      PH_BEGIN phase_gather_u_mfma(lds, H1, EID, GATE, ws + WS_U8, (const float*)(ws + WS_DQU), (const float*)(ws + WS_DQV)); PH_END
      PH_BEGIN phase_gather_v_mfma<false>(H1, EID, GATE, ws + WS_V8, in[14] + D, in[15] + D, XB  , nullptr); PH_END
#ifdef PROBE_L2
    PH_BEGIN phase_gather_v<false, PROBE_L2>(H1, EID, GATE, ws + WS_V8, in[14] + D, in[15] + D, Y  , nullptr); PH_END
#endif
      PH_BEGIN pg8::Gemm g{XB, (const bf16*)(ws + WS_WCIN), T, C_IN, D}; pg8::StaticOrder S; S.init(T, C_IN, (int)gridDim.x, (int)blockIdx.x);
                      pg8::EpiCInF E2{(bf16*)(ws + WS_CQ), (bf16*)(ws + WS_CK), (bf16*)(ws + WS_CV), (bf16*)(ws + WS_CG), (const float*)(ws + WS_LB)};
                      pg8::gemm_phase<pg8::EpiCInF, pg8::StaticOrder, true, true>(lds, g, S, E2); PH_END
      PH_BEGIN phase_hgrn_prep(ws, args.out); PH_END
      PH_BEGIN phase_hgrn_scan(lds, ws, args.out); PH_END
      PH_BEGIN phase_hgrn_norm(in[8], ws); PH_END
      PH_BEGIN pg8::Gemm g{(const bf16*)(ws + WS_Y2), (const bf16*)(ws + WS_WCOUT), T, D, D}; pg8::StaticOrder S; S.init(T, D, (int)gridDim.x, (int)blockIdx.x); pg8::EpiResidF32 E{XB, Z};
                      pg8::gemm_phase<pg8::EpiResidF32, pg8::StaticOrder, true, true>(lds, g, S, E); PH_END
      PH_BEGIN phase_ln(Z, H1  , in[14] + 2 * D, in[15] + 2 * D); PH_END
      PH_BEGIN pg8::Gemm g{H1, (const bf16*)(ws + WS_WQ) + (size_t)2048 * D, T, 2048, D}; pg8::StaticOrder S; S.init(T, 2048, (int)gridDim.x, (int)blockIdx.x); pg8::EpiBf16<0> E{(bf16*)(ws + WS_Q1), 2048, nullptr, 0, 0, 1.f};
                      pg8::gemm_phase<pg8::EpiBf16<0>, pg8::StaticOrder, true, true>(lds, g, S, E); PH_END
      PH_BEGIN phase_topk_fast(lds, (const bf16*)(ws + WS_Q1), (const bf16*)(ws + WS_KEYS) + (size_t)8 * 2 * 128 * 128, EID, GATE); PH_END
      PH_BEGIN phase_gather_u_mfma(lds, H1, EID, GATE, ws + WS_U8 + (size_t)NEXP * 512, (const float*)(ws + WS_DQU) + NEXP, (const float*)(ws + WS_DQV) + NEXP); PH_END
      PH_BEGIN phase_gather_v_mfma<true>(H1, EID, GATE, ws + WS_V8 + (size_t)NEXP * 512, in[14] + 3 * D, in[15] + 3 * D, nullptr, args.out); PH_END
#undef PH_BEGIN
#undef PH_END
#undef IN
#undef SEAM
}

extern "C" void kernel_launch(void* const* d_in, const int* in_sizes, int n_in, void* d_out, int out_size, void* d_ws, size_t ws_size, hipStream_t stream) {
    static int grid = 0;
    if (grid == 0) {
        if (n_in != 16 || in_sizes[0] != T * D || out_size != T * D || ws_size < WS_END) { fprintf(stderr, "kernel_launch: unexpected problem (n_in %d, in0 %d, out %d, ws %zu); nothing launched\n", n_in, n_in > 0 ? in_sizes[0] : -1, out_size, ws_size); grid = -1; return; }
        int dev = 0, cus = 0;
        if (hipGetDevice(&dev) != hipSuccess || hipDeviceGetAttribute(&cus, hipDeviceAttributeMultiprocessorCount, dev) != hipSuccess) { grid = -1; return; }
        if (hipFuncSetAttribute((const void*)mk_fwd, hipFuncAttributeMaxDynamicSharedMemorySize, LDS_BYTES) != hipSuccess) { fprintf(stderr, "kernel_launch: hipFuncSetAttribute failed\n"); grid = -1; return; }
        (void)hipGetLastError();
        grid = cus;
    }
    if (grid < 0) return;
    if (hipMemsetAsync((char*)d_ws + WS_CTL, 0, CTL_ZERO_BYTES, stream) != hipSuccess) return;
    Args a{};
    for (int i = 0; i < 16; ++i) a.in[i] = (const float*)d_in[i];
    a.out = (float*)d_out; a.ws = (unsigned char*)d_ws;
    for (int li = 0; li < N_LAUNCHES; ++li) {
        a.ph_lo = (N_LAUNCHES == 1) ? 0 : li; a.ph_hi = (N_LAUNCHES == 1) ? NPHASE : li + 1; a.li = li;
        hipLaunchKernelGGL(mk_fwd, dim3(grid), dim3(NTHR), LDS_BYTES, stream, a);
        if (hipPeekAtLastError() != hipSuccess) { fprintf(stderr, "kernel_launch: launch %d failed\n", li); break; }
    }
}
```
